# Optimizing an MI355X kernel written in HIP

```python
import math
import jax, jax.numpy as jnp
from jax import lax
import numpy as np

D_MODEL = 1024
BATCH = 8
SEQ = 8192
DEPTH = 1

CTX_LEN = 256
GRID_W = 64
MIX_W = D_MODEL
F_W = MIX_W // 2
F_GROUPS = 4
F_GROUP_W = F_W // F_GROUPS
DN_W = MIX_W - F_W
DN_HEADS = 4
DK = DN_W // DN_HEADS
DV = DN_W // DN_HEADS
QK_W = DN_HEADS * DK
V_W = DN_HEADS * DV
CONV_CH = 2 * QK_W + V_W
W_IN = F_W + CONV_CH + V_W + 4 * DN_HEADS
CONV_K = 3
CHUNK = 64
N_GROUPS = 4
EXPERTS_PER_GROUP = 8
N_EXPERTS = N_GROUPS * EXPERTS_PER_GROUP
TOP_K = 2
D_EXPERT = D_MODEL // 2
MOE_BLOCK = 128
EPS = 1e-6

kernel_name = "hymba_fnet_gdn_hmoe_dit"


def rmsnorm(x, g):
    xf = x.astype(jnp.float32)
    y = xf * lax.rsqrt(jnp.mean(xf * xf, axis=-1, keepdims=True) + EPS) * g.astype(jnp.float32)
    return y.astype(x.dtype)


def l2norm(a):
    af = a.astype(jnp.float32)
    return af * lax.rsqrt(jnp.sum(af * af, axis=-1, keepdims=True) + EPS)


def modulate(h, shift, scale):
    return h * (1 + scale) + shift


def conv_grid(u, w):
    b, t, ch = u.shape
    rows = t // GRID_W
    y = lax.conv_general_dilated(u.reshape(b, rows, GRID_W, ch), w[:, :, None, :].astype(u.dtype),
                                 (1, 1), 'SAME', dimension_numbers=('NHWC', 'HWIO', 'NHWC'),
                                 feature_group_count=ch)
    return y.reshape(b, t, ch)


def conv_seq(u, w):
    ch = u.shape[-1]
    return lax.conv_general_dilated(u, w[1][:, None, :].astype(u.dtype), (1,), 'SAME',
                                    dimension_numbers=('NWC', 'WIO', 'NWC'), feature_group_count=ch)


def fourier_mix(f):
    b, t, _ = f.shape
    fg = f.astype(jnp.float32).reshape(b, t, F_GROUPS, F_GROUP_W)
    out = jnp.fft.fft2(fg, axes=(1, 3), norm='ortho').real
    return out.reshape(b, t, F_W).astype(f.dtype)


def gated_delta_chunked(q, k, v, g, beta, s0):
    b, t, h, dk = q.shape
    dv = v.shape[-1]
    n = t // CHUNK

    def chunks(a):
        a = jnp.moveaxis(a.astype(jnp.float32), 2, 1)
        return a.reshape(b, h, n, CHUNK, *a.shape[3:])

    q = chunks(q) * dk ** -0.5
    k = chunks(k)
    v = chunks(v)
    beta = chunks(beta)
    gc = jnp.cumsum(chunks(g), axis=-1)
    idx = jnp.arange(CHUNK)
    lower = idx[:, None] >= idx[None, :]
    decay = jnp.exp(jnp.where(lower, gc[..., :, None] - gc[..., None, :], -jnp.inf))
    k_beta = k * beta[..., None]
    m = jnp.where(idx[:, None] > idx[None, :],
                  jnp.einsum('bhnid,bhnjd->bhnij', k_beta, k) * decay, 0.0)
    eye = jnp.eye(CHUNK, dtype=jnp.float32)
    a_mat = eye + m
    t_inv = lax.linalg.triangular_solve(a_mat, jnp.broadcast_to(eye, a_mat.shape), left_side=True,
                                        lower=True, unit_diagonal=True)
    u = t_inv @ (v * beta[..., None])
    w = t_inv @ (k_beta * jnp.exp(gc)[..., None])
    intra = jnp.einsum('bhnid,bhnjd->bhnij', q, k) * decay

    def step(s, blk):
        q_i, k_i, u_i, w_i, a_i, g_i = blk
        v_new = u_i - w_i @ s
        o_i = (q_i * jnp.exp(g_i)[..., None]) @ s + a_i @ v_new
        g_last = g_i[..., -1:]
        s = s * jnp.exp(g_last)[..., None] + jnp.einsum(
            'bhcd,bhce->bhde', k_i * jnp.exp(g_last - g_i)[..., None], v_new)
        return s, o_i

    xs = tuple(jnp.moveaxis(a, 2, 0) for a in (q, k, u, w, intra, gc))
    s_final, o = lax.scan(step, s0.astype(jnp.float32), xs)
    o = jnp.moveaxis(o, 0, 2).reshape(b, h, t, dv)
    return jnp.moveaxis(o, 1, 2), s_final


def bidir_delta(q, k, v, g, beta, s0_fwd, s0_bwd):
    flip = lambda a: jnp.flip(a, axis=1)
    o_f, s_f = gated_delta_chunked(q, k, v, g[:, :, 0], beta[:, :, 0], s0_fwd)
    o_b, s_b = gated_delta_chunked(flip(q), flip(k), flip(v), flip(g[:, :, 1]), flip(beta[:, :, 1]), s0_bwd)
    return o_f + flip(o_b), s_f, s_b


def mixer_features(h, w_in, conv_w, a_log, dt_bias, conv_fn):
    b, t = h.shape[:2]
    p = h @ w_in
    f, qkv, z, gates = jnp.split(p, [F_W, F_W + CONV_CH, F_W + CONV_CH + V_W], axis=-1)
    qkv = jax.nn.silu(conv_fn(qkv, conv_w))
    q, k, v = jnp.split(qkv, [QK_W, 2 * QK_W], axis=-1)
    q = l2norm(q.reshape(b, t, DN_HEADS, DK))
    k = l2norm(k.reshape(b, t, DN_HEADS, DK))
    v = v.reshape(b, t, DN_HEADS, DV)
    gates = gates.astype(jnp.float32).reshape(b, t, 2, 2, DN_HEADS)
    beta = jax.nn.sigmoid(gates[:, :, 0])
    g = -jnp.exp(a_log.astype(jnp.float32)) * jax.nn.softplus(gates[:, :, 1] + dt_bias.astype(jnp.float32))
    return f, q, k, v, z, g, beta


def mixer_output(f, o, z, onorm_g, w_out):
    b, t = f.shape[:2]
    o = (rmsnorm(o, onorm_g) * jax.nn.silu(z.reshape(b, t, DN_HEADS, DV))).astype(f.dtype)
    return jnp.concatenate([fourier_mix(f), o.reshape(b, t, V_W)], axis=-1) @ w_out


def moe_ffn(h, w_group, b_group, w_router, b_router, w_gate, w_up, w_down):
    shp = h.shape
    d = shp[-1]
    xf = h.reshape(-1, d)
    n = xf.shape[0]
    pg = jax.nn.softmax((xf @ w_group).astype(jnp.float32) + b_group.astype(jnp.float32), axis=-1)
    pg_top, g_top = lax.top_k(pg, 1)
    el = ((xf @ w_router).astype(jnp.float32) + b_router.astype(jnp.float32)).reshape(
        n, N_GROUPS, EXPERTS_PER_GROUP)
    el_g = el[jnp.arange(n), g_top[:, 0]]
    pe_top, e_top = lax.top_k(jax.nn.softmax(el_g, axis=-1), TOP_K)
    wts = pg_top * pe_top / jnp.sum(pe_top, axis=-1, keepdims=True)
    eid = (g_top * EXPERTS_PER_GROUP + e_top).reshape(-1).astype(jnp.int32)
    w_f = wts.reshape(-1)
    n_assign = n * TOP_K
    order = jnp.argsort(eid)
    e_s = eid[order]
    tok_s = (order // TOP_K).astype(jnp.int32)
    w_s = w_f[order]
    counts = jnp.zeros((N_EXPERTS,), jnp.int32).at[eid].add(1)
    start = jnp.cumsum(counts) - counts
    pcounts = (counts + MOE_BLOCK - 1) // MOE_BLOCK * MOE_BLOCK
    pend = jnp.cumsum(pcounts)
    pstart = pend - pcounts
    dest = pstart[e_s] + (jnp.arange(n_assign, dtype=jnp.int32) - start[e_s])
    n_slots = -(-n_assign // MOE_BLOCK) * MOE_BLOCK + N_EXPERTS * MOE_BLOCK
    n_blocks = n_slots // MOE_BLOCK
    slot_tok = jnp.full((n_slots,), n, jnp.int32).at[dest].set(tok_s)
    slot_w = jnp.zeros((n_slots,), jnp.float32).at[dest].set(w_s)
    blk_expert = jnp.minimum(
        jnp.searchsorted(pend, jnp.arange(n_blocks, dtype=jnp.int32) * MOE_BLOCK, side='right'),
        N_EXPERTS - 1)
    x_pad = jnp.concatenate([xf, jnp.zeros((1, d), xf.dtype)], axis=0)
    xs = x_pad[slot_tok].reshape(n_blocks, MOE_BLOCK, d)

    def expert_block(args):
        xb, e = args
        hid = jax.nn.silu(xb @ w_gate[e]) * (xb @ w_up[e])
        return hid @ w_down[e]

    ys = lax.map(expert_block, (xs, blk_expert)).reshape(n_slots, d)
    out = jnp.zeros((n + 1, d), ys.dtype).at[slot_tok].add(ys * slot_w[:, None].astype(ys.dtype))
    return out[:n].reshape(shp)


def trunk_layer(x, ctx, c, c_ctx, w_mod, b_mod, norm1_g, w_in, conv_w, a_log, dt_bias, onorm_g, w_out,
                norm2_g, w_group, b_group, w_router, b_router, w_gate, w_up, w_down, update_ctx):
    mod_x = jnp.split((jax.nn.silu(c) @ w_mod + b_mod)[:, None, :], 6, axis=-1)
    mod_c = jnp.split((jax.nn.silu(c_ctx) @ w_mod + b_mod)[None, None, :], 6, axis=-1)

    hc = modulate(rmsnorm(ctx, norm1_g), mod_c[0], mod_c[1])
    fc, qc, kc, vc, zc, gc, bc = mixer_features(hc, w_in, conv_w, a_log, dt_bias, conv_seq)
    zero_state = jnp.zeros((ctx.shape[0], DN_HEADS, DK, DV), jnp.float32)
    oc, s_fwd, s_bwd = bidir_delta(qc, kc, vc, gc, bc, zero_state, zero_state)

    hx = modulate(rmsnorm(x, norm1_g), mod_x[0], mod_x[1])
    fx, qx, kx, vx, zx, gx, bx = mixer_features(hx, w_in, conv_w, a_log, dt_bias, conv_grid)
    ox, _, _ = bidir_delta(qx, kx, vx, gx, bx, s_fwd, s_bwd)
    x = x + mod_x[2] * mixer_output(fx, ox, zx, onorm_g, w_out)
    x = x + mod_x[5] * moe_ffn(modulate(rmsnorm(x, norm2_g), mod_x[3], mod_x[4]),
                               w_group, b_group, w_router, b_router, w_gate, w_up, w_down)
    if update_ctx:
        ctx = ctx + mod_c[2] * mixer_output(fc, oc, zc, onorm_g, w_out)
        ctx = ctx + mod_c[5] * moe_ffn(modulate(rmsnorm(ctx, norm2_g), mod_c[3], mod_c[4]),
                                       w_group, b_group, w_router, b_router, w_gate, w_up, w_down)
    return x, ctx


def setup_inputs(seed: int = 0) -> dict:
    key = jax.random.key(seed)
    ks = jax.random.split(key, 24)
    nrm = lambda k, shape, s: jax.random.normal(k, shape, jnp.float32) * s
    x = nrm(ks[0], (BATCH, SEQ, D_MODEL), 1.0)
    c = nrm(ks[1], (BATCH, D_MODEL), 1.0)
    ctx = nrm(ks[2], (BATCH, CTX_LEN, D_MODEL), 1.0)
    c_ctx = nrm(ks[3], (D_MODEL,), 1.0)
    w_mod = nrm(ks[4], (DEPTH, D_MODEL, 6 * D_MODEL), 0.5 * D_MODEL ** -0.5)
    b_mod = nrm(ks[5], (DEPTH, 6 * D_MODEL), 0.01)
    norm1_g = 1.0 + nrm(ks[6], (DEPTH, D_MODEL), 0.02)
    w_in = nrm(ks[7], (DEPTH, D_MODEL, W_IN), D_MODEL ** -0.5)
    conv_w = nrm(ks[8], (DEPTH, CONV_K, CONV_K, CONV_CH), 1.0 / CONV_K)
    a_log = jnp.log(jax.random.uniform(ks[9], (DEPTH, 2, DN_HEADS), jnp.float32, 1.0, 16.0))
    dt = jnp.exp(jax.random.uniform(ks[10], (DEPTH, 2, DN_HEADS), jnp.float32,
                                    math.log(1e-3), math.log(1e-1)))
    dt_bias = dt + jnp.log(-jnp.expm1(-dt))
    onorm_g = 1.0 + nrm(ks[11], (DEPTH, DV), 0.02)
    w_out = nrm(ks[12], (DEPTH, MIX_W, D_MODEL), MIX_W ** -0.5)
    norm2_g = 1.0 + nrm(ks[13], (DEPTH, D_MODEL), 0.02)
    w_group = nrm(ks[14], (DEPTH, D_MODEL, N_GROUPS), D_MODEL ** -0.5)
    b_group = nrm(ks[15], (DEPTH, N_GROUPS), 0.01)
    w_router = nrm(ks[16], (DEPTH, D_MODEL, N_EXPERTS), D_MODEL ** -0.5)
    b_router = nrm(ks[17], (DEPTH, N_EXPERTS), 0.01)
    w_gate = nrm(ks[18], (DEPTH, N_EXPERTS, D_MODEL, D_EXPERT), D_MODEL ** -0.5)
    w_up = nrm(ks[19], (DEPTH, N_EXPERTS, D_MODEL, D_EXPERT), D_MODEL ** -0.5)
    w_down = nrm(ks[20], (DEPTH, N_EXPERTS, D_EXPERT, D_MODEL), D_EXPERT ** -0.5)
    final_g = 1.0 + nrm(ks[21], (D_MODEL,), 0.02)
    return {"x": x, "c": c, "ctx": ctx, "c_ctx": c_ctx, "w_mod": w_mod, "b_mod": b_mod,
            "norm1_g": norm1_g, "w_in": w_in, "conv_w": conv_w, "a_log": a_log, "dt_bias": dt_bias,
            "onorm_g": onorm_g, "w_out": w_out, "norm2_g": norm2_g, "w_group": w_group,
            "b_group": b_group, "w_router": w_router, "b_router": b_router, "w_gate": w_gate,
            "w_up": w_up, "w_down": w_down, "final_g": final_g}


def reference(x, c, ctx, c_ctx, w_mod, b_mod, norm1_g, w_in, conv_w, a_log, dt_bias, onorm_g, w_out,
              norm2_g, w_group, b_group, w_router, b_router, w_gate, w_up, w_down, final_g):
    for l in range(DEPTH):
        x, ctx = trunk_layer(x, ctx, c, c_ctx, w_mod[l], b_mod[l], norm1_g[l], w_in[l], conv_w[l], a_log[l],
                             dt_bias[l], onorm_g[l], w_out[l], norm2_g[l], w_group[l], b_group[l],
                             w_router[l], b_router[l], w_gate[l], w_up[l], w_down[l],
                             update_ctx=(l < DEPTH - 1))
    return rmsnorm(x, final_g)
```

```cpp
#ifndef CPU_EMU
#include <hip/hip_runtime.h>
#include <cstdio>
#include <cstdint>
#define DEV __device__ __forceinline__
#define TID tid_local
#define PHASE_TID int tid_local = (int)threadIdx.x; asm volatile("" : "+v"(tid_local))
#define BID ((int)blockIdx.x)
#define NBLK ((int)gridDim.x)
#define SYNC() __syncthreads()
#endif

typedef unsigned short bf16_t;
typedef short bf16x8 __attribute__((ext_vector_type(8)));
typedef float f32x4 __attribute__((ext_vector_type(4)));
typedef unsigned u32x4 __attribute__((ext_vector_type(4)));
typedef unsigned u32x2 __attribute__((ext_vector_type(2)));

constexpr int D = 1024, NB = 8, SEQ = 8192, CTX = 256;
constexpr int NTOK = NB * SEQ;
constexpr int NCTX = NB * CTX;
constexpr int MROWS = NTOK + NCTX;
constexpr int W_IN = 2576;
constexpr int NSTEP = 4 + 128;
constexpr int NCHAIN = NB * 4 * 2;
constexpr int NPROB = NCHAIN * NSTEP;
constexpr float EPS = 1e-6f;
constexpr int NEXP = 32;
constexpr int LCAP = 65536;

constexpr int IMG_W = 0, IMG_KT = 17408, IMG_Q = 35840, IMG_A = 53248, IMG_U = 62464, IMG_SC = 79872, IMG_BYTES = 79936;

constexpr size_t MiB = 1048576;
constexpr size_t WS_BAR = 0;
constexpr size_t WS_MOD = 16384;
constexpr size_t WS_CNT = 16384 + 221184;
constexpr size_t WS_ZERO_BYTES = WS_CNT + 256;
constexpr size_t WS_TAB = 262144;
constexpr size_t WS_GB = 1 * MiB;
constexpr size_t WS_TOKK = 6 * MiB;
constexpr size_t WS_WL = 14 * MiB;
constexpr size_t WS_W = 22 * MiB;
constexpr size_t WS_WQKVZ = WS_W;
constexpr size_t WS_WF = WS_WQKVZ + 2048ull * 1024 * 2;
constexpr size_t WS_WOUT = WS_WF + 1024ull * 1024 * 2;
constexpr size_t WS_WGU = WS_WOUT + 1024ull * 1024 * 2;
constexpr size_t WS_WD = WS_WGU + 32ull * 1024 * 1024 * 2;
constexpr size_t WS_R3 = 126 * MiB;
constexpr size_t WS_R4 = 324 * MiB;
constexpr size_t WS_NEED = WS_R4 + 645 * MiB;
constexpr size_t R4_H = 0, R4_P = 132 * MiB;
constexpr size_t R4_AMIX = 0, R4_H2 = 128 * MiB, R4_HID = 256 * MiB, R4_Y = 0;
constexpr size_t DO_GT = 0, DO_ZT = 128 * MiB, DO_ZS = 192 * MiB;

constexpr int LDS_BYTES = 153600;

struct Params {
    const float *x, *c, *ctx, *c_ctx, *w_mod, *b_mod, *norm1_g, *w_in, *conv_w, *a_log, *dt_bias, *onorm_g, *w_out, *norm2_g,
                *w_group, *b_group, *w_router, *b_router, *w_gate, *w_up, *w_down, *final_g;
    float* out;
    unsigned char* ws;
};

DEV bf16_t f2bf(float f) { unsigned u = __builtin_bit_cast(unsigned, f); u += 0x7FFFu + ((u >> 16) & 1u); return (bf16_t)(u >> 16); }
DEV float bf2f(bf16_t b) { return __builtin_bit_cast(float, ((unsigned)b) << 16); }
DEV unsigned pk2(float lo, float hi) { return (unsigned)f2bf(lo) | ((unsigned)f2bf(hi) << 16); }
DEV float silu_f(float v) { return v / (1.0f + __expf(-v)); }

#ifndef CPU_EMU
DEV f32x4 mfma16(bf16x8 a, bf16x8 b, f32x4 c) { return __builtin_amdgcn_mfma_f32_16x16x32_bf16(a, b, c, 0, 0, 0); }
DEV float shfl_xor_f(float v, int m) { return __shfl_xor(v, m); }
DEV float shfl_up_f(float v, int d) { return __shfl_up(v, d); }
DEV void atomic_add_f32(float* p, float v) { atomicAdd(p, v); }
DEV unsigned atomic_add_u32(unsigned* p, unsigned v) { return atomicAdd(p, v); }
DEV void sincospi_f(float x, float* s, float* c) { sincospif(x, s, c); }
#endif

DEV float wave_sum(float v) {
#pragma unroll
    for (int o = 32; o >= 1; o >>= 1) v += shfl_xor_f(v, o);
    return v;
}
DEV bf16x8 frag_gather(const bf16_t* p, int stride) {
    bf16x8 r;
#pragma unroll
    for (int j = 0; j < 8; ++j) r[j] = (short)p[j * stride];
    return r;
}
DEV bf16x8 frag16(const bf16_t* p) { return *(const bf16x8*)p; }

DEV void phase0_mod(const Params& P, unsigned char* sm) {
    PHASE_TID;
    float* sil = (float*)sm;
    for (int i = TID; i < 9 * 1024; i += 512) { const int r = i >> 10, k = i & 1023; const float v = r < 8 ? P.c[r * 1024 + k] : P.c_ctx[k]; sil[i] = silu_f(v); }
    SYNC();
    float* mod = (float*)(P.ws + WS_MOD);
    for (int it = BID; it < 12 * 64; it += NBLK) {
        const int cb = it % 12, kc = it / 12, j = cb * 512 + TID, k0 = kc * 16;
        float acc[9];
#pragma unroll
        for (int r = 0; r < 9; ++r) acc[r] = 0.f;
        for (int kk = 0; kk < 16; ++kk) { const float w = P.w_mod[(size_t)(k0 + kk) * 6144 + j];
#pragma unroll
            for (int r = 0; r < 9; ++r) acc[r] += sil[r * 1024 + k0 + kk] * w; }
        if (kc == 0) { const float bb = P.b_mod[j];
#pragma unroll
            for (int r = 0; r < 9; ++r) acc[r] += bb; }
#pragma unroll
        for (int r = 0; r < 9; ++r) atomic_add_f32(&mod[r * 6144 + j], acc[r]);
    }
    SYNC();
}

DEV void tconv_tile(const float* src, int lds_, bf16_t* dst, int ldd, unsigned char* sm) {
    PHASE_TID;
    float* tile = (float*)sm;
    const int r = TID >> 4, c4 = (TID & 15) * 4;
#pragma unroll
    for (int pass = 0; pass < 2; ++pass) { const int rr = r + pass * 32; const f32x4 v = *(const f32x4*)(src + (size_t)rr * lds_ + c4);
        tile[rr * 65 + c4 + 0] = v[0]; tile[rr * 65 + c4 + 1] = v[1]; tile[rr * 65 + c4 + 2] = v[2]; tile[rr * 65 + c4 + 3] = v[3]; }
    SYNC();
    const int cr = TID >> 3, seg = (TID & 7) * 8;
    u32x4 w;
    w[0] = pk2(tile[(seg + 0) * 65 + cr], tile[(seg + 1) * 65 + cr]); w[1] = pk2(tile[(seg + 2) * 65 + cr], tile[(seg + 3) * 65 + cr]);
    w[2] = pk2(tile[(seg + 4) * 65 + cr], tile[(seg + 5) * 65 + cr]); w[3] = pk2(tile[(seg + 6) * 65 + cr], tile[(seg + 7) * 65 + cr]);
    *(u32x4*)(dst + (size_t)cr * ldd + seg) = w;
    SYNC();
}

DEV void phase0_weights(const Params& P, unsigned char* sm) {
    bf16_t* wqkvz = (bf16_t*)(P.ws + WS_WQKVZ); bf16_t* wout = (bf16_t*)(P.ws + WS_WOUT); bf16_t* wgu = (bf16_t*)(P.ws + WS_WGU); bf16_t* wd = (bf16_t*)(P.ws + WS_WD);
    const int NJ = 512 + 256 + 3 * 4096;
    for (int t = BID; t < NJ; t += NBLK) {
        if (t < 512) { const int kt = t >> 5, nt = t & 31;
            tconv_tile(P.w_in + (size_t)(kt * 64) * W_IN + 512 + nt * 64, W_IN, wqkvz + (size_t)(nt * 64) * 1024 + kt * 64, 1024, sm);
        } else if (t < 768) { const int u = t - 512, kt = u >> 4, nt = u & 15;
            tconv_tile(P.w_out + (size_t)(kt * 64) * 1024 + nt * 64, 1024, wout + (size_t)(nt * 64) * 1024 + kt * 64, 1024, sm);
        } else if (t < 768 + 8192) { const int u = t - 768, up = u >> 12, v = u & 4095, e = v >> 7, w = v & 127, kt = w >> 3, nt = w & 7;
            const float* src = (up ? P.w_up : P.w_gate) + (size_t)e * 1024 * 512 + (size_t)(kt * 64) * 512 + nt * 64;
            const int n0 = nt * 64, drow = (n0 >> 7) * 256 + up * 128 + (n0 & 127);
            tconv_tile(src, 512, wgu + (size_t)e * 1024 * 1024 + (size_t)drow * 1024 + kt * 64, 1024, sm);
        } else { const int v = t - 768 - 8192, e = v >> 7, w = v & 127, kt = w >> 4, nt = w & 15;
            tconv_tile(P.w_down + (size_t)e * 512 * 1024 + (size_t)(kt * 64) * 1024 + nt * 64, 1024, wd + (size_t)e * 1024 * 512 + (size_t)(nt * 64) * 512 + kt * 64, 512, sm);
        }
    }
}

DEV void phase0_wf(const Params& P, unsigned char* sm) {
    PHASE_TID;
    float* cs = (float*)sm;
    if (TID < 128) { float s, c; sincospi_f((float)TID * (2.0f / 128.0f), &s, &c); cs[TID] = c; cs[128 + TID] = s; }
    SYNC();
    bf16_t* wf = (bf16_t*)(P.ws + WS_WF);
    const float sc = 0.08838834764831845f;
    for (int it = BID; it < 256; it += NBLK) {
        const int kb = it & 1, cb = (it >> 1) & 15, part = (it >> 5) & 1, g = it >> 6;
        const int k = kb * 512 + TID;
        const float* wrow = P.w_in + (size_t)k * W_IN + g * 128;
        float acc[8];
#pragma unroll
        for (int q = 0; q < 8; ++q) acc[q] = 0.f;
        for (int c = 0; c < 128; ++c) { const float w = wrow[c];
#pragma unroll
            for (int q = 0; q < 8; ++q) { const int cp = cb * 8 + q; acc[q] += w * cs[part * 128 + ((c * cp) & 127)]; } }
#pragma unroll
        for (int q = 0; q < 8; ++q) { const int chc = part * 512 + g * 128 + cb * 8 + q; wf[(size_t)chc * 1024 + k] = f2bf((part ? -acc[q] : acc[q]) * sc); }
    }
    bf16_t* tab = (bf16_t*)(P.ws + WS_TAB);
    const float sc2 = 0.011048543456039806f;
    for (int i = BID * 512 + TID; i < 4096 + 16384; i += NBLK * 512) {
        if (i < 4096) { const int a = i >> 6, b = i & 63; float s, c; sincospi_f((float)((a * b) & 63) * (2.0f / 64.0f), &s, &c); tab[i] = f2bf(c); tab[4096 + i] = f2bf(s); }
        else { const int j = i - 4096, a = j >> 7, b = j & 127; float s, c; sincospi_f((float)((a * b) & 127) * (2.0f / 128.0f), &s, &c); tab[8192 + j] = f2bf(c * sc2); tab[8192 + 16384 + j] = f2bf(s * sc2); }
    }
}

DEV void phase1_prep(const Params& P, unsigned char* sm) {
    PHASE_TID;
    float* wg = (float*)sm;
    for (int i = TID; i < 1024 * 16; i += 512) wg[i] = P.w_in[(size_t)(i >> 4) * W_IN + 2560 + (i & 15)];
    SYNC();
    const float* mod = (const float*)(P.ws + WS_MOD);
    bf16_t* h = (bf16_t*)(P.ws + WS_R4 + R4_H);
    float* gb = (float*)(P.ws + WS_GB);
    const int wid = TID >> 6, lane = TID & 63;
    for (int r = BID * 8 + wid; r < MROWS; r += NBLK * 8) {
        const float* src; int mb;
        if (r < NTOK) { src = P.x + (size_t)r * D; mb = r >> 13; } else { src = P.ctx + (size_t)(r - NTOK) * D; mb = 8; }
        const float* shift = mod + mb * 6144, *scale = shift + 1024;
        float ss = 0.f;
#pragma unroll
        for (int i = 0; i < 4; ++i) { const f32x4 t = *(const f32x4*)(src + i * 256 + lane * 4); ss += t[0] * t[0] + t[1] * t[1] + t[2] * t[2] + t[3] * t[3]; }
        ss = wave_sum(ss);
        const float rstd = 1.0f / sqrtf(ss * (1.0f / 1024.0f) + EPS);
        float ga[16];
#pragma unroll
        for (int j = 0; j < 16; ++j) ga[j] = 0.f;
#pragma unroll 1
        for (int i = 0; i < 4; ++i) {
            const int k = i * 256 + lane * 4;
            const f32x4 vv = *(const f32x4*)(src + k);
            const f32x4 g1 = *(const f32x4*)(P.norm1_g + k), sc = *(const f32x4*)(scale + k), sh = *(const f32x4*)(shift + k);
            float hv[4];
#pragma unroll
            for (int e = 0; e < 4; ++e) hv[e] = vv[e] * rstd * g1[e] * (1.0f + sc[e]) + sh[e];
            u32x2 w; w[0] = pk2(hv[0], hv[1]); w[1] = pk2(hv[2], hv[3]);
            *(u32x2*)(h + (size_t)r * D + k) = w;
#pragma unroll
            for (int e = 0; e < 4; ++e) {
#pragma unroll
                for (int q = 0; q < 4; ++q) { const f32x4 wv = *(const f32x4*)(wg + (k + e) * 16 + q * 4);
                    ga[q * 4 + 0] += hv[e] * wv[0]; ga[q * 4 + 1] += hv[e] * wv[1]; ga[q * 4 + 2] += hv[e] * wv[2]; ga[q * 4 + 3] += hv[e] * wv[3]; } }
        }
        float mine = 0.f;
#pragma unroll
        for (int j = 0; j < 16; ++j) { const float t = wave_sum(ga[j]); if (lane == j) mine = t; }
        if (lane < 16) {
            float o;
            if (lane < 8) o = 1.0f / (1.0f + __expf(-mine));
            else { const int dh = lane - 8; const float z = mine + P.dt_bias[dh]; const float sp = z > 20.f ? z : log1pf(__expf(z)); o = -__expf(P.a_log[dh]) * sp; }
            gb[(size_t)r * 16 + lane] = o;
        }
    }
}

#ifndef CPU_EMU
namespace pg8 {
#define PG8_LAS __attribute__((address_space(3)))
constexpr int BM = 256, BK = 64, HALF = 128, HTB = HALF * BK * 2, STAGE_BYTES = 8 * HTB;
__device__ __forceinline__ int lds_byte(int r, int c) { const int st = (r >> 4) * 2 + (c >> 5), rr = r & 15, cc = c & 31, ob = rr * 64 + cc * 2; return st * 1024 + (ob ^ (((ob >> 9) & 1) << 5)); }
__device__ __forceinline__ void stage_rc(int b, int& R, int& C) { const int st = b / 1024, sb = b % 1024, swz = sb ^ (((sb >> 9) & 1) << 5); R = (st >> 1) * 16 + swz / 64; C = (st & 1) * 32 + (swz % 64) / 2; }
__device__ __forceinline__ int perm32(int rho) { const int n = rho >> 4, i = rho & 15; return 8 * (i >> 2) + 4 * n + (i & 3); }
struct Unit { int pm, pn, e, cnt; };
__device__ __forceinline__ unsigned cvt_pk_bf16(float lo, float hi) { unsigned r; asm volatile("v_cvt_pk_bf16_f32 %0, %1, %2" : "=v"(r) : "v"(lo), "v"(hi)); return r; }

template <class Prob, class Epi>
__device__ __forceinline__ void gemm_phase(PG8_LAS unsigned char* lds, const Prob& G, const Epi& E) {
    int tid_ = threadIdx.x; asm volatile("" : "+v"(tid_));
    const int tid = tid_, wid = __builtin_amdgcn_readfirstlane(tid >> 6), lane = tid & 63, wr = wid >> 2, wc = wid & 3, fr = lane & 15, fq = lane >> 4;
    const int K = G.K, nt = K / BK;
    int R0, C0; stage_rc(tid * 16, R0, C0);
    const int rA0 = R0, rA1 = R0 + 64;
    const int rB0 = Epi::PERM ? ((R0 & ~31) + perm32(R0 & 31)) : R0, rB1 = Epi::PERM ? (((R0 + 64) & ~31) + perm32((R0 + 64) & 31)) : R0 + 64;
    const unsigned ldsw = (unsigned)wid * 1024u;
    const int aoff = lds_byte(wr * 64 + fr, fq * 8), boff = lds_byte(wc * 32 + fr, fq * 8);
    const char* Ab = (const char*)G.A; const char* Bb = (const char*)G.Bt;
#define PG8_SA(b, h) (((b) * 2 + (h)) * HTB)
#define PG8_SB(b, h) ((4 + (b) * 2 + (h)) * HTB)
#define PG8_STAGE(bufoff, gbase, ub, l0, l1) do { \
        __builtin_amdgcn_global_load_lds((const unsigned*)((gbase) + (size_t)(ub) + (l0)), (PG8_LAS unsigned*)(lds + (bufoff) + ldsw), 16, 0, 0); \
        __builtin_amdgcn_global_load_lds((const unsigned*)((gbase) + (size_t)(ub) + (l1)), (PG8_LAS unsigned*)(lds + (bufoff) + ldsw + 8192), 16, 0, 0); } while (0)
#define PG8_LDA(dst, b, h) do { _Pragma("unroll") for (int m = 0; m < 4; ++m) _Pragma("unroll") for (int k = 0; k < 2; ++k) dst[m][k] = *(const PG8_LAS bf16x8*)(lds + PG8_SA(b, h) + aoff + m * 2048 + k * 1024); } while (0)
#define PG8_LDB(dst, b, h) do { _Pragma("unroll") for (int n = 0; n < 2; ++n) _Pragma("unroll") for (int k = 0; k < 2; ++k) dst[n][k] = *(const PG8_LAS bf16x8*)(lds + PG8_SB(b, h) + boff + n * 2048 + k * 1024); } while (0)
#define PG8_MMA(ai, bj, At, Bt) do { __builtin_amdgcn_s_setprio(1); _Pragma("unroll") for (int m = 0; m < 4; ++m) _Pragma("unroll") for (int n = 0; n < 2; ++n) _Pragma("unroll") for (int k = 0; k < 2; ++k) \
        acc[ai][bj][m][n] = __builtin_amdgcn_mfma_f32_16x16x32_bf16(Bt[n][k], At[m][k], acc[ai][bj][m][n], 0, 0, 0); __builtin_amdgcn_s_setprio(0); } while (0)
#define PG8_WAIT_V(n) asm volatile("s_waitcnt vmcnt(" #n ")" ::: "memory")
#define PG8_WAIT_L(n) asm volatile("s_waitcnt lgkmcnt(" #n ")" ::: "memory")
#define PG8_BAR __builtin_amdgcn_s_barrier()
#define PG8_SCHED __builtin_amdgcn_sched_barrier(0)
    Unit cur, nxt; int ui = 0;
    if (!G.next(0, cur)) return;
    f32x4 acc[2][2][4][2];
#pragma unroll
    for (int a = 0; a < 2; ++a)
#pragma unroll
        for (int b = 0; b < 2; ++b)
#pragma unroll
            for (int m = 0; m < 4; ++m)
#pragma unroll
                for (int n = 0; n < 2; ++n) acc[a][b][m][n] = (f32x4){0.f, 0.f, 0.f, 0.f};
    bf16x8 At[4][2], B0[2][2], B1[2][2];
    const unsigned cb2 = (unsigned)C0 * 2u;
    const unsigned lB00 = G.laneB(rB0) + cb2, lB01 = G.laneB(rB1) + cb2, lB10 = G.laneB(128 + rB0) + cb2, lB11 = G.laneB(128 + rB1) + cb2;
    const unsigned lA00 = G.laneA(rA0) + cb2, lA01 = G.laneA(rA1) + cb2, lA10 = G.laneA(128 + rA0) + cb2, lA11 = G.laneA(128 + rA1) + cb2;
    unsigned cA00 = lA00, cA01 = lA01, cA10 = lA10, cA11 = lA11, nA00 = lA00, nA01 = lA01, nA10 = lA10, nA11 = lA11;
    if constexpr (Prob::GATHER_A) { cA00 += G.gathA(cur, rA0); cA01 += G.gathA(cur, rA1); cA10 += G.gathA(cur, 128 + rA0); cA11 += G.gathA(cur, 128 + rA1); }
    unsigned uAc = G.baseA(cur), uBc = G.baseB(cur), uAn = uAc, uBn = uBc;
    PG8_STAGE(PG8_SB(0, 0), Bb, uBc, lB00, lB01); PG8_STAGE(PG8_SA(0, 0), Ab, uAc, cA00, cA01); PG8_STAGE(PG8_SB(0, 1), Bb, uBc, lB10, lB11); PG8_STAGE(PG8_SA(0, 1), Ab, uAc, cA10, cA11);
    if (wr == 1) PG8_BAR;
    PG8_WAIT_V(4); PG8_BAR;
    PG8_STAGE(PG8_SB(1, 0), Bb, uBc + 128u, lB00, lB01); PG8_STAGE(PG8_SA(1, 0), Ab, uAc + 128u, cA00, cA01); PG8_STAGE(PG8_SB(1, 1), Bb, uBc + 128u, lB10, lB11);
    PG8_WAIT_V(6); PG8_BAR;
    for (;;) {
        const bool has_next = G.next(ui + 1, nxt);
        if (has_next) {
            uAn = G.baseA(nxt); uBn = G.baseB(nxt);
            if constexpr (Prob::GATHER_A) { nA00 = lA00 + G.gathA(nxt, rA0); nA01 = lA01 + G.gathA(nxt, rA1); nA10 = lA10 + G.gathA(nxt, 128 + rA0); nA11 = lA11 + G.gathA(nxt, 128 + rA1); }
        } else { uAn = uAc; uBn = uBc; if constexpr (Prob::GATHER_A) { nA00 = cA00; nA01 = cA01; nA10 = cA10; nA11 = cA11; } }
        for (int t = 0; t < nt; t += 2) {
            const bool last = (t == nt - 2);
            const unsigned k1 = (unsigned)(t + 1) * 128u;
            const unsigned uA2 = last ? uAn : uAc + (unsigned)(t + 2) * 128u, uB2 = last ? uBn : uBc + (unsigned)(t + 2) * 128u, uA3 = uA2 + 128u, uB3 = uB2 + 128u;
            unsigned a00 = cA00, a01 = cA01, a10 = cA10, a11 = cA11;
            if constexpr (Prob::GATHER_A) { a00 = last ? nA00 : cA00; a01 = last ? nA01 : cA01; a10 = last ? nA10 : cA10; a11 = last ? nA11 : cA11; }
            PG8_LDB(B0, 0, 0); PG8_SCHED; PG8_LDA(At, 0, 0); PG8_STAGE(PG8_SA(1, 1), Ab, uAc + k1, cA10, cA11);
            PG8_WAIT_L(8); PG8_BAR; PG8_WAIT_L(0); PG8_MMA(0, 0, At, B0); PG8_BAR; PG8_SCHED;
            PG8_LDB(B1, 0, 1); PG8_STAGE(PG8_SB(0, 0), Bb, uB2, lB00, lB01);
            PG8_BAR; PG8_WAIT_L(0); PG8_MMA(0, 1, At, B1); PG8_BAR;
            PG8_LDA(At, 0, 1); PG8_STAGE(PG8_SA(0, 0), Ab, uA2, a00, a01);
            PG8_BAR; PG8_WAIT_L(0); PG8_MMA(1, 0, At, B0); PG8_BAR; PG8_SCHED;
            PG8_STAGE(PG8_SB(0, 1), Bb, uB2, lB10, lB11);
            PG8_WAIT_V(6); PG8_BAR; PG8_MMA(1, 1, At, B1); PG8_BAR;
            PG8_LDB(B0, 1, 0); PG8_SCHED; PG8_LDA(At, 1, 0); PG8_STAGE(PG8_SA(0, 1), Ab, uA2, a10, a11);
            PG8_WAIT_L(8); PG8_BAR; PG8_WAIT_L(0); PG8_MMA(0, 0, At, B0); PG8_BAR; PG8_SCHED;
            PG8_LDB(B1, 1, 1); PG8_STAGE(PG8_SB(1, 0), Bb, uB3, lB00, lB01);
            PG8_BAR; PG8_WAIT_L(0); PG8_MMA(0, 1, At, B1); PG8_BAR;
            PG8_LDA(At, 1, 1); PG8_STAGE(PG8_SA(1, 0), Ab, uA3, a00, a01);
            PG8_BAR; PG8_WAIT_L(0); PG8_MMA(1, 0, At, B0); PG8_BAR; PG8_SCHED;
            PG8_STAGE(PG8_SB(1, 1), Bb, uB3, lB10, lB11);
            PG8_WAIT_V(6); PG8_BAR; PG8_MMA(1, 1, At, B1); PG8_BAR;
        }
        E(acc, cur, wr, wc, fr, fq);
        if (!has_next) break;
#pragma unroll
        for (int a = 0; a < 2; ++a)
#pragma unroll
            for (int b = 0; b < 2; ++b)
#pragma unroll
                for (int m = 0; m < 4; ++m)
#pragma unroll
                    for (int n = 0; n < 2; ++n) acc[a][b][m][n] = (f32x4){0.f, 0.f, 0.f, 0.f};
        cur = nxt; ++ui; uAc = uAn; uBc = uBn;
        if constexpr (Prob::GATHER_A) { cA00 = nA00; cA01 = nA01; cA10 = nA10; cA11 = nA11; }
    }
    PG8_WAIT_V(0);
    if (wr == 0) PG8_BAR;
    PG8_BAR;
#undef PG8_SA
#undef PG8_SB
#undef PG8_STAGE
#undef PG8_LDA
#undef PG8_LDB
#undef PG8_MMA
#undef PG8_WAIT_V
#undef PG8_WAIT_L
#undef PG8_BAR
#undef PG8_SCHED
}

struct GridOrder {
    int nM, nN, nwg, G, c;
    __device__ __forceinline__ void init(int nM_, int nN_, int G_, int c_) { nM = nM_; nN = nN_; nwg = nM * nN; G = G_; c = c_; }
    __device__ __forceinline__ bool next(int i, Unit& u) const {
        const long L = (long)i * G + c; if (L >= nwg) return false;
        int wgid = (int)L; { const int q = nwg / 8, r = nwg % 8, xcd = wgid % 8, off = wgid / 8; wgid = (xcd < r ? xcd * (q + 1) : r * (q + 1) + (xcd - r) * q) + off; }
        const int nig = 8 * nN, gid = wgid / nig, fm = gid * 8, gsz = (nM - fm) < 8 ? (nM - fm) : 8;
        u.pm = fm + ((wgid % nig) % gsz); u.pn = (wgid % nig) / gsz; u.e = 0; u.cnt = 256; return true;
    }
};

struct ProbInproj : GridOrder { const bf16_t* A; const bf16_t* Bt; int K; static constexpr bool GATHER_A = false;
    __device__ __forceinline__ unsigned laneA(int r) const { return (unsigned)r * 2048u; }
    __device__ __forceinline__ unsigned laneB(int r) const { return (unsigned)r * 2048u; }
    __device__ __forceinline__ unsigned baseA(const Unit& u) const { return (unsigned)(u.pm * 256) * 2048u; }
    __device__ __forceinline__ unsigned baseB(const Unit& u) const { return (unsigned)(u.pn * 256) * 2048u; }
    __device__ __forceinline__ unsigned gathA(const Unit&, int) const { return 0u; } };
struct ProbGT : GridOrder { const bf16_t* A; const bf16_t* Bt; int K; static constexpr bool GATHER_A = false;
    __device__ __forceinline__ unsigned laneA(int r) const { return (unsigned)r * 2048u; }
    __device__ __forceinline__ unsigned laneB(int r) const { return (unsigned)(128 * (r & 63) + (r >> 6)) * 2048u; }
    __device__ __forceinline__ unsigned baseA(const Unit& u) const { return (unsigned)(u.pm * 256) * 2048u; }
    __device__ __forceinline__ unsigned baseB(const Unit& u) const { const int col = u.pn * 256, b = col >> 13, w = col & 8191; return (unsigned)(b * 8192 + (w >> 6)) * 2048u; }
    __device__ __forceinline__ unsigned gathA(const Unit&, int) const { return 0u; } };
struct EpiStoreBf16 {
    static constexpr bool PERM = true; bf16_t* O; int ldc;
    __device__ __forceinline__ void operator()(const f32x4 (&acc)[2][2][4][2], const Unit& u, int wr, int wc, int fr, int fq) const {
        const int row0 = u.pm * 256 + wr * 64 + fr, col0 = u.pn * 256 + wc * 32 + 8 * fq;
#pragma unroll
        for (int ai = 0; ai < 2; ++ai)
#pragma unroll
            for (int m = 0; m < 4; ++m) { bf16_t* rowp = O + (size_t)(row0 + ai * 128 + m * 16) * ldc + col0;
#pragma unroll
                for (int bj = 0; bj < 2; ++bj) { const f32x4 v0 = acc[ai][bj][m][0], v1 = acc[ai][bj][m][1];
                    u32x4 w; w.x = cvt_pk_bf16(v0[0], v0[1]); w.y = cvt_pk_bf16(v0[2], v0[3]); w.z = cvt_pk_bf16(v1[0], v1[1]); w.w = cvt_pk_bf16(v1[2], v1[3]);
                    *(u32x4*)(rowp + bj * 128) = w; } }
    }
};
typedef ProbInproj ProbOut;
struct EpiResid {
    static constexpr bool PERM = false; const float* x; const float* mod; float* out;
    __device__ __forceinline__ void operator()(const f32x4 (&acc)[2][2][4][2], const Unit& u, int wr, int wc, int fr, int fq) const {
        const int row0 = u.pm * 256 + wr * 64 + fr, col0 = u.pn * 256 + wc * 32 + 4 * fq;
        const float* gate = mod + ((u.pm * 256) >> 13) * 6144 + 2 * 1024;
        f32x4 gv[2][2];
#pragma unroll
        for (int bj = 0; bj < 2; ++bj)
#pragma unroll
            for (int n = 0; n < 2; ++n) gv[bj][n] = *(const f32x4*)(gate + col0 + bj * 128 + n * 16);
#pragma unroll
        for (int ai = 0; ai < 2; ++ai)
#pragma unroll
            for (int m = 0; m < 4; ++m) { const size_t off = (size_t)(row0 + ai * 128 + m * 16) * 1024 + col0;
#pragma unroll
                for (int bj = 0; bj < 2; ++bj)
#pragma unroll
                    for (int n = 0; n < 2; ++n) { const f32x4 xv = *(const f32x4*)(x + off + bj * 128 + n * 16); *(f32x4*)(out + off + bj * 128 + n * 16) = xv + gv[bj][n] * acc[ai][bj][m][n]; } }
    }
};
struct MoeOrder {
    const PG8_LAS int* tb; const PG8_LAS int* cnt; int G, c;
    __device__ __forceinline__ bool next(int i, Unit& u) const {
        const int L = i * G + c, ntile = tb[32]; if (L >= ntile * 4) return false;
        const int tile = L >> 2; u.pn = L & 3; int e = 0;
#pragma unroll
        for (int s = 16; s >= 1; s >>= 1) if (__builtin_amdgcn_readfirstlane(tb[e + s]) <= tile) e += s;
        u.e = e; u.pm = tile; const int loc = (tile - __builtin_amdgcn_readfirstlane(tb[e])) * 256; u.cnt = __builtin_amdgcn_readfirstlane(cnt[e]) - loc; return true;
    }
};
struct ProbMoe1 : MoeOrder { const bf16_t* A; const bf16_t* Bt; int K; const unsigned* tokk; static constexpr bool GATHER_A = true;
    __device__ __forceinline__ unsigned laneA(int) const { return 0u; }
    __device__ __forceinline__ unsigned laneB(int r) const { return (unsigned)r * 2048u; }
    __device__ __forceinline__ unsigned baseA(const Unit&) const { return 0u; }
    __device__ __forceinline__ unsigned baseB(const Unit& u) const { return (unsigned)(u.e * 1024 + u.pn * 256) * 2048u; }
    __device__ __forceinline__ unsigned gathA(const Unit& u, int r) const { const int loc = (u.pm - __builtin_amdgcn_readfirstlane(tb[u.e])) * 256 + r; const unsigned tk = r < u.cnt ? tokk[(size_t)u.e * LCAP + loc] : 0u; return (tk >> 1) * 2048u; } };
struct EpiMoe1 {
    static constexpr bool PERM = true; bf16_t* hid;
    __device__ __forceinline__ void operator()(const f32x4 (&acc)[2][2][4][2], const Unit& u, int wr, int wc, int fr, int fq) const {
        const int row0 = u.pm * 256 + wr * 64 + fr, col0 = u.pn * 128 + wc * 32 + 8 * fq;
#pragma unroll
        for (int ai = 0; ai < 2; ++ai)
#pragma unroll
            for (int m = 0; m < 4; ++m) { float hv[8];
#pragma unroll
                for (int n = 0; n < 2; ++n)
#pragma unroll
                    for (int j = 0; j < 4; ++j) { const float g = acc[ai][0][m][n][j], up = acc[ai][1][m][n][j]; hv[n * 4 + j] = g / (1.0f + __expf(-g)) * up; }
                u32x4 w; w.x = cvt_pk_bf16(hv[0], hv[1]); w.y = cvt_pk_bf16(hv[2], hv[3]); w.z = cvt_pk_bf16(hv[4], hv[5]); w.w = cvt_pk_bf16(hv[6], hv[7]);
                *(u32x4*)(hid + (size_t)(row0 + ai * 128 + m * 16) * 512 + col0) = w; }
    }
};
struct ProbMoe2 : MoeOrder { const bf16_t* A; const bf16_t* Bt; int K; static constexpr bool GATHER_A = false;
    __device__ __forceinline__ unsigned laneA(int r) const { return (unsigned)r * 1024u; }
    __device__ __forceinline__ unsigned laneB(int r) const { return (unsigned)r * 1024u; }
    __device__ __forceinline__ unsigned baseA(const Unit& u) const { return (unsigned)(u.pm * 256) * 1024u; }
    __device__ __forceinline__ unsigned baseB(const Unit& u) const { return (unsigned)(u.e * 1024 + u.pn * 256) * 1024u; }
    __device__ __forceinline__ unsigned gathA(const Unit&, int) const { return 0u; } };
struct EpiMoe2 {
    static constexpr bool PERM = true; bf16_t* Y; const unsigned* tokk; const float* wl; const PG8_LAS int* tb;
    __device__ __forceinline__ void operator()(const f32x4 (&acc)[2][2][4][2], const Unit& u, int wr, int wc, int fr, int fq) const {
        const int col0 = u.pn * 256 + wc * 32 + 8 * fq, locb = (u.pm - __builtin_amdgcn_readfirstlane(tb[u.e])) * 256;
#pragma unroll
        for (int ai = 0; ai < 2; ++ai)
#pragma unroll
            for (int m = 0; m < 4; ++m) { const int r = ai * 128 + wr * 64 + m * 16 + fr;
                if (r < u.cnt) { const unsigned tk = tokk[(size_t)u.e * LCAP + locb + r]; const float w = wl[(size_t)u.e * LCAP + locb + r];
                    bf16_t* rowp = Y + ((size_t)(tk & 1u) * NTOK + (tk >> 1)) * 1024 + col0;
#pragma unroll
                    for (int bj = 0; bj < 2; ++bj) { const f32x4 v0 = acc[ai][bj][m][0] * w, v1 = acc[ai][bj][m][1] * w;
                        u32x4 q; q.x = cvt_pk_bf16(v0[0], v0[1]); q.y = cvt_pk_bf16(v0[2], v0[3]); q.z = cvt_pk_bf16(v1[0], v1[1]); q.w = cvt_pk_bf16(v1[2], v1[3]);
                        *(u32x4*)(rowp + bj * 128) = q; } } }
    }
};
}
#endif

DEV void phase3_conv(const Params& P, unsigned char* sm) {
    PHASE_TID;
    const bf16_t* p = (const bf16_t*)(P.ws + WS_R4 + R4_P);
    bf16_t* qkvn = (bf16_t*)(P.ws + WS_R3);
    bf16_t* tile = (bf16_t*)sm;
    const int NIT = NB * 128 * 12 + NB * 4 * 12;
    for (int it = BID; it < NIT; it += NBLK) {
        int slab, rowbase, t0, L; bool isctx;
        if (it < NB * 128 * 12) { slab = it % 12; const int yy = (it / 12) & 127, b = it / (12 * 128); rowbase = b * SEQ; t0 = yy * 64; L = SEQ; isctx = false; }
        else { const int u = it - NB * 128 * 12; slab = u % 12; const int sg = (u / 12) & 3, b = u / 48; rowbase = NTOK + b * CTX; t0 = sg * 64; L = CTX; isctx = true; }
        for (int q = TID; q < 3 * 66 * 16; q += 512) {
            const int piece = q & 15, cc = (q >> 4) % 66, ky = (q >> 4) / 66;
            const int xg = cc - 1;
            u32x4 v = (u32x4){0u, 0u, 0u, 0u};
            bool ok;
            int tok;
            if (!isctx) { tok = t0 + (ky - 1) * 64 + xg; ok = (xg >= 0 && xg < 64 && tok >= 0 && tok < L); }
            else { tok = t0 + xg; ok = (ky == 1 && tok >= 0 && tok < L); }
            if (ok) v = *(const u32x4*)(p + (size_t)(rowbase + tok) * 2048 + slab * 128 + piece * 8);
            *(u32x4*)(tile + (ky * 66 + cc) * 128 + piece * 8) = v;
        }
        SYNC();
        const int tokl = TID >> 3, cg = TID & 7;
        float acc[16];
#pragma unroll
        for (int j = 0; j < 16; ++j) acc[j] = 0.f;
#pragma unroll
        for (int ky = 0; ky < 3; ++ky)
#pragma unroll
            for (int kx = 0; kx < 3; ++kx) {
                const float* wp = P.conv_w + (size_t)(ky * 3 + kx) * 1536 + slab * 128 + cg * 16;
                const bf16_t* tp = tile + (ky * 66 + tokl + kx) * 128 + cg * 16;
                const u32x4 a = *(const u32x4*)tp, b = *(const u32x4*)(tp + 8);
                const unsigned wv[8] = {a[0], a[1], a[2], a[3], b[0], b[1], b[2], b[3]};
#pragma unroll
                for (int j = 0; j < 8; ++j) { acc[2 * j] += wp[2 * j] * bf2f((bf16_t)(wv[j] & 0xffffu)); acc[2 * j + 1] += wp[2 * j + 1] * bf2f((bf16_t)(wv[j] >> 16)); }
            }
        float ss = 0.f;
#pragma unroll
        for (int j = 0; j < 16; ++j) { acc[j] = silu_f(acc[j]); ss += acc[j] * acc[j]; }
        if (slab < 8) { ss += shfl_xor_f(ss, 1); ss += shfl_xor_f(ss, 2); ss += shfl_xor_f(ss, 4); const float sc = 1.0f / sqrtf(ss + EPS);
#pragma unroll
            for (int j = 0; j < 16; ++j) acc[j] *= sc; }
        u32x4 o0, o1;
        o0[0] = pk2(acc[0], acc[1]); o0[1] = pk2(acc[2], acc[3]); o0[2] = pk2(acc[4], acc[5]); o0[3] = pk2(acc[6], acc[7]);
        o1[0] = pk2(acc[8], acc[9]); o1[1] = pk2(acc[10], acc[11]); o1[2] = pk2(acc[12], acc[13]); o1[3] = pk2(acc[14], acc[15]);
        bf16_t* dst = qkvn + (size_t)(rowbase + t0 + tokl) * 1536 + slab * 128 + cg * 16;
        *(u32x4*)dst = o0; *(u32x4*)(dst + 8) = o1;
        SYNC();
    }
    bf16_t* zs = (bf16_t*)((unsigned char*)P.out + DO_ZS);
    for (size_t i = (size_t)BID * 512 + TID; i < (size_t)NTOK * 64; i += (size_t)NBLK * 512) {
        const size_t r = i >> 6; const int c8 = (int)(i & 63) * 8;
        const u32x4 v = *(const u32x4*)(p + r * 2048 + 1536 + c8); u32x4 o;
#pragma unroll
        for (int j = 0; j < 4; ++j) o[j] = pk2(silu_f(bf2f((bf16_t)(v[j] & 0xffffu))), silu_f(bf2f((bf16_t)(v[j] >> 16))));
        *(u32x4*)(zs + r * 512 + c8) = o;
    }
}

constexpr int PP_MB0 = IMG_BYTES, PP_MB1 = PP_MB0 + 9216, PP_MB2 = PP_MB1 + 9216, PP_MB3 = PP_MB2 + 9216, PP_GC = PP_MB3 + 9216;

DEV int chunk_row(int chain, int step, int i) {
    const int b = chain >> 3, dir = chain & 1;
    if (step < 4) { const int pos = step * 64 + i; return NTOK + b * CTX + (dir ? (CTX - 1 - pos) : pos); }
    const int pos = (step - 4) * 64 + i; return b * SEQ + (dir ? (SEQ - 1 - pos) : pos);
}

DEV void phase4_prepass(const Params& P, unsigned char* sm) {
    PHASE_TID;
    const bf16_t* qkvn = (const bf16_t*)(P.ws + WS_R3);
    const float* gb = (const float*)(P.ws + WS_GB);
    unsigned char* images = P.ws + WS_R4;
    bf16_t* Ks = (bf16_t*)(sm + IMG_W); bf16_t* KT = (bf16_t*)(sm + IMG_KT); bf16_t* Qs = (bf16_t*)(sm + IMG_Q); bf16_t* Am = (bf16_t*)(sm + IMG_A); bf16_t* Vs = (bf16_t*)(sm + IMG_U);
    bf16_t* MB0 = (bf16_t*)(sm + PP_MB0); bf16_t* MB1 = (bf16_t*)(sm + PP_MB1); bf16_t* MB2 = (bf16_t*)(sm + PP_MB2); bf16_t* MB3 = (bf16_t*)(sm + PP_MB3);
    float* gcs = (float*)(sm + PP_GC); float* bts = gcs + 64;
    const int wid = TID >> 6, lane = TID & 63, fr = lane & 15, fq = lane >> 4;
    const float QSCALE = 0.08838834764831845f;
    for (int pid = BID; pid < NPROB; pid += NBLK) {
        const int chain = pid / NSTEP, step = pid - chain * NSTEP, hh = (chain >> 1) & 3, dir = chain & 1;
        for (int q = TID; q < 3 * 64 * 16; q += 512) {
            const int piece = q & 15, i = (q >> 4) & 63, which = q >> 10;
            const int row = chunk_row(chain, step, i);
            const u32x4 v = *(const u32x4*)(qkvn + (size_t)row * 1536 + which * 512 + hh * 128 + piece * 8);
            bf16_t* dst = (which == 0 ? Qs : which == 1 ? Ks : Vs) + i * 136 + piece * 8;
            *(u32x4*)dst = v;
        }
        if (wid == 0) {
            const int row = chunk_row(chain, step, lane);
            float g = gb[(size_t)row * 16 + 8 + dir * 4 + hh]; const float bt = gb[(size_t)row * 16 + dir * 4 + hh];
#pragma unroll
            for (int o = 1; o < 64; o <<= 1) { const float t = shfl_up_f(g, o); if (lane >= o) g += t; }
            gcs[lane] = g; bts[lane] = bt;
        }
        SYNC();
        f32x4 Treg[2];
#pragma unroll
        for (int tt = 0; tt < 2; ++tt) {
            const int t = wid * 2 + tt, ti = t >> 2, tj = t & 3;
            f32x4 kk = (f32x4){0.f, 0.f, 0.f, 0.f}, qk = (f32x4){0.f, 0.f, 0.f, 0.f};
#pragma unroll
            for (int ks = 0; ks < 4; ++ks) {
                const bf16x8 bk = frag16(Ks + (tj * 16 + fr) * 136 + ks * 32 + fq * 8);
                const bf16x8 ak = frag16(Ks + (ti * 16 + fr) * 136 + ks * 32 + fq * 8);
                const bf16x8 aq = frag16(Qs + (ti * 16 + fr) * 136 + ks * 32 + fq * 8);
                kk = mfma16(ak, bk, kk); qk = mfma16(aq, bk, qk);
            }
            const int j = tj * 16 + fr; const float gcj = gcs[j];
#pragma unroll
            for (int r = 0; r < 4; ++r) {
                const int i = ti * 16 + fq * 4 + r; const float gci = gcs[i];
                const float dec = (i >= j) ? __expf(gci - gcj) : 0.f;
                const float mv = (i > j) ? bts[i] * kk[r] * dec : 0.f;
                MB0[i * 72 + j] = f2bf(mv);
                Treg[tt][r] = (i == j ? 1.0f : 0.0f) - mv;
                Am[i * 72 + j] = f2bf(qk[r] * QSCALE * dec);
            }
        }
        SYNC();
        {
            const bf16_t* Pc = MB0;
#pragma unroll 1
            for (int s = 0; s < 5; ++s) {
                bf16_t* Pn = (s & 1) ? MB2 : MB1;
#pragma unroll
                for (int tt = 0; tt < 2; ++tt) {
                    const int t = wid * 2 + tt, ti = t >> 2, tj = t & 3;
#pragma unroll
                    for (int r = 0; r < 4; ++r) MB3[(ti * 16 + fq * 4 + r) * 72 + tj * 16 + fr] = f2bf(Treg[tt][r]);
                    f32x4 a = (f32x4){0.f, 0.f, 0.f, 0.f};
#pragma unroll
                    for (int ks = 0; ks < 2; ++ks) a = mfma16(frag16(Pc + (ti * 16 + fr) * 72 + ks * 32 + fq * 8), frag_gather(Pc + (ks * 32 + fq * 8) * 72 + tj * 16 + fr, 72), a);
#pragma unroll
                    for (int r = 0; r < 4; ++r) Pn[(ti * 16 + fq * 4 + r) * 72 + tj * 16 + fr] = f2bf(a[r]);
                }
                SYNC();
#pragma unroll
                for (int tt = 0; tt < 2; ++tt) {
                    const int t = wid * 2 + tt, ti = t >> 2, tj = t & 3;
#pragma unroll
                    for (int ks = 0; ks < 2; ++ks) Treg[tt] = mfma16(frag16(MB3 + (ti * 16 + fr) * 72 + ks * 32 + fq * 8), frag_gather(Pn + (ks * 32 + fq * 8) * 72 + tj * 16 + fr, 72), Treg[tt]);
                }
                SYNC();
                Pc = Pn;
            }
        }
        {
            const float gl = gcs[63];
#pragma unroll
            for (int tt = 0; tt < 2; ++tt) {
                const int t = wid * 2 + tt, ti = t >> 2, tj = t & 3, j = tj * 16 + fr; const float bj = bts[j], ej = __expf(gcs[j]);
#pragma unroll
                for (int r = 0; r < 4; ++r) { const int i = ti * 16 + fq * 4 + r; MB0[i * 72 + j] = f2bf(Treg[tt][r] * bj); MB3[i * 72 + j] = f2bf(Treg[tt][r] * bj * ej); }
            }
            const int tok = TID & 63, dg = TID >> 6;
            const float kscale = __expf(gl - gcs[tok]), qscale = QSCALE * __expf(gcs[tok]);
#pragma unroll
            for (int jj = 0; jj < 16; ++jj) { const int d = dg * 16 + jj; KT[d * 72 + tok] = f2bf(bf2f(Ks[tok * 136 + d]) * kscale); Qs[tok * 136 + d] = f2bf(bf2f(Qs[tok * 136 + d]) * qscale); }
            if (TID == 0) { float* scp = (float*)(sm + IMG_SC); scp[0] = __expf(gl); }
        }
        SYNC();
        f32x4 ua[4], wa[4];
#pragma unroll
        for (int ti = 0; ti < 4; ++ti) { ua[ti] = (f32x4){0.f, 0.f, 0.f, 0.f}; wa[ti] = (f32x4){0.f, 0.f, 0.f, 0.f}; }
#pragma unroll
        for (int ks = 0; ks < 2; ++ks) {
            const bf16x8 bv = frag_gather(Vs + (ks * 32 + fq * 8) * 136 + wid * 16 + fr, 136), bk = frag_gather(Ks + (ks * 32 + fq * 8) * 136 + wid * 16 + fr, 136);
#pragma unroll
            for (int ti = 0; ti < 4; ++ti) { ua[ti] = mfma16(frag16(MB0 + (ti * 16 + fr) * 72 + ks * 32 + fq * 8), bv, ua[ti]); wa[ti] = mfma16(frag16(MB3 + (ti * 16 + fr) * 72 + ks * 32 + fq * 8), bk, wa[ti]); }
        }
        SYNC();
#pragma unroll
        for (int ti = 0; ti < 4; ++ti)
#pragma unroll
            for (int r = 0; r < 4; ++r) { const int i = ti * 16 + fq * 4 + r; Vs[i * 136 + wid * 16 + fr] = f2bf(ua[ti][r]); Ks[i * 136 + wid * 16 + fr] = f2bf(wa[ti][r]); }
        SYNC();
        { u32x4* dst = (u32x4*)(images + (size_t)pid * IMG_BYTES); const u32x4* src = (const u32x4*)sm;
          for (int q = TID; q < IMG_BYTES / 16; q += 512) dst[q] = src[q]; }
        SYNC();
    }
}

DEV void phase4_fft(const Params& P, unsigned char* sm) {
    PHASE_TID;
    const bf16_t* GT = (const bf16_t*)((const unsigned char*)P.out + DO_GT);
    bf16_t* ZT = (bf16_t*)((unsigned char*)P.out + DO_ZT);
    const bf16_t* tab = (const bf16_t*)(P.ws + WS_TAB);
    bf16_t* YR = (bf16_t*)sm; bf16_t* YI = YR + 64 * 136;
    const int wid = TID >> 6, lane = TID & 63, fr = lane & 15, fq = lane >> 4;
    bf16x8 c64[4][2], s64[4][2], c128[4], s128[4];
#pragma unroll
    for (int nt = 0; nt < 4; ++nt)
#pragma unroll
        for (int ks = 0; ks < 2; ++ks) { c64[nt][ks] = frag16(tab + (nt * 16 + fr) * 64 + ks * 32 + fq * 8); s64[nt][ks] = frag16(tab + 4096 + (nt * 16 + fr) * 64 + ks * 32 + fq * 8); }
#pragma unroll
    for (int ks = 0; ks < 4; ++ks) { c128[ks] = frag16(tab + 8192 + (wid * 16 + fr) * 128 + ks * 32 + fq * 8); s128[ks] = frag16(tab + 8192 + 16384 + (wid * 16 + fr) * 128 + ks * 32 + fq * 8); }
    for (int it = BID; it < 512 * NB; it += NBLK) {
        const int cp = it >> 3, b = it & 7;
        const bf16_t* gr = GT + (size_t)cp * NTOK + b * SEQ; const bf16_t* gi = GT + (size_t)(512 + cp) * NTOK + b * SEQ;
        bf16x8 ar[2], ai[2], an[2];
#pragma unroll
        for (int ks = 0; ks < 2; ++ks) { ar[ks] = frag16(gr + (wid * 16 + fr) * 64 + ks * 32 + fq * 8); ai[ks] = frag16(gi + (wid * 16 + fr) * 64 + ks * 32 + fq * 8);
#pragma unroll
            for (int j = 0; j < 8; ++j) an[ks][j] = (short)(ar[ks][j] ^ (short)0x8000); }
#pragma unroll
        for (int nt = 0; nt < 4; ++nt) {
            f32x4 yr = (f32x4){0.f, 0.f, 0.f, 0.f}, yi = (f32x4){0.f, 0.f, 0.f, 0.f};
#pragma unroll
            for (int ks = 0; ks < 2; ++ks) { yr = mfma16(ar[ks], c64[nt][ks], yr); yr = mfma16(ai[ks], s64[nt][ks], yr); yi = mfma16(ai[ks], c64[nt][ks], yi); yi = mfma16(an[ks], s64[nt][ks], yi); }
            const int k1 = nt * 16 + fr; float orr[4], oii[4];
#pragma unroll
            for (int r = 0; r < 4; ++r) { const int n2 = wid * 16 + fq * 4 + r; float s, c; sincospi_f((float)(n2 * k1) * (2.0f / 8192.0f), &s, &c);
                orr[r] = yr[r] * c + yi[r] * s; oii[r] = yi[r] * c - yr[r] * s; }
            u32x2 w; w[0] = pk2(orr[0], orr[1]); w[1] = pk2(orr[2], orr[3]); *(u32x2*)(YR + k1 * 136 + wid * 16 + fq * 4) = w;
            w[0] = pk2(oii[0], oii[1]); w[1] = pk2(oii[2], oii[3]); *(u32x2*)(YI + k1 * 136 + wid * 16 + fq * 4) = w;
        }
        SYNC();
        bf16_t* zrow = ZT + (size_t)cp * NTOK + b * SEQ;
#pragma unroll
        for (int mt = 0; mt < 4; ++mt) {
            f32x4 z = (f32x4){0.f, 0.f, 0.f, 0.f};
#pragma unroll
            for (int ks = 0; ks < 4; ++ks) { z = mfma16(frag16(YR + (mt * 16 + fr) * 136 + ks * 32 + fq * 8), c128[ks], z); z = mfma16(frag16(YI + (mt * 16 + fr) * 136 + ks * 32 + fq * 8), s128[ks], z); }
            u32x2 w; w[0] = pk2(z[0], z[1]); w[1] = pk2(z[2], z[3]);
            *(u32x2*)(zrow + 64 * (wid * 16 + fr) + mt * 16 + fq * 4) = w;
        }
        SYNC();
    }
}

constexpr int SC_W = 0, SC_U = 17408, SC_KT = 22528, SC_Q = SC_KT + 18432, SC_A = SC_Q + 17408, SC_ST = SC_A + 9216, SC_VN = SC_ST + 2 * 8704, SC_END = SC_VN + 4608;

DEV void phase5_scan(const Params& P, unsigned char* sm) {
    PHASE_TID;
    const unsigned char* images = P.ws + WS_R4;
    bf16_t* obuf = (bf16_t*)(P.ws + WS_R3);
    const int wid = TID >> 6, lane = TID & 63, fr = lane & 15, fq = lane >> 4;
    bf16_t* Wm = (bf16_t*)(sm + SC_W); bf16_t* Us = (bf16_t*)(sm + SC_U); bf16_t* KT = (bf16_t*)(sm + SC_KT); bf16_t* Qg = (bf16_t*)(sm + SC_Q); bf16_t* Am = (bf16_t*)(sm + SC_A);
    bf16_t* ST = (bf16_t*)(sm + SC_ST); bf16_t* VN = (bf16_t*)(sm + SC_VN);
    for (int item = BID; item < NCHAIN * 4; item += NBLK) {
        const int chain = item >> 2, c0 = (item & 3) * 32, b = chain >> 3, hh = (chain >> 1) & 3, dir = chain & 1;
        const unsigned char* blk0 = images + (size_t)chain * NSTEP * IMG_BYTES;
        u32x4 xr[3], yr[6];
#define SC_LOADX(blk) do { _Pragma("unroll") for (int q = 0; q < 3; ++q) { const int pc = TID + q * 512; if (pc < 1344) { \
            const int so = pc < 1088 ? pc * 16 : (IMG_U + ((pc - 1088) >> 2) * 272 + c0 * 2 + ((pc - 1088) & 3) * 16); xr[q] = *(const u32x4*)((blk) + so); } } } while (0)
#define SC_STOREX() do { _Pragma("unroll") for (int q = 0; q < 3; ++q) { const int pc = TID + q * 512; if (pc < 1344) { \
            const int d_ = pc < 1088 ? (SC_W + pc * 16) : (SC_U + ((pc - 1088) >> 2) * 80 + ((pc - 1088) & 3) * 16); *(u32x4*)(sm + d_) = xr[q]; } } } while (0)
#define SC_LOADY(blk) do { _Pragma("unroll") for (int q = 0; q < 6; ++q) { const int pc = TID + q * 512; if (pc < 2816) yr[q] = *(const u32x4*)((blk) + IMG_KT + pc * 16); } } while (0)
#define SC_STOREY() do { _Pragma("unroll") for (int q = 0; q < 6; ++q) { const int pc = TID + q * 512; if (pc < 2816) *(u32x4*)(sm + SC_KT + pc * 16) = yr[q]; } } while (0)
        f32x4 Sacc[2];
        Sacc[0] = (f32x4){0.f, 0.f, 0.f, 0.f}; Sacc[1] = (f32x4){0.f, 0.f, 0.f, 0.f};
        for (int q = TID; q < 2 * 8704 / 4; q += 512) ((unsigned*)ST)[q] = 0u;
        SC_LOADX(blk0); SC_STOREX(); SC_LOADY(blk0);
        SYNC();
        const int mt = wid >> 1, nt = wid & 1;
#pragma unroll 1
        for (int step = 0; step < NSTEP; ++step) {
            const int cur = step & 1;
            const unsigned char* blk = blk0 + (size_t)step * IMG_BYTES;
            const bf16_t* STc = ST + cur * 4352; bf16_t* STn = ST + (cur ^ 1) * 4352;
            SC_STOREY();
            if (step + 1 < NSTEP) SC_LOADX(blk + IMG_BYTES);
            const float dl = *(const float*)(blk + IMG_SC);
            f32x4 vn = (f32x4){0.f, 0.f, 0.f, 0.f};
#pragma unroll
            for (int ks = 0; ks < 4; ++ks) vn = mfma16(frag16(Wm + (mt * 16 + fr) * 136 + ks * 32 + fq * 8), frag16(STc + (nt * 16 + fr) * 136 + ks * 32 + fq * 8), vn);
            { float v4[4];
#pragma unroll
              for (int r = 0; r < 4; ++r) v4[r] = bf2f(Us[(mt * 16 + fq * 4 + r) * 40 + nt * 16 + fr]) - vn[r];
              u32x2 w; w[0] = pk2(v4[0], v4[1]); w[1] = pk2(v4[2], v4[3]); *(u32x2*)(VN + (nt * 16 + fr) * 72 + mt * 16 + fq * 4) = w; }
            SYNC();
            SC_STOREX();
            if (step + 1 < NSTEP) SC_LOADY(blk + IMG_BYTES);
#pragma unroll
            for (int tt = 0; tt < 2; ++tt) {
                const int t2 = wid * 2 + tt, dt = t2 >> 1, n2 = t2 & 1;
                f32x4 a = Sacc[tt] * dl;
#pragma unroll
                for (int ks = 0; ks < 2; ++ks) a = mfma16(frag16(KT + (dt * 16 + fr) * 72 + ks * 32 + fq * 8), frag16(VN + (n2 * 16 + fr) * 72 + ks * 32 + fq * 8), a);
                Sacc[tt] = a;
                u32x2 w; w[0] = pk2(a[0], a[1]); w[1] = pk2(a[2], a[3]); *(u32x2*)(STn + (n2 * 16 + fr) * 136 + dt * 16 + fq * 4) = w;
            }
            if (step >= 4) {
                f32x4 o = (f32x4){0.f, 0.f, 0.f, 0.f};
#pragma unroll
                for (int ks = 0; ks < 4; ++ks) o = mfma16(frag16(Qg + (mt * 16 + fr) * 136 + ks * 32 + fq * 8), frag16(STc + (nt * 16 + fr) * 136 + ks * 32 + fq * 8), o);
#pragma unroll
                for (int ks = 0; ks < 2; ++ks) o = mfma16(frag16(Am + (mt * 16 + fr) * 72 + ks * 32 + fq * 8), frag16(VN + (nt * 16 + fr) * 72 + ks * 32 + fq * 8), o);
#pragma unroll
                for (int r = 0; r < 4; ++r) { const int pos = (step - 4) * 64 + mt * 16 + fq * 4 + r; const int tok = b * SEQ + (dir ? (SEQ - 1 - pos) : pos);
                    obuf[((size_t)dir * NTOK + tok) * 512 + hh * 128 + c0 + nt * 16 + fr] = f2bf(o[r]); }
            }
            SYNC();
        }
        SYNC();
    }
#undef SC_LOADX
#undef SC_STOREX
#undef SC_LOADY
#undef SC_STOREY
}

DEV void phase6_amix(const Params& P, unsigned char* sm) {
    PHASE_TID;
    const bf16_t* ZT = (const bf16_t*)((const unsigned char*)P.out + DO_ZT);
    const bf16_t* zs = (const bf16_t*)((const unsigned char*)P.out + DO_ZS);
    const bf16_t* obuf = (const bf16_t*)(P.ws + WS_R3);
    bf16_t* amix = (bf16_t*)(P.ws + WS_R4 + R4_AMIX);
    bf16_t* tile = (bf16_t*)sm;
    for (int tt = BID; tt < NTOK / 64; tt += NBLK) {
        const int tok0 = tt * 64;
        for (int q = TID; q < 512 * 8; q += 512) { const int cp = q >> 3, piece = q & 7; *(u32x4*)(tile + cp * 72 + piece * 8) = *(const u32x4*)(ZT + (size_t)cp * NTOK + tok0 + piece * 8); }
        SYNC();
        for (int q = TID; q < 64 * 64; q += 512) { const int tok = q >> 6, c8 = (q & 63) * 8; u32x4 o;
#pragma unroll
            for (int j = 0; j < 4; ++j) o[j] = (unsigned)tile[(c8 + 2 * j) * 72 + tok] | ((unsigned)tile[(c8 + 2 * j + 1) * 72 + tok] << 16);
            *(u32x4*)(amix + (size_t)(tok0 + tok) * 1024 + c8) = o; }
        for (int q = TID; q < 64 * 64; q += 512) {
            const int tok = q >> 6, hh = (q >> 4) & 3, l16 = q & 15; const size_t off = (size_t)(tok0 + tok) * 512 + hh * 128 + l16 * 8;
            const u32x4 a = *(const u32x4*)(obuf + off), bq = *(const u32x4*)(obuf + (size_t)NTOK * 512 + off), zv = *(const u32x4*)(zs + off);
            float v[8]; float ss = 0.f;
#pragma unroll
            for (int j = 0; j < 4; ++j) { v[2 * j] = bf2f((bf16_t)(a[j] & 0xffffu)) + bf2f((bf16_t)(bq[j] & 0xffffu)); v[2 * j + 1] = bf2f((bf16_t)(a[j] >> 16)) + bf2f((bf16_t)(bq[j] >> 16)); }
#pragma unroll
            for (int j = 0; j < 8; ++j) ss += v[j] * v[j];
            ss += shfl_xor_f(ss, 1); ss += shfl_xor_f(ss, 2); ss += shfl_xor_f(ss, 4); ss += shfl_xor_f(ss, 8);
            const float rstd = 1.0f / sqrtf(ss * (1.0f / 128.0f) + EPS);
            u32x4 o;
#pragma unroll
            for (int j = 0; j < 4; ++j) { const float g0 = P.onorm_g[l16 * 8 + 2 * j], g1 = P.onorm_g[l16 * 8 + 2 * j + 1];
                o[j] = pk2(v[2 * j] * rstd * g0 * bf2f((bf16_t)(zv[j] & 0xffffu)), v[2 * j + 1] * rstd * g1 * bf2f((bf16_t)(zv[j] >> 16))); }
            *(u32x4*)(amix + (size_t)(tok0 + tok) * 1024 + 512 + hh * 128 + l16 * 8) = o;
        }
        SYNC();
    }
}

DEV void phase8_router(const Params& P, unsigned char* sm) {
    PHASE_TID;
    float* wr = (float*)sm;
    for (int i = TID; i < 1024 * 36; i += 512) { const int k = i / 36, j = i - k * 36; wr[i] = j < 4 ? P.w_group[k * 4 + j] : P.w_router[k * 32 + j - 4]; }
    SYNC();
    const float* mod = (const float*)(P.ws + WS_MOD);
    const float* x1 = P.out;
    bf16_t* h2 = (bf16_t*)(P.ws + WS_R4 + R4_H2);
    unsigned* cnt = (unsigned*)(P.ws + WS_CNT); unsigned* tokk = (unsigned*)(P.ws + WS_TOKK); float* wl = (float*)(P.ws + WS_WL);
    const int wid = TID >> 6, lane = TID & 63;
    for (int r = BID * 8 + wid; r < NTOK; r += NBLK * 8) {
        const float* src = x1 + (size_t)r * D; const float* shift = mod + (r >> 13) * 6144 + 3 * 1024, *scale = shift + 1024;
        float ss = 0.f;
#pragma unroll
        for (int i = 0; i < 4; ++i) { const f32x4 t = *(const f32x4*)(src + i * 256 + lane * 4); ss += t[0] * t[0] + t[1] * t[1] + t[2] * t[2] + t[3] * t[3]; }
        ss = wave_sum(ss);
        const float rstd = 1.0f / sqrtf(ss * (1.0f / 1024.0f) + EPS);
        float gl[4] = {0.f, 0.f, 0.f, 0.f};
#pragma unroll 1
        for (int i = 0; i < 4; ++i) {
            const int k = i * 256 + lane * 4;
            const f32x4 vv = *(const f32x4*)(src + k), g2 = *(const f32x4*)(P.norm2_g + k), sc = *(const f32x4*)(scale + k), sh = *(const f32x4*)(shift + k);
            float hv[4];
#pragma unroll
            for (int e = 0; e < 4; ++e) { const float t = vv[e] * rstd * g2[e] * (1.0f + sc[e]) + sh[e]; hv[e] = t; const f32x4 wv = *(const f32x4*)(wr + (k + e) * 36);
                gl[0] += t * wv[0]; gl[1] += t * wv[1]; gl[2] += t * wv[2]; gl[3] += t * wv[3]; }
            u32x2 w; w[0] = pk2(hv[0], hv[1]); w[1] = pk2(hv[2], hv[3]);
            *(u32x2*)(h2 + (size_t)r * D + k) = w;
        }
#pragma unroll
        for (int j = 0; j < 4; ++j) gl[j] = wave_sum(gl[j]) + P.b_group[j];
        int gsel = 0; float gmax = gl[0];
#pragma unroll
        for (int j = 1; j < 4; ++j) if (gl[j] > gmax) { gmax = gl[j]; gsel = j; }
        float gden = 0.f;
#pragma unroll
        for (int j = 0; j < 4; ++j) gden += __expf(gl[j] - gmax);
        const float pg = 1.0f / gden;
        float el[8] = {0.f, 0.f, 0.f, 0.f, 0.f, 0.f, 0.f, 0.f};
#pragma unroll 1
        for (int i = 0; i < 4; ++i) {
            const int k = i * 256 + lane * 4;
            const f32x4 vv = *(const f32x4*)(src + k), g2 = *(const f32x4*)(P.norm2_g + k), sc = *(const f32x4*)(scale + k), sh = *(const f32x4*)(shift + k);
#pragma unroll
            for (int e = 0; e < 4; ++e) { const float t = vv[e] * rstd * g2[e] * (1.0f + sc[e]) + sh[e];
                const f32x4 w0 = *(const f32x4*)(wr + (k + e) * 36 + 4 + gsel * 8), w1 = *(const f32x4*)(wr + (k + e) * 36 + 8 + gsel * 8);
                el[0] += t * w0[0]; el[1] += t * w0[1]; el[2] += t * w0[2]; el[3] += t * w0[3]; el[4] += t * w1[0]; el[5] += t * w1[1]; el[6] += t * w1[2]; el[7] += t * w1[3]; }
        }
#pragma unroll
        for (int j = 0; j < 8; ++j) el[j] = wave_sum(el[j]) + P.b_router[gsel * 8 + j];
        int e1 = 0; float m1 = el[0];
#pragma unroll
        for (int j = 1; j < 8; ++j) if (el[j] > m1) { m1 = el[j]; e1 = j; }
        int e2 = -1; float m2 = -3.0e38f;
#pragma unroll
        for (int j = 0; j < 8; ++j) if (j != e1 && el[j] > m2) { m2 = el[j]; e2 = j; }
        const float p2 = __expf(m2 - m1);
        const float w1 = pg / (1.0f + p2), w2 = pg * p2 / (1.0f + p2);
        if (lane < 2) {
            const int ee = gsel * 8 + (lane == 0 ? e1 : e2); const float ww = lane == 0 ? w1 : w2;
            const unsigned pos = atomic_add_u32(&cnt[ee], 1u);
            tokk[(size_t)ee * LCAP + pos] = (unsigned)r * 2u + (unsigned)lane; wl[(size_t)ee * LCAP + pos] = ww;
        }
    }
}

DEV void phase11_final(const Params& P, unsigned char* sm) {
    PHASE_TID;
    (void)sm;
    const float* mod = (const float*)(P.ws + WS_MOD);
    const bf16_t* Y = (const bf16_t*)(P.ws + WS_R4 + R4_Y);
    const int wid = TID >> 6, lane = TID & 63;
    for (int r = BID * 8 + wid; r < NTOK; r += NBLK * 8) {
        float* row = P.out + (size_t)r * D; const float* gate = mod + (r >> 13) * 6144 + 5 * 1024;
        f32x4 v[4]; float ss = 0.f;
#pragma unroll
        for (int i = 0; i < 4; ++i) { const int k = i * 256 + lane * 4; const f32x4 xv = *(const f32x4*)(row + k), gv = *(const f32x4*)(gate + k);
            const u32x2 y0 = *(const u32x2*)(Y + (size_t)r * D + k), y1 = *(const u32x2*)(Y + ((size_t)NTOK + r) * D + k);
            f32x4 m; m[0] = bf2f((bf16_t)(y0[0] & 0xffffu)) + bf2f((bf16_t)(y1[0] & 0xffffu)); m[1] = bf2f((bf16_t)(y0[0] >> 16)) + bf2f((bf16_t)(y1[0] >> 16));
            m[2] = bf2f((bf16_t)(y0[1] & 0xffffu)) + bf2f((bf16_t)(y1[1] & 0xffffu)); m[3] = bf2f((bf16_t)(y0[1] >> 16)) + bf2f((bf16_t)(y1[1] >> 16));
            v[i] = xv + gv * m; ss += v[i][0] * v[i][0] + v[i][1] * v[i][1] + v[i][2] * v[i][2] + v[i][3] * v[i][3]; }
        ss = wave_sum(ss);
        const float rstd = 1.0f / sqrtf(ss * (1.0f / 1024.0f) + EPS);
#pragma unroll
        for (int i = 0; i < 4; ++i) { const int k = i * 256 + lane * 4; const f32x4 fg = *(const f32x4*)(P.final_g + k); *(f32x4*)(row + k) = v[i] * rstd * fg; }
    }
}

#ifndef CPU_EMU
#define XB_TMO      128
#define XB_XCNT(j)  (256  + 64 * (j))
#define XB_XSUB(j)  (1280 + 64 * (j))
#define XB_XGEN(j)  (2304 + 64 * (j))
#define XB_TOP      3328
#define XB_TOPGEN   3392
#define XCD_BAR_WORDS 3456
#define XB_SPIN_CAP (1u << 22)
#define LAS __attribute__((address_space(3)))
__device__ __forceinline__ unsigned xb_ld(unsigned* p)              { return __hip_atomic_load(p, __ATOMIC_RELAXED, __HIP_MEMORY_SCOPE_AGENT); }
__device__ __forceinline__ unsigned xb_add(unsigned* p, unsigned v) { return __hip_atomic_fetch_add(p, v, __ATOMIC_RELAXED, __HIP_MEMORY_SCOPE_AGENT); }
__device__ __forceinline__ unsigned xb_xcc_id() { return (unsigned)__builtin_amdgcn_s_getreg((3 << 11) | 20) & 0xFu; }
#define XB_SPIN(cond, bar) do { unsigned _sp = 0; while (cond) { __builtin_amdgcn_s_sleep(1); \
    if ((++_sp & 255u) == 0u) { if (xb_ld(&(bar)[XB_TMO])) break; if (_sp > XB_SPIN_CAP) { atomicAdd(&(bar)[XB_TMO], 1u); break; } } } } while (0)
struct XcdBarrier { unsigned* bar; unsigned x; volatile LAS unsigned* st; };
__device__ __forceinline__ XcdBarrier xcd_barrier_post(unsigned* bar, volatile LAS unsigned* st) {
    XcdBarrier b; b.bar = bar; b.x = xb_xcc_id(); b.st = st;
    if (threadIdx.x == 0) (void)xb_add(&bar[XB_XCNT(b.x)], 1u);
    return b;
}
__device__ __forceinline__ void xcd_barrier_complete(unsigned* bar, unsigned x, unsigned& nloc, unsigned& nx) {
    const unsigned G = gridDim.x * gridDim.y * gridDim.z;
    unsigned sum, cnt, mine, sp = 0u;
    for (;;) {
        sum = 0u; cnt = 0u; mine = 0u;
#pragma unroll
        for (unsigned j = 0; j < 16; ++j) { const unsigned c = xb_ld(&bar[XB_XCNT(j)]); sum += c; cnt += (c > 0u) ? 1u : 0u; mine = (j == x) ? c : mine; }
        if (sum == G) break;
        __builtin_amdgcn_s_sleep(1);
        if ((++sp & 255u) == 0u) { if (xb_ld(&bar[XB_TMO])) break; if (sp > XB_SPIN_CAP) { atomicAdd(&bar[XB_TMO], 1u); break; } }
    }
    nloc = mine > 0u ? mine : 1u; nx = cnt > 0u ? cnt : 1u;
}
__device__ __forceinline__ void xcd_barrier(const XcdBarrier& b) {
    asm volatile("s_waitcnt vmcnt(0)" ::: "memory");
    __syncthreads();
    if (threadIdx.x == 0) {
        unsigned* bar = b.bar;
        __builtin_amdgcn_s_waitcnt(0);
        unsigned nloc = b.st[0], nx = b.st[1];
        if (nloc == 0u) { xcd_barrier_complete(bar, b.x, nloc, nx); b.st[0] = nloc; b.st[1] = nx; }
        const unsigned old = xb_add(&bar[XB_XSUB(b.x)], 1u);
        const unsigned gen = old / nloc;
        if (old + 1u == (gen + 1u) * nloc) {
            __builtin_amdgcn_fence(__ATOMIC_RELEASE, "agent");
            asm volatile("s_waitcnt vmcnt(0)" ::: "memory");
            const unsigned og = xb_add(&bar[XB_TOP], 1u);
            const unsigned tg = og / nx;
            if (og + 1u == (tg + 1u) * nx) xb_add(&bar[XB_TOPGEN], 1u);
            else XB_SPIN(xb_ld(&bar[XB_TOPGEN]) == tg, bar);
            __builtin_amdgcn_fence(__ATOMIC_ACQUIRE, "agent");
            xb_add(&bar[XB_XGEN(b.x)], 1u);
            asm volatile("s_waitcnt vmcnt(0)" ::: "memory");
        } else {
            XB_SPIN(xb_ld(&bar[XB_XGEN(b.x)]) == gen, bar);
            __builtin_amdgcn_fence(__ATOMIC_ACQUIRE, "agent");
            asm volatile("s_waitcnt vmcnt(0)" ::: "memory");
        }
    }
    __syncthreads();
}

#ifndef MK_PH
#define MK_PH 0x7ff
#endif
extern __shared__ __attribute__((aligned(16))) unsigned char smem_dyn[];

__device__ __forceinline__ void moe_tables(const Params& P, LAS int* tb, LAS int* cn) {
    const unsigned* cnt = (const unsigned*)(P.ws + WS_CNT);
    if (threadIdx.x < 32) cn[threadIdx.x] = (int)cnt[threadIdx.x];
    __syncthreads();
    if (threadIdx.x == 0) { int acc = 0; for (int e = 0; e < 32; ++e) { tb[e] = acc; acc += (cn[e] + 255) >> 8; } tb[32] = acc; }
    __syncthreads();
}

__global__ void __launch_bounds__(512, 2) hymba_fwd(Params P) {
    unsigned char* sm = smem_dyn;
    LAS unsigned char* lsm = (LAS unsigned char*)smem_dyn;
    volatile LAS unsigned* xbw = (volatile LAS unsigned*)(lsm + LDS_BYTES - 16);
    if (threadIdx.x == 0) { xbw[0] = 0u; xbw[1] = 0u; xbw[2] = 0u; xbw[3] = 0u; }
    __syncthreads();
    XcdBarrier bar = xcd_barrier_post((unsigned*)(P.ws + WS_BAR), xbw);
    using namespace pg8;

#if (MK_PH >> 0) & 1
    phase0_mod(P, sm); phase0_weights(P, sm); phase0_wf(P, sm);
    xcd_barrier(bar);
#endif
#if (MK_PH >> 1) & 1
    phase1_prep(P, sm);
    xcd_barrier(bar);
#endif
#if (MK_PH >> 2) & 1
    { ProbInproj G; G.init(MROWS / 256, 8, gridDim.x, blockIdx.x); G.A = (const bf16_t*)(P.ws + WS_R4 + R4_H); G.Bt = (const bf16_t*)(P.ws + WS_WQKVZ); G.K = 1024;
      EpiStoreBf16 E; E.O = (bf16_t*)(P.ws + WS_R4 + R4_P); E.ldc = 2048; gemm_phase(lsm, G, E); }
    { ProbGT G; G.init(4, NTOK / 256, gridDim.x, blockIdx.x); G.A = (const bf16_t*)(P.ws + WS_WF); G.Bt = (const bf16_t*)(P.ws + WS_R4 + R4_H); G.K = 1024;
      EpiStoreBf16 E; E.O = (bf16_t*)((unsigned char*)P.out + DO_GT); E.ldc = NTOK; gemm_phase(lsm, G, E); }
    xcd_barrier(bar);
#endif
#if (MK_PH >> 3) & 1
    phase3_conv(P, sm);
    xcd_barrier(bar);
#endif
#if (MK_PH >> 4) & 1
    phase4_prepass(P, sm); phase4_fft(P, sm);
    xcd_barrier(bar);
#endif
#if (MK_PH >> 5) & 1
    phase5_scan(P, sm);
    xcd_barrier(bar);
#endif
#if (MK_PH >> 6) & 1
    phase6_amix(P, sm);
    xcd_barrier(bar);
#endif
#if (MK_PH >> 7) & 1
    { ProbOut G; G.init(NTOK / 256, 4, gridDim.x, blockIdx.x); G.A = (const bf16_t*)(P.ws + WS_R4 + R4_AMIX); G.Bt = (const bf16_t*)(P.ws + WS_WOUT); G.K = 1024;
      EpiResid E; E.x = P.x; E.mod = (const float*)(P.ws + WS_MOD); E.out = P.out; gemm_phase(lsm, G, E); }
    xcd_barrier(bar);
#endif
#if (MK_PH >> 8) & 1
    phase8_router(P, sm);
    xcd_barrier(bar);
#endif
#if (MK_PH >> 9) & 1
    LAS int* tb = (LAS int*)(lsm + STAGE_BYTES); LAS int* cn = tb + 64;
    moe_tables(P, tb, cn);
    { ProbMoe1 G; G.tb = tb; G.cnt = cn; G.G = gridDim.x; G.c = blockIdx.x; G.A = (const bf16_t*)(P.ws + WS_R4 + R4_H2); G.Bt = (const bf16_t*)(P.ws + WS_WGU); G.K = 1024; G.tokk = (const unsigned*)(P.ws + WS_TOKK);
      EpiMoe1 E; E.hid = (bf16_t*)(P.ws + WS_R4 + R4_HID); gemm_phase(lsm, G, E); }
    xcd_barrier(bar);
    { ProbMoe2 G; G.tb = tb; G.cnt = cn; G.G = gridDim.x; G.c = blockIdx.x; G.A = (const bf16_t*)(P.ws + WS_R4 + R4_HID); G.Bt = (const bf16_t*)(P.ws + WS_WD); G.K = 512;
      EpiMoe2 E; E.Y = (bf16_t*)(P.ws + WS_R4 + R4_Y); E.tokk = (const unsigned*)(P.ws + WS_TOKK); E.wl = (const float*)(P.ws + WS_WL); E.tb = tb; gemm_phase(lsm, G, E); }
    xcd_barrier(bar);
#endif
#if (MK_PH >> 10) & 1
    phase11_final(P, sm);
#endif
}

extern "C" void kernel_launch(void* const* d_in, const int* in_sizes, int n_in, void* d_out, int out_size, void* d_ws, size_t ws_size, hipStream_t stream) {
    (void)in_sizes; (void)n_in; (void)out_size;
    static int grid = 0;
    if (!grid) {
        int dev = 0, cus = 0, per_cu = 0;
        hipGetDevice(&dev);
        hipDeviceGetAttribute(&cus, hipDeviceAttributeMultiprocessorCount, dev);
        hipFuncSetAttribute((const void*)hymba_fwd, hipFuncAttributeMaxDynamicSharedMemorySize, LDS_BYTES);
        hipOccupancyMaxActiveBlocksPerMultiprocessor(&per_cu, hymba_fwd, 512, LDS_BYTES);
        if (per_cu < 1) { fprintf(stderr, "occupancy query says 0 blocks per CU\n"); per_cu = 1; }
        grid = cus;
        if (ws_size < WS_NEED) fprintf(stderr, "workspace too small: %zu < %zu\n", ws_size, (size_t)WS_NEED);
    }
    Params p{};
    p.x = (const float*)d_in[0]; p.c = (const float*)d_in[1]; p.ctx = (const float*)d_in[2]; p.c_ctx = (const float*)d_in[3]; p.w_mod = (const float*)d_in[4]; p.b_mod = (const float*)d_in[5];
    p.norm1_g = (const float*)d_in[6]; p.w_in = (const float*)d_in[7]; p.conv_w = (const float*)d_in[8]; p.a_log = (const float*)d_in[9]; p.dt_bias = (const float*)d_in[10]; p.onorm_g = (const float*)d_in[11];
    p.w_out = (const float*)d_in[12]; p.norm2_g = (const float*)d_in[13]; p.w_group = (const float*)d_in[14]; p.b_group = (const float*)d_in[15]; p.w_router = (const float*)d_in[16]; p.b_router = (const float*)d_in[17];
    p.w_gate = (const float*)d_in[18]; p.w_up = (const float*)d_in[19]; p.w_down = (const float*)d_in[20]; p.final_g = (const float*)d_in[21];
    p.out = (float*)d_out; p.ws = (unsigned char*)d_ws;
    hipMemsetAsync(d_ws, 0, WS_ZERO_BYTES, stream);
    hipLaunchKernelGGL(hymba_fwd, dim3(grid), dim3(512), LDS_BYTES, stream, p);
}
#endif
```

```cpp
#ifndef CPU_EMU
#include <hip/hip_runtime.h>
#include <cstdio>
#include <cstdint>
#define DEV __device__ __forceinline__
#define TID tid_local
#define PHASE_TID int tid_local = (int)threadIdx.x; asm volatile("" : "+v"(tid_local))
#define BID ((int)blockIdx.x)
#define NBLK ((int)gridDim.x)
#define SYNC() __syncthreads()
#endif

typedef unsigned short bf16_t;
typedef short bf16x8 __attribute__((ext_vector_type(8)));
typedef float f32x4 __attribute__((ext_vector_type(4)));
typedef unsigned u32x4 __attribute__((ext_vector_type(4)));
typedef unsigned u32x2 __attribute__((ext_vector_type(2)));

constexpr int D = 1024, NB = 8, SEQ = 8192, CTX = 256;
constexpr int NTOK = NB * SEQ;
constexpr int NCTX = NB * CTX;
constexpr int MROWS = NTOK + NCTX;
constexpr int W_IN = 2576;
constexpr int NSTEP = 4 + 128;
constexpr int NCHAIN = NB * 4 * 2;
constexpr int NPROB = NCHAIN * NSTEP;
constexpr float EPS = 1e-6f;
constexpr int NEXP = 32;
constexpr int LCAP = 65536;

constexpr int IMG_W = 0, IMG_KT = 17408, IMG_Q = 35840, IMG_A = 53248, IMG_U = 62464, IMG_SC = 79872, IMG_BYTES = 79936;

constexpr size_t MiB = 1048576;
constexpr size_t WS_BAR = 0;
constexpr size_t WS_MOD = 16384;
constexpr size_t WS_CNT = 16384 + 221184;
constexpr size_t WS_ZERO_BYTES = WS_CNT + 16384;
constexpr size_t WS_TAB = 262144;
constexpr size_t WS_GB = 1 * MiB;
constexpr size_t WS_TOKK = 6 * MiB;
constexpr size_t WS_WL = 14 * MiB;
constexpr size_t WS_W = 22 * MiB;
constexpr size_t WS_WQKVZ = WS_W;
constexpr size_t WS_WF = WS_WQKVZ + 2048ull * 1024 * 2;
constexpr size_t WS_WOUT = WS_WF + 1024ull * 1024 * 2;
constexpr size_t WS_WGU = WS_WOUT + 1024ull * 1024 * 2;
constexpr size_t WS_WD = WS_WGU + 32ull * 1024 * 1024 * 2;
constexpr size_t WS_R3 = 126 * MiB;
constexpr size_t WS_R4 = 324 * MiB;
constexpr size_t WS_NEED = WS_R4 + 645 * MiB;
constexpr size_t R4_H = 0, R4_P = 132 * MiB;
constexpr size_t R4_AMIX = 0, R4_H2 = 128 * MiB, R4_HID = 256 * MiB, R4_Y = 0;
constexpr size_t DO_GT = 0, DO_ZT = 128 * MiB, DO_ZS = 192 * MiB;

constexpr int LDS_BYTES = 163840;

struct Params {
    const float *x, *c, *ctx, *c_ctx, *w_mod, *b_mod, *norm1_g, *w_in, *conv_w, *a_log, *dt_bias, *onorm_g, *w_out, *norm2_g,
                *w_group, *b_group, *w_router, *b_router, *w_gate, *w_up, *w_down, *final_g;
    float* out;
    unsigned char* ws;
};

DEV bf16_t f2bf(float f) { unsigned u = __builtin_bit_cast(unsigned, f); u += 0x7FFFu + ((u >> 16) & 1u); return (bf16_t)(u >> 16); }
DEV float bf2f(bf16_t b) { return __builtin_bit_cast(float, ((unsigned)b) << 16); }
DEV unsigned pk2(float lo, float hi) { return (unsigned)f2bf(lo) | ((unsigned)f2bf(hi) << 16); }
DEV float silu_f(float v) { return v / (1.0f + __expf(-v)); }

#ifndef CPU_EMU
DEV f32x4 mfma16(bf16x8 a, bf16x8 b, f32x4 c) { return __builtin_amdgcn_mfma_f32_16x16x32_bf16(a, b, c, 0, 0, 0); }
DEV float shfl_xor_f(float v, int m) { return __shfl_xor(v, m); }
DEV float shfl_up_f(float v, int d) { return __shfl_up(v, d); }
DEV void atomic_add_f32(float* p, float v) { atomicAdd(p, v); }
DEV unsigned atomic_add_u32(unsigned* p, unsigned v) { return atomicAdd(p, v); }
DEV void sincospi_f(float x, float* s, float* c) { sincospif(x, s, c); }
#endif

DEV float wave_sum(float v) {
#pragma unroll
    for (int o = 32; o >= 1; o >>= 1) v += shfl_xor_f(v, o);
    return v;
}
DEV bf16x8 frag_gather(const bf16_t* p, int stride) {
    bf16x8 r;
#pragma unroll
    for (int j = 0; j < 8; ++j) r[j] = (short)p[j * stride];
    return r;
}
DEV bf16x8 frag16(const bf16_t* p) { return *(const bf16x8*)p; }

DEV void phase0_mod(const Params& P, unsigned char* sm) {
    PHASE_TID;
    float* sil = (float*)sm;
    float* red = (float*)(sm + 36864);
    for (int i = TID; i < 9 * 1024; i += 512) { const int r = i >> 10, k = i & 1023; const float v = r < 8 ? P.c[r * 1024 + k] : P.c_ctx[k]; sil[i] = silu_f(v); }
    SYNC();
    float* mod = (float*)(P.ws + WS_MOD);
    for (int cb = BID; cb < 256; cb += NBLK) {
        const int c = TID % 24, kg = TID / 24, j0 = cb * 24;
        if (kg < 21) {
            float acc[9];
#pragma unroll
            for (int r = 0; r < 9; ++r) acc[r] = 0.f;
#pragma unroll 7
            for (int k = kg; k < 1024; k += 21) { const float w = P.w_mod[(size_t)k * 6144 + j0 + c];
#pragma unroll
                for (int r = 0; r < 9; ++r) acc[r] += sil[r * 1024 + k] * w; }
#pragma unroll
            for (int r = 0; r < 9; ++r) red[(kg * 24 + c) * 9 + r] = acc[r];
        }
        SYNC();
        if (TID < 24 * 9) { const int cc = TID / 9, r = TID - cc * 9; float t = P.b_mod[j0 + cc];
            for (int g = 0; g < 21; ++g) t += red[(g * 24 + cc) * 9 + r];
            mod[r * 6144 + j0 + cc] = t; }
        SYNC();
    }
}

DEV void tconv_tile(const float* src, int lds_, bf16_t* dst, int ldd, int inter, unsigned char* sm) {
    PHASE_TID;
    float* tile = (float*)sm;
    f32x4 v[8];
#pragma unroll
    for (int q = 0; q < 8; ++q) v[q] = *(const f32x4*)(src + (size_t)((TID >> 6) + q * 8) * lds_ + (TID & 63) * 4);
#pragma unroll
    for (int q = 0; q < 8; ++q) { float* t = tile + ((TID >> 6) + q * 8) * 257 + (TID & 63) * 4; t[0] = v[q][0]; t[1] = v[q][1]; t[2] = v[q][2]; t[3] = v[q][3]; }
    SYNC();
    const int c = TID & 255, half = TID >> 8;
    const int drow = inter ? ((c >> 7) * 256 + (inter - 1) * 128 + (c & 127)) : c;
    u32x4 w[4];
#pragma unroll
    for (int q = 0; q < 4; ++q)
#pragma unroll
        for (int j = 0; j < 4; ++j) w[q][j] = pk2(tile[(half * 32 + q * 8 + 2 * j) * 257 + c], tile[(half * 32 + q * 8 + 2 * j + 1) * 257 + c]);
#pragma unroll
    for (int q = 0; q < 4; ++q) *(u32x4*)(dst + (size_t)drow * ldd + half * 32 + q * 8) = w[q];
    SYNC();
}

DEV void phase0_weights(const Params& P, unsigned char* sm) {
    bf16_t* wqkvz = (bf16_t*)(P.ws + WS_WQKVZ); bf16_t* wout = (bf16_t*)(P.ws + WS_WOUT); bf16_t* wgu = (bf16_t*)(P.ws + WS_WGU); bf16_t* wd = (bf16_t*)(P.ws + WS_WD);
    const int NJ = 128 + 64 + 3 * 1024;
    for (int t = BID; t < NJ; t += NBLK) {
        if (t < 128) { const int kt = t >> 3, nt = t & 7;
            tconv_tile(P.w_in + (size_t)(kt * 64) * W_IN + 512 + nt * 256, W_IN, wqkvz + (size_t)(nt * 256) * 1024 + kt * 64, 1024, 0, sm);
        } else if (t < 192) { const int u = t - 128, kt = u >> 2, nt = u & 3;
            tconv_tile(P.w_out + (size_t)(kt * 64) * 1024 + nt * 256, 1024, wout + (size_t)(nt * 256) * 1024 + kt * 64, 1024, 0, sm);
        } else if (t < 192 + 2048) { const int u = t - 192, up = u >> 10, v = u & 1023, e = v >> 5, w = v & 31, kt = w >> 1, nt = w & 1;
            const float* src = (up ? P.w_up : P.w_gate) + (size_t)e * 1024 * 512 + (size_t)(kt * 64) * 512 + nt * 256;
            tconv_tile(src, 512, wgu + (size_t)e * 1024 * 1024 + (size_t)(nt * 512) * 1024 + kt * 64, 1024, 1 + up, sm);
        } else { const int v = t - 192 - 2048, e = v >> 5, w = v & 31, kt = w >> 2, nt = w & 3;
            tconv_tile(P.w_down + (size_t)e * 512 * 1024 + (size_t)(kt * 64) * 1024 + nt * 256, 1024, wd + (size_t)e * 1024 * 512 + (size_t)(nt * 256) * 512 + kt * 64, 512, 0, sm);
        }
    }
}

DEV void phase0_wf(const Params& P, unsigned char* sm) {
    PHASE_TID;
    float* cs = (float*)sm;
    if (TID < 128) { float s, c; sincospi_f((float)TID * (2.0f / 128.0f), &s, &c); cs[TID] = c; cs[128 + TID] = s; }
    SYNC();
    bf16_t* wf = (bf16_t*)(P.ws + WS_WF);
    const float sc = 0.08838834764831845f;
    for (int it = BID; it < 256; it += NBLK) {
        const int kb = it & 1, cb = (it >> 1) & 15, part = (it >> 5) & 1, g = it >> 6;
        const int k = kb * 512 + TID;
        const float* wrow = P.w_in + (size_t)k * W_IN + g * 128;
        float acc[8];
#pragma unroll
        for (int q = 0; q < 8; ++q) acc[q] = 0.f;
#pragma unroll 8
        for (int c4 = 0; c4 < 32; ++c4) { const f32x4 w4 = *(const f32x4*)(wrow + c4 * 4);
#pragma unroll
            for (int e = 0; e < 4; ++e) { const int c = c4 * 4 + e;
#pragma unroll
                for (int q = 0; q < 8; ++q) { const int cp = cb * 8 + q; acc[q] += w4[e] * cs[part * 128 + ((c * cp) & 127)]; } } }
#pragma unroll
        for (int q = 0; q < 8; ++q) { const int chc = part * 512 + g * 128 + cb * 8 + q; wf[(size_t)chc * 1024 + k] = f2bf((part ? -acc[q] : acc[q]) * sc); }
    }
    bf16_t* tab = (bf16_t*)(P.ws + WS_TAB);
    const float sc2 = 0.011048543456039806f;
    for (int i = BID * 512 + TID; i < 4096 + 16384; i += NBLK * 512) {
        if (i < 4096) { const int a = i >> 6, b = i & 63; float s, c; sincospi_f((float)((a * b) & 63) * (2.0f / 64.0f), &s, &c); tab[i] = f2bf(c); tab[4096 + i] = f2bf(s); }
        else { const int j = i - 4096, a = j >> 7, b = j & 127; float s, c; sincospi_f((float)((a * b) & 127) * (2.0f / 128.0f), &s, &c); tab[8192 + j] = f2bf(c * sc2); tab[8192 + 16384 + j] = f2bf(s * sc2); }
    }
}

DEV void phase1_prep(const Params& P, unsigned char* sm) {
    PHASE_TID;
    bf16_t* Bhi = (bf16_t*)sm; bf16_t* Blo = (bf16_t*)(sm + 33024);
    float* gsv = (float*)(sm + 66048); float* shv = (float*)(sm + 70144);
    {
        f32x4 w[2][4];
#pragma unroll
        for (int h = 0; h < 2; ++h)
#pragma unroll
            for (int q = 0; q < 4; ++q) w[h][q] = *(const f32x4*)(P.w_in + (size_t)(TID + h * 512) * W_IN + 2560 + q * 4);
#pragma unroll
        for (int h = 0; h < 2; ++h)
#pragma unroll
            for (int q = 0; q < 4; ++q)
#pragma unroll
                for (int e = 0; e < 4; ++e) { const int n = q * 4 + e, k = TID + h * 512; const float v = w[h][q][e]; const bf16_t hi = f2bf(v); Bhi[n * 1032 + k] = hi; Blo[n * 1032 + k] = f2bf(v - bf2f(hi)); }
    }
    const float* mod = (const float*)(P.ws + WS_MOD);
    bf16_t* h = (bf16_t*)(P.ws + WS_R4 + R4_H);
    float* gb = (float*)(P.ws + WS_GB);
    const int wid = TID >> 6, lane = TID & 63, fr = lane & 15, fq = lane >> 4;
    for (int t = BID; t < MROWS / 128; t += NBLK) {
        const int r0 = t * 128 + wid * 16, mb = (t * 128 < NTOK) ? ((t * 128) >> 13) : 8;
        SYNC();
        { const float* shift = mod + mb * 6144, *scale = shift + 1024;
#pragma unroll
          for (int q = 0; q < 2; ++q) { const int k = TID + q * 512; gsv[k] = P.norm1_g[k] * (1.0f + scale[k]); shv[k] = shift[k]; } }
        SYNC();
        const int rr = r0 + fr;
        const float* src = (rr < NTOK ? P.x + (size_t)rr * D : P.ctx + (size_t)(rr - NTOK) * D) + fq * 8;
        float ss = 0.f;
#pragma unroll 8
        for (int ks = 0; ks < 32; ++ks) { const f32x4 a0 = *(const f32x4*)(src + ks * 32), a1 = *(const f32x4*)(src + ks * 32 + 4);
            ss += a0[0] * a0[0] + a0[1] * a0[1] + a0[2] * a0[2] + a0[3] * a0[3] + a1[0] * a1[0] + a1[1] * a1[1] + a1[2] * a1[2] + a1[3] * a1[3]; }
        ss += shfl_xor_f(ss, 16); ss += shfl_xor_f(ss, 32);
        const float rstd = 1.0f / sqrtf(ss * (1.0f / 1024.0f) + EPS);
        f32x4 acc = (f32x4){0.f, 0.f, 0.f, 0.f};
        bf16_t* hrow = h + (size_t)rr * D + fq * 8;
#pragma unroll 4
        for (int ks = 0; ks < 32; ++ks) {
            const f32x4 a0 = *(const f32x4*)(src + ks * 32), a1 = *(const f32x4*)(src + ks * 32 + 4);
            const f32x4 g0 = *(const f32x4*)(gsv + ks * 32 + fq * 8), g1 = *(const f32x4*)(gsv + ks * 32 + fq * 8 + 4), s0 = *(const f32x4*)(shv + ks * 32 + fq * 8), s1 = *(const f32x4*)(shv + ks * 32 + fq * 8 + 4);
            float hv[8];
#pragma unroll
            for (int e = 0; e < 4; ++e) { hv[e] = a0[e] * rstd * g0[e] + s0[e]; hv[4 + e] = a1[e] * rstd * g1[e] + s1[e]; }
            u32x4 whi, wlo;
#pragma unroll
            for (int e = 0; e < 4; ++e) { const bf16_t h0 = f2bf(hv[2 * e]), h1 = f2bf(hv[2 * e + 1]); whi[e] = (unsigned)h0 | ((unsigned)h1 << 16); wlo[e] = pk2(hv[2 * e] - bf2f(h0), hv[2 * e + 1] - bf2f(h1)); }
            *(u32x4*)(hrow + ks * 32) = whi;
            const bf16x8 ahi = __builtin_bit_cast(bf16x8, whi), alo = __builtin_bit_cast(bf16x8, wlo);
            const bf16x8 bhi = frag16(Bhi + fr * 1032 + ks * 32 + fq * 8), blo = frag16(Blo + fr * 1032 + ks * 32 + fq * 8);
            acc = mfma16(ahi, bhi, acc); acc = mfma16(alo, bhi, acc); acc = mfma16(ahi, blo, acc);
        }
        float ea = 0.f, db = 0.f;
        if (fr >= 8) { ea = -__expf(P.a_log[fr - 8]); db = P.dt_bias[fr - 8]; }
#pragma unroll
        for (int reg = 0; reg < 4; ++reg) { const float v = acc[reg]; float o;
            if (fr < 8) o = 1.0f / (1.0f + __expf(-v));
            else { const float z = v + db; const float sp = z > 20.f ? z : log1pf(__expf(z)); o = ea * sp; }
            gb[(size_t)(r0 + fq * 4 + reg) * 16 + fr] = o; }
    }
}

#ifndef CPU_EMU
namespace pg8 {
#define PG8_LAS __attribute__((address_space(3)))
constexpr int BM = 256, BK = 64, HALF = 128, HTB = HALF * BK * 2, STAGE_BYTES = 8 * HTB;
__device__ __forceinline__ int lds_byte(int r, int c) { const int st = (r >> 4) * 2 + (c >> 5), rr = r & 15, cc = c & 31, ob = rr * 64 + cc * 2; return st * 1024 + (ob ^ (((ob >> 9) & 1) << 5)); }
__device__ __forceinline__ void stage_rc(int b, int& R, int& C) { const int st = b / 1024, sb = b % 1024, swz = sb ^ (((sb >> 9) & 1) << 5); R = (st >> 1) * 16 + swz / 64; C = (st & 1) * 32 + (swz % 64) / 2; }
__device__ __forceinline__ int perm32(int rho) { const int n = rho >> 4, i = rho & 15; return 8 * (i >> 2) + 4 * n + (i & 3); }
struct Unit { int pm, pn, e, cnt; };
__device__ __forceinline__ unsigned cvt_pk_bf16(float lo, float hi) { unsigned r; asm volatile("v_cvt_pk_bf16_f32 %0, %1, %2" : "=v"(r) : "v"(lo), "v"(hi)); return r; }

template <class Prob, class Epi>
__device__ __forceinline__ void gemm_phase(PG8_LAS unsigned char* lds, const Prob& G, const Epi& E) {
    int tid_ = threadIdx.x; asm volatile("" : "+v"(tid_));
    const int tid = tid_, wid = __builtin_amdgcn_readfirstlane(tid >> 6), lane = tid & 63, wr = wid >> 2, wc = wid & 3, fr = lane & 15, fq = lane >> 4;
    const int K = G.K, nt = K / BK;
    int R0, C0; stage_rc(tid * 16, R0, C0);
    const int rA0 = R0, rA1 = R0 + 64;
    const int rB0 = Epi::PERM ? ((R0 & ~31) + perm32(R0 & 31)) : R0, rB1 = Epi::PERM ? (((R0 + 64) & ~31) + perm32((R0 + 64) & 31)) : R0 + 64;
    const unsigned ldsw = (unsigned)wid * 1024u;
    const int aoff = lds_byte(wr * 64 + fr, fq * 8), boff = lds_byte(wc * 32 + fr, fq * 8);
    const char* Ab = (const char*)G.A; const char* Bb = (const char*)G.Bt;
#define PG8_SA(b, h) (((b) * 2 + (h)) * HTB)
#define PG8_SB(b, h) ((4 + (b) * 2 + (h)) * HTB)
#define PG8_STAGE(bufoff, gbase, ub, l0, l1) do { \
        __builtin_amdgcn_global_load_lds((const unsigned*)((gbase) + (size_t)(ub) + (l0)), (PG8_LAS unsigned*)(lds + (bufoff) + ldsw), 16, 0, 0); \
        __builtin_amdgcn_global_load_lds((const unsigned*)((gbase) + (size_t)(ub) + (l1)), (PG8_LAS unsigned*)(lds + (bufoff) + ldsw + 8192), 16, 0, 0); } while (0)
#define PG8_LDA(dst, b, h) do { _Pragma("unroll") for (int m = 0; m < 4; ++m) _Pragma("unroll") for (int k = 0; k < 2; ++k) dst[m][k] = *(const PG8_LAS bf16x8*)(lds + PG8_SA(b, h) + aoff + m * 2048 + k * 1024); } while (0)
#define PG8_LDB(dst, b, h) do { _Pragma("unroll") for (int n = 0; n < 2; ++n) _Pragma("unroll") for (int k = 0; k < 2; ++k) dst[n][k] = *(const PG8_LAS bf16x8*)(lds + PG8_SB(b, h) + boff + n * 2048 + k * 1024); } while (0)
#define PG8_MMA(ai, bj, At, Bt) do { __builtin_amdgcn_s_setprio(1); _Pragma("unroll") for (int m = 0; m < 4; ++m) _Pragma("unroll") for (int n = 0; n < 2; ++n) _Pragma("unroll") for (int k = 0; k < 2; ++k) \
        acc[ai][bj][m][n] = __builtin_amdgcn_mfma_f32_16x16x32_bf16(Bt[n][k], At[m][k], acc[ai][bj][m][n], 0, 0, 0); __builtin_amdgcn_s_setprio(0); } while (0)
#define PG8_WAIT_V(n) asm volatile("s_waitcnt vmcnt(" #n ")" ::: "memory")
#define PG8_WAIT_L(n) asm volatile("s_waitcnt lgkmcnt(" #n ")" ::: "memory")
#define PG8_BAR __builtin_amdgcn_s_barrier()
#define PG8_SCHED __builtin_amdgcn_sched_barrier(0)
    Unit cur, nxt; int ui = 0;
    if (!G.next(0, cur)) return;
    f32x4 acc[2][2][4][2];
#pragma unroll
    for (int a = 0; a < 2; ++a)
#pragma unroll
        for (int b = 0; b < 2; ++b)
#pragma unroll
            for (int m = 0; m < 4; ++m)
#pragma unroll
                for (int n = 0; n < 2; ++n) acc[a][b][m][n] = (f32x4){0.f, 0.f, 0.f, 0.f};
    bf16x8 At[4][2], B0[2][2], B1[2][2];
    const unsigned cb2 = (unsigned)C0 * 2u;
    const unsigned lB00 = G.laneB(rB0) + cb2, lB01 = G.laneB(rB1) + cb2, lB10 = G.laneB(128 + rB0) + cb2, lB11 = G.laneB(128 + rB1) + cb2;
    const unsigned lA00 = G.laneA(rA0) + cb2, lA01 = G.laneA(rA1) + cb2, lA10 = G.laneA(128 + rA0) + cb2, lA11 = G.laneA(128 + rA1) + cb2;
    unsigned cA00 = lA00, cA01 = lA01, cA10 = lA10, cA11 = lA11, nA00 = lA00, nA01 = lA01, nA10 = lA10, nA11 = lA11;
    if constexpr (Prob::GATHER_A) { cA00 += G.gathA(cur, rA0); cA01 += G.gathA(cur, rA1); cA10 += G.gathA(cur, 128 + rA0); cA11 += G.gathA(cur, 128 + rA1); }
    unsigned uAc = G.baseA(cur), uBc = G.baseB(cur), uAn = uAc, uBn = uBc;
    PG8_STAGE(PG8_SB(0, 0), Bb, uBc, lB00, lB01); PG8_STAGE(PG8_SA(0, 0), Ab, uAc, cA00, cA01); PG8_STAGE(PG8_SB(0, 1), Bb, uBc, lB10, lB11); PG8_STAGE(PG8_SA(0, 1), Ab, uAc, cA10, cA11);
    if (wr == 1) PG8_BAR;
    PG8_WAIT_V(4); PG8_BAR;
    PG8_STAGE(PG8_SB(1, 0), Bb, uBc + 128u, lB00, lB01); PG8_STAGE(PG8_SA(1, 0), Ab, uAc + 128u, cA00, cA01); PG8_STAGE(PG8_SB(1, 1), Bb, uBc + 128u, lB10, lB11);
    PG8_WAIT_V(6); PG8_BAR;
    for (;;) {
        const bool has_next = G.next(ui + 1, nxt);
        if (has_next) {
            uAn = G.baseA(nxt); uBn = G.baseB(nxt);
            if constexpr (Prob::GATHER_A) { nA00 = lA00 + G.gathA(nxt, rA0); nA01 = lA01 + G.gathA(nxt, rA1); nA10 = lA10 + G.gathA(nxt, 128 + rA0); nA11 = lA11 + G.gathA(nxt, 128 + rA1); }
        } else { uAn = uAc; uBn = uBc; if constexpr (Prob::GATHER_A) { nA00 = cA00; nA01 = cA01; nA10 = cA10; nA11 = cA11; } }
        for (int t = 0; t < nt; t += 2) {
            const bool last = (t == nt - 2);
            const unsigned k1 = (unsigned)(t + 1) * 128u;
            const unsigned uA2 = last ? uAn : uAc + (unsigned)(t + 2) * 128u, uB2 = last ? uBn : uBc + (unsigned)(t + 2) * 128u, uA3 = uA2 + 128u, uB3 = uB2 + 128u;
            unsigned a00 = cA00, a01 = cA01, a10 = cA10, a11 = cA11;
            if constexpr (Prob::GATHER_A) { a00 = last ? nA00 : cA00; a01 = last ? nA01 : cA01; a10 = last ? nA10 : cA10; a11 = last ? nA11 : cA11; }
            PG8_LDB(B0, 0, 0); PG8_SCHED; PG8_LDA(At, 0, 0); PG8_STAGE(PG8_SA(1, 1), Ab, uAc + k1, cA10, cA11);
            PG8_WAIT_L(8); PG8_BAR; PG8_WAIT_L(0); PG8_MMA(0, 0, At, B0); PG8_BAR; PG8_SCHED;
            PG8_LDB(B1, 0, 1); PG8_STAGE(PG8_SB(0, 0), Bb, uB2, lB00, lB01);
            PG8_BAR; PG8_WAIT_L(0); PG8_MMA(0, 1, At, B1); PG8_BAR;
            PG8_LDA(At, 0, 1); PG8_STAGE(PG8_SA(0, 0), Ab, uA2, a00, a01);
            PG8_BAR; PG8_WAIT_L(0); PG8_MMA(1, 0, At, B0); PG8_BAR; PG8_SCHED;
            PG8_STAGE(PG8_SB(0, 1), Bb, uB2, lB10, lB11);
            PG8_WAIT_V(6); PG8_BAR; PG8_MMA(1, 1, At, B1); PG8_BAR;
            PG8_LDB(B0, 1, 0); PG8_SCHED; PG8_LDA(At, 1, 0); PG8_STAGE(PG8_SA(0, 1), Ab, uA2, a10, a11);
            PG8_WAIT_L(8); PG8_BAR; PG8_WAIT_L(0); PG8_MMA(0, 0, At, B0); PG8_BAR; PG8_SCHED;
            PG8_LDB(B1, 1, 1); PG8_STAGE(PG8_SB(1, 0), Bb, uB3, lB00, lB01);
            PG8_BAR; PG8_WAIT_L(0); PG8_MMA(0, 1, At, B1); PG8_BAR;
            PG8_LDA(At, 1, 1); PG8_STAGE(PG8_SA(1, 0), Ab, uA3, a00, a01);
            PG8_BAR; PG8_WAIT_L(0); PG8_MMA(1, 0, At, B0); PG8_BAR; PG8_SCHED;
            PG8_STAGE(PG8_SB(1, 1), Bb, uB3, lB10, lB11);
            PG8_WAIT_V(6); PG8_BAR; PG8_MMA(1, 1, At, B1); PG8_BAR;
        }
        E(acc, cur, wr, wc, fr, fq);
        if (!has_next) break;
#pragma unroll
        for (int a = 0; a < 2; ++a)
#pragma unroll
            for (int b = 0; b < 2; ++b)
#pragma unroll
                for (int m = 0; m < 4; ++m)
#pragma unroll
                    for (int n = 0; n < 2; ++n) acc[a][b][m][n] = (f32x4){0.f, 0.f, 0.f, 0.f};
        cur = nxt; ++ui; uAc = uAn; uBc = uBn;
        if constexpr (Prob::GATHER_A) { cA00 = nA00; cA01 = nA01; cA10 = nA10; cA11 = nA11; }
    }
    PG8_WAIT_V(0);
    if (wr == 0) PG8_BAR;
    PG8_BAR;
#undef PG8_SA
#undef PG8_SB
#undef PG8_STAGE
#undef PG8_LDA
#undef PG8_LDB
#undef PG8_MMA
#undef PG8_WAIT_V
#undef PG8_WAIT_L
#undef PG8_BAR
#undef PG8_SCHED
}

struct GridOrder {
    int nM, nN, nwg, G, c;
    __device__ __forceinline__ void init(int nM_, int nN_, int G_, int c_) { nM = nM_; nN = nN_; nwg = nM * nN; G = G_; c = c_; }
    __device__ __forceinline__ bool next(int i, Unit& u) const {
        const long L = (long)i * G + c; if (L >= nwg) return false;
        int wgid = (int)L; { const int q = nwg / 8, r = nwg % 8, xcd = wgid % 8, off = wgid / 8; wgid = (xcd < r ? xcd * (q + 1) : r * (q + 1) + (xcd - r) * q) + off; }
        const int nig = 8 * nN, gid = wgid / nig, fm = gid * 8, gsz = (nM - fm) < 8 ? (nM - fm) : 8;
        u.pm = fm + ((wgid % nig) % gsz); u.pn = (wgid % nig) / gsz; u.e = 0; u.cnt = 256; return true;
    }
};

struct ProbInproj : GridOrder { const bf16_t* A; const bf16_t* Bt; int K; static constexpr bool GATHER_A = false;
    __device__ __forceinline__ unsigned laneA(int r) const { return (unsigned)r * 2048u; }
    __device__ __forceinline__ unsigned laneB(int r) const { return (unsigned)r * 2048u; }
    __device__ __forceinline__ unsigned baseA(const Unit& u) const { return (unsigned)(u.pm * 256) * 2048u; }
    __device__ __forceinline__ unsigned baseB(const Unit& u) const { return (unsigned)(u.pn * 256) * 2048u; }
    __device__ __forceinline__ unsigned gathA(const Unit&, int) const { return 0u; } };
struct ProbGT : GridOrder { const bf16_t* A; const bf16_t* Bt; int K; static constexpr bool GATHER_A = false;
    __device__ __forceinline__ unsigned laneA(int r) const { return (unsigned)r * 2048u; }
    __device__ __forceinline__ unsigned laneB(int r) const { return (unsigned)(128 * (r & 63) + (r >> 6)) * 2048u; }
    __device__ __forceinline__ unsigned baseA(const Unit& u) const { return (unsigned)(u.pm * 256) * 2048u; }
    __device__ __forceinline__ unsigned baseB(const Unit& u) const { const int col = u.pn * 256, b = col >> 13, w = col & 8191; return (unsigned)(b * 8192 + (w >> 6)) * 2048u; }
    __device__ __forceinline__ unsigned gathA(const Unit&, int) const { return 0u; } };
struct EpiStoreBf16 {
    static constexpr bool PERM = true; bf16_t* O; int ldc;
    __device__ __forceinline__ void operator()(const f32x4 (&acc)[2][2][4][2], const Unit& u, int wr, int wc, int fr, int fq) const {
        const int row0 = u.pm * 256 + wr * 64 + fr, col0 = u.pn * 256 + wc * 32 + 8 * fq;
#pragma unroll
        for (int ai = 0; ai < 2; ++ai)
#pragma unroll
            for (int m = 0; m < 4; ++m) { bf16_t* rowp = O + (size_t)(row0 + ai * 128 + m * 16) * ldc + col0;
#pragma unroll
                for (int bj = 0; bj < 2; ++bj) { const f32x4 v0 = acc[ai][bj][m][0], v1 = acc[ai][bj][m][1];
                    u32x4 w; w.x = cvt_pk_bf16(v0[0], v0[1]); w.y = cvt_pk_bf16(v0[2], v0[3]); w.z = cvt_pk_bf16(v1[0], v1[1]); w.w = cvt_pk_bf16(v1[2], v1[3]);
                    *(u32x4*)(rowp + bj * 128) = w; } }
    }
};
struct EpiInproj {
    static constexpr bool PERM = true; bf16_t* O; bf16_t* zs;
    __device__ __forceinline__ void operator()(const f32x4 (&acc)[2][2][4][2], const Unit& u, int wr, int wc, int fr, int fq) const {
        const int row0 = u.pm * 256 + wr * 64 + fr, col0 = u.pn * 256 + wc * 32 + 8 * fq;
        const bool isz = u.pn >= 6;
        if (isz && u.pm * 256 >= NTOK) return;
#pragma unroll
        for (int ai = 0; ai < 2; ++ai)
#pragma unroll
            for (int m = 0; m < 4; ++m) { const size_t row = (size_t)(row0 + ai * 128 + m * 16);
                bf16_t* rowp = isz ? zs + row * 512 + (col0 - 1536) : O + row * 2048 + col0;
#pragma unroll
                for (int bj = 0; bj < 2; ++bj) { f32x4 v0 = acc[ai][bj][m][0], v1 = acc[ai][bj][m][1];
                    if (isz) {
#pragma unroll
                        for (int j = 0; j < 4; ++j) { v0[j] = v0[j] / (1.0f + __expf(-v0[j])); v1[j] = v1[j] / (1.0f + __expf(-v1[j])); } }
                    u32x4 w; w.x = cvt_pk_bf16(v0[0], v0[1]); w.y = cvt_pk_bf16(v0[2], v0[3]); w.z = cvt_pk_bf16(v1[0], v1[1]); w.w = cvt_pk_bf16(v1[2], v1[3]);
                    *(u32x4*)(rowp + bj * 128) = w; } }
    }
};
typedef ProbInproj ProbOut;
struct EpiResid {
    static constexpr bool PERM = false; const float* x; const float* mod; float* out;
    __device__ __forceinline__ void operator()(const f32x4 (&acc)[2][2][4][2], const Unit& u, int wr, int wc, int fr, int fq) const {
        const int row0 = u.pm * 256 + wr * 64 + fr, col0 = u.pn * 256 + wc * 32 + 4 * fq;
        const float* gate = mod + ((u.pm * 256) >> 13) * 6144 + 2 * 1024;
        f32x4 gv[2][2];
#pragma unroll
        for (int bj = 0; bj < 2; ++bj)
#pragma unroll
            for (int n = 0; n < 2; ++n) gv[bj][n] = *(const f32x4*)(gate + col0 + bj * 128 + n * 16);
#pragma unroll
        for (int ai = 0; ai < 2; ++ai)
#pragma unroll
            for (int m = 0; m < 4; ++m) { const size_t off = (size_t)(row0 + ai * 128 + m * 16) * 1024 + col0;
#pragma unroll
                for (int bj = 0; bj < 2; ++bj)
#pragma unroll
                    for (int n = 0; n < 2; ++n) { const f32x4 xv = *(const f32x4*)(x + off + bj * 128 + n * 16); *(f32x4*)(out + off + bj * 128 + n * 16) = xv + gv[bj][n] * acc[ai][bj][m][n]; } }
    }
};
struct MoeOrder {
    const PG8_LAS int* tb; const PG8_LAS int* cnt; int G, c;
    __device__ __forceinline__ bool next(int i, Unit& u) const {
        const int L = i * G + c, ntile = tb[32]; if (L >= ntile * 4) return false;
        const int tile = L >> 2; u.pn = L & 3; int e = 0;
#pragma unroll
        for (int s = 16; s >= 1; s >>= 1) if (__builtin_amdgcn_readfirstlane(tb[e + s]) <= tile) e += s;
        u.e = e; u.pm = tile; const int loc = (tile - __builtin_amdgcn_readfirstlane(tb[e])) * 256; u.cnt = __builtin_amdgcn_readfirstlane(cnt[e]) - loc; return true;
    }
};
struct ProbMoe1 : MoeOrder { const bf16_t* A; const bf16_t* Bt; int K; const unsigned* tokk; static constexpr bool GATHER_A = true;
    __device__ __forceinline__ unsigned laneA(int) const { return 0u; }
    __device__ __forceinline__ unsigned laneB(int r) const { return (unsigned)r * 2048u; }
    __device__ __forceinline__ unsigned baseA(const Unit&) const { return 0u; }
    __device__ __forceinline__ unsigned baseB(const Unit& u) const { return (unsigned)(u.e * 1024 + u.pn * 256) * 2048u; }
    __device__ __forceinline__ unsigned gathA(const Unit& u, int r) const { const int loc = (u.pm - __builtin_amdgcn_readfirstlane(tb[u.e])) * 256 + r; const unsigned tk = r < u.cnt ? tokk[(size_t)u.e * LCAP + loc] : 0u; return (tk >> 1) * 2048u; } };
struct EpiMoe1 {
    static constexpr bool PERM = true; bf16_t* hid;
    __device__ __forceinline__ void operator()(const f32x4 (&acc)[2][2][4][2], const Unit& u, int wr, int wc, int fr, int fq) const {
        const int row0 = u.pm * 256 + wr * 64 + fr, col0 = u.pn * 128 + wc * 32 + 8 * fq;
#pragma unroll
        for (int ai = 0; ai < 2; ++ai)
#pragma unroll
            for (int m = 0; m < 4; ++m) { float hv[8];
#pragma unroll
                for (int n = 0; n < 2; ++n)
#pragma unroll
                    for (int j = 0; j < 4; ++j) { const float g = acc[ai][0][m][n][j], up = acc[ai][1][m][n][j]; hv[n * 4 + j] = g / (1.0f + __expf(-g)) * up; }
                u32x4 w; w.x = cvt_pk_bf16(hv[0], hv[1]); w.y = cvt_pk_bf16(hv[2], hv[3]); w.z = cvt_pk_bf16(hv[4], hv[5]); w.w = cvt_pk_bf16(hv[6], hv[7]);
                *(u32x4*)(hid + (size_t)(row0 + ai * 128 + m * 16) * 512 + col0) = w; }
    }
};
struct ProbMoe2 : MoeOrder { const bf16_t* A; const bf16_t* Bt; int K; static constexpr bool GATHER_A = false;
    __device__ __forceinline__ unsigned laneA(int r) const { return (unsigned)r * 1024u; }
    __device__ __forceinline__ unsigned laneB(int r) const { return (unsigned)r * 1024u; }
    __device__ __forceinline__ unsigned baseA(const Unit& u) const { return (unsigned)(u.pm * 256) * 1024u; }
    __device__ __forceinline__ unsigned baseB(const Unit& u) const { return (unsigned)(u.e * 1024 + u.pn * 256) * 1024u; }
    __device__ __forceinline__ unsigned gathA(const Unit&, int) const { return 0u; } };
struct EpiMoe2 {
    static constexpr bool PERM = true; bf16_t* Y; const unsigned* tokk; const float* wl; const PG8_LAS int* tb;
    __device__ __forceinline__ void operator()(const f32x4 (&acc)[2][2][4][2], const Unit& u, int wr, int wc, int fr, int fq) const {
        const int col0 = u.pn * 256 + wc * 32 + 8 * fq, locb = (u.pm - __builtin_amdgcn_readfirstlane(tb[u.e])) * 256;
#pragma unroll
        for (int ai = 0; ai < 2; ++ai)
#pragma unroll
            for (int m = 0; m < 4; ++m) { const int r = ai * 128 + wr * 64 + m * 16 + fr;
                if (r < u.cnt) { const unsigned tk = tokk[(size_t)u.e * LCAP + locb + r]; const float w = wl[(size_t)u.e * LCAP + locb + r];
                    bf16_t* rowp = Y + ((size_t)(tk & 1u) * NTOK + (tk >> 1)) * 1024 + col0;
#pragma unroll
                    for (int bj = 0; bj < 2; ++bj) { const f32x4 v0 = acc[ai][bj][m][0] * w, v1 = acc[ai][bj][m][1] * w;
                        u32x4 q; q.x = cvt_pk_bf16(v0[0], v0[1]); q.y = cvt_pk_bf16(v0[2], v0[3]); q.z = cvt_pk_bf16(v1[0], v1[1]); q.w = cvt_pk_bf16(v1[2], v1[3]);
                        *(u32x4*)(rowp + bj * 128) = q; } } }
    }
};
}
#endif

DEV void conv_row_compute(const Params& P, const bf16_t* ring, const float* wts, int s0, int s1, int s2, int ntap_rows, int slab, bf16_t* dst, int tid) {
    const int cq = tid & 31, tg = tid >> 5;
    float acc[4][4];
#pragma unroll
    for (int t = 0; t < 4; ++t)
#pragma unroll
        for (int c = 0; c < 4; ++c) acc[t][c] = 0.f;
#pragma unroll
    for (int ky = 0; ky < 3; ++ky) {
        if (ntap_rows == 1 && ky != 1) continue;
        const int sl = ky == 0 ? s0 : ky == 1 ? s1 : s2;
        f32x4 w[3];
#pragma unroll
        for (int kx = 0; kx < 3; ++kx) w[kx] = *(const f32x4*)(wts + (ky * 3 + kx) * 128 + cq * 4);
        float in[6][4];
#pragma unroll
        for (int pos = 0; pos < 6; ++pos) { const u32x2 v = *(const u32x2*)(ring + sl * 8448 + (tg * 4 + pos) * 128 + cq * 4);
            in[pos][0] = bf2f((bf16_t)(v[0] & 0xffffu)); in[pos][1] = bf2f((bf16_t)(v[0] >> 16)); in[pos][2] = bf2f((bf16_t)(v[1] & 0xffffu)); in[pos][3] = bf2f((bf16_t)(v[1] >> 16)); }
#pragma unroll
        for (int t = 0; t < 4; ++t)
#pragma unroll
            for (int kx = 0; kx < 3; ++kx)
#pragma unroll
                for (int c = 0; c < 4; ++c) acc[t][c] += w[kx][c] * in[t + kx][c];
    }
#pragma unroll
    for (int t = 0; t < 4; ++t) {
        float ss = 0.f;
#pragma unroll
        for (int c = 0; c < 4; ++c) { acc[t][c] = silu_f(acc[t][c]); ss += acc[t][c] * acc[t][c]; }
        if (slab < 8) { ss += shfl_xor_f(ss, 1); ss += shfl_xor_f(ss, 2); ss += shfl_xor_f(ss, 4); ss += shfl_xor_f(ss, 8); ss += shfl_xor_f(ss, 16); const float sc = 1.0f / sqrtf(ss + EPS);
#pragma unroll
            for (int c = 0; c < 4; ++c) acc[t][c] *= sc; }
        u32x2 o; o[0] = pk2(acc[t][0], acc[t][1]); o[1] = pk2(acc[t][2], acc[t][3]);
        *(u32x2*)(dst + (size_t)(tg * 4 + t) * 1536 + cq * 4) = o;
    }
}

DEV void phase3_conv(const Params& P, unsigned char* sm) {
    PHASE_TID;
    const bf16_t* p = (const bf16_t*)(P.ws + WS_R4 + R4_P);
    bf16_t* qkvn = (bf16_t*)(P.ws + WS_R3);
    bf16_t* ring = (bf16_t*)sm;
    float* wts = (float*)(sm + 3 * 16896);
    const u32x4 zero4 = (u32x4){0u, 0u, 0u, 0u};
    for (int it = BID; it < NB * 12 * 8; it += NBLK) {
        const int slab = it % 12, yb = (it / 12) & 7, b = it / 96, y0 = yb * 16;
        const bf16_t* src = p + (size_t)(b * SEQ) * 2048 + slab * 128;
        if (TID < 96) { const int sl = TID / 32, w = TID & 31, cc = (w >> 4) * 65, pc = w & 15; *(u32x4*)(ring + sl * 8448 + cc * 128 + pc * 8) = zero4; }
        if (TID < 288) *(f32x4*)(wts + TID * 4) = *(const f32x4*)(P.conv_w + (size_t)(TID >> 5) * 1536 + slab * 128 + (TID & 31) * 4);
        const int tk0 = TID >> 4, pc = TID & 15;
        u32x4 rr[4][2];
#define CV_LOAD(set, y) do { rr[set][0] = zero4; rr[set][1] = zero4; if ((y) >= 0 && (y) < 128) { \
            rr[set][0] = *(const u32x4*)(src + (size_t)((y) * 64 + tk0) * 2048 + pc * 8); rr[set][1] = *(const u32x4*)(src + (size_t)((y) * 64 + tk0 + 32) * 2048 + pc * 8); } } while (0)
#define CV_STORE(set, slot) do { *(u32x4*)(ring + (slot) * 8448 + (tk0 + 1) * 128 + pc * 8) = rr[set][0]; *(u32x4*)(ring + (slot) * 8448 + (tk0 + 33) * 128 + pc * 8) = rr[set][1]; } while (0)
        CV_LOAD(0, y0 - 1); CV_LOAD(1, y0); CV_LOAD(2, y0 + 1); CV_LOAD(3, y0 + 2);
        CV_STORE(0, 0); CV_STORE(1, 1);
        CV_LOAD(0, y0 + 3);
#pragma unroll 1
        for (int y4 = 0; y4 < 16; y4 += 4) {
#pragma unroll
            for (int u = 0; u < 4; ++u) {
                const int yy = y4 + u;
                const int s0 = yy % 3, s1 = (yy + 1) % 3, s2 = (yy + 2) % 3;
                CV_STORE((u + 2) & 3, s2);
                SYNC();
                if (yy + 4 <= 16) CV_LOAD((u + 1) & 3, y0 + yy + 4);
                conv_row_compute(P, ring, wts, s0, s1, s2, 3, slab, qkvn + (size_t)(b * SEQ + (y0 + yy) * 64) * 1536 + slab * 128, TID);
                SYNC();
            }
        }
#undef CV_LOAD
#undef CV_STORE
    }
    for (int it = BID; it < NB * 12 * 4; it += NBLK) {
        const int slab = it % 12, sg = (it / 12) & 3, b = it / 48;
        const bf16_t* src = p + (size_t)(NTOK + b * CTX) * 2048 + slab * 128;
        if (TID < 288) *(f32x4*)(wts + TID * 4) = *(const f32x4*)(P.conv_w + (size_t)(TID >> 5) * 1536 + slab * 128 + (TID & 31) * 4);
        u32x4 r[3];
#pragma unroll
        for (int q = 0; q < 3; ++q) { const int idx = TID + q * 512; r[q] = zero4;
            if (idx < 66 * 16) { const int cc = idx >> 4, pc = idx & 15, tok = sg * 64 + cc - 1; if (tok >= 0 && tok < CTX) r[q] = *(const u32x4*)(src + (size_t)tok * 2048 + pc * 8); } }
#pragma unroll
        for (int q = 0; q < 3; ++q) { const int idx = TID + q * 512; if (idx < 66 * 16) { const int cc = idx >> 4, pc = idx & 15; *(u32x4*)(ring + 1 * 8448 + cc * 128 + pc * 8) = r[q]; } }
        SYNC();
        conv_row_compute(P, ring, wts, 0, 1, 2, 1, slab, qkvn + (size_t)(NTOK + b * CTX + sg * 64) * 1536 + slab * 128, TID);
        SYNC();
    }
}

constexpr int PP_MB0 = IMG_BYTES, PP_MB1 = PP_MB0 + 9216, PP_MB2 = PP_MB1 + 9216, PP_MB3 = PP_MB2 + 9216, PP_GC = PP_MB3 + 9216;

DEV int chunk_row(int chain, int step, int i) {
    const int b = chain >> 3, dir = chain & 1;
    if (step < 4) { const int pos = step * 64 + i; return NTOK + b * CTX + (dir ? (CTX - 1 - pos) : pos); }
    const int pos = (step - 4) * 64 + i; return b * SEQ + (dir ? (SEQ - 1 - pos) : pos);
}

DEV void phase4_prepass(const Params& P, unsigned char* sm) {
    PHASE_TID;
    const bf16_t* qkvn = (const bf16_t*)(P.ws + WS_R3);
    const float* gb = (const float*)(P.ws + WS_GB);
    unsigned char* images = P.ws + WS_R4;
    bf16_t* Ks = (bf16_t*)(sm + IMG_W); bf16_t* KT = (bf16_t*)(sm + IMG_KT); bf16_t* Qs = (bf16_t*)(sm + IMG_Q); bf16_t* Am = (bf16_t*)(sm + IMG_A); bf16_t* Vs = (bf16_t*)(sm + IMG_U);
    bf16_t* MB0 = (bf16_t*)(sm + PP_MB0); bf16_t* MB1 = (bf16_t*)(sm + PP_MB1); bf16_t* MB2 = (bf16_t*)(sm + PP_MB2); bf16_t* MB3 = (bf16_t*)(sm + PP_MB3);
    float* gcs = (float*)(sm + PP_GC); float* bts = gcs + 64;
    const int wid = TID >> 6, lane = TID & 63, fr = lane & 15, fq = lane >> 4;
    const float QSCALE = 0.08838834764831845f;
    for (int pid = BID; pid < NPROB; pid += NBLK) {
        const int chain = pid / NSTEP, step = pid - chain * NSTEP, hh = (chain >> 1) & 3, dir = chain & 1;
        for (int q = TID; q < 3 * 64 * 16; q += 512) {
            const int piece = q & 15, i = (q >> 4) & 63, which = q >> 10;
            const int row = chunk_row(chain, step, i);
            const u32x4 v = *(const u32x4*)(qkvn + (size_t)row * 1536 + which * 512 + hh * 128 + piece * 8);
            bf16_t* dst = (which == 0 ? Qs : which == 1 ? Ks : Vs) + i * 136 + piece * 8;
            *(u32x4*)dst = v;
        }
        if (wid == 0) {
            const int row = chunk_row(chain, step, lane);
            float g = gb[(size_t)row * 16 + 8 + dir * 4 + hh]; const float bt = gb[(size_t)row * 16 + dir * 4 + hh];
#pragma unroll
            for (int o = 1; o < 64; o <<= 1) { const float t = shfl_up_f(g, o); if (lane >= o) g += t; }
            gcs[lane] = g; bts[lane] = bt;
        }
        SYNC();
        f32x4 Treg[2];
#pragma unroll
        for (int tt = 0; tt < 2; ++tt) {
            const int t = wid * 2 + tt, ti = t >> 2, tj = t & 3;
            f32x4 kk = (f32x4){0.f, 0.f, 0.f, 0.f}, qk = (f32x4){0.f, 0.f, 0.f, 0.f};
#pragma unroll
            for (int ks = 0; ks < 4; ++ks) {
                const bf16x8 bk = frag16(Ks + (tj * 16 + fr) * 136 + ks * 32 + fq * 8);
                const bf16x8 ak = frag16(Ks + (ti * 16 + fr) * 136 + ks * 32 + fq * 8);
                const bf16x8 aq = frag16(Qs + (ti * 16 + fr) * 136 + ks * 32 + fq * 8);
                kk = mfma16(ak, bk, kk); qk = mfma16(aq, bk, qk);
            }
            const int j = tj * 16 + fr; const float gcj = gcs[j];
#pragma unroll
            for (int r = 0; r < 4; ++r) {
                const int i = ti * 16 + fq * 4 + r; const float gci = gcs[i];
                const float dec = (i >= j) ? __expf(gci - gcj) : 0.f;
                const float mv = (i > j) ? bts[i] * kk[r] * dec : 0.f;
                MB0[i * 72 + j] = f2bf(mv);
                Treg[tt][r] = (i == j ? 1.0f : 0.0f) - mv;
                Am[i * 72 + j] = f2bf(qk[r] * QSCALE * dec);
            }
        }
        SYNC();
        {
            const bf16_t* Pc = MB0;
#pragma unroll 1
            for (int s = 0; s < 5; ++s) {
                bf16_t* Pn = (s & 1) ? MB2 : MB1;
#pragma unroll
                for (int tt = 0; tt < 2; ++tt) {
                    const int t = wid * 2 + tt, ti = t >> 2, tj = t & 3;
#pragma unroll
                    for (int r = 0; r < 4; ++r) MB3[(ti * 16 + fq * 4 + r) * 72 + tj * 16 + fr] = f2bf(Treg[tt][r]);
                    f32x4 a = (f32x4){0.f, 0.f, 0.f, 0.f};
#pragma unroll
                    for (int ks = 0; ks < 2; ++ks) a = mfma16(frag16(Pc + (ti * 16 + fr) * 72 + ks * 32 + fq * 8), frag_gather(Pc + (ks * 32 + fq * 8) * 72 + tj * 16 + fr, 72), a);
#pragma unroll
                    for (int r = 0; r < 4; ++r) Pn[(ti * 16 + fq * 4 + r) * 72 + tj * 16 + fr] = f2bf(a[r]);
                }
                SYNC();
#pragma unroll
                for (int tt = 0; tt < 2; ++tt) {
                    const int t = wid * 2 + tt, ti = t >> 2, tj = t & 3;
#pragma unroll
                    for (int ks = 0; ks < 2; ++ks) Treg[tt] = mfma16(frag16(MB3 + (ti * 16 + fr) * 72 + ks * 32 + fq * 8), frag_gather(Pn + (ks * 32 + fq * 8) * 72 + tj * 16 + fr, 72), Treg[tt]);
                }
                SYNC();
                Pc = Pn;
            }
        }
        {
            const float gl = gcs[63];
#pragma unroll
            for (int tt = 0; tt < 2; ++tt) {
                const int t = wid * 2 + tt, ti = t >> 2, tj = t & 3, j = tj * 16 + fr; const float bj = bts[j], ej = __expf(gcs[j]);
#pragma unroll
                for (int r = 0; r < 4; ++r) { const int i = ti * 16 + fq * 4 + r; MB0[i * 72 + j] = f2bf(Treg[tt][r] * bj); MB3[i * 72 + j] = f2bf(Treg[tt][r] * bj * ej); }
            }
            const int tok = TID & 63, dg = TID >> 6;
            const float kscale = __expf(gl - gcs[tok]), qscale = QSCALE * __expf(gcs[tok]);
#pragma unroll
            for (int jj = 0; jj < 16; ++jj) { const int d = dg * 16 + jj; KT[d * 72 + tok] = f2bf(bf2f(Ks[tok * 136 + d]) * kscale); Qs[tok * 136 + d] = f2bf(bf2f(Qs[tok * 136 + d]) * qscale); }
            if (TID == 0) { float* scp = (float*)(sm + IMG_SC); scp[0] = __expf(gl); }
        }
        SYNC();
        f32x4 ua[4], wa[4];
#pragma unroll
        for (int ti = 0; ti < 4; ++ti) { ua[ti] = (f32x4){0.f, 0.f, 0.f, 0.f}; wa[ti] = (f32x4){0.f, 0.f, 0.f, 0.f}; }
#pragma unroll
        for (int ks = 0; ks < 2; ++ks) {
            const bf16x8 bv = frag_gather(Vs + (ks * 32 + fq * 8) * 136 + wid * 16 + fr, 136), bk = frag_gather(Ks + (ks * 32 + fq * 8) * 136 + wid * 16 + fr, 136);
#pragma unroll
            for (int ti = 0; ti < 4; ++ti) { ua[ti] = mfma16(frag16(MB0 + (ti * 16 + fr) * 72 + ks * 32 + fq * 8), bv, ua[ti]); wa[ti] = mfma16(frag16(MB3 + (ti * 16 + fr) * 72 + ks * 32 + fq * 8), bk, wa[ti]); }
        }
        SYNC();
#pragma unroll
        for (int ti = 0; ti < 4; ++ti)
#pragma unroll
            for (int r = 0; r < 4; ++r) { const int i = ti * 16 + fq * 4 + r; Vs[i * 136 + wid * 16 + fr] = f2bf(ua[ti][r]); Ks[i * 136 + wid * 16 + fr] = f2bf(wa[ti][r]); }
        SYNC();
        { u32x4* dst = (u32x4*)(images + (size_t)pid * IMG_BYTES); const u32x4* src = (const u32x4*)sm;
          for (int q = TID; q < IMG_BYTES / 16; q += 512) dst[q] = src[q]; }
        SYNC();
    }
}

DEV void phase4_fft(const Params& P, unsigned char* sm) {
    PHASE_TID;
    const bf16_t* GT = (const bf16_t*)((const unsigned char*)P.out + DO_GT);
    bf16_t* ZT = (bf16_t*)((unsigned char*)P.out + DO_ZT);
    const bf16_t* tab = (const bf16_t*)(P.ws + WS_TAB);
    bf16_t* YR = (bf16_t*)sm; bf16_t* YI = YR + 64 * 136;
    const int wid = TID >> 6, lane = TID & 63, fr = lane & 15, fq = lane >> 4;
    bf16x8 c64[4][2], s64[4][2], c128[4], s128[4];
#pragma unroll
    for (int nt = 0; nt < 4; ++nt)
#pragma unroll
        for (int ks = 0; ks < 2; ++ks) { c64[nt][ks] = frag16(tab + (nt * 16 + fr) * 64 + ks * 32 + fq * 8); s64[nt][ks] = frag16(tab + 4096 + (nt * 16 + fr) * 64 + ks * 32 + fq * 8); }
#pragma unroll
    for (int ks = 0; ks < 4; ++ks) { c128[ks] = frag16(tab + 8192 + (wid * 16 + fr) * 128 + ks * 32 + fq * 8); s128[ks] = frag16(tab + 8192 + 16384 + (wid * 16 + fr) * 128 + ks * 32 + fq * 8); }
    for (int it = BID; it < 512 * NB; it += NBLK) {
        const int cp = it >> 3, b = it & 7;
        const bf16_t* gr = GT + (size_t)cp * NTOK + b * SEQ; const bf16_t* gi = GT + (size_t)(512 + cp) * NTOK + b * SEQ;
        bf16x8 ar[2], ai[2], an[2];
#pragma unroll
        for (int ks = 0; ks < 2; ++ks) { ar[ks] = frag16(gr + (wid * 16 + fr) * 64 + ks * 32 + fq * 8); ai[ks] = frag16(gi + (wid * 16 + fr) * 64 + ks * 32 + fq * 8);
#pragma unroll
            for (int j = 0; j < 8; ++j) an[ks][j] = (short)(ar[ks][j] ^ (short)0x8000); }
#pragma unroll
        for (int nt = 0; nt < 4; ++nt) {
            f32x4 yr = (f32x4){0.f, 0.f, 0.f, 0.f}, yi = (f32x4){0.f, 0.f, 0.f, 0.f};
#pragma unroll
            for (int ks = 0; ks < 2; ++ks) { yr = mfma16(ar[ks], c64[nt][ks], yr); yr = mfma16(ai[ks], s64[nt][ks], yr); yi = mfma16(ai[ks], c64[nt][ks], yi); yi = mfma16(an[ks], s64[nt][ks], yi); }
            const int k1 = nt * 16 + fr; float orr[4], oii[4];
#pragma unroll
            for (int r = 0; r < 4; ++r) { const int n2 = wid * 16 + fq * 4 + r; float s, c; sincospi_f((float)(n2 * k1) * (2.0f / 8192.0f), &s, &c);
                orr[r] = yr[r] * c + yi[r] * s; oii[r] = yi[r] * c - yr[r] * s; }
            u32x2 w; w[0] = pk2(orr[0], orr[1]); w[1] = pk2(orr[2], orr[3]); *(u32x2*)(YR + k1 * 136 + wid * 16 + fq * 4) = w;
            w[0] = pk2(oii[0], oii[1]); w[1] = pk2(oii[2], oii[3]); *(u32x2*)(YI + k1 * 136 + wid * 16 + fq * 4) = w;
        }
        SYNC();
        bf16_t* zrow = ZT + (size_t)cp * NTOK + b * SEQ;
#pragma unroll
        for (int mt = 0; mt < 4; ++mt) {
            f32x4 z = (f32x4){0.f, 0.f, 0.f, 0.f};
#pragma unroll
            for (int ks = 0; ks < 4; ++ks) { z = mfma16(frag16(YR + (mt * 16 + fr) * 136 + ks * 32 + fq * 8), c128[ks], z); z = mfma16(frag16(YI + (mt * 16 + fr) * 136 + ks * 32 + fq * 8), s128[ks], z); }
            u32x2 w; w[0] = pk2(z[0], z[1]); w[1] = pk2(z[2], z[3]);
            *(u32x2*)(zrow + 64 * (wid * 16 + fr) + mt * 16 + fq * 4) = w;
        }
        SYNC();
    }
}

constexpr int SC_W = 0, SC_U = 17408, SC_KT = 22528, SC_Q = SC_KT + 18432, SC_A = SC_Q + 17408, SC_ST = SC_A + 9216, SC_VN = SC_ST + 2 * 8704, SC_END = SC_VN + 4608;

DEV void phase5_scan(const Params& P, unsigned char* sm) {
    PHASE_TID;
    const unsigned char* images = P.ws + WS_R4;
    bf16_t* obuf = (bf16_t*)(P.ws + WS_R3);
    const int wid = TID >> 6, lane = TID & 63, fr = lane & 15, fq = lane >> 4;
    bf16_t* Wm = (bf16_t*)(sm + SC_W); bf16_t* Us = (bf16_t*)(sm + SC_U); bf16_t* KT = (bf16_t*)(sm + SC_KT); bf16_t* Qg = (bf16_t*)(sm + SC_Q); bf16_t* Am = (bf16_t*)(sm + SC_A);
    bf16_t* ST = (bf16_t*)(sm + SC_ST); bf16_t* VN = (bf16_t*)(sm + SC_VN);
    for (int item = BID; item < NCHAIN * 4; item += NBLK) {
        const int xj = item >> 3, chain = (item & 7) * 8 + (xj >> 2), c0 = (xj & 3) * 32, b = chain >> 3, hh = (chain >> 1) & 3, dir = chain & 1;
        const unsigned char* blk0 = images + (size_t)chain * NSTEP * IMG_BYTES;
        u32x4 xr[3][3], yr[3][6];
        int xso[3], xdo[3];
#pragma unroll
        for (int q = 0; q < 3; ++q) { const int pc = TID + q * 512;
            xso[q] = pc < 1088 ? pc * 16 : (IMG_U + ((pc - 1088) >> 2) * 272 + c0 * 2 + ((pc - 1088) & 3) * 16);
            xdo[q] = pc < 1088 ? (SC_W + pc * 16) : (SC_U + ((pc - 1088) >> 2) * 80 + ((pc - 1088) & 3) * 16); }
#define SC_LOADX(set, blk) do { _Pragma("unroll") for (int q = 0; q < 3; ++q) if (TID + q * 512 < 1344) xr[set][q] = *(const u32x4*)((blk) + xso[q]); } while (0)
#define SC_STOREX(set) do { _Pragma("unroll") for (int q = 0; q < 3; ++q) if (TID + q * 512 < 1344) *(u32x4*)(sm + xdo[q]) = xr[set][q]; } while (0)
#define SC_LOADY(set, blk) do { _Pragma("unroll") for (int q = 0; q < 6; ++q) if (TID + q * 512 < 2816) yr[set][q] = *(const u32x4*)((blk) + IMG_KT + (TID + q * 512) * 16); } while (0)
#define SC_STOREY(set) do { _Pragma("unroll") for (int q = 0; q < 6; ++q) if (TID + q * 512 < 2816) *(u32x4*)(sm + SC_KT + (TID + q * 512) * 16) = yr[set][q]; } while (0)
        f32x4 Sacc[2];
        Sacc[0] = (f32x4){0.f, 0.f, 0.f, 0.f}; Sacc[1] = (f32x4){0.f, 0.f, 0.f, 0.f};
        for (int q = TID; q < 2 * 8704 / 4; q += 512) ((unsigned*)ST)[q] = 0u;
        SC_LOADX(0, blk0); SC_LOADY(0, blk0);
        SC_LOADX(1, blk0 + IMG_BYTES); SC_LOADY(1, blk0 + IMG_BYTES);
        SC_LOADX(2, blk0 + 2 * IMG_BYTES); SC_LOADY(2, blk0 + 2 * IMG_BYTES);
        SC_STOREX(0);
        SYNC();
        const int mt = wid >> 1, nt = wid & 1;
#pragma unroll 1
        for (int s3 = 0; s3 < NSTEP; s3 += 3) {
#pragma unroll
            for (int u = 0; u < 3; ++u) {
                const int step = s3 + u, cur = step & 1;
                const unsigned char* blk = blk0 + (size_t)step * IMG_BYTES;
                const bf16_t* STc = ST + cur * 4352; bf16_t* STn = ST + (cur ^ 1) * 4352;
                SC_STOREY(u);
                if (step + 3 < NSTEP) SC_LOADX(u, blk + 3 * IMG_BYTES);
                const float dl = *(const float*)(blk + IMG_SC);
                f32x4 vn = (f32x4){0.f, 0.f, 0.f, 0.f};
#pragma unroll
                for (int ks = 0; ks < 4; ++ks) vn = mfma16(frag16(Wm + (mt * 16 + fr) * 136 + ks * 32 + fq * 8), frag16(STc + (nt * 16 + fr) * 136 + ks * 32 + fq * 8), vn);
                { float v4[4];
#pragma unroll
                  for (int r = 0; r < 4; ++r) v4[r] = bf2f(Us[(mt * 16 + fq * 4 + r) * 40 + nt * 16 + fr]) - vn[r];
                  u32x2 w; w[0] = pk2(v4[0], v4[1]); w[1] = pk2(v4[2], v4[3]); *(u32x2*)(VN + (nt * 16 + fr) * 72 + mt * 16 + fq * 4) = w; }
                SYNC();
                SC_STOREX((u + 1) % 3);
                if (step + 3 < NSTEP) SC_LOADY(u, blk + 3 * IMG_BYTES);
#pragma unroll
                for (int tt = 0; tt < 2; ++tt) {
                    const int t2 = wid * 2 + tt, dt = t2 >> 1, n2 = t2 & 1;
                    f32x4 a = Sacc[tt] * dl;
#pragma unroll
                    for (int ks = 0; ks < 2; ++ks) a = mfma16(frag16(KT + (dt * 16 + fr) * 72 + ks * 32 + fq * 8), frag16(VN + (n2 * 16 + fr) * 72 + ks * 32 + fq * 8), a);
                    Sacc[tt] = a;
                    u32x2 w; w[0] = pk2(a[0], a[1]); w[1] = pk2(a[2], a[3]); *(u32x2*)(STn + (n2 * 16 + fr) * 136 + dt * 16 + fq * 4) = w;
                }
                if (step >= 4) {
                    f32x4 o = (f32x4){0.f, 0.f, 0.f, 0.f};
#pragma unroll
                    for (int ks = 0; ks < 4; ++ks) o = mfma16(frag16(Qg + (mt * 16 + fr) * 136 + ks * 32 + fq * 8), frag16(STc + (nt * 16 + fr) * 136 + ks * 32 + fq * 8), o);
#pragma unroll
                    for (int ks = 0; ks < 2; ++ks) o = mfma16(frag16(Am + (mt * 16 + fr) * 72 + ks * 32 + fq * 8), frag16(VN + (nt * 16 + fr) * 72 + ks * 32 + fq * 8), o);
#pragma unroll
                    for (int r = 0; r < 4; ++r) { const int pos = (step - 4) * 64 + mt * 16 + fq * 4 + r; const int tok = b * SEQ + (dir ? (SEQ - 1 - pos) : pos);
                        obuf[((size_t)dir * NTOK + tok) * 512 + hh * 128 + c0 + nt * 16 + fr] = f2bf(o[r]); }
                }
                SYNC();
            }
        }
        SYNC();
    }
#undef SC_LOADX
#undef SC_STOREX
#undef SC_LOADY
#undef SC_STOREY
}

DEV void phase6_amix(const Params& P, unsigned char* sm) {
    PHASE_TID;
    const bf16_t* ZT = (const bf16_t*)((const unsigned char*)P.out + DO_ZT);
    const bf16_t* zs = (const bf16_t*)((const unsigned char*)P.out + DO_ZS);
    const bf16_t* obuf = (const bf16_t*)(P.ws + WS_R3);
    bf16_t* amix = (bf16_t*)(P.ws + WS_R4 + R4_AMIX);
    unsigned* tile = (unsigned*)sm;
    for (int tt = BID; tt < NTOK / 64; tt += NBLK) {
        const int tok0 = tt * 64;
        { u32x4 r[8];
#pragma unroll
          for (int q = 0; q < 8; ++q) { const int idx = TID + q * 512, cp = idx >> 3, piece = idx & 7; r[q] = *(const u32x4*)(ZT + (size_t)cp * NTOK + tok0 + piece * 8); }
#pragma unroll
          for (int q = 0; q < 8; ++q) { const int idx = TID + q * 512, cp = idx >> 3, piece = idx & 7; unsigned* t = tile + cp * 33 + piece * 4; t[0] = r[q][0]; t[1] = r[q][1]; t[2] = r[q][2]; t[3] = r[q][3]; } }
        SYNC();
        u32x4 oa[8], ob[8], oz[8];
#pragma unroll
        for (int q = 0; q < 8; ++q) { const int idx = TID + q * 512, tok = idx >> 6, hh = (idx >> 4) & 3, l16 = idx & 15; const size_t off = (size_t)(tok0 + tok) * 512 + hh * 128 + l16 * 8;
            oa[q] = *(const u32x4*)(obuf + off); ob[q] = *(const u32x4*)(obuf + (size_t)NTOK * 512 + off); oz[q] = *(const u32x4*)(zs + off); }
#pragma unroll
        for (int q = 0; q < 8; ++q) { const int tok = TID & 63, c8 = ((TID >> 6) * 8 + q) * 8, sh = (tok & 1) * 16; u32x4 o;
#pragma unroll
            for (int j = 0; j < 4; ++j) o[j] = ((tile[(c8 + 2 * j) * 33 + (tok >> 1)] >> sh) & 0xffffu) | (((tile[(c8 + 2 * j + 1) * 33 + (tok >> 1)] >> sh) & 0xffffu) << 16);
            *(u32x4*)(amix + (size_t)(tok0 + tok) * 1024 + c8) = o; }
        const int l16 = TID & 15;
        float og[8];
#pragma unroll
        for (int j = 0; j < 8; ++j) og[j] = P.onorm_g[l16 * 8 + j];
#pragma unroll
        for (int q = 0; q < 8; ++q) {
            const int idx = TID + q * 512, tok = idx >> 6, hh = (idx >> 4) & 3;
            const u32x4 a = oa[q], bq = ob[q], zv = oz[q];
            float v[8]; float ss = 0.f;
#pragma unroll
            for (int j = 0; j < 4; ++j) { v[2 * j] = bf2f((bf16_t)(a[j] & 0xffffu)) + bf2f((bf16_t)(bq[j] & 0xffffu)); v[2 * j + 1] = bf2f((bf16_t)(a[j] >> 16)) + bf2f((bf16_t)(bq[j] >> 16)); }
#pragma unroll
            for (int j = 0; j < 8; ++j) ss += v[j] * v[j];
            ss += shfl_xor_f(ss, 1); ss += shfl_xor_f(ss, 2); ss += shfl_xor_f(ss, 4); ss += shfl_xor_f(ss, 8);
            const float rstd = 1.0f / sqrtf(ss * (1.0f / 128.0f) + EPS);
            u32x4 o;
#pragma unroll
            for (int j = 0; j < 4; ++j) o[j] = pk2(v[2 * j] * rstd * og[2 * j] * bf2f((bf16_t)(zv[j] & 0xffffu)), v[2 * j + 1] * rstd * og[2 * j + 1] * bf2f((bf16_t)(zv[j] >> 16)));
            *(u32x4*)(amix + (size_t)(tok0 + tok) * 1024 + 512 + hh * 128 + l16 * 8) = o;
        }
        SYNC();
    }
}

DEV void phase8_router(const Params& P, unsigned char* sm, int dry) {
    PHASE_TID;
    float* wr = (float*)sm;
    {
        f32x4 g[2], rt[2][8];
#pragma unroll
        for (int h = 0; h < 2; ++h) { const int k = TID + h * 512; g[h] = *(const f32x4*)(P.w_group + k * 4);
#pragma unroll
            for (int q = 0; q < 8; ++q) rt[h][q] = *(const f32x4*)(P.w_router + k * 32 + q * 4); }
#pragma unroll
        for (int h = 0; h < 2; ++h) { const int k = TID + h * 512;
#pragma unroll
            for (int e = 0; e < 4; ++e) wr[e * 1028 + k] = g[h][e];
#pragma unroll
            for (int q = 0; q < 8; ++q)
#pragma unroll
                for (int e = 0; e < 4; ++e) wr[(4 + q * 4 + e) * 1028 + k] = rt[h][q][e]; }
    }
    SYNC();
    const float* mod = (const float*)(P.ws + WS_MOD);
    const float* x1 = P.out;
    bf16_t* h2 = (bf16_t*)(P.ws + WS_R4 + R4_H2);
    unsigned* cnt = (unsigned*)(P.ws + WS_CNT + (dry ? 8192 : 0)); unsigned* tokk = (unsigned*)(P.ws + (dry ? WS_R3 : WS_TOKK)); float* wl = (float*)(P.ws + (dry ? WS_R3 + 16 * MiB : WS_WL));
    const int wid = TID >> 6, lane = TID & 63;
    const int rstep = NBLK * 8;
    int r = BID * 8 + wid;
    unsigned* lc = (unsigned*)(sm + 148224);
    unsigned* aE = lc + 64; float* aW = (float*)(aE + 512); unsigned* aP = (unsigned*)(aW + 512);
    if (TID < 32) lc[TID] = 0u;
    SYNC();
    int jrow = 0;
    f32x4 vn[4], vm[4];
    if (r < NTOK) {
#pragma unroll
        for (int i = 0; i < 4; ++i) vn[i] = *(const f32x4*)(x1 + (size_t)r * D + i * 256 + lane * 4);
    }
    if (r + rstep < NTOK) {
#pragma unroll
        for (int i = 0; i < 4; ++i) vm[i] = *(const f32x4*)(x1 + (size_t)(r + rstep) * D + i * 256 + lane * 4);
    }
    for (; r < NTOK; r += rstep) {
        const float* shift = mod + (r >> 13) * 6144 + 3 * 1024, *scale = shift + 1024;
        f32x4 v[4]; float ss = 0.f;
#pragma unroll
        for (int i = 0; i < 4; ++i) { v[i] = vn[i]; vn[i] = vm[i]; ss += v[i][0] * v[i][0] + v[i][1] * v[i][1] + v[i][2] * v[i][2] + v[i][3] * v[i][3]; }
        if (r + 2 * rstep < NTOK) {
#pragma unroll
            for (int i = 0; i < 4; ++i) vm[i] = *(const f32x4*)(x1 + (size_t)(r + 2 * rstep) * D + i * 256 + lane * 4);
        }
        ss = wave_sum(ss);
        const float rstd = 1.0f / sqrtf(ss * (1.0f / 1024.0f) + EPS);
        float gl[4] = {0.f, 0.f, 0.f, 0.f};
#pragma unroll
        for (int i = 0; i < 4; ++i) {
            const int k = i * 256 + lane * 4;
            const f32x4 g2 = *(const f32x4*)(P.norm2_g + k), sc = *(const f32x4*)(scale + k), sh = *(const f32x4*)(shift + k);
#pragma unroll
            for (int e = 0; e < 4; ++e) v[i][e] = v[i][e] * rstd * g2[e] * (1.0f + sc[e]) + sh[e];
#pragma unroll
            for (int j = 0; j < 4; ++j) { const f32x4 wv = *(const f32x4*)(wr + j * 1028 + k); gl[j] += v[i][0] * wv[0] + v[i][1] * wv[1] + v[i][2] * wv[2] + v[i][3] * wv[3]; }
            u32x2 w; w[0] = pk2(v[i][0], v[i][1]); w[1] = pk2(v[i][2], v[i][3]);
            *(u32x2*)(h2 + (size_t)r * D + k) = w;
        }
#pragma unroll
        for (int j = 0; j < 4; ++j) gl[j] = wave_sum(gl[j]) + P.b_group[j];
        int gsel = 0; float gmax = gl[0];
#pragma unroll
        for (int j = 1; j < 4; ++j) if (gl[j] > gmax) { gmax = gl[j]; gsel = j; }
        float gden = 0.f;
#pragma unroll
        for (int j = 0; j < 4; ++j) gden += __expf(gl[j] - gmax);
        const float pg = 1.0f / gden;
        float el[8] = {0.f, 0.f, 0.f, 0.f, 0.f, 0.f, 0.f, 0.f};
#pragma unroll
        for (int i = 0; i < 4; ++i)
#pragma unroll
            for (int j = 0; j < 8; ++j) { const f32x4 wv = *(const f32x4*)(wr + (4 + gsel * 8 + j) * 1028 + i * 256 + lane * 4); el[j] += v[i][0] * wv[0] + v[i][1] * wv[1] + v[i][2] * wv[2] + v[i][3] * wv[3]; }
#pragma unroll
        for (int j = 0; j < 8; ++j) el[j] = wave_sum(el[j]) + P.b_router[gsel * 8 + j];
        int e1 = 0; float m1 = el[0];
#pragma unroll
        for (int j = 1; j < 8; ++j) if (el[j] > m1) { m1 = el[j]; e1 = j; }
        int e2 = -1; float m2 = -3.0e38f;
#pragma unroll
        for (int j = 0; j < 8; ++j) if (j != e1 && el[j] > m2) { m2 = el[j]; e2 = j; }
        const float p2 = __expf(m2 - m1);
        const float w1 = pg / (1.0f + p2), w2 = pg * p2 / (1.0f + p2);
        if (lane < 2) {
            const int ee = gsel * 8 + (lane == 0 ? e1 : e2); const float ww = lane == 0 ? w1 : w2;
            const unsigned pos = atomic_add_u32(&lc[ee], 1u);
            const int a = (jrow * 8 + wid) * 2 + lane;
            if (a < 512) { aE[a] = (unsigned)ee; aW[a] = ww; aP[a] = pos; }
        }
        ++jrow;
    }
    SYNC();
    if (TID < 32) lc[32 + TID] = atomic_add_u32(&cnt[TID * 64], lc[TID]);
    SYNC();
    { const int a = TID, rl = a >> 1, rr = BID * 8 + (rl & 7) + (rl >> 3) * rstep;
      if (rr < NTOK && (rl >> 3) < jrow) { const unsigned ee = aE[a]; const unsigned pos = lc[32 + ee] + aP[a];
          tokk[(size_t)ee * LCAP + pos] = (unsigned)rr * 2u + (unsigned)(a & 1); wl[(size_t)ee * LCAP + pos] = aW[a]; } }
}

DEV void phase11_final(const Params& P, unsigned char* sm, float* dstbase) {
    PHASE_TID;
    (void)sm;
    const float* mod = (const float*)(P.ws + WS_MOD);
    const bf16_t* Y = (const bf16_t*)(P.ws + WS_R4 + R4_Y);
    const int wid = TID >> 6, lane = TID & 63;
    for (int r0 = (BID * 8 + wid) * 2; r0 < NTOK; r0 += NBLK * 16) {
        f32x4 xv[2][4]; u32x2 y0[2][4], y1[2][4];
#pragma unroll
        for (int u = 0; u < 2; ++u)
#pragma unroll
            for (int i = 0; i < 4; ++i) { const int k = i * 256 + lane * 4; const size_t r = (size_t)(r0 + u);
                xv[u][i] = *(const f32x4*)(P.out + r * D + k); y0[u][i] = *(const u32x2*)(Y + r * D + k); y1[u][i] = *(const u32x2*)(Y + ((size_t)NTOK + r) * D + k); }
        const float* gate = mod + (r0 >> 13) * 6144 + 5 * 1024;
#pragma unroll
        for (int u = 0; u < 2; ++u) {
            float* row = dstbase + (size_t)(r0 + u) * D;
            f32x4 v[4]; float ss = 0.f;
#pragma unroll
            for (int i = 0; i < 4; ++i) { const int k = i * 256 + lane * 4; const f32x4 gv = *(const f32x4*)(gate + k);
                f32x4 m; m[0] = bf2f((bf16_t)(y0[u][i][0] & 0xffffu)) + bf2f((bf16_t)(y1[u][i][0] & 0xffffu)); m[1] = bf2f((bf16_t)(y0[u][i][0] >> 16)) + bf2f((bf16_t)(y1[u][i][0] >> 16));
                m[2] = bf2f((bf16_t)(y0[u][i][1] & 0xffffu)) + bf2f((bf16_t)(y1[u][i][1] & 0xffffu)); m[3] = bf2f((bf16_t)(y0[u][i][1] >> 16)) + bf2f((bf16_t)(y1[u][i][1] >> 16));
                v[i] = xv[u][i] + gv * m; ss += v[i][0] * v[i][0] + v[i][1] * v[i][1] + v[i][2] * v[i][2] + v[i][3] * v[i][3]; }
            ss = wave_sum(ss);
            const float rstd = 1.0f / sqrtf(ss * (1.0f / 1024.0f) + EPS);
#pragma unroll
            for (int i = 0; i < 4; ++i) { const int k = i * 256 + lane * 4; const f32x4 fg = *(const f32x4*)(P.final_g + k); *(f32x4*)(row + k) = v[i] * rstd * fg; }
        }
    }
}

#ifndef CPU_EMU
#define XB_TMO      128
#define XB_XCNT(j)  (256  + 64 * (j))
#define XB_XSUB(j)  (1280 + 64 * (j))
#define XB_XGEN(j)  (2304 + 64 * (j))
#define XB_TOP      3328
#define XB_TOPGEN   3392
#define XCD_BAR_WORDS 3456
#define XB_SPIN_CAP (1u << 22)
#define LAS __attribute__((address_space(3)))
__device__ __forceinline__ unsigned xb_ld(unsigned* p)              { return __hip_atomic_load(p, __ATOMIC_RELAXED, __HIP_MEMORY_SCOPE_AGENT); }
__device__ __forceinline__ unsigned xb_add(unsigned* p, unsigned v) { return __hip_atomic_fetch_add(p, v, __ATOMIC_RELAXED, __HIP_MEMORY_SCOPE_AGENT); }
__device__ __forceinline__ unsigned xb_xcc_id() { return (unsigned)__builtin_amdgcn_s_getreg((3 << 11) | 20) & 0xFu; }
#define XB_SPIN(cond, bar) do { unsigned _sp = 0; while (cond) { __builtin_amdgcn_s_sleep(1); \
    if ((++_sp & 255u) == 0u) { if (xb_ld(&(bar)[XB_TMO])) break; if (_sp > XB_SPIN_CAP) { atomicAdd(&(bar)[XB_TMO], 1u); break; } } } } while (0)
struct XcdBarrier { unsigned* bar; unsigned x; volatile LAS unsigned* st; };
__device__ __forceinline__ XcdBarrier xcd_barrier_post(unsigned* bar, volatile LAS unsigned* st) {
    XcdBarrier b; b.bar = bar; b.x = xb_xcc_id(); b.st = st;
    if (threadIdx.x == 0) (void)xb_add(&bar[XB_XCNT(b.x)], 1u);
    return b;
}
__device__ __forceinline__ void xcd_barrier_complete(unsigned* bar, unsigned x, unsigned& nloc, unsigned& nx) {
    const unsigned G = gridDim.x * gridDim.y * gridDim.z;
    unsigned sum, cnt, mine, sp = 0u;
    for (;;) {
        sum = 0u; cnt = 0u; mine = 0u;
#pragma unroll
        for (unsigned j = 0; j < 16; ++j) { const unsigned c = xb_ld(&bar[XB_XCNT(j)]); sum += c; cnt += (c > 0u) ? 1u : 0u; mine = (j == x) ? c : mine; }
        if (sum == G) break;
        __builtin_amdgcn_s_sleep(1);
        if ((++sp & 255u) == 0u) { if (xb_ld(&bar[XB_TMO])) break; if (sp > XB_SPIN_CAP) { atomicAdd(&bar[XB_TMO], 1u); break; } }
    }
    nloc = mine > 0u ? mine : 1u; nx = cnt > 0u ? cnt : 1u;
}
__device__ __forceinline__ void xcd_barrier(const XcdBarrier& b) {
    asm volatile("s_waitcnt vmcnt(0)" ::: "memory");
    __syncthreads();
    if (threadIdx.x == 0) {
        unsigned* bar = b.bar;
        __builtin_amdgcn_s_waitcnt(0);
        unsigned nloc = b.st[0], nx = b.st[1];
        if (nloc == 0u) { xcd_barrier_complete(bar, b.x, nloc, nx); b.st[0] = nloc; b.st[1] = nx; }
        const unsigned old = xb_add(&bar[XB_XSUB(b.x)], 1u);
        const unsigned gen = old / nloc;
        if (old + 1u == (gen + 1u) * nloc) {
            __builtin_amdgcn_fence(__ATOMIC_RELEASE, "agent");
            asm volatile("s_waitcnt vmcnt(0)" ::: "memory");
            const unsigned og = xb_add(&bar[XB_TOP], 1u);
            const unsigned tg = og / nx;
            if (og + 1u == (tg + 1u) * nx) xb_add(&bar[XB_TOPGEN], 1u);
            else XB_SPIN(xb_ld(&bar[XB_TOPGEN]) == tg, bar);
            __builtin_amdgcn_fence(__ATOMIC_ACQUIRE, "agent");
            xb_add(&bar[XB_XGEN(b.x)], 1u);
            asm volatile("s_waitcnt vmcnt(0)" ::: "memory");
        } else {
            XB_SPIN(xb_ld(&bar[XB_XGEN(b.x)]) == gen, bar);
            __builtin_amdgcn_fence(__ATOMIC_ACQUIRE, "agent");
            asm volatile("s_waitcnt vmcnt(0)" ::: "memory");
        }
    }
    __syncthreads();
}

#ifndef MK_PH
#define MK_PH 0x7ff
#endif
#ifndef MK_REP
#define MK_REP 0
#endif
#define REPS(k) for (int rep_ = 0; rep_ < (((MK_REP >> (k)) & 1) ? 2 : 1); ++rep_)
extern __shared__ __attribute__((aligned(16))) unsigned char smem_dyn[];

__device__ __forceinline__ void moe_tables(const Params& P, LAS int* tb, LAS int* cn) {
    const unsigned* cnt = (const unsigned*)(P.ws + WS_CNT);
    if (threadIdx.x < 32) cn[threadIdx.x] = (int)cnt[threadIdx.x * 64];
    __syncthreads();
    if (threadIdx.x == 0) { int acc = 0; for (int e = 0; e < 32; ++e) { tb[e] = acc; acc += (cn[e] + 255) >> 8; } tb[32] = acc; }
    __syncthreads();
}

__global__ void __launch_bounds__(512, 2) hymba_fwd(Params P) {
    unsigned char* sm = smem_dyn;
    LAS unsigned char* lsm = (LAS unsigned char*)smem_dyn;
    volatile LAS unsigned* xbw = (volatile LAS unsigned*)(lsm + LDS_BYTES - 16);
    if (threadIdx.x == 0) { xbw[0] = 0u; xbw[1] = 0u; xbw[2] = 0u; xbw[3] = 0u; }
    __syncthreads();
    XcdBarrier bar = xcd_barrier_post((unsigned*)(P.ws + WS_BAR), xbw);
    using namespace pg8;

#if (MK_PH >> 0) & 1
    REPS(15) phase0_mod(P, sm); REPS(0) { phase0_weights(P, sm); phase0_wf(P, sm); }
    xcd_barrier(bar);
#endif
#if (MK_PH >> 1) & 1
    REPS(1) phase1_prep(P, sm);
    xcd_barrier(bar);
#endif
#if (MK_PH >> 2) & 1
    REPS(2) {
    { ProbInproj G; G.init(MROWS / 256, 8, gridDim.x, blockIdx.x); G.A = (const bf16_t*)(P.ws + WS_R4 + R4_H); G.Bt = (const bf16_t*)(P.ws + WS_WQKVZ); G.K = 1024;
      EpiInproj E; E.O = (bf16_t*)(P.ws + WS_R4 + R4_P); E.zs = (bf16_t*)((unsigned char*)P.out + DO_ZS); gemm_phase(lsm, G, E); }
    { ProbGT G; G.init(4, NTOK / 256, gridDim.x, blockIdx.x); G.A = (const bf16_t*)(P.ws + WS_WF); G.Bt = (const bf16_t*)(P.ws + WS_R4 + R4_H); G.K = 1024;
      EpiStoreBf16 E; E.O = (bf16_t*)((unsigned char*)P.out + DO_GT); E.ldc = NTOK; gemm_phase(lsm, G, E); }
    }
    xcd_barrier(bar);
#endif
#if (MK_PH >> 3) & 1
    REPS(3) phase3_conv(P, sm);
    xcd_barrier(bar);
#endif
#if (MK_PH >> 4) & 1
    REPS(4) phase4_prepass(P, sm);
    REPS(11) phase4_fft(P, sm);
    xcd_barrier(bar);
#endif
#if (MK_PH >> 5) & 1
    REPS(5) phase5_scan(P, sm);
    xcd_barrier(bar);
#endif
#if (MK_PH >> 6) & 1
    REPS(6) phase6_amix(P, sm);
    xcd_barrier(bar);
#endif
#if (MK_PH >> 7) & 1
    REPS(7)
    { ProbOut G; G.init(NTOK / 256, 4, gridDim.x, blockIdx.x); G.A = (const bf16_t*)(P.ws + WS_R4 + R4_AMIX); G.Bt = (const bf16_t*)(P.ws + WS_WOUT); G.K = 1024;
      EpiResid E; E.x = P.x; E.mod = (const float*)(P.ws + WS_MOD); E.out = P.out; gemm_phase(lsm, G, E); }
    xcd_barrier(bar);
#endif
#if (MK_PH >> 8) & 1
#if (MK_REP >> 13) & 1
    phase8_router(P, sm, 1);
#endif
    phase8_router(P, sm, 0);
#if (MK_REP >> 14) & 1
    xcd_barrier(bar); xcd_barrier(bar); xcd_barrier(bar); xcd_barrier(bar);
#endif
    xcd_barrier(bar);
#endif
#if (MK_PH >> 9) & 1
    LAS int* tb = (LAS int*)(lsm + STAGE_BYTES); LAS int* cn = tb + 64;
    moe_tables(P, tb, cn);
    REPS(9)
    { ProbMoe1 G; G.tb = tb; G.cnt = cn; G.G = gridDim.x; G.c = blockIdx.x; G.A = (const bf16_t*)(P.ws + WS_R4 + R4_H2); G.Bt = (const bf16_t*)(P.ws + WS_WGU); G.K = 1024; G.tokk = (const unsigned*)(P.ws + WS_TOKK);
      EpiMoe1 E; E.hid = (bf16_t*)(P.ws + WS_R4 + R4_HID); gemm_phase(lsm, G, E); }
    xcd_barrier(bar);
    REPS(10)
    { ProbMoe2 G; G.tb = tb; G.cnt = cn; G.G = gridDim.x; G.c = blockIdx.x; G.A = (const bf16_t*)(P.ws + WS_R4 + R4_HID); G.Bt = (const bf16_t*)(P.ws + WS_WD); G.K = 512;
      EpiMoe2 E; E.Y = (bf16_t*)(P.ws + WS_R4 + R4_Y); E.tokk = (const unsigned*)(P.ws + WS_TOKK); E.wl = (const float*)(P.ws + WS_WL); E.tb = tb; gemm_phase(lsm, G, E); }
    xcd_barrier(bar);
#endif
#if (MK_PH >> 10) & 1
#if (MK_REP >> 12) & 1
    phase11_final(P, sm, (float*)(P.ws + WS_R4 + 300 * MiB));
#endif
    phase11_final(P, sm, P.out);
#endif
}

extern "C" void kernel_launch(void* const* d_in, const int* in_sizes, int n_in, void* d_out, int out_size, void* d_ws, size_t ws_size, hipStream_t stream) {
    (void)in_sizes; (void)n_in; (void)out_size;
    static int grid = 0;
    if (!grid) {
        int dev = 0, cus = 0, per_cu = 0;
        hipGetDevice(&dev);
        hipDeviceGetAttribute(&cus, hipDeviceAttributeMultiprocessorCount, dev);
        hipFuncSetAttribute((const void*)hymba_fwd, hipFuncAttributeMaxDynamicSharedMemorySize, LDS_BYTES);
        hipOccupancyMaxActiveBlocksPerMultiprocessor(&per_cu, hymba_fwd, 512, LDS_BYTES);
        if (per_cu < 1) { fprintf(stderr, "occupancy query says 0 blocks per CU\n"); per_cu = 1; }
        grid = cus;
        if (ws_size < WS_NEED) fprintf(stderr, "workspace too small: %zu < %zu\n", ws_size, (size_t)WS_NEED);
    }
    Params p{};
    p.x = (const float*)d_in[0]; p.c = (const float*)d_in[1]; p.ctx = (const float*)d_in[2]; p.c_ctx = (const float*)d_in[3]; p.w_mod = (const float*)d_in[4]; p.b_mod = (const float*)d_in[5];
    p.norm1_g = (const float*)d_in[6]; p.w_in = (const float*)d_in[7]; p.conv_w = (const float*)d_in[8]; p.a_log = (const float*)d_in[9]; p.dt_bias = (const float*)d_in[10]; p.onorm_g = (const float*)d_in[11];
    p.w_out = (const float*)d_in[12]; p.norm2_g = (const float*)d_in[13]; p.w_group = (const float*)d_in[14]; p.b_group = (const float*)d_in[15]; p.w_router = (const float*)d_in[16]; p.b_router = (const float*)d_in[17];
    p.w_gate = (const float*)d_in[18]; p.w_up = (const float*)d_in[19]; p.w_down = (const float*)d_in[20]; p.final_g = (const float*)d_in[21];
    p.out = (float*)d_out; p.ws = (unsigned char*)d_ws;
    hipMemsetAsync(d_ws, 0, WS_ZERO_BYTES, stream);
    hipLaunchKernelGGL(hymba_fwd, dim3(grid), dim3(512), LDS_BYTES, stream, p);
}
#endif
```

```cpp
#ifndef CPU_EMU
#include <hip/hip_runtime.h>
#include <cstdio>
#include <cstdint>
#define DEV __device__ __forceinline__
#define TID tid_local
#define PHASE_TID int tid_local = (int)threadIdx.x; asm volatile("" : "+v"(tid_local))
#define BID ((int)blockIdx.x)
#define NBLK ((int)gridDim.x)
#define SYNC() __syncthreads()
#endif

typedef unsigned short bf16_t;
typedef short bf16x8 __attribute__((ext_vector_type(8)));
typedef float f32x4 __attribute__((ext_vector_type(4)));
typedef unsigned u32x4 __attribute__((ext_vector_type(4)));
typedef unsigned u32x2 __attribute__((ext_vector_type(2)));

constexpr int D = 1024, NB = 8, SEQ = 8192, CTX = 256;
constexpr int NTOK = NB * SEQ;
constexpr int NCTX = NB * CTX;
constexpr int MROWS = NTOK + NCTX;
constexpr int W_IN = 2576;
constexpr int NSTEP = 4 + 128;
constexpr int NCHAIN = NB * 4 * 2;
constexpr int NPROB = NCHAIN * NSTEP;
constexpr float EPS = 1e-6f;
constexpr int NEXP = 32;
constexpr int LCAP = 65536;

constexpr int IMG_W = 0, IMG_KT = 16384, IMG_Q = 32768, IMG_A = 49152, IMG_U = 57344, IMG_SC = 73728, IMG_BYTES = 73792;

constexpr size_t MiB = 1048576;
constexpr size_t WS_BAR = 0;
constexpr size_t WS_MOD = 16384;
constexpr size_t WS_CNT = 16384 + 221184;
constexpr size_t WS_ZERO_BYTES = WS_CNT + 16384;
constexpr size_t WS_TAB = 262144;
constexpr size_t WS_GB = 1 * MiB;
constexpr size_t WS_TOKK = 6 * MiB;
constexpr size_t WS_WL = 14 * MiB;
constexpr size_t WS_W = 22 * MiB;
constexpr size_t WS_WQKVZ = WS_W;
constexpr size_t WS_WF = WS_WQKVZ + 2048ull * 1024 * 2;
constexpr size_t WS_WOUT = WS_WF + 1024ull * 1024 * 2;
constexpr size_t WS_WGU = WS_WOUT + 1024ull * 1024 * 2;
constexpr size_t WS_WD = WS_WGU + 32ull * 1024 * 1024 * 2;
constexpr size_t WS_R3 = 126 * MiB;
constexpr size_t WS_R4 = 324 * MiB;
constexpr size_t WS_NEED = WS_R4 + 645 * MiB;
constexpr size_t R4_H = 0, R4_P = 132 * MiB;
constexpr size_t R4_AMIX = 0, R4_H2 = 128 * MiB, R4_HID = 256 * MiB, R4_Y = 0;
constexpr size_t DO_GT = 0, DO_ZT = 128 * MiB, DO_ZS = 192 * MiB;

constexpr int LDS_BYTES = 163840;

struct Params {
    const float *x, *c, *ctx, *c_ctx, *w_mod, *b_mod, *norm1_g, *w_in, *conv_w, *a_log, *dt_bias, *onorm_g, *w_out, *norm2_g,
                *w_group, *b_group, *w_router, *b_router, *w_gate, *w_up, *w_down, *final_g;
    float* out;
    unsigned char* ws;
};

DEV bf16_t f2bf(float f) { unsigned u = __builtin_bit_cast(unsigned, f); u += 0x7FFFu + ((u >> 16) & 1u); return (bf16_t)(u >> 16); }
DEV float bf2f(bf16_t b) { return __builtin_bit_cast(float, ((unsigned)b) << 16); }
#ifndef CPU_EMU
typedef __bf16 bf16n2 __attribute__((ext_vector_type(2)));
DEV unsigned pk2(float lo, float hi) { bf16n2 v; v[0] = (__bf16)lo; v[1] = (__bf16)hi; return __builtin_bit_cast(unsigned, v); }
DEV float rcp_f(float x) { return __builtin_amdgcn_rcpf(x); }
DEV float rsq_f(float x) { return __builtin_amdgcn_rsqf(x); }
#else
DEV unsigned pk2(float lo, float hi) { return (unsigned)f2bf(lo) | ((unsigned)f2bf(hi) << 16); }
DEV float rcp_f(float x) { return 1.0f / x; }
DEV float rsq_f(float x) { return 1.0f / sqrtf(x); }
#endif
DEV float silu_f(float v) { return v * rcp_f(1.0f + __expf(-v)); }

#ifndef CPU_EMU
DEV f32x4 mfma16(bf16x8 a, bf16x8 b, f32x4 c) { return __builtin_amdgcn_mfma_f32_16x16x32_bf16(a, b, c, 0, 0, 0); }
DEV float shfl_xor_f(float v, int m) { return __shfl_xor(v, m); }
DEV float shfl_up_f(float v, int d) { return __shfl_up(v, d); }
DEV void atomic_add_f32(float* p, float v) { atomicAdd(p, v); }
DEV unsigned atomic_add_u32(unsigned* p, unsigned v) { return atomicAdd(p, v); }
DEV void sincospi_f(float x, float* s, float* c) { sincospif(x, s, c); }
#endif

DEV float wave_sum(float v) {
#pragma unroll
    for (int o = 32; o >= 1; o >>= 1) v += shfl_xor_f(v, o);
    return v;
}
template <int N> DEV float wave_sum_multi(const float (&v)[N], int lane) {
    float a[N];
#pragma unroll
    for (int i = 0; i < N; ++i) a[i] = v[i];
    int m = 1;
#pragma unroll
    for (int n = N; n > 1; n >>= 1, m <<= 1) {
        const bool up = (lane & m) != 0;
#pragma unroll
        for (int i = 0; i < n / 2; ++i) { const float keep = up ? a[2 * i + 1] : a[2 * i], send = up ? a[2 * i] : a[2 * i + 1]; a[i] = keep + shfl_xor_f(send, m); }
    }
    float r = a[0];
#pragma unroll
    for (int o = N; o < 64; o <<= 1) r += shfl_xor_f(r, o);
    return r;
}
#ifndef CPU_EMU
DEV float lane_bcast(float v, int l) { return __builtin_bit_cast(float, __builtin_amdgcn_readlane(__builtin_bit_cast(int, v), l)); }
#endif
DEV bf16x8 frag_gather(const bf16_t* p, int stride) {
    bf16x8 r;
#pragma unroll
    for (int j = 0; j < 8; ++j) r[j] = (short)p[j * stride];
    return r;
}
DEV bf16x8 frag16(const bf16_t* p) { return *(const bf16x8*)p; }

DEV void phase0_mod(const Params& P, unsigned char* sm) {
    PHASE_TID;
    float* sil = (float*)sm;
    float* red = (float*)(sm + 36864);
    for (int i = TID; i < 9 * 1024; i += 512) { const int r = i >> 10, k = i & 1023; const float v = r < 8 ? P.c[r * 1024 + k] : P.c_ctx[k]; sil[i] = silu_f(v); }
    SYNC();
    float* mod = (float*)(P.ws + WS_MOD);
    for (int cb = BID; cb < 256; cb += NBLK) {
        const int c = TID % 24, kg = TID / 24, j0 = cb * 24;
        if (kg < 21) {
            float acc[9];
#pragma unroll
            for (int r = 0; r < 9; ++r) acc[r] = 0.f;
#pragma unroll 7
            for (int k = kg; k < 1024; k += 21) { const float w = P.w_mod[(size_t)k * 6144 + j0 + c];
#pragma unroll
                for (int r = 0; r < 9; ++r) acc[r] += sil[r * 1024 + k] * w; }
#pragma unroll
            for (int r = 0; r < 9; ++r) red[(kg * 24 + c) * 9 + r] = acc[r];
        }
        SYNC();
        if (TID < 24 * 9) { const int cc = TID / 9, r = TID - cc * 9; float t = P.b_mod[j0 + cc];
            for (int g = 0; g < 21; ++g) t += red[(g * 24 + cc) * 9 + r];
            mod[r * 6144 + j0 + cc] = t; }
        SYNC();
    }
}

DEV void tconv_tile(const float* src, int lds_, bf16_t* dst, int ldd, int inter, unsigned char* sm) {
    PHASE_TID;
    float* tile = (float*)sm;
    f32x4 v[8];
#pragma unroll
    for (int q = 0; q < 8; ++q) v[q] = *(const f32x4*)(src + (size_t)((TID >> 6) + q * 8) * lds_ + (TID & 63) * 4);
#pragma unroll
    for (int q = 0; q < 8; ++q) { float* t = tile + ((TID >> 6) + q * 8) * 257 + (TID & 63) * 4; t[0] = v[q][0]; t[1] = v[q][1]; t[2] = v[q][2]; t[3] = v[q][3]; }
    SYNC();
    const int c = TID & 255, half = TID >> 8;
    const int drow = inter ? ((c >> 7) * 256 + (inter - 1) * 128 + (c & 127)) : c;
    u32x4 w[4];
#pragma unroll
    for (int q = 0; q < 4; ++q)
#pragma unroll
        for (int j = 0; j < 4; ++j) w[q][j] = pk2(tile[(half * 32 + q * 8 + 2 * j) * 257 + c], tile[(half * 32 + q * 8 + 2 * j + 1) * 257 + c]);
#pragma unroll
    for (int q = 0; q < 4; ++q) *(u32x4*)(dst + (size_t)drow * ldd + half * 32 + q * 8) = w[q];
    SYNC();
}

DEV void phase0_weights(const Params& P, unsigned char* sm) {
    bf16_t* wqkvz = (bf16_t*)(P.ws + WS_WQKVZ); bf16_t* wout = (bf16_t*)(P.ws + WS_WOUT); bf16_t* wgu = (bf16_t*)(P.ws + WS_WGU); bf16_t* wd = (bf16_t*)(P.ws + WS_WD);
    const int NJ = 128 + 64 + 3 * 1024;
    for (int t = BID; t < NJ; t += NBLK) {
        if (t < 128) { const int kt = t >> 3, nt = t & 7;
            tconv_tile(P.w_in + (size_t)(kt * 64) * W_IN + 512 + nt * 256, W_IN, wqkvz + (size_t)(nt * 256) * 1024 + kt * 64, 1024, 0, sm);
        } else if (t < 192) { const int u = t - 128, kt = u >> 2, nt = u & 3;
            tconv_tile(P.w_out + (size_t)(kt * 64) * 1024 + nt * 256, 1024, wout + (size_t)(nt * 256) * 1024 + kt * 64, 1024, 0, sm);
        } else if (t < 192 + 2048) { const int u = t - 192, up = u >> 10, v = u & 1023, e = v >> 5, w = v & 31, kt = w >> 1, nt = w & 1;
            const float* src = (up ? P.w_up : P.w_gate) + (size_t)e * 1024 * 512 + (size_t)(kt * 64) * 512 + nt * 256;
            tconv_tile(src, 512, wgu + (size_t)e * 1024 * 1024 + (size_t)(nt * 512) * 1024 + kt * 64, 1024, 1 + up, sm);
        } else { const int v = t - 192 - 2048, e = v >> 5, w = v & 31, kt = w >> 2, nt = w & 3;
            tconv_tile(P.w_down + (size_t)e * 512 * 1024 + (size_t)(kt * 64) * 1024 + nt * 256, 1024, wd + (size_t)e * 1024 * 512 + (size_t)(nt * 256) * 512 + kt * 64, 512, 0, sm);
        }
    }
}

DEV void phase0_wf(const Params& P, unsigned char* sm) {
    PHASE_TID;
    float* cs = (float*)sm;
    if (TID < 128) { float s, c; sincospi_f((float)TID * (2.0f / 128.0f), &s, &c); cs[TID] = c; cs[128 + TID] = s; }
    SYNC();
    bf16_t* wf = (bf16_t*)(P.ws + WS_WF);
    const float sc = 0.08838834764831845f;
    for (int it = BID; it < 256; it += NBLK) {
        const int kb = it & 1, cb = (it >> 1) & 15, part = (it >> 5) & 1, g = it >> 6;
        const int k = kb * 512 + TID;
        const float* wrow = P.w_in + (size_t)k * W_IN + g * 128;
        float acc[8];
#pragma unroll
        for (int q = 0; q < 8; ++q) acc[q] = 0.f;
#pragma unroll 8
        for (int c4 = 0; c4 < 32; ++c4) { const f32x4 w4 = *(const f32x4*)(wrow + c4 * 4);
#pragma unroll
            for (int e = 0; e < 4; ++e) { const int c = c4 * 4 + e;
#pragma unroll
                for (int q = 0; q < 8; ++q) { const int cp = cb * 8 + q; acc[q] += w4[e] * cs[part * 128 + ((c * cp) & 127)]; } } }
#pragma unroll
        for (int q = 0; q < 8; ++q) { const int chc = part * 512 + g * 128 + cb * 8 + q; wf[(size_t)chc * 1024 + k] = f2bf((part ? -acc[q] : acc[q]) * sc); }
    }
    bf16_t* tab = (bf16_t*)(P.ws + WS_TAB);
    const float sc2 = 0.011048543456039806f;
    for (int i = BID * 512 + TID; i < 4096 + 16384; i += NBLK * 512) {
        if (i < 4096) { const int a = i >> 6, b = i & 63; float s, c; sincospi_f((float)((a * b) & 63) * (2.0f / 64.0f), &s, &c); tab[i] = f2bf(c); tab[4096 + i] = f2bf(s); }
        else { const int j = i - 4096, a = j >> 7, b = j & 127; float s, c; sincospi_f((float)((a * b) & 127) * (2.0f / 128.0f), &s, &c); tab[8192 + j] = f2bf(c * sc2); tab[8192 + 16384 + j] = f2bf(s * sc2); }
    }
}

DEV void phase1_prep(const Params& P, unsigned char* sm) {
    PHASE_TID;
    bf16_t* Bhi = (bf16_t*)sm; bf16_t* Blo = (bf16_t*)(sm + 33024);
    float* gsv = (float*)(sm + 66048); float* shv = (float*)(sm + 70144);
    {
        f32x4 w[2][4];
#pragma unroll
        for (int h = 0; h < 2; ++h)
#pragma unroll
            for (int q = 0; q < 4; ++q) w[h][q] = *(const f32x4*)(P.w_in + (size_t)(TID + h * 512) * W_IN + 2560 + q * 4);
#pragma unroll
        for (int h = 0; h < 2; ++h)
#pragma unroll
            for (int q = 0; q < 4; ++q)
#pragma unroll
                for (int e = 0; e < 4; ++e) { const int n = q * 4 + e, k = TID + h * 512; const float v = w[h][q][e]; const bf16_t hi = f2bf(v); Bhi[n * 1032 + k] = hi; Blo[n * 1032 + k] = f2bf(v - bf2f(hi)); }
    }
    const float* mod = (const float*)(P.ws + WS_MOD);
    bf16_t* h = (bf16_t*)(P.ws + WS_R4 + R4_H);
    float* gb = (float*)(P.ws + WS_GB);
    const int wid = TID >> 6, lane = TID & 63, fr = lane & 15, fq = lane >> 4;
    for (int t = BID; t < MROWS / 128; t += NBLK) {
        const int r0 = t * 128 + wid * 16, mb = (t * 128 < NTOK) ? ((t * 128) >> 13) : 8;
        SYNC();
        { const float* shift = mod + mb * 6144, *scale = shift + 1024;
#pragma unroll
          for (int q = 0; q < 2; ++q) { const int k = TID + q * 512; gsv[k] = P.norm1_g[k] * (1.0f + scale[k]); shv[k] = shift[k]; } }
        SYNC();
        const int rr = r0 + fr;
        const float* src = (rr < NTOK ? P.x + (size_t)rr * D : P.ctx + (size_t)(rr - NTOK) * D) + fq * 8;
        float ss = 0.f;
#pragma unroll 8
        for (int ks = 0; ks < 32; ++ks) { const f32x4 a0 = *(const f32x4*)(src + ks * 32), a1 = *(const f32x4*)(src + ks * 32 + 4);
            ss += a0[0] * a0[0] + a0[1] * a0[1] + a0[2] * a0[2] + a0[3] * a0[3] + a1[0] * a1[0] + a1[1] * a1[1] + a1[2] * a1[2] + a1[3] * a1[3]; }
        ss += shfl_xor_f(ss, 16); ss += shfl_xor_f(ss, 32);
        const float rstd = rsq_f(ss * (1.0f / 1024.0f) + EPS);
        f32x4 acc = (f32x4){0.f, 0.f, 0.f, 0.f};
        bf16_t* hrow = h + (size_t)rr * D + fq * 8;
#pragma unroll 4
        for (int ks = 0; ks < 32; ++ks) {
            const f32x4 a0 = *(const f32x4*)(src + ks * 32), a1 = *(const f32x4*)(src + ks * 32 + 4);
            const f32x4 g0 = *(const f32x4*)(gsv + ks * 32 + fq * 8), g1 = *(const f32x4*)(gsv + ks * 32 + fq * 8 + 4), s0 = *(const f32x4*)(shv + ks * 32 + fq * 8), s1 = *(const f32x4*)(shv + ks * 32 + fq * 8 + 4);
            float hv[8];
#pragma unroll
            for (int e = 0; e < 4; ++e) { hv[e] = a0[e] * rstd * g0[e] + s0[e]; hv[4 + e] = a1[e] * rstd * g1[e] + s1[e]; }
            u32x4 whi, wlo;
#pragma unroll
            for (int e = 0; e < 4; ++e) { const bf16_t h0 = f2bf(hv[2 * e]), h1 = f2bf(hv[2 * e + 1]); whi[e] = (unsigned)h0 | ((unsigned)h1 << 16); wlo[e] = pk2(hv[2 * e] - bf2f(h0), hv[2 * e + 1] - bf2f(h1)); }
            *(u32x4*)(hrow + ks * 32) = whi;
            const bf16x8 ahi = __builtin_bit_cast(bf16x8, whi), alo = __builtin_bit_cast(bf16x8, wlo);
            const bf16x8 bhi = frag16(Bhi + fr * 1032 + ks * 32 + fq * 8), blo = frag16(Blo + fr * 1032 + ks * 32 + fq * 8);
            acc = mfma16(ahi, bhi, acc); acc = mfma16(alo, bhi, acc); acc = mfma16(ahi, blo, acc);
        }
        float ea = 0.f, db = 0.f;
        if (fr >= 8) { ea = -__expf(P.a_log[fr - 8]); db = P.dt_bias[fr - 8]; }
#pragma unroll
        for (int reg = 0; reg < 4; ++reg) { const float v = acc[reg]; float o;
            if (fr < 8) o = rcp_f(1.0f + __expf(-v));
            else { const float z = v + db; const float sp = z > 20.f ? z : log1pf(__expf(z)); o = ea * sp; }
            gb[(size_t)(r0 + fq * 4 + reg) * 16 + fr] = o; }
    }
}

#ifndef CPU_EMU
namespace pg8 {
#define PG8_LAS __attribute__((address_space(3)))
constexpr int BM = 256, BK = 64, HALF = 128, HTB = HALF * BK * 2, STAGE_BYTES = 8 * HTB;
__device__ __forceinline__ int lds_byte(int r, int c) { const int st = (r >> 4) * 2 + (c >> 5), rr = r & 15, cc = c & 31, ob = rr * 64 + cc * 2; return st * 1024 + (ob ^ (((ob >> 9) & 1) << 5)); }
__device__ __forceinline__ void stage_rc(int b, int& R, int& C) { const int st = b / 1024, sb = b % 1024, swz = sb ^ (((sb >> 9) & 1) << 5); R = (st >> 1) * 16 + swz / 64; C = (st & 1) * 32 + (swz % 64) / 2; }
__device__ __forceinline__ int perm32(int rho) { const int n = rho >> 4, i = rho & 15; return 8 * (i >> 2) + 4 * n + (i & 3); }
struct Unit { int pm, pn, e, cnt; };
__device__ __forceinline__ unsigned cvt_pk_bf16(float lo, float hi) { unsigned r; asm volatile("v_cvt_pk_bf16_f32 %0, %1, %2" : "=v"(r) : "v"(lo), "v"(hi)); return r; }

template <class Prob, class Epi>
__device__ __forceinline__ void gemm_phase(PG8_LAS unsigned char* lds, const Prob& G, const Epi& E) {
    int tid_ = threadIdx.x; asm volatile("" : "+v"(tid_));
    const int tid = tid_, wid = __builtin_amdgcn_readfirstlane(tid >> 6), lane = tid & 63, wr = wid >> 2, wc = wid & 3, fr = lane & 15, fq = lane >> 4;
    const int K = G.K, nt = K / BK;
    int R0, C0; stage_rc(tid * 16, R0, C0);
    const int rA0 = R0, rA1 = R0 + 64;
    const int rB0 = Epi::PERM ? ((R0 & ~31) + perm32(R0 & 31)) : R0, rB1 = Epi::PERM ? (((R0 + 64) & ~31) + perm32((R0 + 64) & 31)) : R0 + 64;
    const unsigned ldsw = (unsigned)wid * 1024u;
    const int aoff = lds_byte(wr * 64 + fr, fq * 8), boff = lds_byte(wc * 32 + fr, fq * 8);
    const char* Ab = (const char*)G.A; const char* Bb = (const char*)G.Bt;
#define PG8_SA(b, h) (((b) * 2 + (h)) * HTB)
#define PG8_SB(b, h) ((4 + (b) * 2 + (h)) * HTB)
#define PG8_STAGE(bufoff, gbase, ub, l0, l1) do { \
        __builtin_amdgcn_global_load_lds((const unsigned*)((gbase) + (size_t)(ub) + (l0)), (PG8_LAS unsigned*)(lds + (bufoff) + ldsw), 16, 0, 0); \
        __builtin_amdgcn_global_load_lds((const unsigned*)((gbase) + (size_t)(ub) + (l1)), (PG8_LAS unsigned*)(lds + (bufoff) + ldsw + 8192), 16, 0, 0); } while (0)
#define PG8_LDA(dst, b, h) do { _Pragma("unroll") for (int m = 0; m < 4; ++m) _Pragma("unroll") for (int k = 0; k < 2; ++k) dst[m][k] = *(const PG8_LAS bf16x8*)(lds + PG8_SA(b, h) + aoff + m * 2048 + k * 1024); } while (0)
#define PG8_LDB(dst, b, h) do { _Pragma("unroll") for (int n = 0; n < 2; ++n) _Pragma("unroll") for (int k = 0; k < 2; ++k) dst[n][k] = *(const PG8_LAS bf16x8*)(lds + PG8_SB(b, h) + boff + n * 2048 + k * 1024); } while (0)
#define PG8_MMA(ai, bj, At, Bt) do { __builtin_amdgcn_s_setprio(1); _Pragma("unroll") for (int m = 0; m < 4; ++m) _Pragma("unroll") for (int n = 0; n < 2; ++n) _Pragma("unroll") for (int k = 0; k < 2; ++k) \
        acc[ai][bj][m][n] = __builtin_amdgcn_mfma_f32_16x16x32_bf16(Bt[n][k], At[m][k], acc[ai][bj][m][n], 0, 0, 0); __builtin_amdgcn_s_setprio(0); } while (0)
#define PG8_WAIT_V(n) asm volatile("s_waitcnt vmcnt(" #n ")" ::: "memory")
#define PG8_WAIT_L(n) asm volatile("s_waitcnt lgkmcnt(" #n ")" ::: "memory")
#define PG8_BAR __builtin_amdgcn_s_barrier()
#define PG8_SCHED __builtin_amdgcn_sched_barrier(0)
    Unit cur, nxt; int ui = 0;
    if (!G.next(0, cur)) return;
    f32x4 acc[2][2][4][2];
#pragma unroll
    for (int a = 0; a < 2; ++a)
#pragma unroll
        for (int b = 0; b < 2; ++b)
#pragma unroll
            for (int m = 0; m < 4; ++m)
#pragma unroll
                for (int n = 0; n < 2; ++n) acc[a][b][m][n] = (f32x4){0.f, 0.f, 0.f, 0.f};
    bf16x8 At[4][2], B0[2][2], B1[2][2];
    const unsigned cb2 = (unsigned)C0 * 2u;
    const unsigned lB00 = G.laneB(rB0) + cb2, lB01 = G.laneB(rB1) + cb2, lB10 = G.laneB(128 + rB0) + cb2, lB11 = G.laneB(128 + rB1) + cb2;
    const unsigned lA00 = G.laneA(rA0) + cb2, lA01 = G.laneA(rA1) + cb2, lA10 = G.laneA(128 + rA0) + cb2, lA11 = G.laneA(128 + rA1) + cb2;
    unsigned cA00 = lA00, cA01 = lA01, cA10 = lA10, cA11 = lA11, nA00 = lA00, nA01 = lA01, nA10 = lA10, nA11 = lA11;
    if constexpr (Prob::GATHER_A) { cA00 += G.gathA(cur, rA0); cA01 += G.gathA(cur, rA1); cA10 += G.gathA(cur, 128 + rA0); cA11 += G.gathA(cur, 128 + rA1); }
    unsigned uAc = G.baseA(cur), uBc = G.baseB(cur), uAn = uAc, uBn = uBc;
    PG8_STAGE(PG8_SB(0, 0), Bb, uBc, lB00, lB01); PG8_STAGE(PG8_SA(0, 0), Ab, uAc, cA00, cA01); PG8_STAGE(PG8_SB(0, 1), Bb, uBc, lB10, lB11); PG8_STAGE(PG8_SA(0, 1), Ab, uAc, cA10, cA11);
    if (wr == 1) PG8_BAR;
    PG8_WAIT_V(4); PG8_BAR;
    PG8_STAGE(PG8_SB(1, 0), Bb, uBc + 128u, lB00, lB01); PG8_STAGE(PG8_SA(1, 0), Ab, uAc + 128u, cA00, cA01); PG8_STAGE(PG8_SB(1, 1), Bb, uBc + 128u, lB10, lB11);
    PG8_WAIT_V(6); PG8_BAR;
    for (;;) {
        const bool has_next = G.next(ui + 1, nxt);
        if (has_next) {
            uAn = G.baseA(nxt); uBn = G.baseB(nxt);
            if constexpr (Prob::GATHER_A) { nA00 = lA00 + G.gathA(nxt, rA0); nA01 = lA01 + G.gathA(nxt, rA1); nA10 = lA10 + G.gathA(nxt, 128 + rA0); nA11 = lA11 + G.gathA(nxt, 128 + rA1); }
        } else { uAn = uAc; uBn = uBc; if constexpr (Prob::GATHER_A) { nA00 = cA00; nA01 = cA01; nA10 = cA10; nA11 = cA11; } }
        for (int t = 0; t < nt; t += 2) {
            const bool last = (t == nt - 2);
            const unsigned k1 = (unsigned)(t + 1) * 128u;
            const unsigned uA2 = last ? uAn : uAc + (unsigned)(t + 2) * 128u, uB2 = last ? uBn : uBc + (unsigned)(t + 2) * 128u, uA3 = uA2 + 128u, uB3 = uB2 + 128u;
            unsigned a00 = cA00, a01 = cA01, a10 = cA10, a11 = cA11;
            if constexpr (Prob::GATHER_A) { a00 = last ? nA00 : cA00; a01 = last ? nA01 : cA01; a10 = last ? nA10 : cA10; a11 = last ? nA11 : cA11; }
            PG8_LDB(B0, 0, 0); PG8_SCHED; PG8_LDA(At, 0, 0); PG8_STAGE(PG8_SA(1, 1), Ab, uAc + k1, cA10, cA11);
            PG8_WAIT_L(8); PG8_BAR; PG8_WAIT_L(0); PG8_MMA(0, 0, At, B0); PG8_BAR; PG8_SCHED;
            PG8_LDB(B1, 0, 1); PG8_STAGE(PG8_SB(0, 0), Bb, uB2, lB00, lB01);
            PG8_BAR; PG8_WAIT_L(0); PG8_MMA(0, 1, At, B1); PG8_BAR;
            PG8_LDA(At, 0, 1); PG8_STAGE(PG8_SA(0, 0), Ab, uA2, a00, a01);
            PG8_BAR; PG8_WAIT_L(0); PG8_MMA(1, 0, At, B0); PG8_BAR; PG8_SCHED;
            PG8_STAGE(PG8_SB(0, 1), Bb, uB2, lB10, lB11);
            PG8_WAIT_V(6); PG8_BAR; PG8_MMA(1, 1, At, B1); PG8_BAR;
            PG8_LDB(B0, 1, 0); PG8_SCHED; PG8_LDA(At, 1, 0); PG8_STAGE(PG8_SA(0, 1), Ab, uA2, a10, a11);
            PG8_WAIT_L(8); PG8_BAR; PG8_WAIT_L(0); PG8_MMA(0, 0, At, B0); PG8_BAR; PG8_SCHED;
            PG8_LDB(B1, 1, 1); PG8_STAGE(PG8_SB(1, 0), Bb, uB3, lB00, lB01);
            PG8_BAR; PG8_WAIT_L(0); PG8_MMA(0, 1, At, B1); PG8_BAR;
            PG8_LDA(At, 1, 1); PG8_STAGE(PG8_SA(1, 0), Ab, uA3, a00, a01);
            PG8_BAR; PG8_WAIT_L(0); PG8_MMA(1, 0, At, B0); PG8_BAR; PG8_SCHED;
            PG8_STAGE(PG8_SB(1, 1), Bb, uB3, lB10, lB11);
            PG8_WAIT_V(6); PG8_BAR; PG8_MMA(1, 1, At, B1); PG8_BAR;
        }
        E(acc, cur, wr, wc, fr, fq);
        if (!has_next) break;
#pragma unroll
        for (int a = 0; a < 2; ++a)
#pragma unroll
            for (int b = 0; b < 2; ++b)
#pragma unroll
                for (int m = 0; m < 4; ++m)
#pragma unroll
                    for (int n = 0; n < 2; ++n) acc[a][b][m][n] = (f32x4){0.f, 0.f, 0.f, 0.f};
        cur = nxt; ++ui; uAc = uAn; uBc = uBn;
        if constexpr (Prob::GATHER_A) { cA00 = nA00; cA01 = nA01; cA10 = nA10; cA11 = nA11; }
    }
    PG8_WAIT_V(0);
    if (wr == 0) PG8_BAR;
    PG8_BAR;
#undef PG8_SA
#undef PG8_SB
#undef PG8_STAGE
#undef PG8_LDA
#undef PG8_LDB
#undef PG8_MMA
#undef PG8_WAIT_V
#undef PG8_WAIT_L
#undef PG8_BAR
#undef PG8_SCHED
}

struct GridOrder {
    int nM, nN, nwg, G, c;
    __device__ __forceinline__ void init(int nM_, int nN_, int G_, int c_) { nM = nM_; nN = nN_; nwg = nM * nN; G = G_; c = c_; }
    __device__ __forceinline__ bool next(int i, Unit& u) const {
        const long L = (long)i * G + c; if (L >= nwg) return false;
        int wgid = (int)L; { const int q = nwg / 8, r = nwg % 8, xcd = wgid % 8, off = wgid / 8; wgid = (xcd < r ? xcd * (q + 1) : r * (q + 1) + (xcd - r) * q) + off; }
        const int nig = 8 * nN, gid = wgid / nig, fm = gid * 8, gsz = (nM - fm) < 8 ? (nM - fm) : 8;
        u.pm = fm + ((wgid % nig) % gsz); u.pn = (wgid % nig) / gsz; u.e = 0; u.cnt = 256; return true;
    }
};

struct ProbInproj : GridOrder { const bf16_t* A; const bf16_t* Bt; int K; static constexpr bool GATHER_A = false;
    __device__ __forceinline__ unsigned laneA(int r) const { return (unsigned)r * 2048u; }
    __device__ __forceinline__ unsigned laneB(int r) const { return (unsigned)r * 2048u; }
    __device__ __forceinline__ unsigned baseA(const Unit& u) const { return (unsigned)(u.pm * 256) * 2048u; }
    __device__ __forceinline__ unsigned baseB(const Unit& u) const { return (unsigned)(u.pn * 256) * 2048u; }
    __device__ __forceinline__ unsigned gathA(const Unit&, int) const { return 0u; } };
struct ProbGT : GridOrder { const bf16_t* A; const bf16_t* Bt; int K; static constexpr bool GATHER_A = false;
    __device__ __forceinline__ unsigned laneA(int r) const { return (unsigned)r * 2048u; }
    __device__ __forceinline__ unsigned laneB(int r) const { return (unsigned)(128 * (r & 63) + (r >> 6)) * 2048u; }
    __device__ __forceinline__ unsigned baseA(const Unit& u) const { return (unsigned)(u.pm * 256) * 2048u; }
    __device__ __forceinline__ unsigned baseB(const Unit& u) const { const int col = u.pn * 256, b = col >> 13, w = col & 8191; return (unsigned)(b * 8192 + (w >> 6)) * 2048u; }
    __device__ __forceinline__ unsigned gathA(const Unit&, int) const { return 0u; } };
struct EpiStoreBf16 {
    static constexpr bool PERM = true; bf16_t* O; int ldc;
    __device__ __forceinline__ void operator()(const f32x4 (&acc)[2][2][4][2], const Unit& u, int wr, int wc, int fr, int fq) const {
        const int row0 = u.pm * 256 + wr * 64 + fr, col0 = u.pn * 256 + wc * 32 + 8 * fq;
#pragma unroll
        for (int ai = 0; ai < 2; ++ai)
#pragma unroll
            for (int m = 0; m < 4; ++m) { bf16_t* rowp = O + (size_t)(row0 + ai * 128 + m * 16) * ldc + col0;
#pragma unroll
                for (int bj = 0; bj < 2; ++bj) { const f32x4 v0 = acc[ai][bj][m][0], v1 = acc[ai][bj][m][1];
                    u32x4 w; w.x = cvt_pk_bf16(v0[0], v0[1]); w.y = cvt_pk_bf16(v0[2], v0[3]); w.z = cvt_pk_bf16(v1[0], v1[1]); w.w = cvt_pk_bf16(v1[2], v1[3]);
                    *(u32x4*)(rowp + bj * 128) = w; } }
    }
};
struct EpiInproj {
    static constexpr bool PERM = true; bf16_t* O; bf16_t* zs;
    __device__ __forceinline__ void operator()(const f32x4 (&acc)[2][2][4][2], const Unit& u, int wr, int wc, int fr, int fq) const {
        const int row0 = u.pm * 256 + wr * 64 + fr, col0 = u.pn * 256 + wc * 32 + 8 * fq;
        const bool isz = u.pn >= 6;
        if (isz && u.pm * 256 >= NTOK) return;
#pragma unroll
        for (int ai = 0; ai < 2; ++ai)
#pragma unroll
            for (int m = 0; m < 4; ++m) { const size_t row = (size_t)(row0 + ai * 128 + m * 16);
                bf16_t* rowp = isz ? zs + row * 512 + (col0 - 1536) : O + row * 2048 + col0;
#pragma unroll
                for (int bj = 0; bj < 2; ++bj) { f32x4 v0 = acc[ai][bj][m][0], v1 = acc[ai][bj][m][1];
                    if (isz) {
#pragma unroll
                        for (int j = 0; j < 4; ++j) { v0[j] = v0[j] * __builtin_amdgcn_rcpf(1.0f + __expf(-v0[j])); v1[j] = v1[j] * __builtin_amdgcn_rcpf(1.0f + __expf(-v1[j])); } }
                    u32x4 w; w.x = cvt_pk_bf16(v0[0], v0[1]); w.y = cvt_pk_bf16(v0[2], v0[3]); w.z = cvt_pk_bf16(v1[0], v1[1]); w.w = cvt_pk_bf16(v1[2], v1[3]);
                    *(u32x4*)(rowp + bj * 128) = w; } }
    }
};
typedef ProbInproj ProbOut;
struct EpiResid {
    static constexpr bool PERM = false; const float* x; const float* mod; float* out;
    __device__ __forceinline__ void operator()(const f32x4 (&acc)[2][2][4][2], const Unit& u, int wr, int wc, int fr, int fq) const {
        const int row0 = u.pm * 256 + wr * 64 + fr, col0 = u.pn * 256 + wc * 32 + 4 * fq;
        const float* gate = mod + ((u.pm * 256) >> 13) * 6144 + 2 * 1024;
        f32x4 gv[2][2];
#pragma unroll
        for (int bj = 0; bj < 2; ++bj)
#pragma unroll
            for (int n = 0; n < 2; ++n) gv[bj][n] = *(const f32x4*)(gate + col0 + bj * 128 + n * 16);
#pragma unroll
        for (int ai = 0; ai < 2; ++ai)
#pragma unroll
            for (int m = 0; m < 4; ++m) { const size_t off = (size_t)(row0 + ai * 128 + m * 16) * 1024 + col0;
#pragma unroll
                for (int bj = 0; bj < 2; ++bj)
#pragma unroll
                    for (int n = 0; n < 2; ++n) { const f32x4 xv = *(const f32x4*)(x + off + bj * 128 + n * 16); *(f32x4*)(out + off + bj * 128 + n * 16) = xv + gv[bj][n] * acc[ai][bj][m][n]; } }
    }
};
struct MoeOrder {
    const PG8_LAS int* tb; const PG8_LAS int* cnt; int G, c;
    __device__ __forceinline__ bool next(int i, Unit& u) const {
        const int L = i * G + c, ntile = tb[32]; if (L >= ntile * 4) return false;
        const int tile = L >> 2; u.pn = L & 3; int e = 0;
#pragma unroll
        for (int s = 16; s >= 1; s >>= 1) if (__builtin_amdgcn_readfirstlane(tb[e + s]) <= tile) e += s;
        u.e = e; u.pm = tile; const int loc = (tile - __builtin_amdgcn_readfirstlane(tb[e])) * 256; u.cnt = __builtin_amdgcn_readfirstlane(cnt[e]) - loc; return true;
    }
};
struct ProbMoe1 : MoeOrder { const bf16_t* A; const bf16_t* Bt; int K; const unsigned* tokk; static constexpr bool GATHER_A = true;
    __device__ __forceinline__ unsigned laneA(int) const { return 0u; }
    __device__ __forceinline__ unsigned laneB(int r) const { return (unsigned)r * 2048u; }
    __device__ __forceinline__ unsigned baseA(const Unit&) const { return 0u; }
    __device__ __forceinline__ unsigned baseB(const Unit& u) const { return (unsigned)(u.e * 1024 + u.pn * 256) * 2048u; }
    __device__ __forceinline__ unsigned gathA(const Unit& u, int r) const { const int loc = (u.pm - __builtin_amdgcn_readfirstlane(tb[u.e])) * 256 + r; const unsigned tk = r < u.cnt ? tokk[(size_t)u.e * LCAP + loc] : 0u; return (tk >> 1) * 2048u; } };
struct EpiMoe1 {
    static constexpr bool PERM = true; bf16_t* hid;
    __device__ __forceinline__ void operator()(const f32x4 (&acc)[2][2][4][2], const Unit& u, int wr, int wc, int fr, int fq) const {
        const int row0 = u.pm * 256 + wr * 64 + fr, col0 = u.pn * 128 + wc * 32 + 8 * fq;
#pragma unroll
        for (int ai = 0; ai < 2; ++ai)
#pragma unroll
            for (int m = 0; m < 4; ++m) { float hv[8];
#pragma unroll
                for (int n = 0; n < 2; ++n)
#pragma unroll
                    for (int j = 0; j < 4; ++j) { const float g = acc[ai][0][m][n][j], up = acc[ai][1][m][n][j]; hv[n * 4 + j] = g * __builtin_amdgcn_rcpf(1.0f + __expf(-g)) * up; }
                u32x4 w; w.x = cvt_pk_bf16(hv[0], hv[1]); w.y = cvt_pk_bf16(hv[2], hv[3]); w.z = cvt_pk_bf16(hv[4], hv[5]); w.w = cvt_pk_bf16(hv[6], hv[7]);
                *(u32x4*)(hid + (size_t)(row0 + ai * 128 + m * 16) * 512 + col0) = w; }
    }
};
struct ProbMoe2 : MoeOrder { const bf16_t* A; const bf16_t* Bt; int K; static constexpr bool GATHER_A = false;
    __device__ __forceinline__ unsigned laneA(int r) const { return (unsigned)r * 1024u; }
    __device__ __forceinline__ unsigned laneB(int r) const { return (unsigned)r * 1024u; }
    __device__ __forceinline__ unsigned baseA(const Unit& u) const { return (unsigned)(u.pm * 256) * 1024u; }
    __device__ __forceinline__ unsigned baseB(const Unit& u) const { return (unsigned)(u.e * 1024 + u.pn * 256) * 1024u; }
    __device__ __forceinline__ unsigned gathA(const Unit&, int) const { return 0u; } };
struct EpiMoe2 {
    static constexpr bool PERM = true; bf16_t* Y; const unsigned* tokk; const float* wl; const PG8_LAS int* tb;
    __device__ __forceinline__ void operator()(const f32x4 (&acc)[2][2][4][2], const Unit& u, int wr, int wc, int fr, int fq) const {
        const int col0 = u.pn * 256 + wc * 32 + 8 * fq, locb = (u.pm - __builtin_amdgcn_readfirstlane(tb[u.e])) * 256;
#pragma unroll
        for (int ai = 0; ai < 2; ++ai)
#pragma unroll
            for (int m = 0; m < 4; ++m) { const int r = ai * 128 + wr * 64 + m * 16 + fr;
                if (r < u.cnt) { const unsigned tk = tokk[(size_t)u.e * LCAP + locb + r]; const float w = wl[(size_t)u.e * LCAP + locb + r];
                    bf16_t* rowp = Y + ((size_t)(tk & 1u) * NTOK + (tk >> 1)) * 1024 + col0;
#pragma unroll
                    for (int bj = 0; bj < 2; ++bj) { const f32x4 v0 = acc[ai][bj][m][0] * w, v1 = acc[ai][bj][m][1] * w;
                        u32x4 q; q.x = cvt_pk_bf16(v0[0], v0[1]); q.y = cvt_pk_bf16(v0[2], v0[3]); q.z = cvt_pk_bf16(v1[0], v1[1]); q.w = cvt_pk_bf16(v1[2], v1[3]);
                        *(u32x4*)(rowp + bj * 128) = q; } } }
    }
};
}
#endif

DEV void conv_row_compute(const Params& P, const bf16_t* ring, const float* wts, int s0, int s1, int s2, int ntap_rows, int slab, bf16_t* dst, int tid) {
    const int cq = tid & 31, tg = tid >> 5;
    typedef float f32x2 __attribute__((ext_vector_type(2)));
    f32x2 acc2[4][2];
#pragma unroll
    for (int t = 0; t < 4; ++t) { acc2[t][0] = (f32x2){0.f, 0.f}; acc2[t][1] = (f32x2){0.f, 0.f}; }
#pragma unroll
    for (int ky = 0; ky < 3; ++ky) {
        if (ntap_rows == 1 && ky != 1) continue;
        const int sl = ky == 0 ? s0 : ky == 1 ? s1 : s2;
        f32x2 w[3][2];
#pragma unroll
        for (int kx = 0; kx < 3; ++kx) { const f32x4 t = *(const f32x4*)(wts + (ky * 3 + kx) * 128 + cq * 4); w[kx][0] = (f32x2){t[0], t[1]}; w[kx][1] = (f32x2){t[2], t[3]}; }
        f32x2 in[6][2];
#pragma unroll
        for (int pos = 0; pos < 6; ++pos) { const u32x2 v = *(const u32x2*)(ring + sl * 8448 + (tg * 4 + pos) * 128 + cq * 4);
            in[pos][0] = (f32x2){__builtin_bit_cast(float, v[0] << 16), __builtin_bit_cast(float, v[0] & 0xffff0000u)}; in[pos][1] = (f32x2){__builtin_bit_cast(float, v[1] << 16), __builtin_bit_cast(float, v[1] & 0xffff0000u)}; }
#pragma unroll
        for (int t = 0; t < 4; ++t)
#pragma unroll
            for (int kx = 0; kx < 3; ++kx) { acc2[t][0] += w[kx][0] * in[t + kx][0]; acc2[t][1] += w[kx][1] * in[t + kx][1]; }
    }
    float acc[4][4];
#pragma unroll
    for (int t = 0; t < 4; ++t) { acc[t][0] = acc2[t][0][0]; acc[t][1] = acc2[t][0][1]; acc[t][2] = acc2[t][1][0]; acc[t][3] = acc2[t][1][1]; }
#pragma unroll
    for (int t = 0; t < 4; ++t) {
        float ss = 0.f;
#pragma unroll
        for (int c = 0; c < 4; ++c) { acc[t][c] = silu_f(acc[t][c]); ss += acc[t][c] * acc[t][c]; }
        if (slab < 8) { ss += shfl_xor_f(ss, 1); ss += shfl_xor_f(ss, 2); ss += shfl_xor_f(ss, 4); ss += shfl_xor_f(ss, 8); ss += shfl_xor_f(ss, 16); const float sc = rsq_f(ss + EPS);
#pragma unroll
            for (int c = 0; c < 4; ++c) acc[t][c] *= sc; }
        u32x2 o; o[0] = pk2(acc[t][0], acc[t][1]); o[1] = pk2(acc[t][2], acc[t][3]);
        *(u32x2*)(dst + (size_t)(tg * 4 + t) * 1536 + cq * 4) = o;
    }
}

DEV void phase3_conv(const Params& P, unsigned char* sm) {
    PHASE_TID;
    const bf16_t* p = (const bf16_t*)(P.ws + WS_R4 + R4_P);
    bf16_t* qkvn = (bf16_t*)(P.ws + WS_R3);
    bf16_t* ring = (bf16_t*)sm;
    float* wts = (float*)(sm + 3 * 16896);
    const u32x4 zero4 = (u32x4){0u, 0u, 0u, 0u};
    for (int it = BID; it < NB * 12 * 8; it += NBLK) {
        const int slab = it % 12, yb = (it / 12) & 7, b = it / 96, y0 = yb * 16;
        const bf16_t* src = p + (size_t)(b * SEQ) * 2048 + slab * 128;
        if (TID < 96) { const int sl = TID / 32, w = TID & 31, cc = (w >> 4) * 65, pc = w & 15; *(u32x4*)(ring + sl * 8448 + cc * 128 + pc * 8) = zero4; }
        if (TID < 288) *(f32x4*)(wts + TID * 4) = *(const f32x4*)(P.conv_w + (size_t)(TID >> 5) * 1536 + slab * 128 + (TID & 31) * 4);
        const int tk0 = TID >> 4, pc = TID & 15;
        u32x4 rr[4][2];
#define CV_LOAD(set, y) do { const bool ok_ = (y) >= 0 && (y) < 128; const int yc_ = ok_ ? (y) : y0;        \
            const u32x4 t0_ = *(const u32x4*)(src + (size_t)(yc_ * 64 + tk0) * 2048 + pc * 8), t1_ = *(const u32x4*)(src + (size_t)(yc_ * 64 + tk0 + 32) * 2048 + pc * 8); \
            rr[set][0] = ok_ ? t0_ : zero4; rr[set][1] = ok_ ? t1_ : zero4; } while (0)
#define CV_STORE(set, slot) do { *(u32x4*)(ring + (slot) * 8448 + (tk0 + 1) * 128 + pc * 8) = rr[set][0]; *(u32x4*)(ring + (slot) * 8448 + (tk0 + 33) * 128 + pc * 8) = rr[set][1]; } while (0)
        CV_LOAD(0, y0 - 1); CV_LOAD(1, y0); CV_LOAD(2, y0 + 1); CV_LOAD(3, y0 + 2);
        CV_STORE(0, 0); CV_STORE(1, 1);
        CV_LOAD(0, y0 + 3);
#pragma unroll 1
        for (int y4 = 0; y4 < 16; y4 += 4) {
#pragma unroll
            for (int u = 0; u < 4; ++u) {
                const int yy = y4 + u;
                const int s0 = yy % 3, s1 = (yy + 1) % 3, s2 = (yy + 2) % 3;
                CV_STORE((u + 2) & 3, s2);
                SYNC();
                CV_LOAD((u + 1) & 3, (yy + 4 <= 16) ? y0 + yy + 4 : 999);
                conv_row_compute(P, ring, wts, s0, s1, s2, 3, slab, qkvn + (size_t)(b * SEQ + (y0 + yy) * 64) * 1536 + slab * 128, TID);
                SYNC();
            }
        }
#undef CV_LOAD
#undef CV_STORE
    }
    for (int it = BID; it < NB * 12 * 4; it += NBLK) {
        const int slab = it % 12, sg = (it / 12) & 3, b = it / 48;
        const bf16_t* src = p + (size_t)(NTOK + b * CTX) * 2048 + slab * 128;
        if (TID < 288) *(f32x4*)(wts + TID * 4) = *(const f32x4*)(P.conv_w + (size_t)(TID >> 5) * 1536 + slab * 128 + (TID & 31) * 4);
        u32x4 r[3];
#pragma unroll
        for (int q = 0; q < 3; ++q) { const int idx = TID + q * 512; r[q] = zero4;
            if (idx < 66 * 16) { const int cc = idx >> 4, pc = idx & 15, tok = sg * 64 + cc - 1; if (tok >= 0 && tok < CTX) r[q] = *(const u32x4*)(src + (size_t)tok * 2048 + pc * 8); } }
#pragma unroll
        for (int q = 0; q < 3; ++q) { const int idx = TID + q * 512; if (idx < 66 * 16) { const int cc = idx >> 4, pc = idx & 15; *(u32x4*)(ring + 1 * 8448 + cc * 128 + pc * 8) = r[q]; } }
        SYNC();
        conv_row_compute(P, ring, wts, 0, 1, 2, 1, slab, qkvn + (size_t)(NTOK + b * CTX + sg * 64) * 1536 + slab * 128, TID);
        SYNC();
    }
}

constexpr int L_K = 0, L_Q = 17408, L_V = 34816, L_KTR = 52224, L_VT = 70656, L_X0 = 89088, L_X0T = L_X0 + 9216, L_X1 = L_X0T + 9216, L_X1T = L_X1 + 9216, L_TT = L_X1T + 9216, L_GC = L_TT + 9216;

DEV int chunk_row(int chain, int step, int i) {
    const int b = chain >> 3, dir = chain & 1;
    if (step < 4) { const int pos = step * 64 + i; return NTOK + b * CTX + (dir ? (CTX - 1 - pos) : pos); }
    const int pos = (step - 4) * 64 + i; return b * SEQ + (dir ? (SEQ - 1 - pos) : pos);
}

DEV void phase4_prepass(const Params& P, unsigned char* sm) {
    PHASE_TID;
    const bf16_t* qkvn = (const bf16_t*)(P.ws + WS_R3);
    const float* gb = (const float*)(P.ws + WS_GB);
    unsigned char* images = P.ws + WS_R4;
    bf16_t* Ks = (bf16_t*)(sm + L_K); bf16_t* Qs = (bf16_t*)(sm + L_Q); bf16_t* Vs = (bf16_t*)(sm + L_V); bf16_t* KTR = (bf16_t*)(sm + L_KTR); bf16_t* VT = (bf16_t*)(sm + L_VT);
    bf16_t* X0 = (bf16_t*)(sm + L_X0); bf16_t* X0T = (bf16_t*)(sm + L_X0T); bf16_t* X1 = (bf16_t*)(sm + L_X1); bf16_t* X1T = (bf16_t*)(sm + L_X1T); bf16_t* TT = (bf16_t*)(sm + L_TT);
    float* gcs = (float*)(sm + L_GC); float* bts = gcs + 64;
    const int wid = TID >> 6, lane = TID & 63, fr = lane & 15, fq = lane >> 4;
    const float QSCALE = 0.08838834764831845f;
    const f32x4 z4 = (f32x4){0.f, 0.f, 0.f, 0.f};
    u32x4 pf[6]; float gpf, bpf;
#define PP_LOAD(pid_) do { const int ch_ = (pid_) / NSTEP, st_ = (pid_) - ch_ * NSTEP, h_ = (ch_ >> 1) & 3, d_ = ch_ & 1; \
        _Pragma("unroll") for (int q = 0; q < 6; ++q) { const int idx = TID + q * 512, piece = idx & 15, i = (idx >> 4) & 63, which = idx >> 10; \
            pf[q] = *(const u32x4*)(qkvn + (size_t)chunk_row(ch_, st_, i) * 1536 + which * 512 + h_ * 128 + piece * 8); } \
        { const size_t row = (size_t)chunk_row(ch_, st_, lane); gpf = gb[row * 16 + 8 + d_ * 4 + h_]; bpf = gb[row * 16 + d_ * 4 + h_]; } } while (0)
    int pid = BID;
    if (pid < NPROB) PP_LOAD(pid);
    for (; pid < NPROB; pid += NBLK) {
        unsigned char* img = images + (size_t)pid * IMG_BYTES;
#pragma unroll
        for (int q = 0; q < 6; ++q) { const int idx = TID + q * 512, piece = idx & 15, i = (idx >> 4) & 63, which = idx >> 10;
            *(u32x4*)((which == 0 ? Qs : which == 1 ? Ks : Vs) + i * 136 + piece * 8) = pf[q]; }
        if (wid == 0) { float g = gpf;
#pragma unroll
            for (int o = 1; o < 64; o <<= 1) { const float t = shfl_up_f(g, o); if (lane >= o) g += t; }
            gcs[lane] = g; bts[lane] = bpf; }
        { const int nx = (pid + NBLK < NPROB) ? pid + NBLK : pid; PP_LOAD(nx); }
        SYNC();
        const float gl = gcs[63];
        f32x4 Treg[2], TTreg[2];
#pragma unroll
        for (int tt = 0; tt < 2; ++tt) {
            const int t = wid * 2 + tt, ti = t >> 2, tj = t & 3;
            f32x4 kk = z4, kkT = z4, qkT = z4;
#pragma unroll
            for (int ks = 0; ks < 4; ++ks) {
                const bf16x8 fKi = frag16(Ks + (ti * 16 + fr) * 136 + ks * 32 + fq * 8), fKj = frag16(Ks + (tj * 16 + fr) * 136 + ks * 32 + fq * 8), fQi = frag16(Qs + (ti * 16 + fr) * 136 + ks * 32 + fq * 8);
                kk = mfma16(fKi, fKj, kk); kkT = mfma16(fKj, fKi, kkT); qkT = mfma16(fKj, fQi, qkT);
            }
            {
              const int j = tj * 16 + fr; const float gcj = gcs[j]; float mv[4];
#pragma unroll
              for (int r = 0; r < 4; ++r) { const int i = ti * 16 + fq * 4 + r; mv[r] = (i > j) ? bts[i] * kk[r] * __expf(gcs[i] - gcj) : 0.f; Treg[tt][r] = (i == j ? 1.0f : 0.0f) - mv[r]; }
              u32x2 w; w[0] = pk2(mv[0], mv[1]); w[1] = pk2(mv[2], mv[3]); *(u32x2*)(X0T + j * 72 + ti * 16 + fq * 4) = w;
              w[0] = pk2(Treg[tt][0], Treg[tt][1]); w[1] = pk2(Treg[tt][2], Treg[tt][3]); *(u32x2*)(TT + j * 72 + ti * 16 + fq * 4) = w; }
            {
              const int i = ti * 16 + fr; const float gci = gcs[i], bi = bts[i]; float mv[4], av[4];
#pragma unroll
              for (int r = 0; r < 4; ++r) { const int j = tj * 16 + fq * 4 + r; const float dec = (i >= j) ? __expf(gci - gcs[j]) : 0.f;
                  mv[r] = (i > j) ? bi * kkT[r] * dec : 0.f; TTreg[tt][r] = (i == j ? 1.0f : 0.0f) - mv[r]; av[r] = qkT[r] * QSCALE * dec; }
              u32x2 w; w[0] = pk2(mv[0], mv[1]); w[1] = pk2(mv[2], mv[3]); *(u32x2*)(X0 + i * 72 + tj * 16 + fq * 4) = w;
              w[0] = pk2(av[0], av[1]); w[1] = pk2(av[2], av[3]); *(u32x2*)(img + IMG_A + (((ti * 2 + (tj >> 1)) * 64 + ((tj & 1) * 2 + (fq >> 1)) * 16 + fr) * 16 + (fq & 1) * 8)) = w; }
        }
        {
            const int dcol = wid * 16 + fr, ks = wid >> 1;
            bf16x8 idf;
#pragma unroll
            for (int j = 0; j < 8; ++j) idf[j] = (dcol == ks * 32 + fq * 8 + j) ? (short)0x3F80 : (short)0;
#pragma unroll
            for (int t4 = 0; t4 < 4; ++t4) {
                const f32x4 kt = mfma16(frag16(Ks + (t4 * 16 + fr) * 136 + ks * 32 + fq * 8), idf, z4);
                const f32x4 vt = mfma16(frag16(Vs + (t4 * 16 + fr) * 136 + ks * 32 + fq * 8), idf, z4);
                const int tok = t4 * 16 + fq * 4;
                u32x2 w; w[0] = pk2(kt[0], kt[1]); w[1] = pk2(kt[2], kt[3]); *(u32x2*)(KTR + dcol * 72 + tok) = w;
                w[0] = pk2(vt[0], vt[1]); w[1] = pk2(vt[2], vt[3]); *(u32x2*)(VT + dcol * 72 + tok) = w;
                const f32x4 gq = *(const f32x4*)(gcs + tok);
                w[0] = pk2(kt[0] * __expf(gl - gq[0]), kt[1] * __expf(gl - gq[1])); w[1] = pk2(kt[2] * __expf(gl - gq[2]), kt[3] * __expf(gl - gq[3]));
                *(u32x2*)(img + IMG_KT + (((wid * 2 + (t4 >> 1)) * 64 + ((t4 & 1) * 2 + (fq >> 1)) * 16 + fr) * 16 + (fq & 1) * 8)) = w;
            }
        }
        SYNC();
#pragma unroll 1
        for (int s5 = 0; s5 < 5; ++s5) {
            const bf16_t* Pc = (s5 & 1) ? X1 : X0; const bf16_t* PcT = (s5 & 1) ? X1T : X0T; bf16_t* Pn = (s5 & 1) ? X0 : X1; bf16_t* PnT = (s5 & 1) ? X0T : X1T;
#pragma unroll
            for (int tt = 0; tt < 2; ++tt) {
                const int t = wid * 2 + tt, ti = t >> 2, tj = t & 3;
                f32x4 p2 = z4, p2T = z4;
#pragma unroll
                for (int ks = 0; ks < 2; ++ks) { const bf16x8 a = frag16(Pc + (ti * 16 + fr) * 72 + ks * 32 + fq * 8), b = frag16(PcT + (tj * 16 + fr) * 72 + ks * 32 + fq * 8);
                    p2 = mfma16(a, b, p2); p2T = mfma16(b, a, p2T); }
                u32x2 w; w[0] = pk2(p2[0], p2[1]); w[1] = pk2(p2[2], p2[3]); *(u32x2*)(PnT + (tj * 16 + fr) * 72 + ti * 16 + fq * 4) = w;
                w[0] = pk2(p2T[0], p2T[1]); w[1] = pk2(p2T[2], p2T[3]); *(u32x2*)(Pn + (ti * 16 + fr) * 72 + tj * 16 + fq * 4) = w;
            }
            SYNC();
#pragma unroll
            for (int tt = 0; tt < 2; ++tt) {
                const int t = wid * 2 + tt, ti = t >> 2, tj = t & 3;
#pragma unroll
                for (int ks = 0; ks < 2; ++ks) { const bf16x8 a = frag16(Pn + (ti * 16 + fr) * 72 + ks * 32 + fq * 8), b = frag16(TT + (tj * 16 + fr) * 72 + ks * 32 + fq * 8);
                    Treg[tt] = mfma16(a, b, Treg[tt]); TTreg[tt] = mfma16(b, a, TTreg[tt]); }
            }
            SYNC();
            if (s5 < 4) {
#pragma unroll
                for (int tt = 0; tt < 2; ++tt) { const int t = wid * 2 + tt, ti = t >> 2, tj = t & 3;
                    u32x2 w; w[0] = pk2(Treg[tt][0], Treg[tt][1]); w[1] = pk2(Treg[tt][2], Treg[tt][3]); *(u32x2*)(TT + (tj * 16 + fr) * 72 + ti * 16 + fq * 4) = w; }
            }
        }
#pragma unroll
        for (int tt = 0; tt < 2; ++tt) {
            const int t = wid * 2 + tt, ti = t >> 2, tj = t & 3, i = ti * 16 + fr, j0 = tj * 16 + fq * 4;
            const f32x4 bq = *(const f32x4*)(bts + j0), gq = *(const f32x4*)(gcs + j0);
            float tu[4], tw[4];
#pragma unroll
            for (int r = 0; r < 4; ++r) { tu[r] = TTreg[tt][r] * bq[r]; tw[r] = tu[r] * __expf(gq[r]); }
            u32x2 w; w[0] = pk2(tu[0], tu[1]); w[1] = pk2(tu[2], tu[3]); *(u32x2*)(X0 + i * 72 + j0) = w;
            w[0] = pk2(tw[0], tw[1]); w[1] = pk2(tw[2], tw[3]); *(u32x2*)(X0T + i * 72 + j0) = w;
        }
        { const int tok = TID >> 3, c16 = (TID & 7) * 16; const float qs = QSCALE * __expf(gcs[tok]);
          u32x4 a = *(const u32x4*)(Qs + tok * 136 + c16), b = *(const u32x4*)(Qs + tok * 136 + c16 + 8);
#pragma unroll
          for (int e = 0; e < 4; ++e) { a[e] = pk2(bf2f((bf16_t)(a[e] & 0xffffu)) * qs, bf2f((bf16_t)(a[e] >> 16)) * qs); b[e] = pk2(bf2f((bf16_t)(b[e] & 0xffffu)) * qs, bf2f((bf16_t)(b[e] >> 16)) * qs); }
          *(u32x4*)(Qs + tok * 136 + c16) = a; *(u32x4*)(Qs + tok * 136 + c16 + 8) = b;
          if (TID == 0) { float* scp = (float*)(sm + L_GC + 512); scp[0] = __expf(gl); scp[1] = 0.f; scp[2] = 0.f; scp[3] = 0.f; } }
        SYNC();
#pragma unroll
        for (int it = 0; it < 4; ++it) {
            f32x4 ua = z4, wa = z4;
#pragma unroll
            for (int ks = 0; ks < 2; ++ks) {
                const bf16x8 av = frag16(VT + (wid * 16 + fr) * 72 + ks * 32 + fq * 8), ak = frag16(KTR + (wid * 16 + fr) * 72 + ks * 32 + fq * 8);
                const bf16x8 bu = frag16(X0 + (it * 16 + fr) * 72 + ks * 32 + fq * 8), bw = frag16(X0T + (it * 16 + fr) * 72 + ks * 32 + fq * 8);
                ua = mfma16(bu, av, ua); wa = mfma16(ak, bw, wa);
            }
            u32x2 w; w[0] = pk2(ua[0], ua[1]); w[1] = pk2(ua[2], ua[3]); *(u32x2*)(img + IMG_U + ((wid * 4 + it) * 64 + lane) * 8) = w;
            const int i = it * 16 + fr, c = wid * 16 + fq * 4;
            w[0] = pk2(wa[0], wa[1]); w[1] = pk2(wa[2], wa[3]); *(u32x2*)(Ks + i * 136 + c) = w;
        }
        SYNC();
#pragma unroll
        for (int q = 0; q < 5; ++q) { int pc = TID + q * 512; pc = pc < 2049 ? pc : 2048;
            const int reg = pc >> 10, p = pc & 1023, mt = p >> 8, ks = (p >> 6) & 3, ln = p & 63;
            const int so = pc == 2048 ? L_GC + 512 : (reg == 0 ? L_K : L_Q) + ((mt * 16 + (ln & 15)) * 136 + ks * 32 + (ln >> 4) * 8) * 2;
            const int dofs = pc == 2048 ? IMG_SC : (reg == 0 ? IMG_W : IMG_Q) + p * 16;
            *(u32x4*)(img + dofs) = *(const u32x4*)(sm + so); }
        SYNC();
    }
#undef PP_LOAD
}

DEV void phase4_fft(const Params& P, unsigned char* sm) {
    PHASE_TID;
    const bf16_t* GT = (const bf16_t*)((const unsigned char*)P.out + DO_GT);
    bf16_t* ZT = (bf16_t*)((unsigned char*)P.out + DO_ZT);
    const bf16_t* tab = (const bf16_t*)(P.ws + WS_TAB);
    bf16_t* YR = (bf16_t*)sm; bf16_t* YI = YR + 64 * 136;
    const int wid = TID >> 6, lane = TID & 63, fr = lane & 15, fq = lane >> 4;
    bf16x8 c64[4][2], s64[4][2], c128[4], s128[4];
#pragma unroll
    for (int nt = 0; nt < 4; ++nt)
#pragma unroll
        for (int ks = 0; ks < 2; ++ks) { c64[nt][ks] = frag16(tab + (nt * 16 + fr) * 64 + ks * 32 + fq * 8); s64[nt][ks] = frag16(tab + 4096 + (nt * 16 + fr) * 64 + ks * 32 + fq * 8); }
#pragma unroll
    for (int ks = 0; ks < 4; ++ks) { c128[ks] = frag16(tab + 8192 + (wid * 16 + fr) * 128 + ks * 32 + fq * 8); s128[ks] = frag16(tab + 8192 + 16384 + (wid * 16 + fr) * 128 + ks * 32 + fq * 8); }
    for (int it = BID; it < 512 * NB; it += NBLK) {
        const int cp = it >> 3, b = it & 7;
        const bf16_t* gr = GT + (size_t)cp * NTOK + b * SEQ; const bf16_t* gi = GT + (size_t)(512 + cp) * NTOK + b * SEQ;
        bf16x8 ar[2], ai[2], an[2];
#pragma unroll
        for (int ks = 0; ks < 2; ++ks) { ar[ks] = frag16(gr + (wid * 16 + fr) * 64 + ks * 32 + fq * 8); ai[ks] = frag16(gi + (wid * 16 + fr) * 64 + ks * 32 + fq * 8);
#pragma unroll
            for (int j = 0; j < 8; ++j) an[ks][j] = (short)(ar[ks][j] ^ (short)0x8000); }
#pragma unroll
        for (int nt = 0; nt < 4; ++nt) {
            f32x4 yr = (f32x4){0.f, 0.f, 0.f, 0.f}, yi = (f32x4){0.f, 0.f, 0.f, 0.f};
#pragma unroll
            for (int ks = 0; ks < 2; ++ks) { yr = mfma16(ar[ks], c64[nt][ks], yr); yr = mfma16(ai[ks], s64[nt][ks], yr); yi = mfma16(ai[ks], c64[nt][ks], yi); yi = mfma16(an[ks], s64[nt][ks], yi); }
            const int k1 = nt * 16 + fr; float orr[4], oii[4];
#pragma unroll
            for (int r = 0; r < 4; ++r) { const int n2 = wid * 16 + fq * 4 + r; float s, c; sincospi_f((float)(n2 * k1) * (2.0f / 8192.0f), &s, &c);
                orr[r] = yr[r] * c + yi[r] * s; oii[r] = yi[r] * c - yr[r] * s; }
            u32x2 w; w[0] = pk2(orr[0], orr[1]); w[1] = pk2(orr[2], orr[3]); *(u32x2*)(YR + k1 * 136 + wid * 16 + fq * 4) = w;
            w[0] = pk2(oii[0], oii[1]); w[1] = pk2(oii[2], oii[3]); *(u32x2*)(YI + k1 * 136 + wid * 16 + fq * 4) = w;
        }
        SYNC();
        bf16_t* zrow = ZT + (size_t)cp * NTOK + b * SEQ;
#pragma unroll
        for (int mt = 0; mt < 4; ++mt) {
            f32x4 z = (f32x4){0.f, 0.f, 0.f, 0.f};
#pragma unroll
            for (int ks = 0; ks < 4; ++ks) { z = mfma16(frag16(YR + (mt * 16 + fr) * 136 + ks * 32 + fq * 8), c128[ks], z); z = mfma16(frag16(YI + (mt * 16 + fr) * 136 + ks * 32 + fq * 8), s128[ks], z); }
            u32x2 w; w[0] = pk2(z[0], z[1]); w[1] = pk2(z[2], z[3]);
            *(u32x2*)(zrow + 64 * (wid * 16 + fr) + mt * 16 + fq * 4) = w;
        }
        SYNC();
    }
}

constexpr int SC_W = 0, SC_U = 17408, SC_KT = 22528, SC_Q = SC_KT + 18432, SC_A = SC_Q + 17408, SC_ST = SC_A + 9216, SC_VN = SC_ST + 2 * 8704, SC_END = SC_VN + 4608;

DEV void phase5_scan(const Params& P, unsigned char* sm) {
    PHASE_TID;
    const unsigned char* images = P.ws + WS_R4;
    bf16_t* obuf = (bf16_t*)(P.ws + WS_R3);
    const int wid = TID >> 6, lane = TID & 63, fr = lane & 15, fq = lane >> 4;
    bf16_t* ST = (bf16_t*)sm; bf16_t* VN = (bf16_t*)(sm + 2 * 8704);
    for (int item = BID; item < NCHAIN * 4; item += NBLK) {
        const int xj = item >> 3, chain = (item & 7) * 8 + (xj >> 2), c0 = (xj & 3) * 32, b = chain >> 3, hh = (chain >> 1) & 3, dir = chain & 1;
        const unsigned char* blk0 = images + (size_t)chain * NSTEP * IMG_BYTES;
        const int oK = IMG_KT + (wid * 2 * 64 + lane) * 16;
        f32x4 Sacc[2];
        Sacc[0] = (f32x4){0.f, 0.f, 0.f, 0.f}; Sacc[1] = (f32x4){0.f, 0.f, 0.f, 0.f};
        for (int q = TID; q < 2 * 8704 / 4; q += 512) ((unsigned*)ST)[q] = 0u;
#define SC_SUPD(rkset) do { _Pragma("unroll") for (int tt = 0; tt < 2; ++tt) { f32x4 a = Sacc[tt] * dl; \
            _Pragma("unroll") for (int ks = 0; ks < 2; ++ks) a = mfma16(__builtin_bit_cast(bf16x8, rkset[ks]), frag16(VN + (tt * 16 + fr) * 72 + ks * 32 + fq * 8), a); \
            Sacc[tt] = a; u32x2 w_; w_[0] = pk2(a[0], a[1]); w_[1] = pk2(a[2], a[3]); *(u32x2*)(STn + (tt * 16 + fr) * 136 + wid * 16 + fq * 4) = w_; } } while (0)
        if (wid < 4) {
            const int mt = wid;
            const int oW = IMG_W + (mt * 4 * 64 + lane) * 16, oQ = IMG_Q + (mt * 4 * 64 + lane) * 16, oA = IMG_A + (mt * 2 * 64 + lane) * 16;
            const int oU = IMG_U + (((c0 >> 4) * 4 + mt) * 64 + lane) * 8;
            u32x4 rw[3][4], rk[3][2], rq[3][4], ra[3][2]; u32x2 ru[3][2]; float dlr[3];
#define SC_LOAD1(set, blk) do { \
            _Pragma("unroll") for (int ks = 0; ks < 4; ++ks) rw[set][ks] = *(const u32x4*)((blk) + oW + ks * 1024); \
            ru[set][0] = *(const u32x2*)((blk) + oU); ru[set][1] = *(const u32x2*)((blk) + oU + 2048); dlr[set] = *(const float*)((blk) + IMG_SC); } while (0)
#define SC_LOAD2(set, blk) do { \
            _Pragma("unroll") for (int ks = 0; ks < 2; ++ks) rk[set][ks] = *(const u32x4*)((blk) + oK + ks * 1024); \
            _Pragma("unroll") for (int ks = 0; ks < 4; ++ks) rq[set][ks] = *(const u32x4*)((blk) + oQ + ks * 1024); \
            _Pragma("unroll") for (int ks = 0; ks < 2; ++ks) ra[set][ks] = *(const u32x4*)((blk) + oA + ks * 1024); } while (0)
#define SC_LOAD(set, blk) do { SC_LOAD1(set, blk); SC_LOAD2(set, blk); } while (0)
            SC_LOAD(0, blk0); SC_LOAD(1, blk0 + IMG_BYTES); SC_LOAD(2, blk0 + 2 * IMG_BYTES);
            SYNC();
#pragma unroll 1
            for (int s3 = 0; s3 < NSTEP; s3 += 3) {
#pragma unroll
                for (int u = 0; u < 3; ++u) {
                    const int step = s3 + u, cur = step & 1;
                    const bf16_t* STc = ST + cur * 4352; bf16_t* STn = ST + (cur ^ 1) * 4352;
#pragma unroll
                    for (int nt = 0; nt < 2; ++nt) {
                        f32x4 vn = (f32x4){0.f, 0.f, 0.f, 0.f};
#pragma unroll
                        for (int ks = 0; ks < 4; ++ks) vn = mfma16(__builtin_bit_cast(bf16x8, rw[u][ks]), frag16(STc + (nt * 16 + fr) * 136 + ks * 32 + fq * 8), vn);
                        const unsigned u0 = ru[u][nt][0], u1 = ru[u][nt][1];
                        u32x2 w; w[0] = pk2(bf2f((bf16_t)(u0 & 0xffffu)) - vn[0], bf2f((bf16_t)(u0 >> 16)) - vn[1]); w[1] = pk2(bf2f((bf16_t)(u1 & 0xffffu)) - vn[2], bf2f((bf16_t)(u1 >> 16)) - vn[3]);
                        *(u32x2*)(VN + (nt * 16 + fr) * 72 + mt * 16 + fq * 4) = w;
                    }
                    const float dl = dlr[u];
                    const unsigned char* blk3 = blk0 + (size_t)(step + 3 < NSTEP ? step + 3 : NSTEP - 1) * IMG_BYTES;
                    SC_LOAD1(u, blk3);
                    SYNC();
                    SC_SUPD(rk[u]);
                    if (step >= 4) {
#pragma unroll
                        for (int nt = 0; nt < 2; ++nt) {
                            f32x4 o = (f32x4){0.f, 0.f, 0.f, 0.f};
#pragma unroll
                            for (int ks = 0; ks < 4; ++ks) o = mfma16(__builtin_bit_cast(bf16x8, rq[u][ks]), frag16(STc + (nt * 16 + fr) * 136 + ks * 32 + fq * 8), o);
#pragma unroll
                            for (int ks = 0; ks < 2; ++ks) o = mfma16(__builtin_bit_cast(bf16x8, ra[u][ks]), frag16(VN + (nt * 16 + fr) * 72 + ks * 32 + fq * 8), o);
#pragma unroll
                            for (int r = 0; r < 4; ++r) { const int pos = (step - 4) * 64 + mt * 16 + fq * 4 + r; const int tok = b * SEQ + (dir ? (SEQ - 1 - pos) : pos);
                                obuf[((size_t)dir * NTOK + tok) * 512 + hh * 128 + c0 + nt * 16 + fr] = f2bf(o[r]); }
                        }
                    }
                    SC_LOAD2(u, blk3);
                    SYNC();
                }
            }
#undef SC_LOAD
#undef SC_LOAD1
#undef SC_LOAD2
        } else {
            u32x4 rk[3][2]; float dlr[3];
#define SC_LOADK(set, blk) do { dlr[set] = *(const float*)((blk) + IMG_SC); _Pragma("unroll") for (int ks = 0; ks < 2; ++ks) rk[set][ks] = *(const u32x4*)((blk) + oK + ks * 1024); } while (0)
            SC_LOADK(0, blk0); SC_LOADK(1, blk0 + IMG_BYTES); SC_LOADK(2, blk0 + 2 * IMG_BYTES);
            SYNC();
#pragma unroll 1
            for (int s3 = 0; s3 < NSTEP; s3 += 3) {
#pragma unroll
                for (int u = 0; u < 3; ++u) {
                    const int step = s3 + u, cur = step & 1;
                    bf16_t* STn = ST + (cur ^ 1) * 4352;
                    const float dl = dlr[u];
                    SYNC();
                    SC_SUPD(rk[u]);
                    { const unsigned char* blk3 = blk0 + (size_t)(step + 3 < NSTEP ? step + 3 : NSTEP - 1) * IMG_BYTES; SC_LOADK(u, blk3); }
                    SYNC();
                }
            }
#undef SC_LOADK
        }
#undef SC_SUPD
        SYNC();
    }
}

DEV void phase6_amix(const Params& P, unsigned char* sm) {
    PHASE_TID;
    const bf16_t* ZT = (const bf16_t*)((const unsigned char*)P.out + DO_ZT);
    const bf16_t* zs = (const bf16_t*)((const unsigned char*)P.out + DO_ZS);
    const bf16_t* obuf = (const bf16_t*)(P.ws + WS_R3);
    bf16_t* amix = (bf16_t*)(P.ws + WS_R4 + R4_AMIX);
    unsigned* tile = (unsigned*)sm;
    for (int tt = BID; tt < NTOK / 64; tt += NBLK) {
        const int tok0 = tt * 64;
        { u32x4 r[8];
#pragma unroll
          for (int q = 0; q < 8; ++q) { const int idx = TID + q * 512, cp = idx >> 3, piece = idx & 7; r[q] = *(const u32x4*)(ZT + (size_t)cp * NTOK + tok0 + piece * 8); }
#pragma unroll
          for (int q = 0; q < 8; ++q) { const int idx = TID + q * 512, cp = idx >> 3, piece = idx & 7; unsigned* t = tile + cp * 33 + piece * 4; t[0] = r[q][0]; t[1] = r[q][1]; t[2] = r[q][2]; t[3] = r[q][3]; } }
        SYNC();
        u32x4 oa[8], ob[8], oz[8];
#pragma unroll
        for (int q = 0; q < 8; ++q) { const int idx = TID + q * 512, tok = idx >> 6, hh = (idx >> 4) & 3, l16 = idx & 15; const size_t off = (size_t)(tok0 + tok) * 512 + hh * 128 + l16 * 8;
            oa[q] = *(const u32x4*)(obuf + off); ob[q] = *(const u32x4*)(obuf + (size_t)NTOK * 512 + off); oz[q] = *(const u32x4*)(zs + off); }
#pragma unroll
        for (int q = 0; q < 8; ++q) { const int tok = TID & 63, c8 = ((TID >> 6) * 8 + q) * 8, sh = (tok & 1) * 16; u32x4 o;
#pragma unroll
            for (int j = 0; j < 4; ++j) o[j] = ((tile[(c8 + 2 * j) * 33 + (tok >> 1)] >> sh) & 0xffffu) | (((tile[(c8 + 2 * j + 1) * 33 + (tok >> 1)] >> sh) & 0xffffu) << 16);
            *(u32x4*)(amix + (size_t)(tok0 + tok) * 1024 + c8) = o; }
        const int l16 = TID & 15;
        float og[8];
#pragma unroll
        for (int j = 0; j < 8; ++j) og[j] = P.onorm_g[l16 * 8 + j];
#pragma unroll
        for (int q = 0; q < 8; ++q) {
            const int idx = TID + q * 512, tok = idx >> 6, hh = (idx >> 4) & 3;
            const u32x4 a = oa[q], bq = ob[q], zv = oz[q];
            float v[8]; float ss = 0.f;
#pragma unroll
            for (int j = 0; j < 4; ++j) { v[2 * j] = bf2f((bf16_t)(a[j] & 0xffffu)) + bf2f((bf16_t)(bq[j] & 0xffffu)); v[2 * j + 1] = bf2f((bf16_t)(a[j] >> 16)) + bf2f((bf16_t)(bq[j] >> 16)); }
#pragma unroll
            for (int j = 0; j < 8; ++j) ss += v[j] * v[j];
            ss += shfl_xor_f(ss, 1); ss += shfl_xor_f(ss, 2); ss += shfl_xor_f(ss, 4); ss += shfl_xor_f(ss, 8);
            const float rstd = rsq_f(ss * (1.0f / 128.0f) + EPS);
            u32x4 o;
#pragma unroll
            for (int j = 0; j < 4; ++j) o[j] = pk2(v[2 * j] * rstd * og[2 * j] * bf2f((bf16_t)(zv[j] & 0xffffu)), v[2 * j + 1] * rstd * og[2 * j + 1] * bf2f((bf16_t)(zv[j] >> 16)));
            *(u32x4*)(amix + (size_t)(tok0 + tok) * 1024 + 512 + hh * 128 + l16 * 8) = o;
        }
        SYNC();
    }
}

DEV void phase8_router(const Params& P, unsigned char* sm, int dry) {
    PHASE_TID;
    float* wr = (float*)sm;
    {
        f32x4 g[2], rt[2][8];
#pragma unroll
        for (int h = 0; h < 2; ++h) { const int k = TID + h * 512; g[h] = *(const f32x4*)(P.w_group + k * 4);
#pragma unroll
            for (int q = 0; q < 8; ++q) rt[h][q] = *(const f32x4*)(P.w_router + k * 32 + q * 4); }
#pragma unroll
        for (int h = 0; h < 2; ++h) { const int k = TID + h * 512;
#pragma unroll
            for (int e = 0; e < 4; ++e) wr[e * 1028 + k] = g[h][e];
#pragma unroll
            for (int q = 0; q < 8; ++q)
#pragma unroll
                for (int e = 0; e < 4; ++e) wr[(4 + q * 4 + e) * 1028 + k] = rt[h][q][e]; }
    }
    SYNC();
    const float* mod = (const float*)(P.ws + WS_MOD);
    const float* x1 = P.out;
    bf16_t* h2 = (bf16_t*)(P.ws + WS_R4 + R4_H2);
    unsigned* cnt = (unsigned*)(P.ws + WS_CNT + (dry ? 8192 : 0)); unsigned* tokk = (unsigned*)(P.ws + (dry ? WS_R3 : WS_TOKK)); float* wl = (float*)(P.ws + (dry ? WS_R3 + 16 * MiB : WS_WL));
    const int wid = TID >> 6, lane = TID & 63;
    const int rstep = NBLK * 8;
    int r = BID * 8 + wid;
    unsigned* lc = (unsigned*)(sm + 148224);
    unsigned* aE = lc + 64; float* aW = (float*)(aE + 512); unsigned* aP = (unsigned*)(aW + 512);
    float* gsv = (float*)(sm + 154624); float* shv = gsv + 1024;
    float* brs = shv + 1024;
    if (TID < 32) { lc[TID] = 0u; brs[TID] = P.b_router[TID]; }
    const float bg0 = P.b_group[0], bg1 = P.b_group[1], bg2 = P.b_group[2], bg3 = P.b_group[3];
    int mbcur = -1;
    SYNC();
    int jrow = 0;
    f32x4 vn[4], vm[4];
    if (r < NTOK) {
#pragma unroll
        for (int i = 0; i < 4; ++i) vn[i] = *(const f32x4*)(x1 + (size_t)r * D + i * 256 + lane * 4);
    }
    if (r + rstep < NTOK) {
#pragma unroll
        for (int i = 0; i < 4; ++i) vm[i] = *(const f32x4*)(x1 + (size_t)(r + rstep) * D + i * 256 + lane * 4);
    }
    for (; r < NTOK; r += rstep) {
        if ((r >> 13) != mbcur) {
            mbcur = r >> 13; const float* shift = mod + mbcur * 6144 + 3 * 1024, *scale = shift + 1024;
            SYNC();
#pragma unroll
            for (int q = 0; q < 2; ++q) { const int k = TID + q * 512; gsv[k] = P.norm2_g[k] * (1.0f + scale[k]); shv[k] = shift[k]; }
            SYNC();
        }
        f32x4 v[4]; float ss = 0.f;
#pragma unroll
        for (int i = 0; i < 4; ++i) { v[i] = vn[i]; vn[i] = vm[i]; ss += v[i][0] * v[i][0] + v[i][1] * v[i][1] + v[i][2] * v[i][2] + v[i][3] * v[i][3]; }
        { const int rl = (r + 2 * rstep < NTOK) ? r + 2 * rstep : r;
#pragma unroll
          for (int i = 0; i < 4; ++i) vm[i] = *(const f32x4*)(x1 + (size_t)rl * D + i * 256 + lane * 4); }
        ss = wave_sum(ss);
        const float rstd = rsq_f(ss * (1.0f / 1024.0f) + EPS);
        float gl[4] = {0.f, 0.f, 0.f, 0.f};
#pragma unroll
        for (int i = 0; i < 4; ++i) {
            const int k = i * 256 + lane * 4;
            const f32x4 g2 = *(const f32x4*)(gsv + k), sh = *(const f32x4*)(shv + k);
#pragma unroll
            for (int e = 0; e < 4; ++e) v[i][e] = v[i][e] * rstd * g2[e] + sh[e];
#pragma unroll
            for (int j = 0; j < 4; ++j) { const f32x4 wv = *(const f32x4*)(wr + j * 1028 + k); gl[j] += v[i][0] * wv[0] + v[i][1] * wv[1] + v[i][2] * wv[2] + v[i][3] * wv[3]; }
            u32x2 w; w[0] = pk2(v[i][0], v[i][1]); w[1] = pk2(v[i][2], v[i][3]);
            *(u32x2*)(h2 + (size_t)r * D + k) = w;
        }
#pragma unroll
        for (int j = 0; j < 4; ++j) gl[j] += 0.f;
        { const float t = wave_sum_multi<4>(gl, lane);
#pragma unroll
          for (int j = 0; j < 4; ++j) gl[j] = lane_bcast(t, j) + (j == 0 ? bg0 : j == 1 ? bg1 : j == 2 ? bg2 : bg3); }
        int gsel = 0; float gmax = gl[0];
#pragma unroll
        for (int j = 1; j < 4; ++j) if (gl[j] > gmax) { gmax = gl[j]; gsel = j; }
        float gden = 0.f;
#pragma unroll
        for (int j = 0; j < 4; ++j) gden += __expf(gl[j] - gmax);
        const float pg = 1.0f / gden;
        float el[8] = {0.f, 0.f, 0.f, 0.f, 0.f, 0.f, 0.f, 0.f};
#pragma unroll
        for (int i = 0; i < 4; ++i)
#pragma unroll
            for (int j = 0; j < 8; ++j) { const f32x4 wv = *(const f32x4*)(wr + (4 + gsel * 8 + j) * 1028 + i * 256 + lane * 4); el[j] += v[i][0] * wv[0] + v[i][1] * wv[1] + v[i][2] * wv[2] + v[i][3] * wv[3]; }
#pragma unroll
        for (int j = 0; j < 8; ++j) el[j] += 0.f;
        { const float t = wave_sum_multi<8>(el, lane);
#pragma unroll
          for (int j = 0; j < 8; ++j) el[j] = lane_bcast(t, j) + brs[gsel * 8 + j]; }
        int e1 = 0; float m1 = el[0];
#pragma unroll
        for (int j = 1; j < 8; ++j) if (el[j] > m1) { m1 = el[j]; e1 = j; }
        int e2 = -1; float m2 = -3.0e38f;
#pragma unroll
        for (int j = 0; j < 8; ++j) if (j != e1 && el[j] > m2) { m2 = el[j]; e2 = j; }
        if (e2 < 0) e2 = (e1 + 1) & 7;
        const float p2 = __expf(m2 - m1);
        const float w1 = pg / (1.0f + p2), w2 = pg * p2 / (1.0f + p2);
        if (lane < 2) {
            const int ee = gsel * 8 + (lane == 0 ? e1 : e2); const float ww = lane == 0 ? w1 : w2;
            const unsigned pos = atomic_add_u32(&lc[ee], 1u);
            const int a = (jrow * 8 + wid) * 2 + lane;
            if (a < 512) { aE[a] = (unsigned)ee; aW[a] = ww; aP[a] = pos; }
        }
        ++jrow;
    }
    SYNC();
    if (TID < 32) lc[32 + TID] = atomic_add_u32(&cnt[TID * 64], lc[TID]);
    SYNC();
    { const int a = TID, rl = a >> 1, rr = BID * 8 + (rl & 7) + (rl >> 3) * rstep;
      if (rr < NTOK && (rl >> 3) < jrow) { const unsigned ee = aE[a]; const unsigned pos = lc[32 + ee] + aP[a];
          tokk[(size_t)ee * LCAP + pos] = (unsigned)rr * 2u + (unsigned)(a & 1); wl[(size_t)ee * LCAP + pos] = aW[a]; } }
}

DEV void phase11_final(const Params& P, unsigned char* sm, float* dstbase) {
    PHASE_TID;
    (void)sm;
    const float* mod = (const float*)(P.ws + WS_MOD);
    const bf16_t* Y = (const bf16_t*)(P.ws + WS_R4 + R4_Y);
    const int wid = TID >> 6, lane = TID & 63;
    for (int r0 = (BID * 8 + wid) * 2; r0 < NTOK; r0 += NBLK * 16) {
        f32x4 xv[2][4]; u32x2 y0[2][4], y1[2][4];
#pragma unroll
        for (int u = 0; u < 2; ++u)
#pragma unroll
            for (int i = 0; i < 4; ++i) { const int k = i * 256 + lane * 4; const size_t r = (size_t)(r0 + u);
                xv[u][i] = *(const f32x4*)(P.out + r * D + k); y0[u][i] = *(const u32x2*)(Y + r * D + k); y1[u][i] = *(const u32x2*)(Y + ((size_t)NTOK + r) * D + k); }
        const float* gate = mod + (r0 >> 13) * 6144 + 5 * 1024;
#pragma unroll
        for (int u = 0; u < 2; ++u) {
            float* row = dstbase + (size_t)(r0 + u) * D;
            f32x4 v[4]; float ss = 0.f;
#pragma unroll
            for (int i = 0; i < 4; ++i) { const int k = i * 256 + lane * 4; const f32x4 gv = *(const f32x4*)(gate + k);
                f32x4 m; m[0] = bf2f((bf16_t)(y0[u][i][0] & 0xffffu)) + bf2f((bf16_t)(y1[u][i][0] & 0xffffu)); m[1] = bf2f((bf16_t)(y0[u][i][0] >> 16)) + bf2f((bf16_t)(y1[u][i][0] >> 16));
                m[2] = bf2f((bf16_t)(y0[u][i][1] & 0xffffu)) + bf2f((bf16_t)(y1[u][i][1] & 0xffffu)); m[3] = bf2f((bf16_t)(y0[u][i][1] >> 16)) + bf2f((bf16_t)(y1[u][i][1] >> 16));
                v[i] = xv[u][i] + gv * m; ss += v[i][0] * v[i][0] + v[i][1] * v[i][1] + v[i][2] * v[i][2] + v[i][3] * v[i][3]; }
            ss = wave_sum(ss);
            const float rstd = rsq_f(ss * (1.0f / 1024.0f) + EPS);
#pragma unroll
            for (int i = 0; i < 4; ++i) { const int k = i * 256 + lane * 4; const f32x4 fg = *(const f32x4*)(P.final_g + k); *(f32x4*)(row + k) = v[i] * rstd * fg; }
        }
    }
}

#ifndef CPU_EMU
#define XB_TMO      128
#define XB_XCNT(j)  (256  + 64 * (j))
#define XB_XSUB(j)  (1280 + 64 * (j))
#define XB_XGEN(j)  (2304 + 64 * (j))
#define XB_TOP      3328
#define XB_TOPGEN   3392
#define XCD_BAR_WORDS 3456
#define XB_SPIN_CAP (1u << 22)
#define LAS __attribute__((address_space(3)))
__device__ __forceinline__ unsigned xb_ld(unsigned* p)              { return __hip_atomic_load(p, __ATOMIC_RELAXED, __HIP_MEMORY_SCOPE_AGENT); }
__device__ __forceinline__ unsigned xb_add(unsigned* p, unsigned v) { return __hip_atomic_fetch_add(p, v, __ATOMIC_RELAXED, __HIP_MEMORY_SCOPE_AGENT); }
__device__ __forceinline__ unsigned xb_xcc_id() { return (unsigned)__builtin_amdgcn_s_getreg((3 << 11) | 20) & 0xFu; }
#define XB_SPIN(cond, bar) do { unsigned _sp = 0; while (cond) { __builtin_amdgcn_s_sleep(1); \
    if ((++_sp & 255u) == 0u) { if (xb_ld(&(bar)[XB_TMO])) break; if (_sp > XB_SPIN_CAP) { atomicAdd(&(bar)[XB_TMO], 1u); break; } } } } while (0)
struct XcdBarrier { unsigned* bar; unsigned x; volatile LAS unsigned* st; };
__device__ __forceinline__ XcdBarrier xcd_barrier_post(unsigned* bar, volatile LAS unsigned* st) {
    XcdBarrier b; b.bar = bar; b.x = xb_xcc_id(); b.st = st;
    if (threadIdx.x == 0) (void)xb_add(&bar[XB_XCNT(b.x)], 1u);
    return b;
}
__device__ __forceinline__ void xcd_barrier_complete(unsigned* bar, unsigned x, unsigned& nloc, unsigned& nx) {
    const unsigned G = gridDim.x * gridDim.y * gridDim.z;
    unsigned sum, cnt, mine, sp = 0u;
    for (;;) {
        sum = 0u; cnt = 0u; mine = 0u;
#pragma unroll
        for (unsigned j = 0; j < 16; ++j) { const unsigned c = xb_ld(&bar[XB_XCNT(j)]); sum += c; cnt += (c > 0u) ? 1u : 0u; mine = (j == x) ? c : mine; }
        if (sum == G) break;
        __builtin_amdgcn_s_sleep(1);
        if ((++sp & 255u) == 0u) { if (xb_ld(&bar[XB_TMO])) break; if (sp > XB_SPIN_CAP) { atomicAdd(&bar[XB_TMO], 1u); break; } }
    }
    nloc = mine > 0u ? mine : 1u; nx = cnt > 0u ? cnt : 1u;
}
__device__ __forceinline__ void xcd_barrier(const XcdBarrier& b) {
    asm volatile("s_waitcnt vmcnt(0)" ::: "memory");
    __syncthreads();
    if (threadIdx.x == 0) {
        unsigned* bar = b.bar;
        __builtin_amdgcn_s_waitcnt(0);
        unsigned nloc = b.st[0], nx = b.st[1];
        if (nloc == 0u) { xcd_barrier_complete(bar, b.x, nloc, nx); b.st[0] = nloc; b.st[1] = nx; }
        const unsigned old = xb_add(&bar[XB_XSUB(b.x)], 1u);
        const unsigned gen = old / nloc;
        if (old + 1u == (gen + 1u) * nloc) {
            __builtin_amdgcn_fence(__ATOMIC_RELEASE, "agent");
            asm volatile("s_waitcnt vmcnt(0)" ::: "memory");
            const unsigned og = xb_add(&bar[XB_TOP], 1u);
            const unsigned tg = og / nx;
            if (og + 1u == (tg + 1u) * nx) xb_add(&bar[XB_TOPGEN], 1u);
            else XB_SPIN(xb_ld(&bar[XB_TOPGEN]) == tg, bar);
            __builtin_amdgcn_fence(__ATOMIC_ACQUIRE, "agent");
            xb_add(&bar[XB_XGEN(b.x)], 1u);
            asm volatile("s_waitcnt vmcnt(0)" ::: "memory");
        } else {
            XB_SPIN(xb_ld(&bar[XB_XGEN(b.x)]) == gen, bar);
            __builtin_amdgcn_fence(__ATOMIC_ACQUIRE, "agent");
            asm volatile("s_waitcnt vmcnt(0)" ::: "memory");
        }
    }
    __syncthreads();
}

#ifndef MK_PH
#define MK_PH 0x7ff
#endif
#ifndef MK_REP
#define MK_REP 0
#endif
#define REPS(k) for (int rep_ = 0; rep_ < (((MK_REP >> (k)) & 1) ? 2 : 1); ++rep_)
extern __shared__ __attribute__((aligned(16))) unsigned char smem_dyn[];

__device__ __forceinline__ void moe_tables(const Params& P, LAS int* tb, LAS int* cn) {
    const unsigned* cnt = (const unsigned*)(P.ws + WS_CNT);
    if (threadIdx.x < 32) cn[threadIdx.x] = (int)cnt[threadIdx.x * 64];
    __syncthreads();
    if (threadIdx.x == 0) { int acc = 0; for (int e = 0; e < 32; ++e) { tb[e] = acc; acc += (cn[e] + 255) >> 8; } tb[32] = acc; }
    __syncthreads();
}

__global__ void __launch_bounds__(512, 2) hymba_fwd(Params P) {
    unsigned char* sm = smem_dyn;
    LAS unsigned char* lsm = (LAS unsigned char*)smem_dyn;
    volatile LAS unsigned* xbw = (volatile LAS unsigned*)(lsm + LDS_BYTES - 16);
    if (threadIdx.x == 0) { xbw[0] = 0u; xbw[1] = 0u; xbw[2] = 0u; xbw[3] = 0u; }
    __syncthreads();
    XcdBarrier bar = xcd_barrier_post((unsigned*)(P.ws + WS_BAR), xbw);
    using namespace pg8;

#if (MK_PH >> 0) & 1
    REPS(15) phase0_mod(P, sm); REPS(0) { phase0_weights(P, sm); phase0_wf(P, sm); }
    xcd_barrier(bar);
#endif
#if (MK_PH >> 1) & 1
    REPS(1) phase1_prep(P, sm);
    xcd_barrier(bar);
#endif
#if (MK_PH >> 2) & 1
    REPS(2) {
    { ProbInproj G; G.init(MROWS / 256, 8, gridDim.x, blockIdx.x); G.A = (const bf16_t*)(P.ws + WS_R4 + R4_H); G.Bt = (const bf16_t*)(P.ws + WS_WQKVZ); G.K = 1024;
      EpiInproj E; E.O = (bf16_t*)(P.ws + WS_R4 + R4_P); E.zs = (bf16_t*)((unsigned char*)P.out + DO_ZS); gemm_phase(lsm, G, E); }
    { ProbGT G; G.init(4, NTOK / 256, gridDim.x, blockIdx.x); G.A = (const bf16_t*)(P.ws + WS_WF); G.Bt = (const bf16_t*)(P.ws + WS_R4 + R4_H); G.K = 1024;
      EpiStoreBf16 E; E.O = (bf16_t*)((unsigned char*)P.out + DO_GT); E.ldc = NTOK; gemm_phase(lsm, G, E); }
    }
    xcd_barrier(bar);
#endif
#if (MK_PH >> 3) & 1
    REPS(3) phase3_conv(P, sm);
    xcd_barrier(bar);
#endif
#if (MK_PH >> 4) & 1
    REPS(4) phase4_prepass(P, sm);
    REPS(11) phase4_fft(P, sm);
    xcd_barrier(bar);
#endif
#if (MK_PH >> 5) & 1
    REPS(5) phase5_scan(P, sm);
    xcd_barrier(bar);
#endif
#if (MK_PH >> 6) & 1
    REPS(6) phase6_amix(P, sm);
    xcd_barrier(bar);
#endif
#if (MK_PH >> 7) & 1
    REPS(7)
    { ProbOut G; G.init(NTOK / 256, 4, gridDim.x, blockIdx.x); G.A = (const bf16_t*)(P.ws + WS_R4 + R4_AMIX); G.Bt = (const bf16_t*)(P.ws + WS_WOUT); G.K = 1024;
      EpiResid E; E.x = P.x; E.mod = (const float*)(P.ws + WS_MOD); E.out = P.out; gemm_phase(lsm, G, E); }
    xcd_barrier(bar);
#endif
#if (MK_PH >> 8) & 1
#if (MK_REP >> 13) & 1
    phase8_router(P, sm, 1);
#endif
    phase8_router(P, sm, 0);
#if (MK_REP >> 14) & 1
    xcd_barrier(bar); xcd_barrier(bar); xcd_barrier(bar); xcd_barrier(bar);
#endif
    xcd_barrier(bar);
#endif
#if (MK_PH >> 9) & 1
    LAS int* tb = (LAS int*)(lsm + STAGE_BYTES); LAS int* cn = tb + 64;
    moe_tables(P, tb, cn);
    REPS(9)
    { ProbMoe1 G; G.tb = tb; G.cnt = cn; G.G = gridDim.x; G.c = blockIdx.x; G.A = (const bf16_t*)(P.ws + WS_R4 + R4_H2); G.Bt = (const bf16_t*)(P.ws + WS_WGU); G.K = 1024; G.tokk = (const unsigned*)(P.ws + WS_TOKK);
      EpiMoe1 E; E.hid = (bf16_t*)(P.ws + WS_R4 + R4_HID); gemm_phase(lsm, G, E); }
    xcd_barrier(bar);
    REPS(10)
    { ProbMoe2 G; G.tb = tb; G.cnt = cn; G.G = gridDim.x; G.c = blockIdx.x; G.A = (const bf16_t*)(P.ws + WS_R4 + R4_HID); G.Bt = (const bf16_t*)(P.ws + WS_WD); G.K = 512;
      EpiMoe2 E; E.Y = (bf16_t*)(P.ws + WS_R4 + R4_Y); E.tokk = (const unsigned*)(P.ws + WS_TOKK); E.wl = (const float*)(P.ws + WS_WL); E.tb = tb; gemm_phase(lsm, G, E); }
    xcd_barrier(bar);
#endif
#if (MK_PH >> 10) & 1
#if (MK_REP >> 12) & 1
    phase11_final(P, sm, (float*)(P.ws + WS_R4 + 300 * MiB));
#endif
    phase11_final(P, sm, P.out);
#endif
}

extern "C" void kernel_launch(void* const* d_in, const int* in_sizes, int n_in, void* d_out, int out_size, void* d_ws, size_t ws_size, hipStream_t stream) {
    (void)in_sizes; (void)n_in; (void)out_size;
    static int grid = 0;
    if (!grid) {
        int dev = 0, cus = 0, per_cu = 0;
        hipGetDevice(&dev);
        hipDeviceGetAttribute(&cus, hipDeviceAttributeMultiprocessorCount, dev);
        hipFuncSetAttribute((const void*)hymba_fwd, hipFuncAttributeMaxDynamicSharedMemorySize, LDS_BYTES);
        hipOccupancyMaxActiveBlocksPerMultiprocessor(&per_cu, hymba_fwd, 512, LDS_BYTES);
        if (per_cu < 1) { fprintf(stderr, "occupancy query says 0 blocks per CU\n"); per_cu = 1; }
        grid = cus;
        if (ws_size < WS_NEED) fprintf(stderr, "workspace too small: %zu < %zu\n", ws_size, (size_t)WS_NEED);
    }
    Params p{};
    p.x = (const float*)d_in[0]; p.c = (const float*)d_in[1]; p.ctx = (const float*)d_in[2]; p.c_ctx = (const float*)d_in[3]; p.w_mod = (const float*)d_in[4]; p.b_mod = (const float*)d_in[5];
    p.norm1_g = (const float*)d_in[6]; p.w_in = (const float*)d_in[7]; p.conv_w = (const float*)d_in[8]; p.a_log = (const float*)d_in[9]; p.dt_bias = (const float*)d_in[10]; p.onorm_g = (const float*)d_in[11];
    p.w_out = (const float*)d_in[12]; p.norm2_g = (const float*)d_in[13]; p.w_group = (const float*)d_in[14]; p.b_group = (const float*)d_in[15]; p.w_router = (const float*)d_in[16]; p.b_router = (const float*)d_in[17];
    p.w_gate = (const float*)d_in[18]; p.w_up = (const float*)d_in[19]; p.w_down = (const float*)d_in[20]; p.final_g = (const float*)d_in[21];
    p.out = (float*)d_out; p.ws = (unsigned char*)d_ws;
    hipMemsetAsync(d_ws, 0, WS_ZERO_BYTES, stream);
    hipLaunchKernelGGL(hymba_fwd, dim3(grid), dim3(512), LDS_BYTES, stream, p);
}
#endif
```

```cpp
#ifndef CPU_EMU
#include <hip/hip_runtime.h>
#include <cstdio>
#include <cstdint>
#define DEV __device__ __forceinline__
#define TID tid_local
#define PHASE_TID int tid_local = (int)threadIdx.x; asm volatile("" : "+v"(tid_local))
#define BID ((int)blockIdx.x)
#define NBLK ((int)gridDim.x)
#define SYNC() __syncthreads()
#define SCHED_FENCE() __builtin_amdgcn_sched_barrier(0)
#endif

typedef unsigned short bf16_t;
typedef short bf16x8 __attribute__((ext_vector_type(8)));
typedef float f32x4 __attribute__((ext_vector_type(4)));
typedef unsigned u32x4 __attribute__((ext_vector_type(4)));
typedef unsigned u32x2 __attribute__((ext_vector_type(2)));

constexpr int D = 1024, NB = 8, SEQ = 8192, CTX = 256;
constexpr int NTOK = NB * SEQ;
constexpr int NCTX = NB * CTX;
constexpr int MROWS = NTOK + NCTX;
constexpr int W_IN = 2576;
constexpr int NSTEP = 4 + 128;
constexpr int NCHAIN = NB * 4 * 2;
constexpr int NPROB = NCHAIN * NSTEP;
constexpr float EPS = 1e-6f;
constexpr int NEXP = 32;
constexpr int LCAP = 65536;

constexpr int IMG_W = 0, IMG_KT = 16384, IMG_Q = 32768, IMG_A = 49152, IMG_U = 57344, IMG_SC = 73728, IMG_BYTES = 73792;

constexpr size_t MiB = 1048576;
constexpr size_t WS_BAR = 0;
constexpr size_t WS_MOD = 16384;
constexpr size_t WS_CNT = 16384 + 221184;
constexpr size_t WS_ZERO_BYTES = WS_CNT + 16384;
constexpr size_t WS_TAB = 262144;
constexpr size_t WS_BIAS = 393216;
constexpr size_t WS_RSTD = 5 * MiB + 524288;
constexpr size_t WS_GB = 1 * MiB;
constexpr size_t WS_TOKK = 6 * MiB;
constexpr size_t WS_WL = 14 * MiB;
constexpr size_t WS_W = 22 * MiB;
constexpr size_t WS_WQKVZ = WS_W;
constexpr size_t WS_WF = WS_WQKVZ + 2048ull * 1024 * 2;
constexpr size_t WS_WOUT = WS_WF + 1024ull * 1024 * 2;
constexpr size_t WS_WGU = WS_WOUT + 1024ull * 1024 * 2;
constexpr size_t WS_WD = WS_WGU + 32ull * 1024 * 1024 * 2;
constexpr size_t WS_R3 = 126 * MiB;
constexpr size_t WS_R4 = 324 * MiB;
constexpr size_t WS_NEED = WS_R4 + 645 * MiB;
constexpr size_t R4_H = 0, R4_P = 132 * MiB;
constexpr size_t R4_AMIX = 0, R4_H2 = 128 * MiB, R4_HID = 256 * MiB, R4_Y = 0;
constexpr size_t DO_GT = 0, DO_ZT = 128 * MiB, DO_ZS = 192 * MiB;

constexpr int LDS_BYTES = 163840;

struct Params {
    const float *x, *c, *ctx, *c_ctx, *w_mod, *b_mod, *norm1_g, *w_in, *conv_w, *a_log, *dt_bias, *onorm_g, *w_out, *norm2_g,
                *w_group, *b_group, *w_router, *b_router, *w_gate, *w_up, *w_down, *final_g;
    float* out;
    unsigned char* ws;
};

DEV bf16_t f2bf(float f) { unsigned u = __builtin_bit_cast(unsigned, f); u += 0x7FFFu + ((u >> 16) & 1u); return (bf16_t)(u >> 16); }
DEV float bf2f(bf16_t b) { return __builtin_bit_cast(float, ((unsigned)b) << 16); }
#ifndef CPU_EMU
typedef __bf16 bf16n2 __attribute__((ext_vector_type(2)));
DEV unsigned pk2(float lo, float hi) { bf16n2 v; v[0] = (__bf16)lo; v[1] = (__bf16)hi; return __builtin_bit_cast(unsigned, v); }
DEV float rcp_f(float x) { return __builtin_amdgcn_rcpf(x); }
DEV float rsq_f(float x) { return __builtin_amdgcn_rsqf(x); }
#else
DEV unsigned pk2(float lo, float hi) { return (unsigned)f2bf(lo) | ((unsigned)f2bf(hi) << 16); }
DEV float rcp_f(float x) { return 1.0f / x; }
DEV float rsq_f(float x) { return 1.0f / sqrtf(x); }
#endif
DEV float silu_f(float v) { return v * rcp_f(1.0f + __expf(-v)); }

#ifndef CPU_EMU
DEV f32x4 mfma16(bf16x8 a, bf16x8 b, f32x4 c) { return __builtin_amdgcn_mfma_f32_16x16x32_bf16(a, b, c, 0, 0, 0); }
DEV float shfl_xor_f(float v, int m) { return __shfl_xor(v, m); }
DEV float shfl_up_f(float v, int d) { return __shfl_up(v, d); }
DEV float shfl_idx_f(float v, int l) { return __shfl(v, l); }
DEV void atomic_add_f32(float* p, float v) { atomicAdd(p, v); }
DEV unsigned atomic_add_u32(unsigned* p, unsigned v) { return atomicAdd(p, v); }
DEV void sincospi_f(float x, float* s, float* c) { sincospif(x, s, c); }
#endif

DEV float wave_sum(float v) {
#pragma unroll
    for (int o = 32; o >= 1; o >>= 1) v += shfl_xor_f(v, o);
    return v;
}
template <int N> DEV float wave_sum_multi(const float (&v)[N], int lane) {
    float a[N];
#pragma unroll
    for (int i = 0; i < N; ++i) a[i] = v[i];
    int m = 1;
#pragma unroll
    for (int n = N; n > 1; n >>= 1, m <<= 1) {
        const bool up = (lane & m) != 0;
#pragma unroll
        for (int i = 0; i < n / 2; ++i) { const float keep = up ? a[2 * i + 1] : a[2 * i], send = up ? a[2 * i] : a[2 * i + 1]; a[i] = keep + shfl_xor_f(send, m); }
    }
    float r = a[0];
#pragma unroll
    for (int o = N; o < 64; o <<= 1) r += shfl_xor_f(r, o);
    return r;
}
#ifndef CPU_EMU
DEV float lane_bcast(float v, int l) { return __builtin_bit_cast(float, __builtin_amdgcn_readlane(__builtin_bit_cast(int, v), l)); }
#endif
DEV bf16x8 frag_gather(const bf16_t* p, int stride) {
    bf16x8 r;
#pragma unroll
    for (int j = 0; j < 8; ++j) r[j] = (short)p[j * stride];
    return r;
}
DEV bf16x8 frag16(const bf16_t* p) { return *(const bf16x8*)p; }

DEV void phase0_mod(const Params& P, unsigned char* sm) {
    PHASE_TID;
    float* sil = (float*)sm;
    float* red = (float*)(sm + 36864);
    for (int i = TID; i < 9 * 1024; i += 512) { const int r = i >> 10, k = i & 1023; const float v = r < 8 ? P.c[r * 1024 + k] : P.c_ctx[k]; sil[i] = silu_f(v); }
    SYNC();
    float* mod = (float*)(P.ws + WS_MOD);
    for (int cb = BID; cb < 256; cb += NBLK) {
        const int c = TID % 24, kg = TID / 24, j0 = cb * 24;
        if (kg < 21) {
            float acc[9];
#pragma unroll
            for (int r = 0; r < 9; ++r) acc[r] = 0.f;
#pragma unroll 7
            for (int k = kg; k < 1024; k += 21) { const float w = P.w_mod[(size_t)k * 6144 + j0 + c];
#pragma unroll
                for (int r = 0; r < 9; ++r) acc[r] += sil[r * 1024 + k] * w; }
#pragma unroll
            for (int r = 0; r < 9; ++r) red[(kg * 24 + c) * 9 + r] = acc[r];
        }
        SYNC();
        if (TID < 24 * 9) { const int cc = TID / 9, r = TID - cc * 9; float t = P.b_mod[j0 + cc];
            for (int g = 0; g < 21; ++g) t += red[(g * 24 + cc) * 9 + r];
            mod[r * 6144 + j0 + cc] = t; }
        SYNC();
    }
}

DEV void tconv_tile(const float* src, int lds_, bf16_t* dst, int ldd, int inter, unsigned char* sm) {
    PHASE_TID;
    float* tile = (float*)sm;
    f32x4 v[8];
#pragma unroll
    for (int q = 0; q < 8; ++q) v[q] = *(const f32x4*)(src + (size_t)((TID >> 6) + q * 8) * lds_ + (TID & 63) * 4);
#pragma unroll
    for (int q = 0; q < 8; ++q) { float* t = tile + ((TID >> 6) + q * 8) * 257 + (TID & 63) * 4; t[0] = v[q][0]; t[1] = v[q][1]; t[2] = v[q][2]; t[3] = v[q][3]; }
    SYNC();
    const int c = TID & 255, half = TID >> 8;
    const int drow = inter ? ((c >> 7) * 256 + (inter - 1) * 128 + (c & 127)) : c;
    u32x4 w[4];
#pragma unroll
    for (int q = 0; q < 4; ++q)
#pragma unroll
        for (int j = 0; j < 4; ++j) w[q][j] = pk2(tile[(half * 32 + q * 8 + 2 * j) * 257 + c], tile[(half * 32 + q * 8 + 2 * j + 1) * 257 + c]);
#pragma unroll
    for (int q = 0; q < 4; ++q) *(u32x4*)(dst + (size_t)drow * ldd + half * 32 + q * 8) = w[q];
    SYNC();
}

DEV void phase0_weights(const Params& P, unsigned char* sm) {
    bf16_t* wqkvz = (bf16_t*)(P.ws + WS_WQKVZ); bf16_t* wout = (bf16_t*)(P.ws + WS_WOUT); bf16_t* wgu = (bf16_t*)(P.ws + WS_WGU); bf16_t* wd = (bf16_t*)(P.ws + WS_WD);
    const int NJ = 128 + 64 + 3 * 1024;
    for (int t = BID; t < NJ; t += NBLK) {
        if (t < 128) { const int kt = t >> 3, nt = t & 7;
            tconv_tile(P.w_in + (size_t)(kt * 64) * W_IN + 512 + nt * 256, W_IN, wqkvz + (size_t)(nt * 256) * 1024 + kt * 64, 1024, 0, sm);
        } else if (t < 192) { const int u = t - 128, kt = u >> 2, nt = u & 3;
            tconv_tile(P.w_out + (size_t)(kt * 64) * 1024 + nt * 256, 1024, wout + (size_t)(nt * 256) * 1024 + kt * 64, 1024, 0, sm);
        } else if (t < 192 + 2048) { const int u = t - 192, up = u >> 10, v = u & 1023, e = v >> 5, w = v & 31, kt = w >> 1, nt = w & 1;
            const float* src = (up ? P.w_up : P.w_gate) + (size_t)e * 1024 * 512 + (size_t)(kt * 64) * 512 + nt * 256;
            tconv_tile(src, 512, wgu + (size_t)e * 1024 * 1024 + (size_t)(nt * 512) * 1024 + kt * 64, 1024, 1 + up, sm);
        } else { const int v = t - 192 - 2048, e = v >> 5, w = v & 31, kt = w >> 2, nt = w & 3;
            tconv_tile(P.w_down + (size_t)e * 512 * 1024 + (size_t)(kt * 64) * 1024 + nt * 256, 1024, wd + (size_t)e * 1024 * 512 + (size_t)(nt * 256) * 512 + kt * 64, 512, 0, sm);
        }
    }
}

DEV void phase0_wf(const Params& P, unsigned char* sm) {
    PHASE_TID;
    float* cs = (float*)sm;
    if (TID < 128) { float s, c; sincospi_f((float)TID * (2.0f / 128.0f), &s, &c); cs[TID] = c; cs[128 + TID] = s; }
    SYNC();
    bf16_t* wf = (bf16_t*)(P.ws + WS_WF);
    const float sc = 0.08838834764831845f;
    for (int it = BID; it < 256; it += NBLK) {
        const int kb = it & 1, cb = (it >> 1) & 15, part = (it >> 5) & 1, g = it >> 6;
        const int k = kb * 512 + TID;
        const float* wrow = P.w_in + (size_t)k * W_IN + g * 128;
        float acc[8];
#pragma unroll
        for (int q = 0; q < 8; ++q) acc[q] = 0.f;
#pragma unroll 8
        for (int c4 = 0; c4 < 32; ++c4) { const f32x4 w4 = *(const f32x4*)(wrow + c4 * 4);
#pragma unroll
            for (int e = 0; e < 4; ++e) { const int c = c4 * 4 + e;
#pragma unroll
                for (int q = 0; q < 8; ++q) { const int cp = cb * 8 + q; acc[q] += w4[e] * cs[part * 128 + ((c * cp) & 127)]; } } }
#pragma unroll
        for (int q = 0; q < 8; ++q) { const int chc = part * 512 + g * 128 + cb * 8 + q; wf[(size_t)chc * 1024 + k] = f2bf((part ? -acc[q] : acc[q]) * sc); }
    }
    bf16_t* tab = (bf16_t*)(P.ws + WS_TAB);
    const float sc2 = 0.011048543456039806f;
    for (int i = BID * 512 + TID; i < 4096 + 16384; i += NBLK * 512) {
        if (i < 4096) { const int a = i >> 6, b = i & 63; float s, c; sincospi_f((float)((a * b) & 63) * (2.0f / 64.0f), &s, &c); tab[i] = f2bf(c); tab[4096 + i] = f2bf(s); }
        else { const int j = i - 4096, a = j >> 7, b = j & 127; float s, c; sincospi_f((float)((a * b) & 127) * (2.0f / 128.0f), &s, &c); tab[8192 + j] = f2bf(c * sc2); tab[8192 + 16384 + j] = f2bf(s * sc2); }
    }
}

DEV void phase1_prep(const Params& P, unsigned char* sm) {
    PHASE_TID;
    bf16_t* Bhi = (bf16_t*)sm; bf16_t* Blo = (bf16_t*)(sm + 33024);
    float* gsv = (float*)(sm + 66048);
    float* gbl = (float*)(sm + 70144);
    {
        f32x4 w[2][4];
#pragma unroll
        for (int h = 0; h < 2; ++h)
#pragma unroll
            for (int q = 0; q < 4; ++q) w[h][q] = *(const f32x4*)(P.w_in + (size_t)(TID + h * 512) * W_IN + 2560 + q * 4);
#pragma unroll
        for (int h = 0; h < 2; ++h)
#pragma unroll
            for (int q = 0; q < 4; ++q)
#pragma unroll
                for (int e = 0; e < 4; ++e) { const int n = q * 4 + e, k = TID + h * 512; const float v = w[h][q][e]; const bf16_t hi = f2bf(v); Bhi[n * 1032 + k] = hi; Blo[n * 1032 + k] = f2bf(v - bf2f(hi)); }
    }
    const float* mod = (const float*)(P.ws + WS_MOD);
    bf16_t* h = (bf16_t*)(P.ws + WS_R4 + R4_H);
    float* gb = (float*)(P.ws + WS_GB);
    float* rstd_arr = (float*)(P.ws + WS_RSTD);
    float* bias = (float*)(P.ws + WS_BIAS);
    const int wid = TID >> 6, lane = TID & 63, fr = lane & 15, fq = lane >> 4;
    SYNC();
    const float* shrow = mod + (fr < 8 ? fr : 8) * 6144 + fq * 8;
    if (TID < 256) gbl[TID] = 0.f;
    SYNC();
    {
        f32x4 acc = (f32x4){0.f, 0.f, 0.f, 0.f};
#pragma unroll
        for (int k4 = 0; k4 < 4; ++k4) {
            const int ks = wid * 4 + k4;
            const f32x4 a0 = *(const f32x4*)(shrow + ks * 32), a1 = *(const f32x4*)(shrow + ks * 32 + 4);
            const float hv[8] = {a0[0], a0[1], a0[2], a0[3], a1[0], a1[1], a1[2], a1[3]};
            u32x4 whi, wlo;
#pragma unroll
            for (int e = 0; e < 4; ++e) { whi[e] = pk2(hv[2 * e], hv[2 * e + 1]); wlo[e] = pk2(hv[2 * e] - __builtin_bit_cast(float, whi[e] << 16), hv[2 * e + 1] - __builtin_bit_cast(float, whi[e] & 0xffff0000u)); }
            const bf16x8 ahi = __builtin_bit_cast(bf16x8, whi), alo = __builtin_bit_cast(bf16x8, wlo);
            const bf16x8 bhi = frag16(Bhi + fr * 1032 + ks * 32 + fq * 8), blo = frag16(Blo + fr * 1032 + ks * 32 + fq * 8);
            acc = mfma16(ahi, bhi, acc); acc = mfma16(alo, bhi, acc); acc = mfma16(ahi, blo, acc);
        }
#pragma unroll
        for (int r = 0; r < 4; ++r) atomic_add_f32(&gbl[(fq * 4 + r) * 16 + fr], acc[r]);
    }
    {
        const bf16_t* wq = (const bf16_t*)(P.ws + WS_WQKVZ); const bf16_t* wf = (const bf16_t*)(P.ws + WS_WF);
        for (int it = BID * 8 + wid; it < 192; it += NBLK * 8) {
            const int n0 = it * 16;
            const bf16_t* wrow = (n0 < 2048 ? wq + (size_t)(n0 + fr) * 1024 : wf + (size_t)(n0 - 2048 + fr) * 1024) + fq * 8;
            f32x4 acc = (f32x4){0.f, 0.f, 0.f, 0.f};
#pragma unroll 4
            for (int ks = 0; ks < 32; ++ks) {
                const f32x4 a0 = *(const f32x4*)(shrow + ks * 32), a1 = *(const f32x4*)(shrow + ks * 32 + 4);
                const float hv[8] = {a0[0], a0[1], a0[2], a0[3], a1[0], a1[1], a1[2], a1[3]};
                u32x4 whi, wlo;
#pragma unroll
                for (int e = 0; e < 4; ++e) { whi[e] = pk2(hv[2 * e], hv[2 * e + 1]); wlo[e] = pk2(hv[2 * e] - __builtin_bit_cast(float, whi[e] << 16), hv[2 * e + 1] - __builtin_bit_cast(float, whi[e] & 0xffff0000u)); }
                const bf16x8 bw = frag16(wrow + ks * 32);
                acc = mfma16(__builtin_bit_cast(bf16x8, whi), bw, acc); acc = mfma16(__builtin_bit_cast(bf16x8, wlo), bw, acc);
            }
#pragma unroll
            for (int r = 0; r < 4; ++r) { const int mbr = fq * 4 + r; if (mbr < 9) bias[mbr * 3072 + n0 + fr] = acc[r]; }
        }
    }
    for (int t = BID; t < MROWS / 128; t += NBLK) {
        const int r0 = t * 128 + wid * 16, mb = (t * 128 < NTOK) ? ((t * 128) >> 13) : 8;
        SYNC();
        { const float* scale = mod + mb * 6144 + 1024;
#pragma unroll
          for (int q = 0; q < 2; ++q) { const int k = TID + q * 512; gsv[k] = P.norm1_g[k] * (1.0f + scale[k]); } }
        SYNC();
        const int rr = r0 + fr;
        const float* src = (rr < NTOK ? P.x + (size_t)rr * D : P.ctx + (size_t)(rr - NTOK) * D) + fq * 8;
        float ss = 0.f;
        f32x4 acc = (f32x4){0.f, 0.f, 0.f, 0.f};
        bf16_t* hrow = h + (size_t)rr * D + fq * 8;
#pragma unroll 8
        for (int ks = 0; ks < 32; ++ks) {
            const f32x4 a0 = *(const f32x4*)(src + ks * 32), a1 = *(const f32x4*)(src + ks * 32 + 4);
            ss += a0[0] * a0[0] + a0[1] * a0[1] + a0[2] * a0[2] + a0[3] * a0[3] + a1[0] * a1[0] + a1[1] * a1[1] + a1[2] * a1[2] + a1[3] * a1[3];
            const f32x4 g0 = *(const f32x4*)(gsv + ks * 32 + fq * 8), g1 = *(const f32x4*)(gsv + ks * 32 + fq * 8 + 4);
            float hv[8];
#pragma unroll
            for (int e = 0; e < 4; ++e) { hv[e] = a0[e] * g0[e]; hv[4 + e] = a1[e] * g1[e]; }
            u32x4 whi, wlo;
#pragma unroll
            for (int e = 0; e < 4; ++e) { whi[e] = pk2(hv[2 * e], hv[2 * e + 1]); wlo[e] = pk2(hv[2 * e] - __builtin_bit_cast(float, whi[e] << 16), hv[2 * e + 1] - __builtin_bit_cast(float, whi[e] & 0xffff0000u)); }
            *(u32x4*)(hrow + ks * 32) = whi;
            const bf16x8 ahi = __builtin_bit_cast(bf16x8, whi), alo = __builtin_bit_cast(bf16x8, wlo);
            const bf16x8 bhi = frag16(Bhi + fr * 1032 + ks * 32 + fq * 8), blo = frag16(Blo + fr * 1032 + ks * 32 + fq * 8);
            acc = mfma16(ahi, bhi, acc); acc = mfma16(alo, bhi, acc); acc = mfma16(ahi, blo, acc);
        }
        ss += shfl_xor_f(ss, 16); ss += shfl_xor_f(ss, 32);
        const float rstd = rsq_f(ss * (1.0f / 1024.0f) + EPS);
        if (fq == 0) rstd_arr[rr] = rstd;
        float ea = 0.f, db = 0.f;
        if (fr >= 8) { ea = -__expf(P.a_log[fr - 8]); db = P.dt_bias[fr - 8]; }
        const float gbias = gbl[mb * 16 + fr];
#pragma unroll
        for (int reg = 0; reg < 4; ++reg) { const float v = acc[reg] * shfl_idx_f(rstd, fq * 4 + reg) + gbias; float o;
            if (fr < 8) o = rcp_f(1.0f + __expf(-v));
            else { const float z = v + db; const float sp = z > 20.f ? z : log1pf(__expf(z)); o = ea * sp; }
            gb[(size_t)(r0 + fq * 4 + reg) * 16 + fr] = o; }
    }
}

#ifndef CPU_EMU
namespace pg8 {
#define PG8_LAS __attribute__((address_space(3)))
constexpr int BM = 256, BK = 64, HALF = 128, HTB = HALF * BK * 2, STAGE_BYTES = 8 * HTB;
__device__ __forceinline__ int lds_byte(int r, int c) { const int st = (r >> 4) * 2 + (c >> 5), rr = r & 15, cc = c & 31, ob = rr * 64 + cc * 2; return st * 1024 + (ob ^ (((ob >> 9) & 1) << 5)); }
__device__ __forceinline__ void stage_rc(int b, int& R, int& C) { const int st = b / 1024, sb = b % 1024, swz = sb ^ (((sb >> 9) & 1) << 5); R = (st >> 1) * 16 + swz / 64; C = (st & 1) * 32 + (swz % 64) / 2; }
__device__ __forceinline__ int perm32(int rho) { const int n = rho >> 4, i = rho & 15; return 8 * (i >> 2) + 4 * n + (i & 3); }
struct Unit { int pm, pn, e, cnt; };
__device__ __forceinline__ unsigned cvt_pk_bf16(float lo, float hi) { unsigned r; asm volatile("v_cvt_pk_bf16_f32 %0, %1, %2" : "=v"(r) : "v"(lo), "v"(hi)); return r; }

template <class Prob, class Epi>
__device__ __forceinline__ void gemm_phase(PG8_LAS unsigned char* lds, const Prob& G, const Epi& E) {
    int tid_ = threadIdx.x; asm volatile("" : "+v"(tid_));
    const int tid = tid_, wid = __builtin_amdgcn_readfirstlane(tid >> 6), lane = tid & 63, wr = wid >> 2, wc = wid & 3, fr = lane & 15, fq = lane >> 4;
    const int K = G.K, nt = K / BK;
    int R0, C0; stage_rc(tid * 16, R0, C0);
    const int rA0 = R0, rA1 = R0 + 64;
    const int rB0 = Epi::PERM ? ((R0 & ~31) + perm32(R0 & 31)) : R0, rB1 = Epi::PERM ? (((R0 + 64) & ~31) + perm32((R0 + 64) & 31)) : R0 + 64;
    const unsigned ldsw = (unsigned)wid * 1024u;
    const int aoff = lds_byte(wr * 64 + fr, fq * 8), boff = lds_byte(wc * 32 + fr, fq * 8);
    const char* Ab = (const char*)G.A; const char* Bb = (const char*)G.Bt;
#define PG8_SA(b, h) (((b) * 2 + (h)) * HTB)
#define PG8_SB(b, h) ((4 + (b) * 2 + (h)) * HTB)
#define PG8_STAGE(bufoff, gbase, ub, l0, l1) do { \
        __builtin_amdgcn_global_load_lds((const unsigned*)((gbase) + (size_t)(ub) + (l0)), (PG8_LAS unsigned*)(lds + (bufoff) + ldsw), 16, 0, 0); \
        __builtin_amdgcn_global_load_lds((const unsigned*)((gbase) + (size_t)(ub) + (l1)), (PG8_LAS unsigned*)(lds + (bufoff) + ldsw + 8192), 16, 0, 0); } while (0)
#define PG8_LDA(dst, b, h) do { _Pragma("unroll") for (int m = 0; m < 4; ++m) _Pragma("unroll") for (int k = 0; k < 2; ++k) dst[m][k] = *(const PG8_LAS bf16x8*)(lds + PG8_SA(b, h) + aoff + m * 2048 + k * 1024); } while (0)
#define PG8_LDB(dst, b, h) do { _Pragma("unroll") for (int n = 0; n < 2; ++n) _Pragma("unroll") for (int k = 0; k < 2; ++k) dst[n][k] = *(const PG8_LAS bf16x8*)(lds + PG8_SB(b, h) + boff + n * 2048 + k * 1024); } while (0)
#define PG8_MMA(ai, bj, At, Bt) do { __builtin_amdgcn_s_setprio(1); _Pragma("unroll") for (int m = 0; m < 4; ++m) _Pragma("unroll") for (int n = 0; n < 2; ++n) _Pragma("unroll") for (int k = 0; k < 2; ++k) \
        acc[ai][bj][m][n] = __builtin_amdgcn_mfma_f32_16x16x32_bf16(Bt[n][k], At[m][k], acc[ai][bj][m][n], 0, 0, 0); __builtin_amdgcn_s_setprio(0); } while (0)
#define PG8_WAIT_V(n) asm volatile("s_waitcnt vmcnt(" #n ")" ::: "memory")
#define PG8_WAIT_L(n) asm volatile("s_waitcnt lgkmcnt(" #n ")" ::: "memory")
#define PG8_BAR __builtin_amdgcn_s_barrier()
#define PG8_SCHED __builtin_amdgcn_sched_barrier(0)
    Unit cur, nxt; int ui = 0;
    if (!G.next(0, cur)) return;
    f32x4 acc[2][2][4][2];
#pragma unroll
    for (int a = 0; a < 2; ++a)
#pragma unroll
        for (int b = 0; b < 2; ++b)
#pragma unroll
            for (int m = 0; m < 4; ++m)
#pragma unroll
                for (int n = 0; n < 2; ++n) acc[a][b][m][n] = (f32x4){0.f, 0.f, 0.f, 0.f};
    bf16x8 At[4][2], B0[2][2], B1[2][2];
    const unsigned cb2 = (unsigned)C0 * 2u;
    const unsigned lB00 = G.laneB(rB0) + cb2, lB01 = G.laneB(rB1) + cb2, lB10 = G.laneB(128 + rB0) + cb2, lB11 = G.laneB(128 + rB1) + cb2;
    const unsigned lA00 = G.laneA(rA0) + cb2, lA01 = G.laneA(rA1) + cb2, lA10 = G.laneA(128 + rA0) + cb2, lA11 = G.laneA(128 + rA1) + cb2;
    unsigned cA00 = lA00, cA01 = lA01, cA10 = lA10, cA11 = lA11, nA00 = lA00, nA01 = lA01, nA10 = lA10, nA11 = lA11;
    if constexpr (Prob::GATHER_A) { cA00 += G.gathA(cur, rA0); cA01 += G.gathA(cur, rA1); cA10 += G.gathA(cur, 128 + rA0); cA11 += G.gathA(cur, 128 + rA1); }
    unsigned uAc = G.baseA(cur), uBc = G.baseB(cur), uAn = uAc, uBn = uBc;
    if constexpr (Epi::PREFETCH) E.prefetch(cur, lds + STAGE_BYTES + 2048, wid, lane);
    PG8_STAGE(PG8_SB(0, 0), Bb, uBc, lB00, lB01); PG8_STAGE(PG8_SA(0, 0), Ab, uAc, cA00, cA01); PG8_STAGE(PG8_SB(0, 1), Bb, uBc, lB10, lB11); PG8_STAGE(PG8_SA(0, 1), Ab, uAc, cA10, cA11);
    if (wr == 1) PG8_BAR;
    PG8_WAIT_V(4); PG8_BAR;
    PG8_STAGE(PG8_SB(1, 0), Bb, uBc + 128u, lB00, lB01); PG8_STAGE(PG8_SA(1, 0), Ab, uAc + 128u, cA00, cA01); PG8_STAGE(PG8_SB(1, 1), Bb, uBc + 128u, lB10, lB11);
    PG8_WAIT_V(6); PG8_BAR;
    for (;;) {
        const bool has_next = G.next(ui + 1, nxt);
        if constexpr (Epi::PREFETCH) { if (has_next) E.prefetch(nxt, lds + STAGE_BYTES + 2048 + ((ui + 1) % 3) * 2048, wid, lane); }
        if (has_next) {
            uAn = G.baseA(nxt); uBn = G.baseB(nxt);
            if constexpr (Prob::GATHER_A) { nA00 = lA00 + G.gathA(nxt, rA0); nA01 = lA01 + G.gathA(nxt, rA1); nA10 = lA10 + G.gathA(nxt, 128 + rA0); nA11 = lA11 + G.gathA(nxt, 128 + rA1); }
        } else { uAn = uAc; uBn = uBc; if constexpr (Prob::GATHER_A) { nA00 = cA00; nA01 = cA01; nA10 = cA10; nA11 = cA11; } }
        for (int t = 0; t < nt; t += 2) {
            const bool last = (t == nt - 2);
            const unsigned k1 = (unsigned)(t + 1) * 128u;
            const unsigned uA2 = last ? uAn : uAc + (unsigned)(t + 2) * 128u, uB2 = last ? uBn : uBc + (unsigned)(t + 2) * 128u, uA3 = uA2 + 128u, uB3 = uB2 + 128u;
            unsigned a00 = cA00, a01 = cA01, a10 = cA10, a11 = cA11;
            if constexpr (Prob::GATHER_A) { a00 = last ? nA00 : cA00; a01 = last ? nA01 : cA01; a10 = last ? nA10 : cA10; a11 = last ? nA11 : cA11; }
            PG8_LDB(B0, 0, 0); PG8_SCHED; PG8_LDA(At, 0, 0); PG8_STAGE(PG8_SA(1, 1), Ab, uAc + k1, cA10, cA11);
            PG8_WAIT_L(8); PG8_BAR; PG8_WAIT_L(0); PG8_MMA(0, 0, At, B0); PG8_BAR; PG8_SCHED;
            PG8_LDB(B1, 0, 1); PG8_STAGE(PG8_SB(0, 0), Bb, uB2, lB00, lB01);
            PG8_BAR; PG8_WAIT_L(0); PG8_MMA(0, 1, At, B1); PG8_BAR;
            PG8_LDA(At, 0, 1); PG8_STAGE(PG8_SA(0, 0), Ab, uA2, a00, a01);
            PG8_BAR; PG8_WAIT_L(0); PG8_MMA(1, 0, At, B0); PG8_BAR; PG8_SCHED;
            PG8_STAGE(PG8_SB(0, 1), Bb, uB2, lB10, lB11);
            PG8_WAIT_V(6); PG8_BAR; PG8_MMA(1, 1, At, B1); PG8_BAR;
            PG8_LDB(B0, 1, 0); PG8_SCHED; PG8_LDA(At, 1, 0); PG8_STAGE(PG8_SA(0, 1), Ab, uA2, a10, a11);
            PG8_WAIT_L(8); PG8_BAR; PG8_WAIT_L(0); PG8_MMA(0, 0, At, B0); PG8_BAR; PG8_SCHED;
            PG8_LDB(B1, 1, 1); PG8_STAGE(PG8_SB(1, 0), Bb, uB3, lB00, lB01);
            PG8_BAR; PG8_WAIT_L(0); PG8_MMA(0, 1, At, B1); PG8_BAR;
            PG8_LDA(At, 1, 1); PG8_STAGE(PG8_SA(1, 0), Ab, uA3, a00, a01);
            PG8_BAR; PG8_WAIT_L(0); PG8_MMA(1, 0, At, B0); PG8_BAR; PG8_SCHED;
            PG8_STAGE(PG8_SB(1, 1), Bb, uB3, lB10, lB11);
            PG8_WAIT_V(6); PG8_BAR; PG8_MMA(1, 1, At, B1); PG8_BAR;
        }
        E(acc, cur, wr, wc, fr, fq, (const PG8_LAS float*)(lds + STAGE_BYTES + 2048 + (ui % 3) * 2048));
        if (!has_next) break;
#pragma unroll
        for (int a = 0; a < 2; ++a)
#pragma unroll
            for (int b = 0; b < 2; ++b)
#pragma unroll
                for (int m = 0; m < 4; ++m)
#pragma unroll
                    for (int n = 0; n < 2; ++n) acc[a][b][m][n] = (f32x4){0.f, 0.f, 0.f, 0.f};
        cur = nxt; ++ui; uAc = uAn; uBc = uBn;
        if constexpr (Prob::GATHER_A) { cA00 = nA00; cA01 = nA01; cA10 = nA10; cA11 = nA11; }
    }
    PG8_WAIT_V(0);
    if (wr == 0) PG8_BAR;
    PG8_BAR;
#undef PG8_SA
#undef PG8_SB
#undef PG8_STAGE
#undef PG8_LDA
#undef PG8_LDB
#undef PG8_MMA
#undef PG8_WAIT_V
#undef PG8_WAIT_L
#undef PG8_BAR
#undef PG8_SCHED
}

struct GridOrder {
    int nM, nN, nwg, G, c;
    __device__ __forceinline__ void init(int nM_, int nN_, int G_, int c_) { nM = nM_; nN = nN_; nwg = nM * nN; G = G_; c = c_; }
    __device__ __forceinline__ bool next(int i, Unit& u) const {
        const long L = (long)i * G + c; if (L >= nwg) return false;
        int wgid = (int)L; { const int q = nwg / 8, r = nwg % 8, xcd = wgid % 8, off = wgid / 8; wgid = (xcd < r ? xcd * (q + 1) : r * (q + 1) + (xcd - r) * q) + off; }
        const int nig = 8 * nN, gid = wgid / nig, fm = gid * 8, gsz = (nM - fm) < 8 ? (nM - fm) : 8;
        u.pm = fm + ((wgid % nig) % gsz); u.pn = (wgid % nig) / gsz; u.e = 0; u.cnt = 256; return true;
    }
};

struct ProbInproj : GridOrder { const bf16_t* A; const bf16_t* Bt; int K; static constexpr bool GATHER_A = false;
    __device__ __forceinline__ unsigned laneA(int r) const { return (unsigned)r * 2048u; }
    __device__ __forceinline__ unsigned laneB(int r) const { return (unsigned)r * 2048u; }
    __device__ __forceinline__ unsigned baseA(const Unit& u) const { return (unsigned)(u.pm * 256) * 2048u; }
    __device__ __forceinline__ unsigned baseB(const Unit& u) const { return (unsigned)(u.pn * 256) * 2048u; }
    __device__ __forceinline__ unsigned gathA(const Unit&, int) const { return 0u; } };
struct ProbGT : GridOrder { const bf16_t* A; const bf16_t* Bt; int K; static constexpr bool GATHER_A = false;
    __device__ __forceinline__ unsigned laneA(int r) const { return (unsigned)r * 2048u; }
    __device__ __forceinline__ unsigned laneB(int r) const { return (unsigned)(128 * (r & 63) + (r >> 6)) * 2048u; }
    __device__ __forceinline__ unsigned baseA(const Unit& u) const { return (unsigned)(u.pm * 256) * 2048u; }
    __device__ __forceinline__ unsigned baseB(const Unit& u) const { const int col = u.pn * 256, b = col >> 13, w = col & 8191; return (unsigned)(b * 8192 + (w >> 6)) * 2048u; }
    __device__ __forceinline__ unsigned gathA(const Unit&, int) const { return 0u; } };
struct EpiStoreBf16 {
    static constexpr bool PERM = true, PREFETCH = false; bf16_t* O; int ldc;
    __device__ __forceinline__ void operator()(const f32x4 (&acc)[2][2][4][2], const Unit& u, int wr, int wc, int fr, int fq, const PG8_LAS float* ex) const {
        const int row0 = u.pm * 256 + wr * 64 + fr, col0 = u.pn * 256 + wc * 32 + 8 * fq;
#pragma unroll
        for (int ai = 0; ai < 2; ++ai)
#pragma unroll
            for (int m = 0; m < 4; ++m) { bf16_t* rowp = O + (size_t)(row0 + ai * 128 + m * 16) * ldc + col0;
#pragma unroll
                for (int bj = 0; bj < 2; ++bj) { const f32x4 v0 = acc[ai][bj][m][0], v1 = acc[ai][bj][m][1];
                    u32x4 w; w.x = cvt_pk_bf16(v0[0], v0[1]); w.y = cvt_pk_bf16(v0[2], v0[3]); w.z = cvt_pk_bf16(v1[0], v1[1]); w.w = cvt_pk_bf16(v1[2], v1[3]);
                    *(u32x4*)(rowp + bj * 128) = w; } }
    }
};
struct EpiGT {
    static constexpr bool PERM = true, PREFETCH = true; bf16_t* O; const float* rstd; const float* bias;
    __device__ __forceinline__ void prefetch(const Unit& u, PG8_LAS unsigned char* ex, int wid, int lane) const {
        const int mb = (u.pn * 256) >> 13;
        if (wid == 0) __builtin_amdgcn_global_load_lds((const unsigned*)(bias + mb * 3072 + 2048 + u.pm * 256 + lane * 4), (PG8_LAS unsigned*)(ex + 1024), 16, 0, 0);
        else if (wid <= 4) { const int c = u.pn * 256 + (wid - 1) * 64 + lane, w = c & 8191;
            __builtin_amdgcn_global_load_lds((const unsigned*)(rstd + mb * 8192 + 128 * (w & 63) + (w >> 6)), (PG8_LAS unsigned*)(ex + (wid - 1) * 256), 4, 0, 0); }
    }
    __device__ __forceinline__ void operator()(const f32x4 (&acc)[2][2][4][2], const Unit& u, int wr, int wc, int fr, int fq, const PG8_LAS float* ex) const {
        const int row0 = u.pm * 256 + wr * 64 + fr, col0 = u.pn * 256 + wc * 32 + 8 * fq;
        float rs[2][8];
#pragma unroll
        for (int bj = 0; bj < 2; ++bj) { const f32x4 r0_ = *(const PG8_LAS f32x4*)(ex + bj * 128 + wc * 32 + 8 * fq), r1_ = *(const PG8_LAS f32x4*)(ex + bj * 128 + wc * 32 + 8 * fq + 4);
            rs[bj][0] = r0_[0]; rs[bj][1] = r0_[1]; rs[bj][2] = r0_[2]; rs[bj][3] = r0_[3]; rs[bj][4] = r1_[0]; rs[bj][5] = r1_[1]; rs[bj][6] = r1_[2]; rs[bj][7] = r1_[3]; }
#pragma unroll
        for (int ai = 0; ai < 2; ++ai)
#pragma unroll
            for (int m = 0; m < 4; ++m) { const int row = row0 + ai * 128 + m * 16; const float bg = ex[256 + wr * 64 + fr + ai * 128 + m * 16]; bf16_t* rowp = O + (size_t)row * NTOK + col0;
#pragma unroll
                for (int bj = 0; bj < 2; ++bj) { const f32x4 a0 = acc[ai][bj][m][0], a1 = acc[ai][bj][m][1];
                    u32x4 w; w.x = cvt_pk_bf16(a0[0] * rs[bj][0] + bg, a0[1] * rs[bj][1] + bg); w.y = cvt_pk_bf16(a0[2] * rs[bj][2] + bg, a0[3] * rs[bj][3] + bg);
                    w.z = cvt_pk_bf16(a1[0] * rs[bj][4] + bg, a1[1] * rs[bj][5] + bg); w.w = cvt_pk_bf16(a1[2] * rs[bj][6] + bg, a1[3] * rs[bj][7] + bg);
                    *(u32x4*)(rowp + bj * 128) = w; } }
    }
};
struct EpiInproj {
    static constexpr bool PERM = true, PREFETCH = true; bf16_t* O; bf16_t* zs; const float* rstd; const float* bias;
    __device__ __forceinline__ void prefetch(const Unit& u, PG8_LAS unsigned char* ex, int wid, int lane) const {
        if (wid == 0) __builtin_amdgcn_global_load_lds((const unsigned*)(rstd + u.pm * 256 + lane * 4), (PG8_LAS unsigned*)ex, 16, 0, 0);
        else if (wid == 1) __builtin_amdgcn_global_load_lds((const unsigned*)(bias + ((u.pm * 256 < NTOK) ? ((u.pm * 256) >> 13) : 8) * 3072 + u.pn * 256 + lane * 4), (PG8_LAS unsigned*)(ex + 1024), 16, 0, 0);
    }
    __device__ __forceinline__ void operator()(const f32x4 (&acc)[2][2][4][2], const Unit& u, int wr, int wc, int fr, int fq, const PG8_LAS float* ex) const {
        const int row0 = u.pm * 256 + wr * 64 + fr, col0 = u.pn * 256 + wc * 32 + 8 * fq;
        const bool isz = u.pn >= 6;
        if (isz && u.pm * 256 >= NTOK) return;
        f32x4 bv[2][2];
#pragma unroll
        for (int bj = 0; bj < 2; ++bj) { bv[bj][0] = *(const PG8_LAS f32x4*)(ex + 256 + bj * 128 + wc * 32 + 8 * fq); bv[bj][1] = *(const PG8_LAS f32x4*)(ex + 256 + bj * 128 + wc * 32 + 8 * fq + 4); }
#pragma unroll
        for (int ai = 0; ai < 2; ++ai)
#pragma unroll
            for (int m = 0; m < 4; ++m) { const size_t row = (size_t)(row0 + ai * 128 + m * 16); const float rs = ex[wr * 64 + fr + ai * 128 + m * 16];
                bf16_t* rowp = isz ? zs + row * 512 + (col0 - 1536) : O + row * 2048 + col0;
#pragma unroll
                for (int bj = 0; bj < 2; ++bj) { f32x4 v0 = acc[ai][bj][m][0] * rs + bv[bj][0], v1 = acc[ai][bj][m][1] * rs + bv[bj][1];
                    if (isz) {
#pragma unroll
                        for (int j = 0; j < 4; ++j) { v0[j] = v0[j] * __builtin_amdgcn_rcpf(1.0f + __expf(-v0[j])); v1[j] = v1[j] * __builtin_amdgcn_rcpf(1.0f + __expf(-v1[j])); } }
                    u32x4 w; w.x = cvt_pk_bf16(v0[0], v0[1]); w.y = cvt_pk_bf16(v0[2], v0[3]); w.z = cvt_pk_bf16(v1[0], v1[1]); w.w = cvt_pk_bf16(v1[2], v1[3]);
                    *(u32x4*)(rowp + bj * 128) = w; } }
    }
};
typedef ProbInproj ProbOut;
struct EpiResid {
    static constexpr bool PERM = false, PREFETCH = false; const float* x; const float* mod; float* out;
    __device__ __forceinline__ void operator()(const f32x4 (&acc)[2][2][4][2], const Unit& u, int wr, int wc, int fr, int fq, const PG8_LAS float* ex) const {
        const int row0 = u.pm * 256 + wr * 64 + fr, col0 = u.pn * 256 + wc * 32 + 4 * fq;
        const float* gate = mod + ((u.pm * 256) >> 13) * 6144 + 2 * 1024;
        f32x4 gv[2][2];
#pragma unroll
        for (int bj = 0; bj < 2; ++bj)
#pragma unroll
            for (int n = 0; n < 2; ++n) gv[bj][n] = *(const f32x4*)(gate + col0 + bj * 128 + n * 16);
#pragma unroll
        for (int ai = 0; ai < 2; ++ai)
#pragma unroll
            for (int m = 0; m < 4; ++m) { const size_t off = (size_t)(row0 + ai * 128 + m * 16) * 1024 + col0;
#pragma unroll
                for (int bj = 0; bj < 2; ++bj)
#pragma unroll
                    for (int n = 0; n < 2; ++n) { const f32x4 xv = *(const f32x4*)(x + off + bj * 128 + n * 16); *(f32x4*)(out + off + bj * 128 + n * 16) = xv + gv[bj][n] * acc[ai][bj][m][n]; } }
    }
};
struct MoeOrder {
    const PG8_LAS int* tb; const PG8_LAS int* cnt; int G, c;
    __device__ __forceinline__ bool next(int i, Unit& u) const {
        const int L = i * G + c, ntile = tb[32]; if (L >= ntile * 4) return false;
        const int tile = L >> 2; u.pn = L & 3; int e = 0;
#pragma unroll
        for (int s = 16; s >= 1; s >>= 1) if (__builtin_amdgcn_readfirstlane(tb[e + s]) <= tile) e += s;
        u.e = e; u.pm = tile; const int loc = (tile - __builtin_amdgcn_readfirstlane(tb[e])) * 256; u.cnt = __builtin_amdgcn_readfirstlane(cnt[e]) - loc; return true;
    }
};
struct ProbMoe1 : MoeOrder { const bf16_t* A; const bf16_t* Bt; int K; const unsigned* tokk; static constexpr bool GATHER_A = true;
    __device__ __forceinline__ unsigned laneA(int) const { return 0u; }
    __device__ __forceinline__ unsigned laneB(int r) const { return (unsigned)r * 2048u; }
    __device__ __forceinline__ unsigned baseA(const Unit&) const { return 0u; }
    __device__ __forceinline__ unsigned baseB(const Unit& u) const { return (unsigned)(u.e * 1024 + u.pn * 256) * 2048u; }
    __device__ __forceinline__ unsigned gathA(const Unit& u, int r) const { const int loc = (u.pm - __builtin_amdgcn_readfirstlane(tb[u.e])) * 256 + r; const unsigned tk = r < u.cnt ? tokk[(size_t)u.e * LCAP + loc] : 0u; return (tk >> 1) * 2048u; } };
struct EpiMoe1 {
    static constexpr bool PERM = true, PREFETCH = false; bf16_t* hid;
    __device__ __forceinline__ void operator()(const f32x4 (&acc)[2][2][4][2], const Unit& u, int wr, int wc, int fr, int fq, const PG8_LAS float* ex) const {
        const int row0 = u.pm * 256 + wr * 64 + fr, col0 = u.pn * 128 + wc * 32 + 8 * fq;
#pragma unroll
        for (int ai = 0; ai < 2; ++ai)
#pragma unroll
            for (int m = 0; m < 4; ++m) { float hv[8];
#pragma unroll
                for (int n = 0; n < 2; ++n)
#pragma unroll
                    for (int j = 0; j < 4; ++j) { const float g = acc[ai][0][m][n][j], up = acc[ai][1][m][n][j]; hv[n * 4 + j] = g * __builtin_amdgcn_rcpf(1.0f + __expf(-g)) * up; }
                u32x4 w; w.x = cvt_pk_bf16(hv[0], hv[1]); w.y = cvt_pk_bf16(hv[2], hv[3]); w.z = cvt_pk_bf16(hv[4], hv[5]); w.w = cvt_pk_bf16(hv[6], hv[7]);
                *(u32x4*)(hid + (size_t)(row0 + ai * 128 + m * 16) * 512 + col0) = w; }
    }
};
struct ProbMoe2 : MoeOrder { const bf16_t* A; const bf16_t* Bt; int K; static constexpr bool GATHER_A = false;
    __device__ __forceinline__ unsigned laneA(int r) const { return (unsigned)r * 1024u; }
    __device__ __forceinline__ unsigned laneB(int r) const { return (unsigned)r * 1024u; }
    __device__ __forceinline__ unsigned baseA(const Unit& u) const { return (unsigned)(u.pm * 256) * 1024u; }
    __device__ __forceinline__ unsigned baseB(const Unit& u) const { return (unsigned)(u.e * 1024 + u.pn * 256) * 1024u; }
    __device__ __forceinline__ unsigned gathA(const Unit&, int) const { return 0u; } };
struct EpiMoe2 {
    static constexpr bool PERM = true, PREFETCH = false; bf16_t* Y; const unsigned* tokk; const float* wl; const PG8_LAS int* tb;
    __device__ __forceinline__ void operator()(const f32x4 (&acc)[2][2][4][2], const Unit& u, int wr, int wc, int fr, int fq, const PG8_LAS float* ex) const {
        const int col0 = u.pn * 256 + wc * 32 + 8 * fq, locb = (u.pm - __builtin_amdgcn_readfirstlane(tb[u.e])) * 256;
#pragma unroll
        for (int ai = 0; ai < 2; ++ai)
#pragma unroll
            for (int m = 0; m < 4; ++m) { const int r = ai * 128 + wr * 64 + m * 16 + fr;
                if (r < u.cnt) { const unsigned tk = tokk[(size_t)u.e * LCAP + locb + r]; const float w = wl[(size_t)u.e * LCAP + locb + r];
                    bf16_t* rowp = Y + ((size_t)(tk & 1u) * NTOK + (tk >> 1)) * 1024 + col0;
#pragma unroll
                    for (int bj = 0; bj < 2; ++bj) { const f32x4 v0 = acc[ai][bj][m][0] * w, v1 = acc[ai][bj][m][1] * w;
                        u32x4 q; q.x = cvt_pk_bf16(v0[0], v0[1]); q.y = cvt_pk_bf16(v0[2], v0[3]); q.z = cvt_pk_bf16(v1[0], v1[1]); q.w = cvt_pk_bf16(v1[2], v1[3]);
                        *(u32x4*)(rowp + bj * 128) = q; } } }
    }
};
}
#endif

DEV void conv_row_compute(const Params& P, const bf16_t* ring, const float* wts, int s0, int s1, int s2, int ntap_rows, int slab, bf16_t* dst, int tid) {
    const int cq = tid & 31, tg = tid >> 5;
    typedef float f32x2 __attribute__((ext_vector_type(2)));
    f32x2 acc2[4][2];
#pragma unroll
    for (int t = 0; t < 4; ++t) { acc2[t][0] = (f32x2){0.f, 0.f}; acc2[t][1] = (f32x2){0.f, 0.f}; }
#pragma unroll
    for (int ky = 0; ky < 3; ++ky) {
        if (ntap_rows == 1 && ky != 1) continue;
        const int sl = ky == 0 ? s0 : ky == 1 ? s1 : s2;
        f32x2 w[3][2];
#pragma unroll
        for (int kx = 0; kx < 3; ++kx) { const f32x4 t = *(const f32x4*)(wts + (ky * 3 + kx) * 128 + cq * 4); w[kx][0] = (f32x2){t[0], t[1]}; w[kx][1] = (f32x2){t[2], t[3]}; }
        f32x2 in[6][2];
#pragma unroll
        for (int pos = 0; pos < 6; ++pos) { const u32x2 v = *(const u32x2*)(ring + sl * 8448 + (tg * 4 + pos) * 128 + cq * 4);
            in[pos][0] = (f32x2){__builtin_bit_cast(float, v[0] << 16), __builtin_bit_cast(float, v[0] & 0xffff0000u)}; in[pos][1] = (f32x2){__builtin_bit_cast(float, v[1] << 16), __builtin_bit_cast(float, v[1] & 0xffff0000u)}; }
#pragma unroll
        for (int t = 0; t < 4; ++t)
#pragma unroll
            for (int kx = 0; kx < 3; ++kx) { acc2[t][0] += w[kx][0] * in[t + kx][0]; acc2[t][1] += w[kx][1] * in[t + kx][1]; }
    }
    float acc[4][4];
#pragma unroll
    for (int t = 0; t < 4; ++t) { acc[t][0] = acc2[t][0][0]; acc[t][1] = acc2[t][0][1]; acc[t][2] = acc2[t][1][0]; acc[t][3] = acc2[t][1][1]; }
#pragma unroll
    for (int t = 0; t < 4; ++t) {
        float ss = 0.f;
#pragma unroll
        for (int c = 0; c < 4; ++c) { acc[t][c] = silu_f(acc[t][c]); ss += acc[t][c] * acc[t][c]; }
        if (slab < 8) { ss += shfl_xor_f(ss, 1); ss += shfl_xor_f(ss, 2); ss += shfl_xor_f(ss, 4); ss += shfl_xor_f(ss, 8); ss += shfl_xor_f(ss, 16); const float sc = rsq_f(ss + EPS);
#pragma unroll
            for (int c = 0; c < 4; ++c) acc[t][c] *= sc; }
        u32x2 o; o[0] = pk2(acc[t][0], acc[t][1]); o[1] = pk2(acc[t][2], acc[t][3]);
        *(u32x2*)(dst + (size_t)(tg * 4 + t) * 1536 + cq * 4) = o;
    }
}

DEV void phase3_conv(const Params& P, unsigned char* sm) {
    PHASE_TID;
    const bf16_t* p = (const bf16_t*)(P.ws + WS_R4 + R4_P);
    bf16_t* qkvn = (bf16_t*)(P.ws + WS_R3);
    bf16_t* ring = (bf16_t*)sm;
    float* wts = (float*)(sm + 3 * 16896);
    const u32x4 zero4 = (u32x4){0u, 0u, 0u, 0u};
    for (int it = BID; it < NB * 12 * 8; it += NBLK) {
        const int slab = it % 12, yb = (it / 12) & 7, b = it / 96, y0 = yb * 16;
        const bf16_t* src = p + (size_t)(b * SEQ) * 2048 + slab * 128;
        if (TID < 96) { const int sl = TID / 32, w = TID & 31, cc = (w >> 4) * 65, pc = w & 15; *(u32x4*)(ring + sl * 8448 + cc * 128 + pc * 8) = zero4; }
        if (TID < 288) *(f32x4*)(wts + TID * 4) = *(const f32x4*)(P.conv_w + (size_t)(TID >> 5) * 1536 + slab * 128 + (TID & 31) * 4);
        const int tk0 = TID >> 4, pc = TID & 15;
        u32x4 rr[4][2];
#define CV_LOAD(set, y) do { const bool ok_ = (y) >= 0 && (y) < 128; const int yc_ = ok_ ? (y) : y0;        \
            const u32x4 t0_ = *(const u32x4*)(src + (size_t)(yc_ * 64 + tk0) * 2048 + pc * 8), t1_ = *(const u32x4*)(src + (size_t)(yc_ * 64 + tk0 + 32) * 2048 + pc * 8); \
            rr[set][0] = ok_ ? t0_ : zero4; rr[set][1] = ok_ ? t1_ : zero4; } while (0)
#define CV_STORE(set, slot) do { *(u32x4*)(ring + (slot) * 8448 + (tk0 + 1) * 128 + pc * 8) = rr[set][0]; *(u32x4*)(ring + (slot) * 8448 + (tk0 + 33) * 128 + pc * 8) = rr[set][1]; } while (0)
        CV_LOAD(0, y0 - 1); CV_LOAD(1, y0); CV_LOAD(2, y0 + 1); CV_LOAD(3, y0 + 2);
        CV_STORE(0, 0); CV_STORE(1, 1);
        CV_LOAD(0, y0 + 3);
#pragma unroll 1
        for (int y4 = 0; y4 < 16; y4 += 4) {
#pragma unroll
            for (int u = 0; u < 4; ++u) {
                const int yy = y4 + u;
                const int s0 = yy % 3, s1 = (yy + 1) % 3, s2 = (yy + 2) % 3;
                CV_STORE((u + 2) & 3, s2);
                SYNC();
                CV_LOAD((u + 1) & 3, (yy + 4 <= 16) ? y0 + yy + 4 : 999);
                conv_row_compute(P, ring, wts, s0, s1, s2, 3, slab, qkvn + (size_t)(b * SEQ + (y0 + yy) * 64) * 1536 + slab * 128, TID);
                SYNC();
            }
        }
#undef CV_LOAD
#undef CV_STORE
    }
    for (int it = BID; it < NB * 12 * 4; it += NBLK) {
        const int slab = it % 12, sg = (it / 12) & 3, b = it / 48;
        const bf16_t* src = p + (size_t)(NTOK + b * CTX) * 2048 + slab * 128;
        if (TID < 288) *(f32x4*)(wts + TID * 4) = *(const f32x4*)(P.conv_w + (size_t)(TID >> 5) * 1536 + slab * 128 + (TID & 31) * 4);
        u32x4 r[3];
#pragma unroll
        for (int q = 0; q < 3; ++q) { const int idx = TID + q * 512; r[q] = zero4;
            if (idx < 66 * 16) { const int cc = idx >> 4, pc = idx & 15, tok = sg * 64 + cc - 1; if (tok >= 0 && tok < CTX) r[q] = *(const u32x4*)(src + (size_t)tok * 2048 + pc * 8); } }
#pragma unroll
        for (int q = 0; q < 3; ++q) { const int idx = TID + q * 512; if (idx < 66 * 16) { const int cc = idx >> 4, pc = idx & 15; *(u32x4*)(ring + 1 * 8448 + cc * 128 + pc * 8) = r[q]; } }
        SYNC();
        conv_row_compute(P, ring, wts, 0, 1, 2, 1, slab, qkvn + (size_t)(NTOK + b * CTX + sg * 64) * 1536 + slab * 128, TID);
        SYNC();
    }
}

constexpr int L_K = 0, L_Q = 17408, L_V = 34816, L_KTR = 52224, L_VT = 70656, L_X0F = 89088, L_X0TF = 98304, L_TTF = 107520, L_X0B = 116736, L_X0TB = 125952, L_TTB = 135168, L_GC = 144384, L_SCAL = 145408;
constexpr int L_X1F = 0, L_X1TF = 9216, L_X1B = 18432, L_X1TB = 27648, L_WF = 0, L_WB = 17408, L_AF = 145440, L_AB = 153632;

DEV int chunk_row(int chain, int step, int i) {
    const int b = chain >> 3, dir = chain & 1;
    if (step < 4) { const int pos = step * 64 + i; return NTOK + b * CTX + (dir ? (CTX - 1 - pos) : pos); }
    const int pos = (step - 4) * 64 + i; return b * SEQ + (dir ? (SEQ - 1 - pos) : pos);
}

DEV int img_piece_A(int row, int col0) { return (((row >> 4) * 2 + (col0 >> 5)) * 64 + ((col0 & 31) >> 3) * 16 + (row & 15)) * 16 + ((col0 >> 2) & 1) * 8; }
DEV int img_piece_W(int row, int d0) { return (((row >> 4) * 4 + (d0 >> 5)) * 64 + ((d0 & 31) >> 3) * 16 + (row & 15)) * 16; }

DEV void phase4_prepass(const Params& P, unsigned char* sm) {
    PHASE_TID;
    const bf16_t* qkvn = (const bf16_t*)(P.ws + WS_R3);
    const float* gb = (const float*)(P.ws + WS_GB);
    unsigned char* images = P.ws + WS_R4;
    bf16_t* Ks = (bf16_t*)(sm + L_K); bf16_t* Qs = (bf16_t*)(sm + L_Q); bf16_t* Vs = (bf16_t*)(sm + L_V); bf16_t* KTR = (bf16_t*)(sm + L_KTR); bf16_t* VT = (bf16_t*)(sm + L_VT);
    float* gcf = (float*)(sm + L_GC); float* gcb = gcf + 64; float* btf = gcf + 128; float* btb = gcf + 192;
    const float QSCALE = 0.08838834764831845f;
    const f32x4 z4 = (f32x4){0.f, 0.f, 0.f, 0.f};
    u32x4 pf[6]; float gfp, bfp, gbp, bbp, gbr;
#define PP_ROW0(it_) ((((it_) % NSTEP) < 4) ? NTOK + ((it_) / NSTEP / 4) * CTX + ((it_) % NSTEP) * 64 : ((it_) / NSTEP / 4) * SEQ + (((it_) % NSTEP) - 4) * 64)
#define PP_LOAD(it_) do { const int row0_ = PP_ROW0(it_), h_ = ((it_) / NSTEP) & 3; \
        _Pragma("unroll") for (int q = 0; q < 6; ++q) { const int idx = TID + q * 512, piece = idx & 15, i = (idx >> 4) & 63, which = idx >> 10; \
            pf[q] = *(const u32x4*)(qkvn + (size_t)(row0_ + i) * 1536 + which * 512 + h_ * 128 + piece * 8); } \
        { const int ln_ = TID & 63; const float* gr = gb + (size_t)(row0_ + ln_) * 16; gfp = gr[8 + h_]; bfp = gr[h_]; gbp = gr[12 + h_]; bbp = gr[4 + h_]; gbr = gb[(size_t)(row0_ + 63 - ln_) * 16 + 12 + h_]; } } while (0)
    const int NIT = NB * 4 * NSTEP;
    int it = BID;
    if (it < NIT) PP_LOAD(it);
    for (; it < NIT; it += NBLK) {
        int tq_ = TID;
#ifndef CPU_EMU
        asm volatile("" : "+v"(tq_));
#endif
        const int wid = tq_ >> 6, lane = tq_ & 63, fr = lane & 15, fq = lane >> 4;
        const int bh = it / NSTEP, st = it - bh * NSTEP;
        const int stb = st < 4 ? 3 - st : 4 + (127 - (st - 4));
        unsigned char* imgf = images + ((size_t)(bh * 2) * NSTEP + st) * IMG_BYTES;
        unsigned char* imgb = images + ((size_t)(bh * 2 + 1) * NSTEP + stb) * IMG_BYTES;
#pragma unroll
        for (int q = 0; q < 6; ++q) { const int idx = TID + q * 512, piece = idx & 15, i = (idx >> 4) & 63, which = idx >> 10;
            *(u32x4*)((which == 0 ? Qs : which == 1 ? Ks : Vs) + i * 136 + piece * 8) = pf[q]; }
        if (wid == 0) { float g = gfp;
#pragma unroll
            for (int o = 1; o < 64; o <<= 1) { const float t = shfl_up_f(g, o); if (lane >= o) g += t; }
            gcf[lane] = g; btf[lane] = bfp; }
        if (wid == 1) { float g = gbr;
#pragma unroll
            for (int o = 1; o < 64; o <<= 1) { const float t = shfl_up_f(g, o); if (lane >= o) g += t; }
            gcb[63 - lane] = g; btb[lane] = bbp; }
        { const int nx = (it + NBLK < NIT) ? it + NBLK : it; PP_LOAD(nx); }
        SYNC();
        const float glf = gcf[63], glb = gcb[0];
        bf16_t* X0F = (bf16_t*)(sm + L_X0F); bf16_t* X0TF = (bf16_t*)(sm + L_X0TF); bf16_t* TTF = (bf16_t*)(sm + L_TTF);
        bf16_t* X0B = (bf16_t*)(sm + L_X0B); bf16_t* X0TB = (bf16_t*)(sm + L_X0TB); bf16_t* TTB = (bf16_t*)(sm + L_TTB);
        f32x4 TregF[2], TTregF[2], TregB[2], TTregB[2];
#pragma unroll
        for (int tt = 0; tt < 2; ++tt) {
            const int t = wid * 2 + tt, ti = t >> 2, tj = t & 3;
            f32x4 kk = z4, kkT = z4, qkT = z4;
#pragma unroll
            for (int ks = 0; ks < 4; ++ks) {
                const bf16x8 fKi = frag16(Ks + (ti * 16 + fr) * 136 + ks * 32 + fq * 8), fKj = frag16(Ks + (tj * 16 + fr) * 136 + ks * 32 + fq * 8), fQi = frag16(Qs + (ti * 16 + fr) * 136 + ks * 32 + fq * 8);
                kk = mfma16(fKi, fKj, kk); kkT = mfma16(fKj, fKi, kkT); qkT = mfma16(fKj, fQi, qkT);
            }
            {
              const int j = tj * 16 + fr; const float gfj = gcf[j], gbj = gcb[j]; float mf[4], mb_[4];
#pragma unroll
              for (int r = 0; r < 4; ++r) { const int i = ti * 16 + fq * 4 + r;
                  mf[r] = (i > j) ? btf[i] * kk[r] * __expf(gcf[i] - gfj) : 0.f; TregF[tt][r] = (i == j ? 1.0f : 0.0f) - mf[r];
                  mb_[r] = (i < j) ? btb[i] * kk[r] * __expf(gcb[i] - gbj) : 0.f; TregB[tt][r] = (i == j ? 1.0f : 0.0f) - mb_[r]; }
              u32x2 w; const int o_ = j * 72 + ti * 16 + fq * 4;
              w[0] = pk2(mf[0], mf[1]); w[1] = pk2(mf[2], mf[3]); *(u32x2*)(X0TF + o_) = w;
              w[0] = pk2(TregF[tt][0], TregF[tt][1]); w[1] = pk2(TregF[tt][2], TregF[tt][3]); *(u32x2*)(TTF + o_) = w;
              w[0] = pk2(mb_[0], mb_[1]); w[1] = pk2(mb_[2], mb_[3]); *(u32x2*)(X0TB + o_) = w;
              w[0] = pk2(TregB[tt][0], TregB[tt][1]); w[1] = pk2(TregB[tt][2], TregB[tt][3]); *(u32x2*)(TTB + o_) = w; }
            SCHED_FENCE();
            {
              const int i = ti * 16 + fr, j0 = tj * 16 + fq * 4; const float gfi = gcf[i], gbi = gcb[i], bfi = btf[i], bbi = btb[i]; float mf[4], af[4], mb_[4], ab[4];
#pragma unroll
              for (int r = 0; r < 4; ++r) { const int j = j0 + r;
                  const float df = (i >= j) ? __expf(gfi - gcf[j]) : 0.f, db = (i <= j) ? __expf(gbi - gcb[j]) : 0.f;
                  mf[r] = (i > j) ? bfi * kkT[r] * df : 0.f; TTregF[tt][r] = (i == j ? 1.0f : 0.0f) - mf[r]; af[r] = qkT[r] * QSCALE * df;
                  mb_[r] = (i < j) ? bbi * kkT[r] * db : 0.f; TTregB[tt][r] = (i == j ? 1.0f : 0.0f) - mb_[r]; ab[r] = qkT[r] * QSCALE * db; }
              u32x2 w; const int o_ = i * 72 + j0;
              w[0] = pk2(mf[0], mf[1]); w[1] = pk2(mf[2], mf[3]); *(u32x2*)(X0F + o_) = w;
              w[0] = pk2(mb_[0], mb_[1]); w[1] = pk2(mb_[2], mb_[3]); *(u32x2*)(X0B + o_) = w;
              w[0] = pk2(af[0], af[1]); w[1] = pk2(af[2], af[3]); *(u32x2*)((bf16_t*)(sm + L_AF) + i * 64 + j0) = w;
              w[0] = pk2(ab[3], ab[2]); w[1] = pk2(ab[1], ab[0]); *(u32x2*)((bf16_t*)(sm + L_AB) + (63 - i) * 64 + 60 - j0) = w; }
            SCHED_FENCE();
        }
        {
#pragma unroll
            for (int q = 0; q < 2; ++q) { const int pc = TID + q * 512, i = pc >> 4, d0 = (pc & 15) * 8;
                const u32x4 v = *(const u32x4*)(Qs + i * 136 + d0); const float sf = QSCALE * __expf(gcf[i]), sb = QSCALE * __expf(gcb[i]); u32x4 of, ob;
#pragma unroll
                for (int e = 0; e < 4; ++e) { const float lo = __builtin_bit_cast(float, v[e] << 16), hi = __builtin_bit_cast(float, v[e] & 0xffff0000u); of[e] = pk2(lo * sf, hi * sf); ob[e] = pk2(lo * sb, hi * sb); }
                *(u32x4*)(imgf + IMG_Q + img_piece_W(i, d0)) = of; *(u32x4*)(imgb + IMG_Q + img_piece_W(63 - i, d0)) = ob; }
            SCHED_FENCE();
        }
        {
            const int dcol = wid * 16 + fr, ks = wid >> 1;
            bf16x8 idf;
#pragma unroll
            for (int j = 0; j < 8; ++j) idf[j] = (dcol == ks * 32 + fq * 8 + j) ? (short)0x3F80 : (short)0;
#pragma unroll
            for (int t4 = 0; t4 < 4; ++t4) {
                const f32x4 kt = mfma16(frag16(Ks + (t4 * 16 + fr) * 136 + ks * 32 + fq * 8), idf, z4);
                const f32x4 vt = mfma16(frag16(Vs + (t4 * 16 + fr) * 136 + ks * 32 + fq * 8), idf, z4);
                const int tok = t4 * 16 + fq * 4;
                u32x2 w; w[0] = pk2(kt[0], kt[1]); w[1] = pk2(kt[2], kt[3]); *(u32x2*)(KTR + dcol * 72 + tok) = w;
                w[0] = pk2(vt[0], vt[1]); w[1] = pk2(vt[2], vt[3]); *(u32x2*)(VT + dcol * 72 + tok) = w;
                SCHED_FENCE();
            }
        }
        SYNC();
#pragma unroll 1
        for (int s5 = 0; s5 < 5; ++s5) {
            const bf16_t* PcF = (bf16_t*)(sm + ((s5 & 1) ? L_X1F : L_X0F)); const bf16_t* PcTF = (bf16_t*)(sm + ((s5 & 1) ? L_X1TF : L_X0TF));
            bf16_t* PnF = (bf16_t*)(sm + ((s5 & 1) ? L_X0F : L_X1F)); bf16_t* PnTF = (bf16_t*)(sm + ((s5 & 1) ? L_X0TF : L_X1TF));
            const bf16_t* PcB = (bf16_t*)(sm + ((s5 & 1) ? L_X1B : L_X0B)); const bf16_t* PcTB = (bf16_t*)(sm + ((s5 & 1) ? L_X1TB : L_X0TB));
            bf16_t* PnB = (bf16_t*)(sm + ((s5 & 1) ? L_X0B : L_X1B)); bf16_t* PnTB = (bf16_t*)(sm + ((s5 & 1) ? L_X0TB : L_X1TB));
#pragma unroll
            for (int tt = 0; tt < 2; ++tt) {
                const int t = wid * 2 + tt, ti = t >> 2, tj = t & 3;
                f32x4 p2 = z4, p2T = z4, q2 = z4, q2T = z4;
#pragma unroll
                for (int ks = 0; ks < 2; ++ks) { const int oa = (ti * 16 + fr) * 72 + ks * 32 + fq * 8, ob = (tj * 16 + fr) * 72 + ks * 32 + fq * 8;
                    const bf16x8 a = frag16(PcF + oa), b = frag16(PcTF + ob), c = frag16(PcB + oa), d = frag16(PcTB + ob);
                    p2 = mfma16(a, b, p2); p2T = mfma16(b, a, p2T); q2 = mfma16(c, d, q2); q2T = mfma16(d, c, q2T); }
                u32x2 w; const int oT = (tj * 16 + fr) * 72 + ti * 16 + fq * 4, oN = (ti * 16 + fr) * 72 + tj * 16 + fq * 4;
                w[0] = pk2(p2[0], p2[1]); w[1] = pk2(p2[2], p2[3]); *(u32x2*)(PnTF + oT) = w;
                w[0] = pk2(p2T[0], p2T[1]); w[1] = pk2(p2T[2], p2T[3]); *(u32x2*)(PnF + oN) = w;
                w[0] = pk2(q2[0], q2[1]); w[1] = pk2(q2[2], q2[3]); *(u32x2*)(PnTB + oT) = w;
                w[0] = pk2(q2T[0], q2T[1]); w[1] = pk2(q2T[2], q2T[3]); *(u32x2*)(PnB + oN) = w;
            }
            SYNC();
#pragma unroll
            for (int tt = 0; tt < 2; ++tt) {
                const int t = wid * 2 + tt, ti = t >> 2, tj = t & 3;
#pragma unroll
                for (int ks = 0; ks < 2; ++ks) { const int oa = (ti * 16 + fr) * 72 + ks * 32 + fq * 8, ob = (tj * 16 + fr) * 72 + ks * 32 + fq * 8;
                    const bf16x8 a = frag16(PnF + oa), b = frag16(TTF + ob), c = frag16(PnB + oa), d = frag16(TTB + ob);
                    TregF[tt] = mfma16(a, b, TregF[tt]); TTregF[tt] = mfma16(b, a, TTregF[tt]); TregB[tt] = mfma16(c, d, TregB[tt]); TTregB[tt] = mfma16(d, c, TTregB[tt]); }
            }
            SYNC();
            if (s5 < 4) {
#pragma unroll
                for (int tt = 0; tt < 2; ++tt) { const int t = wid * 2 + tt, ti = t >> 2, tj = t & 3, oT = (tj * 16 + fr) * 72 + ti * 16 + fq * 4;
                    u32x2 w; w[0] = pk2(TregF[tt][0], TregF[tt][1]); w[1] = pk2(TregF[tt][2], TregF[tt][3]); *(u32x2*)(TTF + oT) = w;
                    w[0] = pk2(TregB[tt][0], TregB[tt][1]); w[1] = pk2(TregB[tt][2], TregB[tt][3]); *(u32x2*)(TTB + oT) = w; }
            }
        }
#pragma unroll
        for (int tt = 0; tt < 2; ++tt) {
            const int t = wid * 2 + tt, ti = t >> 2, tj = t & 3, i = ti * 16 + fr, j0 = tj * 16 + fq * 4;
            const f32x4 bq = *(const f32x4*)(btf + j0), gq = *(const f32x4*)(gcf + j0), cq = *(const f32x4*)(btb + j0), hq = *(const f32x4*)(gcb + j0);
            float tu[4], tw[4], su[4], sw[4];
#pragma unroll
            for (int r = 0; r < 4; ++r) { tu[r] = TTregF[tt][r] * bq[r]; tw[r] = tu[r] * __expf(gq[r]); su[r] = TTregB[tt][r] * cq[r]; sw[r] = su[r] * __expf(hq[r]); }
            u32x2 w; const int o_ = i * 72 + j0;
            w[0] = pk2(tu[0], tu[1]); w[1] = pk2(tu[2], tu[3]); *(u32x2*)(X0F + o_) = w;
            w[0] = pk2(tw[0], tw[1]); w[1] = pk2(tw[2], tw[3]); *(u32x2*)(X0TF + o_) = w;
            w[0] = pk2(su[0], su[1]); w[1] = pk2(su[2], su[3]); *(u32x2*)(X0B + o_) = w;
            w[0] = pk2(sw[0], sw[1]); w[1] = pk2(sw[2], sw[3]); *(u32x2*)(X0TB + o_) = w;
        }
        if (TID == 0) { float* scp = (float*)(sm + L_SCAL); scp[0] = __expf(glf); scp[1] = 0.f; scp[2] = 0.f; scp[3] = 0.f; scp[4] = __expf(glb); scp[5] = 0.f; scp[6] = 0.f; scp[7] = 0.f; }
        SYNC();
        bf16_t* WF = (bf16_t*)(sm + L_WF); bf16_t* WB = (bf16_t*)(sm + L_WB);
#pragma unroll
        for (int i4 = 0; i4 < 4; ++i4) {
            f32x4 uf = z4, wf = z4, ub = z4, wb = z4;
#pragma unroll
            for (int ks = 0; ks < 2; ++ks) {
                const bf16x8 av = frag16(VT + (wid * 16 + fr) * 72 + ks * 32 + fq * 8), ak = frag16(KTR + (wid * 16 + fr) * 72 + ks * 32 + fq * 8);
                const int ot = (i4 * 16 + fr) * 72 + ks * 32 + fq * 8;
                uf = mfma16(frag16(X0F + ot), av, uf); wf = mfma16(ak, frag16(X0TF + ot), wf); ub = mfma16(frag16(X0B + ot), av, ub); wb = mfma16(ak, frag16(X0TB + ot), wb);
            }
            u32x2 w; w[0] = pk2(uf[0], uf[1]); w[1] = pk2(uf[2], uf[3]); *(u32x2*)(imgf + IMG_U + ((wid * 4 + i4) * 64 + lane) * 8) = w;
            w[0] = pk2(ub[3], ub[2]); w[1] = pk2(ub[1], ub[0]); *(u32x2*)(imgb + IMG_U + ((wid * 4 + (3 - i4)) * 64 + (3 - fq) * 16 + fr) * 8) = w;
            const int i = i4 * 16 + fr, c = wid * 16 + fq * 4;
            w[0] = pk2(wf[0], wf[1]); w[1] = pk2(wf[2], wf[3]); *(u32x2*)(WF + i * 136 + c) = w;
            w[0] = pk2(wb[0], wb[1]); w[1] = pk2(wb[2], wb[3]); *(u32x2*)(WB + (63 - i) * 136 + c) = w;
        }
        SYNC();
#pragma unroll
        for (int q = 0; q < 5; ++q) { int pc = TID + q * 512; pc = pc < 2050 ? pc : 2049;
            const int dirb = pc >= 2048 ? (pc & 1) : (pc >> 10), p = pc & 1023, mt = p >> 8, ks = (p >> 6) & 3, ln = p & 63;
            const int so = pc >= 2048 ? L_SCAL + dirb * 16 : (dirb ? L_WB : L_WF) + ((mt * 16 + (ln & 15)) * 136 + ks * 32 + (ln >> 4) * 8) * 2;
            const int dofs = pc >= 2048 ? IMG_SC : IMG_W + p * 16;
            *(u32x4*)((dirb ? imgb : imgf) + dofs) = *(const u32x4*)(sm + so); }
#pragma unroll
        for (int q = 0; q < 2; ++q) { const int p = TID + q * 512, d = (p >> 7) * 16 + (p & 15), p0 = ((p >> 6) & 1) * 32 + ((p >> 4) & 3) * 8;
            { const u32x4 v = *(const u32x4*)(KTR + d * 72 + p0); const f32x4 g0 = *(const f32x4*)(gcf + p0), g1 = *(const f32x4*)(gcf + p0 + 4); u32x4 o;
              o[0] = pk2(__builtin_bit_cast(float, v[0] << 16) * __expf(glf - g0[0]), __builtin_bit_cast(float, v[0] & 0xffff0000u) * __expf(glf - g0[1]));
              o[1] = pk2(__builtin_bit_cast(float, v[1] << 16) * __expf(glf - g0[2]), __builtin_bit_cast(float, v[1] & 0xffff0000u) * __expf(glf - g0[3]));
              o[2] = pk2(__builtin_bit_cast(float, v[2] << 16) * __expf(glf - g1[0]), __builtin_bit_cast(float, v[2] & 0xffff0000u) * __expf(glf - g1[1]));
              o[3] = pk2(__builtin_bit_cast(float, v[3] << 16) * __expf(glf - g1[2]), __builtin_bit_cast(float, v[3] & 0xffff0000u) * __expf(glf - g1[3]));
              *(u32x4*)(imgf + IMG_KT + p * 16) = o; }
            { const int t0 = 56 - p0;
              const u32x4 v = *(const u32x4*)(KTR + d * 72 + t0); const f32x4 g0 = *(const f32x4*)(gcb + t0), g1 = *(const f32x4*)(gcb + t0 + 4); u32x4 o;
              o[0] = pk2(__builtin_bit_cast(float, v[3] & 0xffff0000u) * __expf(glb - g1[3]), __builtin_bit_cast(float, v[3] << 16) * __expf(glb - g1[2]));
              o[1] = pk2(__builtin_bit_cast(float, v[2] & 0xffff0000u) * __expf(glb - g1[1]), __builtin_bit_cast(float, v[2] << 16) * __expf(glb - g1[0]));
              o[2] = pk2(__builtin_bit_cast(float, v[1] & 0xffff0000u) * __expf(glb - g0[3]), __builtin_bit_cast(float, v[1] << 16) * __expf(glb - g0[2]));
              o[3] = pk2(__builtin_bit_cast(float, v[0] & 0xffff0000u) * __expf(glb - g0[1]), __builtin_bit_cast(float, v[0] << 16) * __expf(glb - g0[0]));
              *(u32x4*)(imgb + IMG_KT + p * 16) = o; } }
        { const int p = TID, row = (p >> 7) * 16 + (p & 15), c0 = ((p >> 6) & 1) * 32 + ((p >> 4) & 3) * 8;
          *(u32x4*)(imgf + IMG_A + p * 16) = *(const u32x4*)((const bf16_t*)(sm + L_AF) + row * 64 + c0);
          *(u32x4*)(imgb + IMG_A + p * 16) = *(const u32x4*)((const bf16_t*)(sm + L_AB) + row * 64 + c0); }
        SYNC();
    }
#undef PP_LOAD
#undef PP_ROW0
}

DEV void phase4_fft(const Params& P, unsigned char* sm) {
    PHASE_TID;
    const bf16_t* GT = (const bf16_t*)((const unsigned char*)P.out + DO_GT);
    bf16_t* ZT = (bf16_t*)((unsigned char*)P.out + DO_ZT);
    const bf16_t* tab = (const bf16_t*)(P.ws + WS_TAB);
    bf16_t* YR = (bf16_t*)sm; bf16_t* YI = YR + 64 * 136;
    const int wid = TID >> 6, lane = TID & 63, fr = lane & 15, fq = lane >> 4;
    bf16x8 c64[4][2], s64[4][2], c128[4], s128[4];
#pragma unroll
    for (int nt = 0; nt < 4; ++nt)
#pragma unroll
        for (int ks = 0; ks < 2; ++ks) { c64[nt][ks] = frag16(tab + (nt * 16 + fr) * 64 + ks * 32 + fq * 8); s64[nt][ks] = frag16(tab + 4096 + (nt * 16 + fr) * 64 + ks * 32 + fq * 8); }
#pragma unroll
    for (int ks = 0; ks < 4; ++ks) { c128[ks] = frag16(tab + 8192 + (wid * 16 + fr) * 128 + ks * 32 + fq * 8); s128[ks] = frag16(tab + 8192 + 16384 + (wid * 16 + fr) * 128 + ks * 32 + fq * 8); }
    for (int it = BID; it < 512 * NB; it += NBLK) {
        const int cp = it >> 3, b = it & 7;
        const bf16_t* gr = GT + (size_t)cp * NTOK + b * SEQ; const bf16_t* gi = GT + (size_t)(512 + cp) * NTOK + b * SEQ;
        bf16x8 ar[2], ai[2], an[2];
#pragma unroll
        for (int ks = 0; ks < 2; ++ks) { ar[ks] = frag16(gr + (wid * 16 + fr) * 64 + ks * 32 + fq * 8); ai[ks] = frag16(gi + (wid * 16 + fr) * 64 + ks * 32 + fq * 8);
#pragma unroll
            for (int j = 0; j < 8; ++j) an[ks][j] = (short)(ar[ks][j] ^ (short)0x8000); }
#pragma unroll
        for (int nt = 0; nt < 4; ++nt) {
            f32x4 yr = (f32x4){0.f, 0.f, 0.f, 0.f}, yi = (f32x4){0.f, 0.f, 0.f, 0.f};
#pragma unroll
            for (int ks = 0; ks < 2; ++ks) { yr = mfma16(ar[ks], c64[nt][ks], yr); yr = mfma16(ai[ks], s64[nt][ks], yr); yi = mfma16(ai[ks], c64[nt][ks], yi); yi = mfma16(an[ks], s64[nt][ks], yi); }
            const int k1 = nt * 16 + fr; float orr[4], oii[4];
#pragma unroll
            for (int r = 0; r < 4; ++r) { const int n2 = wid * 16 + fq * 4 + r; float s, c; sincospi_f((float)(n2 * k1) * (2.0f / 8192.0f), &s, &c);
                orr[r] = yr[r] * c + yi[r] * s; oii[r] = yi[r] * c - yr[r] * s; }
            u32x2 w; w[0] = pk2(orr[0], orr[1]); w[1] = pk2(orr[2], orr[3]); *(u32x2*)(YR + k1 * 136 + wid * 16 + fq * 4) = w;
            w[0] = pk2(oii[0], oii[1]); w[1] = pk2(oii[2], oii[3]); *(u32x2*)(YI + k1 * 136 + wid * 16 + fq * 4) = w;
        }
        SYNC();
        bf16_t* zrow = ZT + (size_t)cp * NTOK + b * SEQ;
#pragma unroll
        for (int mt = 0; mt < 4; ++mt) {
            f32x4 z = (f32x4){0.f, 0.f, 0.f, 0.f};
#pragma unroll
            for (int ks = 0; ks < 4; ++ks) { z = mfma16(frag16(YR + (mt * 16 + fr) * 136 + ks * 32 + fq * 8), c128[ks], z); z = mfma16(frag16(YI + (mt * 16 + fr) * 136 + ks * 32 + fq * 8), s128[ks], z); }
            u32x2 w; w[0] = pk2(z[0], z[1]); w[1] = pk2(z[2], z[3]);
            *(u32x2*)(zrow + 64 * (wid * 16 + fr) + mt * 16 + fq * 4) = w;
        }
        SYNC();
    }
}

constexpr int SC_W = 0, SC_U = 17408, SC_KT = 22528, SC_Q = SC_KT + 18432, SC_A = SC_Q + 17408, SC_ST = SC_A + 9216, SC_VN = SC_ST + 2 * 8704, SC_END = SC_VN + 4608;

DEV void phase5_scan(const Params& P, unsigned char* sm) {
    PHASE_TID;
    const unsigned char* images = P.ws + WS_R4;
    bf16_t* obuf = (bf16_t*)(P.ws + WS_R3);
    const int wid = TID >> 6, lane = TID & 63, fr = lane & 15, fq = lane >> 4;
    bf16_t* ST = (bf16_t*)sm; bf16_t* VN = (bf16_t*)(sm + 2 * 8704);
    for (int item = BID; item < NCHAIN * 4; item += NBLK) {
        const int xj = item >> 3, chain = (item & 7) * 8 + (xj >> 2), c0 = (xj & 3) * 32, b = chain >> 3, hh = (chain >> 1) & 3, dir = chain & 1;
        const unsigned char* blk0 = images + (size_t)chain * NSTEP * IMG_BYTES;
        const int oK = IMG_KT + (wid * 2 * 64 + lane) * 16;
        f32x4 Sacc[2];
        Sacc[0] = (f32x4){0.f, 0.f, 0.f, 0.f}; Sacc[1] = (f32x4){0.f, 0.f, 0.f, 0.f};
        for (int q = TID; q < 2 * 8704 / 4; q += 512) ((unsigned*)ST)[q] = 0u;
#define SC_SUPD(rkset) do { _Pragma("unroll") for (int tt = 0; tt < 2; ++tt) { f32x4 a = Sacc[tt] * dl; \
            _Pragma("unroll") for (int ks = 0; ks < 2; ++ks) a = mfma16(__builtin_bit_cast(bf16x8, rkset[ks]), frag16(VN + (tt * 16 + fr) * 72 + ks * 32 + fq * 8), a); \
            Sacc[tt] = a; u32x2 w_; w_[0] = pk2(a[0], a[1]); w_[1] = pk2(a[2], a[3]); *(u32x2*)(STn + (tt * 16 + fr) * 136 + wid * 16 + fq * 4) = w_; } } while (0)
        if (wid < 4) {
            const int mt = wid;
            const int oW = IMG_W + (mt * 4 * 64 + lane) * 16, oQ = IMG_Q + (mt * 4 * 64 + lane) * 16, oA = IMG_A + (mt * 2 * 64 + lane) * 16;
            const int oU = IMG_U + (((c0 >> 4) * 4 + mt) * 64 + lane) * 8;
            u32x4 rw[3][4], rk[3][2], rq[3][4], ra[3][2]; u32x2 ru[3][2]; float dlr[3];
#define SC_LOAD1(set, blk) do { \
            _Pragma("unroll") for (int ks = 0; ks < 4; ++ks) rw[set][ks] = *(const u32x4*)((blk) + oW + ks * 1024); \
            ru[set][0] = *(const u32x2*)((blk) + oU); ru[set][1] = *(const u32x2*)((blk) + oU + 2048); dlr[set] = *(const float*)((blk) + IMG_SC); } while (0)
#define SC_LOAD2(set, blk) do { \
            _Pragma("unroll") for (int ks = 0; ks < 2; ++ks) rk[set][ks] = *(const u32x4*)((blk) + oK + ks * 1024); \
            _Pragma("unroll") for (int ks = 0; ks < 4; ++ks) rq[set][ks] = *(const u32x4*)((blk) + oQ + ks * 1024); \
            _Pragma("unroll") for (int ks = 0; ks < 2; ++ks) ra[set][ks] = *(const u32x4*)((blk) + oA + ks * 1024); } while (0)
#define SC_LOAD(set, blk) do { SC_LOAD1(set, blk); SC_LOAD2(set, blk); } while (0)
            SC_LOAD(0, blk0); SC_LOAD(1, blk0 + IMG_BYTES); SC_LOAD(2, blk0 + 2 * IMG_BYTES);
            SYNC();
#pragma unroll 1
            for (int s3 = 0; s3 < NSTEP; s3 += 3) {
#pragma unroll
                for (int u = 0; u < 3; ++u) {
                    const int step = s3 + u, cur = step & 1;
                    const bf16_t* STc = ST + cur * 4352; bf16_t* STn = ST + (cur ^ 1) * 4352;
#pragma unroll
                    for (int nt = 0; nt < 2; ++nt) {
                        f32x4 vn = (f32x4){0.f, 0.f, 0.f, 0.f};
#pragma unroll
                        for (int ks = 0; ks < 4; ++ks) vn = mfma16(__builtin_bit_cast(bf16x8, rw[u][ks]), frag16(STc + (nt * 16 + fr) * 136 + ks * 32 + fq * 8), vn);
                        const unsigned u0 = ru[u][nt][0], u1 = ru[u][nt][1];
                        u32x2 w; w[0] = pk2(bf2f((bf16_t)(u0 & 0xffffu)) - vn[0], bf2f((bf16_t)(u0 >> 16)) - vn[1]); w[1] = pk2(bf2f((bf16_t)(u1 & 0xffffu)) - vn[2], bf2f((bf16_t)(u1 >> 16)) - vn[3]);
                        *(u32x2*)(VN + (nt * 16 + fr) * 72 + mt * 16 + fq * 4) = w;
                    }
                    const float dl = dlr[u];
                    const unsigned char* blk3 = blk0 + (size_t)(step + 3 < NSTEP ? step + 3 : NSTEP - 1) * IMG_BYTES;
                    SC_LOAD1(u, blk3);
                    SYNC();
                    SC_SUPD(rk[u]);
                    if (step >= 4) {
#pragma unroll
                        for (int nt = 0; nt < 2; ++nt) {
                            f32x4 o = (f32x4){0.f, 0.f, 0.f, 0.f};
#pragma unroll
                            for (int ks = 0; ks < 4; ++ks) o = mfma16(__builtin_bit_cast(bf16x8, rq[u][ks]), frag16(STc + (nt * 16 + fr) * 136 + ks * 32 + fq * 8), o);
#pragma unroll
                            for (int ks = 0; ks < 2; ++ks) o = mfma16(__builtin_bit_cast(bf16x8, ra[u][ks]), frag16(VN + (nt * 16 + fr) * 72 + ks * 32 + fq * 8), o);
#pragma unroll
                            for (int r = 0; r < 4; ++r) { const int pos = (step - 4) * 64 + mt * 16 + fq * 4 + r; const int tok = b * SEQ + (dir ? (SEQ - 1 - pos) : pos);
                                obuf[((size_t)dir * NTOK + tok) * 512 + hh * 128 + c0 + nt * 16 + fr] = f2bf(o[r]); }
                        }
                    }
                    SC_LOAD2(u, blk3);
                    SYNC();
                }
            }
#undef SC_LOAD
#undef SC_LOAD1
#undef SC_LOAD2
        } else {
            u32x4 rk[3][2]; float dlr[3];
#define SC_LOADK(set, blk) do { dlr[set] = *(const float*)((blk) + IMG_SC); _Pragma("unroll") for (int ks = 0; ks < 2; ++ks) rk[set][ks] = *(const u32x4*)((blk) + oK + ks * 1024); } while (0)
            SC_LOADK(0, blk0); SC_LOADK(1, blk0 + IMG_BYTES); SC_LOADK(2, blk0 + 2 * IMG_BYTES);
            SYNC();
#pragma unroll 1
            for (int s3 = 0; s3 < NSTEP; s3 += 3) {
#pragma unroll
                for (int u = 0; u < 3; ++u) {
                    const int step = s3 + u, cur = step & 1;
                    bf16_t* STn = ST + (cur ^ 1) * 4352;
                    const float dl = dlr[u];
                    SYNC();
                    SC_SUPD(rk[u]);
                    { const unsigned char* blk3 = blk0 + (size_t)(step + 3 < NSTEP ? step + 3 : NSTEP - 1) * IMG_BYTES; SC_LOADK(u, blk3); }
                    SYNC();
                }
            }
#undef SC_LOADK
        }
#undef SC_SUPD
        SYNC();
    }
}

DEV void phase6_amix(const Params& P, unsigned char* sm) {
    PHASE_TID;
    const bf16_t* ZT = (const bf16_t*)((const unsigned char*)P.out + DO_ZT);
    const bf16_t* zs = (const bf16_t*)((const unsigned char*)P.out + DO_ZS);
    const bf16_t* obuf = (const bf16_t*)(P.ws + WS_R3);
    bf16_t* amix = (bf16_t*)(P.ws + WS_R4 + R4_AMIX);
    unsigned* tile = (unsigned*)sm;
    for (int tt = BID; tt < NTOK / 64; tt += NBLK) {
        const int tok0 = tt * 64;
        { u32x4 r[8];
#pragma unroll
          for (int q = 0; q < 8; ++q) { const int idx = TID + q * 512, cp = idx >> 3, piece = idx & 7; r[q] = *(const u32x4*)(ZT + (size_t)cp * NTOK + tok0 + piece * 8); }
#pragma unroll
          for (int q = 0; q < 8; ++q) { const int idx = TID + q * 512, cp = idx >> 3, piece = idx & 7; unsigned* t = tile + cp * 33 + piece * 4; t[0] = r[q][0]; t[1] = r[q][1]; t[2] = r[q][2]; t[3] = r[q][3]; } }
        SYNC();
        u32x4 oa[8], ob[8], oz[8];
#pragma unroll
        for (int q = 0; q < 8; ++q) { const int idx = TID + q * 512, tok = idx >> 6, hh = (idx >> 4) & 3, l16 = idx & 15; const size_t off = (size_t)(tok0 + tok) * 512 + hh * 128 + l16 * 8;
            oa[q] = *(const u32x4*)(obuf + off); ob[q] = *(const u32x4*)(obuf + (size_t)NTOK * 512 + off); oz[q] = *(const u32x4*)(zs + off); }
#pragma unroll
        for (int q = 0; q < 8; ++q) { const int tok = TID & 63, c8 = ((TID >> 6) * 8 + q) * 8, sh = (tok & 1) * 16; u32x4 o;
#pragma unroll
            for (int j = 0; j < 4; ++j) o[j] = ((tile[(c8 + 2 * j) * 33 + (tok >> 1)] >> sh) & 0xffffu) | (((tile[(c8 + 2 * j + 1) * 33 + (tok >> 1)] >> sh) & 0xffffu) << 16);
            *(u32x4*)(amix + (size_t)(tok0 + tok) * 1024 + c8) = o; }
        const int l16 = TID & 15;
        float og[8];
#pragma unroll
        for (int j = 0; j < 8; ++j) og[j] = P.onorm_g[l16 * 8 + j];
#pragma unroll
        for (int q = 0; q < 8; ++q) {
            const int idx = TID + q * 512, tok = idx >> 6, hh = (idx >> 4) & 3;
            const u32x4 a = oa[q], bq = ob[q], zv = oz[q];
            float v[8]; float ss = 0.f;
#pragma unroll
            for (int j = 0; j < 4; ++j) { v[2 * j] = bf2f((bf16_t)(a[j] & 0xffffu)) + bf2f((bf16_t)(bq[j] & 0xffffu)); v[2 * j + 1] = bf2f((bf16_t)(a[j] >> 16)) + bf2f((bf16_t)(bq[j] >> 16)); }
#pragma unroll
            for (int j = 0; j < 8; ++j) ss += v[j] * v[j];
            ss += shfl_xor_f(ss, 1); ss += shfl_xor_f(ss, 2); ss += shfl_xor_f(ss, 4); ss += shfl_xor_f(ss, 8);
            const float rstd = rsq_f(ss * (1.0f / 128.0f) + EPS);
            u32x4 o;
#pragma unroll
            for (int j = 0; j < 4; ++j) o[j] = pk2(v[2 * j] * rstd * og[2 * j] * bf2f((bf16_t)(zv[j] & 0xffffu)), v[2 * j + 1] * rstd * og[2 * j + 1] * bf2f((bf16_t)(zv[j] >> 16)));
            *(u32x4*)(amix + (size_t)(tok0 + tok) * 1024 + 512 + hh * 128 + l16 * 8) = o;
        }
        SYNC();
    }
}

DEV void phase8_router(const Params& P, unsigned char* sm, int dry) {
    PHASE_TID;
    float* wr = (float*)sm;
    {
        f32x4 g[2], rt[2][8];
#pragma unroll
        for (int h = 0; h < 2; ++h) { const int k = TID + h * 512; g[h] = *(const f32x4*)(P.w_group + k * 4);
#pragma unroll
            for (int q = 0; q < 8; ++q) rt[h][q] = *(const f32x4*)(P.w_router + k * 32 + q * 4); }
#pragma unroll
        for (int h = 0; h < 2; ++h) { const int k = TID + h * 512;
#pragma unroll
            for (int e = 0; e < 4; ++e) wr[e * 1028 + k] = g[h][e];
#pragma unroll
            for (int q = 0; q < 8; ++q)
#pragma unroll
                for (int e = 0; e < 4; ++e) wr[(4 + q * 4 + e) * 1028 + k] = rt[h][q][e]; }
    }
    SYNC();
    const float* mod = (const float*)(P.ws + WS_MOD);
    const float* x1 = P.out;
    bf16_t* h2 = (bf16_t*)(P.ws + WS_R4 + R4_H2);
    unsigned* cnt = (unsigned*)(P.ws + WS_CNT + (dry ? 8192 : 0)); unsigned* tokk = (unsigned*)(P.ws + (dry ? WS_R3 : WS_TOKK)); float* wl = (float*)(P.ws + (dry ? WS_R3 + 16 * MiB : WS_WL));
    const int wid = TID >> 6, lane = TID & 63;
    const int rstep = NBLK * 8;
    int r = BID * 8 + wid;
    unsigned* lc = (unsigned*)(sm + 148224);
    unsigned* aE = lc + 64; float* aW = (float*)(aE + 512); unsigned* aP = (unsigned*)(aW + 512);
    float* gsv = (float*)(sm + 154624); float* shv = gsv + 1024;
    float* brs = shv + 1024;
    if (TID < 32) { lc[TID] = 0u; brs[TID] = P.b_router[TID]; }
    const float bg0 = P.b_group[0], bg1 = P.b_group[1], bg2 = P.b_group[2], bg3 = P.b_group[3];
    SYNC();
    int jrow = 0;
    f32x4 vr[4][4];
#pragma unroll
    for (int jj = 0; jj < 4; ++jj) { const int rl = (r + jj * rstep < NTOK) ? r + jj * rstep : r;
#pragma unroll
        for (int i = 0; i < 4; ++i) vr[jj][i] = *(const f32x4*)(x1 + (size_t)rl * D + i * 256 + lane * 4); }
    const float n2a = P.norm2_g[TID], n2b = P.norm2_g[TID + 512];
    float msa, msb, mha, mhb;
    { const float* shift = mod + (r >> 13) * 6144 + 3 * 1024; msa = shift[1024 + TID]; msb = shift[1024 + TID + 512]; mha = shift[TID]; mhb = shift[TID + 512]; }
#pragma unroll 1
    for (; r < NTOK; ) {
        SYNC();
        gsv[TID] = n2a * (1.0f + msa); gsv[TID + 512] = n2b * (1.0f + msb); shv[TID] = mha; shv[TID + 512] = mhb;
        { const int rn = (r + 4 * rstep < NTOK) ? r + 4 * rstep : r; const float* shift = mod + (rn >> 13) * 6144 + 3 * 1024; msa = shift[1024 + TID]; msb = shift[1024 + TID + 512]; mha = shift[TID]; mhb = shift[TID + 512]; }
        SYNC();
#pragma unroll
      for (int jj = 0; jj < 4; ++jj) { if (r < NTOK) {
        f32x4 v[4]; float ss = 0.f;
#pragma unroll
        for (int i = 0; i < 4; ++i) { v[i] = vr[jj][i]; ss += v[i][0] * v[i][0] + v[i][1] * v[i][1] + v[i][2] * v[i][2] + v[i][3] * v[i][3]; }
        { const int rl = (r + 4 * rstep < NTOK) ? r + 4 * rstep : r;
#pragma unroll
          for (int i = 0; i < 4; ++i) vr[jj][i] = *(const f32x4*)(x1 + (size_t)rl * D + i * 256 + lane * 4); }
        ss = wave_sum(ss);
        const float rstd = rsq_f(ss * (1.0f / 1024.0f) + EPS);
        float gl[4] = {0.f, 0.f, 0.f, 0.f};
#pragma unroll
        for (int i = 0; i < 4; ++i) {
            const int k = i * 256 + lane * 4;
            const f32x4 g2 = *(const f32x4*)(gsv + k), sh = *(const f32x4*)(shv + k);
#pragma unroll
            for (int e = 0; e < 4; ++e) v[i][e] = v[i][e] * rstd * g2[e] + sh[e];
#pragma unroll
            for (int j = 0; j < 4; ++j) { const f32x4 wv = *(const f32x4*)(wr + j * 1028 + k); gl[j] += v[i][0] * wv[0] + v[i][1] * wv[1] + v[i][2] * wv[2] + v[i][3] * wv[3]; }
            u32x2 w; w[0] = pk2(v[i][0], v[i][1]); w[1] = pk2(v[i][2], v[i][3]);
            *(u32x2*)(h2 + (size_t)r * D + k) = w;
        }
#pragma unroll
        for (int j = 0; j < 4; ++j) gl[j] += 0.f;
        { const float t = wave_sum_multi<4>(gl, lane);
#pragma unroll
          for (int j = 0; j < 4; ++j) gl[j] = lane_bcast(t, j) + (j == 0 ? bg0 : j == 1 ? bg1 : j == 2 ? bg2 : bg3); }
        int gsel = 0; float gmax = gl[0];
#pragma unroll
        for (int j = 1; j < 4; ++j) if (gl[j] > gmax) { gmax = gl[j]; gsel = j; }
        float gden = 0.f;
#pragma unroll
        for (int j = 0; j < 4; ++j) gden += __expf(gl[j] - gmax);
        const float pg = 1.0f / gden;
        float el[8] = {0.f, 0.f, 0.f, 0.f, 0.f, 0.f, 0.f, 0.f};
#pragma unroll
        for (int i = 0; i < 4; ++i)
#pragma unroll
            for (int j = 0; j < 8; ++j) { const f32x4 wv = *(const f32x4*)(wr + (4 + gsel * 8 + j) * 1028 + i * 256 + lane * 4); el[j] += v[i][0] * wv[0] + v[i][1] * wv[1] + v[i][2] * wv[2] + v[i][3] * wv[3]; }
#pragma unroll
        for (int j = 0; j < 8; ++j) el[j] += 0.f;
        { const float t = wave_sum_multi<8>(el, lane);
#pragma unroll
          for (int j = 0; j < 8; ++j) el[j] = lane_bcast(t, j) + brs[gsel * 8 + j]; }
        int e1 = 0; float m1 = el[0];
#pragma unroll
        for (int j = 1; j < 8; ++j) if (el[j] > m1) { m1 = el[j]; e1 = j; }
        int e2 = -1; float m2 = -3.0e38f;
#pragma unroll
        for (int j = 0; j < 8; ++j) if (j != e1 && el[j] > m2) { m2 = el[j]; e2 = j; }
        if (e2 < 0) e2 = (e1 + 1) & 7;
        const float p2 = __expf(m2 - m1);
        const float w1 = pg / (1.0f + p2), w2 = pg * p2 / (1.0f + p2);
        if (lane < 2) {
            const int ee = gsel * 8 + (lane == 0 ? e1 : e2); const float ww = lane == 0 ? w1 : w2;
            const unsigned pos = atomic_add_u32(&lc[ee], 1u);
            const int a = (jrow * 8 + wid) * 2 + lane;
            if (a < 512) { aE[a] = (unsigned)ee; aW[a] = ww; aP[a] = pos; }
        }
        ++jrow; r += rstep;
      } }
    }
    SYNC();
    if (TID < 32) lc[32 + TID] = atomic_add_u32(&cnt[TID * 64], lc[TID]);
    SYNC();
    { const int a = TID, rl = a >> 1, rr = BID * 8 + (rl & 7) + (rl >> 3) * rstep;
      if (rr < NTOK && (rl >> 3) < jrow) { const unsigned ee = aE[a]; const unsigned pos = lc[32 + ee] + aP[a];
          tokk[(size_t)ee * LCAP + pos] = (unsigned)rr * 2u + (unsigned)(a & 1); wl[(size_t)ee * LCAP + pos] = aW[a]; } }
}

DEV void phase11_final(const Params& P, unsigned char* sm, float* dstbase) {
    PHASE_TID;
    (void)sm;
    const float* mod = (const float*)(P.ws + WS_MOD);
    const bf16_t* Y = (const bf16_t*)(P.ws + WS_R4 + R4_Y);
    const int wid = TID >> 6, lane = TID & 63;
    for (int r0 = (BID * 8 + wid) * 2; r0 < NTOK; r0 += NBLK * 16) {
        f32x4 xv[2][4]; u32x2 y0[2][4], y1[2][4];
#pragma unroll
        for (int u = 0; u < 2; ++u)
#pragma unroll
            for (int i = 0; i < 4; ++i) { const int k = i * 256 + lane * 4; const size_t r = (size_t)(r0 + u);
                xv[u][i] = *(const f32x4*)(P.out + r * D + k); y0[u][i] = *(const u32x2*)(Y + r * D + k); y1[u][i] = *(const u32x2*)(Y + ((size_t)NTOK + r) * D + k); }
        const float* gate = mod + (r0 >> 13) * 6144 + 5 * 1024;
#pragma unroll
        for (int u = 0; u < 2; ++u) {
            float* row = dstbase + (size_t)(r0 + u) * D;
            f32x4 v[4]; float ss = 0.f;
#pragma unroll
            for (int i = 0; i < 4; ++i) { const int k = i * 256 + lane * 4; const f32x4 gv = *(const f32x4*)(gate + k);
                f32x4 m; m[0] = bf2f((bf16_t)(y0[u][i][0] & 0xffffu)) + bf2f((bf16_t)(y1[u][i][0] & 0xffffu)); m[1] = bf2f((bf16_t)(y0[u][i][0] >> 16)) + bf2f((bf16_t)(y1[u][i][0] >> 16));
                m[2] = bf2f((bf16_t)(y0[u][i][1] & 0xffffu)) + bf2f((bf16_t)(y1[u][i][1] & 0xffffu)); m[3] = bf2f((bf16_t)(y0[u][i][1] >> 16)) + bf2f((bf16_t)(y1[u][i][1] >> 16));
                v[i] = xv[u][i] + gv * m; ss += v[i][0] * v[i][0] + v[i][1] * v[i][1] + v[i][2] * v[i][2] + v[i][3] * v[i][3]; }
            ss = wave_sum(ss);
            const float rstd = rsq_f(ss * (1.0f / 1024.0f) + EPS);
#pragma unroll
            for (int i = 0; i < 4; ++i) { const int k = i * 256 + lane * 4; const f32x4 fg = *(const f32x4*)(P.final_g + k); *(f32x4*)(row + k) = v[i] * rstd * fg; }
        }
    }
}

#ifndef CPU_EMU
#define XB_TMO      128
#define XB_XCNT(j)  (256  + 64 * (j))
#define XB_XSUB(j)  (1280 + 64 * (j))
#define XB_XGEN(j)  (2304 + 64 * (j))
#define XB_TOP      3328
#define XB_TOPGEN   3392
#define XCD_BAR_WORDS 3456
#define XB_SPIN_CAP (1u << 22)
#define LAS __attribute__((address_space(3)))
__device__ __forceinline__ unsigned xb_ld(unsigned* p)              { return __hip_atomic_load(p, __ATOMIC_RELAXED, __HIP_MEMORY_SCOPE_AGENT); }
__device__ __forceinline__ unsigned xb_add(unsigned* p, unsigned v) { return __hip_atomic_fetch_add(p, v, __ATOMIC_RELAXED, __HIP_MEMORY_SCOPE_AGENT); }
__device__ __forceinline__ unsigned xb_xcc_id() { return (unsigned)__builtin_amdgcn_s_getreg((3 << 11) | 20) & 0xFu; }
#define XB_SPIN(cond, bar) do { unsigned _sp = 0; while (cond) { __builtin_amdgcn_s_sleep(1); \
    if ((++_sp & 255u) == 0u) { if (xb_ld(&(bar)[XB_TMO])) break; if (_sp > XB_SPIN_CAP) { atomicAdd(&(bar)[XB_TMO], 1u); break; } } } } while (0)
struct XcdBarrier { unsigned* bar; unsigned x; volatile LAS unsigned* st; };
__device__ __forceinline__ XcdBarrier xcd_barrier_post(unsigned* bar, volatile LAS unsigned* st) {
    XcdBarrier b; b.bar = bar; b.x = xb_xcc_id(); b.st = st;
    if (threadIdx.x == 0) (void)xb_add(&bar[XB_XCNT(b.x)], 1u);
    return b;
}
__device__ __forceinline__ void xcd_barrier_complete(unsigned* bar, unsigned x, unsigned& nloc, unsigned& nx) {
    const unsigned G = gridDim.x * gridDim.y * gridDim.z;
    unsigned sum, cnt, mine, sp = 0u;
    for (;;) {
        sum = 0u; cnt = 0u; mine = 0u;
#pragma unroll
        for (unsigned j = 0; j < 16; ++j) { const unsigned c = xb_ld(&bar[XB_XCNT(j)]); sum += c; cnt += (c > 0u) ? 1u : 0u; mine = (j == x) ? c : mine; }
        if (sum == G) break;
        __builtin_amdgcn_s_sleep(1);
        if ((++sp & 255u) == 0u) { if (xb_ld(&bar[XB_TMO])) break; if (sp > XB_SPIN_CAP) { atomicAdd(&bar[XB_TMO], 1u); break; } }
    }
    nloc = mine > 0u ? mine : 1u; nx = cnt > 0u ? cnt : 1u;
}
__device__ __forceinline__ void xcd_barrier(const XcdBarrier& b) {
    asm volatile("s_waitcnt vmcnt(0)" ::: "memory");
    __syncthreads();
    if (threadIdx.x == 0) {
        unsigned* bar = b.bar;
        __builtin_amdgcn_s_waitcnt(0);
        unsigned nloc = b.st[0], nx = b.st[1];
        if (nloc == 0u) { xcd_barrier_complete(bar, b.x, nloc, nx); b.st[0] = nloc; b.st[1] = nx; }
        const unsigned old = xb_add(&bar[XB_XSUB(b.x)], 1u);
        const unsigned gen = old / nloc;
        if (old + 1u == (gen + 1u) * nloc) {
            __builtin_amdgcn_fence(__ATOMIC_RELEASE, "agent");
            asm volatile("s_waitcnt vmcnt(0)" ::: "memory");
            const unsigned og = xb_add(&bar[XB_TOP], 1u);
            const unsigned tg = og / nx;
            if (og + 1u == (tg + 1u) * nx) xb_add(&bar[XB_TOPGEN], 1u);
            else XB_SPIN(xb_ld(&bar[XB_TOPGEN]) == tg, bar);
            __builtin_amdgcn_fence(__ATOMIC_ACQUIRE, "agent");
            xb_add(&bar[XB_XGEN(b.x)], 1u);
            asm volatile("s_waitcnt vmcnt(0)" ::: "memory");
        } else {
            XB_SPIN(xb_ld(&bar[XB_XGEN(b.x)]) == gen, bar);
            __builtin_amdgcn_fence(__ATOMIC_ACQUIRE, "agent");
            asm volatile("s_waitcnt vmcnt(0)" ::: "memory");
        }
    }
    __syncthreads();
}

#ifndef MK_PH
#define MK_PH 0x7ff
#endif
#ifndef MK_REP
#define MK_REP 0
#endif
#define REPS(k) for (int rep_ = 0; rep_ < (((MK_REP >> (k)) & 1) ? 2 : 1); ++rep_)
extern __shared__ __attribute__((aligned(16))) unsigned char smem_dyn[];

__device__ __forceinline__ void moe_tables(const Params& P, LAS int* tb, LAS int* cn) {
    const unsigned* cnt = (const unsigned*)(P.ws + WS_CNT);
    if (threadIdx.x < 32) cn[threadIdx.x] = (int)cnt[threadIdx.x * 64];
    __syncthreads();
    if (threadIdx.x == 0) { int acc = 0; for (int e = 0; e < 32; ++e) { tb[e] = acc; acc += (cn[e] + 255) >> 8; } tb[32] = acc; }
    __syncthreads();
}

__global__ void __launch_bounds__(512, 2) hymba_fwd(Params P) {
    unsigned char* sm = smem_dyn;
    LAS unsigned char* lsm = (LAS unsigned char*)smem_dyn;
    volatile LAS unsigned* xbw = (volatile LAS unsigned*)(lsm + LDS_BYTES - 16);
    if (threadIdx.x == 0) { xbw[0] = 0u; xbw[1] = 0u; xbw[2] = 0u; xbw[3] = 0u; }
    __syncthreads();
    XcdBarrier bar = xcd_barrier_post((unsigned*)(P.ws + WS_BAR), xbw);
    using namespace pg8;

#if (MK_PH >> 0) & 1
    REPS(15) phase0_mod(P, sm); REPS(0) { phase0_weights(P, sm); phase0_wf(P, sm); }
    xcd_barrier(bar);
#endif
#if (MK_PH >> 1) & 1
    REPS(1) phase1_prep(P, sm);
    xcd_barrier(bar);
#endif
#if (MK_PH >> 2) & 1
    REPS(2) {
    { ProbInproj G; G.init(MROWS / 256, 8, gridDim.x, blockIdx.x); G.A = (const bf16_t*)(P.ws + WS_R4 + R4_H); G.Bt = (const bf16_t*)(P.ws + WS_WQKVZ); G.K = 1024;
      EpiInproj E; E.O = (bf16_t*)(P.ws + WS_R4 + R4_P); E.zs = (bf16_t*)((unsigned char*)P.out + DO_ZS); E.rstd = (const float*)(P.ws + WS_RSTD); E.bias = (const float*)(P.ws + WS_BIAS); gemm_phase(lsm, G, E); }
    { ProbGT G; G.init(4, NTOK / 256, gridDim.x, blockIdx.x); G.A = (const bf16_t*)(P.ws + WS_WF); G.Bt = (const bf16_t*)(P.ws + WS_R4 + R4_H); G.K = 1024;
      EpiGT E; E.O = (bf16_t*)((unsigned char*)P.out + DO_GT); E.rstd = (const float*)(P.ws + WS_RSTD); E.bias = (const float*)(P.ws + WS_BIAS); gemm_phase(lsm, G, E); }
    }
    xcd_barrier(bar);
#endif
#if (MK_PH >> 3) & 1
    REPS(3) phase3_conv(P, sm);
    xcd_barrier(bar);
#endif
#if (MK_PH >> 4) & 1
    REPS(4) phase4_prepass(P, sm);
    REPS(11) phase4_fft(P, sm);
    xcd_barrier(bar);
#endif
#if (MK_PH >> 5) & 1
    REPS(5) phase5_scan(P, sm);
    xcd_barrier(bar);
#endif
#if (MK_PH >> 6) & 1
    REPS(6) phase6_amix(P, sm);
    xcd_barrier(bar);
#endif
#if (MK_PH >> 7) & 1
    REPS(7)
    { ProbOut G; G.init(NTOK / 256, 4, gridDim.x, blockIdx.x); G.A = (const bf16_t*)(P.ws + WS_R4 + R4_AMIX); G.Bt = (const bf16_t*)(P.ws + WS_WOUT); G.K = 1024;
      EpiResid E; E.x = P.x; E.mod = (const float*)(P.ws + WS_MOD); E.out = P.out; gemm_phase(lsm, G, E); }
    xcd_barrier(bar);
#endif
#if (MK_PH >> 8) & 1
#if (MK_REP >> 13) & 1
    phase8_router(P, sm, 1);
#endif
    phase8_router(P, sm, 0);
#if (MK_REP >> 14) & 1
    xcd_barrier(bar); xcd_barrier(bar); xcd_barrier(bar); xcd_barrier(bar);
#endif
    xcd_barrier(bar);
#endif
#if (MK_PH >> 9) & 1
    LAS int* tb = (LAS int*)(lsm + STAGE_BYTES); LAS int* cn = tb + 64;
    moe_tables(P, tb, cn);
    REPS(9)
    { ProbMoe1 G; G.tb = tb; G.cnt = cn; G.G = gridDim.x; G.c = blockIdx.x; G.A = (const bf16_t*)(P.ws + WS_R4 + R4_H2); G.Bt = (const bf16_t*)(P.ws + WS_WGU); G.K = 1024; G.tokk = (const unsigned*)(P.ws + WS_TOKK);
      EpiMoe1 E; E.hid = (bf16_t*)(P.ws + WS_R4 + R4_HID); gemm_phase(lsm, G, E); }
    xcd_barrier(bar);
    REPS(10)
    { ProbMoe2 G; G.tb = tb; G.cnt = cn; G.G = gridDim.x; G.c = blockIdx.x; G.A = (const bf16_t*)(P.ws + WS_R4 + R4_HID); G.Bt = (const bf16_t*)(P.ws + WS_WD); G.K = 512;
      EpiMoe2 E; E.Y = (bf16_t*)(P.ws + WS_R4 + R4_Y); E.tokk = (const unsigned*)(P.ws + WS_TOKK); E.wl = (const float*)(P.ws + WS_WL); E.tb = tb; gemm_phase(lsm, G, E); }
    xcd_barrier(bar);
#endif
#if (MK_PH >> 10) & 1
#if (MK_REP >> 12) & 1
    phase11_final(P, sm, (float*)(P.ws + WS_R4 + 300 * MiB));
#endif
    phase11_final(P, sm, P.out);
#endif
}

extern "C" void kernel_launch(void* const* d_in, const int* in_sizes, int n_in, void* d_out, int out_size, void* d_ws, size_t ws_size, hipStream_t stream) {
    (void)in_sizes; (void)n_in; (void)out_size;
    static int grid = 0;
    if (!grid) {
        int dev = 0, cus = 0, per_cu = 0;
        hipGetDevice(&dev);
        hipDeviceGetAttribute(&cus, hipDeviceAttributeMultiprocessorCount, dev);
        hipFuncSetAttribute((const void*)hymba_fwd, hipFuncAttributeMaxDynamicSharedMemorySize, LDS_BYTES);
        hipOccupancyMaxActiveBlocksPerMultiprocessor(&per_cu, hymba_fwd, 512, LDS_BYTES);
        if (per_cu < 1) { fprintf(stderr, "occupancy query says 0 blocks per CU\n"); per_cu = 1; }
        grid = cus;
        if (ws_size < WS_NEED) fprintf(stderr, "workspace too small: %zu < %zu\n", ws_size, (size_t)WS_NEED);
    }
    Params p{};
    p.x = (const float*)d_in[0]; p.c = (const float*)d_in[1]; p.ctx = (const float*)d_in[2]; p.c_ctx = (const float*)d_in[3]; p.w_mod = (const float*)d_in[4]; p.b_mod = (const float*)d_in[5];
    p.norm1_g = (const float*)d_in[6]; p.w_in = (const float*)d_in[7]; p.conv_w = (const float*)d_in[8]; p.a_log = (const float*)d_in[9]; p.dt_bias = (const float*)d_in[10]; p.onorm_g = (const float*)d_in[11];
    p.w_out = (const float*)d_in[12]; p.norm2_g = (const float*)d_in[13]; p.w_group = (const float*)d_in[14]; p.b_group = (const float*)d_in[15]; p.w_router = (const float*)d_in[16]; p.b_router = (const float*)d_in[17];
    p.w_gate = (const float*)d_in[18]; p.w_up = (const float*)d_in[19]; p.w_down = (const float*)d_in[20]; p.final_g = (const float*)d_in[21];
    p.out = (float*)d_out; p.ws = (unsigned char*)d_ws;
    hipMemsetAsync(d_ws, 0, WS_ZERO_BYTES, stream);
    hipLaunchKernelGGL(hymba_fwd, dim3(grid), dim3(512), LDS_BYTES, stream, p);
}
#endif
```

```cpp
#ifndef CPU_EMU
#include <hip/hip_runtime.h>
#include <cstdio>
#include <cstdint>
#define DEV __device__ __forceinline__
#define TID tid_local
#define PHASE_TID int tid_local = (int)threadIdx.x; asm volatile("" : "+v"(tid_local))
#define BID ((int)blockIdx.x)
#define NBLK ((int)gridDim.x)
#define SYNC() __syncthreads()
#define SCHED_FENCE() __builtin_amdgcn_sched_barrier(0)
#endif

typedef unsigned short bf16_t;
typedef short bf16x8 __attribute__((ext_vector_type(8)));
typedef float f32x4 __attribute__((ext_vector_type(4)));
typedef unsigned u32x4 __attribute__((ext_vector_type(4)));
typedef unsigned u32x2 __attribute__((ext_vector_type(2)));

constexpr int D = 1024, NB = 8, SEQ = 8192, CTX = 256;
constexpr int NTOK = NB * SEQ;
constexpr int NCTX = NB * CTX;
constexpr int MROWS = NTOK + NCTX;
constexpr int W_IN = 2576;
constexpr int NSTEP = 4 + 128;
constexpr int NCHAIN = NB * 4 * 2;
constexpr int NPROB = NCHAIN * NSTEP;
constexpr float EPS = 1e-6f;
constexpr int NEXP = 32;
constexpr int LCAP = 65536;

constexpr int IMG_W = 0, IMG_KT = 16384, IMG_A = 32768, IMG_U = 40960, IMG_SC = 57344, IMG_BYTES = 57664;

constexpr size_t MiB = 1048576;
constexpr size_t WS_BAR = 0;
constexpr size_t WS_MOD = 16384;
constexpr size_t WS_CNT = 16384 + 221184;
constexpr size_t WS_ZERO_BYTES = WS_CNT + 16384;
constexpr size_t WS_TAB = 262144;
constexpr size_t WS_BIAS = 393216;
constexpr size_t WS_RSTD = 5 * MiB + 524288;
constexpr size_t WS_GB = 1 * MiB;
constexpr size_t WS_TOKK = 6 * MiB;
constexpr size_t WS_WL = 14 * MiB;
constexpr size_t WS_W = 22 * MiB;
constexpr size_t WS_WQKVZ = WS_W;
constexpr size_t WS_WF = WS_WQKVZ + 2048ull * 1024 * 2;
constexpr size_t WS_WOUT = WS_WF + 1024ull * 1024 * 2;
constexpr size_t WS_WGU = WS_WOUT + 1024ull * 1024 * 2;
constexpr size_t WS_WD = WS_WGU + 32ull * 1024 * 1024 * 2;
constexpr size_t WS_R3 = 126 * MiB;
constexpr size_t WS_R4 = 324 * MiB;
constexpr size_t WS_NEED = WS_R4 + 645 * MiB;
constexpr size_t R4_H = 0, R4_P = 132 * MiB;
constexpr size_t R4_AMIX = 0, R4_H2 = 128 * MiB, R4_HID = 256 * MiB, R4_Y = 0;
constexpr size_t R4_OBUF = 480 * MiB;
constexpr size_t DO_GT = 0, DO_ZT = 128 * MiB, DO_ZS = 192 * MiB;

constexpr int LDS_BYTES = 163840;

struct Params {
    const float *x, *c, *ctx, *c_ctx, *w_mod, *b_mod, *norm1_g, *w_in, *conv_w, *a_log, *dt_bias, *onorm_g, *w_out, *norm2_g,
                *w_group, *b_group, *w_router, *b_router, *w_gate, *w_up, *w_down, *final_g;
    float* out;
    unsigned char* ws;
};

DEV bf16_t f2bf(float f) { unsigned u = __builtin_bit_cast(unsigned, f); u += 0x7FFFu + ((u >> 16) & 1u); return (bf16_t)(u >> 16); }
DEV float bf2f(bf16_t b) { return __builtin_bit_cast(float, ((unsigned)b) << 16); }
#ifndef CPU_EMU
typedef __bf16 bf16n2 __attribute__((ext_vector_type(2)));
DEV unsigned pk2(float lo, float hi) { bf16n2 v; v[0] = (__bf16)lo; v[1] = (__bf16)hi; return __builtin_bit_cast(unsigned, v); }
DEV float rcp_f(float x) { return __builtin_amdgcn_rcpf(x); }
DEV float rsq_f(float x) { return __builtin_amdgcn_rsqf(x); }
#else
DEV unsigned pk2(float lo, float hi) { return (unsigned)f2bf(lo) | ((unsigned)f2bf(hi) << 16); }
DEV float rcp_f(float x) { return 1.0f / x; }
DEV float rsq_f(float x) { return 1.0f / sqrtf(x); }
#endif
DEV float silu_f(float v) { return v * rcp_f(1.0f + __expf(-v)); }

#ifndef CPU_EMU
DEV f32x4 mfma16(bf16x8 a, bf16x8 b, f32x4 c) { return __builtin_amdgcn_mfma_f32_16x16x32_bf16(a, b, c, 0, 0, 0); }
DEV float shfl_xor_f(float v, int m) { return __shfl_xor(v, m); }
DEV float shfl_up_f(float v, int d) { return __shfl_up(v, d); }
DEV float shfl_idx_f(float v, int l) { return __shfl(v, l); }
DEV void atomic_add_f32(float* p, float v) { atomicAdd(p, v); }
DEV unsigned atomic_add_u32(unsigned* p, unsigned v) { return atomicAdd(p, v); }
DEV void sincospi_f(float x, float* s, float* c) { sincospif(x, s, c); }
#endif

DEV float wave_sum(float v) {
#pragma unroll
    for (int o = 32; o >= 1; o >>= 1) v += shfl_xor_f(v, o);
    return v;
}
template <int N> DEV float wave_sum_multi(const float (&v)[N], int lane) {
    float a[N];
#pragma unroll
    for (int i = 0; i < N; ++i) a[i] = v[i];
    int m = 1;
#pragma unroll
    for (int n = N; n > 1; n >>= 1, m <<= 1) {
        const bool up = (lane & m) != 0;
#pragma unroll
        for (int i = 0; i < n / 2; ++i) { const float keep = up ? a[2 * i + 1] : a[2 * i], send = up ? a[2 * i] : a[2 * i + 1]; a[i] = keep + shfl_xor_f(send, m); }
    }
    float r = a[0];
#pragma unroll
    for (int o = N; o < 64; o <<= 1) r += shfl_xor_f(r, o);
    return r;
}
#ifndef CPU_EMU
DEV float lane_bcast(float v, int l) { return __builtin_bit_cast(float, __builtin_amdgcn_readlane(__builtin_bit_cast(int, v), l)); }
#endif
DEV bf16x8 frag_gather(const bf16_t* p, int stride) {
    bf16x8 r;
#pragma unroll
    for (int j = 0; j < 8; ++j) r[j] = (short)p[j * stride];
    return r;
}
DEV bf16x8 frag16(const bf16_t* p) { return *(const bf16x8*)p; }

DEV void phase0_mod(const Params& P, unsigned char* sm) {
    PHASE_TID;
    float* sil = (float*)sm;
    float* red = (float*)(sm + 36864);
    for (int i = TID; i < 9 * 1024; i += 512) { const int r = i >> 10, k = i & 1023; const float v = r < 8 ? P.c[r * 1024 + k] : P.c_ctx[k]; sil[i] = silu_f(v); }
    SYNC();
    float* mod = (float*)(P.ws + WS_MOD);
    for (int cb = BID; cb < 256; cb += NBLK) {
        const int c = TID % 24, kg = TID / 24, j0 = cb * 24;
        if (kg < 21) {
            float acc[9];
#pragma unroll
            for (int r = 0; r < 9; ++r) acc[r] = 0.f;
#pragma unroll 7
            for (int k = kg; k < 1024; k += 21) { const float w = P.w_mod[(size_t)k * 6144 + j0 + c];
#pragma unroll
                for (int r = 0; r < 9; ++r) acc[r] += sil[r * 1024 + k] * w; }
#pragma unroll
            for (int r = 0; r < 9; ++r) red[(kg * 24 + c) * 9 + r] = acc[r];
        }
        SYNC();
        if (TID < 24 * 9) { const int cc = TID / 9, r = TID - cc * 9; float t = P.b_mod[j0 + cc];
            for (int g = 0; g < 21; ++g) t += red[(g * 24 + cc) * 9 + r];
            mod[r * 6144 + j0 + cc] = t; }
        SYNC();
    }
}

DEV void tconv_tile(const float* src, int lds_, bf16_t* dst, int ldd, int inter, unsigned char* sm) {
    PHASE_TID;
    float* tile = (float*)sm;
    f32x4 v[8];
#pragma unroll
    for (int q = 0; q < 8; ++q) v[q] = *(const f32x4*)(src + (size_t)((TID >> 6) + q * 8) * lds_ + (TID & 63) * 4);
#pragma unroll
    for (int q = 0; q < 8; ++q) { float* t = tile + ((TID >> 6) + q * 8) * 257 + (TID & 63) * 4; t[0] = v[q][0]; t[1] = v[q][1]; t[2] = v[q][2]; t[3] = v[q][3]; }
    SYNC();
    const int c = TID & 255, half = TID >> 8;
    const int drow = inter ? ((c >> 7) * 256 + (inter - 1) * 128 + (c & 127)) : c;
    u32x4 w[4];
#pragma unroll
    for (int q = 0; q < 4; ++q)
#pragma unroll
        for (int j = 0; j < 4; ++j) w[q][j] = pk2(tile[(half * 32 + q * 8 + 2 * j) * 257 + c], tile[(half * 32 + q * 8 + 2 * j + 1) * 257 + c]);
#pragma unroll
    for (int q = 0; q < 4; ++q) *(u32x4*)(dst + (size_t)drow * ldd + half * 32 + q * 8) = w[q];
    SYNC();
}

DEV void phase0_weights(const Params& P, unsigned char* sm) {
    bf16_t* wqkvz = (bf16_t*)(P.ws + WS_WQKVZ); bf16_t* wout = (bf16_t*)(P.ws + WS_WOUT); bf16_t* wgu = (bf16_t*)(P.ws + WS_WGU); bf16_t* wd = (bf16_t*)(P.ws + WS_WD);
    const int NJ = 128 + 64 + 3 * 1024;
    for (int t = BID; t < NJ; t += NBLK) {
        if (t < 128) { const int kt = t >> 3, nt = t & 7;
            tconv_tile(P.w_in + (size_t)(kt * 64) * W_IN + 512 + nt * 256, W_IN, wqkvz + (size_t)(nt * 256) * 1024 + kt * 64, 1024, 0, sm);
        } else if (t < 192) { const int u = t - 128, kt = u >> 2, nt = u & 3;
            tconv_tile(P.w_out + (size_t)(kt * 64) * 1024 + nt * 256, 1024, wout + (size_t)(nt * 256) * 1024 + kt * 64, 1024, 0, sm);
        } else if (t < 192 + 2048) { const int u = t - 192, up = u >> 10, v = u & 1023, e = v >> 5, w = v & 31, kt = w >> 1, nt = w & 1;
            const float* src = (up ? P.w_up : P.w_gate) + (size_t)e * 1024 * 512 + (size_t)(kt * 64) * 512 + nt * 256;
            tconv_tile(src, 512, wgu + (size_t)e * 1024 * 1024 + (size_t)(nt * 512) * 1024 + kt * 64, 1024, 1 + up, sm);
        } else { const int v = t - 192 - 2048, e = v >> 5, w = v & 31, kt = w >> 2, nt = w & 3;
            tconv_tile(P.w_down + (size_t)e * 512 * 1024 + (size_t)(kt * 64) * 1024 + nt * 256, 1024, wd + (size_t)e * 1024 * 512 + (size_t)(nt * 256) * 512 + kt * 64, 512, 0, sm);
        }
    }
}

DEV void phase0_wf(const Params& P, unsigned char* sm) {
    PHASE_TID;
    float* cs = (float*)sm;
    if (TID < 128) { float s, c; sincospi_f((float)TID * (2.0f / 128.0f), &s, &c); cs[TID] = c; cs[128 + TID] = s; }
    SYNC();
    bf16_t* wf = (bf16_t*)(P.ws + WS_WF);
    const float sc = 0.08838834764831845f;
    for (int it = BID; it < 256; it += NBLK) {
        const int kb = it & 1, cb = (it >> 1) & 15, part = (it >> 5) & 1, g = it >> 6;
        const int k = kb * 512 + TID;
        const float* wrow = P.w_in + (size_t)k * W_IN + g * 128;
        float acc[8];
#pragma unroll
        for (int q = 0; q < 8; ++q) acc[q] = 0.f;
#pragma unroll 8
        for (int c4 = 0; c4 < 32; ++c4) { const f32x4 w4 = *(const f32x4*)(wrow + c4 * 4);
#pragma unroll
            for (int e = 0; e < 4; ++e) { const int c = c4 * 4 + e;
#pragma unroll
                for (int q = 0; q < 8; ++q) { const int cp = cb * 8 + q; acc[q] += w4[e] * cs[part * 128 + ((c * cp) & 127)]; } } }
#pragma unroll
        for (int q = 0; q < 8; ++q) { const int chc = part * 512 + g * 128 + cb * 8 + q; wf[(size_t)chc * 1024 + k] = f2bf((part ? -acc[q] : acc[q]) * sc); }
    }
    bf16_t* tab = (bf16_t*)(P.ws + WS_TAB);
    const float sc2 = 0.011048543456039806f;
    for (int i = BID * 512 + TID; i < 4096 + 16384; i += NBLK * 512) {
        if (i < 4096) { const int a = i >> 6, b = i & 63; float s, c; sincospi_f((float)((a * b) & 63) * (2.0f / 64.0f), &s, &c); tab[i] = f2bf(c); tab[4096 + i] = f2bf(s); }
        else { const int j = i - 4096, a = j >> 7, b = j & 127; float s, c; sincospi_f((float)((a * b) & 127) * (2.0f / 128.0f), &s, &c); tab[8192 + j] = f2bf(c * sc2); tab[8192 + 16384 + j] = f2bf(s * sc2); }
    }
}

DEV void phase1_prep(const Params& P, unsigned char* sm) {
    PHASE_TID;
    bf16_t* Bhi = (bf16_t*)sm; bf16_t* Blo = (bf16_t*)(sm + 33024);
    float* gsv = (float*)(sm + 66048);
    float* gbl = (float*)(sm + 70144);
    {
        f32x4 w[2][4];
#pragma unroll
        for (int h = 0; h < 2; ++h)
#pragma unroll
            for (int q = 0; q < 4; ++q) w[h][q] = *(const f32x4*)(P.w_in + (size_t)(TID + h * 512) * W_IN + 2560 + q * 4);
#pragma unroll
        for (int h = 0; h < 2; ++h)
#pragma unroll
            for (int q = 0; q < 4; ++q)
#pragma unroll
                for (int e = 0; e < 4; ++e) { const int n = q * 4 + e, k = TID + h * 512; const float v = w[h][q][e]; const bf16_t hi = f2bf(v); Bhi[n * 1032 + k] = hi; Blo[n * 1032 + k] = f2bf(v - bf2f(hi)); }
    }
    const float* mod = (const float*)(P.ws + WS_MOD);
    bf16_t* h = (bf16_t*)(P.ws + WS_R4 + R4_H);
    float* gb = (float*)(P.ws + WS_GB);
    float* rstd_arr = (float*)(P.ws + WS_RSTD);
    float* bias = (float*)(P.ws + WS_BIAS);
    const int wid = TID >> 6, lane = TID & 63, fr = lane & 15, fq = lane >> 4;
    SYNC();
    const float* shrow = mod + (fr < 8 ? fr : 8) * 6144 + fq * 8;
    if (TID < 256) gbl[TID] = 0.f;
    SYNC();
    {
        f32x4 acc = (f32x4){0.f, 0.f, 0.f, 0.f};
#pragma unroll
        for (int k4 = 0; k4 < 4; ++k4) {
            const int ks = wid * 4 + k4;
            const f32x4 a0 = *(const f32x4*)(shrow + ks * 32), a1 = *(const f32x4*)(shrow + ks * 32 + 4);
            const float hv[8] = {a0[0], a0[1], a0[2], a0[3], a1[0], a1[1], a1[2], a1[3]};
            u32x4 whi, wlo;
#pragma unroll
            for (int e = 0; e < 4; ++e) { whi[e] = pk2(hv[2 * e], hv[2 * e + 1]); wlo[e] = pk2(hv[2 * e] - __builtin_bit_cast(float, whi[e] << 16), hv[2 * e + 1] - __builtin_bit_cast(float, whi[e] & 0xffff0000u)); }
            const bf16x8 ahi = __builtin_bit_cast(bf16x8, whi), alo = __builtin_bit_cast(bf16x8, wlo);
            const bf16x8 bhi = frag16(Bhi + fr * 1032 + ks * 32 + fq * 8), blo = frag16(Blo + fr * 1032 + ks * 32 + fq * 8);
            acc = mfma16(ahi, bhi, acc); acc = mfma16(alo, bhi, acc); acc = mfma16(ahi, blo, acc);
        }
#pragma unroll
        for (int r = 0; r < 4; ++r) atomic_add_f32(&gbl[(fq * 4 + r) * 16 + fr], acc[r]);
    }
    {
        const bf16_t* wq = (const bf16_t*)(P.ws + WS_WQKVZ); const bf16_t* wf = (const bf16_t*)(P.ws + WS_WF);
        for (int it = BID * 8 + wid; it < 192; it += NBLK * 8) {
            const int n0 = it * 16;
            const bf16_t* wrow = (n0 < 2048 ? wq + (size_t)(n0 + fr) * 1024 : wf + (size_t)(n0 - 2048 + fr) * 1024) + fq * 8;
            f32x4 acc = (f32x4){0.f, 0.f, 0.f, 0.f};
#pragma unroll 4
            for (int ks = 0; ks < 32; ++ks) {
                const f32x4 a0 = *(const f32x4*)(shrow + ks * 32), a1 = *(const f32x4*)(shrow + ks * 32 + 4);
                const float hv[8] = {a0[0], a0[1], a0[2], a0[3], a1[0], a1[1], a1[2], a1[3]};
                u32x4 whi, wlo;
#pragma unroll
                for (int e = 0; e < 4; ++e) { whi[e] = pk2(hv[2 * e], hv[2 * e + 1]); wlo[e] = pk2(hv[2 * e] - __builtin_bit_cast(float, whi[e] << 16), hv[2 * e + 1] - __builtin_bit_cast(float, whi[e] & 0xffff0000u)); }
                const bf16x8 bw = frag16(wrow + ks * 32);
                acc = mfma16(__builtin_bit_cast(bf16x8, whi), bw, acc); acc = mfma16(__builtin_bit_cast(bf16x8, wlo), bw, acc);
            }
#pragma unroll
            for (int r = 0; r < 4; ++r) { const int mbr = fq * 4 + r; if (mbr < 9) bias[mbr * 3072 + n0 + fr] = acc[r]; }
        }
    }
    for (int t = BID; t < MROWS / 128; t += NBLK) {
        const int r0 = t * 128 + wid * 16, mb = (t * 128 < NTOK) ? ((t * 128) >> 13) : 8;
        SYNC();
        { const float* scale = mod + mb * 6144 + 1024;
#pragma unroll
          for (int q = 0; q < 2; ++q) { const int k = TID + q * 512; gsv[k] = P.norm1_g[k] * (1.0f + scale[k]); } }
        SYNC();
        const int rr = r0 + fr;
        const float* src = (rr < NTOK ? P.x + (size_t)rr * D : P.ctx + (size_t)(rr - NTOK) * D) + fq * 8;
        float ss = 0.f;
        f32x4 acc = (f32x4){0.f, 0.f, 0.f, 0.f};
        bf16_t* hrow = h + (size_t)rr * D + fq * 8;
#pragma unroll 8
        for (int ks = 0; ks < 32; ++ks) {
            const f32x4 a0 = *(const f32x4*)(src + ks * 32), a1 = *(const f32x4*)(src + ks * 32 + 4);
            ss += a0[0] * a0[0] + a0[1] * a0[1] + a0[2] * a0[2] + a0[3] * a0[3] + a1[0] * a1[0] + a1[1] * a1[1] + a1[2] * a1[2] + a1[3] * a1[3];
            const f32x4 g0 = *(const f32x4*)(gsv + ks * 32 + fq * 8), g1 = *(const f32x4*)(gsv + ks * 32 + fq * 8 + 4);
            float hv[8];
#pragma unroll
            for (int e = 0; e < 4; ++e) { hv[e] = a0[e] * g0[e]; hv[4 + e] = a1[e] * g1[e]; }
            u32x4 whi, wlo;
#pragma unroll
            for (int e = 0; e < 4; ++e) { whi[e] = pk2(hv[2 * e], hv[2 * e + 1]); wlo[e] = pk2(hv[2 * e] - __builtin_bit_cast(float, whi[e] << 16), hv[2 * e + 1] - __builtin_bit_cast(float, whi[e] & 0xffff0000u)); }
            *(u32x4*)(hrow + ks * 32) = whi;
            const bf16x8 ahi = __builtin_bit_cast(bf16x8, whi), alo = __builtin_bit_cast(bf16x8, wlo);
            const bf16x8 bhi = frag16(Bhi + fr * 1032 + ks * 32 + fq * 8), blo = frag16(Blo + fr * 1032 + ks * 32 + fq * 8);
            acc = mfma16(ahi, bhi, acc); acc = mfma16(alo, bhi, acc); acc = mfma16(ahi, blo, acc);
        }
        ss += shfl_xor_f(ss, 16); ss += shfl_xor_f(ss, 32);
        const float rstd = rsq_f(ss * (1.0f / 1024.0f) + EPS);
        if (fq == 0) rstd_arr[rr] = rstd;
        float ea = 0.f, db = 0.f;
        if (fr >= 8) { ea = -__expf(P.a_log[fr - 8]); db = P.dt_bias[fr - 8]; }
        const float gbias = gbl[mb * 16 + fr];
#pragma unroll
        for (int reg = 0; reg < 4; ++reg) { const float v = acc[reg] * shfl_idx_f(rstd, fq * 4 + reg) + gbias; float o;
            if (fr < 8) o = rcp_f(1.0f + __expf(-v));
            else { const float z = v + db; const float sp = z > 20.f ? z : log1pf(__expf(z)); o = ea * sp; }
            gb[(size_t)(r0 + fq * 4 + reg) * 16 + fr] = o; }
    }
}

#ifndef CPU_EMU
namespace pg8 {
#define PG8_LAS __attribute__((address_space(3)))
constexpr int BM = 256, BK = 64, HALF = 128, HTB = HALF * BK * 2, STAGE_BYTES = 8 * HTB;
__device__ __forceinline__ int lds_byte(int r, int c) { const int st = (r >> 4) * 2 + (c >> 5), rr = r & 15, cc = c & 31, ob = rr * 64 + cc * 2; return st * 1024 + (ob ^ (((ob >> 9) & 1) << 5)); }
__device__ __forceinline__ void stage_rc(int b, int& R, int& C) { const int st = b / 1024, sb = b % 1024, swz = sb ^ (((sb >> 9) & 1) << 5); R = (st >> 1) * 16 + swz / 64; C = (st & 1) * 32 + (swz % 64) / 2; }
__device__ __forceinline__ int perm32(int rho) { const int n = rho >> 4, i = rho & 15; return 8 * (i >> 2) + 4 * n + (i & 3); }
struct Unit { int pm, pn, e, cnt; };
__device__ __forceinline__ unsigned cvt_pk_bf16(float lo, float hi) { unsigned r; asm volatile("v_cvt_pk_bf16_f32 %0, %1, %2" : "=v"(r) : "v"(lo), "v"(hi)); return r; }

template <class Prob, class Epi>
__device__ __forceinline__ void gemm_phase(PG8_LAS unsigned char* lds, const Prob& G, const Epi& E) {
    int tid_ = threadIdx.x; asm volatile("" : "+v"(tid_));
    const int tid = tid_, wid = __builtin_amdgcn_readfirstlane(tid >> 6), lane = tid & 63, wr = wid >> 2, wc = wid & 3, fr = lane & 15, fq = lane >> 4;
    const int K = G.K, nt = K / BK;
    int R0, C0; stage_rc(tid * 16, R0, C0);
    const int rA0 = R0, rA1 = R0 + 64;
    const int rB0 = Epi::PERM ? ((R0 & ~31) + perm32(R0 & 31)) : R0, rB1 = Epi::PERM ? (((R0 + 64) & ~31) + perm32((R0 + 64) & 31)) : R0 + 64;
    const unsigned ldsw = (unsigned)wid * 1024u;
    const int aoff = lds_byte(wr * 64 + fr, fq * 8), boff = lds_byte(wc * 32 + fr, fq * 8);
    const char* Ab = (const char*)G.A; const char* Bb = (const char*)G.Bt;
#define PG8_SA(b, h) (((b) * 2 + (h)) * HTB)
#define PG8_SB(b, h) ((4 + (b) * 2 + (h)) * HTB)
#define PG8_STAGE(bufoff, gbase, ub, l0, l1) do { \
        __builtin_amdgcn_global_load_lds((const unsigned*)((gbase) + (size_t)(ub) + (l0)), (PG8_LAS unsigned*)(lds + (bufoff) + ldsw), 16, 0, 0); \
        __builtin_amdgcn_global_load_lds((const unsigned*)((gbase) + (size_t)(ub) + (l1)), (PG8_LAS unsigned*)(lds + (bufoff) + ldsw + 8192), 16, 0, 0); } while (0)
#define PG8_LDA(dst, b, h) do { _Pragma("unroll") for (int m = 0; m < 4; ++m) _Pragma("unroll") for (int k = 0; k < 2; ++k) dst[m][k] = *(const PG8_LAS bf16x8*)(lds + PG8_SA(b, h) + aoff + m * 2048 + k * 1024); } while (0)
#define PG8_LDB(dst, b, h) do { _Pragma("unroll") for (int n = 0; n < 2; ++n) _Pragma("unroll") for (int k = 0; k < 2; ++k) dst[n][k] = *(const PG8_LAS bf16x8*)(lds + PG8_SB(b, h) + boff + n * 2048 + k * 1024); } while (0)
#define PG8_MMA(ai, bj, At, Bt) do { __builtin_amdgcn_s_setprio(1); _Pragma("unroll") for (int m = 0; m < 4; ++m) _Pragma("unroll") for (int n = 0; n < 2; ++n) _Pragma("unroll") for (int k = 0; k < 2; ++k) \
        acc[ai][bj][m][n] = __builtin_amdgcn_mfma_f32_16x16x32_bf16(Bt[n][k], At[m][k], acc[ai][bj][m][n], 0, 0, 0); __builtin_amdgcn_s_setprio(0); } while (0)
#define PG8_WAIT_V(n) asm volatile("s_waitcnt vmcnt(" #n ")" ::: "memory")
#define PG8_WAIT_L(n) asm volatile("s_waitcnt lgkmcnt(" #n ")" ::: "memory")
#define PG8_BAR __builtin_amdgcn_s_barrier()
#define PG8_SCHED __builtin_amdgcn_sched_barrier(0)
    Unit cur, nxt; int ui = 0;
    if (!G.next(0, cur)) return;
    f32x4 acc[2][2][4][2];
#pragma unroll
    for (int a = 0; a < 2; ++a)
#pragma unroll
        for (int b = 0; b < 2; ++b)
#pragma unroll
            for (int m = 0; m < 4; ++m)
#pragma unroll
                for (int n = 0; n < 2; ++n) acc[a][b][m][n] = (f32x4){0.f, 0.f, 0.f, 0.f};
    bf16x8 At[4][2], B0[2][2], B1[2][2];
    const unsigned cb2 = (unsigned)C0 * 2u;
    const unsigned lB00 = G.laneB(rB0) + cb2, lB01 = G.laneB(rB1) + cb2, lB10 = G.laneB(128 + rB0) + cb2, lB11 = G.laneB(128 + rB1) + cb2;
    const unsigned lA00 = G.laneA(rA0) + cb2, lA01 = G.laneA(rA1) + cb2, lA10 = G.laneA(128 + rA0) + cb2, lA11 = G.laneA(128 + rA1) + cb2;
    unsigned cA00 = lA00, cA01 = lA01, cA10 = lA10, cA11 = lA11, nA00 = lA00, nA01 = lA01, nA10 = lA10, nA11 = lA11;
    if constexpr (Prob::GATHER_A) { cA00 += G.gathA(cur, rA0); cA01 += G.gathA(cur, rA1); cA10 += G.gathA(cur, 128 + rA0); cA11 += G.gathA(cur, 128 + rA1); }
    unsigned uAc = G.baseA(cur), uBc = G.baseB(cur), uAn = uAc, uBn = uBc;
    if constexpr (Epi::PREFETCH) E.prefetch(cur, lds + STAGE_BYTES + 2048, wid, lane);
    PG8_STAGE(PG8_SB(0, 0), Bb, uBc, lB00, lB01); PG8_STAGE(PG8_SA(0, 0), Ab, uAc, cA00, cA01); PG8_STAGE(PG8_SB(0, 1), Bb, uBc, lB10, lB11); PG8_STAGE(PG8_SA(0, 1), Ab, uAc, cA10, cA11);
    if (wr == 1) PG8_BAR;
    PG8_WAIT_V(4); PG8_BAR;
    PG8_STAGE(PG8_SB(1, 0), Bb, uBc + 128u, lB00, lB01); PG8_STAGE(PG8_SA(1, 0), Ab, uAc + 128u, cA00, cA01); PG8_STAGE(PG8_SB(1, 1), Bb, uBc + 128u, lB10, lB11);
    PG8_WAIT_V(6); PG8_BAR;
    for (;;) {
        const bool has_next = G.next(ui + 1, nxt);
        if constexpr (Epi::PREFETCH) { if (has_next) E.prefetch(nxt, lds + STAGE_BYTES + 2048 + ((ui + 1) % 3) * 2048, wid, lane); }
        if (has_next) {
            uAn = G.baseA(nxt); uBn = G.baseB(nxt);
            if constexpr (Prob::GATHER_A) { nA00 = lA00 + G.gathA(nxt, rA0); nA01 = lA01 + G.gathA(nxt, rA1); nA10 = lA10 + G.gathA(nxt, 128 + rA0); nA11 = lA11 + G.gathA(nxt, 128 + rA1); }
        } else { uAn = uAc; uBn = uBc; if constexpr (Prob::GATHER_A) { nA00 = cA00; nA01 = cA01; nA10 = cA10; nA11 = cA11; } }
        for (int t = 0; t < nt; t += 2) {
            const bool last = (t == nt - 2);
            const unsigned k1 = (unsigned)(t + 1) * 128u;
            const unsigned uA2 = last ? uAn : uAc + (unsigned)(t + 2) * 128u, uB2 = last ? uBn : uBc + (unsigned)(t + 2) * 128u, uA3 = uA2 + 128u, uB3 = uB2 + 128u;
            unsigned a00 = cA00, a01 = cA01, a10 = cA10, a11 = cA11;
            if constexpr (Prob::GATHER_A) { a00 = last ? nA00 : cA00; a01 = last ? nA01 : cA01; a10 = last ? nA10 : cA10; a11 = last ? nA11 : cA11; }
            PG8_LDB(B0, 0, 0); PG8_SCHED; PG8_LDA(At, 0, 0); PG8_STAGE(PG8_SA(1, 1), Ab, uAc + k1, cA10, cA11);
            PG8_WAIT_L(8); PG8_BAR; PG8_WAIT_L(0); PG8_MMA(0, 0, At, B0); PG8_BAR; PG8_SCHED;
            PG8_LDB(B1, 0, 1); PG8_STAGE(PG8_SB(0, 0), Bb, uB2, lB00, lB01);
            PG8_BAR; PG8_WAIT_L(0); PG8_MMA(0, 1, At, B1); PG8_BAR;
            PG8_LDA(At, 0, 1); PG8_STAGE(PG8_SA(0, 0), Ab, uA2, a00, a01);
            PG8_BAR; PG8_WAIT_L(0); PG8_MMA(1, 0, At, B0); PG8_BAR; PG8_SCHED;
            PG8_STAGE(PG8_SB(0, 1), Bb, uB2, lB10, lB11);
            PG8_WAIT_V(6); PG8_BAR; PG8_MMA(1, 1, At, B1); PG8_BAR;
            PG8_LDB(B0, 1, 0); PG8_SCHED; PG8_LDA(At, 1, 0); PG8_STAGE(PG8_SA(0, 1), Ab, uA2, a10, a11);
            PG8_WAIT_L(8); PG8_BAR; PG8_WAIT_L(0); PG8_MMA(0, 0, At, B0); PG8_BAR; PG8_SCHED;
            PG8_LDB(B1, 1, 1); PG8_STAGE(PG8_SB(1, 0), Bb, uB3, lB00, lB01);
            PG8_BAR; PG8_WAIT_L(0); PG8_MMA(0, 1, At, B1); PG8_BAR;
            PG8_LDA(At, 1, 1); PG8_STAGE(PG8_SA(1, 0), Ab, uA3, a00, a01);
            PG8_BAR; PG8_WAIT_L(0); PG8_MMA(1, 0, At, B0); PG8_BAR; PG8_SCHED;
            PG8_STAGE(PG8_SB(1, 1), Bb, uB3, lB10, lB11);
            PG8_WAIT_V(6); PG8_BAR; PG8_MMA(1, 1, At, B1); PG8_BAR;
        }
        E(acc, cur, wr, wc, fr, fq, (const PG8_LAS float*)(lds + STAGE_BYTES + 2048 + (ui % 3) * 2048));
        if (!has_next) break;
#pragma unroll
        for (int a = 0; a < 2; ++a)
#pragma unroll
            for (int b = 0; b < 2; ++b)
#pragma unroll
                for (int m = 0; m < 4; ++m)
#pragma unroll
                    for (int n = 0; n < 2; ++n) acc[a][b][m][n] = (f32x4){0.f, 0.f, 0.f, 0.f};
        cur = nxt; ++ui; uAc = uAn; uBc = uBn;
        if constexpr (Prob::GATHER_A) { cA00 = nA00; cA01 = nA01; cA10 = nA10; cA11 = nA11; }
    }
    PG8_WAIT_V(0);
    if (wr == 0) PG8_BAR;
    PG8_BAR;
#undef PG8_SA
#undef PG8_SB
#undef PG8_STAGE
#undef PG8_LDA
#undef PG8_LDB
#undef PG8_MMA
#undef PG8_WAIT_V
#undef PG8_WAIT_L
#undef PG8_BAR
#undef PG8_SCHED
}

struct GridOrder {
    int nM, nN, nwg, G, c;
    __device__ __forceinline__ void init(int nM_, int nN_, int G_, int c_) { nM = nM_; nN = nN_; nwg = nM * nN; G = G_; c = c_; }
    __device__ __forceinline__ bool next(int i, Unit& u) const {
        const long L = (long)i * G + c; if (L >= nwg) return false;
        int wgid = (int)L; { const int q = nwg / 8, r = nwg % 8, xcd = wgid % 8, off = wgid / 8; wgid = (xcd < r ? xcd * (q + 1) : r * (q + 1) + (xcd - r) * q) + off; }
        const int nig = 8 * nN, gid = wgid / nig, fm = gid * 8, gsz = (nM - fm) < 8 ? (nM - fm) : 8;
        u.pm = fm + ((wgid % nig) % gsz); u.pn = (wgid % nig) / gsz; u.e = 0; u.cnt = 256; return true;
    }
};

struct ProbInproj : GridOrder { const bf16_t* A; const bf16_t* Bt; int K; static constexpr bool GATHER_A = false;
    __device__ __forceinline__ unsigned laneA(int r) const { return (unsigned)r * 2048u; }
    __device__ __forceinline__ unsigned laneB(int r) const { return (unsigned)r * 2048u; }
    __device__ __forceinline__ unsigned baseA(const Unit& u) const { return (unsigned)(u.pm * 256) * 2048u; }
    __device__ __forceinline__ unsigned baseB(const Unit& u) const { return (unsigned)(u.pn * 256) * 2048u; }
    __device__ __forceinline__ unsigned gathA(const Unit&, int) const { return 0u; } };
struct ProbGT : GridOrder { const bf16_t* A; const bf16_t* Bt; int K; static constexpr bool GATHER_A = false;
    __device__ __forceinline__ unsigned laneA(int r) const { return (unsigned)r * 2048u; }
    __device__ __forceinline__ unsigned laneB(int r) const { return (unsigned)(128 * (r & 63) + (r >> 6)) * 2048u; }
    __device__ __forceinline__ unsigned baseA(const Unit& u) const { return (unsigned)(u.pm * 256) * 2048u; }
    __device__ __forceinline__ unsigned baseB(const Unit& u) const { const int col = u.pn * 256, b = col >> 13, w = col & 8191; return (unsigned)(b * 8192 + (w >> 6)) * 2048u; }
    __device__ __forceinline__ unsigned gathA(const Unit&, int) const { return 0u; } };
struct EpiStoreBf16 {
    static constexpr bool PERM = true, PREFETCH = false; bf16_t* O; int ldc;
    __device__ __forceinline__ void operator()(const f32x4 (&acc)[2][2][4][2], const Unit& u, int wr, int wc, int fr, int fq, const PG8_LAS float* ex) const {
        const int row0 = u.pm * 256 + wr * 64 + fr, col0 = u.pn * 256 + wc * 32 + 8 * fq;
#pragma unroll
        for (int ai = 0; ai < 2; ++ai)
#pragma unroll
            for (int m = 0; m < 4; ++m) { bf16_t* rowp = O + (size_t)(row0 + ai * 128 + m * 16) * ldc + col0;
#pragma unroll
                for (int bj = 0; bj < 2; ++bj) { const f32x4 v0 = acc[ai][bj][m][0], v1 = acc[ai][bj][m][1];
                    u32x4 w; w.x = cvt_pk_bf16(v0[0], v0[1]); w.y = cvt_pk_bf16(v0[2], v0[3]); w.z = cvt_pk_bf16(v1[0], v1[1]); w.w = cvt_pk_bf16(v1[2], v1[3]);
                    *(u32x4*)(rowp + bj * 128) = w; } }
    }
};
struct EpiGT {
    static constexpr bool PERM = true, PREFETCH = true; bf16_t* O; const float* rstd; const float* bias;
    __device__ __forceinline__ void prefetch(const Unit& u, PG8_LAS unsigned char* ex, int wid, int lane) const {
        const int mb = (u.pn * 256) >> 13;
        if (wid == 0) __builtin_amdgcn_global_load_lds((const unsigned*)(bias + mb * 3072 + 2048 + u.pm * 256 + lane * 4), (PG8_LAS unsigned*)(ex + 1024), 16, 0, 0);
        else if (wid <= 4) { const int c = u.pn * 256 + (wid - 1) * 64 + lane, w = c & 8191;
            __builtin_amdgcn_global_load_lds((const unsigned*)(rstd + mb * 8192 + 128 * (w & 63) + (w >> 6)), (PG8_LAS unsigned*)(ex + (wid - 1) * 256), 4, 0, 0); }
    }
    __device__ __forceinline__ void operator()(const f32x4 (&acc)[2][2][4][2], const Unit& u, int wr, int wc, int fr, int fq, const PG8_LAS float* ex) const {
        const int row0 = u.pm * 256 + wr * 64 + fr, col0 = u.pn * 256 + wc * 32 + 8 * fq;
        float rs[2][8];
#pragma unroll
        for (int bj = 0; bj < 2; ++bj) { const f32x4 r0_ = *(const PG8_LAS f32x4*)(ex + bj * 128 + wc * 32 + 8 * fq), r1_ = *(const PG8_LAS f32x4*)(ex + bj * 128 + wc * 32 + 8 * fq + 4);
            rs[bj][0] = r0_[0]; rs[bj][1] = r0_[1]; rs[bj][2] = r0_[2]; rs[bj][3] = r0_[3]; rs[bj][4] = r1_[0]; rs[bj][5] = r1_[1]; rs[bj][6] = r1_[2]; rs[bj][7] = r1_[3]; }
#pragma unroll
        for (int ai = 0; ai < 2; ++ai)
#pragma unroll
            for (int m = 0; m < 4; ++m) { const int row = row0 + ai * 128 + m * 16; const float bg = ex[256 + wr * 64 + fr + ai * 128 + m * 16]; bf16_t* rowp = O + (size_t)row * NTOK + col0;
#pragma unroll
                for (int bj = 0; bj < 2; ++bj) { const f32x4 a0 = acc[ai][bj][m][0], a1 = acc[ai][bj][m][1];
                    u32x4 w; w.x = cvt_pk_bf16(a0[0] * rs[bj][0] + bg, a0[1] * rs[bj][1] + bg); w.y = cvt_pk_bf16(a0[2] * rs[bj][2] + bg, a0[3] * rs[bj][3] + bg);
                    w.z = cvt_pk_bf16(a1[0] * rs[bj][4] + bg, a1[1] * rs[bj][5] + bg); w.w = cvt_pk_bf16(a1[2] * rs[bj][6] + bg, a1[3] * rs[bj][7] + bg);
                    *(u32x4*)(rowp + bj * 128) = w; } }
    }
};
struct EpiInproj {
    static constexpr bool PERM = true, PREFETCH = true; bf16_t* O; bf16_t* zs; const float* rstd; const float* bias;
    __device__ __forceinline__ void prefetch(const Unit& u, PG8_LAS unsigned char* ex, int wid, int lane) const {
        if (wid == 0) __builtin_amdgcn_global_load_lds((const unsigned*)(rstd + u.pm * 256 + lane * 4), (PG8_LAS unsigned*)ex, 16, 0, 0);
        else if (wid == 1) __builtin_amdgcn_global_load_lds((const unsigned*)(bias + ((u.pm * 256 < NTOK) ? ((u.pm * 256) >> 13) : 8) * 3072 + u.pn * 256 + lane * 4), (PG8_LAS unsigned*)(ex + 1024), 16, 0, 0);
    }
    __device__ __forceinline__ void operator()(const f32x4 (&acc)[2][2][4][2], const Unit& u, int wr, int wc, int fr, int fq, const PG8_LAS float* ex) const {
        const int row0 = u.pm * 256 + wr * 64 + fr, col0 = u.pn * 256 + wc * 32 + 8 * fq;
        const bool isz = u.pn >= 6;
        if (isz && u.pm * 256 >= NTOK) return;
        f32x4 bv[2][2];
#pragma unroll
        for (int bj = 0; bj < 2; ++bj) { bv[bj][0] = *(const PG8_LAS f32x4*)(ex + 256 + bj * 128 + wc * 32 + 8 * fq); bv[bj][1] = *(const PG8_LAS f32x4*)(ex + 256 + bj * 128 + wc * 32 + 8 * fq + 4); }
#pragma unroll
        for (int ai = 0; ai < 2; ++ai)
#pragma unroll
            for (int m = 0; m < 4; ++m) { const size_t row = (size_t)(row0 + ai * 128 + m * 16); const float rs = ex[wr * 64 + fr + ai * 128 + m * 16];
                bf16_t* rowp = isz ? zs + row * 512 + (col0 - 1536) : O + row * 2048 + col0;
#pragma unroll
                for (int bj = 0; bj < 2; ++bj) { f32x4 v0 = acc[ai][bj][m][0] * rs + bv[bj][0], v1 = acc[ai][bj][m][1] * rs + bv[bj][1];
                    if (isz) {
#pragma unroll
                        for (int j = 0; j < 4; ++j) { v0[j] = v0[j] * __builtin_amdgcn_rcpf(1.0f + __expf(-v0[j])); v1[j] = v1[j] * __builtin_amdgcn_rcpf(1.0f + __expf(-v1[j])); } }
                    u32x4 w; w.x = cvt_pk_bf16(v0[0], v0[1]); w.y = cvt_pk_bf16(v0[2], v0[3]); w.z = cvt_pk_bf16(v1[0], v1[1]); w.w = cvt_pk_bf16(v1[2], v1[3]);
                    *(u32x4*)(rowp + bj * 128) = w; } }
    }
};
typedef ProbInproj ProbOut;
struct EpiResid {
    static constexpr bool PERM = false, PREFETCH = false; const float* x; const float* mod; float* out;
    __device__ __forceinline__ void operator()(const f32x4 (&acc)[2][2][4][2], const Unit& u, int wr, int wc, int fr, int fq, const PG8_LAS float* ex) const {
        const int row0 = u.pm * 256 + wr * 64 + fr, col0 = u.pn * 256 + wc * 32 + 4 * fq;
        const float* gate = mod + ((u.pm * 256) >> 13) * 6144 + 2 * 1024;
        f32x4 gv[2][2];
#pragma unroll
        for (int bj = 0; bj < 2; ++bj)
#pragma unroll
            for (int n = 0; n < 2; ++n) gv[bj][n] = *(const f32x4*)(gate + col0 + bj * 128 + n * 16);
#pragma unroll
        for (int ai = 0; ai < 2; ++ai)
#pragma unroll
            for (int m = 0; m < 4; ++m) { const size_t off = (size_t)(row0 + ai * 128 + m * 16) * 1024 + col0;
#pragma unroll
                for (int bj = 0; bj < 2; ++bj)
#pragma unroll
                    for (int n = 0; n < 2; ++n) { const f32x4 xv = *(const f32x4*)(x + off + bj * 128 + n * 16); *(f32x4*)(out + off + bj * 128 + n * 16) = xv + gv[bj][n] * acc[ai][bj][m][n]; } }
    }
};
struct MoeOrder {
    const PG8_LAS int* tb; const PG8_LAS int* cnt; int G, c;
    __device__ __forceinline__ bool next(int i, Unit& u) const {
        const int L = i * G + c, ntile = tb[32]; if (L >= ntile * 4) return false;
        const int tile = L >> 2; u.pn = L & 3; int e = 0;
#pragma unroll
        for (int s = 16; s >= 1; s >>= 1) if (__builtin_amdgcn_readfirstlane(tb[e + s]) <= tile) e += s;
        u.e = e; u.pm = tile; const int loc = (tile - __builtin_amdgcn_readfirstlane(tb[e])) * 256; u.cnt = __builtin_amdgcn_readfirstlane(cnt[e]) - loc; return true;
    }
};
struct ProbMoe1 : MoeOrder { const bf16_t* A; const bf16_t* Bt; int K; const unsigned* tokk; static constexpr bool GATHER_A = true;
    __device__ __forceinline__ unsigned laneA(int) const { return 0u; }
    __device__ __forceinline__ unsigned laneB(int r) const { return (unsigned)r * 2048u; }
    __device__ __forceinline__ unsigned baseA(const Unit&) const { return 0u; }
    __device__ __forceinline__ unsigned baseB(const Unit& u) const { return (unsigned)(u.e * 1024 + u.pn * 256) * 2048u; }
    __device__ __forceinline__ unsigned gathA(const Unit& u, int r) const { const int loc = (u.pm - __builtin_amdgcn_readfirstlane(tb[u.e])) * 256 + r; const unsigned tk = r < u.cnt ? tokk[(size_t)u.e * LCAP + loc] : 0u; return (tk >> 1) * 2048u; } };
struct EpiMoe1 {
    static constexpr bool PERM = true, PREFETCH = false; bf16_t* hid;
    __device__ __forceinline__ void operator()(const f32x4 (&acc)[2][2][4][2], const Unit& u, int wr, int wc, int fr, int fq, const PG8_LAS float* ex) const {
        const int row0 = u.pm * 256 + wr * 64 + fr, col0 = u.pn * 128 + wc * 32 + 8 * fq;
#pragma unroll
        for (int ai = 0; ai < 2; ++ai)
#pragma unroll
            for (int m = 0; m < 4; ++m) { float hv[8];
#pragma unroll
                for (int n = 0; n < 2; ++n)
#pragma unroll
                    for (int j = 0; j < 4; ++j) { const float g = acc[ai][0][m][n][j], up = acc[ai][1][m][n][j]; hv[n * 4 + j] = g * __builtin_amdgcn_rcpf(1.0f + __expf(-g)) * up; }
                u32x4 w; w.x = cvt_pk_bf16(hv[0], hv[1]); w.y = cvt_pk_bf16(hv[2], hv[3]); w.z = cvt_pk_bf16(hv[4], hv[5]); w.w = cvt_pk_bf16(hv[6], hv[7]);
                *(u32x4*)(hid + (size_t)(row0 + ai * 128 + m * 16) * 512 + col0) = w; }
    }
};
struct ProbMoe2 : MoeOrder { const bf16_t* A; const bf16_t* Bt; int K; static constexpr bool GATHER_A = false;
    __device__ __forceinline__ unsigned laneA(int r) const { return (unsigned)r * 1024u; }
    __device__ __forceinline__ unsigned laneB(int r) const { return (unsigned)r * 1024u; }
    __device__ __forceinline__ unsigned baseA(const Unit& u) const { return (unsigned)(u.pm * 256) * 1024u; }
    __device__ __forceinline__ unsigned baseB(const Unit& u) const { return (unsigned)(u.e * 1024 + u.pn * 256) * 1024u; }
    __device__ __forceinline__ unsigned gathA(const Unit&, int) const { return 0u; } };
struct EpiMoe2 {
    static constexpr bool PERM = true, PREFETCH = true; bf16_t* Y; const unsigned* tokk; const float* wl; const PG8_LAS int* tb;
    __device__ __forceinline__ void prefetch(const Unit& u, PG8_LAS unsigned char* ex, int wid, int lane) const {
        const size_t o = (size_t)u.e * LCAP + (u.pm - __builtin_amdgcn_readfirstlane(tb[u.e])) * 256 + lane * 4;
        if (wid == 0) __builtin_amdgcn_global_load_lds((const unsigned*)(tokk + o), (PG8_LAS unsigned*)ex, 16, 0, 0);
        else if (wid == 1) __builtin_amdgcn_global_load_lds((const unsigned*)(wl + o), (PG8_LAS unsigned*)(ex + 1024), 16, 0, 0);
    }
    __device__ __forceinline__ void operator()(const f32x4 (&acc)[2][2][4][2], const Unit& u, int wr, int wc, int fr, int fq, const PG8_LAS float* ex) const {
        const int col0 = u.pn * 256 + wc * 32 + 8 * fq;
#pragma unroll
        for (int ai = 0; ai < 2; ++ai)
#pragma unroll
            for (int m = 0; m < 4; ++m) { const int r = ai * 128 + wr * 64 + m * 16 + fr;
                if (r < u.cnt) { const unsigned tk = __builtin_bit_cast(unsigned, ex[r]); const float w = ex[256 + r];
                    bf16_t* rowp = Y + ((size_t)(tk & 1u) * NTOK + (tk >> 1)) * 1024 + col0;
#pragma unroll
                    for (int bj = 0; bj < 2; ++bj) { const f32x4 v0 = acc[ai][bj][m][0] * w, v1 = acc[ai][bj][m][1] * w;
                        u32x4 q; q.x = cvt_pk_bf16(v0[0], v0[1]); q.y = cvt_pk_bf16(v0[2], v0[3]); q.z = cvt_pk_bf16(v1[0], v1[1]); q.w = cvt_pk_bf16(v1[2], v1[3]);
                        *(u32x4*)(rowp + bj * 128) = q; } } }
    }
};
}
#endif

DEV void conv_row_compute(const Params& P, const bf16_t* ring, const float* wts, int s0, int s1, int s2, int ntap_rows, int slab, bf16_t* dst, int tid) {
    const int cq = tid & 31, tg = tid >> 5;
    typedef float f32x2 __attribute__((ext_vector_type(2)));
    f32x2 acc2[4][2];
#pragma unroll
    for (int t = 0; t < 4; ++t) { acc2[t][0] = (f32x2){0.f, 0.f}; acc2[t][1] = (f32x2){0.f, 0.f}; }
#pragma unroll
    for (int ky = 0; ky < 3; ++ky) {
        if (ntap_rows == 1 && ky != 1) continue;
        const int sl = ky == 0 ? s0 : ky == 1 ? s1 : s2;
        f32x2 w[3][2];
#pragma unroll
        for (int kx = 0; kx < 3; ++kx) { const f32x4 t = *(const f32x4*)(wts + (ky * 3 + kx) * 128 + cq * 4); w[kx][0] = (f32x2){t[0], t[1]}; w[kx][1] = (f32x2){t[2], t[3]}; }
        f32x2 in[6][2];
#pragma unroll
        for (int pos = 0; pos < 6; ++pos) { const u32x2 v = *(const u32x2*)(ring + sl * 8448 + (tg * 4 + pos) * 128 + cq * 4);
            in[pos][0] = (f32x2){__builtin_bit_cast(float, v[0] << 16), __builtin_bit_cast(float, v[0] & 0xffff0000u)}; in[pos][1] = (f32x2){__builtin_bit_cast(float, v[1] << 16), __builtin_bit_cast(float, v[1] & 0xffff0000u)}; }
#pragma unroll
        for (int t = 0; t < 4; ++t)
#pragma unroll
            for (int kx = 0; kx < 3; ++kx) { acc2[t][0] += w[kx][0] * in[t + kx][0]; acc2[t][1] += w[kx][1] * in[t + kx][1]; }
    }
    float acc[4][4];
#pragma unroll
    for (int t = 0; t < 4; ++t) { acc[t][0] = acc2[t][0][0]; acc[t][1] = acc2[t][0][1]; acc[t][2] = acc2[t][1][0]; acc[t][3] = acc2[t][1][1]; }
#pragma unroll
    for (int t = 0; t < 4; ++t) {
        float ss = 0.f;
#pragma unroll
        for (int c = 0; c < 4; ++c) { acc[t][c] = silu_f(acc[t][c]); ss += acc[t][c] * acc[t][c]; }
        if (slab < 8) { ss += shfl_xor_f(ss, 1); ss += shfl_xor_f(ss, 2); ss += shfl_xor_f(ss, 4); ss += shfl_xor_f(ss, 8); ss += shfl_xor_f(ss, 16); const float sc = rsq_f(ss + EPS);
#pragma unroll
            for (int c = 0; c < 4; ++c) acc[t][c] *= sc; }
        u32x2 o; o[0] = pk2(acc[t][0], acc[t][1]); o[1] = pk2(acc[t][2], acc[t][3]);
        *(u32x2*)(dst + (size_t)(tg * 4 + t) * 1536 + cq * 4) = o;
    }
}

DEV void phase3_conv(const Params& P, unsigned char* sm) {
    PHASE_TID;
    const bf16_t* p = (const bf16_t*)(P.ws + WS_R4 + R4_P);
    bf16_t* qkvn = (bf16_t*)(P.ws + WS_R3);
    bf16_t* ring = (bf16_t*)sm;
    float* wts = (float*)(sm + 3 * 16896);
    const u32x4 zero4 = (u32x4){0u, 0u, 0u, 0u};
    for (int it = BID; it < NB * 12 * 8; it += NBLK) {
        const int slab = it % 12, yb = (it / 12) & 7, b = it / 96, y0 = yb * 16;
        const bf16_t* src = p + (size_t)(b * SEQ) * 2048 + slab * 128;
        if (TID < 96) { const int sl = TID / 32, w = TID & 31, cc = (w >> 4) * 65, pc = w & 15; *(u32x4*)(ring + sl * 8448 + cc * 128 + pc * 8) = zero4; }
        if (TID < 288) *(f32x4*)(wts + TID * 4) = *(const f32x4*)(P.conv_w + (size_t)(TID >> 5) * 1536 + slab * 128 + (TID & 31) * 4);
        const int tk0 = TID >> 4, pc = TID & 15;
        u32x4 rr[4][2];
#define CV_LOAD(set, y) do { const bool ok_ = (y) >= 0 && (y) < 128; const int yc_ = ok_ ? (y) : y0;        \
            const u32x4 t0_ = *(const u32x4*)(src + (size_t)(yc_ * 64 + tk0) * 2048 + pc * 8), t1_ = *(const u32x4*)(src + (size_t)(yc_ * 64 + tk0 + 32) * 2048 + pc * 8); \
            rr[set][0] = ok_ ? t0_ : zero4; rr[set][1] = ok_ ? t1_ : zero4; } while (0)
#define CV_STORE(set, slot) do { *(u32x4*)(ring + (slot) * 8448 + (tk0 + 1) * 128 + pc * 8) = rr[set][0]; *(u32x4*)(ring + (slot) * 8448 + (tk0 + 33) * 128 + pc * 8) = rr[set][1]; } while (0)
        CV_LOAD(0, y0 - 1); CV_LOAD(1, y0); CV_LOAD(2, y0 + 1); CV_LOAD(3, y0 + 2);
        CV_STORE(0, 0); CV_STORE(1, 1);
        CV_LOAD(0, y0 + 3);
#pragma unroll 1
        for (int y4 = 0; y4 < 16; y4 += 4) {
#pragma unroll
            for (int u = 0; u < 4; ++u) {
                const int yy = y4 + u;
                const int s0 = yy % 3, s1 = (yy + 1) % 3, s2 = (yy + 2) % 3;
                CV_STORE((u + 2) & 3, s2);
                SYNC();
                CV_LOAD((u + 1) & 3, (yy + 4 <= 16) ? y0 + yy + 4 : 999);
                conv_row_compute(P, ring, wts, s0, s1, s2, 3, slab, qkvn + (size_t)(b * SEQ + (y0 + yy) * 64) * 1536 + slab * 128, TID);
                SYNC();
            }
        }
#undef CV_LOAD
#undef CV_STORE
    }
    for (int it = BID; it < NB * 12 * 4; it += NBLK) {
        const int slab = it % 12, sg = (it / 12) & 3, b = it / 48;
        const bf16_t* src = p + (size_t)(NTOK + b * CTX) * 2048 + slab * 128;
        if (TID < 288) *(f32x4*)(wts + TID * 4) = *(const f32x4*)(P.conv_w + (size_t)(TID >> 5) * 1536 + slab * 128 + (TID & 31) * 4);
        u32x4 r[3];
#pragma unroll
        for (int q = 0; q < 3; ++q) { const int idx = TID + q * 512; r[q] = zero4;
            if (idx < 66 * 16) { const int cc = idx >> 4, pc = idx & 15, tok = sg * 64 + cc - 1; if (tok >= 0 && tok < CTX) r[q] = *(const u32x4*)(src + (size_t)tok * 2048 + pc * 8); } }
#pragma unroll
        for (int q = 0; q < 3; ++q) { const int idx = TID + q * 512; if (idx < 66 * 16) { const int cc = idx >> 4, pc = idx & 15; *(u32x4*)(ring + 1 * 8448 + cc * 128 + pc * 8) = r[q]; } }
        SYNC();
        conv_row_compute(P, ring, wts, 0, 1, 2, 1, slab, qkvn + (size_t)(NTOK + b * CTX + sg * 64) * 1536 + slab * 128, TID);
        SYNC();
    }
}

constexpr int L_K = 0, L_Q = 17408, L_V = 34816, L_KTR = 52224, L_VT = 70656, L_X0F = 89088, L_X0TF = 98304, L_TTF = 107520, L_X0B = 116736, L_X0TB = 125952, L_TTB = 135168, L_GC = 144384, L_SCAL = 161824;
constexpr int L_X1F = 0, L_X1TF = 9216, L_X1B = 18432, L_X1TB = 27648, L_WF = 0, L_WB = 17408, L_AF = 145440, L_AB = 153632;

DEV int chunk_row(int chain, int step, int i) {
    const int b = chain >> 3, dir = chain & 1;
    if (step < 4) { const int pos = step * 64 + i; return NTOK + b * CTX + (dir ? (CTX - 1 - pos) : pos); }
    const int pos = (step - 4) * 64 + i; return b * SEQ + (dir ? (SEQ - 1 - pos) : pos);
}

DEV int img_piece_A(int row, int col0) { return (((row >> 4) * 2 + (col0 >> 5)) * 64 + ((col0 & 31) >> 3) * 16 + (row & 15)) * 16 + ((col0 >> 2) & 1) * 8; }
DEV int img_piece_W(int row, int d0) { return (((row >> 4) * 4 + (d0 >> 5)) * 64 + ((d0 & 31) >> 3) * 16 + (row & 15)) * 16; }

DEV void phase4_prepass(const Params& P, unsigned char* sm) {
    PHASE_TID;
    const bf16_t* qkvn = (const bf16_t*)(P.ws + WS_R3);
    const float* gb = (const float*)(P.ws + WS_GB);
    unsigned char* images = P.ws + WS_R4;
    bf16_t* Ks = (bf16_t*)(sm + L_K); bf16_t* Qs = (bf16_t*)(sm + L_Q); bf16_t* Vs = (bf16_t*)(sm + L_V); bf16_t* KTR = (bf16_t*)(sm + L_KTR); bf16_t* VT = (bf16_t*)(sm + L_VT);
    float* gcf = (float*)(sm + L_GC); float* gcb = gcf + 64; float* btf = gcf + 128; float* btb = gcf + 192;
    const float QSCALE = 0.08838834764831845f;
    const f32x4 z4 = (f32x4){0.f, 0.f, 0.f, 0.f};
    u32x4 pf[6]; float gfp, bfp, gbp, bbp, gbr;
#define PP_ROW0(it_) ((((it_) % NSTEP) < 4) ? NTOK + ((it_) / NSTEP / 4) * CTX + ((it_) % NSTEP) * 64 : ((it_) / NSTEP / 4) * SEQ + (((it_) % NSTEP) - 4) * 64)
#define PP_LOAD(it_) do { const int row0_ = PP_ROW0(it_), h_ = ((it_) / NSTEP) & 3; \
        _Pragma("unroll") for (int q = 0; q < 6; ++q) { const int idx = TID + q * 512, piece = idx & 15, i = (idx >> 4) & 63, which = idx >> 10; \
            pf[q] = *(const u32x4*)(qkvn + (size_t)(row0_ + i) * 1536 + which * 512 + h_ * 128 + piece * 8); } \
        { const int ln_ = TID & 63; const float* gr = gb + (size_t)(row0_ + ln_) * 16; gfp = gr[8 + h_]; bfp = gr[h_]; gbp = gr[12 + h_]; bbp = gr[4 + h_]; gbr = gb[(size_t)(row0_ + 63 - ln_) * 16 + 12 + h_]; } } while (0)
    const int NIT = NB * 4 * NSTEP;
    int it = BID;
    if (it < NIT) PP_LOAD(it);
    for (; it < NIT; it += NBLK) {
        int tq_ = TID;
#ifndef CPU_EMU
        asm volatile("" : "+v"(tq_));
#endif
        const int wid = tq_ >> 6, lane = tq_ & 63, fr = lane & 15, fq = lane >> 4;
        const int bh = it / NSTEP, st = it - bh * NSTEP;
        const int stb = st < 4 ? 3 - st : 4 + (127 - (st - 4));
        unsigned char* imgf = images + ((size_t)(bh * 2) * NSTEP + st) * IMG_BYTES;
        unsigned char* imgb = images + ((size_t)(bh * 2 + 1) * NSTEP + stb) * IMG_BYTES;
#pragma unroll
        for (int q = 0; q < 6; ++q) { const int idx = TID + q * 512, piece = idx & 15, i = (idx >> 4) & 63, which = idx >> 10;
            *(u32x4*)((which == 0 ? Qs : which == 1 ? Ks : Vs) + i * 136 + piece * 8) = pf[q]; }
        if (wid == 0) { float g = gfp;
#pragma unroll
            for (int o = 1; o < 64; o <<= 1) { const float t = shfl_up_f(g, o); if (lane >= o) g += t; }
            gcf[lane] = g; btf[lane] = bfp; }
        if (wid == 1) { float g = gbr;
#pragma unroll
            for (int o = 1; o < 64; o <<= 1) { const float t = shfl_up_f(g, o); if (lane >= o) g += t; }
            gcb[63 - lane] = g; btb[lane] = bbp; }
        { const int nx = (it + NBLK < NIT) ? it + NBLK : it; PP_LOAD(nx); }
        SYNC();
        const float glf = gcf[63], glb = gcb[0];
        bf16_t* X0F = (bf16_t*)(sm + L_X0F); bf16_t* X0TF = (bf16_t*)(sm + L_X0TF); bf16_t* TTF = (bf16_t*)(sm + L_TTF);
        bf16_t* X0B = (bf16_t*)(sm + L_X0B); bf16_t* X0TB = (bf16_t*)(sm + L_X0TB); bf16_t* TTB = (bf16_t*)(sm + L_TTB);
        f32x4 TregF[2], TTregF[2], TregB[2], TTregB[2];
#pragma unroll
        for (int tt = 0; tt < 2; ++tt) {
            const int t = wid * 2 + tt, ti = t >> 2, tj = t & 3;
            f32x4 kk = z4, kkT = z4, qkT = z4;
#pragma unroll
            for (int ks = 0; ks < 4; ++ks) {
                const bf16x8 fKi = frag16(Ks + (ti * 16 + fr) * 136 + ks * 32 + fq * 8), fKj = frag16(Ks + (tj * 16 + fr) * 136 + ks * 32 + fq * 8), fQi = frag16(Qs + (ti * 16 + fr) * 136 + ks * 32 + fq * 8);
                kk = mfma16(fKi, fKj, kk); kkT = mfma16(fKj, fKi, kkT); qkT = mfma16(fKj, fQi, qkT);
            }
            {
              const int j = tj * 16 + fr; const float gfj = gcf[j], gbj = gcb[j]; float mf[4], mb_[4];
#pragma unroll
              for (int r = 0; r < 4; ++r) { const int i = ti * 16 + fq * 4 + r;
                  const float ef = __expf(fminf(gcf[i] - gfj, 0.f)) * btf[i] * kk[r], eb = __expf(fminf(gcb[i] - gbj, 0.f)) * btb[i] * kk[r];
                  mf[r] = (i > j) ? ef : 0.f; TregF[tt][r] = (i == j ? 1.0f : 0.0f) - mf[r];
                  mb_[r] = (i < j) ? eb : 0.f; TregB[tt][r] = (i == j ? 1.0f : 0.0f) - mb_[r]; }
              u32x2 w; const int o_ = j * 72 + ti * 16 + fq * 4;
              w[0] = pk2(mf[0], mf[1]); w[1] = pk2(mf[2], mf[3]); *(u32x2*)(X0TF + o_) = w;
              w[0] = pk2(TregF[tt][0], TregF[tt][1]); w[1] = pk2(TregF[tt][2], TregF[tt][3]); *(u32x2*)(TTF + o_) = w;
              w[0] = pk2(mb_[0], mb_[1]); w[1] = pk2(mb_[2], mb_[3]); *(u32x2*)(X0TB + o_) = w;
              w[0] = pk2(TregB[tt][0], TregB[tt][1]); w[1] = pk2(TregB[tt][2], TregB[tt][3]); *(u32x2*)(TTB + o_) = w; }
            SCHED_FENCE();
            {
              const int i = ti * 16 + fr, j0 = tj * 16 + fq * 4; const float gfi = gcf[i], gbi = gcb[i], bfi = btf[i], bbi = btb[i]; float mf[4], af[4], mb_[4], ab[4];
#pragma unroll
              for (int r = 0; r < 4; ++r) { const int j = j0 + r;
                  const float ef = __expf(fminf(gfi - gcf[j], 0.f)), eb = __expf(fminf(gbi - gcb[j], 0.f));
                  const float df = (i >= j) ? ef : 0.f, db = (i <= j) ? eb : 0.f;
                  mf[r] = (i > j) ? bfi * kkT[r] * ef : 0.f; TTregF[tt][r] = (i == j ? 1.0f : 0.0f) - mf[r]; af[r] = qkT[r] * QSCALE * df;
                  mb_[r] = (i < j) ? bbi * kkT[r] * eb : 0.f; TTregB[tt][r] = (i == j ? 1.0f : 0.0f) - mb_[r]; ab[r] = qkT[r] * QSCALE * db; }
              u32x2 w; const int o_ = i * 72 + j0;
              w[0] = pk2(mf[0], mf[1]); w[1] = pk2(mf[2], mf[3]); *(u32x2*)(X0F + o_) = w;
              w[0] = pk2(mb_[0], mb_[1]); w[1] = pk2(mb_[2], mb_[3]); *(u32x2*)(X0B + o_) = w;
              w[0] = pk2(af[0], af[1]); w[1] = pk2(af[2], af[3]); *(u32x2*)((bf16_t*)(sm + L_AF) + i * 64 + j0) = w;
              w[0] = pk2(ab[3], ab[2]); w[1] = pk2(ab[1], ab[0]); *(u32x2*)((bf16_t*)(sm + L_AB) + (63 - i) * 64 + 60 - j0) = w; }
            SCHED_FENCE();
        }
        if (TID < 64) { float* sf = (float*)(sm + L_SCAL), *sb = (float*)(sm + L_SCAL + 288);
            sf[4 + TID] = QSCALE * __expf(gcf[TID]); sb[4 + TID] = QSCALE * __expf(gcb[63 - TID]); }
        {
            const int dcol = wid * 16 + fr, ks = wid >> 1;
            bf16x8 idf;
#pragma unroll
            for (int j = 0; j < 8; ++j) idf[j] = (dcol == ks * 32 + fq * 8 + j) ? (short)0x3F80 : (short)0;
#pragma unroll
            for (int t4 = 0; t4 < 4; ++t4) {
                const f32x4 kt = mfma16(frag16(Ks + (t4 * 16 + fr) * 136 + ks * 32 + fq * 8), idf, z4);
                const f32x4 vt = mfma16(frag16(Vs + (t4 * 16 + fr) * 136 + ks * 32 + fq * 8), idf, z4);
                const int tok = t4 * 16 + fq * 4;
                u32x2 w; w[0] = pk2(kt[0], kt[1]); w[1] = pk2(kt[2], kt[3]); *(u32x2*)(KTR + dcol * 72 + tok) = w;
                w[0] = pk2(vt[0], vt[1]); w[1] = pk2(vt[2], vt[3]); *(u32x2*)(VT + dcol * 72 + tok) = w;
                SCHED_FENCE();
            }
        }
        SYNC();
#pragma unroll 1
        for (int s5 = 0; s5 < 5; ++s5) {
            const bf16_t* PcF = (bf16_t*)(sm + ((s5 & 1) ? L_X1F : L_X0F)); const bf16_t* PcTF = (bf16_t*)(sm + ((s5 & 1) ? L_X1TF : L_X0TF));
            bf16_t* PnF = (bf16_t*)(sm + ((s5 & 1) ? L_X0F : L_X1F)); bf16_t* PnTF = (bf16_t*)(sm + ((s5 & 1) ? L_X0TF : L_X1TF));
            const bf16_t* PcB = (bf16_t*)(sm + ((s5 & 1) ? L_X1B : L_X0B)); const bf16_t* PcTB = (bf16_t*)(sm + ((s5 & 1) ? L_X1TB : L_X0TB));
            bf16_t* PnB = (bf16_t*)(sm + ((s5 & 1) ? L_X0B : L_X1B)); bf16_t* PnTB = (bf16_t*)(sm + ((s5 & 1) ? L_X0TB : L_X1TB));
#pragma unroll
            for (int tt = 0; tt < 2; ++tt) {
                const int t = wid * 2 + tt, ti = t >> 2, tj = t & 3;
                f32x4 p2 = z4, p2T = z4, q2 = z4, q2T = z4;
#pragma unroll
                for (int ks = 0; ks < 2; ++ks) { const int oa = (ti * 16 + fr) * 72 + ks * 32 + fq * 8, ob = (tj * 16 + fr) * 72 + ks * 32 + fq * 8;
                    const bf16x8 a = frag16(PcF + oa), b = frag16(PcTF + ob), c = frag16(PcB + oa), d = frag16(PcTB + ob);
                    p2 = mfma16(a, b, p2); p2T = mfma16(b, a, p2T); q2 = mfma16(c, d, q2); q2T = mfma16(d, c, q2T); }
                u32x2 w; const int oT = (tj * 16 + fr) * 72 + ti * 16 + fq * 4, oN = (ti * 16 + fr) * 72 + tj * 16 + fq * 4;
                w[0] = pk2(p2[0], p2[1]); w[1] = pk2(p2[2], p2[3]); *(u32x2*)(PnTF + oT) = w;
                w[0] = pk2(p2T[0], p2T[1]); w[1] = pk2(p2T[2], p2T[3]); *(u32x2*)(PnF + oN) = w;
                w[0] = pk2(q2[0], q2[1]); w[1] = pk2(q2[2], q2[3]); *(u32x2*)(PnTB + oT) = w;
                w[0] = pk2(q2T[0], q2T[1]); w[1] = pk2(q2T[2], q2T[3]); *(u32x2*)(PnB + oN) = w;
            }
            SYNC();
#pragma unroll
            for (int tt = 0; tt < 2; ++tt) {
                const int t = wid * 2 + tt, ti = t >> 2, tj = t & 3;
#pragma unroll
                for (int ks = 0; ks < 2; ++ks) { const int oa = (ti * 16 + fr) * 72 + ks * 32 + fq * 8, ob = (tj * 16 + fr) * 72 + ks * 32 + fq * 8;
                    const bf16x8 a = frag16(PnF + oa), b = frag16(TTF + ob), c = frag16(PnB + oa), d = frag16(TTB + ob);
                    TregF[tt] = mfma16(a, b, TregF[tt]); TTregF[tt] = mfma16(b, a, TTregF[tt]); TregB[tt] = mfma16(c, d, TregB[tt]); TTregB[tt] = mfma16(d, c, TTregB[tt]); }
            }
            SYNC();
            if (s5 < 4) {
#pragma unroll
                for (int tt = 0; tt < 2; ++tt) { const int t = wid * 2 + tt, ti = t >> 2, tj = t & 3, oT = (tj * 16 + fr) * 72 + ti * 16 + fq * 4;
                    u32x2 w; w[0] = pk2(TregF[tt][0], TregF[tt][1]); w[1] = pk2(TregF[tt][2], TregF[tt][3]); *(u32x2*)(TTF + oT) = w;
                    w[0] = pk2(TregB[tt][0], TregB[tt][1]); w[1] = pk2(TregB[tt][2], TregB[tt][3]); *(u32x2*)(TTB + oT) = w; }
            }
        }
#pragma unroll
        for (int tt = 0; tt < 2; ++tt) {
            const int t = wid * 2 + tt, ti = t >> 2, tj = t & 3, i = ti * 16 + fr, j0 = tj * 16 + fq * 4;
            const f32x4 bq = *(const f32x4*)(btf + j0), gq = *(const f32x4*)(gcf + j0), cq = *(const f32x4*)(btb + j0), hq = *(const f32x4*)(gcb + j0);
            float tu[4], tw[4], su[4], sw[4];
#pragma unroll
            for (int r = 0; r < 4; ++r) { tu[r] = TTregF[tt][r] * bq[r]; tw[r] = tu[r] * __expf(gq[r]); su[r] = TTregB[tt][r] * cq[r]; sw[r] = su[r] * __expf(hq[r]); }
            u32x2 w; const int o_ = i * 72 + j0;
            w[0] = pk2(tu[0], tu[1]); w[1] = pk2(tu[2], tu[3]); *(u32x2*)(X0F + o_) = w;
            w[0] = pk2(tw[0], tw[1]); w[1] = pk2(tw[2], tw[3]); *(u32x2*)(X0TF + o_) = w;
            w[0] = pk2(su[0], su[1]); w[1] = pk2(su[2], su[3]); *(u32x2*)(X0B + o_) = w;
            w[0] = pk2(sw[0], sw[1]); w[1] = pk2(sw[2], sw[3]); *(u32x2*)(X0TB + o_) = w;
        }
        if (TID == 0) { float* scp = (float*)(sm + L_SCAL); scp[0] = __expf(glf); scp[1] = 0.f; scp[2] = 0.f; scp[3] = 0.f; scp[72] = __expf(glb); scp[73] = 0.f; scp[74] = 0.f; scp[75] = 0.f; }
        SYNC();
        bf16_t* WF = (bf16_t*)(sm + L_WF); bf16_t* WB = (bf16_t*)(sm + L_WB);
#pragma unroll
        for (int i4 = 0; i4 < 4; ++i4) {
            f32x4 uf = z4, wf = z4, ub = z4, wb = z4;
#pragma unroll
            for (int ks = 0; ks < 2; ++ks) {
                const bf16x8 av = frag16(VT + (wid * 16 + fr) * 72 + ks * 32 + fq * 8), ak = frag16(KTR + (wid * 16 + fr) * 72 + ks * 32 + fq * 8);
                const int ot = (i4 * 16 + fr) * 72 + ks * 32 + fq * 8;
                uf = mfma16(frag16(X0F + ot), av, uf); wf = mfma16(ak, frag16(X0TF + ot), wf); ub = mfma16(frag16(X0B + ot), av, ub); wb = mfma16(ak, frag16(X0TB + ot), wb);
            }
            u32x2 w; w[0] = pk2(uf[0], uf[1]); w[1] = pk2(uf[2], uf[3]); *(u32x2*)(imgf + IMG_U + ((wid * 4 + i4) * 64 + lane) * 8) = w;
            w[0] = pk2(ub[3], ub[2]); w[1] = pk2(ub[1], ub[0]); *(u32x2*)(imgb + IMG_U + ((wid * 4 + (3 - i4)) * 64 + (3 - fq) * 16 + fr) * 8) = w;
            const int i = i4 * 16 + fr, c = wid * 16 + fq * 4;
            w[0] = pk2(wf[0], wf[1]); w[1] = pk2(wf[2], wf[3]); *(u32x2*)(WF + i * 136 + c) = w;
            w[0] = pk2(wb[0], wb[1]); w[1] = pk2(wb[2], wb[3]); *(u32x2*)(WB + (63 - i) * 136 + c) = w;
        }
        SYNC();
#pragma unroll
        for (int q = 0; q < 5; ++q) { int pc = TID + q * 512; pc = pc < 2082 ? pc : 2081;
            const int sp = pc - 2048, dirb = pc >= 2048 ? (sp >= 17) : (pc >> 10), p = pc & 1023, mt = p >> 8, ks = (p >> 6) & 3, ln = p & 63;
            const int so = pc >= 2048 ? L_SCAL + dirb * 288 + (sp - dirb * 17) * 16 : (dirb ? L_WB : L_WF) + ((mt * 16 + (ln & 15)) * 136 + ks * 32 + (ln >> 4) * 8) * 2;
            const int dofs = pc >= 2048 ? IMG_SC + (sp - dirb * 17) * 16 : IMG_W + p * 16;
            *(u32x4*)((dirb ? imgb : imgf) + dofs) = *(const u32x4*)(sm + so); }
#pragma unroll
        for (int q = 0; q < 2; ++q) { const int p = TID + q * 512, d = (p >> 7) * 16 + (p & 15), p0 = ((p >> 6) & 1) * 32 + ((p >> 4) & 3) * 8;
            { const u32x4 v = *(const u32x4*)(KTR + d * 72 + p0); const f32x4 g0 = *(const f32x4*)(gcf + p0), g1 = *(const f32x4*)(gcf + p0 + 4); u32x4 o;
              o[0] = pk2(__builtin_bit_cast(float, v[0] << 16) * __expf(glf - g0[0]), __builtin_bit_cast(float, v[0] & 0xffff0000u) * __expf(glf - g0[1]));
              o[1] = pk2(__builtin_bit_cast(float, v[1] << 16) * __expf(glf - g0[2]), __builtin_bit_cast(float, v[1] & 0xffff0000u) * __expf(glf - g0[3]));
              o[2] = pk2(__builtin_bit_cast(float, v[2] << 16) * __expf(glf - g1[0]), __builtin_bit_cast(float, v[2] & 0xffff0000u) * __expf(glf - g1[1]));
              o[3] = pk2(__builtin_bit_cast(float, v[3] << 16) * __expf(glf - g1[2]), __builtin_bit_cast(float, v[3] & 0xffff0000u) * __expf(glf - g1[3]));
              *(u32x4*)(imgf + IMG_KT + p * 16) = o; }
            { const int t0 = 56 - p0;
              const u32x4 v = *(const u32x4*)(KTR + d * 72 + t0); const f32x4 g0 = *(const f32x4*)(gcb + t0), g1 = *(const f32x4*)(gcb + t0 + 4); u32x4 o;
              o[0] = pk2(__builtin_bit_cast(float, v[3] & 0xffff0000u) * __expf(glb - g1[3]), __builtin_bit_cast(float, v[3] << 16) * __expf(glb - g1[2]));
              o[1] = pk2(__builtin_bit_cast(float, v[2] & 0xffff0000u) * __expf(glb - g1[1]), __builtin_bit_cast(float, v[2] << 16) * __expf(glb - g1[0]));
              o[2] = pk2(__builtin_bit_cast(float, v[1] & 0xffff0000u) * __expf(glb - g0[3]), __builtin_bit_cast(float, v[1] << 16) * __expf(glb - g0[2]));
              o[3] = pk2(__builtin_bit_cast(float, v[0] & 0xffff0000u) * __expf(glb - g0[1]), __builtin_bit_cast(float, v[0] << 16) * __expf(glb - g0[0]));
              *(u32x4*)(imgb + IMG_KT + p * 16) = o; } }
        { const int p = TID, row = (p >> 7) * 16 + (p & 15), c0 = ((p >> 6) & 1) * 32 + ((p >> 4) & 3) * 8;
          *(u32x4*)(imgf + IMG_A + p * 16) = *(const u32x4*)((const bf16_t*)(sm + L_AF) + row * 64 + c0);
          *(u32x4*)(imgb + IMG_A + p * 16) = *(const u32x4*)((const bf16_t*)(sm + L_AB) + row * 64 + c0); }
        SYNC();
    }
#undef PP_LOAD
#undef PP_ROW0
}

DEV void phase4_fft(const Params& P, unsigned char* sm) {
    PHASE_TID;
    const bf16_t* GT = (const bf16_t*)((const unsigned char*)P.out + DO_GT);
    bf16_t* ZT = (bf16_t*)((unsigned char*)P.out + DO_ZT);
    const bf16_t* tab = (const bf16_t*)(P.ws + WS_TAB);
    bf16_t* YR = (bf16_t*)sm; bf16_t* YI = YR + 64 * 136;
    const int wid = TID >> 6, lane = TID & 63, fr = lane & 15, fq = lane >> 4;
    bf16x8 c64[4][2], s64[4][2], c128[4], s128[4];
#pragma unroll
    for (int nt = 0; nt < 4; ++nt)
#pragma unroll
        for (int ks = 0; ks < 2; ++ks) { c64[nt][ks] = frag16(tab + (nt * 16 + fr) * 64 + ks * 32 + fq * 8); s64[nt][ks] = frag16(tab + 4096 + (nt * 16 + fr) * 64 + ks * 32 + fq * 8); }
#pragma unroll
    for (int ks = 0; ks < 4; ++ks) { c128[ks] = frag16(tab + 8192 + (wid * 16 + fr) * 128 + ks * 32 + fq * 8); s128[ks] = frag16(tab + 8192 + 16384 + (wid * 16 + fr) * 128 + ks * 32 + fq * 8); }
    for (int it = BID; it < 512 * NB; it += NBLK) {
        const int cp = it >> 3, b = it & 7;
        const bf16_t* gr = GT + (size_t)cp * NTOK + b * SEQ; const bf16_t* gi = GT + (size_t)(512 + cp) * NTOK + b * SEQ;
        bf16x8 ar[2], ai[2], an[2];
#pragma unroll
        for (int ks = 0; ks < 2; ++ks) { ar[ks] = frag16(gr + (wid * 16 + fr) * 64 + ks * 32 + fq * 8); ai[ks] = frag16(gi + (wid * 16 + fr) * 64 + ks * 32 + fq * 8);
#pragma unroll
            for (int j = 0; j < 8; ++j) an[ks][j] = (short)(ar[ks][j] ^ (short)0x8000); }
#pragma unroll
        for (int nt = 0; nt < 4; ++nt) {
            f32x4 yr = (f32x4){0.f, 0.f, 0.f, 0.f}, yi = (f32x4){0.f, 0.f, 0.f, 0.f};
#pragma unroll
            for (int ks = 0; ks < 2; ++ks) { yr = mfma16(ar[ks], c64[nt][ks], yr); yr = mfma16(ai[ks], s64[nt][ks], yr); yi = mfma16(ai[ks], c64[nt][ks], yi); yi = mfma16(an[ks], s64[nt][ks], yi); }
            const int k1 = nt * 16 + fr; float orr[4], oii[4];
#pragma unroll
            for (int r = 0; r < 4; ++r) { const int n2 = wid * 16 + fq * 4 + r; float s, c; sincospi_f((float)(n2 * k1) * (2.0f / 8192.0f), &s, &c);
                orr[r] = yr[r] * c + yi[r] * s; oii[r] = yi[r] * c - yr[r] * s; }
            u32x2 w; w[0] = pk2(orr[0], orr[1]); w[1] = pk2(orr[2], orr[3]); *(u32x2*)(YR + k1 * 136 + wid * 16 + fq * 4) = w;
            w[0] = pk2(oii[0], oii[1]); w[1] = pk2(oii[2], oii[3]); *(u32x2*)(YI + k1 * 136 + wid * 16 + fq * 4) = w;
        }
        SYNC();
        bf16_t* zrow = ZT + (size_t)cp * NTOK + b * SEQ;
#pragma unroll
        for (int mt = 0; mt < 4; ++mt) {
            f32x4 z = (f32x4){0.f, 0.f, 0.f, 0.f};
#pragma unroll
            for (int ks = 0; ks < 4; ++ks) { z = mfma16(frag16(YR + (mt * 16 + fr) * 136 + ks * 32 + fq * 8), c128[ks], z); z = mfma16(frag16(YI + (mt * 16 + fr) * 136 + ks * 32 + fq * 8), s128[ks], z); }
            u32x2 w; w[0] = pk2(z[0], z[1]); w[1] = pk2(z[2], z[3]);
            *(u32x2*)(zrow + 64 * (wid * 16 + fr) + mt * 16 + fq * 4) = w;
        }
        SYNC();
    }
}

constexpr int SC_W = 0, SC_U = 17408, SC_KT = 22528, SC_Q = SC_KT + 18432, SC_A = SC_Q + 17408, SC_ST = SC_A + 9216, SC_VN = SC_ST + 2 * 8704, SC_END = SC_VN + 4608;

DEV void phase5_scan(const Params& P, unsigned char* sm) {
    PHASE_TID;
    const unsigned char* images = P.ws + WS_R4;
    bf16_t* obuf = (bf16_t*)(P.ws + WS_R4 + R4_OBUF);
    const int wid = TID >> 6, lane = TID & 63, fr = lane & 15, fq = lane >> 4;
    bf16_t* ST = (bf16_t*)sm; bf16_t* VN = (bf16_t*)(sm + 2 * 8704);
    for (int item = BID; item < NCHAIN * 4; item += NBLK) {
        const int xj = item >> 3, chain = (item & 7) * 8 + (xj >> 2), c0 = (xj & 3) * 32, b = chain >> 3, hh = (chain >> 1) & 3, dir = chain & 1;
        const unsigned char* blk0 = images + (size_t)chain * NSTEP * IMG_BYTES;
        const int oK = IMG_KT + (wid * 2 * 64 + lane) * 16;
        f32x4 Sacc[2];
        Sacc[0] = (f32x4){0.f, 0.f, 0.f, 0.f}; Sacc[1] = (f32x4){0.f, 0.f, 0.f, 0.f};
        for (int q = TID; q < 2 * 8704 / 4; q += 512) ((unsigned*)ST)[q] = 0u;
#define SC_SUPD(rkset) do { _Pragma("unroll") for (int tt = 0; tt < 2; ++tt) { f32x4 a = Sacc[tt] * dl; \
            _Pragma("unroll") for (int ks = 0; ks < 2; ++ks) a = mfma16(__builtin_bit_cast(bf16x8, rkset[ks]), frag16(VN + (tt * 16 + fr) * 72 + ks * 32 + fq * 8), a); \
            Sacc[tt] = a; u32x2 w_; w_[0] = pk2(a[0], a[1]); w_[1] = pk2(a[2], a[3]); *(u32x2*)(STn + (tt * 16 + fr) * 136 + wid * 16 + fq * 4) = w_; } } while (0)
        if (wid < 4) {
            const int mt = wid;
            const int oW = IMG_W + (mt * 4 * 64 + lane) * 16, oA = IMG_A + (mt * 2 * 64 + lane) * 16, oS = IMG_SC + 16 + (mt * 16 + fq * 4) * 4;
            const bf16_t* qbase = (const bf16_t*)(P.ws + WS_R3) + hh * 128 + fq * 8;
            const int oU = IMG_U + (((c0 >> 4) * 4 + mt) * 64 + lane) * 8;
            u32x4 rw[3][4], rk[3][2], rq[3][4], ra[3][2]; u32x2 ru[3][2]; f32x4 rs[3]; float dlr[3];
#define SC_LOAD1(set, blk) do { \
            _Pragma("unroll") for (int ks = 0; ks < 4; ++ks) rw[set][ks] = *(const u32x4*)((blk) + oW + ks * 1024); \
            ru[set][0] = *(const u32x2*)((blk) + oU); ru[set][1] = *(const u32x2*)((blk) + oU + 2048); dlr[set] = *(const float*)((blk) + IMG_SC); } while (0)
#define SC_LOAD2(set, blk, stp) do { const bf16_t* qrow_ = qbase + (size_t)chunk_row(chain, (stp), mt * 16 + fr) * 1536; \
            _Pragma("unroll") for (int ks = 0; ks < 2; ++ks) rk[set][ks] = *(const u32x4*)((blk) + oK + ks * 1024); \
            _Pragma("unroll") for (int ks = 0; ks < 4; ++ks) rq[set][ks] = *(const u32x4*)(qrow_ + ks * 32); \
            rs[set] = *(const f32x4*)((blk) + oS); \
            _Pragma("unroll") for (int ks = 0; ks < 2; ++ks) ra[set][ks] = *(const u32x4*)((blk) + oA + ks * 1024); } while (0)
#define SC_LOAD(set, blk, stp) do { SC_LOAD1(set, blk); SC_LOAD2(set, blk, stp); } while (0)
            SC_LOAD(0, blk0, 0); SC_LOAD(1, blk0 + IMG_BYTES, 1); SC_LOAD(2, blk0 + 2 * IMG_BYTES, 2);
            SYNC();
#pragma unroll 1
            for (int s3 = 0; s3 < NSTEP; s3 += 3) {
#pragma unroll
                for (int u = 0; u < 3; ++u) {
                    const int step = s3 + u, cur = step & 1;
                    const bf16_t* STc = ST + cur * 4352; bf16_t* STn = ST + (cur ^ 1) * 4352;
#pragma unroll
                    for (int nt = 0; nt < 2; ++nt) {
                        f32x4 vn = (f32x4){0.f, 0.f, 0.f, 0.f};
#pragma unroll
                        for (int ks = 0; ks < 4; ++ks) vn = mfma16(__builtin_bit_cast(bf16x8, rw[u][ks]), frag16(STc + (nt * 16 + fr) * 136 + ks * 32 + fq * 8), vn);
                        const unsigned u0 = ru[u][nt][0], u1 = ru[u][nt][1];
                        u32x2 w; w[0] = pk2(bf2f((bf16_t)(u0 & 0xffffu)) - vn[0], bf2f((bf16_t)(u0 >> 16)) - vn[1]); w[1] = pk2(bf2f((bf16_t)(u1 & 0xffffu)) - vn[2], bf2f((bf16_t)(u1 >> 16)) - vn[3]);
                        *(u32x2*)(VN + (nt * 16 + fr) * 72 + mt * 16 + fq * 4) = w;
                    }
                    const float dl = dlr[u];
                    const int stp3 = step + 3 < NSTEP ? step + 3 : NSTEP - 1;
                    const unsigned char* blk3 = blk0 + (size_t)stp3 * IMG_BYTES;
                    SC_LOAD1(u, blk3);
                    SYNC();
                    SC_SUPD(rk[u]);
                    if (step >= 4) {
#pragma unroll
                        for (int nt = 0; nt < 2; ++nt) {
                            f32x4 o1 = (f32x4){0.f, 0.f, 0.f, 0.f}, o = (f32x4){0.f, 0.f, 0.f, 0.f};
#pragma unroll
                            for (int ks = 0; ks < 4; ++ks) o1 = mfma16(__builtin_bit_cast(bf16x8, rq[u][ks]), frag16(STc + (nt * 16 + fr) * 136 + ks * 32 + fq * 8), o1);
#pragma unroll
                            for (int ks = 0; ks < 2; ++ks) o = mfma16(__builtin_bit_cast(bf16x8, ra[u][ks]), frag16(VN + (nt * 16 + fr) * 72 + ks * 32 + fq * 8), o);
                            o += o1 * rs[u];
#pragma unroll
                            for (int r = 0; r < 4; ++r) { const int pos = (step - 4) * 64 + mt * 16 + fq * 4 + r; const int tok = b * SEQ + (dir ? (SEQ - 1 - pos) : pos);
                                obuf[((size_t)dir * NTOK + tok) * 512 + hh * 128 + c0 + nt * 16 + fr] = f2bf(o[r]); }
                        }
                    }
                    SC_LOAD2(u, blk3, stp3);
                    SYNC();
                }
            }
#undef SC_LOAD
#undef SC_LOAD1
#undef SC_LOAD2
        } else {
            u32x4 rk[3][2]; float dlr[3];
#define SC_LOADK(set, blk) do { dlr[set] = *(const float*)((blk) + IMG_SC); _Pragma("unroll") for (int ks = 0; ks < 2; ++ks) rk[set][ks] = *(const u32x4*)((blk) + oK + ks * 1024); } while (0)
            SC_LOADK(0, blk0); SC_LOADK(1, blk0 + IMG_BYTES); SC_LOADK(2, blk0 + 2 * IMG_BYTES);
            SYNC();
#pragma unroll 1
            for (int s3 = 0; s3 < NSTEP; s3 += 3) {
#pragma unroll
                for (int u = 0; u < 3; ++u) {
                    const int step = s3 + u, cur = step & 1;
                    bf16_t* STn = ST + (cur ^ 1) * 4352;
                    const float dl = dlr[u];
                    SYNC();
                    SC_SUPD(rk[u]);
                    { const unsigned char* blk3 = blk0 + (size_t)(step + 3 < NSTEP ? step + 3 : NSTEP - 1) * IMG_BYTES; SC_LOADK(u, blk3); }
                    SYNC();
                }
            }
#undef SC_LOADK
        }
#undef SC_SUPD
        SYNC();
    }
}

DEV void phase6_amix(const Params& P, unsigned char* sm) {
    PHASE_TID;
    const bf16_t* ZT = (const bf16_t*)((const unsigned char*)P.out + DO_ZT);
    const bf16_t* zs = (const bf16_t*)((const unsigned char*)P.out + DO_ZS);
    const bf16_t* obuf = (const bf16_t*)(P.ws + WS_R4 + R4_OBUF);
    bf16_t* amix = (bf16_t*)(P.ws + WS_R4 + R4_AMIX);
    unsigned* tile = (unsigned*)sm;
    for (int tt = BID; tt < NTOK / 64; tt += NBLK) {
        const int tok0 = tt * 64;
        { u32x4 r[8];
#pragma unroll
          for (int q = 0; q < 8; ++q) { const int idx = TID + q * 512, cp = idx >> 3, piece = idx & 7; r[q] = *(const u32x4*)(ZT + (size_t)cp * NTOK + tok0 + piece * 8); }
#pragma unroll
          for (int q = 0; q < 8; ++q) { const int idx = TID + q * 512, cp = idx >> 3, piece = idx & 7; unsigned* t = tile + cp * 33 + piece * 4; t[0] = r[q][0]; t[1] = r[q][1]; t[2] = r[q][2]; t[3] = r[q][3]; } }
        SYNC();
        u32x4 oa[8], ob[8], oz[8];
#pragma unroll
        for (int q = 0; q < 8; ++q) { const int idx = TID + q * 512, tok = idx >> 6, hh = (idx >> 4) & 3, l16 = idx & 15; const size_t off = (size_t)(tok0 + tok) * 512 + hh * 128 + l16 * 8;
            oa[q] = *(const u32x4*)(obuf + off); ob[q] = *(const u32x4*)(obuf + (size_t)NTOK * 512 + off); oz[q] = *(const u32x4*)(zs + off); }
#pragma unroll
        for (int q = 0; q < 8; ++q) { const int tok = TID & 63, c8 = ((TID >> 6) * 8 + q) * 8, sh = (tok & 1) * 16; u32x4 o;
#pragma unroll
            for (int j = 0; j < 4; ++j) o[j] = ((tile[(c8 + 2 * j) * 33 + (tok >> 1)] >> sh) & 0xffffu) | (((tile[(c8 + 2 * j + 1) * 33 + (tok >> 1)] >> sh) & 0xffffu) << 16);
            *(u32x4*)(amix + (size_t)(tok0 + tok) * 1024 + c8) = o; }
        const int l16 = TID & 15;
        float og[8];
#pragma unroll
        for (int j = 0; j < 8; ++j) og[j] = P.onorm_g[l16 * 8 + j];
#pragma unroll
        for (int q = 0; q < 8; ++q) {
            const int idx = TID + q * 512, tok = idx >> 6, hh = (idx >> 4) & 3;
            const u32x4 a = oa[q], bq = ob[q], zv = oz[q];
            float v[8]; float ss = 0.f;
#pragma unroll
            for (int j = 0; j < 4; ++j) { v[2 * j] = bf2f((bf16_t)(a[j] & 0xffffu)) + bf2f((bf16_t)(bq[j] & 0xffffu)); v[2 * j + 1] = bf2f((bf16_t)(a[j] >> 16)) + bf2f((bf16_t)(bq[j] >> 16)); }
#pragma unroll
            for (int j = 0; j < 8; ++j) ss += v[j] * v[j];
            ss += shfl_xor_f(ss, 1); ss += shfl_xor_f(ss, 2); ss += shfl_xor_f(ss, 4); ss += shfl_xor_f(ss, 8);
            const float rstd = rsq_f(ss * (1.0f / 128.0f) + EPS);
            u32x4 o;
#pragma unroll
            for (int j = 0; j < 4; ++j) o[j] = pk2(v[2 * j] * rstd * og[2 * j] * bf2f((bf16_t)(zv[j] & 0xffffu)), v[2 * j + 1] * rstd * og[2 * j + 1] * bf2f((bf16_t)(zv[j] >> 16)));
            *(u32x4*)(amix + (size_t)(tok0 + tok) * 1024 + 512 + hh * 128 + l16 * 8) = o;
        }
        SYNC();
    }
}

DEV void phase8_router(const Params& P, unsigned char* sm, int dry) {
    PHASE_TID;
    float* wr = (float*)sm;
    {
        f32x4 g[2], rt[2][8];
#pragma unroll
        for (int h = 0; h < 2; ++h) { const int k = TID + h * 512; g[h] = *(const f32x4*)(P.w_group + k * 4);
#pragma unroll
            for (int q = 0; q < 8; ++q) rt[h][q] = *(const f32x4*)(P.w_router + k * 32 + q * 4); }
#pragma unroll
        for (int h = 0; h < 2; ++h) { const int k = TID + h * 512;
#pragma unroll
            for (int e = 0; e < 4; ++e) wr[e * 1028 + k] = g[h][e];
#pragma unroll
            for (int q = 0; q < 8; ++q)
#pragma unroll
                for (int e = 0; e < 4; ++e) wr[(4 + q * 4 + e) * 1028 + k] = rt[h][q][e]; }
    }
    SYNC();
    const float* mod = (const float*)(P.ws + WS_MOD);
    const float* x1 = P.out;
    bf16_t* h2 = (bf16_t*)(P.ws + WS_R4 + R4_H2);
    unsigned* cnt = (unsigned*)(P.ws + WS_CNT + (dry ? 8192 : 0)); unsigned* tokk = (unsigned*)(P.ws + (dry ? WS_R3 : WS_TOKK)); float* wl = (float*)(P.ws + (dry ? WS_R3 + 16 * MiB : WS_WL));
    const int wid = TID >> 6, lane = TID & 63;
    const int rstep = NBLK * 8;
    int r = BID * 8 + wid;
    unsigned* lc = (unsigned*)(sm + 148224);
    unsigned* aE = lc + 64; float* aW = (float*)(aE + 512); unsigned* aP = (unsigned*)(aW + 512);
    float* gsv = (float*)(sm + 154624); float* shv = gsv + 1024;
    float* brs = shv + 1024;
    if (TID < 32) { lc[TID] = 0u; brs[TID] = P.b_router[TID]; }
    const float bg0 = P.b_group[0], bg1 = P.b_group[1], bg2 = P.b_group[2], bg3 = P.b_group[3];
    SYNC();
    int jrow = 0;
    f32x4 vr[4][4];
#pragma unroll
    for (int jj = 0; jj < 4; ++jj) { const int rl = (r + jj * rstep < NTOK) ? r + jj * rstep : r;
#pragma unroll
        for (int i = 0; i < 4; ++i) vr[jj][i] = *(const f32x4*)(x1 + (size_t)rl * D + i * 256 + lane * 4); }
    const float n2a = P.norm2_g[TID], n2b = P.norm2_g[TID + 512];
    float msa, msb, mha, mhb;
    { const float* shift = mod + (r >> 13) * 6144 + 3 * 1024; msa = shift[1024 + TID]; msb = shift[1024 + TID + 512]; mha = shift[TID]; mhb = shift[TID + 512]; }
#pragma unroll 1
    for (; r < NTOK; ) {
        SYNC();
        gsv[TID] = n2a * (1.0f + msa); gsv[TID + 512] = n2b * (1.0f + msb); shv[TID] = mha; shv[TID + 512] = mhb;
        { const int rn = (r + 4 * rstep < NTOK) ? r + 4 * rstep : r; const float* shift = mod + (rn >> 13) * 6144 + 3 * 1024; msa = shift[1024 + TID]; msb = shift[1024 + TID + 512]; mha = shift[TID]; mhb = shift[TID + 512]; }
        SYNC();
#pragma unroll
      for (int jj = 0; jj < 4; ++jj) { if (r < NTOK) {
        f32x4 v[4]; float ss = 0.f;
#pragma unroll
        for (int i = 0; i < 4; ++i) { v[i] = vr[jj][i]; ss += v[i][0] * v[i][0] + v[i][1] * v[i][1] + v[i][2] * v[i][2] + v[i][3] * v[i][3]; }
        { const int rl = (r + 4 * rstep < NTOK) ? r + 4 * rstep : r;
#pragma unroll
          for (int i = 0; i < 4; ++i) vr[jj][i] = *(const f32x4*)(x1 + (size_t)rl * D + i * 256 + lane * 4); }
        ss = wave_sum(ss);
        const float rstd = rsq_f(ss * (1.0f / 1024.0f) + EPS);
        float gl[4] = {0.f, 0.f, 0.f, 0.f};
#pragma unroll
        for (int i = 0; i < 4; ++i) {
            const int k = i * 256 + lane * 4;
            const f32x4 g2 = *(const f32x4*)(gsv + k), sh = *(const f32x4*)(shv + k);
#pragma unroll
            for (int e = 0; e < 4; ++e) v[i][e] = v[i][e] * rstd * g2[e] + sh[e];
#pragma unroll
            for (int j = 0; j < 4; ++j) { const f32x4 wv = *(const f32x4*)(wr + j * 1028 + k); gl[j] += v[i][0] * wv[0] + v[i][1] * wv[1] + v[i][2] * wv[2] + v[i][3] * wv[3]; }
            u32x2 w; w[0] = pk2(v[i][0], v[i][1]); w[1] = pk2(v[i][2], v[i][3]);
            *(u32x2*)(h2 + (size_t)r * D + k) = w;
        }
#pragma unroll
        for (int j = 0; j < 4; ++j) gl[j] += 0.f;
        { const float t = wave_sum_multi<4>(gl, lane);
#pragma unroll
          for (int j = 0; j < 4; ++j) gl[j] = lane_bcast(t, j) + (j == 0 ? bg0 : j == 1 ? bg1 : j == 2 ? bg2 : bg3); }
        int gsel = 0; float gmax = gl[0];
#pragma unroll
        for (int j = 1; j < 4; ++j) if (gl[j] > gmax) { gmax = gl[j]; gsel = j; }
        float gden = 0.f;
#pragma unroll
        for (int j = 0; j < 4; ++j) gden += __expf(gl[j] - gmax);
        const float pg = 1.0f / gden;
        float el[8] = {0.f, 0.f, 0.f, 0.f, 0.f, 0.f, 0.f, 0.f};
#pragma unroll
        for (int i = 0; i < 4; ++i)
#pragma unroll
            for (int j = 0; j < 8; ++j) { const f32x4 wv = *(const f32x4*)(wr + (4 + gsel * 8 + j) * 1028 + i * 256 + lane * 4); el[j] += v[i][0] * wv[0] + v[i][1] * wv[1] + v[i][2] * wv[2] + v[i][3] * wv[3]; }
#pragma unroll
        for (int j = 0; j < 8; ++j) el[j] += 0.f;
        { const float t = wave_sum_multi<8>(el, lane);
#pragma unroll
          for (int j = 0; j < 8; ++j) el[j] = lane_bcast(t, j) + brs[gsel * 8 + j]; }
        int e1 = 0; float m1 = el[0];
#pragma unroll
        for (int j = 1; j < 8; ++j) if (el[j] > m1) { m1 = el[j]; e1 = j; }
        int e2 = -1; float m2 = -3.0e38f;
#pragma unroll
        for (int j = 0; j < 8; ++j) if (j != e1 && el[j] > m2) { m2 = el[j]; e2 = j; }
        if (e2 < 0) e2 = (e1 + 1) & 7;
        const float p2 = __expf(m2 - m1);
        const float w1 = pg / (1.0f + p2), w2 = pg * p2 / (1.0f + p2);
        if (lane < 2) {
            const int ee = gsel * 8 + (lane == 0 ? e1 : e2); const float ww = lane == 0 ? w1 : w2;
            const unsigned pos = atomic_add_u32(&lc[ee], 1u);
            const int a = (jrow * 8 + wid) * 2 + lane;
            if (a < 512) { aE[a] = (unsigned)ee; aW[a] = ww; aP[a] = pos; }
        }
        ++jrow; r += rstep;
      } }
    }
    SYNC();
    if (TID < 32) lc[32 + TID] = atomic_add_u32(&cnt[TID * 64], lc[TID]);
    SYNC();
    { const int a = TID, rl = a >> 1, rr = BID * 8 + (rl & 7) + (rl >> 3) * rstep;
      if (rr < NTOK && (rl >> 3) < jrow) { const unsigned ee = aE[a]; const unsigned pos = lc[32 + ee] + aP[a];
          tokk[(size_t)ee * LCAP + pos] = (unsigned)rr * 2u + (unsigned)(a & 1); wl[(size_t)ee * LCAP + pos] = aW[a]; } }
}

DEV void phase11_final(const Params& P, unsigned char* sm, float* dstbase) {
    PHASE_TID;
    (void)sm;
    const float* mod = (const float*)(P.ws + WS_MOD);
    const bf16_t* Y = (const bf16_t*)(P.ws + WS_R4 + R4_Y);
    const int wid = TID >> 6, lane = TID & 63;
    for (int r0 = (BID * 8 + wid) * 2; r0 < NTOK; r0 += NBLK * 16) {
        f32x4 xv[2][4]; u32x2 y0[2][4], y1[2][4];
#pragma unroll
        for (int u = 0; u < 2; ++u)
#pragma unroll
            for (int i = 0; i < 4; ++i) { const int k = i * 256 + lane * 4; const size_t r = (size_t)(r0 + u);
                xv[u][i] = *(const f32x4*)(P.out + r * D + k); y0[u][i] = *(const u32x2*)(Y + r * D + k); y1[u][i] = *(const u32x2*)(Y + ((size_t)NTOK + r) * D + k); }
        const float* gate = mod + (r0 >> 13) * 6144 + 5 * 1024;
#pragma unroll
        for (int u = 0; u < 2; ++u) {
            float* row = dstbase + (size_t)(r0 + u) * D;
            f32x4 v[4]; float ss = 0.f;
#pragma unroll
            for (int i = 0; i < 4; ++i) { const int k = i * 256 + lane * 4; const f32x4 gv = *(const f32x4*)(gate + k);
                f32x4 m; m[0] = bf2f((bf16_t)(y0[u][i][0] & 0xffffu)) + bf2f((bf16_t)(y1[u][i][0] & 0xffffu)); m[1] = bf2f((bf16_t)(y0[u][i][0] >> 16)) + bf2f((bf16_t)(y1[u][i][0] >> 16));
                m[2] = bf2f((bf16_t)(y0[u][i][1] & 0xffffu)) + bf2f((bf16_t)(y1[u][i][1] & 0xffffu)); m[3] = bf2f((bf16_t)(y0[u][i][1] >> 16)) + bf2f((bf16_t)(y1[u][i][1] >> 16));
                v[i] = xv[u][i] + gv * m; ss += v[i][0] * v[i][0] + v[i][1] * v[i][1] + v[i][2] * v[i][2] + v[i][3] * v[i][3]; }
            ss = wave_sum(ss);
            const float rstd = rsq_f(ss * (1.0f / 1024.0f) + EPS);
#pragma unroll
            for (int i = 0; i < 4; ++i) { const int k = i * 256 + lane * 4; const f32x4 fg = *(const f32x4*)(P.final_g + k); *(f32x4*)(row + k) = v[i] * rstd * fg; }
        }
    }
}

#ifndef CPU_EMU
#define XB_TMO      128
#define XB_XCNT(j)  (256  + 64 * (j))
#define XB_XSUB(j)  (1280 + 64 * (j))
#define XB_XGEN(j)  (2304 + 64 * (j))
#define XB_TOP      3328
#define XB_TOPGEN   3392
#define XCD_BAR_WORDS 3456
#define XB_SPIN_CAP (1u << 22)
#define LAS __attribute__((address_space(3)))
__device__ __forceinline__ unsigned xb_ld(unsigned* p)              { return __hip_atomic_load(p, __ATOMIC_RELAXED, __HIP_MEMORY_SCOPE_AGENT); }
__device__ __forceinline__ unsigned xb_add(unsigned* p, unsigned v) { return __hip_atomic_fetch_add(p, v, __ATOMIC_RELAXED, __HIP_MEMORY_SCOPE_AGENT); }
__device__ __forceinline__ unsigned xb_xcc_id() { return (unsigned)__builtin_amdgcn_s_getreg((3 << 11) | 20) & 0xFu; }
#define XB_SPIN(cond, bar) do { unsigned _sp = 0; while (cond) { __builtin_amdgcn_s_sleep(1); \
    if ((++_sp & 255u) == 0u) { if (xb_ld(&(bar)[XB_TMO])) break; if (_sp > XB_SPIN_CAP) { atomicAdd(&(bar)[XB_TMO], 1u); break; } } } } while (0)
struct XcdBarrier { unsigned* bar; unsigned x; volatile LAS unsigned* st; };
__device__ __forceinline__ XcdBarrier xcd_barrier_post(unsigned* bar, volatile LAS unsigned* st) {
    XcdBarrier b; b.bar = bar; b.x = xb_xcc_id(); b.st = st;
    if (threadIdx.x == 0) (void)xb_add(&bar[XB_XCNT(b.x)], 1u);
    return b;
}
__device__ __forceinline__ void xcd_barrier_complete(unsigned* bar, unsigned x, unsigned& nloc, unsigned& nx) {
    const unsigned G = gridDim.x * gridDim.y * gridDim.z;
    unsigned sum, cnt, mine, sp = 0u;
    for (;;) {
        sum = 0u; cnt = 0u; mine = 0u;
#pragma unroll
        for (unsigned j = 0; j < 16; ++j) { const unsigned c = xb_ld(&bar[XB_XCNT(j)]); sum += c; cnt += (c > 0u) ? 1u : 0u; mine = (j == x) ? c : mine; }
        if (sum == G) break;
        __builtin_amdgcn_s_sleep(1);
        if ((++sp & 255u) == 0u) { if (xb_ld(&bar[XB_TMO])) break; if (sp > XB_SPIN_CAP) { atomicAdd(&bar[XB_TMO], 1u); break; } }
    }
    nloc = mine > 0u ? mine : 1u; nx = cnt > 0u ? cnt : 1u;
}
__device__ __forceinline__ void xcd_barrier(const XcdBarrier& b) {
    asm volatile("s_waitcnt vmcnt(0)" ::: "memory");
    __syncthreads();
    if (threadIdx.x == 0) {
        unsigned* bar = b.bar;
        __builtin_amdgcn_s_waitcnt(0);
        unsigned nloc = b.st[0], nx = b.st[1];
        if (nloc == 0u) { xcd_barrier_complete(bar, b.x, nloc, nx); b.st[0] = nloc; b.st[1] = nx; }
        const unsigned old = xb_add(&bar[XB_XSUB(b.x)], 1u);
        const unsigned gen = old / nloc;
        if (old + 1u == (gen + 1u) * nloc) {
            __builtin_amdgcn_fence(__ATOMIC_RELEASE, "agent");
            asm volatile("s_waitcnt vmcnt(0)" ::: "memory");
            const unsigned og = xb_add(&bar[XB_TOP], 1u);
            const unsigned tg = og / nx;
            if (og + 1u == (tg + 1u) * nx) xb_add(&bar[XB_TOPGEN], 1u);
            else XB_SPIN(xb_ld(&bar[XB_TOPGEN]) == tg, bar);
            __builtin_amdgcn_fence(__ATOMIC_ACQUIRE, "agent");
            xb_add(&bar[XB_XGEN(b.x)], 1u);
            asm volatile("s_waitcnt vmcnt(0)" ::: "memory");
        } else {
            XB_SPIN(xb_ld(&bar[XB_XGEN(b.x)]) == gen, bar);
            __builtin_amdgcn_fence(__ATOMIC_ACQUIRE, "agent");
            asm volatile("s_waitcnt vmcnt(0)" ::: "memory");
        }
    }
    __syncthreads();
}

#ifndef MK_PH
#define MK_PH 0x7ff
#endif
#ifndef MK_REP
#define MK_REP 0
#endif
#define REPS(k) for (int rep_ = 0; rep_ < (((MK_REP >> (k)) & 1) ? 2 : 1); ++rep_)
extern __shared__ __attribute__((aligned(16))) unsigned char smem_dyn[];

__device__ __forceinline__ void moe_tables(const Params& P, LAS int* tb, LAS int* cn) {
    const unsigned* cnt = (const unsigned*)(P.ws + WS_CNT);
    if (threadIdx.x < 32) cn[threadIdx.x] = (int)cnt[threadIdx.x * 64];
    __syncthreads();
    if (threadIdx.x == 0) { int acc = 0; for (int e = 0; e < 32; ++e) { tb[e] = acc; acc += (cn[e] + 255) >> 8; } tb[32] = acc; }
    __syncthreads();
}

__global__ void __launch_bounds__(512, 2) hymba_fwd(Params P) {
    unsigned char* sm = smem_dyn;
    LAS unsigned char* lsm = (LAS unsigned char*)smem_dyn;
    volatile LAS unsigned* xbw = (volatile LAS unsigned*)(lsm + LDS_BYTES - 16);
    if (threadIdx.x == 0) { xbw[0] = 0u; xbw[1] = 0u; xbw[2] = 0u; xbw[3] = 0u; }
    __syncthreads();
    XcdBarrier bar = xcd_barrier_post((unsigned*)(P.ws + WS_BAR), xbw);
    using namespace pg8;

#if (MK_PH >> 0) & 1
    REPS(15) phase0_mod(P, sm); REPS(0) { phase0_weights(P, sm); phase0_wf(P, sm); }
    xcd_barrier(bar);
#endif
#if (MK_PH >> 1) & 1
    REPS(1) phase1_prep(P, sm);
    xcd_barrier(bar);
#endif
#if (MK_PH >> 2) & 1
    REPS(2) {
    { ProbInproj G; G.init(MROWS / 256, 8, gridDim.x, blockIdx.x); G.A = (const bf16_t*)(P.ws + WS_R4 + R4_H); G.Bt = (const bf16_t*)(P.ws + WS_WQKVZ); G.K = 1024;
      EpiInproj E; E.O = (bf16_t*)(P.ws + WS_R4 + R4_P); E.zs = (bf16_t*)((unsigned char*)P.out + DO_ZS); E.rstd = (const float*)(P.ws + WS_RSTD); E.bias = (const float*)(P.ws + WS_BIAS); gemm_phase(lsm, G, E); }
    { ProbGT G; G.init(4, NTOK / 256, gridDim.x, blockIdx.x); G.A = (const bf16_t*)(P.ws + WS_WF); G.Bt = (const bf16_t*)(P.ws + WS_R4 + R4_H); G.K = 1024;
      EpiGT E; E.O = (bf16_t*)((unsigned char*)P.out + DO_GT); E.rstd = (const float*)(P.ws + WS_RSTD); E.bias = (const float*)(P.ws + WS_BIAS); gemm_phase(lsm, G, E); }
    }
    xcd_barrier(bar);
#endif
#if (MK_PH >> 3) & 1
    REPS(3) phase3_conv(P, sm);
    xcd_barrier(bar);
#endif
#if (MK_PH >> 4) & 1
    REPS(4) phase4_prepass(P, sm);
    REPS(11) phase4_fft(P, sm);
    xcd_barrier(bar);
#endif
#if (MK_PH >> 5) & 1
    REPS(5) phase5_scan(P, sm);
    xcd_barrier(bar);
#endif
#if (MK_PH >> 6) & 1
    REPS(6) phase6_amix(P, sm);
    xcd_barrier(bar);
#endif
#if (MK_PH >> 7) & 1
    REPS(7)
    { ProbOut G; G.init(NTOK / 256, 4, gridDim.x, blockIdx.x); G.A = (const bf16_t*)(P.ws + WS_R4 + R4_AMIX); G.Bt = (const bf16_t*)(P.ws + WS_WOUT); G.K = 1024;
      EpiResid E; E.x = P.x; E.mod = (const float*)(P.ws + WS_MOD); E.out = P.out; gemm_phase(lsm, G, E); }
    xcd_barrier(bar);
#endif
#if (MK_PH >> 8) & 1
#if (MK_REP >> 13) & 1
    phase8_router(P, sm, 1);
#endif
    phase8_router(P, sm, 0);
#if (MK_REP >> 14) & 1
    xcd_barrier(bar); xcd_barrier(bar); xcd_barrier(bar); xcd_barrier(bar);
#endif
    xcd_barrier(bar);
#endif
#if (MK_PH >> 9) & 1
    LAS int* tb = (LAS int*)(lsm + STAGE_BYTES); LAS int* cn = tb + 64;
    moe_tables(P, tb, cn);
    REPS(9)
    { ProbMoe1 G; G.tb = tb; G.cnt = cn; G.G = gridDim.x; G.c = blockIdx.x; G.A = (const bf16_t*)(P.ws + WS_R4 + R4_H2); G.Bt = (const bf16_t*)(P.ws + WS_WGU); G.K = 1024; G.tokk = (const unsigned*)(P.ws + WS_TOKK);
      EpiMoe1 E; E.hid = (bf16_t*)(P.ws + WS_R4 + R4_HID); gemm_phase(lsm, G, E); }
    xcd_barrier(bar);
    REPS(10)
    { ProbMoe2 G; G.tb = tb; G.cnt = cn; G.G = gridDim.x; G.c = blockIdx.x; G.A = (const bf16_t*)(P.ws + WS_R4 + R4_HID); G.Bt = (const bf16_t*)(P.ws + WS_WD); G.K = 512;
      EpiMoe2 E; E.Y = (bf16_t*)(P.ws + WS_R4 + R4_Y); E.tokk = (const unsigned*)(P.ws + WS_TOKK); E.wl = (const float*)(P.ws + WS_WL); E.tb = tb; gemm_phase(lsm, G, E); }
    xcd_barrier(bar);
#endif
#if (MK_PH >> 10) & 1
#if (MK_REP >> 12) & 1
    phase11_final(P, sm, (float*)(P.ws + WS_R4 + 300 * MiB));
#endif
    phase11_final(P, sm, P.out);
#endif
}

extern "C" void kernel_launch(void* const* d_in, const int* in_sizes, int n_in, void* d_out, int out_size, void* d_ws, size_t ws_size, hipStream_t stream) {
    (void)in_sizes; (void)n_in; (void)out_size;
    static int grid = 0;
    if (!grid) {
        int dev = 0, cus = 0, per_cu = 0;
        hipGetDevice(&dev);
        hipDeviceGetAttribute(&cus, hipDeviceAttributeMultiprocessorCount, dev);
        hipFuncSetAttribute((const void*)hymba_fwd, hipFuncAttributeMaxDynamicSharedMemorySize, LDS_BYTES);
        hipOccupancyMaxActiveBlocksPerMultiprocessor(&per_cu, hymba_fwd, 512, LDS_BYTES);
        if (per_cu < 1) { fprintf(stderr, "occupancy query says 0 blocks per CU\n"); per_cu = 1; }
        grid = cus;
        if (ws_size < WS_NEED) fprintf(stderr, "workspace too small: %zu < %zu\n", ws_size, (size_t)WS_NEED);
    }
    Params p{};
    p.x = (const float*)d_in[0]; p.c = (const float*)d_in[1]; p.ctx = (const float*)d_in[2]; p.c_ctx = (const float*)d_in[3]; p.w_mod = (const float*)d_in[4]; p.b_mod = (const float*)d_in[5];
    p.norm1_g = (const float*)d_in[6]; p.w_in = (const float*)d_in[7]; p.conv_w = (const float*)d_in[8]; p.a_log = (const float*)d_in[9]; p.dt_bias = (const float*)d_in[10]; p.onorm_g = (const float*)d_in[11];
    p.w_out = (const float*)d_in[12]; p.norm2_g = (const float*)d_in[13]; p.w_group = (const float*)d_in[14]; p.b_group = (const float*)d_in[15]; p.w_router = (const float*)d_in[16]; p.b_router = (const float*)d_in[17];
    p.w_gate = (const float*)d_in[18]; p.w_up = (const float*)d_in[19]; p.w_down = (const float*)d_in[20]; p.final_g = (const float*)d_in[21];
    p.out = (float*)d_out; p.ws = (unsigned char*)d_ws;
    hipMemsetAsync(d_ws, 0, WS_ZERO_BYTES, stream);
    hipLaunchKernelGGL(hymba_fwd, dim3(grid), dim3(512), LDS_BYTES, stream, p);
}
#endif
```

```cpp
#ifndef CPU_EMU
#include <hip/hip_runtime.h>
#include <cstdio>
#include <cstdint>
#define DEV __device__ __forceinline__
#define TID tid_local
#define PHASE_TID int tid_local = (int)threadIdx.x; asm volatile("" : "+v"(tid_local))
#define BID ((int)blockIdx.x)
#define NBLK ((int)gridDim.x)
#define SYNC() __syncthreads()
#define SCHED_FENCE() __builtin_amdgcn_sched_barrier(0)
#endif

typedef unsigned short bf16_t;
typedef short bf16x8 __attribute__((ext_vector_type(8)));
typedef float f32x4 __attribute__((ext_vector_type(4)));
typedef unsigned u32x4 __attribute__((ext_vector_type(4)));
typedef unsigned u32x2 __attribute__((ext_vector_type(2)));

constexpr int D = 1024, NB = 8, SEQ = 8192, CTX = 256;
constexpr int NTOK = NB * SEQ;
constexpr int NCTX = NB * CTX;
constexpr int MROWS = NTOK + NCTX;
constexpr int W_IN = 2576;
constexpr int NSTEP = 4 + 128;
constexpr int NCHAIN = NB * 4 * 2;
constexpr int NPROB = NCHAIN * NSTEP;
constexpr float EPS = 1e-6f;
constexpr int NEXP = 32;
constexpr int LCAP = 65536;

constexpr int IMG_W = 0, IMG_KT = 16384, IMG_A = 32768, IMG_U = 40960, IMG_SC = 57344, IMG_BYTES = 57664;

constexpr size_t MiB = 1048576;
constexpr size_t WS_BAR = 0;
constexpr size_t WS_MOD = 16384;
constexpr size_t WS_CNT = 16384 + 221184;
constexpr size_t WS_ZERO_BYTES = WS_CNT + 16384;
constexpr size_t WS_TAB = 262144;
constexpr size_t WS_BIAS = 393216;
constexpr size_t WS_RSTD = 5 * MiB + 524288;
constexpr size_t WS_GB = 1 * MiB;
constexpr size_t WS_TOKK = 6 * MiB;
constexpr size_t WS_WL = 14 * MiB;
constexpr size_t WS_W = 22 * MiB;
constexpr size_t WS_WQKVZ = WS_W;
constexpr size_t WS_WF = WS_WQKVZ + 2048ull * 1024 * 2;
constexpr size_t WS_WOUT = WS_WF + 1024ull * 1024 * 2;
constexpr size_t WS_WGU = WS_WOUT + 1024ull * 1024 * 2;
constexpr size_t WS_WD = WS_WGU + 32ull * 1024 * 1024 * 2;
constexpr size_t WS_R3 = 126 * MiB;
constexpr size_t WS_R4 = 324 * MiB;
constexpr size_t WS_NEED = WS_R4 + 645 * MiB;
constexpr size_t R4_H = 0, R4_P = 132 * MiB;
constexpr size_t R4_AMIX = 0, R4_H2 = 128 * MiB, R4_HID = 256 * MiB, R4_Y = 0;
constexpr size_t R4_OBUF = 480 * MiB;
constexpr size_t DO_GT = 0, DO_ZT = 128 * MiB, DO_ZS = 192 * MiB;

constexpr int LDS_BYTES = 163840;

struct Params {
    const float *x, *c, *ctx, *c_ctx, *w_mod, *b_mod, *norm1_g, *w_in, *conv_w, *a_log, *dt_bias, *onorm_g, *w_out, *norm2_g,
                *w_group, *b_group, *w_router, *b_router, *w_gate, *w_up, *w_down, *final_g;
    float* out;
    unsigned char* ws;
};

DEV bf16_t f2bf(float f) { unsigned u = __builtin_bit_cast(unsigned, f); u += 0x7FFFu + ((u >> 16) & 1u); return (bf16_t)(u >> 16); }
DEV float bf2f(bf16_t b) { return __builtin_bit_cast(float, ((unsigned)b) << 16); }
#ifndef MK_F8
#define MK_F8 1
#endif
#ifndef CPU_EMU
DEV unsigned pk4_fp8(float a, float b, float c, float d) { int t = 0; t = __builtin_amdgcn_cvt_pk_fp8_f32(a, b, t, false); t = __builtin_amdgcn_cvt_pk_fp8_f32(c, d, t, true); return (unsigned)t; }
typedef __bf16 bf16n2 __attribute__((ext_vector_type(2)));
DEV unsigned pk2(float lo, float hi) { bf16n2 v; v[0] = (__bf16)lo; v[1] = (__bf16)hi; return __builtin_bit_cast(unsigned, v); }
DEV float rcp_f(float x) { return __builtin_amdgcn_rcpf(x); }
DEV float rsq_f(float x) { return __builtin_amdgcn_rsqf(x); }
#else
DEV unsigned pk2(float lo, float hi) { return (unsigned)f2bf(lo) | ((unsigned)f2bf(hi) << 16); }
DEV float rcp_f(float x) { return 1.0f / x; }
DEV float rsq_f(float x) { return 1.0f / sqrtf(x); }
#endif
DEV float silu_f(float v) { return v * rcp_f(1.0f + __expf(-v)); }

#ifndef CPU_EMU
DEV f32x4 mfma16(bf16x8 a, bf16x8 b, f32x4 c) { return __builtin_amdgcn_mfma_f32_16x16x32_bf16(a, b, c, 0, 0, 0); }
DEV float shfl_xor_f(float v, int m) { return __shfl_xor(v, m); }
DEV float shfl_up_f(float v, int d) { return __shfl_up(v, d); }
DEV float shfl_idx_f(float v, int l) { return __shfl(v, l); }
DEV void atomic_add_f32(float* p, float v) { atomicAdd(p, v); }
DEV unsigned atomic_add_u32(unsigned* p, unsigned v) { return atomicAdd(p, v); }
DEV void sincospi_f(float x, float* s, float* c) { sincospif(x, s, c); }
#endif

DEV float wave_sum(float v) {
#pragma unroll
    for (int o = 32; o >= 1; o >>= 1) v += shfl_xor_f(v, o);
    return v;
}
template <int N> DEV float wave_sum_multi(const float (&v)[N], int lane) {
    float a[N];
#pragma unroll
    for (int i = 0; i < N; ++i) a[i] = v[i];
    int m = 1;
#pragma unroll
    for (int n = N; n > 1; n >>= 1, m <<= 1) {
        const bool up = (lane & m) != 0;
#pragma unroll
        for (int i = 0; i < n / 2; ++i) { const float keep = up ? a[2 * i + 1] : a[2 * i], send = up ? a[2 * i] : a[2 * i + 1]; a[i] = keep + shfl_xor_f(send, m); }
    }
    float r = a[0];
#pragma unroll
    for (int o = N; o < 64; o <<= 1) r += shfl_xor_f(r, o);
    return r;
}
#ifndef CPU_EMU
DEV float lane_bcast(float v, int l) { return __builtin_bit_cast(float, __builtin_amdgcn_readlane(__builtin_bit_cast(int, v), l)); }
#endif
DEV bf16x8 frag_gather(const bf16_t* p, int stride) {
    bf16x8 r;
#pragma unroll
    for (int j = 0; j < 8; ++j) r[j] = (short)p[j * stride];
    return r;
}
DEV bf16x8 frag16(const bf16_t* p) { return *(const bf16x8*)p; }

DEV void phase0_mod(const Params& P, unsigned char* sm) {
    PHASE_TID;
    float* sil = (float*)sm;
    float* red = (float*)(sm + 36864);
    for (int i = TID; i < 9 * 1024; i += 512) { const int r = i >> 10, k = i & 1023; const float v = r < 8 ? P.c[r * 1024 + k] : P.c_ctx[k]; sil[i] = silu_f(v); }
    SYNC();
    float* mod = (float*)(P.ws + WS_MOD);
    for (int cb = BID; cb < 256; cb += NBLK) {
        const int c = TID % 24, kg = TID / 24, j0 = cb * 24;
        if (kg < 21) {
            float acc[9];
#pragma unroll
            for (int r = 0; r < 9; ++r) acc[r] = 0.f;
#pragma unroll 7
            for (int k = kg; k < 1024; k += 21) { const float w = P.w_mod[(size_t)k * 6144 + j0 + c];
#pragma unroll
                for (int r = 0; r < 9; ++r) acc[r] += sil[r * 1024 + k] * w; }
#pragma unroll
            for (int r = 0; r < 9; ++r) red[(kg * 24 + c) * 9 + r] = acc[r];
        }
        SYNC();
        if (TID < 24 * 9) { const int cc = TID / 9, r = TID - cc * 9; float t = P.b_mod[j0 + cc];
            for (int g = 0; g < 21; ++g) t += red[(g * 24 + cc) * 9 + r];
            mod[r * 6144 + j0 + cc] = t; }
        SYNC();
    }
}

DEV void tconv_tile(const float* src, int lds_, bf16_t* dst, int ldd, int inter, unsigned char* sm, const int f8 = 0) {
    PHASE_TID;
    float* tile = (float*)sm;
    f32x4 v[8];
#pragma unroll
    for (int q = 0; q < 8; ++q) v[q] = *(const f32x4*)(src + (size_t)((TID >> 6) + q * 8) * lds_ + (TID & 63) * 4);
#pragma unroll
    for (int q = 0; q < 8; ++q) { float* t = tile + ((TID >> 6) + q * 8) * 257 + (TID & 63) * 4; t[0] = v[q][0]; t[1] = v[q][1]; t[2] = v[q][2]; t[3] = v[q][3]; }
    SYNC();
    const int c = TID & 255, half = TID >> 8;
    if (f8) {
        const int drow8 = inter ? ((c >> 7) * 256 + ((c >> 5) & 3) * 64 + (inter - 1) * 32 + (c & 31)) : c;
        u32x4 w[2];
#pragma unroll
        for (int q = 0; q < 2; ++q)
#pragma unroll
            for (int j = 0; j < 4; ++j) { const int k0 = half * 32 + q * 16 + j * 4; w[q][j] = pk4_fp8(tile[k0 * 257 + c] * 32.0f, tile[(k0 + 1) * 257 + c] * 32.0f, tile[(k0 + 2) * 257 + c] * 32.0f, tile[(k0 + 3) * 257 + c] * 32.0f); }
        unsigned char* d8 = (unsigned char*)dst + (size_t)drow8 * ldd + half * 32;
        *(u32x4*)d8 = w[0]; *(u32x4*)(d8 + 16) = w[1];
    } else {
        const int drow = inter ? ((c >> 7) * 256 + (inter - 1) * 128 + (c & 127)) : c;
        u32x4 w[4];
#pragma unroll
        for (int q = 0; q < 4; ++q)
#pragma unroll
            for (int j = 0; j < 4; ++j) w[q][j] = pk2(tile[(half * 32 + q * 8 + 2 * j) * 257 + c], tile[(half * 32 + q * 8 + 2 * j + 1) * 257 + c]);
#pragma unroll
        for (int q = 0; q < 4; ++q) *(u32x4*)(dst + (size_t)drow * ldd + half * 32 + q * 8) = w[q];
    }
    SYNC();
}

DEV void phase0_weights(const Params& P, unsigned char* sm) {
    bf16_t* wqkvz = (bf16_t*)(P.ws + WS_WQKVZ); bf16_t* wout = (bf16_t*)(P.ws + WS_WOUT); bf16_t* wgu = (bf16_t*)(P.ws + WS_WGU); bf16_t* wd = (bf16_t*)(P.ws + WS_WD);
    const int NJ = 128 + 64 + 3 * 1024;
    for (int t = BID; t < NJ; t += NBLK) {
        if (t < 128) { const int kt = t >> 3, nt = t & 7;
            tconv_tile(P.w_in + (size_t)(kt * 64) * W_IN + 512 + nt * 256, W_IN, wqkvz + (size_t)(nt * 256) * 1024 + kt * 64, 1024, 0, sm);
        } else if (t < 192) { const int u = t - 128, kt = u >> 2, nt = u & 3;
            tconv_tile(P.w_out + (size_t)(kt * 64) * 1024 + nt * 256, 1024, wout + (size_t)(nt * 256) * 1024 + kt * 64, 1024, 0, sm);
        } else if (t < 192 + 2048) { const int u = t - 192, up = u >> 10, v = u & 1023, e = v >> 5, w = v & 31, kt = w >> 1, nt = w & 1;
            const float* src = (up ? P.w_up : P.w_gate) + (size_t)e * 1024 * 512 + (size_t)(kt * 64) * 512 + nt * 256;
#if MK_F8
            tconv_tile(src, 512, (bf16_t*)((unsigned char*)wgu + (size_t)e * 1024 * 1024 + (size_t)(nt * 512) * 1024 + kt * 64), 1024, 1 + up, sm, 1);
#else
            tconv_tile(src, 512, wgu + (size_t)e * 1024 * 1024 + (size_t)(nt * 512) * 1024 + kt * 64, 1024, 1 + up, sm);
#endif
        } else { const int v = t - 192 - 2048, e = v >> 5, w = v & 31, kt = w >> 2, nt = w & 3;
#if MK_F8
            tconv_tile(P.w_down + (size_t)e * 512 * 1024 + (size_t)(kt * 64) * 1024 + nt * 256, 1024, (bf16_t*)((unsigned char*)wd + (size_t)e * 1024 * 512 + (size_t)(nt * 256) * 512 + kt * 64), 512, 0, sm, 1);
#else
            tconv_tile(P.w_down + (size_t)e * 512 * 1024 + (size_t)(kt * 64) * 1024 + nt * 256, 1024, wd + (size_t)e * 1024 * 512 + (size_t)(nt * 256) * 512 + kt * 64, 512, 0, sm);
#endif
        }
    }
}

DEV void phase0_wf(const Params& P, unsigned char* sm) {
    PHASE_TID;
    float* cs = (float*)sm;
    if (TID < 128) { float s, c; sincospi_f((float)TID * (2.0f / 128.0f), &s, &c); cs[TID] = c; cs[128 + TID] = s; }
    SYNC();
    bf16_t* wf = (bf16_t*)(P.ws + WS_WF);
    const float sc = 0.08838834764831845f;
    for (int it = BID; it < 256; it += NBLK) {
        const int kb = it & 1, cb = (it >> 1) & 15, part = (it >> 5) & 1, g = it >> 6;
        const int k = kb * 512 + TID;
        const float* wrow = P.w_in + (size_t)k * W_IN + g * 128;
        float acc[8];
#pragma unroll
        for (int q = 0; q < 8; ++q) acc[q] = 0.f;
#pragma unroll 8
        for (int c4 = 0; c4 < 32; ++c4) { const f32x4 w4 = *(const f32x4*)(wrow + c4 * 4);
#pragma unroll
            for (int e = 0; e < 4; ++e) { const int c = c4 * 4 + e;
#pragma unroll
                for (int q = 0; q < 8; ++q) { const int cp = cb * 8 + q; acc[q] += w4[e] * cs[part * 128 + ((c * cp) & 127)]; } } }
#pragma unroll
        for (int q = 0; q < 8; ++q) { const int chc = part * 512 + g * 128 + cb * 8 + q; wf[(size_t)chc * 1024 + k] = f2bf((part ? -acc[q] : acc[q]) * sc); }
    }
    bf16_t* tab = (bf16_t*)(P.ws + WS_TAB);
    const float sc2 = 0.011048543456039806f;
    for (int i = BID * 512 + TID; i < 4096 + 16384; i += NBLK * 512) {
        if (i < 4096) { const int a = i >> 6, b = i & 63; float s, c; sincospi_f((float)((a * b) & 63) * (2.0f / 64.0f), &s, &c); tab[i] = f2bf(c); tab[4096 + i] = f2bf(s); }
        else { const int j = i - 4096, a = j >> 7, b = j & 127; float s, c; sincospi_f((float)((a * b) & 127) * (2.0f / 128.0f), &s, &c); tab[8192 + j] = f2bf(c * sc2); tab[8192 + 16384 + j] = f2bf(s * sc2); }
    }
}

DEV void phase1_prep(const Params& P, unsigned char* sm) {
    PHASE_TID;
    bf16_t* Bhi = (bf16_t*)sm; bf16_t* Blo = (bf16_t*)(sm + 33024);
    float* gsv = (float*)(sm + 66048);
    float* gbl = (float*)(sm + 70144);
    {
        f32x4 w[2][4];
#pragma unroll
        for (int h = 0; h < 2; ++h)
#pragma unroll
            for (int q = 0; q < 4; ++q) w[h][q] = *(const f32x4*)(P.w_in + (size_t)(TID + h * 512) * W_IN + 2560 + q * 4);
#pragma unroll
        for (int h = 0; h < 2; ++h)
#pragma unroll
            for (int q = 0; q < 4; ++q)
#pragma unroll
                for (int e = 0; e < 4; ++e) { const int n = q * 4 + e, k = TID + h * 512; const float v = w[h][q][e]; const bf16_t hi = f2bf(v); Bhi[n * 1032 + k] = hi; Blo[n * 1032 + k] = f2bf(v - bf2f(hi)); }
    }
    const float* mod = (const float*)(P.ws + WS_MOD);
    bf16_t* h = (bf16_t*)(P.ws + WS_R4 + R4_H);
    float* gb = (float*)(P.ws + WS_GB);
    float* rstd_arr = (float*)(P.ws + WS_RSTD);
    float* bias = (float*)(P.ws + WS_BIAS);
    const int wid = TID >> 6, lane = TID & 63, fr = lane & 15, fq = lane >> 4;
    SYNC();
    const float* shrow = mod + (fr < 8 ? fr : 8) * 6144 + fq * 8;
    if (TID < 256) gbl[TID] = 0.f;
    SYNC();
    {
        f32x4 acc = (f32x4){0.f, 0.f, 0.f, 0.f};
#pragma unroll
        for (int k4 = 0; k4 < 4; ++k4) {
            const int ks = wid * 4 + k4;
            const f32x4 a0 = *(const f32x4*)(shrow + ks * 32), a1 = *(const f32x4*)(shrow + ks * 32 + 4);
            const float hv[8] = {a0[0], a0[1], a0[2], a0[3], a1[0], a1[1], a1[2], a1[3]};
            u32x4 whi, wlo;
#pragma unroll
            for (int e = 0; e < 4; ++e) { whi[e] = pk2(hv[2 * e], hv[2 * e + 1]); wlo[e] = pk2(hv[2 * e] - __builtin_bit_cast(float, whi[e] << 16), hv[2 * e + 1] - __builtin_bit_cast(float, whi[e] & 0xffff0000u)); }
            const bf16x8 ahi = __builtin_bit_cast(bf16x8, whi), alo = __builtin_bit_cast(bf16x8, wlo);
            const bf16x8 bhi = frag16(Bhi + fr * 1032 + ks * 32 + fq * 8), blo = frag16(Blo + fr * 1032 + ks * 32 + fq * 8);
            acc = mfma16(ahi, bhi, acc); acc = mfma16(alo, bhi, acc); acc = mfma16(ahi, blo, acc);
        }
#pragma unroll
        for (int r = 0; r < 4; ++r) atomic_add_f32(&gbl[(fq * 4 + r) * 16 + fr], acc[r]);
    }
    {
        const bf16_t* wq = (const bf16_t*)(P.ws + WS_WQKVZ); const bf16_t* wf = (const bf16_t*)(P.ws + WS_WF);
        for (int it = BID * 8 + wid; it < 192; it += NBLK * 8) {
            const int n0 = it * 16;
            const bf16_t* wrow = (n0 < 2048 ? wq + (size_t)(n0 + fr) * 1024 : wf + (size_t)(n0 - 2048 + fr) * 1024) + fq * 8;
            f32x4 acc = (f32x4){0.f, 0.f, 0.f, 0.f};
#pragma unroll 4
            for (int ks = 0; ks < 32; ++ks) {
                const f32x4 a0 = *(const f32x4*)(shrow + ks * 32), a1 = *(const f32x4*)(shrow + ks * 32 + 4);
                const float hv[8] = {a0[0], a0[1], a0[2], a0[3], a1[0], a1[1], a1[2], a1[3]};
                u32x4 whi, wlo;
#pragma unroll
                for (int e = 0; e < 4; ++e) { whi[e] = pk2(hv[2 * e], hv[2 * e + 1]); wlo[e] = pk2(hv[2 * e] - __builtin_bit_cast(float, whi[e] << 16), hv[2 * e + 1] - __builtin_bit_cast(float, whi[e] & 0xffff0000u)); }
                const bf16x8 bw = frag16(wrow + ks * 32);
                acc = mfma16(__builtin_bit_cast(bf16x8, whi), bw, acc); acc = mfma16(__builtin_bit_cast(bf16x8, wlo), bw, acc);
            }
#pragma unroll
            for (int r = 0; r < 4; ++r) { const int mbr = fq * 4 + r; if (mbr < 9) bias[mbr * 3072 + n0 + fr] = acc[r]; }
        }
    }
    for (int t = BID; t < MROWS / 128; t += NBLK) {
        const int r0 = t * 128 + wid * 16, mb = (t * 128 < NTOK) ? ((t * 128) >> 13) : 8;
        SYNC();
        { const float* scale = mod + mb * 6144 + 1024;
#pragma unroll
          for (int q = 0; q < 2; ++q) { const int k = TID + q * 512; gsv[k] = P.norm1_g[k] * (1.0f + scale[k]); } }
        SYNC();
        const int rr = r0 + fr;
        const float* src = (rr < NTOK ? P.x + (size_t)rr * D : P.ctx + (size_t)(rr - NTOK) * D) + fq * 8;
        float ss = 0.f;
        f32x4 acc = (f32x4){0.f, 0.f, 0.f, 0.f};
        bf16_t* hrow = h + (size_t)rr * D + fq * 8;
#pragma unroll 8
        for (int ks = 0; ks < 32; ++ks) {
            const f32x4 a0 = *(const f32x4*)(src + ks * 32), a1 = *(const f32x4*)(src + ks * 32 + 4);
            ss += a0[0] * a0[0] + a0[1] * a0[1] + a0[2] * a0[2] + a0[3] * a0[3] + a1[0] * a1[0] + a1[1] * a1[1] + a1[2] * a1[2] + a1[3] * a1[3];
            const f32x4 g0 = *(const f32x4*)(gsv + ks * 32 + fq * 8), g1 = *(const f32x4*)(gsv + ks * 32 + fq * 8 + 4);
            float hv[8];
#pragma unroll
            for (int e = 0; e < 4; ++e) { hv[e] = a0[e] * g0[e]; hv[4 + e] = a1[e] * g1[e]; }
            u32x4 whi, wlo;
#pragma unroll
            for (int e = 0; e < 4; ++e) { whi[e] = pk2(hv[2 * e], hv[2 * e + 1]); wlo[e] = pk2(hv[2 * e] - __builtin_bit_cast(float, whi[e] << 16), hv[2 * e + 1] - __builtin_bit_cast(float, whi[e] & 0xffff0000u)); }
            *(u32x4*)(hrow + ks * 32) = whi;
            const bf16x8 ahi = __builtin_bit_cast(bf16x8, whi), alo = __builtin_bit_cast(bf16x8, wlo);
            const bf16x8 bhi = frag16(Bhi + fr * 1032 + ks * 32 + fq * 8), blo = frag16(Blo + fr * 1032 + ks * 32 + fq * 8);
            acc = mfma16(ahi, bhi, acc); acc = mfma16(alo, bhi, acc); acc = mfma16(ahi, blo, acc);
        }
        ss += shfl_xor_f(ss, 16); ss += shfl_xor_f(ss, 32);
        const float rstd = rsq_f(ss * (1.0f / 1024.0f) + EPS);
        if (fq == 0) rstd_arr[rr] = rstd;
        float ea = 0.f, db = 0.f;
        if (fr >= 8) { ea = -__expf(P.a_log[fr - 8]); db = P.dt_bias[fr - 8]; }
        const float gbias = gbl[mb * 16 + fr];
#pragma unroll
        for (int reg = 0; reg < 4; ++reg) { const float v = acc[reg] * shfl_idx_f(rstd, fq * 4 + reg) + gbias; float o;
            if (fr < 8) o = rcp_f(1.0f + __expf(-v));
            else { const float z = v + db; const float sp = z > 20.f ? z : log1pf(__expf(z)); o = ea * sp; }
            gb[(size_t)(r0 + fq * 4 + reg) * 16 + fr] = o; }
    }
}

#ifndef CPU_EMU
namespace pg8 {
#define PG8_LAS __attribute__((address_space(3)))
constexpr int BM = 256, BK = 64, HALF = 128, HTB = HALF * BK * 2, STAGE_BYTES = 8 * HTB;
__device__ __forceinline__ int lds_byte(int r, int c) { const int st = (r >> 4) * 2 + (c >> 5), rr = r & 15, cc = c & 31, ob = rr * 64 + cc * 2; return st * 1024 + (ob ^ (((ob >> 9) & 1) << 5)); }
__device__ __forceinline__ void stage_rc(int b, int& R, int& C) { const int st = b / 1024, sb = b % 1024, swz = sb ^ (((sb >> 9) & 1) << 5); R = (st >> 1) * 16 + swz / 64; C = (st & 1) * 32 + (swz % 64) / 2; }
__device__ __forceinline__ int perm32(int rho) { const int n = rho >> 4, i = rho & 15; return 8 * (i >> 2) + 4 * n + (i & 3); }
struct Unit { int pm, pn, e, cnt; };
__device__ __forceinline__ unsigned cvt_pk_bf16(float lo, float hi) { unsigned r; asm volatile("v_cvt_pk_bf16_f32 %0, %1, %2" : "=v"(r) : "v"(lo), "v"(hi)); return r; }

template <class Prob, class Epi>
__device__ __forceinline__ void gemm_phase(PG8_LAS unsigned char* lds, const Prob& G, const Epi& E) {
    int tid_ = threadIdx.x; asm volatile("" : "+v"(tid_));
    const int tid = tid_, wid = __builtin_amdgcn_readfirstlane(tid >> 6), lane = tid & 63, wr = wid >> 2, wc = wid & 3, fr = lane & 15, fq = lane >> 4;
    const int K = G.K, nt = K / BK;
    int R0, C0; stage_rc(tid * 16, R0, C0);
    const int rA0 = R0, rA1 = R0 + 64;
    const int rB0 = Epi::PERM ? ((R0 & ~31) + perm32(R0 & 31)) : R0, rB1 = Epi::PERM ? (((R0 + 64) & ~31) + perm32((R0 + 64) & 31)) : R0 + 64;
    const unsigned ldsw = (unsigned)wid * 1024u;
    const int aoff = lds_byte(wr * 64 + fr, fq * 8), boff = lds_byte(wc * 32 + fr, fq * 8);
    const char* Ab = (const char*)G.A; const char* Bb = (const char*)G.Bt;
#define PG8_SA(b, h) (((b) * 2 + (h)) * HTB)
#define PG8_SB(b, h) ((4 + (b) * 2 + (h)) * HTB)
#define PG8_STAGE(bufoff, gbase, ub, l0, l1) do { \
        __builtin_amdgcn_global_load_lds((const unsigned*)((gbase) + (size_t)(ub) + (l0)), (PG8_LAS unsigned*)(lds + (bufoff) + ldsw), 16, 0, 0); \
        __builtin_amdgcn_global_load_lds((const unsigned*)((gbase) + (size_t)(ub) + (l1)), (PG8_LAS unsigned*)(lds + (bufoff) + ldsw + 8192), 16, 0, 0); } while (0)
#define PG8_LDA(dst, b, h) do { _Pragma("unroll") for (int m = 0; m < 4; ++m) _Pragma("unroll") for (int k = 0; k < 2; ++k) dst[m][k] = *(const PG8_LAS bf16x8*)(lds + PG8_SA(b, h) + aoff + m * 2048 + k * 1024); } while (0)
#define PG8_LDB(dst, b, h) do { _Pragma("unroll") for (int n = 0; n < 2; ++n) _Pragma("unroll") for (int k = 0; k < 2; ++k) dst[n][k] = *(const PG8_LAS bf16x8*)(lds + PG8_SB(b, h) + boff + n * 2048 + k * 1024); } while (0)
#define PG8_MMA(ai, bj, At, Bt) do { __builtin_amdgcn_s_setprio(1); _Pragma("unroll") for (int m = 0; m < 4; ++m) _Pragma("unroll") for (int n = 0; n < 2; ++n) _Pragma("unroll") for (int k = 0; k < 2; ++k) \
        acc[ai][bj][m][n] = __builtin_amdgcn_mfma_f32_16x16x32_bf16(Bt[n][k], At[m][k], acc[ai][bj][m][n], 0, 0, 0); __builtin_amdgcn_s_setprio(0); } while (0)
#define PG8_WAIT_V(n) asm volatile("s_waitcnt vmcnt(" #n ")" ::: "memory")
#define PG8_WAIT_L(n) asm volatile("s_waitcnt lgkmcnt(" #n ")" ::: "memory")
#define PG8_BAR __builtin_amdgcn_s_barrier()
#define PG8_SCHED __builtin_amdgcn_sched_barrier(0)
    Unit cur, nxt; int ui = 0;
    if (!G.next(0, cur)) return;
    f32x4 acc[2][2][4][2];
#pragma unroll
    for (int a = 0; a < 2; ++a)
#pragma unroll
        for (int b = 0; b < 2; ++b)
#pragma unroll
            for (int m = 0; m < 4; ++m)
#pragma unroll
                for (int n = 0; n < 2; ++n) acc[a][b][m][n] = (f32x4){0.f, 0.f, 0.f, 0.f};
    bf16x8 At[4][2], B0[2][2], B1[2][2];
    const unsigned cb2 = (unsigned)C0 * 2u;
    const unsigned lB00 = G.laneB(rB0) + cb2, lB01 = G.laneB(rB1) + cb2, lB10 = G.laneB(128 + rB0) + cb2, lB11 = G.laneB(128 + rB1) + cb2;
    const unsigned lA00 = G.laneA(rA0) + cb2, lA01 = G.laneA(rA1) + cb2, lA10 = G.laneA(128 + rA0) + cb2, lA11 = G.laneA(128 + rA1) + cb2;
    unsigned cA00 = lA00, cA01 = lA01, cA10 = lA10, cA11 = lA11, nA00 = lA00, nA01 = lA01, nA10 = lA10, nA11 = lA11;
    if constexpr (Prob::GATHER_A) { cA00 += G.gathA(cur, rA0); cA01 += G.gathA(cur, rA1); cA10 += G.gathA(cur, 128 + rA0); cA11 += G.gathA(cur, 128 + rA1); }
    unsigned uAc = G.baseA(cur), uBc = G.baseB(cur), uAn = uAc, uBn = uBc;
    if constexpr (Epi::PREFETCH) E.prefetch(cur, lds + STAGE_BYTES + 2048, wid, lane);
    PG8_STAGE(PG8_SB(0, 0), Bb, uBc, lB00, lB01); PG8_STAGE(PG8_SA(0, 0), Ab, uAc, cA00, cA01); PG8_STAGE(PG8_SB(0, 1), Bb, uBc, lB10, lB11); PG8_STAGE(PG8_SA(0, 1), Ab, uAc, cA10, cA11);
    if (wr == 1) PG8_BAR;
    PG8_WAIT_V(4); PG8_BAR;
    PG8_STAGE(PG8_SB(1, 0), Bb, uBc + 128u, lB00, lB01); PG8_STAGE(PG8_SA(1, 0), Ab, uAc + 128u, cA00, cA01); PG8_STAGE(PG8_SB(1, 1), Bb, uBc + 128u, lB10, lB11);
    PG8_WAIT_V(6); PG8_BAR;
    for (;;) {
        const bool has_next = G.next(ui + 1, nxt);
        if constexpr (Epi::PREFETCH) { if (has_next) E.prefetch(nxt, lds + STAGE_BYTES + 2048 + ((ui + 1) % 3) * 2048, wid, lane); }
        if (has_next) {
            uAn = G.baseA(nxt); uBn = G.baseB(nxt);
            if constexpr (Prob::GATHER_A) { nA00 = lA00 + G.gathA(nxt, rA0); nA01 = lA01 + G.gathA(nxt, rA1); nA10 = lA10 + G.gathA(nxt, 128 + rA0); nA11 = lA11 + G.gathA(nxt, 128 + rA1); }
        } else { uAn = uAc; uBn = uBc; if constexpr (Prob::GATHER_A) { nA00 = cA00; nA01 = cA01; nA10 = cA10; nA11 = cA11; } }
        for (int t = 0; t < nt; t += 2) {
            const bool last = (t == nt - 2);
            const unsigned k1 = (unsigned)(t + 1) * 128u;
            const unsigned uA2 = last ? uAn : uAc + (unsigned)(t + 2) * 128u, uB2 = last ? uBn : uBc + (unsigned)(t + 2) * 128u, uA3 = uA2 + 128u, uB3 = uB2 + 128u;
            unsigned a00 = cA00, a01 = cA01, a10 = cA10, a11 = cA11;
            if constexpr (Prob::GATHER_A) { a00 = last ? nA00 : cA00; a01 = last ? nA01 : cA01; a10 = last ? nA10 : cA10; a11 = last ? nA11 : cA11; }
            PG8_LDB(B0, 0, 0); PG8_SCHED; PG8_LDA(At, 0, 0); PG8_STAGE(PG8_SA(1, 1), Ab, uAc + k1, cA10, cA11);
            PG8_WAIT_L(8); PG8_BAR; PG8_WAIT_L(0); PG8_MMA(0, 0, At, B0); PG8_BAR; PG8_SCHED;
            PG8_LDB(B1, 0, 1); PG8_STAGE(PG8_SB(0, 0), Bb, uB2, lB00, lB01);
            PG8_BAR; PG8_WAIT_L(0); PG8_MMA(0, 1, At, B1); PG8_BAR;
            PG8_LDA(At, 0, 1); PG8_STAGE(PG8_SA(0, 0), Ab, uA2, a00, a01);
            PG8_BAR; PG8_WAIT_L(0); PG8_MMA(1, 0, At, B0); PG8_BAR; PG8_SCHED;
            PG8_STAGE(PG8_SB(0, 1), Bb, uB2, lB10, lB11);
            PG8_WAIT_V(6); PG8_BAR; PG8_MMA(1, 1, At, B1); PG8_BAR;
            PG8_LDB(B0, 1, 0); PG8_SCHED; PG8_LDA(At, 1, 0); PG8_STAGE(PG8_SA(0, 1), Ab, uA2, a10, a11);
            PG8_WAIT_L(8); PG8_BAR; PG8_WAIT_L(0); PG8_MMA(0, 0, At, B0); PG8_BAR; PG8_SCHED;
            PG8_LDB(B1, 1, 1); PG8_STAGE(PG8_SB(1, 0), Bb, uB3, lB00, lB01);
            PG8_BAR; PG8_WAIT_L(0); PG8_MMA(0, 1, At, B1); PG8_BAR;
            PG8_LDA(At, 1, 1); PG8_STAGE(PG8_SA(1, 0), Ab, uA3, a00, a01);
            PG8_BAR; PG8_WAIT_L(0); PG8_MMA(1, 0, At, B0); PG8_BAR; PG8_SCHED;
            PG8_STAGE(PG8_SB(1, 1), Bb, uB3, lB10, lB11);
            PG8_WAIT_V(6); PG8_BAR; PG8_MMA(1, 1, At, B1); PG8_BAR;
        }
        E(acc, cur, wr, wc, fr, fq, (const PG8_LAS float*)(lds + STAGE_BYTES + 2048 + (ui % 3) * 2048));
        if (!has_next) break;
#pragma unroll
        for (int a = 0; a < 2; ++a)
#pragma unroll
            for (int b = 0; b < 2; ++b)
#pragma unroll
                for (int m = 0; m < 4; ++m)
#pragma unroll
                    for (int n = 0; n < 2; ++n) acc[a][b][m][n] = (f32x4){0.f, 0.f, 0.f, 0.f};
        cur = nxt; ++ui; uAc = uAn; uBc = uBn;
        if constexpr (Prob::GATHER_A) { cA00 = nA00; cA01 = nA01; cA10 = nA10; cA11 = nA11; }
    }
    PG8_WAIT_V(0);
    if (wr == 0) PG8_BAR;
    PG8_BAR;
#undef PG8_SA
#undef PG8_SB
#undef PG8_STAGE
#undef PG8_LDA
#undef PG8_LDB
#undef PG8_MMA
#undef PG8_WAIT_V
#undef PG8_WAIT_L
#undef PG8_BAR
#undef PG8_SCHED
}

struct GridOrder {
    int nM, nN, nwg, G, c;
    __device__ __forceinline__ void init(int nM_, int nN_, int G_, int c_) { nM = nM_; nN = nN_; nwg = nM * nN; G = G_; c = c_; }
    __device__ __forceinline__ bool next(int i, Unit& u) const {
        const long L = (long)i * G + c; if (L >= nwg) return false;
        int wgid = (int)L; { const int q = nwg / 8, r = nwg % 8, xcd = wgid % 8, off = wgid / 8; wgid = (xcd < r ? xcd * (q + 1) : r * (q + 1) + (xcd - r) * q) + off; }
        const int nig = 8 * nN, gid = wgid / nig, fm = gid * 8, gsz = (nM - fm) < 8 ? (nM - fm) : 8;
        u.pm = fm + ((wgid % nig) % gsz); u.pn = (wgid % nig) / gsz; u.e = 0; u.cnt = 256; return true;
    }
};

struct ProbInproj : GridOrder { const bf16_t* A; const bf16_t* Bt; int K; static constexpr bool GATHER_A = false;
    __device__ __forceinline__ unsigned laneA(int r) const { return (unsigned)r * 2048u; }
    __device__ __forceinline__ unsigned laneB(int r) const { return (unsigned)r * 2048u; }
    __device__ __forceinline__ unsigned baseA(const Unit& u) const { return (unsigned)(u.pm * 256) * 2048u; }
    __device__ __forceinline__ unsigned baseB(const Unit& u) const { return (unsigned)(u.pn * 256) * 2048u; }
    __device__ __forceinline__ unsigned gathA(const Unit&, int) const { return 0u; } };
struct ProbGT : GridOrder { const bf16_t* A; const bf16_t* Bt; int K; static constexpr bool GATHER_A = false;
    __device__ __forceinline__ unsigned laneA(int r) const { return (unsigned)r * 2048u; }
    __device__ __forceinline__ unsigned laneB(int r) const { return (unsigned)(128 * (r & 63) + (r >> 6)) * 2048u; }
    __device__ __forceinline__ unsigned baseA(const Unit& u) const { return (unsigned)(u.pm * 256) * 2048u; }
    __device__ __forceinline__ unsigned baseB(const Unit& u) const { const int col = u.pn * 256, b = col >> 13, w = col & 8191; return (unsigned)(b * 8192 + (w >> 6)) * 2048u; }
    __device__ __forceinline__ unsigned gathA(const Unit&, int) const { return 0u; } };
struct EpiStoreBf16 {
    static constexpr bool PERM = true, PREFETCH = false; bf16_t* O; int ldc;
    __device__ __forceinline__ void operator()(const f32x4 (&acc)[2][2][4][2], const Unit& u, int wr, int wc, int fr, int fq, const PG8_LAS float* ex) const {
        const int row0 = u.pm * 256 + wr * 64 + fr, col0 = u.pn * 256 + wc * 32 + 8 * fq;
#pragma unroll
        for (int ai = 0; ai < 2; ++ai)
#pragma unroll
            for (int m = 0; m < 4; ++m) { bf16_t* rowp = O + (size_t)(row0 + ai * 128 + m * 16) * ldc + col0;
#pragma unroll
                for (int bj = 0; bj < 2; ++bj) { const f32x4 v0 = acc[ai][bj][m][0], v1 = acc[ai][bj][m][1];
                    u32x4 w; w.x = cvt_pk_bf16(v0[0], v0[1]); w.y = cvt_pk_bf16(v0[2], v0[3]); w.z = cvt_pk_bf16(v1[0], v1[1]); w.w = cvt_pk_bf16(v1[2], v1[3]);
                    *(u32x4*)(rowp + bj * 128) = w; } }
    }
};
struct EpiGT {
    static constexpr bool PERM = true, PREFETCH = true; bf16_t* O; const float* rstd; const float* bias;
    __device__ __forceinline__ void prefetch(const Unit& u, PG8_LAS unsigned char* ex, int wid, int lane) const {
        const int mb = (u.pn * 256) >> 13;
        if (wid == 0) __builtin_amdgcn_global_load_lds((const unsigned*)(bias + mb * 3072 + 2048 + u.pm * 256 + lane * 4), (PG8_LAS unsigned*)(ex + 1024), 16, 0, 0);
        else if (wid <= 4) { const int c = u.pn * 256 + (wid - 1) * 64 + lane, w = c & 8191;
            __builtin_amdgcn_global_load_lds((const unsigned*)(rstd + mb * 8192 + 128 * (w & 63) + (w >> 6)), (PG8_LAS unsigned*)(ex + (wid - 1) * 256), 4, 0, 0); }
    }
    __device__ __forceinline__ void operator()(const f32x4 (&acc)[2][2][4][2], const Unit& u, int wr, int wc, int fr, int fq, const PG8_LAS float* ex) const {
        const int row0 = u.pm * 256 + wr * 64 + fr, col0 = u.pn * 256 + wc * 32 + 8 * fq;
        float rs[2][8];
#pragma unroll
        for (int bj = 0; bj < 2; ++bj) { const f32x4 r0_ = *(const PG8_LAS f32x4*)(ex + bj * 128 + wc * 32 + 8 * fq), r1_ = *(const PG8_LAS f32x4*)(ex + bj * 128 + wc * 32 + 8 * fq + 4);
            rs[bj][0] = r0_[0]; rs[bj][1] = r0_[1]; rs[bj][2] = r0_[2]; rs[bj][3] = r0_[3]; rs[bj][4] = r1_[0]; rs[bj][5] = r1_[1]; rs[bj][6] = r1_[2]; rs[bj][7] = r1_[3]; }
#pragma unroll
        for (int ai = 0; ai < 2; ++ai)
#pragma unroll
            for (int m = 0; m < 4; ++m) { const int row = row0 + ai * 128 + m * 16; const float bg = ex[256 + wr * 64 + fr + ai * 128 + m * 16]; bf16_t* rowp = O + (size_t)row * NTOK + col0;
#pragma unroll
                for (int bj = 0; bj < 2; ++bj) { const f32x4 a0 = acc[ai][bj][m][0], a1 = acc[ai][bj][m][1];
                    u32x4 w; w.x = cvt_pk_bf16(a0[0] * rs[bj][0] + bg, a0[1] * rs[bj][1] + bg); w.y = cvt_pk_bf16(a0[2] * rs[bj][2] + bg, a0[3] * rs[bj][3] + bg);
                    w.z = cvt_pk_bf16(a1[0] * rs[bj][4] + bg, a1[1] * rs[bj][5] + bg); w.w = cvt_pk_bf16(a1[2] * rs[bj][6] + bg, a1[3] * rs[bj][7] + bg);
                    *(u32x4*)(rowp + bj * 128) = w; } }
    }
};
struct EpiInproj {
    static constexpr bool PERM = true, PREFETCH = true; bf16_t* O; bf16_t* zs; const float* rstd; const float* bias;
    __device__ __forceinline__ void prefetch(const Unit& u, PG8_LAS unsigned char* ex, int wid, int lane) const {
        if (wid == 0) __builtin_amdgcn_global_load_lds((const unsigned*)(rstd + u.pm * 256 + lane * 4), (PG8_LAS unsigned*)ex, 16, 0, 0);
        else if (wid == 1) __builtin_amdgcn_global_load_lds((const unsigned*)(bias + ((u.pm * 256 < NTOK) ? ((u.pm * 256) >> 13) : 8) * 3072 + u.pn * 256 + lane * 4), (PG8_LAS unsigned*)(ex + 1024), 16, 0, 0);
    }
    __device__ __forceinline__ void operator()(const f32x4 (&acc)[2][2][4][2], const Unit& u, int wr, int wc, int fr, int fq, const PG8_LAS float* ex) const {
        const int row0 = u.pm * 256 + wr * 64 + fr, col0 = u.pn * 256 + wc * 32 + 8 * fq;
        const bool isz = u.pn >= 6;
        if (isz && u.pm * 256 >= NTOK) return;
        f32x4 bv[2][2];
#pragma unroll
        for (int bj = 0; bj < 2; ++bj) { bv[bj][0] = *(const PG8_LAS f32x4*)(ex + 256 + bj * 128 + wc * 32 + 8 * fq); bv[bj][1] = *(const PG8_LAS f32x4*)(ex + 256 + bj * 128 + wc * 32 + 8 * fq + 4); }
#pragma unroll
        for (int ai = 0; ai < 2; ++ai)
#pragma unroll
            for (int m = 0; m < 4; ++m) { const size_t row = (size_t)(row0 + ai * 128 + m * 16); const float rs = ex[wr * 64 + fr + ai * 128 + m * 16];
                bf16_t* rowp = isz ? zs + row * 512 + (col0 - 1536) : O + row * 2048 + col0;
#pragma unroll
                for (int bj = 0; bj < 2; ++bj) { f32x4 v0 = acc[ai][bj][m][0] * rs + bv[bj][0], v1 = acc[ai][bj][m][1] * rs + bv[bj][1];
                    if (isz) {
#pragma unroll
                        for (int j = 0; j < 4; ++j) { v0[j] = v0[j] * __builtin_amdgcn_rcpf(1.0f + __expf(-v0[j])); v1[j] = v1[j] * __builtin_amdgcn_rcpf(1.0f + __expf(-v1[j])); } }
                    u32x4 w; w.x = cvt_pk_bf16(v0[0], v0[1]); w.y = cvt_pk_bf16(v0[2], v0[3]); w.z = cvt_pk_bf16(v1[0], v1[1]); w.w = cvt_pk_bf16(v1[2], v1[3]);
                    *(u32x4*)(rowp + bj * 128) = w; } }
    }
};
typedef ProbInproj ProbOut;
struct EpiResid {
    static constexpr bool PERM = false, PREFETCH = false; const float* x; const float* mod; float* out;
    __device__ __forceinline__ void operator()(const f32x4 (&acc)[2][2][4][2], const Unit& u, int wr, int wc, int fr, int fq, const PG8_LAS float* ex) const {
        const int row0 = u.pm * 256 + wr * 64 + fr, col0 = u.pn * 256 + wc * 32 + 4 * fq;
        const float* gate = mod + ((u.pm * 256) >> 13) * 6144 + 2 * 1024;
        f32x4 gv[2][2];
#pragma unroll
        for (int bj = 0; bj < 2; ++bj)
#pragma unroll
            for (int n = 0; n < 2; ++n) gv[bj][n] = *(const f32x4*)(gate + col0 + bj * 128 + n * 16);
#pragma unroll
        for (int ai = 0; ai < 2; ++ai)
#pragma unroll
            for (int m = 0; m < 4; ++m) { const size_t off = (size_t)(row0 + ai * 128 + m * 16) * 1024 + col0;
#pragma unroll
                for (int bj = 0; bj < 2; ++bj)
#pragma unroll
                    for (int n = 0; n < 2; ++n) { const f32x4 xv = *(const f32x4*)(x + off + bj * 128 + n * 16); *(f32x4*)(out + off + bj * 128 + n * 16) = xv + gv[bj][n] * acc[ai][bj][m][n]; } }
    }
};
struct MoeOrder {
    const PG8_LAS int* tb; const PG8_LAS int* cnt; int G, c;
    __device__ __forceinline__ bool next(int i, Unit& u) const {
        const int L = i * G + c, ntile = tb[32]; if (L >= ntile * 4) return false;
        const int tile = L >> 2; u.pn = L & 3; int e = 0;
#pragma unroll
        for (int s = 16; s >= 1; s >>= 1) if (__builtin_amdgcn_readfirstlane(tb[e + s]) <= tile) e += s;
        u.e = e; u.pm = tile; const int loc = (tile - __builtin_amdgcn_readfirstlane(tb[e])) * 256; u.cnt = __builtin_amdgcn_readfirstlane(cnt[e]) - loc; return true;
    }
};
struct ProbMoe1 : MoeOrder { const bf16_t* A; const bf16_t* Bt; int K; const unsigned* tokk; static constexpr bool GATHER_A = true;
    __device__ __forceinline__ unsigned laneA(int) const { return 0u; }
    __device__ __forceinline__ unsigned laneB(int r) const { return (unsigned)r * 2048u; }
    __device__ __forceinline__ unsigned baseA(const Unit&) const { return 0u; }
    __device__ __forceinline__ unsigned baseB(const Unit& u) const { return (unsigned)(u.e * 1024 + u.pn * 256) * 2048u; }
    __device__ __forceinline__ unsigned gathA(const Unit& u, int r) const { const int loc = (u.pm - __builtin_amdgcn_readfirstlane(tb[u.e])) * 256 + r; const unsigned tk = r < u.cnt ? tokk[(size_t)u.e * LCAP + loc] : 0u; return (tk >> 1) * 2048u; } };
struct EpiMoe1 {
    static constexpr bool PERM = true, PREFETCH = false; bf16_t* hid;
    __device__ __forceinline__ void operator()(const f32x4 (&acc)[2][2][4][2], const Unit& u, int wr, int wc, int fr, int fq, const PG8_LAS float* ex) const {
        const int row0 = u.pm * 256 + wr * 64 + fr, col0 = u.pn * 128 + wc * 32 + 8 * fq;
#pragma unroll
        for (int ai = 0; ai < 2; ++ai)
#pragma unroll
            for (int m = 0; m < 4; ++m) { float hv[8];
#pragma unroll
                for (int n = 0; n < 2; ++n)
#pragma unroll
                    for (int j = 0; j < 4; ++j) { const float g = acc[ai][0][m][n][j], up = acc[ai][1][m][n][j]; hv[n * 4 + j] = g * __builtin_amdgcn_rcpf(1.0f + __expf(-g)) * up; }
                u32x4 w; w.x = cvt_pk_bf16(hv[0], hv[1]); w.y = cvt_pk_bf16(hv[2], hv[3]); w.z = cvt_pk_bf16(hv[4], hv[5]); w.w = cvt_pk_bf16(hv[6], hv[7]);
                *(u32x4*)(hid + (size_t)(row0 + ai * 128 + m * 16) * 512 + col0) = w; }
    }
};
struct ProbMoe2 : MoeOrder { const bf16_t* A; const bf16_t* Bt; int K; static constexpr bool GATHER_A = false;
    __device__ __forceinline__ unsigned laneA(int r) const { return (unsigned)r * 1024u; }
    __device__ __forceinline__ unsigned laneB(int r) const { return (unsigned)r * 1024u; }
    __device__ __forceinline__ unsigned baseA(const Unit& u) const { return (unsigned)(u.pm * 256) * 1024u; }
    __device__ __forceinline__ unsigned baseB(const Unit& u) const { return (unsigned)(u.e * 1024 + u.pn * 256) * 1024u; }
    __device__ __forceinline__ unsigned gathA(const Unit&, int) const { return 0u; } };
struct EpiMoe2 {
    static constexpr bool PERM = true, PREFETCH = true; bf16_t* Y; const unsigned* tokk; const float* wl; const PG8_LAS int* tb;
    __device__ __forceinline__ void prefetch(const Unit& u, PG8_LAS unsigned char* ex, int wid, int lane) const {
        const size_t o = (size_t)u.e * LCAP + (u.pm - __builtin_amdgcn_readfirstlane(tb[u.e])) * 256 + lane * 4;
        if (wid == 0) __builtin_amdgcn_global_load_lds((const unsigned*)(tokk + o), (PG8_LAS unsigned*)ex, 16, 0, 0);
        else if (wid == 1) __builtin_amdgcn_global_load_lds((const unsigned*)(wl + o), (PG8_LAS unsigned*)(ex + 1024), 16, 0, 0);
    }
    __device__ __forceinline__ void operator()(const f32x4 (&acc)[2][2][4][2], const Unit& u, int wr, int wc, int fr, int fq, const PG8_LAS float* ex) const {
        const int col0 = u.pn * 256 + wc * 32 + 8 * fq;
#pragma unroll
        for (int ai = 0; ai < 2; ++ai)
#pragma unroll
            for (int m = 0; m < 4; ++m) { const int r = ai * 128 + wr * 64 + m * 16 + fr;
                if (r < u.cnt) { const unsigned tk = __builtin_bit_cast(unsigned, ex[r]); const float w = ex[256 + r];
                    bf16_t* rowp = Y + ((size_t)(tk & 1u) * NTOK + (tk >> 1)) * 1024 + col0;
#pragma unroll
                    for (int bj = 0; bj < 2; ++bj) { const f32x4 v0 = acc[ai][bj][m][0] * w, v1 = acc[ai][bj][m][1] * w;
                        u32x4 q; q.x = cvt_pk_bf16(v0[0], v0[1]); q.y = cvt_pk_bf16(v0[2], v0[3]); q.z = cvt_pk_bf16(v1[0], v1[1]); q.w = cvt_pk_bf16(v1[2], v1[3]);
                        *(u32x4*)(rowp + bj * 128) = q; } } }
    }
};

typedef int v8i32 __attribute__((ext_vector_type(8)));
typedef int v4i32 __attribute__((ext_vector_type(4)));
constexpr int F8_STAGE = 65536, F8_LDS = 2 * F8_STAGE;
template <class Prob, class Epi>
__device__ __forceinline__ void gemm_f8(PG8_LAS unsigned char* lds, const Prob& G, const Epi& E) {
    int tid_ = threadIdx.x; asm volatile("" : "+v"(tid_));
    const int tid = tid_, wid = __builtin_amdgcn_readfirstlane(tid >> 6), lane = tid & 63, wr = wid >> 2, wc = wid & 3, fr = lane & 15, fq = lane >> 4;
    const int nt = G.KB >> 7;
    int R0, C0; stage_rc(tid * 16, R0, C0);
    const unsigned cb = (unsigned)C0 * 2u, ldsw = (unsigned)wid * 1024u;
    const int aoff = lds_byte(wr * 64 + fr, fq * 8), boff = (wc >> 1) * 16384 + lds_byte((wc & 1) * 64 + fr, fq * 8);
    const char* Ab = (const char*)G.A; const char* Bb = (const char*)G.Bt;
    Unit cur, nxt;
    if (!G.next(0, cur)) return;
    const unsigned lB00 = G.laneB(R0) + cb, lB01 = G.laneB(R0 + 64) + cb, lB10 = G.laneB(128 + R0) + cb, lB11 = G.laneB(192 + R0) + cb;
    unsigned cA00 = G.rowA(cur, R0) + cb, cA01 = G.rowA(cur, R0 + 64) + cb, cA10 = G.rowA(cur, 128 + R0) + cb, cA11 = G.rowA(cur, 192 + R0) + cb;
    unsigned nA00 = cA00, nA01 = cA01, nA10 = cA10, nA11 = cA11;
    unsigned uBc = G.baseB(cur), uBn = uBc;
#define F8_ISSUE(buf, a00, a01, a10, a11, ub, kb) do { PG8_LAS unsigned char* sb_ = lds + (buf) * F8_STAGE + ldsw; \
        __builtin_amdgcn_global_load_lds((const unsigned*)(Ab + (size_t)((a00) + (kb))), (PG8_LAS unsigned*)(sb_), 16, 0, 0); \
        __builtin_amdgcn_global_load_lds((const unsigned*)(Ab + (size_t)((a01) + (kb))), (PG8_LAS unsigned*)(sb_ + 8192), 16, 0, 0); \
        __builtin_amdgcn_global_load_lds((const unsigned*)(Ab + (size_t)((a10) + (kb))), (PG8_LAS unsigned*)(sb_ + 16384), 16, 0, 0); \
        __builtin_amdgcn_global_load_lds((const unsigned*)(Ab + (size_t)((a11) + (kb))), (PG8_LAS unsigned*)(sb_ + 24576), 16, 0, 0); \
        __builtin_amdgcn_global_load_lds((const unsigned*)(Bb + (size_t)(ub) + (size_t)(lB00 + (kb))), (PG8_LAS unsigned*)(sb_ + 32768), 16, 0, 0); \
        __builtin_amdgcn_global_load_lds((const unsigned*)(Bb + (size_t)(ub) + (size_t)(lB01 + (kb))), (PG8_LAS unsigned*)(sb_ + 40960), 16, 0, 0); \
        __builtin_amdgcn_global_load_lds((const unsigned*)(Bb + (size_t)(ub) + (size_t)(lB10 + (kb))), (PG8_LAS unsigned*)(sb_ + 49152), 16, 0, 0); \
        __builtin_amdgcn_global_load_lds((const unsigned*)(Bb + (size_t)(ub) + (size_t)(lB11 + (kb))), (PG8_LAS unsigned*)(sb_ + 57344), 16, 0, 0); } while (0)
    f32x4 acc[2][4][4];
#pragma unroll
    for (int a = 0; a < 2; ++a)
#pragma unroll
        for (int m = 0; m < 4; ++m)
#pragma unroll
            for (int n = 0; n < 4; ++n) acc[a][m][n] = (f32x4){0.f, 0.f, 0.f, 0.f};
    F8_ISSUE(0, cA00, cA01, cA10, cA11, uBc, 0u);
    int g = 0, ui = 0;
    for (;;) {
        const bool has_next = G.next(ui + 1, nxt);
        if (has_next) { nA00 = G.rowA(nxt, R0) + cb; nA01 = G.rowA(nxt, R0 + 64) + cb; nA10 = G.rowA(nxt, 128 + R0) + cb; nA11 = G.rowA(nxt, 192 + R0) + cb; uBn = G.baseB(nxt); }
        else { nA00 = cA00; nA01 = cA01; nA10 = cA10; nA11 = cA11; uBn = uBc; }
#pragma unroll 1
        for (int kt = 0; kt < nt; ++kt) {
            asm volatile("s_waitcnt vmcnt(0)" ::: "memory");
            __builtin_amdgcn_s_barrier();
            asm volatile("" ::: "memory");
            {
                const bool wrap = kt + 1 >= nt; const unsigned kb = wrap ? 0u : (unsigned)(kt + 1) * 128u;
                const unsigned a00 = wrap ? nA00 : cA00, a01 = wrap ? nA01 : cA01, a10 = wrap ? nA10 : cA10, a11 = wrap ? nA11 : cA11, ub = wrap ? uBn : uBc;
                F8_ISSUE((g + 1) & 1, a00, a01, a10, a11, ub, kb);
            }
            PG8_LAS unsigned char* st = lds + (g & 1) * F8_STAGE;
            v8i32 B8[4];
#pragma unroll
            for (int n = 0; n < 4; ++n) { const v4i32 lo = *(const PG8_LAS v4i32*)(st + 32768 + boff + n * 2048), hi = *(const PG8_LAS v4i32*)(st + 32768 + boff + n * 2048 + 1024);
                B8[n] = __builtin_shufflevector(lo, hi, 0, 1, 2, 3, 4, 5, 6, 7); }
#pragma unroll
            for (int ai = 0; ai < 2; ++ai) {
                v8i32 A8[4];
#pragma unroll
                for (int m = 0; m < 4; ++m) { const v4i32 lo = *(const PG8_LAS v4i32*)(st + ai * 16384 + aoff + m * 2048), hi = *(const PG8_LAS v4i32*)(st + ai * 16384 + aoff + m * 2048 + 1024);
                    A8[m] = __builtin_shufflevector(lo, hi, 0, 1, 2, 3, 4, 5, 6, 7); }
                asm volatile("s_waitcnt lgkmcnt(0)" ::: "memory");
                __builtin_amdgcn_s_setprio(1);
#pragma unroll
                for (int m = 0; m < 4; ++m)
#pragma unroll
                    for (int n = 0; n < 4; ++n) acc[ai][m][n] = __builtin_amdgcn_mfma_scale_f32_16x16x128_f8f6f4(B8[n], A8[m], acc[ai][m][n], 0, 0, 0, 0, 0, 0);
                __builtin_amdgcn_s_setprio(0);
            }
            ++g;
        }
        E(acc, cur, wr, wc, fr, fq);
        if (!has_next) break;
#pragma unroll
        for (int a = 0; a < 2; ++a)
#pragma unroll
            for (int m = 0; m < 4; ++m)
#pragma unroll
                for (int n = 0; n < 4; ++n) acc[a][m][n] = (f32x4){0.f, 0.f, 0.f, 0.f};
        cur = nxt; ++ui; cA00 = nA00; cA01 = nA01; cA10 = nA10; cA11 = nA11; uBc = uBn;
    }
    asm volatile("s_waitcnt vmcnt(0)" ::: "memory");
    __builtin_amdgcn_s_barrier();
#undef F8_ISSUE
}
struct MoeOrder8 {
    const PG8_LAS int* tb; const PG8_LAS int* cnt; int G, c;
    __device__ __forceinline__ bool next(int i, Unit& u) const {
        const int ntile = __builtin_amdgcn_readfirstlane(tb[32]), xj = c >> 3, tile = i * (G >> 2) + (c & 7) * (G >> 5) + (xj >> 2); if (tile >= ntile) return false;
        u.pn = xj & 3; int e = 0;
#pragma unroll
        for (int s = 16; s >= 1; s >>= 1) if (__builtin_amdgcn_readfirstlane(tb[e + s]) <= tile) e += s;
        u.e = e; u.pm = tile; const int loc = (tile - __builtin_amdgcn_readfirstlane(tb[e])) * 256; u.cnt = __builtin_amdgcn_readfirstlane(cnt[e]) - loc; return true;
    }
};
struct ProbMoe1F8 : MoeOrder8 { const unsigned char* A; const unsigned char* Bt; int KB; const unsigned* tokk;
    __device__ __forceinline__ unsigned laneB(int r) const { return (unsigned)r * 1024u; }
    __device__ __forceinline__ unsigned baseB(const Unit& u) const { return (unsigned)((u.e * 4 + u.pn) * 256) * 1024u; }
    __device__ __forceinline__ unsigned rowA(const Unit& u, int r) const { const int loc = (u.pm - __builtin_amdgcn_readfirstlane(tb[u.e])) * 256 + r; const unsigned tk = r < u.cnt ? tokk[(size_t)u.e * LCAP + loc] : 0u; return (tk >> 1) * 1024u; } };
struct EpiMoe1F8 {
    unsigned char* hid;
    __device__ __forceinline__ void operator()(const f32x4 (&acc)[2][4][4], const Unit& u, int wr, int wc, int fr, int fq) const {
        const int row0 = u.pm * 256 + wr * 64 + fr, col0 = u.pn * 128 + wc * 32 + fq * 4;
#pragma unroll
        for (int ai = 0; ai < 2; ++ai)
#pragma unroll
            for (int m = 0; m < 4; ++m)
#pragma unroll
                for (int n2 = 0; n2 < 2; ++n2) { float hv[4];
#pragma unroll
                    for (int j = 0; j < 4; ++j) { const float g = acc[ai][m][n2][j] * 0.03125f, up = acc[ai][m][2 + n2][j] * 0.03125f; hv[j] = g * __builtin_amdgcn_rcpf(1.0f + __expf(-g)) * up; }
                    *(unsigned*)(hid + (size_t)(row0 + ai * 128 + m * 16) * 512 + col0 + n2 * 16) = pk4_fp8(hv[0], hv[1], hv[2], hv[3]); }
    }
};
struct ProbMoe2F8 : MoeOrder8 { const unsigned char* A; const unsigned char* Bt; int KB;
    __device__ __forceinline__ unsigned laneB(int r) const { return (unsigned)r * 512u; }
    __device__ __forceinline__ unsigned baseB(const Unit& u) const { return (unsigned)(u.e * 1024 + u.pn * 256) * 512u; }
    __device__ __forceinline__ unsigned rowA(const Unit& u, int r) const { return (unsigned)(u.pm * 256 + r) * 512u; } };
struct EpiMoe2F8 {
    bf16_t* Y; const unsigned* tokk; const float* wl; const PG8_LAS int* tb;
    __device__ __forceinline__ void operator()(const f32x4 (&acc)[2][4][4], const Unit& u, int wr, int wc, int fr, int fq) const {
        const int col0 = u.pn * 256 + wc * 64 + 4 * fq, locb = (u.pm - __builtin_amdgcn_readfirstlane(tb[u.e])) * 256;
#pragma unroll
        for (int ai = 0; ai < 2; ++ai)
#pragma unroll
            for (int m = 0; m < 4; ++m) { const int r = ai * 128 + wr * 64 + m * 16 + fr;
                if (r < u.cnt) { const unsigned tk = tokk[(size_t)u.e * LCAP + locb + r]; const float w = wl[(size_t)u.e * LCAP + locb + r] * 0.03125f;
                    bf16_t* rowp = Y + ((size_t)(tk & 1u) * NTOK + (tk >> 1)) * 1024 + col0;
#pragma unroll
                    for (int n = 0; n < 4; ++n) { const f32x4 v = acc[ai][m][n] * w; u32x2 q; q[0] = cvt_pk_bf16(v[0], v[1]); q[1] = cvt_pk_bf16(v[2], v[3]); *(u32x2*)(rowp + n * 16) = q; } } }
    }
};
}
#endif

DEV void conv_row_compute(const Params& P, const bf16_t* ring, const float* wts, int s0, int s1, int s2, int ntap_rows, int slab, bf16_t* dst, int tid) {
    const int cq = tid & 31, tg = tid >> 5;
    typedef float f32x2 __attribute__((ext_vector_type(2)));
    f32x2 acc2[4][2];
#pragma unroll
    for (int t = 0; t < 4; ++t) { acc2[t][0] = (f32x2){0.f, 0.f}; acc2[t][1] = (f32x2){0.f, 0.f}; }
#pragma unroll
    for (int ky = 0; ky < 3; ++ky) {
        if (ntap_rows == 1 && ky != 1) continue;
        const int sl = ky == 0 ? s0 : ky == 1 ? s1 : s2;
        f32x2 w[3][2];
#pragma unroll
        for (int kx = 0; kx < 3; ++kx) { const f32x4 t = *(const f32x4*)(wts + (ky * 3 + kx) * 128 + cq * 4); w[kx][0] = (f32x2){t[0], t[1]}; w[kx][1] = (f32x2){t[2], t[3]}; }
        f32x2 in[6][2];
#pragma unroll
        for (int pos = 0; pos < 6; ++pos) { const u32x2 v = *(const u32x2*)(ring + sl * 8448 + (tg * 4 + pos) * 128 + cq * 4);
            in[pos][0] = (f32x2){__builtin_bit_cast(float, v[0] << 16), __builtin_bit_cast(float, v[0] & 0xffff0000u)}; in[pos][1] = (f32x2){__builtin_bit_cast(float, v[1] << 16), __builtin_bit_cast(float, v[1] & 0xffff0000u)}; }
#pragma unroll
        for (int t = 0; t < 4; ++t)
#pragma unroll
            for (int kx = 0; kx < 3; ++kx) { acc2[t][0] += w[kx][0] * in[t + kx][0]; acc2[t][1] += w[kx][1] * in[t + kx][1]; }
    }
    float acc[4][4];
#pragma unroll
    for (int t = 0; t < 4; ++t) { acc[t][0] = acc2[t][0][0]; acc[t][1] = acc2[t][0][1]; acc[t][2] = acc2[t][1][0]; acc[t][3] = acc2[t][1][1]; }
#pragma unroll
    for (int t = 0; t < 4; ++t) {
        float ss = 0.f;
#pragma unroll
        for (int c = 0; c < 4; ++c) { acc[t][c] = silu_f(acc[t][c]); ss += acc[t][c] * acc[t][c]; }
        if (slab < 8) { ss += shfl_xor_f(ss, 1); ss += shfl_xor_f(ss, 2); ss += shfl_xor_f(ss, 4); ss += shfl_xor_f(ss, 8); ss += shfl_xor_f(ss, 16); const float sc = rsq_f(ss + EPS);
#pragma unroll
            for (int c = 0; c < 4; ++c) acc[t][c] *= sc; }
        u32x2 o; o[0] = pk2(acc[t][0], acc[t][1]); o[1] = pk2(acc[t][2], acc[t][3]);
        *(u32x2*)(dst + (size_t)(tg * 4 + t) * 1536 + cq * 4) = o;
    }
}

DEV void phase3_conv(const Params& P, unsigned char* sm) {
    PHASE_TID;
    const bf16_t* p = (const bf16_t*)(P.ws + WS_R4 + R4_P);
    bf16_t* qkvn = (bf16_t*)(P.ws + WS_R3);
    bf16_t* ring = (bf16_t*)sm;
    float* wts = (float*)(sm + 3 * 16896);
    const u32x4 zero4 = (u32x4){0u, 0u, 0u, 0u};
    for (int it = BID; it < NB * 12 * 8; it += NBLK) {
        const int slab = it % 12, yb = (it / 12) & 7, b = it / 96, y0 = yb * 16;
        const bf16_t* src = p + (size_t)(b * SEQ) * 2048 + slab * 128;
        if (TID < 96) { const int sl = TID / 32, w = TID & 31, cc = (w >> 4) * 65, pc = w & 15; *(u32x4*)(ring + sl * 8448 + cc * 128 + pc * 8) = zero4; }
        if (TID < 288) *(f32x4*)(wts + TID * 4) = *(const f32x4*)(P.conv_w + (size_t)(TID >> 5) * 1536 + slab * 128 + (TID & 31) * 4);
        const int tk0 = TID >> 4, pc = TID & 15;
        u32x4 rr[4][2];
#define CV_LOAD(set, y) do { const bool ok_ = (y) >= 0 && (y) < 128; const int yc_ = ok_ ? (y) : y0;        \
            const u32x4 t0_ = *(const u32x4*)(src + (size_t)(yc_ * 64 + tk0) * 2048 + pc * 8), t1_ = *(const u32x4*)(src + (size_t)(yc_ * 64 + tk0 + 32) * 2048 + pc * 8); \
            rr[set][0] = ok_ ? t0_ : zero4; rr[set][1] = ok_ ? t1_ : zero4; } while (0)
#define CV_STORE(set, slot) do { *(u32x4*)(ring + (slot) * 8448 + (tk0 + 1) * 128 + pc * 8) = rr[set][0]; *(u32x4*)(ring + (slot) * 8448 + (tk0 + 33) * 128 + pc * 8) = rr[set][1]; } while (0)
        CV_LOAD(0, y0 - 1); CV_LOAD(1, y0); CV_LOAD(2, y0 + 1); CV_LOAD(3, y0 + 2);
        CV_STORE(0, 0); CV_STORE(1, 1);
        CV_LOAD(0, y0 + 3);
#pragma unroll 1
        for (int y4 = 0; y4 < 16; y4 += 4) {
#pragma unroll
            for (int u = 0; u < 4; ++u) {
                const int yy = y4 + u;
                const int s0 = yy % 3, s1 = (yy + 1) % 3, s2 = (yy + 2) % 3;
                CV_STORE((u + 2) & 3, s2);
                SYNC();
                CV_LOAD((u + 1) & 3, (yy + 4 <= 16) ? y0 + yy + 4 : 999);
                conv_row_compute(P, ring, wts, s0, s1, s2, 3, slab, qkvn + (size_t)(b * SEQ + (y0 + yy) * 64) * 1536 + slab * 128, TID);
                SYNC();
            }
        }
#undef CV_LOAD
#undef CV_STORE
    }
    for (int it = BID; it < NB * 12 * 4; it += NBLK) {
        const int slab = it % 12, sg = (it / 12) & 3, b = it / 48;
        const bf16_t* src = p + (size_t)(NTOK + b * CTX) * 2048 + slab * 128;
        if (TID < 288) *(f32x4*)(wts + TID * 4) = *(const f32x4*)(P.conv_w + (size_t)(TID >> 5) * 1536 + slab * 128 + (TID & 31) * 4);
        u32x4 r[3];
#pragma unroll
        for (int q = 0; q < 3; ++q) { const int idx = TID + q * 512; r[q] = zero4;
            if (idx < 66 * 16) { const int cc = idx >> 4, pc = idx & 15, tok = sg * 64 + cc - 1; if (tok >= 0 && tok < CTX) r[q] = *(const u32x4*)(src + (size_t)tok * 2048 + pc * 8); } }
#pragma unroll
        for (int q = 0; q < 3; ++q) { const int idx = TID + q * 512; if (idx < 66 * 16) { const int cc = idx >> 4, pc = idx & 15; *(u32x4*)(ring + 1 * 8448 + cc * 128 + pc * 8) = r[q]; } }
        SYNC();
        conv_row_compute(P, ring, wts, 0, 1, 2, 1, slab, qkvn + (size_t)(NTOK + b * CTX + sg * 64) * 1536 + slab * 128, TID);
        SYNC();
    }
}

constexpr int L_K = 0, L_Q = 17408, L_V = 34816, L_KTR = 52224, L_VT = 70656, L_X0F = 89088, L_X0TF = 98304, L_TTF = 107520, L_X0B = 116736, L_X0TB = 125952, L_TTB = 135168, L_GC = 144384, L_SCAL = 161824;
constexpr int L_X1F = 0, L_X1TF = 9216, L_X1B = 18432, L_X1TB = 27648, L_WF = 0, L_WB = 17408, L_AF = 145440, L_AB = 153632;

DEV int chunk_row(int chain, int step, int i) {
    const int b = chain >> 3, dir = chain & 1;
    if (step < 4) { const int pos = step * 64 + i; return NTOK + b * CTX + (dir ? (CTX - 1 - pos) : pos); }
    const int pos = (step - 4) * 64 + i; return b * SEQ + (dir ? (SEQ - 1 - pos) : pos);
}

DEV int img_piece_A(int row, int col0) { return (((row >> 4) * 2 + (col0 >> 5)) * 64 + ((col0 & 31) >> 3) * 16 + (row & 15)) * 16 + ((col0 >> 2) & 1) * 8; }
DEV int img_piece_W(int row, int d0) { return (((row >> 4) * 4 + (d0 >> 5)) * 64 + ((d0 & 31) >> 3) * 16 + (row & 15)) * 16; }

DEV void phase4_prepass(const Params& P, unsigned char* sm) {
    PHASE_TID;
    const bf16_t* qkvn = (const bf16_t*)(P.ws + WS_R3);
    const float* gb = (const float*)(P.ws + WS_GB);
    unsigned char* images = P.ws + WS_R4;
    bf16_t* Ks = (bf16_t*)(sm + L_K); bf16_t* Qs = (bf16_t*)(sm + L_Q); bf16_t* Vs = (bf16_t*)(sm + L_V); bf16_t* KTR = (bf16_t*)(sm + L_KTR); bf16_t* VT = (bf16_t*)(sm + L_VT);
    float* gcf = (float*)(sm + L_GC); float* gcb = gcf + 64; float* btf = gcf + 128; float* btb = gcf + 192;
    const float QSCALE = 0.08838834764831845f;
    const f32x4 z4 = (f32x4){0.f, 0.f, 0.f, 0.f};
    u32x4 pf[6]; float gfp, bfp, gbp, bbp, gbr;
#define PP_ROW0(it_) ((((it_) % NSTEP) < 4) ? NTOK + ((it_) / NSTEP / 4) * CTX + ((it_) % NSTEP) * 64 : ((it_) / NSTEP / 4) * SEQ + (((it_) % NSTEP) - 4) * 64)
#define PP_LOAD(it_) do { const int row0_ = PP_ROW0(it_), h_ = ((it_) / NSTEP) & 3; \
        _Pragma("unroll") for (int q = 0; q < 6; ++q) { const int idx = TID + q * 512, piece = idx & 15, i = (idx >> 4) & 63, which = idx >> 10; \
            pf[q] = *(const u32x4*)(qkvn + (size_t)(row0_ + i) * 1536 + which * 512 + h_ * 128 + piece * 8); } \
        { const int ln_ = TID & 63; const float* gr = gb + (size_t)(row0_ + ln_) * 16; gfp = gr[8 + h_]; bfp = gr[h_]; gbp = gr[12 + h_]; bbp = gr[4 + h_]; gbr = gb[(size_t)(row0_ + 63 - ln_) * 16 + 12 + h_]; } } while (0)
    const int NIT = NB * 4 * NSTEP;
    int it = BID;
    if (it < NIT) PP_LOAD(it);
    for (; it < NIT; it += NBLK) {
        int tq_ = TID;
#ifndef CPU_EMU
        asm volatile("" : "+v"(tq_));
#endif
        const int wid = tq_ >> 6, lane = tq_ & 63, fr = lane & 15, fq = lane >> 4;
        const int bh = it / NSTEP, st = it - bh * NSTEP;
        const int stb = st < 4 ? 3 - st : 4 + (127 - (st - 4));
        unsigned char* imgf = images + ((size_t)(bh * 2) * NSTEP + st) * IMG_BYTES;
        unsigned char* imgb = images + ((size_t)(bh * 2 + 1) * NSTEP + stb) * IMG_BYTES;
#pragma unroll
        for (int q = 0; q < 6; ++q) { const int idx = TID + q * 512, piece = idx & 15, i = (idx >> 4) & 63, which = idx >> 10;
            *(u32x4*)((which == 0 ? Qs : which == 1 ? Ks : Vs) + i * 136 + piece * 8) = pf[q]; }
        if (wid == 0) { float g = gfp;
#pragma unroll
            for (int o = 1; o < 64; o <<= 1) { const float t = shfl_up_f(g, o); if (lane >= o) g += t; }
            gcf[lane] = g; btf[lane] = bfp; }
        if (wid == 1) { float g = gbr;
#pragma unroll
            for (int o = 1; o < 64; o <<= 1) { const float t = shfl_up_f(g, o); if (lane >= o) g += t; }
            gcb[63 - lane] = g; btb[lane] = bbp; }
        { const int nx = (it + NBLK < NIT) ? it + NBLK : it; PP_LOAD(nx); }
        SYNC();
        const float glf = gcf[63], glb = gcb[0];
        bf16_t* X0F = (bf16_t*)(sm + L_X0F); bf16_t* X0TF = (bf16_t*)(sm + L_X0TF); bf16_t* TTF = (bf16_t*)(sm + L_TTF);
        bf16_t* X0B = (bf16_t*)(sm + L_X0B); bf16_t* X0TB = (bf16_t*)(sm + L_X0TB); bf16_t* TTB = (bf16_t*)(sm + L_TTB);
        f32x4 TregF[2], TTregF[2], TregB[2], TTregB[2];
#pragma unroll
        for (int tt = 0; tt < 2; ++tt) {
            const int t = wid * 2 + tt, ti = t >> 2, tj = t & 3;
            f32x4 kk = z4, kkT = z4, qkT = z4;
#pragma unroll
            for (int ks = 0; ks < 4; ++ks) {
                const bf16x8 fKi = frag16(Ks + (ti * 16 + fr) * 136 + ks * 32 + fq * 8), fKj = frag16(Ks + (tj * 16 + fr) * 136 + ks * 32 + fq * 8), fQi = frag16(Qs + (ti * 16 + fr) * 136 + ks * 32 + fq * 8);
                kk = mfma16(fKi, fKj, kk); kkT = mfma16(fKj, fKi, kkT); qkT = mfma16(fKj, fQi, qkT);
            }
            {
              const int j = tj * 16 + fr; const float gfj = gcf[j], gbj = gcb[j]; float mf[4], mb_[4];
#pragma unroll
              for (int r = 0; r < 4; ++r) { const int i = ti * 16 + fq * 4 + r;
                  const float ef = __expf(fminf(gcf[i] - gfj, 0.f)) * btf[i] * kk[r], eb = __expf(fminf(gcb[i] - gbj, 0.f)) * btb[i] * kk[r];
                  mf[r] = (i > j) ? ef : 0.f; TregF[tt][r] = (i == j ? 1.0f : 0.0f) - mf[r];
                  mb_[r] = (i < j) ? eb : 0.f; TregB[tt][r] = (i == j ? 1.0f : 0.0f) - mb_[r]; }
              u32x2 w; const int o_ = j * 72 + ti * 16 + fq * 4;
              w[0] = pk2(mf[0], mf[1]); w[1] = pk2(mf[2], mf[3]); *(u32x2*)(X0TF + o_) = w;
              w[0] = pk2(TregF[tt][0], TregF[tt][1]); w[1] = pk2(TregF[tt][2], TregF[tt][3]); *(u32x2*)(TTF + o_) = w;
              w[0] = pk2(mb_[0], mb_[1]); w[1] = pk2(mb_[2], mb_[3]); *(u32x2*)(X0TB + o_) = w;
              w[0] = pk2(TregB[tt][0], TregB[tt][1]); w[1] = pk2(TregB[tt][2], TregB[tt][3]); *(u32x2*)(TTB + o_) = w; }
            SCHED_FENCE();
            {
              const int i = ti * 16 + fr, j0 = tj * 16 + fq * 4; const float gfi = gcf[i], gbi = gcb[i], bfi = btf[i], bbi = btb[i]; float mf[4], af[4], mb_[4], ab[4];
#pragma unroll
              for (int r = 0; r < 4; ++r) { const int j = j0 + r;
                  const float ef = __expf(fminf(gfi - gcf[j], 0.f)), eb = __expf(fminf(gbi - gcb[j], 0.f));
                  const float df = (i >= j) ? ef : 0.f, db = (i <= j) ? eb : 0.f;
                  mf[r] = (i > j) ? bfi * kkT[r] * ef : 0.f; TTregF[tt][r] = (i == j ? 1.0f : 0.0f) - mf[r]; af[r] = qkT[r] * QSCALE * df;
                  mb_[r] = (i < j) ? bbi * kkT[r] * eb : 0.f; TTregB[tt][r] = (i == j ? 1.0f : 0.0f) - mb_[r]; ab[r] = qkT[r] * QSCALE * db; }
              u32x2 w; const int o_ = i * 72 + j0;
              w[0] = pk2(mf[0], mf[1]); w[1] = pk2(mf[2], mf[3]); *(u32x2*)(X0F + o_) = w;
              w[0] = pk2(mb_[0], mb_[1]); w[1] = pk2(mb_[2], mb_[3]); *(u32x2*)(X0B + o_) = w;
              w[0] = pk2(af[0], af[1]); w[1] = pk2(af[2], af[3]); *(u32x2*)((bf16_t*)(sm + L_AF) + i * 64 + j0) = w;
              w[0] = pk2(ab[3], ab[2]); w[1] = pk2(ab[1], ab[0]); *(u32x2*)((bf16_t*)(sm + L_AB) + (63 - i) * 64 + 60 - j0) = w; }
            SCHED_FENCE();
        }
        if (TID < 64) { float* sf = (float*)(sm + L_SCAL), *sb = (float*)(sm + L_SCAL + 288);
            sf[4 + TID] = QSCALE * __expf(gcf[TID]); sb[4 + TID] = QSCALE * __expf(gcb[63 - TID]); }
        {
            const int dcol = wid * 16 + fr, ks = wid >> 1;
            bf16x8 idf;
#pragma unroll
            for (int j = 0; j < 8; ++j) idf[j] = (dcol == ks * 32 + fq * 8 + j) ? (short)0x3F80 : (short)0;
#pragma unroll
            for (int t4 = 0; t4 < 4; ++t4) {
                const f32x4 kt = mfma16(frag16(Ks + (t4 * 16 + fr) * 136 + ks * 32 + fq * 8), idf, z4);
                const f32x4 vt = mfma16(frag16(Vs + (t4 * 16 + fr) * 136 + ks * 32 + fq * 8), idf, z4);
                const int tok = t4 * 16 + fq * 4;
                u32x2 w; w[0] = pk2(kt[0], kt[1]); w[1] = pk2(kt[2], kt[3]); *(u32x2*)(KTR + dcol * 72 + tok) = w;
                w[0] = pk2(vt[0], vt[1]); w[1] = pk2(vt[2], vt[3]); *(u32x2*)(VT + dcol * 72 + tok) = w;
                SCHED_FENCE();
            }
        }
        SYNC();
#pragma unroll 1
        for (int s5 = 0; s5 < 5; ++s5) {
            const bf16_t* PcF = (bf16_t*)(sm + ((s5 & 1) ? L_X1F : L_X0F)); const bf16_t* PcTF = (bf16_t*)(sm + ((s5 & 1) ? L_X1TF : L_X0TF));
            bf16_t* PnF = (bf16_t*)(sm + ((s5 & 1) ? L_X0F : L_X1F)); bf16_t* PnTF = (bf16_t*)(sm + ((s5 & 1) ? L_X0TF : L_X1TF));
            const bf16_t* PcB = (bf16_t*)(sm + ((s5 & 1) ? L_X1B : L_X0B)); const bf16_t* PcTB = (bf16_t*)(sm + ((s5 & 1) ? L_X1TB : L_X0TB));
            bf16_t* PnB = (bf16_t*)(sm + ((s5 & 1) ? L_X0B : L_X1B)); bf16_t* PnTB = (bf16_t*)(sm + ((s5 & 1) ? L_X0TB : L_X1TB));
#pragma unroll
            for (int tt = 0; tt < 2; ++tt) {
                const int t = wid * 2 + tt, ti = t >> 2, tj = t & 3;
                f32x4 p2 = z4, p2T = z4, q2 = z4, q2T = z4;
#pragma unroll
                for (int ks = 0; ks < 2; ++ks) { const int oa = (ti * 16 + fr) * 72 + ks * 32 + fq * 8, ob = (tj * 16 + fr) * 72 + ks * 32 + fq * 8;
                    const bf16x8 a = frag16(PcF + oa), b = frag16(PcTF + ob), c = frag16(PcB + oa), d = frag16(PcTB + ob);
                    p2 = mfma16(a, b, p2); p2T = mfma16(b, a, p2T); q2 = mfma16(c, d, q2); q2T = mfma16(d, c, q2T); }
                u32x2 w; const int oT = (tj * 16 + fr) * 72 + ti * 16 + fq * 4, oN = (ti * 16 + fr) * 72 + tj * 16 + fq * 4;
                w[0] = pk2(p2[0], p2[1]); w[1] = pk2(p2[2], p2[3]); *(u32x2*)(PnTF + oT) = w;
                w[0] = pk2(p2T[0], p2T[1]); w[1] = pk2(p2T[2], p2T[3]); *(u32x2*)(PnF + oN) = w;
                w[0] = pk2(q2[0], q2[1]); w[1] = pk2(q2[2], q2[3]); *(u32x2*)(PnTB + oT) = w;
                w[0] = pk2(q2T[0], q2T[1]); w[1] = pk2(q2T[2], q2T[3]); *(u32x2*)(PnB + oN) = w;
            }
            SYNC();
#pragma unroll
            for (int tt = 0; tt < 2; ++tt) {
                const int t = wid * 2 + tt, ti = t >> 2, tj = t & 3;
#pragma unroll
                for (int ks = 0; ks < 2; ++ks) { const int oa = (ti * 16 + fr) * 72 + ks * 32 + fq * 8, ob = (tj * 16 + fr) * 72 + ks * 32 + fq * 8;
                    const bf16x8 a = frag16(PnF + oa), b = frag16(TTF + ob), c = frag16(PnB + oa), d = frag16(TTB + ob);
                    TregF[tt] = mfma16(a, b, TregF[tt]); TTregF[tt] = mfma16(b, a, TTregF[tt]); TregB[tt] = mfma16(c, d, TregB[tt]); TTregB[tt] = mfma16(d, c, TTregB[tt]); }
            }
            SYNC();
            if (s5 < 4) {
#pragma unroll
                for (int tt = 0; tt < 2; ++tt) { const int t = wid * 2 + tt, ti = t >> 2, tj = t & 3, oT = (tj * 16 + fr) * 72 + ti * 16 + fq * 4;
                    u32x2 w; w[0] = pk2(TregF[tt][0], TregF[tt][1]); w[1] = pk2(TregF[tt][2], TregF[tt][3]); *(u32x2*)(TTF + oT) = w;
                    w[0] = pk2(TregB[tt][0], TregB[tt][1]); w[1] = pk2(TregB[tt][2], TregB[tt][3]); *(u32x2*)(TTB + oT) = w; }
            }
        }
#pragma unroll
        for (int tt = 0; tt < 2; ++tt) {
            const int t = wid * 2 + tt, ti = t >> 2, tj = t & 3, i = ti * 16 + fr, j0 = tj * 16 + fq * 4;
            const f32x4 bq = *(const f32x4*)(btf + j0), gq = *(const f32x4*)(gcf + j0), cq = *(const f32x4*)(btb + j0), hq = *(const f32x4*)(gcb + j0);
            float tu[4], tw[4], su[4], sw[4];
#pragma unroll
            for (int r = 0; r < 4; ++r) { tu[r] = TTregF[tt][r] * bq[r]; tw[r] = tu[r] * __expf(gq[r]); su[r] = TTregB[tt][r] * cq[r]; sw[r] = su[r] * __expf(hq[r]); }
            u32x2 w; const int o_ = i * 72 + j0;
            w[0] = pk2(tu[0], tu[1]); w[1] = pk2(tu[2], tu[3]); *(u32x2*)(X0F + o_) = w;
            w[0] = pk2(tw[0], tw[1]); w[1] = pk2(tw[2], tw[3]); *(u32x2*)(X0TF + o_) = w;
            w[0] = pk2(su[0], su[1]); w[1] = pk2(su[2], su[3]); *(u32x2*)(X0B + o_) = w;
            w[0] = pk2(sw[0], sw[1]); w[1] = pk2(sw[2], sw[3]); *(u32x2*)(X0TB + o_) = w;
        }
        if (TID == 0) { float* scp = (float*)(sm + L_SCAL); scp[0] = __expf(glf); scp[1] = 0.f; scp[2] = 0.f; scp[3] = 0.f; scp[72] = __expf(glb); scp[73] = 0.f; scp[74] = 0.f; scp[75] = 0.f; }
        SYNC();
        bf16_t* WF = (bf16_t*)(sm + L_WF); bf16_t* WB = (bf16_t*)(sm + L_WB);
#pragma unroll
        for (int i4 = 0; i4 < 4; ++i4) {
            f32x4 uf = z4, wf = z4, ub = z4, wb = z4;
#pragma unroll
            for (int ks = 0; ks < 2; ++ks) {
                const bf16x8 av = frag16(VT + (wid * 16 + fr) * 72 + ks * 32 + fq * 8), ak = frag16(KTR + (wid * 16 + fr) * 72 + ks * 32 + fq * 8);
                const int ot = (i4 * 16 + fr) * 72 + ks * 32 + fq * 8;
                uf = mfma16(frag16(X0F + ot), av, uf); wf = mfma16(ak, frag16(X0TF + ot), wf); ub = mfma16(frag16(X0B + ot), av, ub); wb = mfma16(ak, frag16(X0TB + ot), wb);
            }
            u32x2 w; w[0] = pk2(uf[0], uf[1]); w[1] = pk2(uf[2], uf[3]); *(u32x2*)(imgf + IMG_U + ((wid * 4 + i4) * 64 + lane) * 8) = w;
            w[0] = pk2(ub[3], ub[2]); w[1] = pk2(ub[1], ub[0]); *(u32x2*)(imgb + IMG_U + ((wid * 4 + (3 - i4)) * 64 + (3 - fq) * 16 + fr) * 8) = w;
            const int i = i4 * 16 + fr, c = wid * 16 + fq * 4;
            w[0] = pk2(wf[0], wf[1]); w[1] = pk2(wf[2], wf[3]); *(u32x2*)(WF + i * 136 + c) = w;
            w[0] = pk2(wb[0], wb[1]); w[1] = pk2(wb[2], wb[3]); *(u32x2*)(WB + (63 - i) * 136 + c) = w;
        }
        SYNC();
#pragma unroll
        for (int q = 0; q < 5; ++q) { int pc = TID + q * 512; pc = pc < 2082 ? pc : 2081;
            const int sp = pc - 2048, dirb = pc >= 2048 ? (sp >= 17) : (pc >> 10), p = pc & 1023, mt = p >> 8, ks = (p >> 6) & 3, ln = p & 63;
            const int so = pc >= 2048 ? L_SCAL + dirb * 288 + (sp - dirb * 17) * 16 : (dirb ? L_WB : L_WF) + ((mt * 16 + (ln & 15)) * 136 + ks * 32 + (ln >> 4) * 8) * 2;
            const int dofs = pc >= 2048 ? IMG_SC + (sp - dirb * 17) * 16 : IMG_W + p * 16;
            *(u32x4*)((dirb ? imgb : imgf) + dofs) = *(const u32x4*)(sm + so); }
#pragma unroll
        for (int q = 0; q < 2; ++q) { const int p = TID + q * 512, d = (p >> 7) * 16 + (p & 15), p0 = ((p >> 6) & 1) * 32 + ((p >> 4) & 3) * 8;
            { const u32x4 v = *(const u32x4*)(KTR + d * 72 + p0); const f32x4 g0 = *(const f32x4*)(gcf + p0), g1 = *(const f32x4*)(gcf + p0 + 4); u32x4 o;
              o[0] = pk2(__builtin_bit_cast(float, v[0] << 16) * __expf(glf - g0[0]), __builtin_bit_cast(float, v[0] & 0xffff0000u) * __expf(glf - g0[1]));
              o[1] = pk2(__builtin_bit_cast(float, v[1] << 16) * __expf(glf - g0[2]), __builtin_bit_cast(float, v[1] & 0xffff0000u) * __expf(glf - g0[3]));
              o[2] = pk2(__builtin_bit_cast(float, v[2] << 16) * __expf(glf - g1[0]), __builtin_bit_cast(float, v[2] & 0xffff0000u) * __expf(glf - g1[1]));
              o[3] = pk2(__builtin_bit_cast(float, v[3] << 16) * __expf(glf - g1[2]), __builtin_bit_cast(float, v[3] & 0xffff0000u) * __expf(glf - g1[3]));
              *(u32x4*)(imgf + IMG_KT + p * 16) = o; }
            { const int t0 = 56 - p0;
              const u32x4 v = *(const u32x4*)(KTR + d * 72 + t0); const f32x4 g0 = *(const f32x4*)(gcb + t0), g1 = *(const f32x4*)(gcb + t0 + 4); u32x4 o;
              o[0] = pk2(__builtin_bit_cast(float, v[3] & 0xffff0000u) * __expf(glb - g1[3]), __builtin_bit_cast(float, v[3] << 16) * __expf(glb - g1[2]));
              o[1] = pk2(__builtin_bit_cast(float, v[2] & 0xffff0000u) * __expf(glb - g1[1]), __builtin_bit_cast(float, v[2] << 16) * __expf(glb - g1[0]));
              o[2] = pk2(__builtin_bit_cast(float, v[1] & 0xffff0000u) * __expf(glb - g0[3]), __builtin_bit_cast(float, v[1] << 16) * __expf(glb - g0[2]));
              o[3] = pk2(__builtin_bit_cast(float, v[0] & 0xffff0000u) * __expf(glb - g0[1]), __builtin_bit_cast(float, v[0] << 16) * __expf(glb - g0[0]));
              *(u32x4*)(imgb + IMG_KT + p * 16) = o; } }
        { const int p = TID, row = (p >> 7) * 16 + (p & 15), c0 = ((p >> 6) & 1) * 32 + ((p >> 4) & 3) * 8;
          *(u32x4*)(imgf + IMG_A + p * 16) = *(const u32x4*)((const bf16_t*)(sm + L_AF) + row * 64 + c0);
          *(u32x4*)(imgb + IMG_A + p * 16) = *(const u32x4*)((const bf16_t*)(sm + L_AB) + row * 64 + c0); }
        SYNC();
    }
#undef PP_LOAD
#undef PP_ROW0
}

DEV void phase4_fft(const Params& P, unsigned char* sm) {
    PHASE_TID;
    const bf16_t* GT = (const bf16_t*)((const unsigned char*)P.out + DO_GT);
    bf16_t* ZT = (bf16_t*)((unsigned char*)P.out + DO_ZT);
    const bf16_t* tab = (const bf16_t*)(P.ws + WS_TAB);
    bf16_t* YR = (bf16_t*)sm; bf16_t* YI = YR + 64 * 136;
    const int wid = TID >> 6, lane = TID & 63, fr = lane & 15, fq = lane >> 4;
    bf16x8 c64[4][2], s64[4][2], c128[4], s128[4];
#pragma unroll
    for (int nt = 0; nt < 4; ++nt)
#pragma unroll
        for (int ks = 0; ks < 2; ++ks) { c64[nt][ks] = frag16(tab + (nt * 16 + fr) * 64 + ks * 32 + fq * 8); s64[nt][ks] = frag16(tab + 4096 + (nt * 16 + fr) * 64 + ks * 32 + fq * 8); }
#pragma unroll
    for (int ks = 0; ks < 4; ++ks) { c128[ks] = frag16(tab + 8192 + (wid * 16 + fr) * 128 + ks * 32 + fq * 8); s128[ks] = frag16(tab + 8192 + 16384 + (wid * 16 + fr) * 128 + ks * 32 + fq * 8); }
    for (int it = BID; it < 512 * NB; it += NBLK) {
        const int cp = it >> 3, b = it & 7;
        const bf16_t* gr = GT + (size_t)cp * NTOK + b * SEQ; const bf16_t* gi = GT + (size_t)(512 + cp) * NTOK + b * SEQ;
        bf16x8 ar[2], ai[2], an[2];
#pragma unroll
        for (int ks = 0; ks < 2; ++ks) { ar[ks] = frag16(gr + (wid * 16 + fr) * 64 + ks * 32 + fq * 8); ai[ks] = frag16(gi + (wid * 16 + fr) * 64 + ks * 32 + fq * 8);
#pragma unroll
            for (int j = 0; j < 8; ++j) an[ks][j] = (short)(ar[ks][j] ^ (short)0x8000); }
#pragma unroll
        for (int nt = 0; nt < 4; ++nt) {
            f32x4 yr = (f32x4){0.f, 0.f, 0.f, 0.f}, yi = (f32x4){0.f, 0.f, 0.f, 0.f};
#pragma unroll
            for (int ks = 0; ks < 2; ++ks) { yr = mfma16(ar[ks], c64[nt][ks], yr); yr = mfma16(ai[ks], s64[nt][ks], yr); yi = mfma16(ai[ks], c64[nt][ks], yi); yi = mfma16(an[ks], s64[nt][ks], yi); }
            const int k1 = nt * 16 + fr; float orr[4], oii[4];
#pragma unroll
            for (int r = 0; r < 4; ++r) { const int n2 = wid * 16 + fq * 4 + r; float s, c; sincospi_f((float)(n2 * k1) * (2.0f / 8192.0f), &s, &c);
                orr[r] = yr[r] * c + yi[r] * s; oii[r] = yi[r] * c - yr[r] * s; }
            u32x2 w; w[0] = pk2(orr[0], orr[1]); w[1] = pk2(orr[2], orr[3]); *(u32x2*)(YR + k1 * 136 + wid * 16 + fq * 4) = w;
            w[0] = pk2(oii[0], oii[1]); w[1] = pk2(oii[2], oii[3]); *(u32x2*)(YI + k1 * 136 + wid * 16 + fq * 4) = w;
        }
        SYNC();
        bf16_t* zrow = ZT + (size_t)cp * NTOK + b * SEQ;
#pragma unroll
        for (int mt = 0; mt < 4; ++mt) {
            f32x4 z = (f32x4){0.f, 0.f, 0.f, 0.f};
#pragma unroll
            for (int ks = 0; ks < 4; ++ks) { z = mfma16(frag16(YR + (mt * 16 + fr) * 136 + ks * 32 + fq * 8), c128[ks], z); z = mfma16(frag16(YI + (mt * 16 + fr) * 136 + ks * 32 + fq * 8), s128[ks], z); }
            u32x2 w; w[0] = pk2(z[0], z[1]); w[1] = pk2(z[2], z[3]);
            *(u32x2*)(zrow + 64 * (wid * 16 + fr) + mt * 16 + fq * 4) = w;
        }
        SYNC();
    }
}

constexpr int SC_W = 0, SC_U = 17408, SC_KT = 22528, SC_Q = SC_KT + 18432, SC_A = SC_Q + 17408, SC_ST = SC_A + 9216, SC_VN = SC_ST + 2 * 8704, SC_END = SC_VN + 4608;

DEV void phase5_scan(const Params& P, unsigned char* sm) {
    PHASE_TID;
    const unsigned char* images = P.ws + WS_R4;
    bf16_t* obuf = (bf16_t*)(P.ws + WS_R4 + R4_OBUF);
    const int wid = TID >> 6, lane = TID & 63, fr = lane & 15, fq = lane >> 4;
    bf16_t* ST = (bf16_t*)sm; bf16_t* VN = (bf16_t*)(sm + 2 * 8704);
    for (int item = BID; item < NCHAIN * 4; item += NBLK) {
        const int xj = item >> 3, chain = (item & 7) * 8 + (xj >> 2), c0 = (xj & 3) * 32, b = chain >> 3, hh = (chain >> 1) & 3, dir = chain & 1;
        const unsigned char* blk0 = images + (size_t)chain * NSTEP * IMG_BYTES;
        const int oK = IMG_KT + (wid * 2 * 64 + lane) * 16;
        f32x4 Sacc[2];
        Sacc[0] = (f32x4){0.f, 0.f, 0.f, 0.f}; Sacc[1] = (f32x4){0.f, 0.f, 0.f, 0.f};
        for (int q = TID; q < 2 * 8704 / 4; q += 512) ((unsigned*)ST)[q] = 0u;
#define SC_SUPD(rkset) do { _Pragma("unroll") for (int tt = 0; tt < 2; ++tt) { f32x4 a = Sacc[tt] * dl; \
            _Pragma("unroll") for (int ks = 0; ks < 2; ++ks) a = mfma16(__builtin_bit_cast(bf16x8, rkset[ks]), frag16(VN + (tt * 16 + fr) * 72 + ks * 32 + fq * 8), a); \
            Sacc[tt] = a; u32x2 w_; w_[0] = pk2(a[0], a[1]); w_[1] = pk2(a[2], a[3]); *(u32x2*)(STn + (tt * 16 + fr) * 136 + wid * 16 + fq * 4) = w_; } } while (0)
        if (wid < 4) {
            const int mt = wid;
            const int oW = IMG_W + (mt * 4 * 64 + lane) * 16, oA = IMG_A + (mt * 2 * 64 + lane) * 16, oS = IMG_SC + 16 + (mt * 16 + fq * 4) * 4;
            const bf16_t* qbase = (const bf16_t*)(P.ws + WS_R3) + hh * 128 + fq * 8;
            const int oU = IMG_U + (((c0 >> 4) * 4 + mt) * 64 + lane) * 8;
            u32x4 rw[3][4], rk[3][2], rq[3][4], ra[3][2]; u32x2 ru[3][2]; f32x4 rs[3]; float dlr[3];
#define SC_LOAD1(set, blk) do { \
            _Pragma("unroll") for (int ks = 0; ks < 4; ++ks) rw[set][ks] = *(const u32x4*)((blk) + oW + ks * 1024); \
            ru[set][0] = *(const u32x2*)((blk) + oU); ru[set][1] = *(const u32x2*)((blk) + oU + 2048); dlr[set] = *(const float*)((blk) + IMG_SC); } while (0)
#define SC_LOAD2(set, blk, stp) do { const bf16_t* qrow_ = qbase + (size_t)chunk_row(chain, (stp), mt * 16 + fr) * 1536; \
            _Pragma("unroll") for (int ks = 0; ks < 2; ++ks) rk[set][ks] = *(const u32x4*)((blk) + oK + ks * 1024); \
            _Pragma("unroll") for (int ks = 0; ks < 4; ++ks) rq[set][ks] = *(const u32x4*)(qrow_ + ks * 32); \
            rs[set] = *(const f32x4*)((blk) + oS); \
            _Pragma("unroll") for (int ks = 0; ks < 2; ++ks) ra[set][ks] = *(const u32x4*)((blk) + oA + ks * 1024); } while (0)
#define SC_LOAD(set, blk, stp) do { SC_LOAD1(set, blk); SC_LOAD2(set, blk, stp); } while (0)
            SC_LOAD(0, blk0, 0); SC_LOAD(1, blk0 + IMG_BYTES, 1); SC_LOAD(2, blk0 + 2 * IMG_BYTES, 2);
            SYNC();
#pragma unroll 1
            for (int s3 = 0; s3 < NSTEP; s3 += 3) {
#pragma unroll
                for (int u = 0; u < 3; ++u) {
                    const int step = s3 + u, cur = step & 1;
                    const bf16_t* STc = ST + cur * 4352; bf16_t* STn = ST + (cur ^ 1) * 4352;
#pragma unroll
                    for (int nt = 0; nt < 2; ++nt) {
                        f32x4 vn = (f32x4){0.f, 0.f, 0.f, 0.f};
#pragma unroll
                        for (int ks = 0; ks < 4; ++ks) vn = mfma16(__builtin_bit_cast(bf16x8, rw[u][ks]), frag16(STc + (nt * 16 + fr) * 136 + ks * 32 + fq * 8), vn);
                        const unsigned u0 = ru[u][nt][0], u1 = ru[u][nt][1];
                        u32x2 w; w[0] = pk2(bf2f((bf16_t)(u0 & 0xffffu)) - vn[0], bf2f((bf16_t)(u0 >> 16)) - vn[1]); w[1] = pk2(bf2f((bf16_t)(u1 & 0xffffu)) - vn[2], bf2f((bf16_t)(u1 >> 16)) - vn[3]);
                        *(u32x2*)(VN + (nt * 16 + fr) * 72 + mt * 16 + fq * 4) = w;
                    }
                    const float dl = dlr[u];
                    const int stp3 = step + 3 < NSTEP ? step + 3 : NSTEP - 1;
                    const unsigned char* blk3 = blk0 + (size_t)stp3 * IMG_BYTES;
                    SC_LOAD1(u, blk3);
                    SYNC();
                    SC_SUPD(rk[u]);
                    if (step >= 4) {
#pragma unroll
                        for (int nt = 0; nt < 2; ++nt) {
                            f32x4 o1 = (f32x4){0.f, 0.f, 0.f, 0.f}, o = (f32x4){0.f, 0.f, 0.f, 0.f};
#pragma unroll
                            for (int ks = 0; ks < 4; ++ks) o1 = mfma16(__builtin_bit_cast(bf16x8, rq[u][ks]), frag16(STc + (nt * 16 + fr) * 136 + ks * 32 + fq * 8), o1);
#pragma unroll
                            for (int ks = 0; ks < 2; ++ks) o = mfma16(__builtin_bit_cast(bf16x8, ra[u][ks]), frag16(VN + (nt * 16 + fr) * 72 + ks * 32 + fq * 8), o);
                            o += o1 * rs[u];
#pragma unroll
                            for (int r = 0; r < 4; ++r) { const int pos = (step - 4) * 64 + mt * 16 + fq * 4 + r; const int tok = b * SEQ + (dir ? (SEQ - 1 - pos) : pos);
                                obuf[((size_t)dir * NTOK + tok) * 512 + hh * 128 + c0 + nt * 16 + fr] = f2bf(o[r]); }
                        }
                    }
                    SC_LOAD2(u, blk3, stp3);
                    SYNC();
                }
            }
#undef SC_LOAD
#undef SC_LOAD1
#undef SC_LOAD2
        } else {
            u32x4 rk[3][2]; float dlr[3];
#define SC_LOADK(set, blk) do { dlr[set] = *(const float*)((blk) + IMG_SC); _Pragma("unroll") for (int ks = 0; ks < 2; ++ks) rk[set][ks] = *(const u32x4*)((blk) + oK + ks * 1024); } while (0)
            SC_LOADK(0, blk0); SC_LOADK(1, blk0 + IMG_BYTES); SC_LOADK(2, blk0 + 2 * IMG_BYTES);
            SYNC();
#pragma unroll 1
            for (int s3 = 0; s3 < NSTEP; s3 += 3) {
#pragma unroll
                for (int u = 0; u < 3; ++u) {
                    const int step = s3 + u, cur = step & 1;
                    bf16_t* STn = ST + (cur ^ 1) * 4352;
                    const float dl = dlr[u];
                    SYNC();
                    SC_SUPD(rk[u]);
                    { const unsigned char* blk3 = blk0 + (size_t)(step + 3 < NSTEP ? step + 3 : NSTEP - 1) * IMG_BYTES; SC_LOADK(u, blk3); }
                    SYNC();
                }
            }
#undef SC_LOADK
        }
#undef SC_SUPD
        SYNC();
    }
}

DEV void phase6_amix(const Params& P, unsigned char* sm) {
    PHASE_TID;
    const bf16_t* ZT = (const bf16_t*)((const unsigned char*)P.out + DO_ZT);
    const bf16_t* zs = (const bf16_t*)((const unsigned char*)P.out + DO_ZS);
    const bf16_t* obuf = (const bf16_t*)(P.ws + WS_R4 + R4_OBUF);
    bf16_t* amix = (bf16_t*)(P.ws + WS_R4 + R4_AMIX);
    unsigned* tile = (unsigned*)sm;
    for (int tt = BID; tt < NTOK / 64; tt += NBLK) {
        const int tok0 = tt * 64;
        { u32x4 r[8];
#pragma unroll
          for (int q = 0; q < 8; ++q) { const int idx = TID + q * 512, cp = idx >> 3, piece = idx & 7; r[q] = *(const u32x4*)(ZT + (size_t)cp * NTOK + tok0 + piece * 8); }
#pragma unroll
          for (int q = 0; q < 8; ++q) { const int idx = TID + q * 512, cp = idx >> 3, piece = idx & 7; unsigned* t = tile + cp * 33 + piece * 4; t[0] = r[q][0]; t[1] = r[q][1]; t[2] = r[q][2]; t[3] = r[q][3]; } }
        SYNC();
        u32x4 oa[8], ob[8], oz[8];
#pragma unroll
        for (int q = 0; q < 8; ++q) { const int idx = TID + q * 512, tok = idx >> 6, hh = (idx >> 4) & 3, l16 = idx & 15; const size_t off = (size_t)(tok0 + tok) * 512 + hh * 128 + l16 * 8;
            oa[q] = *(const u32x4*)(obuf + off); ob[q] = *(const u32x4*)(obuf + (size_t)NTOK * 512 + off); oz[q] = *(const u32x4*)(zs + off); }
#pragma unroll
        for (int q = 0; q < 8; ++q) { const int tok = TID & 63, c8 = ((TID >> 6) * 8 + q) * 8, sh = (tok & 1) * 16; u32x4 o;
#pragma unroll
            for (int j = 0; j < 4; ++j) o[j] = ((tile[(c8 + 2 * j) * 33 + (tok >> 1)] >> sh) & 0xffffu) | (((tile[(c8 + 2 * j + 1) * 33 + (tok >> 1)] >> sh) & 0xffffu) << 16);
            *(u32x4*)(amix + (size_t)(tok0 + tok) * 1024 + c8) = o; }
        const int l16 = TID & 15;
        float og[8];
#pragma unroll
        for (int j = 0; j < 8; ++j) og[j] = P.onorm_g[l16 * 8 + j];
#pragma unroll
        for (int q = 0; q < 8; ++q) {
            const int idx = TID + q * 512, tok = idx >> 6, hh = (idx >> 4) & 3;
            const u32x4 a = oa[q], bq = ob[q], zv = oz[q];
            float v[8]; float ss = 0.f;
#pragma unroll
            for (int j = 0; j < 4; ++j) { v[2 * j] = bf2f((bf16_t)(a[j] & 0xffffu)) + bf2f((bf16_t)(bq[j] & 0xffffu)); v[2 * j + 1] = bf2f((bf16_t)(a[j] >> 16)) + bf2f((bf16_t)(bq[j] >> 16)); }
#pragma unroll
            for (int j = 0; j < 8; ++j) ss += v[j] * v[j];
            ss += shfl_xor_f(ss, 1); ss += shfl_xor_f(ss, 2); ss += shfl_xor_f(ss, 4); ss += shfl_xor_f(ss, 8);
            const float rstd = rsq_f(ss * (1.0f / 128.0f) + EPS);
            u32x4 o;
#pragma unroll
            for (int j = 0; j < 4; ++j) o[j] = pk2(v[2 * j] * rstd * og[2 * j] * bf2f((bf16_t)(zv[j] & 0xffffu)), v[2 * j + 1] * rstd * og[2 * j + 1] * bf2f((bf16_t)(zv[j] >> 16)));
            *(u32x4*)(amix + (size_t)(tok0 + tok) * 1024 + 512 + hh * 128 + l16 * 8) = o;
        }
        SYNC();
    }
}

DEV void phase8_router(const Params& P, unsigned char* sm, int dry) {
    PHASE_TID;
    float* wr = (float*)sm;
    {
        f32x4 g[2], rt[2][8];
#pragma unroll
        for (int h = 0; h < 2; ++h) { const int k = TID + h * 512; g[h] = *(const f32x4*)(P.w_group + k * 4);
#pragma unroll
            for (int q = 0; q < 8; ++q) rt[h][q] = *(const f32x4*)(P.w_router + k * 32 + q * 4); }
#pragma unroll
        for (int h = 0; h < 2; ++h) { const int k = TID + h * 512;
#pragma unroll
            for (int e = 0; e < 4; ++e) wr[e * 1028 + k] = g[h][e];
#pragma unroll
            for (int q = 0; q < 8; ++q)
#pragma unroll
                for (int e = 0; e < 4; ++e) wr[(4 + q * 4 + e) * 1028 + k] = rt[h][q][e]; }
    }
    SYNC();
    const float* mod = (const float*)(P.ws + WS_MOD);
    const float* x1 = P.out;
    bf16_t* h2 = (bf16_t*)(P.ws + WS_R4 + R4_H2);
    unsigned* cnt = (unsigned*)(P.ws + WS_CNT + (dry ? 8192 : 0)); unsigned* tokk = (unsigned*)(P.ws + (dry ? WS_R3 : WS_TOKK)); float* wl = (float*)(P.ws + (dry ? WS_R3 + 16 * MiB : WS_WL));
    const int wid = TID >> 6, lane = TID & 63;
    const int rstep = NBLK * 8;
    int r = BID * 8 + wid;
    unsigned* lc = (unsigned*)(sm + 148224);
    unsigned* aE = lc + 64; float* aW = (float*)(aE + 512); unsigned* aP = (unsigned*)(aW + 512);
    float* gsv = (float*)(sm + 154624); float* shv = gsv + 1024;
    float* brs = shv + 1024;
    if (TID < 32) { lc[TID] = 0u; brs[TID] = P.b_router[TID]; }
    const float bg0 = P.b_group[0], bg1 = P.b_group[1], bg2 = P.b_group[2], bg3 = P.b_group[3];
    SYNC();
    int jrow = 0;
    f32x4 vr[4][4];
#pragma unroll
    for (int jj = 0; jj < 4; ++jj) { const int rl = (r + jj * rstep < NTOK) ? r + jj * rstep : r;
#pragma unroll
        for (int i = 0; i < 4; ++i) vr[jj][i] = *(const f32x4*)(x1 + (size_t)rl * D + i * 256 + lane * 4); }
    const float n2a = P.norm2_g[TID], n2b = P.norm2_g[TID + 512];
    float msa, msb, mha, mhb;
    { const float* shift = mod + (r >> 13) * 6144 + 3 * 1024; msa = shift[1024 + TID]; msb = shift[1024 + TID + 512]; mha = shift[TID]; mhb = shift[TID + 512]; }
#pragma unroll 1
    for (; r < NTOK; ) {
        SYNC();
        gsv[TID] = n2a * (1.0f + msa); gsv[TID + 512] = n2b * (1.0f + msb); shv[TID] = mha; shv[TID + 512] = mhb;
        { const int rn = (r + 4 * rstep < NTOK) ? r + 4 * rstep : r; const float* shift = mod + (rn >> 13) * 6144 + 3 * 1024; msa = shift[1024 + TID]; msb = shift[1024 + TID + 512]; mha = shift[TID]; mhb = shift[TID + 512]; }
        SYNC();
#pragma unroll
      for (int jj = 0; jj < 4; ++jj) { if (r < NTOK) {
        f32x4 v[4]; float ss = 0.f;
#pragma unroll
        for (int i = 0; i < 4; ++i) { v[i] = vr[jj][i]; ss += v[i][0] * v[i][0] + v[i][1] * v[i][1] + v[i][2] * v[i][2] + v[i][3] * v[i][3]; }
        { const int rl = (r + 4 * rstep < NTOK) ? r + 4 * rstep : r;
#pragma unroll
          for (int i = 0; i < 4; ++i) vr[jj][i] = *(const f32x4*)(x1 + (size_t)rl * D + i * 256 + lane * 4); }
        ss = wave_sum(ss);
        const float rstd = rsq_f(ss * (1.0f / 1024.0f) + EPS);
        float gl[4] = {0.f, 0.f, 0.f, 0.f};
#pragma unroll
        for (int i = 0; i < 4; ++i) {
            const int k = i * 256 + lane * 4;
            const f32x4 g2 = *(const f32x4*)(gsv + k), sh = *(const f32x4*)(shv + k);
#pragma unroll
            for (int e = 0; e < 4; ++e) v[i][e] = v[i][e] * rstd * g2[e] + sh[e];
#pragma unroll
            for (int j = 0; j < 4; ++j) { const f32x4 wv = *(const f32x4*)(wr + j * 1028 + k); gl[j] += v[i][0] * wv[0] + v[i][1] * wv[1] + v[i][2] * wv[2] + v[i][3] * wv[3]; }
#if MK_F8
            *(unsigned*)((unsigned char*)h2 + (size_t)r * D + k) = pk4_fp8(v[i][0], v[i][1], v[i][2], v[i][3]);
#else
            u32x2 w; w[0] = pk2(v[i][0], v[i][1]); w[1] = pk2(v[i][2], v[i][3]);
            *(u32x2*)(h2 + (size_t)r * D + k) = w;
#endif
        }
#pragma unroll
        for (int j = 0; j < 4; ++j) gl[j] += 0.f;
        { const float t = wave_sum_multi<4>(gl, lane);
#pragma unroll
          for (int j = 0; j < 4; ++j) gl[j] = lane_bcast(t, j) + (j == 0 ? bg0 : j == 1 ? bg1 : j == 2 ? bg2 : bg3); }
        int gsel = 0; float gmax = gl[0];
#pragma unroll
        for (int j = 1; j < 4; ++j) if (gl[j] > gmax) { gmax = gl[j]; gsel = j; }
        float gden = 0.f;
#pragma unroll
        for (int j = 0; j < 4; ++j) gden += __expf(gl[j] - gmax);
        const float pg = 1.0f / gden;
        float el[8] = {0.f, 0.f, 0.f, 0.f, 0.f, 0.f, 0.f, 0.f};
#pragma unroll
        for (int i = 0; i < 4; ++i)
#pragma unroll
            for (int j = 0; j < 8; ++j) { const f32x4 wv = *(const f32x4*)(wr + (4 + gsel * 8 + j) * 1028 + i * 256 + lane * 4); el[j] += v[i][0] * wv[0] + v[i][1] * wv[1] + v[i][2] * wv[2] + v[i][3] * wv[3]; }
#pragma unroll
        for (int j = 0; j < 8; ++j) el[j] += 0.f;
        { const float t = wave_sum_multi<8>(el, lane);
#pragma unroll
          for (int j = 0; j < 8; ++j) el[j] = lane_bcast(t, j) + brs[gsel * 8 + j]; }
        int e1 = 0; float m1 = el[0];
#pragma unroll
        for (int j = 1; j < 8; ++j) if (el[j] > m1) { m1 = el[j]; e1 = j; }
        int e2 = -1; float m2 = -3.0e38f;
#pragma unroll
        for (int j = 0; j < 8; ++j) if (j != e1 && el[j] > m2) { m2 = el[j]; e2 = j; }
        if (e2 < 0) e2 = (e1 + 1) & 7;
        const float p2 = __expf(m2 - m1);
        const float w1 = pg / (1.0f + p2), w2 = pg * p2 / (1.0f + p2);
        if (lane < 2) {
            const int ee = gsel * 8 + (lane == 0 ? e1 : e2); const float ww = lane == 0 ? w1 : w2;
            const unsigned pos = atomic_add_u32(&lc[ee], 1u);
            const int a = (jrow * 8 + wid) * 2 + lane;
            if (a < 512) { aE[a] = (unsigned)ee; aW[a] = ww; aP[a] = pos; }
        }
        ++jrow; r += rstep;
      } }
    }
    SYNC();
    if (TID < 32) lc[32 + TID] = atomic_add_u32(&cnt[TID * 64], lc[TID]);
    SYNC();
    { const int a = TID, rl = a >> 1, rr = BID * 8 + (rl & 7) + (rl >> 3) * rstep;
      if (rr < NTOK && (rl >> 3) < jrow) { const unsigned ee = aE[a]; const unsigned pos = lc[32 + ee] + aP[a];
          tokk[(size_t)ee * LCAP + pos] = (unsigned)rr * 2u + (unsigned)(a & 1); wl[(size_t)ee * LCAP + pos] = aW[a]; } }
}

DEV void phase11_final(const Params& P, unsigned char* sm, float* dstbase) {
    PHASE_TID;
    (void)sm;
    const float* mod = (const float*)(P.ws + WS_MOD);
    const bf16_t* Y = (const bf16_t*)(P.ws + WS_R4 + R4_Y);
    const int wid = TID >> 6, lane = TID & 63;
    for (int r0 = (BID * 8 + wid) * 2; r0 < NTOK; r0 += NBLK * 16) {
        f32x4 xv[2][4]; u32x2 y0[2][4], y1[2][4];
#pragma unroll
        for (int u = 0; u < 2; ++u)
#pragma unroll
            for (int i = 0; i < 4; ++i) { const int k = i * 256 + lane * 4; const size_t r = (size_t)(r0 + u);
                xv[u][i] = *(const f32x4*)(P.out + r * D + k); y0[u][i] = *(const u32x2*)(Y + r * D + k); y1[u][i] = *(const u32x2*)(Y + ((size_t)NTOK + r) * D + k); }
        const float* gate = mod + (r0 >> 13) * 6144 + 5 * 1024;
#pragma unroll
        for (int u = 0; u < 2; ++u) {
            float* row = dstbase + (size_t)(r0 + u) * D;
            f32x4 v[4]; float ss = 0.f;
#pragma unroll
            for (int i = 0; i < 4; ++i) { const int k = i * 256 + lane * 4; const f32x4 gv = *(const f32x4*)(gate + k);
                f32x4 m; m[0] = bf2f((bf16_t)(y0[u][i][0] & 0xffffu)) + bf2f((bf16_t)(y1[u][i][0] & 0xffffu)); m[1] = bf2f((bf16_t)(y0[u][i][0] >> 16)) + bf2f((bf16_t)(y1[u][i][0] >> 16));
                m[2] = bf2f((bf16_t)(y0[u][i][1] & 0xffffu)) + bf2f((bf16_t)(y1[u][i][1] & 0xffffu)); m[3] = bf2f((bf16_t)(y0[u][i][1] >> 16)) + bf2f((bf16_t)(y1[u][i][1] >> 16));
                v[i] = xv[u][i] + gv * m; ss += v[i][0] * v[i][0] + v[i][1] * v[i][1] + v[i][2] * v[i][2] + v[i][3] * v[i][3]; }
            ss = wave_sum(ss);
            const float rstd = rsq_f(ss * (1.0f / 1024.0f) + EPS);
#pragma unroll
            for (int i = 0; i < 4; ++i) { const int k = i * 256 + lane * 4; const f32x4 fg = *(const f32x4*)(P.final_g + k); *(f32x4*)(row + k) = v[i] * rstd * fg; }
        }
    }
}

#ifndef CPU_EMU
#define XB_TMO      128
#define XB_XCNT(j)  (256  + 64 * (j))
#define XB_XSUB(j)  (1280 + 64 * (j))
#define XB_XGEN(j)  (2304 + 64 * (j))
#define XB_TOP      3328
#define XB_TOPGEN   3392
#define XCD_BAR_WORDS 3456
#define XB_SPIN_CAP (1u << 22)
#define LAS __attribute__((address_space(3)))
__device__ __forceinline__ unsigned xb_ld(unsigned* p)              { return __hip_atomic_load(p, __ATOMIC_RELAXED, __HIP_MEMORY_SCOPE_AGENT); }
__device__ __forceinline__ unsigned xb_add(unsigned* p, unsigned v) { return __hip_atomic_fetch_add(p, v, __ATOMIC_RELAXED, __HIP_MEMORY_SCOPE_AGENT); }
__device__ __forceinline__ unsigned xb_xcc_id() { return (unsigned)__builtin_amdgcn_s_getreg((3 << 11) | 20) & 0xFu; }
#define XB_SPIN(cond, bar) do { unsigned _sp = 0; while (cond) { __builtin_amdgcn_s_sleep(1); \
    if ((++_sp & 255u) == 0u) { if (xb_ld(&(bar)[XB_TMO])) break; if (_sp > XB_SPIN_CAP) { atomicAdd(&(bar)[XB_TMO], 1u); break; } } } } while (0)
struct XcdBarrier { unsigned* bar; unsigned x; volatile LAS unsigned* st; };
__device__ __forceinline__ XcdBarrier xcd_barrier_post(unsigned* bar, volatile LAS unsigned* st) {
    XcdBarrier b; b.bar = bar; b.x = xb_xcc_id(); b.st = st;
    if (threadIdx.x == 0) (void)xb_add(&bar[XB_XCNT(b.x)], 1u);
    return b;
}
__device__ __forceinline__ void xcd_barrier_complete(unsigned* bar, unsigned x, unsigned& nloc, unsigned& nx) {
    const unsigned G = gridDim.x * gridDim.y * gridDim.z;
    unsigned sum, cnt, mine, sp = 0u;
    for (;;) {
        sum = 0u; cnt = 0u; mine = 0u;
#pragma unroll
        for (unsigned j = 0; j < 16; ++j) { const unsigned c = xb_ld(&bar[XB_XCNT(j)]); sum += c; cnt += (c > 0u) ? 1u : 0u; mine = (j == x) ? c : mine; }
        if (sum == G) break;
        __builtin_amdgcn_s_sleep(1);
        if ((++sp & 255u) == 0u) { if (xb_ld(&bar[XB_TMO])) break; if (sp > XB_SPIN_CAP) { atomicAdd(&bar[XB_TMO], 1u); break; } }
    }
    nloc = mine > 0u ? mine : 1u; nx = cnt > 0u ? cnt : 1u;
}
__device__ __forceinline__ void xcd_barrier(const XcdBarrier& b) {
    asm volatile("s_waitcnt vmcnt(0)" ::: "memory");
    __syncthreads();
    if (threadIdx.x == 0) {
        unsigned* bar = b.bar;
        __builtin_amdgcn_s_waitcnt(0);
        unsigned nloc = b.st[0], nx = b.st[1];
        if (nloc == 0u) { xcd_barrier_complete(bar, b.x, nloc, nx); b.st[0] = nloc; b.st[1] = nx; }
        const unsigned old = xb_add(&bar[XB_XSUB(b.x)], 1u);
        const unsigned gen = old / nloc;
        if (old + 1u == (gen + 1u) * nloc) {
            __builtin_amdgcn_fence(__ATOMIC_RELEASE, "agent");
            asm volatile("s_waitcnt vmcnt(0)" ::: "memory");
            const unsigned og = xb_add(&bar[XB_TOP], 1u);
            const unsigned tg = og / nx;
            if (og + 1u == (tg + 1u) * nx) xb_add(&bar[XB_TOPGEN], 1u);
            else XB_SPIN(xb_ld(&bar[XB_TOPGEN]) == tg, bar);
            __builtin_amdgcn_fence(__ATOMIC_ACQUIRE, "agent");
            xb_add(&bar[XB_XGEN(b.x)], 1u);
            asm volatile("s_waitcnt vmcnt(0)" ::: "memory");
        } else {
            XB_SPIN(xb_ld(&bar[XB_XGEN(b.x)]) == gen, bar);
            __builtin_amdgcn_fence(__ATOMIC_ACQUIRE, "agent");
            asm volatile("s_waitcnt vmcnt(0)" ::: "memory");
        }
    }
    __syncthreads();
}

#ifndef MK_PH
#define MK_PH 0x7ff
#endif
#ifndef MK_REP
#define MK_REP 0
#endif
#define REPS(k) for (int rep_ = 0; rep_ < (((MK_REP >> (k)) & 1) ? 2 : 1); ++rep_)
extern __shared__ __attribute__((aligned(16))) unsigned char smem_dyn[];

__device__ __forceinline__ void moe_tables(const Params& P, LAS int* tb, LAS int* cn) {
    const unsigned* cnt = (const unsigned*)(P.ws + WS_CNT);
    if (threadIdx.x < 32) cn[threadIdx.x] = (int)cnt[threadIdx.x * 64];
    __syncthreads();
    if (threadIdx.x == 0) { int acc = 0; for (int e = 0; e < 32; ++e) { tb[e] = acc; acc += (cn[e] + 255) >> 8; } tb[32] = acc; }
    __syncthreads();
}

__global__ void __launch_bounds__(512, 2) hymba_fwd(Params P) {
    unsigned char* sm = smem_dyn;
    LAS unsigned char* lsm = (LAS unsigned char*)smem_dyn;
    volatile LAS unsigned* xbw = (volatile LAS unsigned*)(lsm + LDS_BYTES - 16);
    if (threadIdx.x == 0) { xbw[0] = 0u; xbw[1] = 0u; xbw[2] = 0u; xbw[3] = 0u; }
    __syncthreads();
    XcdBarrier bar = xcd_barrier_post((unsigned*)(P.ws + WS_BAR), xbw);
    using namespace pg8;

#if (MK_PH >> 0) & 1
    REPS(15) phase0_mod(P, sm); REPS(0) { phase0_weights(P, sm); phase0_wf(P, sm); }
    xcd_barrier(bar);
#endif
#if (MK_PH >> 1) & 1
    REPS(1) phase1_prep(P, sm);
    xcd_barrier(bar);
#endif
#if (MK_PH >> 2) & 1
    REPS(2) {
    { ProbInproj G; G.init(MROWS / 256, 8, gridDim.x, blockIdx.x); G.A = (const bf16_t*)(P.ws + WS_R4 + R4_H); G.Bt = (const bf16_t*)(P.ws + WS_WQKVZ); G.K = 1024;
      EpiInproj E; E.O = (bf16_t*)(P.ws + WS_R4 + R4_P); E.zs = (bf16_t*)((unsigned char*)P.out + DO_ZS); E.rstd = (const float*)(P.ws + WS_RSTD); E.bias = (const float*)(P.ws + WS_BIAS); gemm_phase(lsm, G, E); }
    { ProbGT G; G.init(4, NTOK / 256, gridDim.x, blockIdx.x); G.A = (const bf16_t*)(P.ws + WS_WF); G.Bt = (const bf16_t*)(P.ws + WS_R4 + R4_H); G.K = 1024;
      EpiGT E; E.O = (bf16_t*)((unsigned char*)P.out + DO_GT); E.rstd = (const float*)(P.ws + WS_RSTD); E.bias = (const float*)(P.ws + WS_BIAS); gemm_phase(lsm, G, E); }
    }
    xcd_barrier(bar);
#endif
#if (MK_PH >> 3) & 1
    REPS(3) phase3_conv(P, sm);
    xcd_barrier(bar);
#endif
#if (MK_PH >> 4) & 1
    REPS(4) phase4_prepass(P, sm);
    REPS(11) phase4_fft(P, sm);
    xcd_barrier(bar);
#endif
#if (MK_PH >> 5) & 1
    REPS(5) phase5_scan(P, sm);
    xcd_barrier(bar);
#endif
#if (MK_PH >> 6) & 1
    REPS(6) phase6_amix(P, sm);
    xcd_barrier(bar);
#endif
#if (MK_PH >> 7) & 1
    REPS(7)
    { ProbOut G; G.init(NTOK / 256, 4, gridDim.x, blockIdx.x); G.A = (const bf16_t*)(P.ws + WS_R4 + R4_AMIX); G.Bt = (const bf16_t*)(P.ws + WS_WOUT); G.K = 1024;
      EpiResid E; E.x = P.x; E.mod = (const float*)(P.ws + WS_MOD); E.out = P.out; gemm_phase(lsm, G, E); }
    xcd_barrier(bar);
#endif
#if (MK_PH >> 8) & 1
#if (MK_REP >> 13) & 1
    phase8_router(P, sm, 1);
#endif
    phase8_router(P, sm, 0);
#if (MK_REP >> 14) & 1
    xcd_barrier(bar); xcd_barrier(bar); xcd_barrier(bar); xcd_barrier(bar);
#endif
    xcd_barrier(bar);
#endif
#if (MK_PH >> 9) & 1
#if MK_F8
    LAS int* tb = (LAS int*)(lsm + F8_LDS); LAS int* cn = tb + 64;
    moe_tables(P, tb, cn);
    { ProbMoe1F8 G; G.tb = tb; G.cnt = cn; G.G = gridDim.x; G.c = blockIdx.x; G.A = P.ws + WS_R4 + R4_H2; G.Bt = P.ws + WS_WGU; G.KB = 1024; G.tokk = (const unsigned*)(P.ws + WS_TOKK);
      EpiMoe1F8 E; E.hid = P.ws + WS_R4 + R4_HID; gemm_f8(lsm, G, E); }
    xcd_barrier(bar);
    { ProbMoe2F8 G; G.tb = tb; G.cnt = cn; G.G = gridDim.x; G.c = blockIdx.x; G.A = P.ws + WS_R4 + R4_HID; G.Bt = P.ws + WS_WD; G.KB = 512;
      EpiMoe2F8 E; E.Y = (bf16_t*)(P.ws + WS_R4 + R4_Y); E.tokk = (const unsigned*)(P.ws + WS_TOKK); E.wl = (const float*)(P.ws + WS_WL); E.tb = tb; gemm_f8(lsm, G, E); }
    xcd_barrier(bar);
#else
    LAS int* tb = (LAS int*)(lsm + STAGE_BYTES); LAS int* cn = tb + 64;
    moe_tables(P, tb, cn);
    REPS(9)
    { ProbMoe1 G; G.tb = tb; G.cnt = cn; G.G = gridDim.x; G.c = blockIdx.x; G.A = (const bf16_t*)(P.ws + WS_R4 + R4_H2); G.Bt = (const bf16_t*)(P.ws + WS_WGU); G.K = 1024; G.tokk = (const unsigned*)(P.ws + WS_TOKK);
      EpiMoe1 E; E.hid = (bf16_t*)(P.ws + WS_R4 + R4_HID); gemm_phase(lsm, G, E); }
    xcd_barrier(bar);
    REPS(10)
    { ProbMoe2 G; G.tb = tb; G.cnt = cn; G.G = gridDim.x; G.c = blockIdx.x; G.A = (const bf16_t*)(P.ws + WS_R4 + R4_HID); G.Bt = (const bf16_t*)(P.ws + WS_WD); G.K = 512;
      EpiMoe2 E; E.Y = (bf16_t*)(P.ws + WS_R4 + R4_Y); E.tokk = (const unsigned*)(P.ws + WS_TOKK); E.wl = (const float*)(P.ws + WS_WL); E.tb = tb; gemm_phase(lsm, G, E); }
    xcd_barrier(bar);
#endif
#endif
#if (MK_PH >> 10) & 1
#if (MK_REP >> 12) & 1
    phase11_final(P, sm, (float*)(P.ws + WS_R4 + 300 * MiB));
#endif
    phase11_final(P, sm, P.out);
#endif
}

extern "C" void kernel_launch(void* const* d_in, const int* in_sizes, int n_in, void* d_out, int out_size, void* d_ws, size_t ws_size, hipStream_t stream) {
    (void)in_sizes; (void)n_in; (void)out_size;
    static int grid = 0;
    if (!grid) {
        int dev = 0, cus = 0, per_cu = 0;
        hipGetDevice(&dev);
        hipDeviceGetAttribute(&cus, hipDeviceAttributeMultiprocessorCount, dev);
        hipFuncSetAttribute((const void*)hymba_fwd, hipFuncAttributeMaxDynamicSharedMemorySize, LDS_BYTES);
        hipOccupancyMaxActiveBlocksPerMultiprocessor(&per_cu, hymba_fwd, 512, LDS_BYTES);
        if (per_cu < 1) { fprintf(stderr, "occupancy query says 0 blocks per CU\n"); per_cu = 1; }
        grid = cus;
        if (ws_size < WS_NEED) fprintf(stderr, "workspace too small: %zu < %zu\n", ws_size, (size_t)WS_NEED);
    }
    Params p{};
    p.x = (const float*)d_in[0]; p.c = (const float*)d_in[1]; p.ctx = (const float*)d_in[2]; p.c_ctx = (const float*)d_in[3]; p.w_mod = (const float*)d_in[4]; p.b_mod = (const float*)d_in[5];
    p.norm1_g = (const float*)d_in[6]; p.w_in = (const float*)d_in[7]; p.conv_w = (const float*)d_in[8]; p.a_log = (const float*)d_in[9]; p.dt_bias = (const float*)d_in[10]; p.onorm_g = (const float*)d_in[11];
    p.w_out = (const float*)d_in[12]; p.norm2_g = (const float*)d_in[13]; p.w_group = (const float*)d_in[14]; p.b_group = (const float*)d_in[15]; p.w_router = (const float*)d_in[16]; p.b_router = (const float*)d_in[17];
    p.w_gate = (const float*)d_in[18]; p.w_up = (const float*)d_in[19]; p.w_down = (const float*)d_in[20]; p.final_g = (const float*)d_in[21];
    p.out = (float*)d_out; p.ws = (unsigned char*)d_ws;
    hipMemsetAsync(d_ws, 0, WS_ZERO_BYTES, stream);
    hipLaunchKernelGGL(hymba_fwd, dim3(grid), dim3(512), LDS_BYTES, stream, p);
}
#endif
```

```cpp
#ifndef CPU_EMU
#include <hip/hip_runtime.h>
#include <cstdio>
#include <cstdint>
#define DEV __device__ __forceinline__
#define TID tid_local
#define PHASE_TID int tid_local = (int)threadIdx.x; asm volatile("" : "+v"(tid_local))
#define BID ((int)blockIdx.x)
#define NBLK ((int)gridDim.x)
#define SYNC() __syncthreads()
#define SCHED_FENCE() __builtin_amdgcn_sched_barrier(0)
#endif

typedef unsigned short bf16_t;
typedef short bf16x8 __attribute__((ext_vector_type(8)));
typedef float f32x4 __attribute__((ext_vector_type(4)));
typedef unsigned u32x4 __attribute__((ext_vector_type(4)));
typedef unsigned u32x2 __attribute__((ext_vector_type(2)));

constexpr int D = 1024, NB = 8, SEQ = 8192, CTX = 256;
constexpr int NTOK = NB * SEQ;
constexpr int NCTX = NB * CTX;
constexpr int MROWS = NTOK + NCTX;
constexpr int W_IN = 2576;
constexpr int NSTEP = 4 + 128;
constexpr int NCHAIN = NB * 4 * 2;
constexpr int NPROB = NCHAIN * NSTEP;
constexpr float EPS = 1e-6f;
constexpr int NEXP = 32;
constexpr int LCAP = 65536;

constexpr int IMG_W = 0, IMG_KT = 16384, IMG_A = 32768, IMG_U = 40960, IMG_SC = 57344, IMG_BYTES = 57664;

constexpr size_t MiB = 1048576;
constexpr size_t WS_BAR = 0;
constexpr size_t WS_MOD = 16384;
constexpr size_t WS_CNT = 16384 + 221184;
constexpr size_t WS_ZERO_BYTES = WS_CNT + 16384;
constexpr size_t WS_TAB = 262144;
constexpr size_t WS_BIAS = 393216;
constexpr size_t WS_RSTD = 5 * MiB + 524288;
constexpr size_t WS_GB = 1 * MiB;
constexpr size_t WS_TOKK = 6 * MiB;
constexpr size_t WS_WL = 14 * MiB;
constexpr size_t WS_W = 22 * MiB;
constexpr size_t WS_WQKVZ = WS_W;
constexpr size_t WS_WF = WS_WQKVZ + 2048ull * 1024 * 2;
constexpr size_t WS_WOUT = WS_WF + 1024ull * 1024 * 2;
constexpr size_t WS_WGU = WS_WOUT + 1024ull * 1024 * 2;
constexpr size_t WS_WD = WS_WGU + 32ull * 1024 * 1024 * 2;
constexpr size_t WS_R3 = 126 * MiB;
constexpr size_t WS_R4 = 324 * MiB;
constexpr size_t WS_NEED = WS_R4 + 645 * MiB;
constexpr size_t R4_H = 0, R4_P = 132 * MiB;
constexpr size_t R4_AMIX = 0, R4_H2 = 128 * MiB, R4_HID = 256 * MiB, R4_Y = 0;
constexpr size_t R4_OBUF = 480 * MiB;
constexpr size_t DO_GT = 0, DO_ZT = 128 * MiB, DO_ZS = 192 * MiB;

constexpr int LDS_BYTES = 163840;

struct Params {
    const float *x, *c, *ctx, *c_ctx, *w_mod, *b_mod, *norm1_g, *w_in, *conv_w, *a_log, *dt_bias, *onorm_g, *w_out, *norm2_g,
                *w_group, *b_group, *w_router, *b_router, *w_gate, *w_up, *w_down, *final_g;
    float* out;
    unsigned char* ws;
};

DEV bf16_t f2bf(float f) { unsigned u = __builtin_bit_cast(unsigned, f); u += 0x7FFFu + ((u >> 16) & 1u); return (bf16_t)(u >> 16); }
DEV float bf2f(bf16_t b) { return __builtin_bit_cast(float, ((unsigned)b) << 16); }
#ifndef MK_F8
#define MK_F8 1
#endif
#ifndef CPU_EMU
DEV unsigned pk4_fp8(float a, float b, float c, float d) { int t = 0; t = __builtin_amdgcn_cvt_pk_fp8_f32(a, b, t, false); t = __builtin_amdgcn_cvt_pk_fp8_f32(c, d, t, true); return (unsigned)t; }
typedef __bf16 bf16n2 __attribute__((ext_vector_type(2)));
DEV unsigned pk2(float lo, float hi) { bf16n2 v; v[0] = (__bf16)lo; v[1] = (__bf16)hi; return __builtin_bit_cast(unsigned, v); }
DEV float rcp_f(float x) { return __builtin_amdgcn_rcpf(x); }
DEV float rsq_f(float x) { return __builtin_amdgcn_rsqf(x); }
#else
DEV unsigned pk2(float lo, float hi) { return (unsigned)f2bf(lo) | ((unsigned)f2bf(hi) << 16); }
DEV float rcp_f(float x) { return 1.0f / x; }
DEV float rsq_f(float x) { return 1.0f / sqrtf(x); }
#endif
DEV float silu_f(float v) { return v * rcp_f(1.0f + __expf(-v)); }

#ifndef CPU_EMU
DEV f32x4 mfma16(bf16x8 a, bf16x8 b, f32x4 c) { return __builtin_amdgcn_mfma_f32_16x16x32_bf16(a, b, c, 0, 0, 0); }
DEV float shfl_xor_f(float v, int m) { return __shfl_xor(v, m); }
DEV float shfl_up_f(float v, int d) { return __shfl_up(v, d); }
DEV float shfl_idx_f(float v, int l) { return __shfl(v, l); }
DEV void atomic_add_f32(float* p, float v) { atomicAdd(p, v); }
DEV unsigned atomic_add_u32(unsigned* p, unsigned v) { return atomicAdd(p, v); }
DEV void sincospi_f(float x, float* s, float* c) { sincospif(x, s, c); }
#endif

DEV float wave_sum(float v) {
#pragma unroll
    for (int o = 32; o >= 1; o >>= 1) v += shfl_xor_f(v, o);
    return v;
}
template <int N> DEV float wave_sum_multi(const float (&v)[N], int lane) {
    float a[N];
#pragma unroll
    for (int i = 0; i < N; ++i) a[i] = v[i];
    int m = 1;
#pragma unroll
    for (int n = N; n > 1; n >>= 1, m <<= 1) {
        const bool up = (lane & m) != 0;
#pragma unroll
        for (int i = 0; i < n / 2; ++i) { const float keep = up ? a[2 * i + 1] : a[2 * i], send = up ? a[2 * i] : a[2 * i + 1]; a[i] = keep + shfl_xor_f(send, m); }
    }
    float r = a[0];
#pragma unroll
    for (int o = N; o < 64; o <<= 1) r += shfl_xor_f(r, o);
    return r;
}
#ifndef CPU_EMU
DEV float lane_bcast(float v, int l) { return __builtin_bit_cast(float, __builtin_amdgcn_readlane(__builtin_bit_cast(int, v), l)); }
#endif
DEV bf16x8 frag_gather(const bf16_t* p, int stride) {
    bf16x8 r;
#pragma unroll
    for (int j = 0; j < 8; ++j) r[j] = (short)p[j * stride];
    return r;
}
DEV bf16x8 frag16(const bf16_t* p) { return *(const bf16x8*)p; }

DEV void phase0_mod(const Params& P, unsigned char* sm) {
    PHASE_TID;
    float* sil = (float*)sm;
    float* red = (float*)(sm + 36864);
    for (int i = TID; i < 9 * 1024; i += 512) { const int r = i >> 10, k = i & 1023; const float v = r < 8 ? P.c[r * 1024 + k] : P.c_ctx[k]; sil[i] = silu_f(v); }
    SYNC();
    float* mod = (float*)(P.ws + WS_MOD);
    for (int cb = BID; cb < 256; cb += NBLK) {
        const int c = TID % 24, kg = TID / 24, j0 = cb * 24;
        if (kg < 21) {
            float acc[9];
#pragma unroll
            for (int r = 0; r < 9; ++r) acc[r] = 0.f;
#pragma unroll 7
            for (int k = kg; k < 1024; k += 21) { const float w = P.w_mod[(size_t)k * 6144 + j0 + c];
#pragma unroll
                for (int r = 0; r < 9; ++r) acc[r] += sil[r * 1024 + k] * w; }
#pragma unroll
            for (int r = 0; r < 9; ++r) red[(kg * 24 + c) * 9 + r] = acc[r];
        }
        SYNC();
        if (TID < 24 * 9) { const int cc = TID / 9, r = TID - cc * 9; float t = P.b_mod[j0 + cc];
            for (int g = 0; g < 21; ++g) t += red[(g * 24 + cc) * 9 + r];
            mod[r * 6144 + j0 + cc] = t; }
        SYNC();
    }
}

struct WJob { const float* src; unsigned char* dst; int lds_, ldd, inter, f8; };
DEV WJob wjob(const Params& P, int t) {
    unsigned char* wqkvz = P.ws + WS_WQKVZ; unsigned char* wout = P.ws + WS_WOUT; unsigned char* wgu = P.ws + WS_WGU; unsigned char* wd = P.ws + WS_WD;
    WJob j;
    if (t < 128) { const int kt = t >> 3, nt = t & 7;
        j.src = P.w_in + (size_t)(kt * 64) * W_IN + 512 + nt * 256; j.lds_ = W_IN; j.dst = wqkvz + ((size_t)(nt * 256) * 1024 + kt * 64) * 2; j.ldd = 2048; j.inter = 0; j.f8 = 0;
    } else if (t < 192) { const int u = t - 128, kt = u >> 2, nt = u & 3;
        j.src = P.w_out + (size_t)(kt * 64) * 1024 + nt * 256; j.lds_ = 1024; j.dst = wout + ((size_t)(nt * 256) * 1024 + kt * 64) * 2; j.ldd = 2048; j.inter = 0; j.f8 = 0;
    } else if (t < 192 + 2048) { const int u = t - 192, up = u >> 10, v = u & 1023, e = v >> 5, w = v & 31, kt = w >> 1, nt = w & 1;
        j.src = (up ? P.w_up : P.w_gate) + (size_t)e * 1024 * 512 + (size_t)(kt * 64) * 512 + nt * 256; j.lds_ = 512; j.inter = 1 + up;
#if MK_F8
        j.dst = wgu + (size_t)e * 1024 * 1024 + (size_t)(nt * 512) * 1024 + kt * 64; j.ldd = 1024; j.f8 = 1;
#else
        j.dst = wgu + ((size_t)e * 1024 * 1024 + (size_t)(nt * 512) * 1024 + kt * 64) * 2; j.ldd = 2048; j.f8 = 0;
#endif
    } else { const int v = t - 192 - 2048, e = v >> 5, w = v & 31, kt = w >> 2, nt = w & 3;
        j.src = P.w_down + (size_t)e * 512 * 1024 + (size_t)(kt * 64) * 1024 + nt * 256; j.lds_ = 1024; j.inter = 0;
#if MK_F8
        j.dst = wd + (size_t)e * 1024 * 512 + (size_t)(nt * 256) * 512 + kt * 64; j.ldd = 512; j.f8 = 1;
#else
        j.dst = wd + ((size_t)e * 1024 * 512 + (size_t)(nt * 256) * 512 + kt * 64) * 2; j.ldd = 1024; j.f8 = 0;
#endif
    }
    return j;
}
DEV void phase0_weights(const Params& P, unsigned char* sm) {
    PHASE_TID;
    float* tile = (float*)sm;
    const int NJ = 128 + 64 + 3 * 1024;
    f32x4 v[8];
    int t = BID;
    if (t < NJ) { const WJob j = wjob(P, t);
#pragma unroll
        for (int q = 0; q < 8; ++q) v[q] = *(const f32x4*)(j.src + (size_t)((TID >> 6) + q * 8) * j.lds_ + (TID & 63) * 4); }
    for (; t < NJ; t += NBLK) {
        const WJob j = wjob(P, t);
#pragma unroll
        for (int q = 0; q < 8; ++q) { float* tp = tile + ((TID >> 6) + q * 8) * 257 + (TID & 63) * 4; tp[0] = v[q][0]; tp[1] = v[q][1]; tp[2] = v[q][2]; tp[3] = v[q][3]; }
        { const WJob jn = wjob(P, t + NBLK < NJ ? t + NBLK : t);
#pragma unroll
          for (int q = 0; q < 8; ++q) v[q] = *(const f32x4*)(jn.src + (size_t)((TID >> 6) + q * 8) * jn.lds_ + (TID & 63) * 4); }
        SYNC();
        const int c = TID & 255, half = TID >> 8;
        if (j.f8) {
            const int drow8 = j.inter ? ((c >> 7) * 256 + ((c >> 5) & 3) * 64 + (j.inter - 1) * 32 + (c & 31)) : c;
            u32x4 w[2];
#pragma unroll
            for (int q = 0; q < 2; ++q)
#pragma unroll
                for (int jj = 0; jj < 4; ++jj) { const int k0 = half * 32 + q * 16 + jj * 4; w[q][jj] = pk4_fp8(tile[k0 * 257 + c] * 32.0f, tile[(k0 + 1) * 257 + c] * 32.0f, tile[(k0 + 2) * 257 + c] * 32.0f, tile[(k0 + 3) * 257 + c] * 32.0f); }
            unsigned char* d8 = j.dst + (size_t)drow8 * j.ldd + half * 32;
            *(u32x4*)d8 = w[0]; *(u32x4*)(d8 + 16) = w[1];
        } else {
            const int drow = j.inter ? ((c >> 7) * 256 + (j.inter - 1) * 128 + (c & 127)) : c;
            u32x4 w[4];
#pragma unroll
            for (int q = 0; q < 4; ++q)
#pragma unroll
                for (int jj = 0; jj < 4; ++jj) w[q][jj] = pk2(tile[(half * 32 + q * 8 + 2 * jj) * 257 + c], tile[(half * 32 + q * 8 + 2 * jj + 1) * 257 + c]);
            unsigned char* d2 = j.dst + (size_t)drow * j.ldd + half * 64;
#pragma unroll
            for (int q = 0; q < 4; ++q) *(u32x4*)(d2 + q * 16) = w[q];
        }
        SYNC();
    }
}

DEV void phase0_wf(const Params& P, unsigned char* sm) {
    PHASE_TID;
    float* cs = (float*)sm;
    if (TID < 128) { float s, c; sincospi_f((float)TID * (2.0f / 128.0f), &s, &c); cs[TID] = c; cs[128 + TID] = s; }
    SYNC();
    bf16_t* wf = (bf16_t*)(P.ws + WS_WF);
    const float sc = 0.08838834764831845f;
    for (int it = BID; it < 256; it += NBLK) {
        const int kb = it & 1, cb = (it >> 1) & 15, part = (it >> 5) & 1, g = it >> 6;
        const int k = kb * 512 + TID;
        const float* wrow = P.w_in + (size_t)k * W_IN + g * 128;
        float acc[8];
#pragma unroll
        for (int q = 0; q < 8; ++q) acc[q] = 0.f;
#pragma unroll 8
        for (int c4 = 0; c4 < 32; ++c4) { const f32x4 w4 = *(const f32x4*)(wrow + c4 * 4);
#pragma unroll
            for (int e = 0; e < 4; ++e) { const int c = c4 * 4 + e;
#pragma unroll
                for (int q = 0; q < 8; ++q) { const int cp = cb * 8 + q; acc[q] += w4[e] * cs[part * 128 + ((c * cp) & 127)]; } } }
#pragma unroll
        for (int q = 0; q < 8; ++q) { const int chc = part * 512 + g * 128 + cb * 8 + q; wf[(size_t)chc * 1024 + k] = f2bf((part ? -acc[q] : acc[q]) * sc); }
    }
    bf16_t* tab = (bf16_t*)(P.ws + WS_TAB);
    const float sc2 = 0.011048543456039806f;
    for (int i = BID * 512 + TID; i < 4096 + 16384; i += NBLK * 512) {
        if (i < 4096) { const int a = i >> 6, b = i & 63; float s, c; sincospi_f((float)((a * b) & 63) * (2.0f / 64.0f), &s, &c); tab[i] = f2bf(c); tab[4096 + i] = f2bf(s); }
        else { const int j = i - 4096, a = j >> 7, b = j & 127; float s, c; sincospi_f((float)((a * b) & 127) * (2.0f / 128.0f), &s, &c); tab[8192 + j] = f2bf(c * sc2); tab[8192 + 16384 + j] = f2bf(s * sc2); }
    }
}

DEV void phase1_prep(const Params& P, unsigned char* sm) {
    PHASE_TID;
    bf16_t* Bhi = (bf16_t*)sm; bf16_t* Blo = (bf16_t*)(sm + 33024);
    float* gsv = (float*)(sm + 66048);
    float* gbl = (float*)(sm + 70144);
    {
        f32x4 w[2][4];
#pragma unroll
        for (int h = 0; h < 2; ++h)
#pragma unroll
            for (int q = 0; q < 4; ++q) w[h][q] = *(const f32x4*)(P.w_in + (size_t)(TID + h * 512) * W_IN + 2560 + q * 4);
#pragma unroll
        for (int h = 0; h < 2; ++h)
#pragma unroll
            for (int q = 0; q < 4; ++q)
#pragma unroll
                for (int e = 0; e < 4; ++e) { const int n = q * 4 + e, k = TID + h * 512; const float v = w[h][q][e]; const bf16_t hi = f2bf(v); Bhi[n * 1032 + k] = hi; Blo[n * 1032 + k] = f2bf(v - bf2f(hi)); }
    }
    const float* mod = (const float*)(P.ws + WS_MOD);
    bf16_t* h = (bf16_t*)(P.ws + WS_R4 + R4_H);
    float* gb = (float*)(P.ws + WS_GB);
    float* rstd_arr = (float*)(P.ws + WS_RSTD);
    float* bias = (float*)(P.ws + WS_BIAS);
    const int wid = TID >> 6, lane = TID & 63, fr = lane & 15, fq = lane >> 4;
    SYNC();
    const float* shrow = mod + (fr < 8 ? fr : 8) * 6144 + fq * 8;
    if (TID < 256) gbl[TID] = 0.f;
    SYNC();
    {
        f32x4 acc = (f32x4){0.f, 0.f, 0.f, 0.f};
#pragma unroll
        for (int k4 = 0; k4 < 4; ++k4) {
            const int ks = wid * 4 + k4;
            const f32x4 a0 = *(const f32x4*)(shrow + ks * 32), a1 = *(const f32x4*)(shrow + ks * 32 + 4);
            const float hv[8] = {a0[0], a0[1], a0[2], a0[3], a1[0], a1[1], a1[2], a1[3]};
            u32x4 whi, wlo;
#pragma unroll
            for (int e = 0; e < 4; ++e) { whi[e] = pk2(hv[2 * e], hv[2 * e + 1]); wlo[e] = pk2(hv[2 * e] - __builtin_bit_cast(float, whi[e] << 16), hv[2 * e + 1] - __builtin_bit_cast(float, whi[e] & 0xffff0000u)); }
            const bf16x8 ahi = __builtin_bit_cast(bf16x8, whi), alo = __builtin_bit_cast(bf16x8, wlo);
            const bf16x8 bhi = frag16(Bhi + fr * 1032 + ks * 32 + fq * 8), blo = frag16(Blo + fr * 1032 + ks * 32 + fq * 8);
            acc = mfma16(ahi, bhi, acc); acc = mfma16(alo, bhi, acc); acc = mfma16(ahi, blo, acc);
        }
#pragma unroll
        for (int r = 0; r < 4; ++r) atomic_add_f32(&gbl[(fq * 4 + r) * 16 + fr], acc[r]);
    }
    {
        const bf16_t* wq = (const bf16_t*)(P.ws + WS_WQKVZ); const bf16_t* wf = (const bf16_t*)(P.ws + WS_WF);
        for (int it = BID * 8 + wid; it < 192; it += NBLK * 8) {
            const int n0 = it * 16;
            const bf16_t* wrow = (n0 < 2048 ? wq + (size_t)(n0 + fr) * 1024 : wf + (size_t)(n0 - 2048 + fr) * 1024) + fq * 8;
            f32x4 acc = (f32x4){0.f, 0.f, 0.f, 0.f};
#pragma unroll 4
            for (int ks = 0; ks < 32; ++ks) {
                const f32x4 a0 = *(const f32x4*)(shrow + ks * 32), a1 = *(const f32x4*)(shrow + ks * 32 + 4);
                const float hv[8] = {a0[0], a0[1], a0[2], a0[3], a1[0], a1[1], a1[2], a1[3]};
                u32x4 whi, wlo;
#pragma unroll
                for (int e = 0; e < 4; ++e) { whi[e] = pk2(hv[2 * e], hv[2 * e + 1]); wlo[e] = pk2(hv[2 * e] - __builtin_bit_cast(float, whi[e] << 16), hv[2 * e + 1] - __builtin_bit_cast(float, whi[e] & 0xffff0000u)); }
                const bf16x8 bw = frag16(wrow + ks * 32);
                acc = mfma16(__builtin_bit_cast(bf16x8, whi), bw, acc); acc = mfma16(__builtin_bit_cast(bf16x8, wlo), bw, acc);
            }
#pragma unroll
            for (int r = 0; r < 4; ++r) { const int mbr = fq * 4 + r; if (mbr < 9) bias[mbr * 3072 + n0 + fr] = acc[r]; }
        }
    }
    for (int t = BID; t < MROWS / 128; t += NBLK) {
        const int r0 = t * 128 + wid * 16, mb = (t * 128 < NTOK) ? ((t * 128) >> 13) : 8;
        SYNC();
        { const float* scale = mod + mb * 6144 + 1024;
#pragma unroll
          for (int q = 0; q < 2; ++q) { const int k = TID + q * 512; gsv[k] = P.norm1_g[k] * (1.0f + scale[k]); } }
        SYNC();
        const int rr = r0 + fr;
        const float* src = (rr < NTOK ? P.x + (size_t)rr * D : P.ctx + (size_t)(rr - NTOK) * D) + fq * 8;
        float ss = 0.f;
        f32x4 acc = (f32x4){0.f, 0.f, 0.f, 0.f};
        bf16_t* hrow = h + (size_t)rr * D + fq * 8;
#pragma unroll 8
        for (int ks = 0; ks < 32; ++ks) {
            const f32x4 a0 = *(const f32x4*)(src + ks * 32), a1 = *(const f32x4*)(src + ks * 32 + 4);
            ss += a0[0] * a0[0] + a0[1] * a0[1] + a0[2] * a0[2] + a0[3] * a0[3] + a1[0] * a1[0] + a1[1] * a1[1] + a1[2] * a1[2] + a1[3] * a1[3];
            const f32x4 g0 = *(const f32x4*)(gsv + ks * 32 + fq * 8), g1 = *(const f32x4*)(gsv + ks * 32 + fq * 8 + 4);
            float hv[8];
#pragma unroll
            for (int e = 0; e < 4; ++e) { hv[e] = a0[e] * g0[e]; hv[4 + e] = a1[e] * g1[e]; }
            u32x4 whi, wlo;
#pragma unroll
            for (int e = 0; e < 4; ++e) { whi[e] = pk2(hv[2 * e], hv[2 * e + 1]); wlo[e] = pk2(hv[2 * e] - __builtin_bit_cast(float, whi[e] << 16), hv[2 * e + 1] - __builtin_bit_cast(float, whi[e] & 0xffff0000u)); }
            *(u32x4*)(hrow + ks * 32) = whi;
            const bf16x8 ahi = __builtin_bit_cast(bf16x8, whi), alo = __builtin_bit_cast(bf16x8, wlo);
            const bf16x8 bhi = frag16(Bhi + fr * 1032 + ks * 32 + fq * 8), blo = frag16(Blo + fr * 1032 + ks * 32 + fq * 8);
            acc = mfma16(ahi, bhi, acc); acc = mfma16(alo, bhi, acc); acc = mfma16(ahi, blo, acc);
        }
        ss += shfl_xor_f(ss, 16); ss += shfl_xor_f(ss, 32);
        const float rstd = rsq_f(ss * (1.0f / 1024.0f) + EPS);
        if (fq == 0) rstd_arr[rr] = rstd;
        float ea = 0.f, db = 0.f;
        if (fr >= 8) { ea = -__expf(P.a_log[fr - 8]); db = P.dt_bias[fr - 8]; }
        const float gbias = gbl[mb * 16 + fr];
#pragma unroll
        for (int reg = 0; reg < 4; ++reg) { const float v = acc[reg] * shfl_idx_f(rstd, fq * 4 + reg) + gbias; float o;
            if (fr < 8) o = rcp_f(1.0f + __expf(-v));
            else { const float z = v + db; const float sp = z > 20.f ? z : log1pf(__expf(z)); o = ea * sp; }
            gb[(size_t)(r0 + fq * 4 + reg) * 16 + fr] = o; }
    }
}

#ifndef CPU_EMU
namespace pg8 {
#define PG8_LAS __attribute__((address_space(3)))
constexpr int BM = 256, BK = 64, HALF = 128, HTB = HALF * BK * 2, STAGE_BYTES = 8 * HTB;
__device__ __forceinline__ int lds_byte(int r, int c) { const int st = (r >> 4) * 2 + (c >> 5), rr = r & 15, cc = c & 31, ob = rr * 64 + cc * 2; return st * 1024 + (ob ^ (((ob >> 9) & 1) << 5)); }
__device__ __forceinline__ void stage_rc(int b, int& R, int& C) { const int st = b / 1024, sb = b % 1024, swz = sb ^ (((sb >> 9) & 1) << 5); R = (st >> 1) * 16 + swz / 64; C = (st & 1) * 32 + (swz % 64) / 2; }
__device__ __forceinline__ int perm32(int rho) { const int n = rho >> 4, i = rho & 15; return 8 * (i >> 2) + 4 * n + (i & 3); }
struct Unit { int pm, pn, e, cnt; };
__device__ __forceinline__ unsigned cvt_pk_bf16(float lo, float hi) { unsigned r; asm volatile("v_cvt_pk_bf16_f32 %0, %1, %2" : "=v"(r) : "v"(lo), "v"(hi)); return r; }

template <class Prob, class Epi>
__device__ __forceinline__ void gemm_phase(PG8_LAS unsigned char* lds, const Prob& G, const Epi& E) {
    int tid_ = threadIdx.x; asm volatile("" : "+v"(tid_));
    const int tid = tid_, wid = __builtin_amdgcn_readfirstlane(tid >> 6), lane = tid & 63, wr = wid >> 2, wc = wid & 3, fr = lane & 15, fq = lane >> 4;
    const int K = G.K, nt = K / BK;
    int R0, C0; stage_rc(tid * 16, R0, C0);
    const int rA0 = R0, rA1 = R0 + 64;
    const int rB0 = Epi::PERM ? ((R0 & ~31) + perm32(R0 & 31)) : R0, rB1 = Epi::PERM ? (((R0 + 64) & ~31) + perm32((R0 + 64) & 31)) : R0 + 64;
    const unsigned ldsw = (unsigned)wid * 1024u;
    const int aoff = lds_byte(wr * 64 + fr, fq * 8), boff = lds_byte(wc * 32 + fr, fq * 8);
    const char* Ab = (const char*)G.A; const char* Bb = (const char*)G.Bt;
#define PG8_SA(b, h) (((b) * 2 + (h)) * HTB)
#define PG8_SB(b, h) ((4 + (b) * 2 + (h)) * HTB)
#define PG8_STAGE(bufoff, gbase, ub, l0, l1) do { \
        __builtin_amdgcn_global_load_lds((const unsigned*)((gbase) + (size_t)(ub) + (l0)), (PG8_LAS unsigned*)(lds + (bufoff) + ldsw), 16, 0, 0); \
        __builtin_amdgcn_global_load_lds((const unsigned*)((gbase) + (size_t)(ub) + (l1)), (PG8_LAS unsigned*)(lds + (bufoff) + ldsw + 8192), 16, 0, 0); } while (0)
#define PG8_LDA(dst, b, h) do { _Pragma("unroll") for (int m = 0; m < 4; ++m) _Pragma("unroll") for (int k = 0; k < 2; ++k) dst[m][k] = *(const PG8_LAS bf16x8*)(lds + PG8_SA(b, h) + aoff + m * 2048 + k * 1024); } while (0)
#define PG8_LDB(dst, b, h) do { _Pragma("unroll") for (int n = 0; n < 2; ++n) _Pragma("unroll") for (int k = 0; k < 2; ++k) dst[n][k] = *(const PG8_LAS bf16x8*)(lds + PG8_SB(b, h) + boff + n * 2048 + k * 1024); } while (0)
#define PG8_MMA(ai, bj, At, Bt) do { __builtin_amdgcn_s_setprio(1); _Pragma("unroll") for (int m = 0; m < 4; ++m) _Pragma("unroll") for (int n = 0; n < 2; ++n) _Pragma("unroll") for (int k = 0; k < 2; ++k) \
        acc[ai][bj][m][n] = __builtin_amdgcn_mfma_f32_16x16x32_bf16(Bt[n][k], At[m][k], acc[ai][bj][m][n], 0, 0, 0); __builtin_amdgcn_s_setprio(0); } while (0)
#define PG8_WAIT_V(n) asm volatile("s_waitcnt vmcnt(" #n ")" ::: "memory")
#define PG8_WAIT_L(n) asm volatile("s_waitcnt lgkmcnt(" #n ")" ::: "memory")
#define PG8_BAR __builtin_amdgcn_s_barrier()
#define PG8_SCHED __builtin_amdgcn_sched_barrier(0)
    Unit cur, nxt; int ui = 0;
    if (!G.next(0, cur)) return;
    f32x4 acc[2][2][4][2];
#pragma unroll
    for (int a = 0; a < 2; ++a)
#pragma unroll
        for (int b = 0; b < 2; ++b)
#pragma unroll
            for (int m = 0; m < 4; ++m)
#pragma unroll
                for (int n = 0; n < 2; ++n) acc[a][b][m][n] = (f32x4){0.f, 0.f, 0.f, 0.f};
    bf16x8 At[4][2], B0[2][2], B1[2][2];
    const unsigned cb2 = (unsigned)C0 * 2u;
    const unsigned lB00 = G.laneB(rB0) + cb2, lB01 = G.laneB(rB1) + cb2, lB10 = G.laneB(128 + rB0) + cb2, lB11 = G.laneB(128 + rB1) + cb2;
    const unsigned lA00 = G.laneA(rA0) + cb2, lA01 = G.laneA(rA1) + cb2, lA10 = G.laneA(128 + rA0) + cb2, lA11 = G.laneA(128 + rA1) + cb2;
    unsigned cA00 = lA00, cA01 = lA01, cA10 = lA10, cA11 = lA11, nA00 = lA00, nA01 = lA01, nA10 = lA10, nA11 = lA11;
    if constexpr (Prob::GATHER_A) { cA00 += G.gathA(cur, rA0); cA01 += G.gathA(cur, rA1); cA10 += G.gathA(cur, 128 + rA0); cA11 += G.gathA(cur, 128 + rA1); }
    unsigned uAc = G.baseA(cur), uBc = G.baseB(cur), uAn = uAc, uBn = uBc;
    if constexpr (Epi::PREFETCH) E.prefetch(cur, lds + STAGE_BYTES + 2048, wid, lane);
    PG8_STAGE(PG8_SB(0, 0), Bb, uBc, lB00, lB01); PG8_STAGE(PG8_SA(0, 0), Ab, uAc, cA00, cA01); PG8_STAGE(PG8_SB(0, 1), Bb, uBc, lB10, lB11); PG8_STAGE(PG8_SA(0, 1), Ab, uAc, cA10, cA11);
    if (wr == 1) PG8_BAR;
    PG8_WAIT_V(4); PG8_BAR;
    PG8_STAGE(PG8_SB(1, 0), Bb, uBc + 128u, lB00, lB01); PG8_STAGE(PG8_SA(1, 0), Ab, uAc + 128u, cA00, cA01); PG8_STAGE(PG8_SB(1, 1), Bb, uBc + 128u, lB10, lB11);
    PG8_WAIT_V(6); PG8_BAR;
    for (;;) {
        const bool has_next = G.next(ui + 1, nxt);
        if constexpr (Epi::PREFETCH) { if (has_next) E.prefetch(nxt, lds + STAGE_BYTES + 2048 + ((ui + 1) % 3) * 2048, wid, lane); }
        if (has_next) {
            uAn = G.baseA(nxt); uBn = G.baseB(nxt);
            if constexpr (Prob::GATHER_A) { nA00 = lA00 + G.gathA(nxt, rA0); nA01 = lA01 + G.gathA(nxt, rA1); nA10 = lA10 + G.gathA(nxt, 128 + rA0); nA11 = lA11 + G.gathA(nxt, 128 + rA1); }
        } else { uAn = uAc; uBn = uBc; if constexpr (Prob::GATHER_A) { nA00 = cA00; nA01 = cA01; nA10 = cA10; nA11 = cA11; } }
        for (int t = 0; t < nt; t += 2) {
            const bool last = (t == nt - 2);
            const unsigned k1 = (unsigned)(t + 1) * 128u;
            const unsigned uA2 = last ? uAn : uAc + (unsigned)(t + 2) * 128u, uB2 = last ? uBn : uBc + (unsigned)(t + 2) * 128u, uA3 = uA2 + 128u, uB3 = uB2 + 128u;
            unsigned a00 = cA00, a01 = cA01, a10 = cA10, a11 = cA11;
            if constexpr (Prob::GATHER_A) { a00 = last ? nA00 : cA00; a01 = last ? nA01 : cA01; a10 = last ? nA10 : cA10; a11 = last ? nA11 : cA11; }
            PG8_LDB(B0, 0, 0); PG8_SCHED; PG8_LDA(At, 0, 0); PG8_STAGE(PG8_SA(1, 1), Ab, uAc + k1, cA10, cA11);
            PG8_WAIT_L(8); PG8_BAR; PG8_WAIT_L(0); PG8_MMA(0, 0, At, B0); PG8_BAR; PG8_SCHED;
            PG8_LDB(B1, 0, 1); PG8_STAGE(PG8_SB(0, 0), Bb, uB2, lB00, lB01);
            PG8_BAR; PG8_WAIT_L(0); PG8_MMA(0, 1, At, B1); PG8_BAR;
            PG8_LDA(At, 0, 1); PG8_STAGE(PG8_SA(0, 0), Ab, uA2, a00, a01);
            PG8_BAR; PG8_WAIT_L(0); PG8_MMA(1, 0, At, B0); PG8_BAR; PG8_SCHED;
            PG8_STAGE(PG8_SB(0, 1), Bb, uB2, lB10, lB11);
            PG8_WAIT_V(6); PG8_BAR; PG8_MMA(1, 1, At, B1); PG8_BAR;
            PG8_LDB(B0, 1, 0); PG8_SCHED; PG8_LDA(At, 1, 0); PG8_STAGE(PG8_SA(0, 1), Ab, uA2, a10, a11);
            PG8_WAIT_L(8); PG8_BAR; PG8_WAIT_L(0); PG8_MMA(0, 0, At, B0); PG8_BAR; PG8_SCHED;
            PG8_LDB(B1, 1, 1); PG8_STAGE(PG8_SB(1, 0), Bb, uB3, lB00, lB01);
            PG8_BAR; PG8_WAIT_L(0); PG8_MMA(0, 1, At, B1); PG8_BAR;
            PG8_LDA(At, 1, 1); PG8_STAGE(PG8_SA(1, 0), Ab, uA3, a00, a01);
            PG8_BAR; PG8_WAIT_L(0); PG8_MMA(1, 0, At, B0); PG8_BAR; PG8_SCHED;
            PG8_STAGE(PG8_SB(1, 1), Bb, uB3, lB10, lB11);
            PG8_WAIT_V(6); PG8_BAR; PG8_MMA(1, 1, At, B1); PG8_BAR;
        }
        E(acc, cur, wr, wc, fr, fq, (const PG8_LAS float*)(lds + STAGE_BYTES + 2048 + (ui % 3) * 2048));
        if (!has_next) break;
#pragma unroll
        for (int a = 0; a < 2; ++a)
#pragma unroll
            for (int b = 0; b < 2; ++b)
#pragma unroll
                for (int m = 0; m < 4; ++m)
#pragma unroll
                    for (int n = 0; n < 2; ++n) acc[a][b][m][n] = (f32x4){0.f, 0.f, 0.f, 0.f};
        cur = nxt; ++ui; uAc = uAn; uBc = uBn;
        if constexpr (Prob::GATHER_A) { cA00 = nA00; cA01 = nA01; cA10 = nA10; cA11 = nA11; }
    }
    PG8_WAIT_V(0);
    if (wr == 0) PG8_BAR;
    PG8_BAR;
#undef PG8_SA
#undef PG8_SB
#undef PG8_STAGE
#undef PG8_LDA
#undef PG8_LDB
#undef PG8_MMA
#undef PG8_WAIT_V
#undef PG8_WAIT_L
#undef PG8_BAR
#undef PG8_SCHED
}

struct GridOrder {
    int nM, nN, nwg, G, c;
    __device__ __forceinline__ void init(int nM_, int nN_, int G_, int c_) { nM = nM_; nN = nN_; nwg = nM * nN; G = G_; c = c_; }
    __device__ __forceinline__ bool next(int i, Unit& u) const {
        const long L = (long)i * G + c; if (L >= nwg) return false;
        int wgid = (int)L; { const int q = nwg / 8, r = nwg % 8, xcd = wgid % 8, off = wgid / 8; wgid = (xcd < r ? xcd * (q + 1) : r * (q + 1) + (xcd - r) * q) + off; }
        const int nig = 8 * nN, gid = wgid / nig, fm = gid * 8, gsz = (nM - fm) < 8 ? (nM - fm) : 8;
        u.pm = fm + ((wgid % nig) % gsz); u.pn = (wgid % nig) / gsz; u.e = 0; u.cnt = 256; return true;
    }
};

struct ProbInproj : GridOrder { const bf16_t* A; const bf16_t* Bt; int K; static constexpr bool GATHER_A = false;
    __device__ __forceinline__ unsigned laneA(int r) const { return (unsigned)r * 2048u; }
    __device__ __forceinline__ unsigned laneB(int r) const { return (unsigned)r * 2048u; }
    __device__ __forceinline__ unsigned baseA(const Unit& u) const { return (unsigned)(u.pm * 256) * 2048u; }
    __device__ __forceinline__ unsigned baseB(const Unit& u) const { return (unsigned)(u.pn * 256) * 2048u; }
    __device__ __forceinline__ unsigned gathA(const Unit&, int) const { return 0u; } };
struct ProbGT : GridOrder { const bf16_t* A; const bf16_t* Bt; int K; static constexpr bool GATHER_A = false;
    __device__ __forceinline__ unsigned laneA(int r) const { return (unsigned)r * 2048u; }
    __device__ __forceinline__ unsigned laneB(int r) const { return (unsigned)(128 * (r & 63) + (r >> 6)) * 2048u; }
    __device__ __forceinline__ unsigned baseA(const Unit& u) const { return (unsigned)(u.pm * 256) * 2048u; }
    __device__ __forceinline__ unsigned baseB(const Unit& u) const { const int col = u.pn * 256, b = col >> 13, w = col & 8191; return (unsigned)(b * 8192 + (w >> 6)) * 2048u; }
    __device__ __forceinline__ unsigned gathA(const Unit&, int) const { return 0u; } };
struct EpiStoreBf16 {
    static constexpr bool PERM = true, PREFETCH = false; bf16_t* O; int ldc;
    __device__ __forceinline__ void operator()(const f32x4 (&acc)[2][2][4][2], const Unit& u, int wr, int wc, int fr, int fq, const PG8_LAS float* ex) const {
        const int row0 = u.pm * 256 + wr * 64 + fr, col0 = u.pn * 256 + wc * 32 + 8 * fq;
#pragma unroll
        for (int ai = 0; ai < 2; ++ai)
#pragma unroll
            for (int m = 0; m < 4; ++m) { bf16_t* rowp = O + (size_t)(row0 + ai * 128 + m * 16) * ldc + col0;
#pragma unroll
                for (int bj = 0; bj < 2; ++bj) { const f32x4 v0 = acc[ai][bj][m][0], v1 = acc[ai][bj][m][1];
                    u32x4 w; w.x = cvt_pk_bf16(v0[0], v0[1]); w.y = cvt_pk_bf16(v0[2], v0[3]); w.z = cvt_pk_bf16(v1[0], v1[1]); w.w = cvt_pk_bf16(v1[2], v1[3]);
                    *(u32x4*)(rowp + bj * 128) = w; } }
    }
};
struct EpiGT {
    static constexpr bool PERM = true, PREFETCH = true; bf16_t* O; const float* rstd; const float* bias;
    __device__ __forceinline__ void prefetch(const Unit& u, PG8_LAS unsigned char* ex, int wid, int lane) const {
        const int mb = (u.pn * 256) >> 13;
        if (wid == 0) __builtin_amdgcn_global_load_lds((const unsigned*)(bias + mb * 3072 + 2048 + u.pm * 256 + lane * 4), (PG8_LAS unsigned*)(ex + 1024), 16, 0, 0);
        else if (wid <= 4) { const int c = u.pn * 256 + (wid - 1) * 64 + lane, w = c & 8191;
            __builtin_amdgcn_global_load_lds((const unsigned*)(rstd + mb * 8192 + 128 * (w & 63) + (w >> 6)), (PG8_LAS unsigned*)(ex + (wid - 1) * 256), 4, 0, 0); }
    }
    __device__ __forceinline__ void operator()(const f32x4 (&acc)[2][2][4][2], const Unit& u, int wr, int wc, int fr, int fq, const PG8_LAS float* ex) const {
        const int row0 = u.pm * 256 + wr * 64 + fr, col0 = u.pn * 256 + wc * 32 + 8 * fq;
        float rs[2][8];
#pragma unroll
        for (int bj = 0; bj < 2; ++bj) { const f32x4 r0_ = *(const PG8_LAS f32x4*)(ex + bj * 128 + wc * 32 + 8 * fq), r1_ = *(const PG8_LAS f32x4*)(ex + bj * 128 + wc * 32 + 8 * fq + 4);
            rs[bj][0] = r0_[0]; rs[bj][1] = r0_[1]; rs[bj][2] = r0_[2]; rs[bj][3] = r0_[3]; rs[bj][4] = r1_[0]; rs[bj][5] = r1_[1]; rs[bj][6] = r1_[2]; rs[bj][7] = r1_[3]; }
#pragma unroll
        for (int ai = 0; ai < 2; ++ai)
#pragma unroll
            for (int m = 0; m < 4; ++m) { const int row = row0 + ai * 128 + m * 16; const float bg = ex[256 + wr * 64 + fr + ai * 128 + m * 16]; bf16_t* rowp = O + (size_t)row * NTOK + col0;
#pragma unroll
                for (int bj = 0; bj < 2; ++bj) { const f32x4 a0 = acc[ai][bj][m][0], a1 = acc[ai][bj][m][1];
                    u32x4 w; w.x = cvt_pk_bf16(a0[0] * rs[bj][0] + bg, a0[1] * rs[bj][1] + bg); w.y = cvt_pk_bf16(a0[2] * rs[bj][2] + bg, a0[3] * rs[bj][3] + bg);
                    w.z = cvt_pk_bf16(a1[0] * rs[bj][4] + bg, a1[1] * rs[bj][5] + bg); w.w = cvt_pk_bf16(a1[2] * rs[bj][6] + bg, a1[3] * rs[bj][7] + bg);
                    *(u32x4*)(rowp + bj * 128) = w; } }
    }
};
struct EpiInproj {
    static constexpr bool PERM = true, PREFETCH = true; bf16_t* O; bf16_t* zs; const float* rstd; const float* bias;
    __device__ __forceinline__ void prefetch(const Unit& u, PG8_LAS unsigned char* ex, int wid, int lane) const {
        if (wid == 0) __builtin_amdgcn_global_load_lds((const unsigned*)(rstd + u.pm * 256 + lane * 4), (PG8_LAS unsigned*)ex, 16, 0, 0);
        else if (wid == 1) __builtin_amdgcn_global_load_lds((const unsigned*)(bias + ((u.pm * 256 < NTOK) ? ((u.pm * 256) >> 13) : 8) * 3072 + u.pn * 256 + lane * 4), (PG8_LAS unsigned*)(ex + 1024), 16, 0, 0);
    }
    __device__ __forceinline__ void operator()(const f32x4 (&acc)[2][2][4][2], const Unit& u, int wr, int wc, int fr, int fq, const PG8_LAS float* ex) const {
        const int row0 = u.pm * 256 + wr * 64 + fr, col0 = u.pn * 256 + wc * 32 + 8 * fq;
        const bool isz = u.pn >= 6;
        if (isz && u.pm * 256 >= NTOK) return;
        f32x4 bv[2][2];
#pragma unroll
        for (int bj = 0; bj < 2; ++bj) { bv[bj][0] = *(const PG8_LAS f32x4*)(ex + 256 + bj * 128 + wc * 32 + 8 * fq); bv[bj][1] = *(const PG8_LAS f32x4*)(ex + 256 + bj * 128 + wc * 32 + 8 * fq + 4); }
#pragma unroll
        for (int ai = 0; ai < 2; ++ai)
#pragma unroll
            for (int m = 0; m < 4; ++m) { const size_t row = (size_t)(row0 + ai * 128 + m * 16); const float rs = ex[wr * 64 + fr + ai * 128 + m * 16];
                bf16_t* rowp = isz ? zs + row * 512 + (col0 - 1536) : O + row * 2048 + col0;
#pragma unroll
                for (int bj = 0; bj < 2; ++bj) { f32x4 v0 = acc[ai][bj][m][0] * rs + bv[bj][0], v1 = acc[ai][bj][m][1] * rs + bv[bj][1];
                    if (isz) {
#pragma unroll
                        for (int j = 0; j < 4; ++j) { v0[j] = v0[j] * __builtin_amdgcn_rcpf(1.0f + __expf(-v0[j])); v1[j] = v1[j] * __builtin_amdgcn_rcpf(1.0f + __expf(-v1[j])); } }
                    u32x4 w; w.x = cvt_pk_bf16(v0[0], v0[1]); w.y = cvt_pk_bf16(v0[2], v0[3]); w.z = cvt_pk_bf16(v1[0], v1[1]); w.w = cvt_pk_bf16(v1[2], v1[3]);
                    *(u32x4*)(rowp + bj * 128) = w; } }
    }
};
typedef ProbInproj ProbOut;
struct EpiResid {
    static constexpr bool PERM = false, PREFETCH = false; const float* x; const float* mod; float* out;
    __device__ __forceinline__ void operator()(const f32x4 (&acc)[2][2][4][2], const Unit& u, int wr, int wc, int fr, int fq, const PG8_LAS float* ex) const {
        const int row0 = u.pm * 256 + wr * 64 + fr, col0 = u.pn * 256 + wc * 32 + 4 * fq;
        const float* gate = mod + ((u.pm * 256) >> 13) * 6144 + 2 * 1024;
        f32x4 gv[2][2];
#pragma unroll
        for (int bj = 0; bj < 2; ++bj)
#pragma unroll
            for (int n = 0; n < 2; ++n) gv[bj][n] = *(const f32x4*)(gate + col0 + bj * 128 + n * 16);
#pragma unroll
        for (int ai = 0; ai < 2; ++ai) {
            f32x4 xv[4][2][2];
#pragma unroll
            for (int m = 0; m < 4; ++m) { const size_t off = (size_t)(row0 + ai * 128 + m * 16) * 1024 + col0;
#pragma unroll
                for (int bj = 0; bj < 2; ++bj)
#pragma unroll
                    for (int n = 0; n < 2; ++n) xv[m][bj][n] = *(const f32x4*)(x + off + bj * 128 + n * 16); }
            __builtin_amdgcn_sched_barrier(0);
#pragma unroll
            for (int m = 0; m < 4; ++m) { const size_t off = (size_t)(row0 + ai * 128 + m * 16) * 1024 + col0;
#pragma unroll
                for (int bj = 0; bj < 2; ++bj)
#pragma unroll
                    for (int n = 0; n < 2; ++n) *(f32x4*)(out + off + bj * 128 + n * 16) = xv[m][bj][n] + gv[bj][n] * acc[ai][bj][m][n]; }
        }
    }
};
struct MoeOrder {
    const PG8_LAS int* tb; const PG8_LAS int* cnt; int G, c;
    __device__ __forceinline__ bool next(int i, Unit& u) const {
        const int L = i * G + c, ntile = tb[32]; if (L >= ntile * 4) return false;
        const int tile = L >> 2; u.pn = L & 3; int e = 0;
#pragma unroll
        for (int s = 16; s >= 1; s >>= 1) if (__builtin_amdgcn_readfirstlane(tb[e + s]) <= tile) e += s;
        u.e = e; u.pm = tile; const int loc = (tile - __builtin_amdgcn_readfirstlane(tb[e])) * 256; u.cnt = __builtin_amdgcn_readfirstlane(cnt[e]) - loc; return true;
    }
};
struct ProbMoe1 : MoeOrder { const bf16_t* A; const bf16_t* Bt; int K; const unsigned* tokk; static constexpr bool GATHER_A = true;
    __device__ __forceinline__ unsigned laneA(int) const { return 0u; }
    __device__ __forceinline__ unsigned laneB(int r) const { return (unsigned)r * 2048u; }
    __device__ __forceinline__ unsigned baseA(const Unit&) const { return 0u; }
    __device__ __forceinline__ unsigned baseB(const Unit& u) const { return (unsigned)(u.e * 1024 + u.pn * 256) * 2048u; }
    __device__ __forceinline__ unsigned gathA(const Unit& u, int r) const { const int loc = (u.pm - __builtin_amdgcn_readfirstlane(tb[u.e])) * 256 + r; const unsigned tk = r < u.cnt ? tokk[(size_t)u.e * LCAP + loc] : 0u; return (tk >> 1) * 2048u; } };
struct EpiMoe1 {
    static constexpr bool PERM = true, PREFETCH = false; bf16_t* hid;
    __device__ __forceinline__ void operator()(const f32x4 (&acc)[2][2][4][2], const Unit& u, int wr, int wc, int fr, int fq, const PG8_LAS float* ex) const {
        const int row0 = u.pm * 256 + wr * 64 + fr, col0 = u.pn * 128 + wc * 32 + 8 * fq;
#pragma unroll
        for (int ai = 0; ai < 2; ++ai)
#pragma unroll
            for (int m = 0; m < 4; ++m) { float hv[8];
#pragma unroll
                for (int n = 0; n < 2; ++n)
#pragma unroll
                    for (int j = 0; j < 4; ++j) { const float g = acc[ai][0][m][n][j], up = acc[ai][1][m][n][j]; hv[n * 4 + j] = g * __builtin_amdgcn_rcpf(1.0f + __expf(-g)) * up; }
                u32x4 w; w.x = cvt_pk_bf16(hv[0], hv[1]); w.y = cvt_pk_bf16(hv[2], hv[3]); w.z = cvt_pk_bf16(hv[4], hv[5]); w.w = cvt_pk_bf16(hv[6], hv[7]);
                *(u32x4*)(hid + (size_t)(row0 + ai * 128 + m * 16) * 512 + col0) = w; }
    }
};
struct ProbMoe2 : MoeOrder { const bf16_t* A; const bf16_t* Bt; int K; static constexpr bool GATHER_A = false;
    __device__ __forceinline__ unsigned laneA(int r) const { return (unsigned)r * 1024u; }
    __device__ __forceinline__ unsigned laneB(int r) const { return (unsigned)r * 1024u; }
    __device__ __forceinline__ unsigned baseA(const Unit& u) const { return (unsigned)(u.pm * 256) * 1024u; }
    __device__ __forceinline__ unsigned baseB(const Unit& u) const { return (unsigned)(u.e * 1024 + u.pn * 256) * 1024u; }
    __device__ __forceinline__ unsigned gathA(const Unit&, int) const { return 0u; } };
struct EpiMoe2 {
    static constexpr bool PERM = true, PREFETCH = true; bf16_t* Y; const unsigned* tokk; const float* wl; const PG8_LAS int* tb;
    __device__ __forceinline__ void prefetch(const Unit& u, PG8_LAS unsigned char* ex, int wid, int lane) const {
        const size_t o = (size_t)u.e * LCAP + (u.pm - __builtin_amdgcn_readfirstlane(tb[u.e])) * 256 + lane * 4;
        if (wid == 0) __builtin_amdgcn_global_load_lds((const unsigned*)(tokk + o), (PG8_LAS unsigned*)ex, 16, 0, 0);
        else if (wid == 1) __builtin_amdgcn_global_load_lds((const unsigned*)(wl + o), (PG8_LAS unsigned*)(ex + 1024), 16, 0, 0);
    }
    __device__ __forceinline__ void operator()(const f32x4 (&acc)[2][2][4][2], const Unit& u, int wr, int wc, int fr, int fq, const PG8_LAS float* ex) const {
        const int col0 = u.pn * 256 + wc * 32 + 8 * fq;
#pragma unroll
        for (int ai = 0; ai < 2; ++ai)
#pragma unroll
            for (int m = 0; m < 4; ++m) { const int r = ai * 128 + wr * 64 + m * 16 + fr;
                if (r < u.cnt) { const unsigned tk = __builtin_bit_cast(unsigned, ex[r]); const float w = ex[256 + r];
                    bf16_t* rowp = Y + ((size_t)(tk & 1u) * NTOK + (tk >> 1)) * 1024 + col0;
#pragma unroll
                    for (int bj = 0; bj < 2; ++bj) { const f32x4 v0 = acc[ai][bj][m][0] * w, v1 = acc[ai][bj][m][1] * w;
                        u32x4 q; q.x = cvt_pk_bf16(v0[0], v0[1]); q.y = cvt_pk_bf16(v0[2], v0[3]); q.z = cvt_pk_bf16(v1[0], v1[1]); q.w = cvt_pk_bf16(v1[2], v1[3]);
                        *(u32x4*)(rowp + bj * 128) = q; } } }
    }
};

typedef int v8i32 __attribute__((ext_vector_type(8)));
typedef int v4i32 __attribute__((ext_vector_type(4)));
constexpr int F8_STAGE = 65536, F8_LDS = 2 * F8_STAGE;
template <class Prob, class Epi>
__device__ __forceinline__ void gemm_f8(PG8_LAS unsigned char* lds, const Prob& G, const Epi& E) {
    int tid_ = threadIdx.x; asm volatile("" : "+v"(tid_));
    const int tid = tid_, wid = __builtin_amdgcn_readfirstlane(tid >> 6), lane = tid & 63, wr = wid >> 2, wc = wid & 3, fr = lane & 15, fq = lane >> 4;
    const int nt = G.KB >> 7;
    int R0, C0; stage_rc(tid * 16, R0, C0);
    const unsigned cb = (unsigned)C0 * 2u, ldsw = (unsigned)wid * 1024u;
    const int aoff = lds_byte(wr * 64 + fr, fq * 8), boff = (wc >> 1) * 16384 + lds_byte((wc & 1) * 64 + fr, fq * 8);
    const char* Ab = (const char*)G.A; const char* Bb = (const char*)G.Bt;
    Unit cur, nxt;
    if (!G.next(0, cur)) return;
    const unsigned lB00 = G.laneB(R0) + cb, lB01 = G.laneB(R0 + 64) + cb, lB10 = G.laneB(128 + R0) + cb, lB11 = G.laneB(192 + R0) + cb;
    unsigned cA00 = G.rowA(cur, R0) + cb, cA01 = G.rowA(cur, R0 + 64) + cb, cA10 = G.rowA(cur, 128 + R0) + cb, cA11 = G.rowA(cur, 192 + R0) + cb;
    unsigned nA00 = cA00, nA01 = cA01, nA10 = cA10, nA11 = cA11;
    unsigned uBc = G.baseB(cur), uBn = uBc;
#define F8_ISSUE(buf, a00, a01, a10, a11, ub, kb) do { PG8_LAS unsigned char* sb_ = lds + (buf) * F8_STAGE + ldsw; \
        __builtin_amdgcn_global_load_lds((const unsigned*)(Ab + (size_t)((a00) + (kb))), (PG8_LAS unsigned*)(sb_), 16, 0, 0); \
        __builtin_amdgcn_global_load_lds((const unsigned*)(Ab + (size_t)((a01) + (kb))), (PG8_LAS unsigned*)(sb_ + 8192), 16, 0, 0); \
        __builtin_amdgcn_global_load_lds((const unsigned*)(Ab + (size_t)((a10) + (kb))), (PG8_LAS unsigned*)(sb_ + 16384), 16, 0, 0); \
        __builtin_amdgcn_global_load_lds((const unsigned*)(Ab + (size_t)((a11) + (kb))), (PG8_LAS unsigned*)(sb_ + 24576), 16, 0, 0); \
        __builtin_amdgcn_global_load_lds((const unsigned*)(Bb + (size_t)(ub) + (size_t)(lB00 + (kb))), (PG8_LAS unsigned*)(sb_ + 32768), 16, 0, 0); \
        __builtin_amdgcn_global_load_lds((const unsigned*)(Bb + (size_t)(ub) + (size_t)(lB01 + (kb))), (PG8_LAS unsigned*)(sb_ + 40960), 16, 0, 0); \
        __builtin_amdgcn_global_load_lds((const unsigned*)(Bb + (size_t)(ub) + (size_t)(lB10 + (kb))), (PG8_LAS unsigned*)(sb_ + 49152), 16, 0, 0); \
        __builtin_amdgcn_global_load_lds((const unsigned*)(Bb + (size_t)(ub) + (size_t)(lB11 + (kb))), (PG8_LAS unsigned*)(sb_ + 57344), 16, 0, 0); } while (0)
    f32x4 acc[2][4][4];
#pragma unroll
    for (int a = 0; a < 2; ++a)
#pragma unroll
        for (int m = 0; m < 4; ++m)
#pragma unroll
            for (int n = 0; n < 4; ++n) acc[a][m][n] = (f32x4){0.f, 0.f, 0.f, 0.f};
    F8_ISSUE(0, cA00, cA01, cA10, cA11, uBc, 0u);
    int g = 0, ui = 0;
    for (;;) {
        const bool has_next = G.next(ui + 1, nxt);
        if (has_next) { nA00 = G.rowA(nxt, R0) + cb; nA01 = G.rowA(nxt, R0 + 64) + cb; nA10 = G.rowA(nxt, 128 + R0) + cb; nA11 = G.rowA(nxt, 192 + R0) + cb; uBn = G.baseB(nxt); }
        else { nA00 = cA00; nA01 = cA01; nA10 = cA10; nA11 = cA11; uBn = uBc; }
#pragma unroll 1
        for (int kt = 0; kt < nt; ++kt) {
            asm volatile("s_waitcnt vmcnt(0)" ::: "memory");
            __builtin_amdgcn_s_barrier();
            asm volatile("" ::: "memory");
            {
                const bool wrap = kt + 1 >= nt; const unsigned kb = wrap ? 0u : (unsigned)(kt + 1) * 128u;
                const unsigned a00 = wrap ? nA00 : cA00, a01 = wrap ? nA01 : cA01, a10 = wrap ? nA10 : cA10, a11 = wrap ? nA11 : cA11, ub = wrap ? uBn : uBc;
                F8_ISSUE((g + 1) & 1, a00, a01, a10, a11, ub, kb);
            }
            PG8_LAS unsigned char* st = lds + (g & 1) * F8_STAGE;
            v8i32 B8[4];
#pragma unroll
            for (int n = 0; n < 4; ++n) { const v4i32 lo = *(const PG8_LAS v4i32*)(st + 32768 + boff + n * 2048), hi = *(const PG8_LAS v4i32*)(st + 32768 + boff + n * 2048 + 1024);
                B8[n] = __builtin_shufflevector(lo, hi, 0, 1, 2, 3, 4, 5, 6, 7); }
#pragma unroll
            for (int ai = 0; ai < 2; ++ai) {
                v8i32 A8[4];
#pragma unroll
                for (int m = 0; m < 4; ++m) { const v4i32 lo = *(const PG8_LAS v4i32*)(st + ai * 16384 + aoff + m * 2048), hi = *(const PG8_LAS v4i32*)(st + ai * 16384 + aoff + m * 2048 + 1024);
                    A8[m] = __builtin_shufflevector(lo, hi, 0, 1, 2, 3, 4, 5, 6, 7); }
                asm volatile("s_waitcnt lgkmcnt(0)" ::: "memory");
                __builtin_amdgcn_s_setprio(1);
#pragma unroll
                for (int m = 0; m < 4; ++m)
#pragma unroll
                    for (int n = 0; n < 4; ++n) acc[ai][m][n] = __builtin_amdgcn_mfma_scale_f32_16x16x128_f8f6f4(B8[n], A8[m], acc[ai][m][n], 0, 0, 0, 0, 0, 0);
                __builtin_amdgcn_s_setprio(0);
            }
            ++g;
        }
        E(acc, cur, wr, wc, fr, fq);
        if (!has_next) break;
#pragma unroll
        for (int a = 0; a < 2; ++a)
#pragma unroll
            for (int m = 0; m < 4; ++m)
#pragma unroll
                for (int n = 0; n < 4; ++n) acc[a][m][n] = (f32x4){0.f, 0.f, 0.f, 0.f};
        cur = nxt; ++ui; cA00 = nA00; cA01 = nA01; cA10 = nA10; cA11 = nA11; uBc = uBn;
    }
    asm volatile("s_waitcnt vmcnt(0)" ::: "memory");
    __builtin_amdgcn_s_barrier();
#undef F8_ISSUE
}
struct MoeOrder8 {
    const PG8_LAS int* tb; const PG8_LAS int* cnt; int G, c;
    __device__ __forceinline__ bool next(int i, Unit& u) const {
        const int ntile = __builtin_amdgcn_readfirstlane(tb[32]), xj = c >> 3, tile = i * (G >> 2) + (c & 7) * (G >> 5) + (xj >> 2); if (tile >= ntile) return false;
        u.pn = xj & 3; int e = 0;
#pragma unroll
        for (int s = 16; s >= 1; s >>= 1) if (__builtin_amdgcn_readfirstlane(tb[e + s]) <= tile) e += s;
        u.e = e; u.pm = tile; const int loc = (tile - __builtin_amdgcn_readfirstlane(tb[e])) * 256; u.cnt = __builtin_amdgcn_readfirstlane(cnt[e]) - loc; return true;
    }
};
struct ProbMoe1F8 : MoeOrder8 { const unsigned char* A; const unsigned char* Bt; int KB; const unsigned* tokk;
    __device__ __forceinline__ unsigned laneB(int r) const { return (unsigned)r * 1024u; }
    __device__ __forceinline__ unsigned baseB(const Unit& u) const { return (unsigned)((u.e * 4 + u.pn) * 256) * 1024u; }
    __device__ __forceinline__ unsigned rowA(const Unit& u, int r) const { const int loc = (u.pm - __builtin_amdgcn_readfirstlane(tb[u.e])) * 256 + r; const unsigned tk = r < u.cnt ? tokk[(size_t)u.e * LCAP + loc] : 0u; return (tk >> 1) * 1024u; } };
struct EpiMoe1F8 {
    unsigned char* hid;
    __device__ __forceinline__ void operator()(const f32x4 (&acc)[2][4][4], const Unit& u, int wr, int wc, int fr, int fq) const {
        const int row0 = u.pm * 256 + wr * 64 + fr, col0 = u.pn * 128 + wc * 32 + fq * 4;
#pragma unroll
        for (int ai = 0; ai < 2; ++ai)
#pragma unroll
            for (int m = 0; m < 4; ++m)
#pragma unroll
                for (int n2 = 0; n2 < 2; ++n2) { float hv[4];
#pragma unroll
                    for (int j = 0; j < 4; ++j) { const float g = acc[ai][m][n2][j] * 0.03125f, up = acc[ai][m][2 + n2][j] * 0.03125f; hv[j] = g * __builtin_amdgcn_rcpf(1.0f + __expf(-g)) * up; }
                    *(unsigned*)(hid + (size_t)(row0 + ai * 128 + m * 16) * 512 + col0 + n2 * 16) = pk4_fp8(hv[0], hv[1], hv[2], hv[3]); }
    }
};
struct ProbMoe2F8 : MoeOrder8 { const unsigned char* A; const unsigned char* Bt; int KB;
    __device__ __forceinline__ unsigned laneB(int r) const { return (unsigned)r * 512u; }
    __device__ __forceinline__ unsigned baseB(const Unit& u) const { return (unsigned)(u.e * 1024 + u.pn * 256) * 512u; }
    __device__ __forceinline__ unsigned rowA(const Unit& u, int r) const { return (unsigned)(u.pm * 256 + r) * 512u; } };
struct EpiMoe2F8 {
    bf16_t* Y; const unsigned* tokk; const float* wl; const PG8_LAS int* tb;
    __device__ __forceinline__ void operator()(const f32x4 (&acc)[2][4][4], const Unit& u, int wr, int wc, int fr, int fq) const {
        const int col0 = u.pn * 256 + wc * 64 + 4 * fq, locb = (u.pm - __builtin_amdgcn_readfirstlane(tb[u.e])) * 256;
#pragma unroll
        for (int ai = 0; ai < 2; ++ai)
#pragma unroll
            for (int m = 0; m < 4; ++m) { const int r = ai * 128 + wr * 64 + m * 16 + fr;
                if (r < u.cnt) { const unsigned tk = tokk[(size_t)u.e * LCAP + locb + r]; const float w = wl[(size_t)u.e * LCAP + locb + r] * 0.03125f;
                    bf16_t* rowp = Y + ((size_t)(tk & 1u) * NTOK + (tk >> 1)) * 1024 + col0;
#pragma unroll
                    for (int n = 0; n < 4; ++n) { const f32x4 v = acc[ai][m][n] * w; u32x2 q; q[0] = cvt_pk_bf16(v[0], v[1]); q[1] = cvt_pk_bf16(v[2], v[3]); *(u32x2*)(rowp + n * 16) = q; } } }
    }
};
}
#endif

DEV void conv_row_compute(const Params& P, const bf16_t* ring, const float* wts, int s0, int s1, int s2, int ntap_rows, int slab, bf16_t* dst, int tid) {
    const int cq = tid & 31, tg = tid >> 5;
    typedef float f32x2 __attribute__((ext_vector_type(2)));
    f32x2 acc2[4][2];
#pragma unroll
    for (int t = 0; t < 4; ++t) { acc2[t][0] = (f32x2){0.f, 0.f}; acc2[t][1] = (f32x2){0.f, 0.f}; }
#pragma unroll
    for (int ky = 0; ky < 3; ++ky) {
        if (ntap_rows == 1 && ky != 1) continue;
        const int sl = ky == 0 ? s0 : ky == 1 ? s1 : s2;
        f32x2 w[3][2];
#pragma unroll
        for (int kx = 0; kx < 3; ++kx) { const f32x4 t = *(const f32x4*)(wts + (ky * 3 + kx) * 128 + cq * 4); w[kx][0] = (f32x2){t[0], t[1]}; w[kx][1] = (f32x2){t[2], t[3]}; }
        f32x2 in[6][2];
#pragma unroll
        for (int pos = 0; pos < 6; ++pos) { const u32x2 v = *(const u32x2*)(ring + sl * 8448 + (tg * 4 + pos) * 128 + cq * 4);
            in[pos][0] = (f32x2){__builtin_bit_cast(float, v[0] << 16), __builtin_bit_cast(float, v[0] & 0xffff0000u)}; in[pos][1] = (f32x2){__builtin_bit_cast(float, v[1] << 16), __builtin_bit_cast(float, v[1] & 0xffff0000u)}; }
#pragma unroll
        for (int t = 0; t < 4; ++t)
#pragma unroll
            for (int kx = 0; kx < 3; ++kx) { acc2[t][0] += w[kx][0] * in[t + kx][0]; acc2[t][1] += w[kx][1] * in[t + kx][1]; }
    }
    float acc[4][4];
#pragma unroll
    for (int t = 0; t < 4; ++t) { acc[t][0] = acc2[t][0][0]; acc[t][1] = acc2[t][0][1]; acc[t][2] = acc2[t][1][0]; acc[t][3] = acc2[t][1][1]; }
#pragma unroll
    for (int t = 0; t < 4; ++t) {
        float ss = 0.f;
#pragma unroll
        for (int c = 0; c < 4; ++c) { acc[t][c] = silu_f(acc[t][c]); ss += acc[t][c] * acc[t][c]; }
        if (slab < 8) { ss += shfl_xor_f(ss, 1); ss += shfl_xor_f(ss, 2); ss += shfl_xor_f(ss, 4); ss += shfl_xor_f(ss, 8); ss += shfl_xor_f(ss, 16); const float sc = rsq_f(ss + EPS);
#pragma unroll
            for (int c = 0; c < 4; ++c) acc[t][c] *= sc; }
        u32x2 o; o[0] = pk2(acc[t][0], acc[t][1]); o[1] = pk2(acc[t][2], acc[t][3]);
        *(u32x2*)(dst + (size_t)(tg * 4 + t) * 1536 + cq * 4) = o;
    }
}

DEV void phase3_conv(const Params& P, unsigned char* sm) {
    PHASE_TID;
    const bf16_t* p = (const bf16_t*)(P.ws + WS_R4 + R4_P);
    bf16_t* qkvn = (bf16_t*)(P.ws + WS_R3);
    bf16_t* ring = (bf16_t*)sm;
    float* wts = (float*)(sm + 3 * 16896);
    const u32x4 zero4 = (u32x4){0u, 0u, 0u, 0u};
    for (int it = BID; it < NB * 12 * 8; it += NBLK) {
        const int slab = it % 12, yb = (it / 12) & 7, b = it / 96, y0 = yb * 16;
        const bf16_t* src = p + (size_t)(b * SEQ) * 2048 + slab * 128;
        if (TID < 96) { const int sl = TID / 32, w = TID & 31, cc = (w >> 4) * 65, pc = w & 15; *(u32x4*)(ring + sl * 8448 + cc * 128 + pc * 8) = zero4; }
        if (TID < 288) *(f32x4*)(wts + TID * 4) = *(const f32x4*)(P.conv_w + (size_t)(TID >> 5) * 1536 + slab * 128 + (TID & 31) * 4);
        const int tk0 = TID >> 4, pc = TID & 15;
        u32x4 rr[4][2];
#define CV_LOAD(set, y) do { const bool ok_ = (y) >= 0 && (y) < 128; const int yc_ = ok_ ? (y) : y0;        \
            const u32x4 t0_ = *(const u32x4*)(src + (size_t)(yc_ * 64 + tk0) * 2048 + pc * 8), t1_ = *(const u32x4*)(src + (size_t)(yc_ * 64 + tk0 + 32) * 2048 + pc * 8); \
            rr[set][0] = ok_ ? t0_ : zero4; rr[set][1] = ok_ ? t1_ : zero4; } while (0)
#define CV_STORE(set, slot) do { *(u32x4*)(ring + (slot) * 8448 + (tk0 + 1) * 128 + pc * 8) = rr[set][0]; *(u32x4*)(ring + (slot) * 8448 + (tk0 + 33) * 128 + pc * 8) = rr[set][1]; } while (0)
        CV_LOAD(0, y0 - 1); CV_LOAD(1, y0); CV_LOAD(2, y0 + 1); CV_LOAD(3, y0 + 2);
        CV_STORE(0, 0); CV_STORE(1, 1);
        CV_LOAD(0, y0 + 3);
#pragma unroll 1
        for (int y4 = 0; y4 < 16; y4 += 4) {
#pragma unroll
            for (int u = 0; u < 4; ++u) {
                const int yy = y4 + u;
                const int s0 = yy % 3, s1 = (yy + 1) % 3, s2 = (yy + 2) % 3;
                CV_STORE((u + 2) & 3, s2);
                SYNC();
                CV_LOAD((u + 1) & 3, (yy + 4 <= 16) ? y0 + yy + 4 : 999);
                conv_row_compute(P, ring, wts, s0, s1, s2, 3, slab, qkvn + (size_t)(b * SEQ + (y0 + yy) * 64) * 1536 + slab * 128, TID);
                SYNC();
            }
        }
#undef CV_LOAD
#undef CV_STORE
    }
    for (int it = BID; it < NB * 12 * 4; it += NBLK) {
        const int slab = it % 12, sg = (it / 12) & 3, b = it / 48;
        const bf16_t* src = p + (size_t)(NTOK + b * CTX) * 2048 + slab * 128;
        if (TID < 288) *(f32x4*)(wts + TID * 4) = *(const f32x4*)(P.conv_w + (size_t)(TID >> 5) * 1536 + slab * 128 + (TID & 31) * 4);
        u32x4 r[3];
#pragma unroll
        for (int q = 0; q < 3; ++q) { const int idx = TID + q * 512; r[q] = zero4;
            if (idx < 66 * 16) { const int cc = idx >> 4, pc = idx & 15, tok = sg * 64 + cc - 1; if (tok >= 0 && tok < CTX) r[q] = *(const u32x4*)(src + (size_t)tok * 2048 + pc * 8); } }
#pragma unroll
        for (int q = 0; q < 3; ++q) { const int idx = TID + q * 512; if (idx < 66 * 16) { const int cc = idx >> 4, pc = idx & 15; *(u32x4*)(ring + 1 * 8448 + cc * 128 + pc * 8) = r[q]; } }
        SYNC();
        conv_row_compute(P, ring, wts, 0, 1, 2, 1, slab, qkvn + (size_t)(NTOK + b * CTX + sg * 64) * 1536 + slab * 128, TID);
        SYNC();
    }
}

constexpr int L_K = 0, L_Q = 17408, L_V = 34816, L_KTR = 52224, L_VT = 70656, L_X0F = 89088, L_X0TF = 98304, L_TTF = 107520, L_X0B = 116736, L_X0TB = 125952, L_TTB = 135168, L_GC = 144384, L_SCAL = 161824;
constexpr int L_X1F = 0, L_X1TF = 9216, L_X1B = 18432, L_X1TB = 27648, L_WF = 0, L_WB = 17408, L_AF = 145440, L_AB = 153632;

DEV int chunk_row(int chain, int step, int i) {
    const int b = chain >> 3, dir = chain & 1;
    if (step < 4) { const int pos = step * 64 + i; return NTOK + b * CTX + (dir ? (CTX - 1 - pos) : pos); }
    const int pos = (step - 4) * 64 + i; return b * SEQ + (dir ? (SEQ - 1 - pos) : pos);
}

DEV int img_piece_A(int row, int col0) { return (((row >> 4) * 2 + (col0 >> 5)) * 64 + ((col0 & 31) >> 3) * 16 + (row & 15)) * 16 + ((col0 >> 2) & 1) * 8; }
DEV int img_piece_W(int row, int d0) { return (((row >> 4) * 4 + (d0 >> 5)) * 64 + ((d0 & 31) >> 3) * 16 + (row & 15)) * 16; }

DEV void phase4_prepass(const Params& P, unsigned char* sm) {
    PHASE_TID;
    const bf16_t* qkvn = (const bf16_t*)(P.ws + WS_R3);
    const float* gb = (const float*)(P.ws + WS_GB);
    unsigned char* images = P.ws + WS_R4;
    bf16_t* Ks = (bf16_t*)(sm + L_K); bf16_t* Qs = (bf16_t*)(sm + L_Q); bf16_t* Vs = (bf16_t*)(sm + L_V); bf16_t* KTR = (bf16_t*)(sm + L_KTR); bf16_t* VT = (bf16_t*)(sm + L_VT);
    float* gcf = (float*)(sm + L_GC); float* gcb = gcf + 64; float* btf = gcf + 128; float* btb = gcf + 192;
    const float QSCALE = 0.08838834764831845f;
    const f32x4 z4 = (f32x4){0.f, 0.f, 0.f, 0.f};
    u32x4 pf[6]; float gfp, bfp, gbp, bbp, gbr;
#define PP_ROW0(it_) ((((it_) % NSTEP) < 4) ? NTOK + ((it_) / NSTEP / 4) * CTX + ((it_) % NSTEP) * 64 : ((it_) / NSTEP / 4) * SEQ + (((it_) % NSTEP) - 4) * 64)
#define PP_LOAD(it_) do { const int row0_ = PP_ROW0(it_), h_ = ((it_) / NSTEP) & 3; \
        _Pragma("unroll") for (int q = 0; q < 6; ++q) { const int idx = TID + q * 512, piece = idx & 15, i = (idx >> 4) & 63, which = idx >> 10; \
            pf[q] = *(const u32x4*)(qkvn + (size_t)(row0_ + i) * 1536 + which * 512 + h_ * 128 + piece * 8); } \
        { const int ln_ = TID & 63; const float* gr = gb + (size_t)(row0_ + ln_) * 16; gfp = gr[8 + h_]; bfp = gr[h_]; gbp = gr[12 + h_]; bbp = gr[4 + h_]; gbr = gb[(size_t)(row0_ + 63 - ln_) * 16 + 12 + h_]; } } while (0)
    const int NIT = NB * 4 * NSTEP;
    int it = BID;
    if (it < NIT) PP_LOAD(it);
    for (; it < NIT; it += NBLK) {
        int tq_ = TID;
#ifndef CPU_EMU
        asm volatile("" : "+v"(tq_));
#endif
        const int wid = tq_ >> 6, lane = tq_ & 63, fr = lane & 15, fq = lane >> 4;
        const int bh = it / NSTEP, st = it - bh * NSTEP;
        const int stb = st < 4 ? 3 - st : 4 + (127 - (st - 4));
        unsigned char* imgf = images + ((size_t)(bh * 2) * NSTEP + st) * IMG_BYTES;
        unsigned char* imgb = images + ((size_t)(bh * 2 + 1) * NSTEP + stb) * IMG_BYTES;
#pragma unroll
        for (int q = 0; q < 6; ++q) { const int idx = TID + q * 512, piece = idx & 15, i = (idx >> 4) & 63, which = idx >> 10;
            *(u32x4*)((which == 0 ? Qs : which == 1 ? Ks : Vs) + i * 136 + piece * 8) = pf[q]; }
        if (wid == 0) { float g = gfp;
#pragma unroll
            for (int o = 1; o < 64; o <<= 1) { const float t = shfl_up_f(g, o); if (lane >= o) g += t; }
            gcf[lane] = g; btf[lane] = bfp; }
        if (wid == 1) { float g = gbr;
#pragma unroll
            for (int o = 1; o < 64; o <<= 1) { const float t = shfl_up_f(g, o); if (lane >= o) g += t; }
            gcb[63 - lane] = g; btb[lane] = bbp; }
        { const int nx = (it + NBLK < NIT) ? it + NBLK : it; PP_LOAD(nx); }
        SYNC();
        const float glf = gcf[63], glb = gcb[0];
        bf16_t* X0F = (bf16_t*)(sm + L_X0F); bf16_t* X0TF = (bf16_t*)(sm + L_X0TF); bf16_t* TTF = (bf16_t*)(sm + L_TTF);
        bf16_t* X0B = (bf16_t*)(sm + L_X0B); bf16_t* X0TB = (bf16_t*)(sm + L_X0TB); bf16_t* TTB = (bf16_t*)(sm + L_TTB);
        f32x4 TregF[2], TTregF[2], TregB[2], TTregB[2];
#pragma unroll
        for (int tt = 0; tt < 2; ++tt) {
            const int t = wid * 2 + tt, ti = t >> 2, tj = t & 3;
            f32x4 kk = z4, kkT = z4, qkT = z4;
#pragma unroll
            for (int ks = 0; ks < 4; ++ks) {
                const bf16x8 fKi = frag16(Ks + (ti * 16 + fr) * 136 + ks * 32 + fq * 8), fKj = frag16(Ks + (tj * 16 + fr) * 136 + ks * 32 + fq * 8), fQi = frag16(Qs + (ti * 16 + fr) * 136 + ks * 32 + fq * 8);
                kk = mfma16(fKi, fKj, kk); kkT = mfma16(fKj, fKi, kkT); qkT = mfma16(fKj, fQi, qkT);
            }
            {
              const int j = tj * 16 + fr; const float gfj = gcf[j], gbj = gcb[j]; float mf[4], mb_[4];
#pragma unroll
              for (int r = 0; r < 4; ++r) { const int i = ti * 16 + fq * 4 + r;
                  const float ef = __expf(fminf(gcf[i] - gfj, 0.f)) * btf[i] * kk[r], eb = __expf(fminf(gcb[i] - gbj, 0.f)) * btb[i] * kk[r];
                  mf[r] = (i > j) ? ef : 0.f; TregF[tt][r] = (i == j ? 1.0f : 0.0f) - mf[r];
                  mb_[r] = (i < j) ? eb : 0.f; TregB[tt][r] = (i == j ? 1.0f : 0.0f) - mb_[r]; }
              u32x2 w; const int o_ = j * 72 + ti * 16 + fq * 4;
              w[0] = pk2(mf[0], mf[1]); w[1] = pk2(mf[2], mf[3]); *(u32x2*)(X0TF + o_) = w;
              w[0] = pk2(TregF[tt][0], TregF[tt][1]); w[1] = pk2(TregF[tt][2], TregF[tt][3]); *(u32x2*)(TTF + o_) = w;
              w[0] = pk2(mb_[0], mb_[1]); w[1] = pk2(mb_[2], mb_[3]); *(u32x2*)(X0TB + o_) = w;
              w[0] = pk2(TregB[tt][0], TregB[tt][1]); w[1] = pk2(TregB[tt][2], TregB[tt][3]); *(u32x2*)(TTB + o_) = w; }
            SCHED_FENCE();
            {
              const int i = ti * 16 + fr, j0 = tj * 16 + fq * 4; const float gfi = gcf[i], gbi = gcb[i], bfi = btf[i], bbi = btb[i]; float mf[4], af[4], mb_[4], ab[4];
#pragma unroll
              for (int r = 0; r < 4; ++r) { const int j = j0 + r;
                  const float ef = __expf(fminf(gfi - gcf[j], 0.f)), eb = __expf(fminf(gbi - gcb[j], 0.f));
                  const float df = (i >= j) ? ef : 0.f, db = (i <= j) ? eb : 0.f;
                  mf[r] = (i > j) ? bfi * kkT[r] * ef : 0.f; TTregF[tt][r] = (i == j ? 1.0f : 0.0f) - mf[r]; af[r] = qkT[r] * QSCALE * df;
                  mb_[r] = (i < j) ? bbi * kkT[r] * eb : 0.f; TTregB[tt][r] = (i == j ? 1.0f : 0.0f) - mb_[r]; ab[r] = qkT[r] * QSCALE * db; }
              u32x2 w; const int o_ = i * 72 + j0;
              w[0] = pk2(mf[0], mf[1]); w[1] = pk2(mf[2], mf[3]); *(u32x2*)(X0F + o_) = w;
              w[0] = pk2(mb_[0], mb_[1]); w[1] = pk2(mb_[2], mb_[3]); *(u32x2*)(X0B + o_) = w;
              w[0] = pk2(af[0], af[1]); w[1] = pk2(af[2], af[3]); *(u32x2*)((bf16_t*)(sm + L_AF) + i * 64 + j0) = w;
              w[0] = pk2(ab[3], ab[2]); w[1] = pk2(ab[1], ab[0]); *(u32x2*)((bf16_t*)(sm + L_AB) + (63 - i) * 64 + 60 - j0) = w; }
            SCHED_FENCE();
        }
        if (TID < 64) { float* sf = (float*)(sm + L_SCAL), *sb = (float*)(sm + L_SCAL + 288);
            sf[4 + TID] = QSCALE * __expf(gcf[TID]); sb[4 + TID] = QSCALE * __expf(gcb[63 - TID]); }
        {
            const int dcol = wid * 16 + fr, ks = wid >> 1;
            bf16x8 idf;
#pragma unroll
            for (int j = 0; j < 8; ++j) idf[j] = (dcol == ks * 32 + fq * 8 + j) ? (short)0x3F80 : (short)0;
#pragma unroll
            for (int t4 = 0; t4 < 4; ++t4) {
                const f32x4 kt = mfma16(frag16(Ks + (t4 * 16 + fr) * 136 + ks * 32 + fq * 8), idf, z4);
                const f32x4 vt = mfma16(frag16(Vs + (t4 * 16 + fr) * 136 + ks * 32 + fq * 8), idf, z4);
                const int tok = t4 * 16 + fq * 4;
                u32x2 w; w[0] = pk2(kt[0], kt[1]); w[1] = pk2(kt[2], kt[3]); *(u32x2*)(KTR + dcol * 72 + tok) = w;
                w[0] = pk2(vt[0], vt[1]); w[1] = pk2(vt[2], vt[3]); *(u32x2*)(VT + dcol * 72 + tok) = w;
                SCHED_FENCE();
            }
        }
        SYNC();
#pragma unroll 1
        for (int s5 = 0; s5 < 5; ++s5) {
            const bf16_t* PcF = (bf16_t*)(sm + ((s5 & 1) ? L_X1F : L_X0F)); const bf16_t* PcTF = (bf16_t*)(sm + ((s5 & 1) ? L_X1TF : L_X0TF));
            bf16_t* PnF = (bf16_t*)(sm + ((s5 & 1) ? L_X0F : L_X1F)); bf16_t* PnTF = (bf16_t*)(sm + ((s5 & 1) ? L_X0TF : L_X1TF));
            const bf16_t* PcB = (bf16_t*)(sm + ((s5 & 1) ? L_X1B : L_X0B)); const bf16_t* PcTB = (bf16_t*)(sm + ((s5 & 1) ? L_X1TB : L_X0TB));
            bf16_t* PnB = (bf16_t*)(sm + ((s5 & 1) ? L_X0B : L_X1B)); bf16_t* PnTB = (bf16_t*)(sm + ((s5 & 1) ? L_X0TB : L_X1TB));
#pragma unroll
            for (int tt = 0; tt < 2; ++tt) {
                const int t = wid * 2 + tt, ti = t >> 2, tj = t & 3;
                f32x4 p2 = z4, p2T = z4, q2 = z4, q2T = z4;
#pragma unroll
                for (int ks = 0; ks < 2; ++ks) { const int oa = (ti * 16 + fr) * 72 + ks * 32 + fq * 8, ob = (tj * 16 + fr) * 72 + ks * 32 + fq * 8;
                    const bf16x8 a = frag16(PcF + oa), b = frag16(PcTF + ob), c = frag16(PcB + oa), d = frag16(PcTB + ob);
                    p2 = mfma16(a, b, p2); p2T = mfma16(b, a, p2T); q2 = mfma16(c, d, q2); q2T = mfma16(d, c, q2T); }
                u32x2 w; const int oT = (tj * 16 + fr) * 72 + ti * 16 + fq * 4, oN = (ti * 16 + fr) * 72 + tj * 16 + fq * 4;
                w[0] = pk2(p2[0], p2[1]); w[1] = pk2(p2[2], p2[3]); *(u32x2*)(PnTF + oT) = w;
                w[0] = pk2(p2T[0], p2T[1]); w[1] = pk2(p2T[2], p2T[3]); *(u32x2*)(PnF + oN) = w;
                w[0] = pk2(q2[0], q2[1]); w[1] = pk2(q2[2], q2[3]); *(u32x2*)(PnTB + oT) = w;
                w[0] = pk2(q2T[0], q2T[1]); w[1] = pk2(q2T[2], q2T[3]); *(u32x2*)(PnB + oN) = w;
            }
            SYNC();
#pragma unroll
            for (int tt = 0; tt < 2; ++tt) {
                const int t = wid * 2 + tt, ti = t >> 2, tj = t & 3;
#pragma unroll
                for (int ks = 0; ks < 2; ++ks) { const int oa = (ti * 16 + fr) * 72 + ks * 32 + fq * 8, ob = (tj * 16 + fr) * 72 + ks * 32 + fq * 8;
                    const bf16x8 a = frag16(PnF + oa), b = frag16(TTF + ob), c = frag16(PnB + oa), d = frag16(TTB + ob);
                    TregF[tt] = mfma16(a, b, TregF[tt]); TTregF[tt] = mfma16(b, a, TTregF[tt]); TregB[tt] = mfma16(c, d, TregB[tt]); TTregB[tt] = mfma16(d, c, TTregB[tt]); }
            }
            SYNC();
            if (s5 < 4) {
#pragma unroll
                for (int tt = 0; tt < 2; ++tt) { const int t = wid * 2 + tt, ti = t >> 2, tj = t & 3, oT = (tj * 16 + fr) * 72 + ti * 16 + fq * 4;
                    u32x2 w; w[0] = pk2(TregF[tt][0], TregF[tt][1]); w[1] = pk2(TregF[tt][2], TregF[tt][3]); *(u32x2*)(TTF + oT) = w;
                    w[0] = pk2(TregB[tt][0], TregB[tt][1]); w[1] = pk2(TregB[tt][2], TregB[tt][3]); *(u32x2*)(TTB + oT) = w; }
            }
        }
#pragma unroll
        for (int tt = 0; tt < 2; ++tt) {
            const int t = wid * 2 + tt, ti = t >> 2, tj = t & 3, i = ti * 16 + fr, j0 = tj * 16 + fq * 4;
            const f32x4 bq = *(const f32x4*)(btf + j0), gq = *(const f32x4*)(gcf + j0), cq = *(const f32x4*)(btb + j0), hq = *(const f32x4*)(gcb + j0);
            float tu[4], tw[4], su[4], sw[4];
#pragma unroll
            for (int r = 0; r < 4; ++r) { tu[r] = TTregF[tt][r] * bq[r]; tw[r] = tu[r] * __expf(gq[r]); su[r] = TTregB[tt][r] * cq[r]; sw[r] = su[r] * __expf(hq[r]); }
            u32x2 w; const int o_ = i * 72 + j0;
            w[0] = pk2(tu[0], tu[1]); w[1] = pk2(tu[2], tu[3]); *(u32x2*)(X0F + o_) = w;
            w[0] = pk2(tw[0], tw[1]); w[1] = pk2(tw[2], tw[3]); *(u32x2*)(X0TF + o_) = w;
            w[0] = pk2(su[0], su[1]); w[1] = pk2(su[2], su[3]); *(u32x2*)(X0B + o_) = w;
            w[0] = pk2(sw[0], sw[1]); w[1] = pk2(sw[2], sw[3]); *(u32x2*)(X0TB + o_) = w;
        }
        if (TID == 0) { float* scp = (float*)(sm + L_SCAL); scp[0] = __expf(glf); scp[1] = 0.f; scp[2] = 0.f; scp[3] = 0.f; scp[72] = __expf(glb); scp[73] = 0.f; scp[74] = 0.f; scp[75] = 0.f; }
        SYNC();
        bf16_t* WF = (bf16_t*)(sm + L_WF); bf16_t* WB = (bf16_t*)(sm + L_WB);
#pragma unroll
        for (int i4 = 0; i4 < 4; ++i4) {
            f32x4 uf = z4, wf = z4, ub = z4, wb = z4;
#pragma unroll
            for (int ks = 0; ks < 2; ++ks) {
                const bf16x8 av = frag16(VT + (wid * 16 + fr) * 72 + ks * 32 + fq * 8), ak = frag16(KTR + (wid * 16 + fr) * 72 + ks * 32 + fq * 8);
                const int ot = (i4 * 16 + fr) * 72 + ks * 32 + fq * 8;
                uf = mfma16(frag16(X0F + ot), av, uf); wf = mfma16(ak, frag16(X0TF + ot), wf); ub = mfma16(frag16(X0B + ot), av, ub); wb = mfma16(ak, frag16(X0TB + ot), wb);
            }
            u32x2 w; w[0] = pk2(uf[0], uf[1]); w[1] = pk2(uf[2], uf[3]); *(u32x2*)(imgf + IMG_U + ((wid * 4 + i4) * 64 + lane) * 8) = w;
            w[0] = pk2(ub[3], ub[2]); w[1] = pk2(ub[1], ub[0]); *(u32x2*)(imgb + IMG_U + ((wid * 4 + (3 - i4)) * 64 + (3 - fq) * 16 + fr) * 8) = w;
            const int i = i4 * 16 + fr, c = wid * 16 + fq * 4;
            w[0] = pk2(wf[0], wf[1]); w[1] = pk2(wf[2], wf[3]); *(u32x2*)(WF + i * 136 + c) = w;
            w[0] = pk2(wb[0], wb[1]); w[1] = pk2(wb[2], wb[3]); *(u32x2*)(WB + (63 - i) * 136 + c) = w;
        }
        SYNC();
#pragma unroll
        for (int q = 0; q < 5; ++q) { int pc = TID + q * 512; pc = pc < 2082 ? pc : 2081;
            const int sp = pc - 2048, dirb = pc >= 2048 ? (sp >= 17) : (pc >> 10), p = pc & 1023, mt = p >> 8, ks = (p >> 6) & 3, ln = p & 63;
            const int so = pc >= 2048 ? L_SCAL + dirb * 288 + (sp - dirb * 17) * 16 : (dirb ? L_WB : L_WF) + ((mt * 16 + (ln & 15)) * 136 + ks * 32 + (ln >> 4) * 8) * 2;
            const int dofs = pc >= 2048 ? IMG_SC + (sp - dirb * 17) * 16 : IMG_W + p * 16;
            *(u32x4*)((dirb ? imgb : imgf) + dofs) = *(const u32x4*)(sm + so); }
#pragma unroll
        for (int q = 0; q < 2; ++q) { const int p = TID + q * 512, d = (p >> 7) * 16 + (p & 15), p0 = ((p >> 6) & 1) * 32 + ((p >> 4) & 3) * 8;
            { const u32x4 v = *(const u32x4*)(KTR + d * 72 + p0); const f32x4 g0 = *(const f32x4*)(gcf + p0), g1 = *(const f32x4*)(gcf + p0 + 4); u32x4 o;
              o[0] = pk2(__builtin_bit_cast(float, v[0] << 16) * __expf(glf - g0[0]), __builtin_bit_cast(float, v[0] & 0xffff0000u) * __expf(glf - g0[1]));
              o[1] = pk2(__builtin_bit_cast(float, v[1] << 16) * __expf(glf - g0[2]), __builtin_bit_cast(float, v[1] & 0xffff0000u) * __expf(glf - g0[3]));
              o[2] = pk2(__builtin_bit_cast(float, v[2] << 16) * __expf(glf - g1[0]), __builtin_bit_cast(float, v[2] & 0xffff0000u) * __expf(glf - g1[1]));
              o[3] = pk2(__builtin_bit_cast(float, v[3] << 16) * __expf(glf - g1[2]), __builtin_bit_cast(float, v[3] & 0xffff0000u) * __expf(glf - g1[3]));
              *(u32x4*)(imgf + IMG_KT + p * 16) = o; }
            { const int t0 = 56 - p0;
              const u32x4 v = *(const u32x4*)(KTR + d * 72 + t0); const f32x4 g0 = *(const f32x4*)(gcb + t0), g1 = *(const f32x4*)(gcb + t0 + 4); u32x4 o;
              o[0] = pk2(__builtin_bit_cast(float, v[3] & 0xffff0000u) * __expf(glb - g1[3]), __builtin_bit_cast(float, v[3] << 16) * __expf(glb - g1[2]));
              o[1] = pk2(__builtin_bit_cast(float, v[2] & 0xffff0000u) * __expf(glb - g1[1]), __builtin_bit_cast(float, v[2] << 16) * __expf(glb - g1[0]));
              o[2] = pk2(__builtin_bit_cast(float, v[1] & 0xffff0000u) * __expf(glb - g0[3]), __builtin_bit_cast(float, v[1] << 16) * __expf(glb - g0[2]));
              o[3] = pk2(__builtin_bit_cast(float, v[0] & 0xffff0000u) * __expf(glb - g0[1]), __builtin_bit_cast(float, v[0] << 16) * __expf(glb - g0[0]));
              *(u32x4*)(imgb + IMG_KT + p * 16) = o; } }
        { const int p = TID, row = (p >> 7) * 16 + (p & 15), c0 = ((p >> 6) & 1) * 32 + ((p >> 4) & 3) * 8;
          *(u32x4*)(imgf + IMG_A + p * 16) = *(const u32x4*)((const bf16_t*)(sm + L_AF) + row * 64 + c0);
          *(u32x4*)(imgb + IMG_A + p * 16) = *(const u32x4*)((const bf16_t*)(sm + L_AB) + row * 64 + c0); }
        SYNC();
    }
#undef PP_LOAD
#undef PP_ROW0
}

DEV void phase4_fft(const Params& P, unsigned char* sm) {
    PHASE_TID;
    const bf16_t* GT = (const bf16_t*)((const unsigned char*)P.out + DO_GT);
    bf16_t* ZT = (bf16_t*)((unsigned char*)P.out + DO_ZT);
    const bf16_t* tab = (const bf16_t*)(P.ws + WS_TAB);
    bf16_t* YR = (bf16_t*)sm; bf16_t* YI = YR + 64 * 136;
    const int wid = TID >> 6, lane = TID & 63, fr = lane & 15, fq = lane >> 4;
    bf16x8 c64[4][2], s64[4][2], c128[4], s128[4];
#pragma unroll
    for (int nt = 0; nt < 4; ++nt)
#pragma unroll
        for (int ks = 0; ks < 2; ++ks) { c64[nt][ks] = frag16(tab + (nt * 16 + fr) * 64 + ks * 32 + fq * 8); s64[nt][ks] = frag16(tab + 4096 + (nt * 16 + fr) * 64 + ks * 32 + fq * 8); }
#pragma unroll
    for (int ks = 0; ks < 4; ++ks) { c128[ks] = frag16(tab + 8192 + (wid * 16 + fr) * 128 + ks * 32 + fq * 8); s128[ks] = frag16(tab + 8192 + 16384 + (wid * 16 + fr) * 128 + ks * 32 + fq * 8); }
    bf16x8 far[2][2], fai[2][2];
#define FFT_LOAD(set, it_) do { const int itc_ = (it_) < 512 * NB ? (it_) : BID; const int cp_ = itc_ >> 3, b_ = itc_ & 7; \
        const bf16_t* gr_ = GT + (size_t)cp_ * NTOK + b_ * SEQ; const bf16_t* gi_ = GT + (size_t)(512 + cp_) * NTOK + b_ * SEQ; \
        _Pragma("unroll") for (int ks = 0; ks < 2; ++ks) { far[set][ks] = frag16(gr_ + (wid * 16 + fr) * 64 + ks * 32 + fq * 8); fai[set][ks] = frag16(gi_ + (wid * 16 + fr) * 64 + ks * 32 + fq * 8); } } while (0)
    FFT_LOAD(0, BID);
    for (int it2 = BID; it2 < 512 * NB; it2 += 2 * NBLK) {
#pragma unroll
      for (int pp = 0; pp < 2; ++pp) { const int it = it2 + pp * NBLK; if (it < 512 * NB) {
        const int cp = it >> 3, b = it & 7;
        bf16x8 ar[2], ai[2], an[2];
#pragma unroll
        for (int ks = 0; ks < 2; ++ks) { ar[ks] = far[pp][ks]; ai[ks] = fai[pp][ks];
#pragma unroll
            for (int j = 0; j < 8; ++j) an[ks][j] = (short)(ar[ks][j] ^ (short)0x8000); }
        FFT_LOAD(pp ^ 1, it + NBLK);
#pragma unroll
        for (int nt = 0; nt < 4; ++nt) {
            f32x4 yr = (f32x4){0.f, 0.f, 0.f, 0.f}, yi = (f32x4){0.f, 0.f, 0.f, 0.f};
#pragma unroll
            for (int ks = 0; ks < 2; ++ks) { yr = mfma16(ar[ks], c64[nt][ks], yr); yr = mfma16(ai[ks], s64[nt][ks], yr); yi = mfma16(ai[ks], c64[nt][ks], yi); yi = mfma16(an[ks], s64[nt][ks], yi); }
            const int k1 = nt * 16 + fr; float orr[4], oii[4];
#pragma unroll
            for (int r = 0; r < 4; ++r) { const int n2 = wid * 16 + fq * 4 + r; float s, c; sincospi_f((float)(n2 * k1) * (2.0f / 8192.0f), &s, &c);
                orr[r] = yr[r] * c + yi[r] * s; oii[r] = yi[r] * c - yr[r] * s; }
            u32x2 w; w[0] = pk2(orr[0], orr[1]); w[1] = pk2(orr[2], orr[3]); *(u32x2*)(YR + k1 * 136 + wid * 16 + fq * 4) = w;
            w[0] = pk2(oii[0], oii[1]); w[1] = pk2(oii[2], oii[3]); *(u32x2*)(YI + k1 * 136 + wid * 16 + fq * 4) = w;
        }
        SYNC();
        bf16_t* zrow = ZT + (size_t)cp * NTOK + b * SEQ;
#pragma unroll
        for (int mt = 0; mt < 4; ++mt) {
            f32x4 z = (f32x4){0.f, 0.f, 0.f, 0.f};
#pragma unroll
            for (int ks = 0; ks < 4; ++ks) { z = mfma16(frag16(YR + (mt * 16 + fr) * 136 + ks * 32 + fq * 8), c128[ks], z); z = mfma16(frag16(YI + (mt * 16 + fr) * 136 + ks * 32 + fq * 8), s128[ks], z); }
            u32x2 w; w[0] = pk2(z[0], z[1]); w[1] = pk2(z[2], z[3]);
            *(u32x2*)(zrow + 64 * (wid * 16 + fr) + mt * 16 + fq * 4) = w;
        }
        SYNC();
      } }
    }
#undef FFT_LOAD
}

constexpr int SC_W = 0, SC_U = 17408, SC_KT = 22528, SC_Q = SC_KT + 18432, SC_A = SC_Q + 17408, SC_ST = SC_A + 9216, SC_VN = SC_ST + 2 * 8704, SC_END = SC_VN + 4608;

DEV void phase5_scan(const Params& P, unsigned char* sm) {
    PHASE_TID;
    const unsigned char* images = P.ws + WS_R4;
    bf16_t* obuf = (bf16_t*)(P.ws + WS_R4 + R4_OBUF);
    const int wid = TID >> 6, lane = TID & 63, fr = lane & 15, fq = lane >> 4;
    bf16_t* ST = (bf16_t*)sm; bf16_t* VN = (bf16_t*)(sm + 2 * 8704);
    for (int item = BID; item < NCHAIN * 4; item += NBLK) {
        const int xj = item >> 3, chain = (item & 7) * 8 + (xj >> 2), c0 = (xj & 3) * 32, b = chain >> 3, hh = (chain >> 1) & 3, dir = chain & 1;
        const unsigned char* blk0 = images + (size_t)chain * NSTEP * IMG_BYTES;
        const int oK = IMG_KT + (wid * 2 * 64 + lane) * 16;
        f32x4 Sacc[2];
        Sacc[0] = (f32x4){0.f, 0.f, 0.f, 0.f}; Sacc[1] = (f32x4){0.f, 0.f, 0.f, 0.f};
        for (int q = TID; q < 2 * 8704 / 4; q += 512) ((unsigned*)ST)[q] = 0u;
#define SC_SUPD(rkset) do { _Pragma("unroll") for (int tt = 0; tt < 2; ++tt) { f32x4 a = Sacc[tt] * dl; \
            _Pragma("unroll") for (int ks = 0; ks < 2; ++ks) a = mfma16(__builtin_bit_cast(bf16x8, rkset[ks]), frag16(VN + (tt * 16 + fr) * 72 + ks * 32 + fq * 8), a); \
            Sacc[tt] = a; u32x2 w_; w_[0] = pk2(a[0], a[1]); w_[1] = pk2(a[2], a[3]); *(u32x2*)(STn + (tt * 16 + fr) * 136 + wid * 16 + fq * 4) = w_; } } while (0)
        if (wid < 4) {
            const int mt = wid;
            const int oW = IMG_W + (mt * 4 * 64 + lane) * 16, oA = IMG_A + (mt * 2 * 64 + lane) * 16, oS = IMG_SC + 16 + (mt * 16 + fq * 4) * 4;
            const bf16_t* qbase = (const bf16_t*)(P.ws + WS_R3) + hh * 128 + fq * 8;
            const int oU = IMG_U + (((c0 >> 4) * 4 + mt) * 64 + lane) * 8;
            u32x4 rw[3][4], rk[3][2], rq[3][4], ra[3][2]; u32x2 ru[3][2]; f32x4 rs[3]; float dlr[3];
#define SC_LOAD1(set, blk) do { \
            _Pragma("unroll") for (int ks = 0; ks < 4; ++ks) rw[set][ks] = *(const u32x4*)((blk) + oW + ks * 1024); \
            ru[set][0] = *(const u32x2*)((blk) + oU); ru[set][1] = *(const u32x2*)((blk) + oU + 2048); dlr[set] = *(const float*)((blk) + IMG_SC); } while (0)
#define SC_LOAD2(set, blk, stp) do { const bf16_t* qrow_ = qbase + (size_t)chunk_row(chain, (stp), mt * 16 + fr) * 1536; \
            _Pragma("unroll") for (int ks = 0; ks < 2; ++ks) rk[set][ks] = *(const u32x4*)((blk) + oK + ks * 1024); \
            _Pragma("unroll") for (int ks = 0; ks < 4; ++ks) rq[set][ks] = *(const u32x4*)(qrow_ + ks * 32); \
            rs[set] = *(const f32x4*)((blk) + oS); \
            _Pragma("unroll") for (int ks = 0; ks < 2; ++ks) ra[set][ks] = *(const u32x4*)((blk) + oA + ks * 1024); } while (0)
#define SC_LOAD(set, blk, stp) do { SC_LOAD1(set, blk); SC_LOAD2(set, blk, stp); } while (0)
            SC_LOAD(0, blk0, 0); SC_LOAD(1, blk0 + IMG_BYTES, 1); SC_LOAD(2, blk0 + 2 * IMG_BYTES, 2);
            SYNC();
#pragma unroll 1
            for (int s3 = 0; s3 < NSTEP; s3 += 3) {
#pragma unroll
                for (int u = 0; u < 3; ++u) {
                    const int step = s3 + u, cur = step & 1;
                    const bf16_t* STc = ST + cur * 4352; bf16_t* STn = ST + (cur ^ 1) * 4352;
#pragma unroll
                    for (int nt = 0; nt < 2; ++nt) {
                        f32x4 vn = (f32x4){0.f, 0.f, 0.f, 0.f};
#pragma unroll
                        for (int ks = 0; ks < 4; ++ks) vn = mfma16(__builtin_bit_cast(bf16x8, rw[u][ks]), frag16(STc + (nt * 16 + fr) * 136 + ks * 32 + fq * 8), vn);
                        const unsigned u0 = ru[u][nt][0], u1 = ru[u][nt][1];
                        u32x2 w; w[0] = pk2(bf2f((bf16_t)(u0 & 0xffffu)) - vn[0], bf2f((bf16_t)(u0 >> 16)) - vn[1]); w[1] = pk2(bf2f((bf16_t)(u1 & 0xffffu)) - vn[2], bf2f((bf16_t)(u1 >> 16)) - vn[3]);
                        *(u32x2*)(VN + (nt * 16 + fr) * 72 + mt * 16 + fq * 4) = w;
                    }
                    const float dl = dlr[u];
                    const int stp3 = step + 3 < NSTEP ? step + 3 : NSTEP - 1;
                    const unsigned char* blk3 = blk0 + (size_t)stp3 * IMG_BYTES;
                    SC_LOAD1(u, blk3);
                    SYNC();
                    SC_SUPD(rk[u]);
                    if (step >= 4) {
#pragma unroll
                        for (int nt = 0; nt < 2; ++nt) {
                            f32x4 o1 = (f32x4){0.f, 0.f, 0.f, 0.f}, o = (f32x4){0.f, 0.f, 0.f, 0.f};
#pragma unroll
                            for (int ks = 0; ks < 4; ++ks) o1 = mfma16(__builtin_bit_cast(bf16x8, rq[u][ks]), frag16(STc + (nt * 16 + fr) * 136 + ks * 32 + fq * 8), o1);
#pragma unroll
                            for (int ks = 0; ks < 2; ++ks) o = mfma16(__builtin_bit_cast(bf16x8, ra[u][ks]), frag16(VN + (nt * 16 + fr) * 72 + ks * 32 + fq * 8), o);
                            o += o1 * rs[u];
#pragma unroll
                            for (int r = 0; r < 4; ++r) { const int pos = (step - 4) * 64 + mt * 16 + fq * 4 + r; const int tok = b * SEQ + (dir ? (SEQ - 1 - pos) : pos);
                                obuf[((size_t)dir * NTOK + tok) * 512 + hh * 128 + c0 + nt * 16 + fr] = f2bf(o[r]); }
                        }
                    }
                    SC_LOAD2(u, blk3, stp3);
                    SYNC();
                }
            }
#undef SC_LOAD
#undef SC_LOAD1
#undef SC_LOAD2
        } else {
            u32x4 rk[3][2]; float dlr[3];
#define SC_LOADK(set, blk) do { dlr[set] = *(const float*)((blk) + IMG_SC); _Pragma("unroll") for (int ks = 0; ks < 2; ++ks) rk[set][ks] = *(const u32x4*)((blk) + oK + ks * 1024); } while (0)
            SC_LOADK(0, blk0); SC_LOADK(1, blk0 + IMG_BYTES); SC_LOADK(2, blk0 + 2 * IMG_BYTES);
            SYNC();
#pragma unroll 1
            for (int s3 = 0; s3 < NSTEP; s3 += 3) {
#pragma unroll
                for (int u = 0; u < 3; ++u) {
                    const int step = s3 + u, cur = step & 1;
                    bf16_t* STn = ST + (cur ^ 1) * 4352;
                    const float dl = dlr[u];
                    SYNC();
                    SC_SUPD(rk[u]);
                    { const unsigned char* blk3 = blk0 + (size_t)(step + 3 < NSTEP ? step + 3 : NSTEP - 1) * IMG_BYTES; SC_LOADK(u, blk3); }
                    SYNC();
                }
            }
#undef SC_LOADK
        }
#undef SC_SUPD
        SYNC();
    }
}

DEV void phase6_amix(const Params& P, unsigned char* sm) {
    PHASE_TID;
    const bf16_t* ZT = (const bf16_t*)((const unsigned char*)P.out + DO_ZT);
    const bf16_t* zs = (const bf16_t*)((const unsigned char*)P.out + DO_ZS);
    const bf16_t* obuf = (const bf16_t*)(P.ws + WS_R4 + R4_OBUF);
    bf16_t* amix = (bf16_t*)(P.ws + WS_R4 + R4_AMIX);
    unsigned* tile = (unsigned*)sm;
    for (int tt = BID; tt < NTOK / 64; tt += NBLK) {
        const int tok0 = tt * 64;
        { u32x4 r[8];
#pragma unroll
          for (int q = 0; q < 8; ++q) { const int idx = TID + q * 512, cp = idx >> 3, piece = idx & 7; r[q] = *(const u32x4*)(ZT + (size_t)cp * NTOK + tok0 + piece * 8); }
#pragma unroll
          for (int q = 0; q < 8; ++q) { const int idx = TID + q * 512, cp = idx >> 3, piece = idx & 7; unsigned* t = tile + cp * 33 + piece * 4; t[0] = r[q][0]; t[1] = r[q][1]; t[2] = r[q][2]; t[3] = r[q][3]; } }
        SYNC();
        u32x4 oa[8], ob[8], oz[8];
#pragma unroll
        for (int q = 0; q < 8; ++q) { const int idx = TID + q * 512, tok = idx >> 6, hh = (idx >> 4) & 3, l16 = idx & 15; const size_t off = (size_t)(tok0 + tok) * 512 + hh * 128 + l16 * 8;
            oa[q] = *(const u32x4*)(obuf + off); ob[q] = *(const u32x4*)(obuf + (size_t)NTOK * 512 + off); oz[q] = *(const u32x4*)(zs + off); }
#pragma unroll
        for (int q = 0; q < 8; ++q) { const int tok = TID & 63, c8 = ((TID >> 6) * 8 + q) * 8, sh = (tok & 1) * 16; u32x4 o;
#pragma unroll
            for (int j = 0; j < 4; ++j) o[j] = ((tile[(c8 + 2 * j) * 33 + (tok >> 1)] >> sh) & 0xffffu) | (((tile[(c8 + 2 * j + 1) * 33 + (tok >> 1)] >> sh) & 0xffffu) << 16);
            *(u32x4*)(amix + (size_t)(tok0 + tok) * 1024 + c8) = o; }
        const int l16 = TID & 15;
        float og[8];
#pragma unroll
        for (int j = 0; j < 8; ++j) og[j] = P.onorm_g[l16 * 8 + j];
#pragma unroll
        for (int q = 0; q < 8; ++q) {
            const int idx = TID + q * 512, tok = idx >> 6, hh = (idx >> 4) & 3;
            const u32x4 a = oa[q], bq = ob[q], zv = oz[q];
            float v[8]; float ss = 0.f;
#pragma unroll
            for (int j = 0; j < 4; ++j) { v[2 * j] = bf2f((bf16_t)(a[j] & 0xffffu)) + bf2f((bf16_t)(bq[j] & 0xffffu)); v[2 * j + 1] = bf2f((bf16_t)(a[j] >> 16)) + bf2f((bf16_t)(bq[j] >> 16)); }
#pragma unroll
            for (int j = 0; j < 8; ++j) ss += v[j] * v[j];
            ss += shfl_xor_f(ss, 1); ss += shfl_xor_f(ss, 2); ss += shfl_xor_f(ss, 4); ss += shfl_xor_f(ss, 8);
            const float rstd = rsq_f(ss * (1.0f / 128.0f) + EPS);
            u32x4 o;
#pragma unroll
            for (int j = 0; j < 4; ++j) o[j] = pk2(v[2 * j] * rstd * og[2 * j] * bf2f((bf16_t)(zv[j] & 0xffffu)), v[2 * j + 1] * rstd * og[2 * j + 1] * bf2f((bf16_t)(zv[j] >> 16)));
            *(u32x4*)(amix + (size_t)(tok0 + tok) * 1024 + 512 + hh * 128 + l16 * 8) = o;
        }
        SYNC();
    }
}

DEV void phase8_router(const Params& P, unsigned char* sm, int dry) {
    PHASE_TID;
    float* wr = (float*)sm;
    {
        f32x4 g[2], rt[2][8];
#pragma unroll
        for (int h = 0; h < 2; ++h) { const int k = TID + h * 512; g[h] = *(const f32x4*)(P.w_group + k * 4);
#pragma unroll
            for (int q = 0; q < 8; ++q) rt[h][q] = *(const f32x4*)(P.w_router + k * 32 + q * 4); }
#pragma unroll
        for (int h = 0; h < 2; ++h) { const int k = TID + h * 512;
#pragma unroll
            for (int e = 0; e < 4; ++e) wr[e * 1028 + k] = g[h][e];
#pragma unroll
            for (int q = 0; q < 8; ++q)
#pragma unroll
                for (int e = 0; e < 4; ++e) wr[(4 + q * 4 + e) * 1028 + k] = rt[h][q][e]; }
    }
    SYNC();
    const float* mod = (const float*)(P.ws + WS_MOD);
    const float* x1 = P.out;
    bf16_t* h2 = (bf16_t*)(P.ws + WS_R4 + R4_H2);
    unsigned* cnt = (unsigned*)(P.ws + WS_CNT + (dry ? 8192 : 0)); unsigned* tokk = (unsigned*)(P.ws + (dry ? WS_R3 : WS_TOKK)); float* wl = (float*)(P.ws + (dry ? WS_R3 + 16 * MiB : WS_WL));
    const int wid = TID >> 6, lane = TID & 63;
    const int rstep = NBLK * 8;
    int r = BID * 8 + wid;
    unsigned* lc = (unsigned*)(sm + 148224);
    unsigned* aE = lc + 64; float* aW = (float*)(aE + 512); unsigned* aP = (unsigned*)(aW + 512);
    float* gsv = (float*)(sm + 154624); float* shv = gsv + 1024;
    float* brs = shv + 1024;
    if (TID < 32) { lc[TID] = 0u; brs[TID] = P.b_router[TID]; }
    const float bg0 = P.b_group[0], bg1 = P.b_group[1], bg2 = P.b_group[2], bg3 = P.b_group[3];
    SYNC();
    int jrow = 0;
    f32x4 vr[4][4];
#pragma unroll
    for (int jj = 0; jj < 4; ++jj) { const int rl = (r + jj * rstep < NTOK) ? r + jj * rstep : r;
#pragma unroll
        for (int i = 0; i < 4; ++i) vr[jj][i] = *(const f32x4*)(x1 + (size_t)rl * D + i * 256 + lane * 4); }
    const float n2a = P.norm2_g[TID], n2b = P.norm2_g[TID + 512];
    float msa, msb, mha, mhb;
    { const float* shift = mod + (r >> 13) * 6144 + 3 * 1024; msa = shift[1024 + TID]; msb = shift[1024 + TID + 512]; mha = shift[TID]; mhb = shift[TID + 512]; }
#pragma unroll 1
    for (; r < NTOK; ) {
        SYNC();
        gsv[TID] = n2a * (1.0f + msa); gsv[TID + 512] = n2b * (1.0f + msb); shv[TID] = mha; shv[TID + 512] = mhb;
        { const int rn = (r + 4 * rstep < NTOK) ? r + 4 * rstep : r; const float* shift = mod + (rn >> 13) * 6144 + 3 * 1024; msa = shift[1024 + TID]; msb = shift[1024 + TID + 512]; mha = shift[TID]; mhb = shift[TID + 512]; }
        SYNC();
#pragma unroll
      for (int jj = 0; jj < 4; ++jj) { if (r < NTOK) {
        f32x4 v[4]; float ss = 0.f;
#pragma unroll
        for (int i = 0; i < 4; ++i) { v[i] = vr[jj][i]; ss += v[i][0] * v[i][0] + v[i][1] * v[i][1] + v[i][2] * v[i][2] + v[i][3] * v[i][3]; }
        { const int rl = (r + 4 * rstep < NTOK) ? r + 4 * rstep : r;
#pragma unroll
          for (int i = 0; i < 4; ++i) vr[jj][i] = *(const f32x4*)(x1 + (size_t)rl * D + i * 256 + lane * 4); }
        ss = wave_sum(ss);
        const float rstd = rsq_f(ss * (1.0f / 1024.0f) + EPS);
        float gl[4] = {0.f, 0.f, 0.f, 0.f};
#pragma unroll
        for (int i = 0; i < 4; ++i) {
            const int k = i * 256 + lane * 4;
            const f32x4 g2 = *(const f32x4*)(gsv + k), sh = *(const f32x4*)(shv + k);
#pragma unroll
            for (int e = 0; e < 4; ++e) v[i][e] = v[i][e] * rstd * g2[e] + sh[e];
#pragma unroll
            for (int j = 0; j < 4; ++j) { const f32x4 wv = *(const f32x4*)(wr + j * 1028 + k); gl[j] += v[i][0] * wv[0] + v[i][1] * wv[1] + v[i][2] * wv[2] + v[i][3] * wv[3]; }
#if MK_F8
            *(unsigned*)((unsigned char*)h2 + (size_t)r * D + k) = pk4_fp8(v[i][0], v[i][1], v[i][2], v[i][3]);
#else
            u32x2 w; w[0] = pk2(v[i][0], v[i][1]); w[1] = pk2(v[i][2], v[i][3]);
            *(u32x2*)(h2 + (size_t)r * D + k) = w;
#endif
        }
#pragma unroll
        for (int j = 0; j < 4; ++j) gl[j] += 0.f;
        { const float t = wave_sum_multi<4>(gl, lane);
#pragma unroll
          for (int j = 0; j < 4; ++j) gl[j] = lane_bcast(t, j) + (j == 0 ? bg0 : j == 1 ? bg1 : j == 2 ? bg2 : bg3); }
        int gsel = 0; float gmax = gl[0];
#pragma unroll
        for (int j = 1; j < 4; ++j) if (gl[j] > gmax) { gmax = gl[j]; gsel = j; }
        float gden = 0.f;
#pragma unroll
        for (int j = 0; j < 4; ++j) gden += __expf(gl[j] - gmax);
        const float pg = 1.0f / gden;
        float el[8] = {0.f, 0.f, 0.f, 0.f, 0.f, 0.f, 0.f, 0.f};
#pragma unroll
        for (int i = 0; i < 4; ++i)
#pragma unroll
            for (int j = 0; j < 8; ++j) { const f32x4 wv = *(const f32x4*)(wr + (4 + gsel * 8 + j) * 1028 + i * 256 + lane * 4); el[j] += v[i][0] * wv[0] + v[i][1] * wv[1] + v[i][2] * wv[2] + v[i][3] * wv[3]; }
#pragma unroll
        for (int j = 0; j < 8; ++j) el[j] += 0.f;
        { const float t = wave_sum_multi<8>(el, lane);
#pragma unroll
          for (int j = 0; j < 8; ++j) el[j] = lane_bcast(t, j) + brs[gsel * 8 + j]; }
        int e1 = 0; float m1 = el[0];
#pragma unroll
        for (int j = 1; j < 8; ++j) if (el[j] > m1) { m1 = el[j]; e1 = j; }
        int e2 = -1; float m2 = -3.0e38f;
#pragma unroll
        for (int j = 0; j < 8; ++j) if (j != e1 && el[j] > m2) { m2 = el[j]; e2 = j; }
        if (e2 < 0) e2 = (e1 + 1) & 7;
        const float p2 = __expf(m2 - m1);
        const float w1 = pg / (1.0f + p2), w2 = pg * p2 / (1.0f + p2);
        if (lane < 2) {
            const int ee = gsel * 8 + (lane == 0 ? e1 : e2); const float ww = lane == 0 ? w1 : w2;
            const unsigned pos = atomic_add_u32(&lc[ee], 1u);
            const int a = (jrow * 8 + wid) * 2 + lane;
            if (a < 512) { aE[a] = (unsigned)ee; aW[a] = ww; aP[a] = pos; }
        }
        ++jrow; r += rstep;
      } }
    }
    SYNC();
    if (TID < 32) lc[32 + TID] = atomic_add_u32(&cnt[TID * 64], lc[TID]);
    SYNC();
    { const int a = TID, rl = a >> 1, rr = BID * 8 + (rl & 7) + (rl >> 3) * rstep;
      if (rr < NTOK && (rl >> 3) < jrow) { const unsigned ee = aE[a]; const unsigned pos = lc[32 + ee] + aP[a];
          tokk[(size_t)ee * LCAP + pos] = (unsigned)rr * 2u + (unsigned)(a & 1); wl[(size_t)ee * LCAP + pos] = aW[a]; } }
}

DEV void phase11_final(const Params& P, unsigned char* sm, float* dstbase) {
    PHASE_TID;
    (void)sm;
    const float* mod = (const float*)(P.ws + WS_MOD);
    const bf16_t* Y = (const bf16_t*)(P.ws + WS_R4 + R4_Y);
    const int wid = TID >> 6, lane = TID & 63;
    for (int r0 = (BID * 8 + wid) * 2; r0 < NTOK; r0 += NBLK * 16) {
        f32x4 xv[2][4]; u32x2 y0[2][4], y1[2][4];
#pragma unroll
        for (int u = 0; u < 2; ++u)
#pragma unroll
            for (int i = 0; i < 4; ++i) { const int k = i * 256 + lane * 4; const size_t r = (size_t)(r0 + u);
                xv[u][i] = *(const f32x4*)(P.out + r * D + k); y0[u][i] = *(const u32x2*)(Y + r * D + k); y1[u][i] = *(const u32x2*)(Y + ((size_t)NTOK + r) * D + k); }
        const float* gate = mod + (r0 >> 13) * 6144 + 5 * 1024;
#pragma unroll
        for (int u = 0; u < 2; ++u) {
            float* row = dstbase + (size_t)(r0 + u) * D;
            f32x4 v[4]; float ss = 0.f;
#pragma unroll
            for (int i = 0; i < 4; ++i) { const int k = i * 256 + lane * 4; const f32x4 gv = *(const f32x4*)(gate + k);
                f32x4 m; m[0] = bf2f((bf16_t)(y0[u][i][0] & 0xffffu)) + bf2f((bf16_t)(y1[u][i][0] & 0xffffu)); m[1] = bf2f((bf16_t)(y0[u][i][0] >> 16)) + bf2f((bf16_t)(y1[u][i][0] >> 16));
                m[2] = bf2f((bf16_t)(y0[u][i][1] & 0xffffu)) + bf2f((bf16_t)(y1[u][i][1] & 0xffffu)); m[3] = bf2f((bf16_t)(y0[u][i][1] >> 16)) + bf2f((bf16_t)(y1[u][i][1] >> 16));
                v[i] = xv[u][i] + gv * m; ss += v[i][0] * v[i][0] + v[i][1] * v[i][1] + v[i][2] * v[i][2] + v[i][3] * v[i][3]; }
            ss = wave_sum(ss);
            const float rstd = rsq_f(ss * (1.0f / 1024.0f) + EPS);
#pragma unroll
            for (int i = 0; i < 4; ++i) { const int k = i * 256 + lane * 4; const f32x4 fg = *(const f32x4*)(P.final_g + k); *(f32x4*)(row + k) = v[i] * rstd * fg; }
        }
    }
}

#ifndef CPU_EMU
#define XB_TMO      128
#define XB_XCNT(j)  (256  + 64 * (j))
#define XB_XSUB(j)  (1280 + 64 * (j))
#define XB_XGEN(j)  (2304 + 64 * (j))
#define XB_TOP      3328
#define XB_TOPGEN   3392
#define XCD_BAR_WORDS 3456
#define XB_SPIN_CAP (1u << 22)
#define LAS __attribute__((address_space(3)))
__device__ __forceinline__ unsigned xb_ld(unsigned* p)              { return __hip_atomic_load(p, __ATOMIC_RELAXED, __HIP_MEMORY_SCOPE_AGENT); }
__device__ __forceinline__ unsigned xb_add(unsigned* p, unsigned v) { return __hip_atomic_fetch_add(p, v, __ATOMIC_RELAXED, __HIP_MEMORY_SCOPE_AGENT); }
__device__ __forceinline__ unsigned xb_xcc_id() { return (unsigned)__builtin_amdgcn_s_getreg((3 << 11) | 20) & 0xFu; }
#define XB_SPIN(cond, bar) do { unsigned _sp = 0; while (cond) { __builtin_amdgcn_s_sleep(1); \
    if ((++_sp & 255u) == 0u) { if (xb_ld(&(bar)[XB_TMO])) break; if (_sp > XB_SPIN_CAP) { atomicAdd(&(bar)[XB_TMO], 1u); break; } } } } while (0)
struct XcdBarrier { unsigned* bar; unsigned x; volatile LAS unsigned* st; };
__device__ __forceinline__ XcdBarrier xcd_barrier_post(unsigned* bar, volatile LAS unsigned* st) {
    XcdBarrier b; b.bar = bar; b.x = xb_xcc_id(); b.st = st;
    if (threadIdx.x == 0) (void)xb_add(&bar[XB_XCNT(b.x)], 1u);
    return b;
}
__device__ __forceinline__ void xcd_barrier_complete(unsigned* bar, unsigned x, unsigned& nloc, unsigned& nx) {
    const unsigned G = gridDim.x * gridDim.y * gridDim.z;
    unsigned sum, cnt, mine, sp = 0u;
    for (;;) {
        sum = 0u; cnt = 0u; mine = 0u;
#pragma unroll
        for (unsigned j = 0; j < 16; ++j) { const unsigned c = xb_ld(&bar[XB_XCNT(j)]); sum += c; cnt += (c > 0u) ? 1u : 0u; mine = (j == x) ? c : mine; }
        if (sum == G) break;
        __builtin_amdgcn_s_sleep(1);
        if ((++sp & 255u) == 0u) { if (xb_ld(&bar[XB_TMO])) break; if (sp > XB_SPIN_CAP) { atomicAdd(&bar[XB_TMO], 1u); break; } }
    }
    nloc = mine > 0u ? mine : 1u; nx = cnt > 0u ? cnt : 1u;
}
__device__ __forceinline__ void xcd_barrier(const XcdBarrier& b) {
    asm volatile("s_waitcnt vmcnt(0)" ::: "memory");
    __syncthreads();
    if (threadIdx.x == 0) {
        unsigned* bar = b.bar;
        __builtin_amdgcn_s_waitcnt(0);
        unsigned nloc = b.st[0], nx = b.st[1];
        if (nloc == 0u) { xcd_barrier_complete(bar, b.x, nloc, nx); b.st[0] = nloc; b.st[1] = nx; }
        const unsigned old = xb_add(&bar[XB_XSUB(b.x)], 1u);
        const unsigned gen = old / nloc;
        if (old + 1u == (gen + 1u) * nloc) {
            __builtin_amdgcn_fence(__ATOMIC_RELEASE, "agent");
            asm volatile("s_waitcnt vmcnt(0)" ::: "memory");
            const unsigned og = xb_add(&bar[XB_TOP], 1u);
            const unsigned tg = og / nx;
            if (og + 1u == (tg + 1u) * nx) xb_add(&bar[XB_TOPGEN], 1u);
            else XB_SPIN(xb_ld(&bar[XB_TOPGEN]) == tg, bar);
            __builtin_amdgcn_fence(__ATOMIC_ACQUIRE, "agent");
            xb_add(&bar[XB_XGEN(b.x)], 1u);
            asm volatile("s_waitcnt vmcnt(0)" ::: "memory");
        } else {
            XB_SPIN(xb_ld(&bar[XB_XGEN(b.x)]) == gen, bar);
            __builtin_amdgcn_fence(__ATOMIC_ACQUIRE, "agent");
            asm volatile("s_waitcnt vmcnt(0)" ::: "memory");
        }
    }
    __syncthreads();
}

#ifndef MK_PH
#define MK_PH 0x7ff
#endif
#ifndef MK_REP
#define MK_REP 0
#endif
#define REPS(k) for (int rep_ = 0; rep_ < (((MK_REP >> (k)) & 1) ? 2 : 1); ++rep_)
extern __shared__ __attribute__((aligned(16))) unsigned char smem_dyn[];

__device__ __forceinline__ void moe_tables(const Params& P, LAS int* tb, LAS int* cn) {
    const unsigned* cnt = (const unsigned*)(P.ws + WS_CNT);
    if (threadIdx.x < 32) cn[threadIdx.x] = (int)cnt[threadIdx.x * 64];
    __syncthreads();
    if (threadIdx.x == 0) { int acc = 0; for (int e = 0; e < 32; ++e) { tb[e] = acc; acc += (cn[e] + 255) >> 8; } tb[32] = acc; }
    __syncthreads();
}

__global__ void __launch_bounds__(512, 2) hymba_fwd(Params P) {
    unsigned char* sm = smem_dyn;
    LAS unsigned char* lsm = (LAS unsigned char*)smem_dyn;
    volatile LAS unsigned* xbw = (volatile LAS unsigned*)(lsm + LDS_BYTES - 16);
    if (threadIdx.x == 0) { xbw[0] = 0u; xbw[1] = 0u; xbw[2] = 0u; xbw[3] = 0u; }
    __syncthreads();
    XcdBarrier bar = xcd_barrier_post((unsigned*)(P.ws + WS_BAR), xbw);
    using namespace pg8;

#if (MK_PH >> 0) & 1
    REPS(15) phase0_mod(P, sm); REPS(0) { phase0_weights(P, sm); phase0_wf(P, sm); }
    xcd_barrier(bar);
#endif
#if (MK_PH >> 1) & 1
    REPS(1) phase1_prep(P, sm);
    xcd_barrier(bar);
#endif
#if (MK_PH >> 2) & 1
    REPS(2) {
    { ProbInproj G; G.init(MROWS / 256, 8, gridDim.x, blockIdx.x); G.A = (const bf16_t*)(P.ws + WS_R4 + R4_H); G.Bt = (const bf16_t*)(P.ws + WS_WQKVZ); G.K = 1024;
      EpiInproj E; E.O = (bf16_t*)(P.ws + WS_R4 + R4_P); E.zs = (bf16_t*)((unsigned char*)P.out + DO_ZS); E.rstd = (const float*)(P.ws + WS_RSTD); E.bias = (const float*)(P.ws + WS_BIAS); gemm_phase(lsm, G, E); }
    { ProbGT G; G.init(4, NTOK / 256, gridDim.x, blockIdx.x); G.A = (const bf16_t*)(P.ws + WS_WF); G.Bt = (const bf16_t*)(P.ws + WS_R4 + R4_H); G.K = 1024;
      EpiGT E; E.O = (bf16_t*)((unsigned char*)P.out + DO_GT); E.rstd = (const float*)(P.ws + WS_RSTD); E.bias = (const float*)(P.ws + WS_BIAS); gemm_phase(lsm, G, E); }
    }
    xcd_barrier(bar);
#endif
#if (MK_PH >> 3) & 1
    REPS(3) phase3_conv(P, sm);
    xcd_barrier(bar);
#endif
#if (MK_PH >> 4) & 1
    REPS(4) phase4_prepass(P, sm);
    REPS(11) phase4_fft(P, sm);
    xcd_barrier(bar);
#endif
#if (MK_PH >> 5) & 1
    REPS(5) phase5_scan(P, sm);
    xcd_barrier(bar);
#endif
#if (MK_PH >> 6) & 1
    REPS(6) phase6_amix(P, sm);
    xcd_barrier(bar);
#endif
#if (MK_PH >> 7) & 1
    REPS(7)
    { ProbOut G; G.init(NTOK / 256, 4, gridDim.x, blockIdx.x); G.A = (const bf16_t*)(P.ws + WS_R4 + R4_AMIX); G.Bt = (const bf16_t*)(P.ws + WS_WOUT); G.K = 1024;
      EpiResid E; E.x = P.x; E.mod = (const float*)(P.ws + WS_MOD); E.out = P.out; gemm_phase(lsm, G, E); }
    xcd_barrier(bar);
#endif
#if (MK_PH >> 8) & 1
#if (MK_REP >> 13) & 1
    phase8_router(P, sm, 1);
#endif
    phase8_router(P, sm, 0);
#if (MK_REP >> 14) & 1
    xcd_barrier(bar); xcd_barrier(bar); xcd_barrier(bar); xcd_barrier(bar);
#endif
    xcd_barrier(bar);
#endif
#if (MK_PH >> 9) & 1
#if MK_F8
    LAS int* tb = (LAS int*)(lsm + F8_LDS); LAS int* cn = tb + 64;
    moe_tables(P, tb, cn);
    { ProbMoe1F8 G; G.tb = tb; G.cnt = cn; G.G = gridDim.x; G.c = blockIdx.x; G.A = P.ws + WS_R4 + R4_H2; G.Bt = P.ws + WS_WGU; G.KB = 1024; G.tokk = (const unsigned*)(P.ws + WS_TOKK);
      EpiMoe1F8 E; E.hid = P.ws + WS_R4 + R4_HID; gemm_f8(lsm, G, E); }
    xcd_barrier(bar);
    { ProbMoe2F8 G; G.tb = tb; G.cnt = cn; G.G = gridDim.x; G.c = blockIdx.x; G.A = P.ws + WS_R4 + R4_HID; G.Bt = P.ws + WS_WD; G.KB = 512;
      EpiMoe2F8 E; E.Y = (bf16_t*)(P.ws + WS_R4 + R4_Y); E.tokk = (const unsigned*)(P.ws + WS_TOKK); E.wl = (const float*)(P.ws + WS_WL); E.tb = tb; gemm_f8(lsm, G, E); }
    xcd_barrier(bar);
#else
    LAS int* tb = (LAS int*)(lsm + STAGE_BYTES); LAS int* cn = tb + 64;
    moe_tables(P, tb, cn);
    REPS(9)
    { ProbMoe1 G; G.tb = tb; G.cnt = cn; G.G = gridDim.x; G.c = blockIdx.x; G.A = (const bf16_t*)(P.ws + WS_R4 + R4_H2); G.Bt = (const bf16_t*)(P.ws + WS_WGU); G.K = 1024; G.tokk = (const unsigned*)(P.ws + WS_TOKK);
      EpiMoe1 E; E.hid = (bf16_t*)(P.ws + WS_R4 + R4_HID); gemm_phase(lsm, G, E); }
    xcd_barrier(bar);
    REPS(10)
    { ProbMoe2 G; G.tb = tb; G.cnt = cn; G.G = gridDim.x; G.c = blockIdx.x; G.A = (const bf16_t*)(P.ws + WS_R4 + R4_HID); G.Bt = (const bf16_t*)(P.ws + WS_WD); G.K = 512;
      EpiMoe2 E; E.Y = (bf16_t*)(P.ws + WS_R4 + R4_Y); E.tokk = (const unsigned*)(P.ws + WS_TOKK); E.wl = (const float*)(P.ws + WS_WL); E.tb = tb; gemm_phase(lsm, G, E); }
    xcd_barrier(bar);
#endif
#endif
#if (MK_PH >> 10) & 1
#if (MK_REP >> 12) & 1
    phase11_final(P, sm, (float*)(P.ws + WS_R4 + 300 * MiB));
#endif
    phase11_final(P, sm, P.out);
#endif
}

extern "C" void kernel_launch(void* const* d_in, const int* in_sizes, int n_in, void* d_out, int out_size, void* d_ws, size_t ws_size, hipStream_t stream) {
    (void)in_sizes; (void)n_in; (void)out_size;
    static int grid = 0;
    if (!grid) {
        int dev = 0, cus = 0, per_cu = 0;
        hipGetDevice(&dev);
        hipDeviceGetAttribute(&cus, hipDeviceAttributeMultiprocessorCount, dev);
        hipFuncSetAttribute((const void*)hymba_fwd, hipFuncAttributeMaxDynamicSharedMemorySize, LDS_BYTES);
        hipOccupancyMaxActiveBlocksPerMultiprocessor(&per_cu, hymba_fwd, 512, LDS_BYTES);
        if (per_cu < 1) { fprintf(stderr, "occupancy query says 0 blocks per CU\n"); per_cu = 1; }
        grid = cus;
        if (ws_size < WS_NEED) fprintf(stderr, "workspace too small: %zu < %zu\n", ws_size, (size_t)WS_NEED);
    }
    Params p{};
    p.x = (const float*)d_in[0]; p.c = (const float*)d_in[1]; p.ctx = (const float*)d_in[2]; p.c_ctx = (const float*)d_in[3]; p.w_mod = (const float*)d_in[4]; p.b_mod = (const float*)d_in[5];
    p.norm1_g = (const float*)d_in[6]; p.w_in = (const float*)d_in[7]; p.conv_w = (const float*)d_in[8]; p.a_log = (const float*)d_in[9]; p.dt_bias = (const float*)d_in[10]; p.onorm_g = (const float*)d_in[11];
    p.w_out = (const float*)d_in[12]; p.norm2_g = (const float*)d_in[13]; p.w_group = (const float*)d_in[14]; p.b_group = (const float*)d_in[15]; p.w_router = (const float*)d_in[16]; p.b_router = (const float*)d_in[17];
    p.w_gate = (const float*)d_in[18]; p.w_up = (const float*)d_in[19]; p.w_down = (const float*)d_in[20]; p.final_g = (const float*)d_in[21];
    p.out = (float*)d_out; p.ws = (unsigned char*)d_ws;
    hipMemsetAsync(d_ws, 0, WS_ZERO_BYTES, stream);
    hipLaunchKernelGGL(hymba_fwd, dim3(grid), dim3(512), LDS_BYTES, stream, p);
}
#endif
```

```cpp
#ifndef CPU_EMU
#include <hip/hip_runtime.h>
#include <cstdio>
#include <cstdint>
#define DEV __device__ __forceinline__
#define TID tid_local
#define PHASE_TID int tid_local = (int)threadIdx.x; asm volatile("" : "+v"(tid_local))
#define BID ((int)blockIdx.x)
#define NBLK ((int)gridDim.x)
#define SYNC() __syncthreads()
#define SCHED_FENCE() __builtin_amdgcn_sched_barrier(0)
#endif

typedef unsigned short bf16_t;
typedef short bf16x8 __attribute__((ext_vector_type(8)));
typedef float f32x4 __attribute__((ext_vector_type(4)));
typedef unsigned u32x4 __attribute__((ext_vector_type(4)));
typedef unsigned u32x2 __attribute__((ext_vector_type(2)));

constexpr int D = 1024, NB = 8, SEQ = 8192, CTX = 256;
constexpr int NTOK = NB * SEQ;
constexpr int NCTX = NB * CTX;
constexpr int MROWS = NTOK + NCTX;
constexpr int W_IN = 2576;
constexpr int NSTEP = 4 + 128;
constexpr int NCHAIN = NB * 4 * 2;
constexpr int NPROB = NCHAIN * NSTEP;
constexpr float EPS = 1e-6f;
constexpr int NEXP = 32;
constexpr int LCAP = 65536;

constexpr int IMG_W = 0, IMG_KT = 16384, IMG_A = 32768, IMG_U = 40960, IMG_SC = 57344, IMG_BYTES = 57664;

constexpr size_t MiB = 1048576;
constexpr size_t WS_BAR = 0;
constexpr size_t WS_MOD = 16384;
constexpr size_t WS_CNT = 16384 + 221184;
constexpr size_t WS_ZERO_BYTES = WS_CNT + 16384;
constexpr size_t WS_TAB = 262144;
constexpr size_t WS_BIAS = 393216;
constexpr size_t WS_RSTD = 5 * MiB + 524288;
constexpr size_t WS_GB = 1 * MiB;
constexpr size_t WS_TOKK = 6 * MiB;
constexpr size_t WS_WL = 14 * MiB;
constexpr size_t WS_W = 22 * MiB;
constexpr size_t WS_WQKVZ = WS_W;
constexpr size_t WS_WF = WS_WQKVZ + 2048ull * 1024 * 2;
constexpr size_t WS_WOUT = WS_WF + 1024ull * 1024 * 2;
constexpr size_t WS_WGU = WS_WOUT + 1024ull * 1024 * 2;
constexpr size_t WS_WD = WS_WGU + 32ull * 1024 * 1024 * 2;
constexpr size_t WS_R3 = 126 * MiB;
constexpr size_t WS_R4 = 324 * MiB;
constexpr size_t WS_NEED = WS_R4 + 645 * MiB;
constexpr size_t R4_H = 0, R4_P = 132 * MiB;
constexpr size_t R4_AMIX = 0, R4_H2 = 128 * MiB, R4_HID = 256 * MiB, R4_Y = 0;
constexpr size_t R4_OBUF = 480 * MiB;
constexpr size_t DO_GT = 0, DO_ZT = 128 * MiB, DO_ZS = 192 * MiB;

constexpr int LDS_BYTES = 163840;

struct Params {
    const float *x, *c, *ctx, *c_ctx, *w_mod, *b_mod, *norm1_g, *w_in, *conv_w, *a_log, *dt_bias, *onorm_g, *w_out, *norm2_g,
                *w_group, *b_group, *w_router, *b_router, *w_gate, *w_up, *w_down, *final_g;
    float* out;
    unsigned char* ws;
};

DEV bf16_t f2bf(float f) { unsigned u = __builtin_bit_cast(unsigned, f); u += 0x7FFFu + ((u >> 16) & 1u); return (bf16_t)(u >> 16); }
DEV float bf2f(bf16_t b) { return __builtin_bit_cast(float, ((unsigned)b) << 16); }
#ifndef MK_F8
#define MK_F8 1
#endif
#ifndef CPU_EMU
DEV unsigned pk4_fp8(float a, float b, float c, float d) { int t = 0; t = __builtin_amdgcn_cvt_pk_fp8_f32(a, b, t, false); t = __builtin_amdgcn_cvt_pk_fp8_f32(c, d, t, true); return (unsigned)t; }
typedef __bf16 bf16n2 __attribute__((ext_vector_type(2)));
DEV unsigned pk2(float lo, float hi) { bf16n2 v; v[0] = (__bf16)lo; v[1] = (__bf16)hi; return __builtin_bit_cast(unsigned, v); }
DEV float rcp_f(float x) { return __builtin_amdgcn_rcpf(x); }
DEV float rsq_f(float x) { return __builtin_amdgcn_rsqf(x); }
#else
DEV unsigned pk2(float lo, float hi) { return (unsigned)f2bf(lo) | ((unsigned)f2bf(hi) << 16); }
DEV float rcp_f(float x) { return 1.0f / x; }
DEV float rsq_f(float x) { return 1.0f / sqrtf(x); }
#endif
DEV float silu_f(float v) { return v * rcp_f(1.0f + __expf(-v)); }

#ifndef CPU_EMU
DEV f32x4 mfma16(bf16x8 a, bf16x8 b, f32x4 c) { return __builtin_amdgcn_mfma_f32_16x16x32_bf16(a, b, c, 0, 0, 0); }
DEV float shfl_xor_f(float v, int m) { return __shfl_xor(v, m); }
DEV float shfl_up_f(float v, int d) { return __shfl_up(v, d); }
DEV float shfl_idx_f(float v, int l) { return __shfl(v, l); }
DEV void atomic_add_f32(float* p, float v) { atomicAdd(p, v); }
DEV unsigned atomic_add_u32(unsigned* p, unsigned v) { return atomicAdd(p, v); }
DEV void sincospi_f(float x, float* s, float* c) { sincospif(x, s, c); }
#endif

DEV float wave_sum(float v) {
#pragma unroll
    for (int o = 32; o >= 1; o >>= 1) v += shfl_xor_f(v, o);
    return v;
}
template <int N> DEV float wave_sum_multi(const float (&v)[N], int lane) {
    float a[N];
#pragma unroll
    for (int i = 0; i < N; ++i) a[i] = v[i];
    int m = 1;
#pragma unroll
    for (int n = N; n > 1; n >>= 1, m <<= 1) {
        const bool up = (lane & m) != 0;
#pragma unroll
        for (int i = 0; i < n / 2; ++i) { const float keep = up ? a[2 * i + 1] : a[2 * i], send = up ? a[2 * i] : a[2 * i + 1]; a[i] = keep + shfl_xor_f(send, m); }
    }
    float r = a[0];
#pragma unroll
    for (int o = N; o < 64; o <<= 1) r += shfl_xor_f(r, o);
    return r;
}
#ifndef CPU_EMU
DEV float lane_bcast(float v, int l) { return __builtin_bit_cast(float, __builtin_amdgcn_readlane(__builtin_bit_cast(int, v), l)); }
#endif
DEV bf16x8 frag_gather(const bf16_t* p, int stride) {
    bf16x8 r;
#pragma unroll
    for (int j = 0; j < 8; ++j) r[j] = (short)p[j * stride];
    return r;
}
DEV bf16x8 frag16(const bf16_t* p) { return *(const bf16x8*)p; }

DEV void phase0_mod(const Params& P, unsigned char* sm) {
    PHASE_TID;
    float* sil = (float*)sm;
    float* red = (float*)(sm + 36864);
    for (int i = TID; i < 9 * 1024; i += 512) { const int r = i >> 10, k = i & 1023; const float v = r < 8 ? P.c[r * 1024 + k] : P.c_ctx[k]; sil[i] = silu_f(v); }
    SYNC();
    float* mod = (float*)(P.ws + WS_MOD);
    for (int cb = BID; cb < 256; cb += NBLK) {
        const int c = TID % 24, kg = TID / 24, j0 = cb * 24;
        if (kg < 21) {
            float acc[9];
#pragma unroll
            for (int r = 0; r < 9; ++r) acc[r] = 0.f;
#pragma unroll 7
            for (int k = kg; k < 1024; k += 21) { const float w = P.w_mod[(size_t)k * 6144 + j0 + c];
#pragma unroll
                for (int r = 0; r < 9; ++r) acc[r] += sil[r * 1024 + k] * w; }
#pragma unroll
            for (int r = 0; r < 9; ++r) red[(kg * 24 + c) * 9 + r] = acc[r];
        }
        SYNC();
        if (TID < 24 * 9) { const int cc = TID / 9, r = TID - cc * 9; float t = P.b_mod[j0 + cc];
            for (int g = 0; g < 21; ++g) t += red[(g * 24 + cc) * 9 + r];
            mod[r * 6144 + j0 + cc] = t; }
        SYNC();
    }
}

struct WJob { const float* src; unsigned char* dst; int lds_, ldd, inter, f8; };
DEV WJob wjob(const Params& P, int t) {
    unsigned char* wqkvz = P.ws + WS_WQKVZ; unsigned char* wout = P.ws + WS_WOUT; unsigned char* wgu = P.ws + WS_WGU; unsigned char* wd = P.ws + WS_WD;
    WJob j;
    if (t < 128) { const int kt = t >> 3, nt = t & 7;
        j.src = P.w_in + (size_t)(kt * 64) * W_IN + 512 + nt * 256; j.lds_ = W_IN; j.dst = wqkvz + ((size_t)(nt * 256) * 1024 + kt * 64) * 2; j.ldd = 2048; j.inter = 0; j.f8 = 0;
    } else if (t < 192) { const int u = t - 128, kt = u >> 2, nt = u & 3;
        j.src = P.w_out + (size_t)(kt * 64) * 1024 + nt * 256; j.lds_ = 1024; j.dst = wout + ((size_t)(nt * 256) * 1024 + kt * 64) * 2; j.ldd = 2048; j.inter = 0; j.f8 = 0;
    } else if (t < 192 + 2048) { const int u = t - 192, up = u >> 10, v = u & 1023, e = v >> 5, w = v & 31, kt = w >> 1, nt = w & 1;
        j.src = (up ? P.w_up : P.w_gate) + (size_t)e * 1024 * 512 + (size_t)(kt * 64) * 512 + nt * 256; j.lds_ = 512; j.inter = 1 + up;
#if MK_F8
        j.dst = wgu + (size_t)e * 1024 * 1024 + (size_t)(nt * 512) * 1024 + kt * 64; j.ldd = 1024; j.f8 = 1;
#else
        j.dst = wgu + ((size_t)e * 1024 * 1024 + (size_t)(nt * 512) * 1024 + kt * 64) * 2; j.ldd = 2048; j.f8 = 0;
#endif
    } else { const int v = t - 192 - 2048, e = v >> 5, w = v & 31, kt = w >> 2, nt = w & 3;
        j.src = P.w_down + (size_t)e * 512 * 1024 + (size_t)(kt * 64) * 1024 + nt * 256; j.lds_ = 1024; j.inter = 0;
#if MK_F8
        j.dst = wd + (size_t)e * 1024 * 512 + (size_t)(nt * 256) * 512 + kt * 64; j.ldd = 512; j.f8 = 1;
#else
        j.dst = wd + ((size_t)e * 1024 * 512 + (size_t)(nt * 256) * 512 + kt * 64) * 2; j.ldd = 1024; j.f8 = 0;
#endif
    }
    return j;
}
DEV void phase0_weights(const Params& P, unsigned char* sm) {
    PHASE_TID;
    float* tile = (float*)sm;
    const int NJ = 128 + 64 + 3 * 1024;
    f32x4 v[8];
    int t = BID;
    if (t < NJ) { const WJob j = wjob(P, t);
#pragma unroll
        for (int q = 0; q < 8; ++q) v[q] = *(const f32x4*)(j.src + (size_t)((TID >> 6) + q * 8) * j.lds_ + (TID & 63) * 4); }
    for (; t < NJ; t += NBLK) {
        const WJob j = wjob(P, t);
#pragma unroll
        for (int q = 0; q < 8; ++q) { float* tp = tile + ((TID >> 6) + q * 8) * 257 + (TID & 63) * 4; tp[0] = v[q][0]; tp[1] = v[q][1]; tp[2] = v[q][2]; tp[3] = v[q][3]; }
        { const WJob jn = wjob(P, t + NBLK < NJ ? t + NBLK : t);
#pragma unroll
          for (int q = 0; q < 8; ++q) v[q] = *(const f32x4*)(jn.src + (size_t)((TID >> 6) + q * 8) * jn.lds_ + (TID & 63) * 4); }
        SYNC();
        const int c = TID & 255, half = TID >> 8;
        if (j.f8) {
            const int c5 = c & 31, p32 = 16 * ((c5 >> 2) & 1) + 4 * (c5 >> 3) + (c5 & 3), s64 = (c & 0xC3) | (((c >> 2) & 3) << 4) | (((c >> 4) & 3) << 2);
            const int drow8 = j.inter ? ((c >> 7) * 256 + ((c >> 5) & 3) * 64 + (j.inter - 1) * 32 + p32) : s64;
            u32x4 w[2];
#pragma unroll
            for (int q = 0; q < 2; ++q)
#pragma unroll
                for (int jj = 0; jj < 4; ++jj) { const int k0 = half * 32 + q * 16 + jj * 4; w[q][jj] = pk4_fp8(tile[k0 * 257 + c] * 32.0f, tile[(k0 + 1) * 257 + c] * 32.0f, tile[(k0 + 2) * 257 + c] * 32.0f, tile[(k0 + 3) * 257 + c] * 32.0f); }
            unsigned char* d8 = j.dst + (size_t)drow8 * j.ldd + half * 32;
            *(u32x4*)d8 = w[0]; *(u32x4*)(d8 + 16) = w[1];
        } else {
            const int drow = j.inter ? ((c >> 7) * 256 + (j.inter - 1) * 128 + (c & 127)) : c;
            u32x4 w[4];
#pragma unroll
            for (int q = 0; q < 4; ++q)
#pragma unroll
                for (int jj = 0; jj < 4; ++jj) w[q][jj] = pk2(tile[(half * 32 + q * 8 + 2 * jj) * 257 + c], tile[(half * 32 + q * 8 + 2 * jj + 1) * 257 + c]);
            unsigned char* d2 = j.dst + (size_t)drow * j.ldd + half * 64;
#pragma unroll
            for (int q = 0; q < 4; ++q) *(u32x4*)(d2 + q * 16) = w[q];
        }
        SYNC();
    }
}

DEV void phase0_wf(const Params& P, unsigned char* sm) {
    PHASE_TID;
    float* cs = (float*)sm;
    if (TID < 128) { float s, c; sincospi_f((float)TID * (2.0f / 128.0f), &s, &c); cs[TID] = c; cs[128 + TID] = s; }
    SYNC();
    bf16_t* wf = (bf16_t*)(P.ws + WS_WF);
    const float sc = 0.08838834764831845f;
    for (int it = BID; it < 256; it += NBLK) {
        const int kb = it & 1, cb = (it >> 1) & 15, part = (it >> 5) & 1, g = it >> 6;
        const int k = kb * 512 + TID;
        const float* wrow = P.w_in + (size_t)k * W_IN + g * 128;
        float acc[8];
#pragma unroll
        for (int q = 0; q < 8; ++q) acc[q] = 0.f;
#pragma unroll 8
        for (int c4 = 0; c4 < 32; ++c4) { const f32x4 w4 = *(const f32x4*)(wrow + c4 * 4);
#pragma unroll
            for (int e = 0; e < 4; ++e) { const int c = c4 * 4 + e;
#pragma unroll
                for (int q = 0; q < 8; ++q) { const int cp = cb * 8 + q; acc[q] += w4[e] * cs[part * 128 + ((c * cp) & 127)]; } } }
#pragma unroll
        for (int q = 0; q < 8; ++q) { const int chc = part * 512 + g * 128 + cb * 8 + q; wf[(size_t)chc * 1024 + k] = f2bf((part ? -acc[q] : acc[q]) * sc); }
    }
    bf16_t* tab = (bf16_t*)(P.ws + WS_TAB);
    const float sc2 = 0.011048543456039806f;
    for (int i = BID * 512 + TID; i < 4096 + 16384; i += NBLK * 512) {
        if (i < 4096) { const int a = i >> 6, b = i & 63; float s, c; sincospi_f((float)((a * b) & 63) * (2.0f / 64.0f), &s, &c); tab[i] = f2bf(c); tab[4096 + i] = f2bf(s); }
        else { const int j = i - 4096, a = j >> 7, b = j & 127; float s, c; sincospi_f((float)((a * b) & 127) * (2.0f / 128.0f), &s, &c); tab[8192 + j] = f2bf(c * sc2); tab[8192 + 16384 + j] = f2bf(s * sc2); }
    }
}

DEV void phase1_prep(const Params& P, unsigned char* sm) {
    PHASE_TID;
    bf16_t* Bhi = (bf16_t*)sm; bf16_t* Blo = (bf16_t*)(sm + 33024);
    float* gsv = (float*)(sm + 66048);
    float* gbl = (float*)(sm + 70144);
    {
        f32x4 w[2][4];
#pragma unroll
        for (int h = 0; h < 2; ++h)
#pragma unroll
            for (int q = 0; q < 4; ++q) w[h][q] = *(const f32x4*)(P.w_in + (size_t)(TID + h * 512) * W_IN + 2560 + q * 4);
#pragma unroll
        for (int h = 0; h < 2; ++h)
#pragma unroll
            for (int q = 0; q < 4; ++q)
#pragma unroll
                for (int e = 0; e < 4; ++e) { const int n = q * 4 + e, k = TID + h * 512; const float v = w[h][q][e]; const bf16_t hi = f2bf(v); Bhi[n * 1032 + k] = hi; Blo[n * 1032 + k] = f2bf(v - bf2f(hi)); }
    }
    const float* mod = (const float*)(P.ws + WS_MOD);
    bf16_t* h = (bf16_t*)(P.ws + WS_R4 + R4_H);
    float* gb = (float*)(P.ws + WS_GB);
    float* rstd_arr = (float*)(P.ws + WS_RSTD);
    float* bias = (float*)(P.ws + WS_BIAS);
    const int wid = TID >> 6, lane = TID & 63, fr = lane & 15, fq = lane >> 4;
    SYNC();
    const float* shrow = mod + (fr < 8 ? fr : 8) * 6144 + fq * 8;
    if (TID < 256) gbl[TID] = 0.f;
    SYNC();
    {
        f32x4 acc = (f32x4){0.f, 0.f, 0.f, 0.f};
#pragma unroll
        for (int k4 = 0; k4 < 4; ++k4) {
            const int ks = wid * 4 + k4;
            const f32x4 a0 = *(const f32x4*)(shrow + ks * 32), a1 = *(const f32x4*)(shrow + ks * 32 + 4);
            const float hv[8] = {a0[0], a0[1], a0[2], a0[3], a1[0], a1[1], a1[2], a1[3]};
            u32x4 whi, wlo;
#pragma unroll
            for (int e = 0; e < 4; ++e) { whi[e] = pk2(hv[2 * e], hv[2 * e + 1]); wlo[e] = pk2(hv[2 * e] - __builtin_bit_cast(float, whi[e] << 16), hv[2 * e + 1] - __builtin_bit_cast(float, whi[e] & 0xffff0000u)); }
            const bf16x8 ahi = __builtin_bit_cast(bf16x8, whi), alo = __builtin_bit_cast(bf16x8, wlo);
            const bf16x8 bhi = frag16(Bhi + fr * 1032 + ks * 32 + fq * 8), blo = frag16(Blo + fr * 1032 + ks * 32 + fq * 8);
            acc = mfma16(ahi, bhi, acc); acc = mfma16(alo, bhi, acc); acc = mfma16(ahi, blo, acc);
        }
#pragma unroll
        for (int r = 0; r < 4; ++r) atomic_add_f32(&gbl[(fq * 4 + r) * 16 + fr], acc[r]);
    }
    {
        const bf16_t* wq = (const bf16_t*)(P.ws + WS_WQKVZ); const bf16_t* wf = (const bf16_t*)(P.ws + WS_WF);
        for (int it = BID * 8 + wid; it < 192; it += NBLK * 8) {
            const int n0 = it * 16;
            const bf16_t* wrow = (n0 < 2048 ? wq + (size_t)(n0 + fr) * 1024 : wf + (size_t)(n0 - 2048 + fr) * 1024) + fq * 8;
            f32x4 acc = (f32x4){0.f, 0.f, 0.f, 0.f};
#pragma unroll 4
            for (int ks = 0; ks < 32; ++ks) {
                const f32x4 a0 = *(const f32x4*)(shrow + ks * 32), a1 = *(const f32x4*)(shrow + ks * 32 + 4);
                const float hv[8] = {a0[0], a0[1], a0[2], a0[3], a1[0], a1[1], a1[2], a1[3]};
                u32x4 whi, wlo;
#pragma unroll
                for (int e = 0; e < 4; ++e) { whi[e] = pk2(hv[2 * e], hv[2 * e + 1]); wlo[e] = pk2(hv[2 * e] - __builtin_bit_cast(float, whi[e] << 16), hv[2 * e + 1] - __builtin_bit_cast(float, whi[e] & 0xffff0000u)); }
                const bf16x8 bw = frag16(wrow + ks * 32);
                acc = mfma16(__builtin_bit_cast(bf16x8, whi), bw, acc); acc = mfma16(__builtin_bit_cast(bf16x8, wlo), bw, acc);
            }
#pragma unroll
            for (int r = 0; r < 4; ++r) { const int mbr = fq * 4 + r; if (mbr < 9) bias[mbr * 3072 + n0 + fr] = acc[r]; }
        }
    }
    for (int t = BID; t < MROWS / 128; t += NBLK) {
        const int r0 = t * 128 + wid * 16, mb = (t * 128 < NTOK) ? ((t * 128) >> 13) : 8;
        SYNC();
        { const float* scale = mod + mb * 6144 + 1024;
#pragma unroll
          for (int q = 0; q < 2; ++q) { const int k = TID + q * 512; gsv[k] = P.norm1_g[k] * (1.0f + scale[k]); } }
        SYNC();
        const int rr = r0 + fr;
        const float* src = (rr < NTOK ? P.x + (size_t)rr * D : P.ctx + (size_t)(rr - NTOK) * D) + fq * 8;
        float ss = 0.f;
        f32x4 acc = (f32x4){0.f, 0.f, 0.f, 0.f};
        bf16_t* hrow = h + (size_t)rr * D + fq * 8;
#pragma unroll 8
        for (int ks = 0; ks < 32; ++ks) {
            const f32x4 a0 = *(const f32x4*)(src + ks * 32), a1 = *(const f32x4*)(src + ks * 32 + 4);
            ss += a0[0] * a0[0] + a0[1] * a0[1] + a0[2] * a0[2] + a0[3] * a0[3] + a1[0] * a1[0] + a1[1] * a1[1] + a1[2] * a1[2] + a1[3] * a1[3];
            const f32x4 g0 = *(const f32x4*)(gsv + ks * 32 + fq * 8), g1 = *(const f32x4*)(gsv + ks * 32 + fq * 8 + 4);
            float hv[8];
#pragma unroll
            for (int e = 0; e < 4; ++e) { hv[e] = a0[e] * g0[e]; hv[4 + e] = a1[e] * g1[e]; }
            u32x4 whi, wlo;
#pragma unroll
            for (int e = 0; e < 4; ++e) { whi[e] = pk2(hv[2 * e], hv[2 * e + 1]); wlo[e] = pk2(hv[2 * e] - __builtin_bit_cast(float, whi[e] << 16), hv[2 * e + 1] - __builtin_bit_cast(float, whi[e] & 0xffff0000u)); }
            *(u32x4*)(hrow + ks * 32) = whi;
            const bf16x8 ahi = __builtin_bit_cast(bf16x8, whi), alo = __builtin_bit_cast(bf16x8, wlo);
            const bf16x8 bhi = frag16(Bhi + fr * 1032 + ks * 32 + fq * 8), blo = frag16(Blo + fr * 1032 + ks * 32 + fq * 8);
            acc = mfma16(ahi, bhi, acc); acc = mfma16(alo, bhi, acc); acc = mfma16(ahi, blo, acc);
        }
        ss += shfl_xor_f(ss, 16); ss += shfl_xor_f(ss, 32);
        const float rstd = rsq_f(ss * (1.0f / 1024.0f) + EPS);
        if (fq == 0) rstd_arr[rr] = rstd;
        float ea = 0.f, db = 0.f;
        if (fr >= 8) { ea = -__expf(P.a_log[fr - 8]); db = P.dt_bias[fr - 8]; }
        const float gbias = gbl[mb * 16 + fr];
#pragma unroll
        for (int reg = 0; reg < 4; ++reg) { const float v = acc[reg] * shfl_idx_f(rstd, fq * 4 + reg) + gbias; float o;
            if (fr < 8) o = rcp_f(1.0f + __expf(-v));
            else { const float z = v + db; const float sp = z > 20.f ? z : log1pf(__expf(z)); o = ea * sp; }
            gb[(size_t)(r0 + fq * 4 + reg) * 16 + fr] = o; }
    }
}

#ifndef CPU_EMU
namespace pg8 {
#define PG8_LAS __attribute__((address_space(3)))
constexpr int BM = 256, BK = 64, HALF = 128, HTB = HALF * BK * 2, STAGE_BYTES = 8 * HTB;
__device__ __forceinline__ int lds_byte(int r, int c) { const int st = (r >> 4) * 2 + (c >> 5), rr = r & 15, cc = c & 31, ob = rr * 64 + cc * 2; return st * 1024 + (ob ^ (((ob >> 9) & 1) << 5)); }
__device__ __forceinline__ void stage_rc(int b, int& R, int& C) { const int st = b / 1024, sb = b % 1024, swz = sb ^ (((sb >> 9) & 1) << 5); R = (st >> 1) * 16 + swz / 64; C = (st & 1) * 32 + (swz % 64) / 2; }
__device__ __forceinline__ int perm32(int rho) { const int n = rho >> 4, i = rho & 15; return 8 * (i >> 2) + 4 * n + (i & 3); }
struct Unit { int pm, pn, e, cnt; };
__device__ __forceinline__ unsigned cvt_pk_bf16(float lo, float hi) { unsigned r; asm volatile("v_cvt_pk_bf16_f32 %0, %1, %2" : "=v"(r) : "v"(lo), "v"(hi)); return r; }

template <class Prob, class Epi>
__device__ __forceinline__ void gemm_phase(PG8_LAS unsigned char* lds, const Prob& G, const Epi& E) {
    int tid_ = threadIdx.x; asm volatile("" : "+v"(tid_));
    const int tid = tid_, wid = __builtin_amdgcn_readfirstlane(tid >> 6), lane = tid & 63, wr = wid >> 2, wc = wid & 3, fr = lane & 15, fq = lane >> 4;
    const int K = G.K, nt = K / BK;
    int R0, C0; stage_rc(tid * 16, R0, C0);
    const int rA0 = R0, rA1 = R0 + 64;
    const int rB0 = Epi::PERM ? ((R0 & ~31) + perm32(R0 & 31)) : R0, rB1 = Epi::PERM ? (((R0 + 64) & ~31) + perm32((R0 + 64) & 31)) : R0 + 64;
    const unsigned ldsw = (unsigned)wid * 1024u;
    const int aoff = lds_byte(wr * 64 + fr, fq * 8), boff = lds_byte(wc * 32 + fr, fq * 8);
    const char* Ab = (const char*)G.A; const char* Bb = (const char*)G.Bt;
#define PG8_SA(b, h) (((b) * 2 + (h)) * HTB)
#define PG8_SB(b, h) ((4 + (b) * 2 + (h)) * HTB)
#define PG8_STAGE(bufoff, gbase, ub, l0, l1) do { \
        __builtin_amdgcn_global_load_lds((const unsigned*)((gbase) + (size_t)(ub) + (l0)), (PG8_LAS unsigned*)(lds + (bufoff) + ldsw), 16, 0, 0); \
        __builtin_amdgcn_global_load_lds((const unsigned*)((gbase) + (size_t)(ub) + (l1)), (PG8_LAS unsigned*)(lds + (bufoff) + ldsw + 8192), 16, 0, 0); } while (0)
#define PG8_LDA(dst, b, h) do { _Pragma("unroll") for (int m = 0; m < 4; ++m) _Pragma("unroll") for (int k = 0; k < 2; ++k) dst[m][k] = *(const PG8_LAS bf16x8*)(lds + PG8_SA(b, h) + aoff + m * 2048 + k * 1024); } while (0)
#define PG8_LDB(dst, b, h) do { _Pragma("unroll") for (int n = 0; n < 2; ++n) _Pragma("unroll") for (int k = 0; k < 2; ++k) dst[n][k] = *(const PG8_LAS bf16x8*)(lds + PG8_SB(b, h) + boff + n * 2048 + k * 1024); } while (0)
#define PG8_MMA(ai, bj, At, Bt) do { __builtin_amdgcn_s_setprio(1); _Pragma("unroll") for (int m = 0; m < 4; ++m) _Pragma("unroll") for (int n = 0; n < 2; ++n) _Pragma("unroll") for (int k = 0; k < 2; ++k) \
        acc[ai][bj][m][n] = __builtin_amdgcn_mfma_f32_16x16x32_bf16(Bt[n][k], At[m][k], acc[ai][bj][m][n], 0, 0, 0); __builtin_amdgcn_s_setprio(0); } while (0)
#define PG8_WAIT_V(n) asm volatile("s_waitcnt vmcnt(" #n ")" ::: "memory")
#define PG8_WAIT_L(n) asm volatile("s_waitcnt lgkmcnt(" #n ")" ::: "memory")
#define PG8_BAR __builtin_amdgcn_s_barrier()
#define PG8_SCHED __builtin_amdgcn_sched_barrier(0)
    Unit cur, nxt; int ui = 0;
    if (!G.next(0, cur)) return;
    f32x4 acc[2][2][4][2];
#pragma unroll
    for (int a = 0; a < 2; ++a)
#pragma unroll
        for (int b = 0; b < 2; ++b)
#pragma unroll
            for (int m = 0; m < 4; ++m)
#pragma unroll
                for (int n = 0; n < 2; ++n) acc[a][b][m][n] = (f32x4){0.f, 0.f, 0.f, 0.f};
    bf16x8 At[4][2], B0[2][2], B1[2][2];
    const unsigned cb2 = (unsigned)C0 * 2u;
    const unsigned lB00 = G.laneB(rB0) + cb2, lB01 = G.laneB(rB1) + cb2, lB10 = G.laneB(128 + rB0) + cb2, lB11 = G.laneB(128 + rB1) + cb2;
    const unsigned lA00 = G.laneA(rA0) + cb2, lA01 = G.laneA(rA1) + cb2, lA10 = G.laneA(128 + rA0) + cb2, lA11 = G.laneA(128 + rA1) + cb2;
    unsigned cA00 = lA00, cA01 = lA01, cA10 = lA10, cA11 = lA11, nA00 = lA00, nA01 = lA01, nA10 = lA10, nA11 = lA11;
    if constexpr (Prob::GATHER_A) { cA00 += G.gathA(cur, rA0); cA01 += G.gathA(cur, rA1); cA10 += G.gathA(cur, 128 + rA0); cA11 += G.gathA(cur, 128 + rA1); }
    unsigned uAc = G.baseA(cur), uBc = G.baseB(cur), uAn = uAc, uBn = uBc;
    if constexpr (Epi::PREFETCH) E.prefetch(cur, lds + STAGE_BYTES + 2048, wid, lane);
    PG8_STAGE(PG8_SB(0, 0), Bb, uBc, lB00, lB01); PG8_STAGE(PG8_SA(0, 0), Ab, uAc, cA00, cA01); PG8_STAGE(PG8_SB(0, 1), Bb, uBc, lB10, lB11); PG8_STAGE(PG8_SA(0, 1), Ab, uAc, cA10, cA11);
    if (wr == 1) PG8_BAR;
    PG8_WAIT_V(4); PG8_BAR;
    PG8_STAGE(PG8_SB(1, 0), Bb, uBc + 128u, lB00, lB01); PG8_STAGE(PG8_SA(1, 0), Ab, uAc + 128u, cA00, cA01); PG8_STAGE(PG8_SB(1, 1), Bb, uBc + 128u, lB10, lB11);
    PG8_WAIT_V(6); PG8_BAR;
    for (;;) {
        const bool has_next = G.next(ui + 1, nxt);
        if constexpr (Epi::PREFETCH) { if (has_next) E.prefetch(nxt, lds + STAGE_BYTES + 2048 + ((ui + 1) % 3) * 2048, wid, lane); }
        if (has_next) {
            uAn = G.baseA(nxt); uBn = G.baseB(nxt);
            if constexpr (Prob::GATHER_A) { nA00 = lA00 + G.gathA(nxt, rA0); nA01 = lA01 + G.gathA(nxt, rA1); nA10 = lA10 + G.gathA(nxt, 128 + rA0); nA11 = lA11 + G.gathA(nxt, 128 + rA1); }
        } else { uAn = uAc; uBn = uBc; if constexpr (Prob::GATHER_A) { nA00 = cA00; nA01 = cA01; nA10 = cA10; nA11 = cA11; } }
        for (int t = 0; t < nt; t += 2) {
            const bool last = (t == nt - 2);
            const unsigned k1 = (unsigned)(t + 1) * 128u;
            const unsigned uA2 = last ? uAn : uAc + (unsigned)(t + 2) * 128u, uB2 = last ? uBn : uBc + (unsigned)(t + 2) * 128u, uA3 = uA2 + 128u, uB3 = uB2 + 128u;
            unsigned a00 = cA00, a01 = cA01, a10 = cA10, a11 = cA11;
            if constexpr (Prob::GATHER_A) { a00 = last ? nA00 : cA00; a01 = last ? nA01 : cA01; a10 = last ? nA10 : cA10; a11 = last ? nA11 : cA11; }
            PG8_LDB(B0, 0, 0); PG8_SCHED; PG8_LDA(At, 0, 0); PG8_STAGE(PG8_SA(1, 1), Ab, uAc + k1, cA10, cA11);
            PG8_WAIT_L(8); PG8_BAR; PG8_WAIT_L(0); PG8_MMA(0, 0, At, B0); PG8_BAR; PG8_SCHED;
            PG8_LDB(B1, 0, 1); PG8_STAGE(PG8_SB(0, 0), Bb, uB2, lB00, lB01);
            PG8_BAR; PG8_WAIT_L(0); PG8_MMA(0, 1, At, B1); PG8_BAR;
            PG8_LDA(At, 0, 1); PG8_STAGE(PG8_SA(0, 0), Ab, uA2, a00, a01);
            PG8_BAR; PG8_WAIT_L(0); PG8_MMA(1, 0, At, B0); PG8_BAR; PG8_SCHED;
            PG8_STAGE(PG8_SB(0, 1), Bb, uB2, lB10, lB11);
            PG8_WAIT_V(6); PG8_BAR; PG8_MMA(1, 1, At, B1); PG8_BAR;
            PG8_LDB(B0, 1, 0); PG8_SCHED; PG8_LDA(At, 1, 0); PG8_STAGE(PG8_SA(0, 1), Ab, uA2, a10, a11);
            PG8_WAIT_L(8); PG8_BAR; PG8_WAIT_L(0); PG8_MMA(0, 0, At, B0); PG8_BAR; PG8_SCHED;
            PG8_LDB(B1, 1, 1); PG8_STAGE(PG8_SB(1, 0), Bb, uB3, lB00, lB01);
            PG8_BAR; PG8_WAIT_L(0); PG8_MMA(0, 1, At, B1); PG8_BAR;
            PG8_LDA(At, 1, 1); PG8_STAGE(PG8_SA(1, 0), Ab, uA3, a00, a01);
            PG8_BAR; PG8_WAIT_L(0); PG8_MMA(1, 0, At, B0); PG8_BAR; PG8_SCHED;
            PG8_STAGE(PG8_SB(1, 1), Bb, uB3, lB10, lB11);
            PG8_WAIT_V(6); PG8_BAR; PG8_MMA(1, 1, At, B1); PG8_BAR;
        }
        E(acc, cur, wr, wc, fr, fq, (const PG8_LAS float*)(lds + STAGE_BYTES + 2048 + (ui % 3) * 2048));
        if (!has_next) break;
#pragma unroll
        for (int a = 0; a < 2; ++a)
#pragma unroll
            for (int b = 0; b < 2; ++b)
#pragma unroll
                for (int m = 0; m < 4; ++m)
#pragma unroll
                    for (int n = 0; n < 2; ++n) acc[a][b][m][n] = (f32x4){0.f, 0.f, 0.f, 0.f};
        cur = nxt; ++ui; uAc = uAn; uBc = uBn;
        if constexpr (Prob::GATHER_A) { cA00 = nA00; cA01 = nA01; cA10 = nA10; cA11 = nA11; }
    }
    PG8_WAIT_V(0);
    if (wr == 0) PG8_BAR;
    PG8_BAR;
#undef PG8_SA
#undef PG8_SB
#undef PG8_STAGE
#undef PG8_LDA
#undef PG8_LDB
#undef PG8_MMA
#undef PG8_WAIT_V
#undef PG8_WAIT_L
#undef PG8_BAR
#undef PG8_SCHED
}

struct GridOrder {
    int nM, nN, nwg, G, c;
    __device__ __forceinline__ void init(int nM_, int nN_, int G_, int c_) { nM = nM_; nN = nN_; nwg = nM * nN; G = G_; c = c_; }
    __device__ __forceinline__ bool next(int i, Unit& u) const {
        const long L = (long)i * G + c; if (L >= nwg) return false;
        int wgid = (int)L; { const int q = nwg / 8, r = nwg % 8, xcd = wgid % 8, off = wgid / 8; wgid = (xcd < r ? xcd * (q + 1) : r * (q + 1) + (xcd - r) * q) + off; }
        const int nig = 8 * nN, gid = wgid / nig, fm = gid * 8, gsz = (nM - fm) < 8 ? (nM - fm) : 8;
        u.pm = fm + ((wgid % nig) % gsz); u.pn = (wgid % nig) / gsz; u.e = 0; u.cnt = 256; return true;
    }
};

struct ProbInproj : GridOrder { const bf16_t* A; const bf16_t* Bt; int K; static constexpr bool GATHER_A = false;
    __device__ __forceinline__ unsigned laneA(int r) const { return (unsigned)r * 2048u; }
    __device__ __forceinline__ unsigned laneB(int r) const { return (unsigned)r * 2048u; }
    __device__ __forceinline__ unsigned baseA(const Unit& u) const { return (unsigned)(u.pm * 256) * 2048u; }
    __device__ __forceinline__ unsigned baseB(const Unit& u) const { return (unsigned)(u.pn * 256) * 2048u; }
    __device__ __forceinline__ unsigned gathA(const Unit&, int) const { return 0u; } };
struct ProbGT : GridOrder { const bf16_t* A; const bf16_t* Bt; int K; static constexpr bool GATHER_A = false;
    __device__ __forceinline__ unsigned laneA(int r) const { return (unsigned)r * 2048u; }
    __device__ __forceinline__ unsigned laneB(int r) const { return (unsigned)(128 * (r & 63) + (r >> 6)) * 2048u; }
    __device__ __forceinline__ unsigned baseA(const Unit& u) const { return (unsigned)(u.pm * 256) * 2048u; }
    __device__ __forceinline__ unsigned baseB(const Unit& u) const { const int col = u.pn * 256, b = col >> 13, w = col & 8191; return (unsigned)(b * 8192 + (w >> 6)) * 2048u; }
    __device__ __forceinline__ unsigned gathA(const Unit&, int) const { return 0u; } };
struct EpiStoreBf16 {
    static constexpr bool PERM = true, PREFETCH = false; bf16_t* O; int ldc;
    __device__ __forceinline__ void operator()(const f32x4 (&acc)[2][2][4][2], const Unit& u, int wr, int wc, int fr, int fq, const PG8_LAS float* ex) const {
        const int row0 = u.pm * 256 + wr * 64 + fr, col0 = u.pn * 256 + wc * 32 + 8 * fq;
#pragma unroll
        for (int ai = 0; ai < 2; ++ai)
#pragma unroll
            for (int m = 0; m < 4; ++m) { bf16_t* rowp = O + (size_t)(row0 + ai * 128 + m * 16) * ldc + col0;
#pragma unroll
                for (int bj = 0; bj < 2; ++bj) { const f32x4 v0 = acc[ai][bj][m][0], v1 = acc[ai][bj][m][1];
                    u32x4 w; w.x = cvt_pk_bf16(v0[0], v0[1]); w.y = cvt_pk_bf16(v0[2], v0[3]); w.z = cvt_pk_bf16(v1[0], v1[1]); w.w = cvt_pk_bf16(v1[2], v1[3]);
                    *(u32x4*)(rowp + bj * 128) = w; } }
    }
};
struct EpiGT {
    static constexpr bool PERM = true, PREFETCH = true; bf16_t* O; const float* rstd; const float* bias;
    __device__ __forceinline__ void prefetch(const Unit& u, PG8_LAS unsigned char* ex, int wid, int lane) const {
        const int mb = (u.pn * 256) >> 13;
        if (wid == 0) __builtin_amdgcn_global_load_lds((const unsigned*)(bias + mb * 3072 + 2048 + u.pm * 256 + lane * 4), (PG8_LAS unsigned*)(ex + 1024), 16, 0, 0);
        else if (wid <= 4) { const int c = u.pn * 256 + (wid - 1) * 64 + lane, w = c & 8191;
            __builtin_amdgcn_global_load_lds((const unsigned*)(rstd + mb * 8192 + 128 * (w & 63) + (w >> 6)), (PG8_LAS unsigned*)(ex + (wid - 1) * 256), 4, 0, 0); }
    }
    __device__ __forceinline__ void operator()(const f32x4 (&acc)[2][2][4][2], const Unit& u, int wr, int wc, int fr, int fq, const PG8_LAS float* ex) const {
        const int row0 = u.pm * 256 + wr * 64 + fr, col0 = u.pn * 256 + wc * 32 + 8 * fq;
        float rs[2][8];
#pragma unroll
        for (int bj = 0; bj < 2; ++bj) { const f32x4 r0_ = *(const PG8_LAS f32x4*)(ex + bj * 128 + wc * 32 + 8 * fq), r1_ = *(const PG8_LAS f32x4*)(ex + bj * 128 + wc * 32 + 8 * fq + 4);
            rs[bj][0] = r0_[0]; rs[bj][1] = r0_[1]; rs[bj][2] = r0_[2]; rs[bj][3] = r0_[3]; rs[bj][4] = r1_[0]; rs[bj][5] = r1_[1]; rs[bj][6] = r1_[2]; rs[bj][7] = r1_[3]; }
#pragma unroll
        for (int ai = 0; ai < 2; ++ai)
#pragma unroll
            for (int m = 0; m < 4; ++m) { const int row = row0 + ai * 128 + m * 16; const float bg = ex[256 + wr * 64 + fr + ai * 128 + m * 16]; bf16_t* rowp = O + (size_t)row * NTOK + col0;
#pragma unroll
                for (int bj = 0; bj < 2; ++bj) { const f32x4 a0 = acc[ai][bj][m][0], a1 = acc[ai][bj][m][1];
                    u32x4 w; w.x = cvt_pk_bf16(a0[0] * rs[bj][0] + bg, a0[1] * rs[bj][1] + bg); w.y = cvt_pk_bf16(a0[2] * rs[bj][2] + bg, a0[3] * rs[bj][3] + bg);
                    w.z = cvt_pk_bf16(a1[0] * rs[bj][4] + bg, a1[1] * rs[bj][5] + bg); w.w = cvt_pk_bf16(a1[2] * rs[bj][6] + bg, a1[3] * rs[bj][7] + bg);
                    *(u32x4*)(rowp + bj * 128) = w; } }
    }
};
struct EpiInproj {
    static constexpr bool PERM = true, PREFETCH = true; bf16_t* O; bf16_t* zs; const float* rstd; const float* bias;
    __device__ __forceinline__ void prefetch(const Unit& u, PG8_LAS unsigned char* ex, int wid, int lane) const {
        if (wid == 0) __builtin_amdgcn_global_load_lds((const unsigned*)(rstd + u.pm * 256 + lane * 4), (PG8_LAS unsigned*)ex, 16, 0, 0);
        else if (wid == 1) __builtin_amdgcn_global_load_lds((const unsigned*)(bias + ((u.pm * 256 < NTOK) ? ((u.pm * 256) >> 13) : 8) * 3072 + u.pn * 256 + lane * 4), (PG8_LAS unsigned*)(ex + 1024), 16, 0, 0);
    }
    __device__ __forceinline__ void operator()(const f32x4 (&acc)[2][2][4][2], const Unit& u, int wr, int wc, int fr, int fq, const PG8_LAS float* ex) const {
        const int row0 = u.pm * 256 + wr * 64 + fr, col0 = u.pn * 256 + wc * 32 + 8 * fq;
        const bool isz = u.pn >= 6;
        if (isz && u.pm * 256 >= NTOK) return;
        f32x4 bv[2][2];
#pragma unroll
        for (int bj = 0; bj < 2; ++bj) { bv[bj][0] = *(const PG8_LAS f32x4*)(ex + 256 + bj * 128 + wc * 32 + 8 * fq); bv[bj][1] = *(const PG8_LAS f32x4*)(ex + 256 + bj * 128 + wc * 32 + 8 * fq + 4); }
#pragma unroll
        for (int ai = 0; ai < 2; ++ai)
#pragma unroll
            for (int m = 0; m < 4; ++m) { const size_t row = (size_t)(row0 + ai * 128 + m * 16); const float rs = ex[wr * 64 + fr + ai * 128 + m * 16];
                bf16_t* rowp = isz ? zs + row * 512 + (col0 - 1536) : O + row * 2048 + col0;
#pragma unroll
                for (int bj = 0; bj < 2; ++bj) { f32x4 v0 = acc[ai][bj][m][0] * rs + bv[bj][0], v1 = acc[ai][bj][m][1] * rs + bv[bj][1];
                    if (isz) {
#pragma unroll
                        for (int j = 0; j < 4; ++j) { v0[j] = v0[j] * __builtin_amdgcn_rcpf(1.0f + __expf(-v0[j])); v1[j] = v1[j] * __builtin_amdgcn_rcpf(1.0f + __expf(-v1[j])); } }
                    u32x4 w; w.x = cvt_pk_bf16(v0[0], v0[1]); w.y = cvt_pk_bf16(v0[2], v0[3]); w.z = cvt_pk_bf16(v1[0], v1[1]); w.w = cvt_pk_bf16(v1[2], v1[3]);
                    *(u32x4*)(rowp + bj * 128) = w; } }
    }
};
typedef ProbInproj ProbOut;
struct EpiResid {
    static constexpr bool PERM = false, PREFETCH = false; const float* x; const float* mod; float* out;
    __device__ __forceinline__ void operator()(const f32x4 (&acc)[2][2][4][2], const Unit& u, int wr, int wc, int fr, int fq, const PG8_LAS float* ex) const {
        const int row0 = u.pm * 256 + wr * 64 + fr, col0 = u.pn * 256 + wc * 32 + 4 * fq;
        const float* gate = mod + ((u.pm * 256) >> 13) * 6144 + 2 * 1024;
        f32x4 gv[2][2];
#pragma unroll
        for (int bj = 0; bj < 2; ++bj)
#pragma unroll
            for (int n = 0; n < 2; ++n) gv[bj][n] = *(const f32x4*)(gate + col0 + bj * 128 + n * 16);
#pragma unroll
        for (int ai = 0; ai < 2; ++ai) {
            f32x4 xv[4][2][2];
#pragma unroll
            for (int m = 0; m < 4; ++m) { const size_t off = (size_t)(row0 + ai * 128 + m * 16) * 1024 + col0;
#pragma unroll
                for (int bj = 0; bj < 2; ++bj)
#pragma unroll
                    for (int n = 0; n < 2; ++n) xv[m][bj][n] = *(const f32x4*)(x + off + bj * 128 + n * 16); }
            __builtin_amdgcn_sched_barrier(0);
#pragma unroll
            for (int m = 0; m < 4; ++m) { const size_t off = (size_t)(row0 + ai * 128 + m * 16) * 1024 + col0;
#pragma unroll
                for (int bj = 0; bj < 2; ++bj)
#pragma unroll
                    for (int n = 0; n < 2; ++n) *(f32x4*)(out + off + bj * 128 + n * 16) = xv[m][bj][n] + gv[bj][n] * acc[ai][bj][m][n]; }
        }
    }
};
struct MoeOrder {
    const PG8_LAS int* tb; const PG8_LAS int* cnt; int G, c;
    __device__ __forceinline__ bool next(int i, Unit& u) const {
        const int L = i * G + c, ntile = tb[32]; if (L >= ntile * 4) return false;
        const int tile = L >> 2; u.pn = L & 3; int e = 0;
#pragma unroll
        for (int s = 16; s >= 1; s >>= 1) if (__builtin_amdgcn_readfirstlane(tb[e + s]) <= tile) e += s;
        u.e = e; u.pm = tile; const int loc = (tile - __builtin_amdgcn_readfirstlane(tb[e])) * 256; u.cnt = __builtin_amdgcn_readfirstlane(cnt[e]) - loc; return true;
    }
};
struct ProbMoe1 : MoeOrder { const bf16_t* A; const bf16_t* Bt; int K; const unsigned* tokk; static constexpr bool GATHER_A = true;
    __device__ __forceinline__ unsigned laneA(int) const { return 0u; }
    __device__ __forceinline__ unsigned laneB(int r) const { return (unsigned)r * 2048u; }
    __device__ __forceinline__ unsigned baseA(const Unit&) const { return 0u; }
    __device__ __forceinline__ unsigned baseB(const Unit& u) const { return (unsigned)(u.e * 1024 + u.pn * 256) * 2048u; }
    __device__ __forceinline__ unsigned gathA(const Unit& u, int r) const { const int loc = (u.pm - __builtin_amdgcn_readfirstlane(tb[u.e])) * 256 + r; const unsigned tk = r < u.cnt ? tokk[(size_t)u.e * LCAP + loc] : 0u; return (tk >> 1) * 2048u; } };
struct EpiMoe1 {
    static constexpr bool PERM = true, PREFETCH = false; bf16_t* hid;
    __device__ __forceinline__ void operator()(const f32x4 (&acc)[2][2][4][2], const Unit& u, int wr, int wc, int fr, int fq, const PG8_LAS float* ex) const {
        const int row0 = u.pm * 256 + wr * 64 + fr, col0 = u.pn * 128 + wc * 32 + 8 * fq;
#pragma unroll
        for (int ai = 0; ai < 2; ++ai)
#pragma unroll
            for (int m = 0; m < 4; ++m) { float hv[8];
#pragma unroll
                for (int n = 0; n < 2; ++n)
#pragma unroll
                    for (int j = 0; j < 4; ++j) { const float g = acc[ai][0][m][n][j], up = acc[ai][1][m][n][j]; hv[n * 4 + j] = g * __builtin_amdgcn_rcpf(1.0f + __expf(-g)) * up; }
                u32x4 w; w.x = cvt_pk_bf16(hv[0], hv[1]); w.y = cvt_pk_bf16(hv[2], hv[3]); w.z = cvt_pk_bf16(hv[4], hv[5]); w.w = cvt_pk_bf16(hv[6], hv[7]);
                *(u32x4*)(hid + (size_t)(row0 + ai * 128 + m * 16) * 512 + col0) = w; }
    }
};
struct ProbMoe2 : MoeOrder { const bf16_t* A; const bf16_t* Bt; int K; static constexpr bool GATHER_A = false;
    __device__ __forceinline__ unsigned laneA(int r) const { return (unsigned)r * 1024u; }
    __device__ __forceinline__ unsigned laneB(int r) const { return (unsigned)r * 1024u; }
    __device__ __forceinline__ unsigned baseA(const Unit& u) const { return (unsigned)(u.pm * 256) * 1024u; }
    __device__ __forceinline__ unsigned baseB(const Unit& u) const { return (unsigned)(u.e * 1024 + u.pn * 256) * 1024u; }
    __device__ __forceinline__ unsigned gathA(const Unit&, int) const { return 0u; } };
struct EpiMoe2 {
    static constexpr bool PERM = true, PREFETCH = true; bf16_t* Y; const unsigned* tokk; const float* wl; const PG8_LAS int* tb;
    __device__ __forceinline__ void prefetch(const Unit& u, PG8_LAS unsigned char* ex, int wid, int lane) const {
        const size_t o = (size_t)u.e * LCAP + (u.pm - __builtin_amdgcn_readfirstlane(tb[u.e])) * 256 + lane * 4;
        if (wid == 0) __builtin_amdgcn_global_load_lds((const unsigned*)(tokk + o), (PG8_LAS unsigned*)ex, 16, 0, 0);
        else if (wid == 1) __builtin_amdgcn_global_load_lds((const unsigned*)(wl + o), (PG8_LAS unsigned*)(ex + 1024), 16, 0, 0);
    }
    __device__ __forceinline__ void operator()(const f32x4 (&acc)[2][2][4][2], const Unit& u, int wr, int wc, int fr, int fq, const PG8_LAS float* ex) const {
        const int col0 = u.pn * 256 + wc * 32 + 8 * fq;
#pragma unroll
        for (int ai = 0; ai < 2; ++ai)
#pragma unroll
            for (int m = 0; m < 4; ++m) { const int r = ai * 128 + wr * 64 + m * 16 + fr;
                if (r < u.cnt) { const unsigned tk = __builtin_bit_cast(unsigned, ex[r]); const float w = ex[256 + r];
                    bf16_t* rowp = Y + ((size_t)(tk & 1u) * NTOK + (tk >> 1)) * 1024 + col0;
#pragma unroll
                    for (int bj = 0; bj < 2; ++bj) { const f32x4 v0 = acc[ai][bj][m][0] * w, v1 = acc[ai][bj][m][1] * w;
                        u32x4 q; q.x = cvt_pk_bf16(v0[0], v0[1]); q.y = cvt_pk_bf16(v0[2], v0[3]); q.z = cvt_pk_bf16(v1[0], v1[1]); q.w = cvt_pk_bf16(v1[2], v1[3]);
                        *(u32x4*)(rowp + bj * 128) = q; } } }
    }
};

typedef int v8i32 __attribute__((ext_vector_type(8)));
typedef int v4i32 __attribute__((ext_vector_type(4)));
constexpr int F8_STAGE = 65536, F8_LDS = 2 * F8_STAGE;
template <class Prob, class Epi>
__device__ __forceinline__ void gemm_f8(PG8_LAS unsigned char* lds, const Prob& G, const Epi& E) {
    int tid_ = threadIdx.x; asm volatile("" : "+v"(tid_));
    const int tid = tid_, wid = __builtin_amdgcn_readfirstlane(tid >> 6), lane = tid & 63, wr = wid >> 2, wc = wid & 3, fr = lane & 15, fq = lane >> 4;
    const int nt = G.KB >> 7;
    int R0, C0; stage_rc(tid * 16, R0, C0);
    const unsigned cb = (unsigned)C0 * 2u, ldsw = (unsigned)wid * 1024u;
    const int aoff = lds_byte(wr * 64 + fr, fq * 8), boff = (wc >> 1) * 16384 + lds_byte((wc & 1) * 64 + fr, fq * 8);
    const char* Ab = (const char*)G.A; const char* Bb = (const char*)G.Bt;
    Unit cur, nxt;
    if (!G.next(0, cur)) return;
    const unsigned lB00 = G.laneB(R0) + cb, lB01 = G.laneB(R0 + 64) + cb, lB10 = G.laneB(128 + R0) + cb, lB11 = G.laneB(192 + R0) + cb;
    unsigned cA00 = G.rowA(cur, R0) + cb, cA01 = G.rowA(cur, R0 + 64) + cb, cA10 = G.rowA(cur, 128 + R0) + cb, cA11 = G.rowA(cur, 192 + R0) + cb;
    unsigned nA00 = cA00, nA01 = cA01, nA10 = cA10, nA11 = cA11;
    unsigned uBc = G.baseB(cur), uBn = uBc;
#define F8_ISSUE(buf, a00, a01, a10, a11, ub, kb) do { PG8_LAS unsigned char* sb_ = lds + (buf) * F8_STAGE + ldsw; \
        __builtin_amdgcn_global_load_lds((const unsigned*)(Ab + (size_t)((a00) + (kb))), (PG8_LAS unsigned*)(sb_), 16, 0, 0); \
        __builtin_amdgcn_global_load_lds((const unsigned*)(Ab + (size_t)((a01) + (kb))), (PG8_LAS unsigned*)(sb_ + 8192), 16, 0, 0); \
        __builtin_amdgcn_global_load_lds((const unsigned*)(Ab + (size_t)((a10) + (kb))), (PG8_LAS unsigned*)(sb_ + 16384), 16, 0, 0); \
        __builtin_amdgcn_global_load_lds((const unsigned*)(Ab + (size_t)((a11) + (kb))), (PG8_LAS unsigned*)(sb_ + 24576), 16, 0, 0); \
        __builtin_amdgcn_global_load_lds((const unsigned*)(Bb + (size_t)(ub) + (size_t)(lB00 + (kb))), (PG8_LAS unsigned*)(sb_ + 32768), 16, 0, 0); \
        __builtin_amdgcn_global_load_lds((const unsigned*)(Bb + (size_t)(ub) + (size_t)(lB01 + (kb))), (PG8_LAS unsigned*)(sb_ + 40960), 16, 0, 0); \
        __builtin_amdgcn_global_load_lds((const unsigned*)(Bb + (size_t)(ub) + (size_t)(lB10 + (kb))), (PG8_LAS unsigned*)(sb_ + 49152), 16, 0, 0); \
        __builtin_amdgcn_global_load_lds((const unsigned*)(Bb + (size_t)(ub) + (size_t)(lB11 + (kb))), (PG8_LAS unsigned*)(sb_ + 57344), 16, 0, 0); } while (0)
    f32x4 acc[2][4][4];
#pragma unroll
    for (int a = 0; a < 2; ++a)
#pragma unroll
        for (int m = 0; m < 4; ++m)
#pragma unroll
            for (int n = 0; n < 4; ++n) acc[a][m][n] = (f32x4){0.f, 0.f, 0.f, 0.f};
    F8_ISSUE(0, cA00, cA01, cA10, cA11, uBc, 0u);
    int g = 0, ui = 0;
    for (;;) {
        const bool has_next = G.next(ui + 1, nxt);
        if (has_next) { nA00 = G.rowA(nxt, R0) + cb; nA01 = G.rowA(nxt, R0 + 64) + cb; nA10 = G.rowA(nxt, 128 + R0) + cb; nA11 = G.rowA(nxt, 192 + R0) + cb; uBn = G.baseB(nxt); }
        else { nA00 = cA00; nA01 = cA01; nA10 = cA10; nA11 = cA11; uBn = uBc; }
#pragma unroll 1
        for (int kt = 0; kt < nt; ++kt) {
            asm volatile("s_waitcnt vmcnt(0)" ::: "memory");
            __builtin_amdgcn_s_barrier();
            asm volatile("" ::: "memory");
            {
                const bool wrap = kt + 1 >= nt; const unsigned kb = wrap ? 0u : (unsigned)(kt + 1) * 128u;
                const unsigned a00 = wrap ? nA00 : cA00, a01 = wrap ? nA01 : cA01, a10 = wrap ? nA10 : cA10, a11 = wrap ? nA11 : cA11, ub = wrap ? uBn : uBc;
                F8_ISSUE((g + 1) & 1, a00, a01, a10, a11, ub, kb);
            }
            PG8_LAS unsigned char* st = lds + (g & 1) * F8_STAGE;
            v8i32 B8[4];
#pragma unroll
            for (int n = 0; n < 4; ++n) { const v4i32 lo = *(const PG8_LAS v4i32*)(st + 32768 + boff + n * 2048), hi = *(const PG8_LAS v4i32*)(st + 32768 + boff + n * 2048 + 1024);
                B8[n] = __builtin_shufflevector(lo, hi, 0, 1, 2, 3, 4, 5, 6, 7); }
#pragma unroll
            for (int ai = 0; ai < 2; ++ai) {
                v8i32 A8[4];
#pragma unroll
                for (int m = 0; m < 4; ++m) { const v4i32 lo = *(const PG8_LAS v4i32*)(st + ai * 16384 + aoff + m * 2048), hi = *(const PG8_LAS v4i32*)(st + ai * 16384 + aoff + m * 2048 + 1024);
                    A8[m] = __builtin_shufflevector(lo, hi, 0, 1, 2, 3, 4, 5, 6, 7); }
                asm volatile("s_waitcnt lgkmcnt(0)" ::: "memory");
                __builtin_amdgcn_s_setprio(1);
#pragma unroll
                for (int m = 0; m < 4; ++m)
#pragma unroll
                    for (int n = 0; n < 4; ++n) acc[ai][m][n] = __builtin_amdgcn_mfma_scale_f32_16x16x128_f8f6f4(B8[n], A8[m], acc[ai][m][n], 0, 0, 0, 0, 0, 0);
                __builtin_amdgcn_s_setprio(0);
            }
            ++g;
        }
        E(acc, cur, wr, wc, fr, fq);
        if (!has_next) break;
#pragma unroll
        for (int a = 0; a < 2; ++a)
#pragma unroll
            for (int m = 0; m < 4; ++m)
#pragma unroll
                for (int n = 0; n < 4; ++n) acc[a][m][n] = (f32x4){0.f, 0.f, 0.f, 0.f};
        cur = nxt; ++ui; cA00 = nA00; cA01 = nA01; cA10 = nA10; cA11 = nA11; uBc = uBn;
    }
    asm volatile("s_waitcnt vmcnt(0)" ::: "memory");
    __builtin_amdgcn_s_barrier();
#undef F8_ISSUE
}
struct MoeOrder8 {
    const PG8_LAS int* tb; const PG8_LAS int* cnt; int G, c;
    __device__ __forceinline__ bool next(int i, Unit& u) const {
        const int ntile = __builtin_amdgcn_readfirstlane(tb[32]), xj = c >> 3, tile = i * (G >> 2) + (c & 7) * (G >> 5) + (xj >> 2); if (tile >= ntile) return false;
        u.pn = xj & 3; int e = 0;
#pragma unroll
        for (int s = 16; s >= 1; s >>= 1) if (__builtin_amdgcn_readfirstlane(tb[e + s]) <= tile) e += s;
        u.e = e; u.pm = tile; const int loc = (tile - __builtin_amdgcn_readfirstlane(tb[e])) * 256; u.cnt = __builtin_amdgcn_readfirstlane(cnt[e]) - loc; return true;
    }
};
struct ProbMoe1F8 : MoeOrder8 { const unsigned char* A; const unsigned char* Bt; int KB; const unsigned* tokk;
    __device__ __forceinline__ unsigned laneB(int r) const { return (unsigned)r * 1024u; }
    __device__ __forceinline__ unsigned baseB(const Unit& u) const { return (unsigned)((u.e * 4 + u.pn) * 256) * 1024u; }
    __device__ __forceinline__ unsigned rowA(const Unit& u, int r) const { const int loc = (u.pm - __builtin_amdgcn_readfirstlane(tb[u.e])) * 256 + r; const unsigned tk = r < u.cnt ? tokk[(size_t)u.e * LCAP + loc] : 0u; return (tk >> 1) * 1024u; } };
struct EpiMoe1F8 {
    unsigned char* hid;
    __device__ __forceinline__ void operator()(const f32x4 (&acc)[2][4][4], const Unit& u, int wr, int wc, int fr, int fq) const {
        const int row0 = u.pm * 256 + wr * 64 + fr, col0 = u.pn * 128 + wc * 32 + fq * 8;
#pragma unroll
        for (int ai = 0; ai < 2; ++ai)
#pragma unroll
            for (int m = 0; m < 4; ++m) { u32x2 q;
#pragma unroll
                for (int n2 = 0; n2 < 2; ++n2) { float hv[4];
#pragma unroll
                    for (int j = 0; j < 4; ++j) { const float g = acc[ai][m][n2][j] * 0.03125f, up = acc[ai][m][2 + n2][j] * 0.03125f; hv[j] = g * __builtin_amdgcn_rcpf(1.0f + __expf(-g)) * up; }
                    q[n2] = pk4_fp8(hv[0], hv[1], hv[2], hv[3]); }
                *(u32x2*)(hid + (size_t)(row0 + ai * 128 + m * 16) * 512 + col0) = q; }
    }
};
struct ProbMoe2F8 : MoeOrder8 { const unsigned char* A; const unsigned char* Bt; int KB;
    __device__ __forceinline__ unsigned laneB(int r) const { return (unsigned)r * 512u; }
    __device__ __forceinline__ unsigned baseB(const Unit& u) const { return (unsigned)(u.e * 1024 + u.pn * 256) * 512u; }
    __device__ __forceinline__ unsigned rowA(const Unit& u, int r) const { return (unsigned)(u.pm * 256 + r) * 512u; } };
struct EpiMoe2F8 {
    unsigned char* Y; const unsigned* tokk; const float* wl; const PG8_LAS int* tb;
    __device__ __forceinline__ void operator()(const f32x4 (&acc)[2][4][4], const Unit& u, int wr, int wc, int fr, int fq) const {
        const int col0 = u.pn * 256 + wc * 64 + 16 * fq, locb = (u.pm - __builtin_amdgcn_readfirstlane(tb[u.e])) * 256;
#pragma unroll
        for (int ai = 0; ai < 2; ++ai)
#pragma unroll
            for (int m = 0; m < 4; ++m) { const int r = ai * 128 + wr * 64 + m * 16 + fr;
                if (r < u.cnt) { const unsigned tk = tokk[(size_t)u.e * LCAP + locb + r]; const float w = wl[(size_t)u.e * LCAP + locb + r] * 0.5f;
                    unsigned char* rowp = Y + ((size_t)(tk & 1u) * NTOK + (tk >> 1)) * 1024 + col0;
                    u32x4 q;
#pragma unroll
                    for (int n = 0; n < 4; ++n) { const f32x4 v = acc[ai][m][n] * w; q[n] = pk4_fp8(v[0], v[1], v[2], v[3]); }
                    *(u32x4*)rowp = q; } }
    }
};
}
#endif

DEV void conv_row_compute(const Params& P, const bf16_t* ring, const float* wts, int s0, int s1, int s2, int ntap_rows, int slab, bf16_t* dst, int tid) {
    const int cq = tid & 31, tg = tid >> 5;
    typedef float f32x2 __attribute__((ext_vector_type(2)));
    f32x2 acc2[4][2];
#pragma unroll
    for (int t = 0; t < 4; ++t) { acc2[t][0] = (f32x2){0.f, 0.f}; acc2[t][1] = (f32x2){0.f, 0.f}; }
#pragma unroll
    for (int ky = 0; ky < 3; ++ky) {
        if (ntap_rows == 1 && ky != 1) continue;
        const int sl = ky == 0 ? s0 : ky == 1 ? s1 : s2;
        f32x2 w[3][2];
#pragma unroll
        for (int kx = 0; kx < 3; ++kx) { const f32x4 t = *(const f32x4*)(wts + (ky * 3 + kx) * 128 + cq * 4); w[kx][0] = (f32x2){t[0], t[1]}; w[kx][1] = (f32x2){t[2], t[3]}; }
        f32x2 in[6][2];
#pragma unroll
        for (int pos = 0; pos < 6; ++pos) { const u32x2 v = *(const u32x2*)(ring + sl * 8448 + (tg * 4 + pos) * 128 + cq * 4);
            in[pos][0] = (f32x2){__builtin_bit_cast(float, v[0] << 16), __builtin_bit_cast(float, v[0] & 0xffff0000u)}; in[pos][1] = (f32x2){__builtin_bit_cast(float, v[1] << 16), __builtin_bit_cast(float, v[1] & 0xffff0000u)}; }
#pragma unroll
        for (int t = 0; t < 4; ++t)
#pragma unroll
            for (int kx = 0; kx < 3; ++kx) { acc2[t][0] += w[kx][0] * in[t + kx][0]; acc2[t][1] += w[kx][1] * in[t + kx][1]; }
    }
    float acc[4][4];
#pragma unroll
    for (int t = 0; t < 4; ++t) { acc[t][0] = acc2[t][0][0]; acc[t][1] = acc2[t][0][1]; acc[t][2] = acc2[t][1][0]; acc[t][3] = acc2[t][1][1]; }
#pragma unroll
    for (int t = 0; t < 4; ++t) {
        float ss = 0.f;
#pragma unroll
        for (int c = 0; c < 4; ++c) { acc[t][c] = silu_f(acc[t][c]); ss += acc[t][c] * acc[t][c]; }
        if (slab < 8) { ss += shfl_xor_f(ss, 1); ss += shfl_xor_f(ss, 2); ss += shfl_xor_f(ss, 4); ss += shfl_xor_f(ss, 8); ss += shfl_xor_f(ss, 16); const float sc = rsq_f(ss + EPS);
#pragma unroll
            for (int c = 0; c < 4; ++c) acc[t][c] *= sc; }
        u32x2 o; o[0] = pk2(acc[t][0], acc[t][1]); o[1] = pk2(acc[t][2], acc[t][3]);
        *(u32x2*)(dst + (size_t)(tg * 4 + t) * 1536 + cq * 4) = o;
    }
}

DEV void phase3_conv(const Params& P, unsigned char* sm) {
    PHASE_TID;
    const bf16_t* p = (const bf16_t*)(P.ws + WS_R4 + R4_P);
    bf16_t* qkvn = (bf16_t*)(P.ws + WS_R3);
    bf16_t* ring = (bf16_t*)sm;
    float* wts = (float*)(sm + 3 * 16896);
    const u32x4 zero4 = (u32x4){0u, 0u, 0u, 0u};
    for (int it = BID; it < NB * 12 * 8; it += NBLK) {
        const int slab = it % 12, yb = (it / 12) & 7, b = it / 96, y0 = yb * 16;
        const bf16_t* src = p + (size_t)(b * SEQ) * 2048 + slab * 128;
        if (TID < 96) { const int sl = TID / 32, w = TID & 31, cc = (w >> 4) * 65, pc = w & 15; *(u32x4*)(ring + sl * 8448 + cc * 128 + pc * 8) = zero4; }
        if (TID < 288) *(f32x4*)(wts + TID * 4) = *(const f32x4*)(P.conv_w + (size_t)(TID >> 5) * 1536 + slab * 128 + (TID & 31) * 4);
        const int tk0 = TID >> 4, pc = TID & 15;
        u32x4 rr[4][2];
#define CV_LOAD(set, y) do { const bool ok_ = (y) >= 0 && (y) < 128; const int yc_ = ok_ ? (y) : y0;        \
            const u32x4 t0_ = *(const u32x4*)(src + (size_t)(yc_ * 64 + tk0) * 2048 + pc * 8), t1_ = *(const u32x4*)(src + (size_t)(yc_ * 64 + tk0 + 32) * 2048 + pc * 8); \
            rr[set][0] = ok_ ? t0_ : zero4; rr[set][1] = ok_ ? t1_ : zero4; } while (0)
#define CV_STORE(set, slot) do { *(u32x4*)(ring + (slot) * 8448 + (tk0 + 1) * 128 + pc * 8) = rr[set][0]; *(u32x4*)(ring + (slot) * 8448 + (tk0 + 33) * 128 + pc * 8) = rr[set][1]; } while (0)
        CV_LOAD(0, y0 - 1); CV_LOAD(1, y0); CV_LOAD(2, y0 + 1); CV_LOAD(3, y0 + 2);
        CV_STORE(0, 0); CV_STORE(1, 1);
        CV_LOAD(0, y0 + 3);
#pragma unroll 1
        for (int y4 = 0; y4 < 16; y4 += 4) {
#pragma unroll
            for (int u = 0; u < 4; ++u) {
                const int yy = y4 + u;
                const int s0 = yy % 3, s1 = (yy + 1) % 3, s2 = (yy + 2) % 3;
                CV_STORE((u + 2) & 3, s2);
                SYNC();
                CV_LOAD((u + 1) & 3, (yy + 4 <= 16) ? y0 + yy + 4 : 999);
                conv_row_compute(P, ring, wts, s0, s1, s2, 3, slab, qkvn + (size_t)(b * SEQ + (y0 + yy) * 64) * 1536 + slab * 128, TID);
                SYNC();
            }
        }
#undef CV_LOAD
#undef CV_STORE
    }
    for (int it = BID; it < NB * 12 * 4; it += NBLK) {
        const int slab = it % 12, sg = (it / 12) & 3, b = it / 48;
        const bf16_t* src = p + (size_t)(NTOK + b * CTX) * 2048 + slab * 128;
        if (TID < 288) *(f32x4*)(wts + TID * 4) = *(const f32x4*)(P.conv_w + (size_t)(TID >> 5) * 1536 + slab * 128 + (TID & 31) * 4);
        u32x4 r[3];
#pragma unroll
        for (int q = 0; q < 3; ++q) { const int idx = TID + q * 512; r[q] = zero4;
            if (idx < 66 * 16) { const int cc = idx >> 4, pc = idx & 15, tok = sg * 64 + cc - 1; if (tok >= 0 && tok < CTX) r[q] = *(const u32x4*)(src + (size_t)tok * 2048 + pc * 8); } }
#pragma unroll
        for (int q = 0; q < 3; ++q) { const int idx = TID + q * 512; if (idx < 66 * 16) { const int cc = idx >> 4, pc = idx & 15; *(u32x4*)(ring + 1 * 8448 + cc * 128 + pc * 8) = r[q]; } }
        SYNC();
        conv_row_compute(P, ring, wts, 0, 1, 2, 1, slab, qkvn + (size_t)(NTOK + b * CTX + sg * 64) * 1536 + slab * 128, TID);
        SYNC();
    }
}

constexpr int L_K = 0, L_Q = 17408, L_V = 34816, L_KTR = 52224, L_VT = 70656, L_X0F = 89088, L_X0TF = 98304, L_TTF = 107520, L_X0B = 116736, L_X0TB = 125952, L_TTB = 135168, L_GC = 144384, L_SCAL = 161824;
constexpr int L_X1F = 0, L_X1TF = 9216, L_X1B = 18432, L_X1TB = 27648, L_WF = 0, L_WB = 17408, L_AF = 145440, L_AB = 153632;

DEV int chunk_row(int chain, int step, int i) {
    const int b = chain >> 3, dir = chain & 1;
    if (step < 4) { const int pos = step * 64 + i; return NTOK + b * CTX + (dir ? (CTX - 1 - pos) : pos); }
    const int pos = (step - 4) * 64 + i; return b * SEQ + (dir ? (SEQ - 1 - pos) : pos);
}

DEV int img_piece_A(int row, int col0) { return (((row >> 4) * 2 + (col0 >> 5)) * 64 + ((col0 & 31) >> 3) * 16 + (row & 15)) * 16 + ((col0 >> 2) & 1) * 8; }
DEV int img_piece_W(int row, int d0) { return (((row >> 4) * 4 + (d0 >> 5)) * 64 + ((d0 & 31) >> 3) * 16 + (row & 15)) * 16; }

DEV void phase4_prepass(const Params& P, unsigned char* sm) {
    PHASE_TID;
    const bf16_t* qkvn = (const bf16_t*)(P.ws + WS_R3);
    const float* gb = (const float*)(P.ws + WS_GB);
    unsigned char* images = P.ws + WS_R4;
    bf16_t* Ks = (bf16_t*)(sm + L_K); bf16_t* Qs = (bf16_t*)(sm + L_Q); bf16_t* Vs = (bf16_t*)(sm + L_V); bf16_t* KTR = (bf16_t*)(sm + L_KTR); bf16_t* VT = (bf16_t*)(sm + L_VT);
    float* gcf = (float*)(sm + L_GC); float* gcb = gcf + 64; float* btf = gcf + 128; float* btb = gcf + 192;
    const float QSCALE = 0.08838834764831845f;
    const f32x4 z4 = (f32x4){0.f, 0.f, 0.f, 0.f};
    u32x4 pf[6]; float gfp, bfp, gbp, bbp, gbr;
#define PP_ROW0(it_) ((((it_) % NSTEP) < 4) ? NTOK + ((it_) / NSTEP / 4) * CTX + ((it_) % NSTEP) * 64 : ((it_) / NSTEP / 4) * SEQ + (((it_) % NSTEP) - 4) * 64)
#define PP_LOAD(it_) do { const int row0_ = PP_ROW0(it_), h_ = ((it_) / NSTEP) & 3; \
        _Pragma("unroll") for (int q = 0; q < 6; ++q) { const int idx = TID + q * 512, piece = idx & 15, i = (idx >> 4) & 63, which = idx >> 10; \
            pf[q] = *(const u32x4*)(qkvn + (size_t)(row0_ + i) * 1536 + which * 512 + h_ * 128 + piece * 8); } \
        { const int ln_ = TID & 63; const float* gr = gb + (size_t)(row0_ + ln_) * 16; gfp = gr[8 + h_]; bfp = gr[h_]; gbp = gr[12 + h_]; bbp = gr[4 + h_]; gbr = gb[(size_t)(row0_ + 63 - ln_) * 16 + 12 + h_]; } } while (0)
    const int NIT = NB * 4 * NSTEP;
    int it = BID;
    if (it < NIT) PP_LOAD(it);
    for (; it < NIT; it += NBLK) {
        int tq_ = TID;
#ifndef CPU_EMU
        asm volatile("" : "+v"(tq_));
#endif
        const int wid = tq_ >> 6, lane = tq_ & 63, fr = lane & 15, fq = lane >> 4;
        const int bh = it / NSTEP, st = it - bh * NSTEP;
        const int stb = st < 4 ? 3 - st : 4 + (127 - (st - 4));
        unsigned char* imgf = images + ((size_t)(bh * 2) * NSTEP + st) * IMG_BYTES;
        unsigned char* imgb = images + ((size_t)(bh * 2 + 1) * NSTEP + stb) * IMG_BYTES;
#pragma unroll
        for (int q = 0; q < 6; ++q) { const int idx = TID + q * 512, piece = idx & 15, i = (idx >> 4) & 63, which = idx >> 10;
            *(u32x4*)((which == 0 ? Qs : which == 1 ? Ks : Vs) + i * 136 + piece * 8) = pf[q]; }
        if (wid == 0) { float g = gfp;
#pragma unroll
            for (int o = 1; o < 64; o <<= 1) { const float t = shfl_up_f(g, o); if (lane >= o) g += t; }
            gcf[lane] = g; btf[lane] = bfp; }
        if (wid == 1) { float g = gbr;
#pragma unroll
            for (int o = 1; o < 64; o <<= 1) { const float t = shfl_up_f(g, o); if (lane >= o) g += t; }
            gcb[63 - lane] = g; btb[lane] = bbp; }
        { const int nx = (it + NBLK < NIT) ? it + NBLK : it; PP_LOAD(nx); }
        SYNC();
        const float glf = gcf[63], glb = gcb[0];
        bf16_t* X0F = (bf16_t*)(sm + L_X0F); bf16_t* X0TF = (bf16_t*)(sm + L_X0TF); bf16_t* TTF = (bf16_t*)(sm + L_TTF);
        bf16_t* X0B = (bf16_t*)(sm + L_X0B); bf16_t* X0TB = (bf16_t*)(sm + L_X0TB); bf16_t* TTB = (bf16_t*)(sm + L_TTB);
        f32x4 TregF[2], TTregF[2], TregB[2], TTregB[2];
#pragma unroll
        for (int tt = 0; tt < 2; ++tt) {
            const int t = wid * 2 + tt, ti = t >> 2, tj = t & 3;
            f32x4 kk = z4, kkT = z4, qkT = z4;
#pragma unroll
            for (int ks = 0; ks < 4; ++ks) {
                const bf16x8 fKi = frag16(Ks + (ti * 16 + fr) * 136 + ks * 32 + fq * 8), fKj = frag16(Ks + (tj * 16 + fr) * 136 + ks * 32 + fq * 8), fQi = frag16(Qs + (ti * 16 + fr) * 136 + ks * 32 + fq * 8);
                kk = mfma16(fKi, fKj, kk); kkT = mfma16(fKj, fKi, kkT); qkT = mfma16(fKj, fQi, qkT);
            }
            {
              const int j = tj * 16 + fr; const float gfj = gcf[j], gbj = gcb[j]; float mf[4], mb_[4];
#pragma unroll
              for (int r = 0; r < 4; ++r) { const int i = ti * 16 + fq * 4 + r;
                  const float ef = __expf(fminf(gcf[i] - gfj, 0.f)) * btf[i] * kk[r], eb = __expf(fminf(gcb[i] - gbj, 0.f)) * btb[i] * kk[r];
                  mf[r] = (i > j) ? ef : 0.f; TregF[tt][r] = (i == j ? 1.0f : 0.0f) - mf[r];
                  mb_[r] = (i < j) ? eb : 0.f; TregB[tt][r] = (i == j ? 1.0f : 0.0f) - mb_[r]; }
              u32x2 w; const int o_ = j * 72 + ti * 16 + fq * 4;
              w[0] = pk2(mf[0], mf[1]); w[1] = pk2(mf[2], mf[3]); *(u32x2*)(X0TF + o_) = w;
              w[0] = pk2(TregF[tt][0], TregF[tt][1]); w[1] = pk2(TregF[tt][2], TregF[tt][3]); *(u32x2*)(TTF + o_) = w;
              w[0] = pk2(mb_[0], mb_[1]); w[1] = pk2(mb_[2], mb_[3]); *(u32x2*)(X0TB + o_) = w;
              w[0] = pk2(TregB[tt][0], TregB[tt][1]); w[1] = pk2(TregB[tt][2], TregB[tt][3]); *(u32x2*)(TTB + o_) = w; }
            SCHED_FENCE();
            {
              const int i = ti * 16 + fr, j0 = tj * 16 + fq * 4; const float gfi = gcf[i], gbi = gcb[i], bfi = btf[i], bbi = btb[i]; float mf[4], af[4], mb_[4], ab[4];
#pragma unroll
              for (int r = 0; r < 4; ++r) { const int j = j0 + r;
                  const float ef = __expf(fminf(gfi - gcf[j], 0.f)), eb = __expf(fminf(gbi - gcb[j], 0.f));
                  const float df = (i >= j) ? ef : 0.f, db = (i <= j) ? eb : 0.f;
                  mf[r] = (i > j) ? bfi * kkT[r] * ef : 0.f; TTregF[tt][r] = (i == j ? 1.0f : 0.0f) - mf[r]; af[r] = qkT[r] * QSCALE * df;
                  mb_[r] = (i < j) ? bbi * kkT[r] * eb : 0.f; TTregB[tt][r] = (i == j ? 1.0f : 0.0f) - mb_[r]; ab[r] = qkT[r] * QSCALE * db; }
              u32x2 w; const int o_ = i * 72 + j0;
              w[0] = pk2(mf[0], mf[1]); w[1] = pk2(mf[2], mf[3]); *(u32x2*)(X0F + o_) = w;
              w[0] = pk2(mb_[0], mb_[1]); w[1] = pk2(mb_[2], mb_[3]); *(u32x2*)(X0B + o_) = w;
              w[0] = pk2(af[0], af[1]); w[1] = pk2(af[2], af[3]); *(u32x2*)((bf16_t*)(sm + L_AF) + i * 64 + j0) = w;
              w[0] = pk2(ab[3], ab[2]); w[1] = pk2(ab[1], ab[0]); *(u32x2*)((bf16_t*)(sm + L_AB) + (63 - i) * 64 + 60 - j0) = w; }
            SCHED_FENCE();
        }
        if (TID < 64) { float* sf = (float*)(sm + L_SCAL), *sb = (float*)(sm + L_SCAL + 288);
            sf[4 + TID] = QSCALE * __expf(gcf[TID]); sb[4 + TID] = QSCALE * __expf(gcb[63 - TID]); }
        {
            const int dcol = wid * 16 + fr, ks = wid >> 1;
            bf16x8 idf;
#pragma unroll
            for (int j = 0; j < 8; ++j) idf[j] = (dcol == ks * 32 + fq * 8 + j) ? (short)0x3F80 : (short)0;
#pragma unroll
            for (int t4 = 0; t4 < 4; ++t4) {
                const f32x4 kt = mfma16(frag16(Ks + (t4 * 16 + fr) * 136 + ks * 32 + fq * 8), idf, z4);
                const f32x4 vt = mfma16(frag16(Vs + (t4 * 16 + fr) * 136 + ks * 32 + fq * 8), idf, z4);
                const int tok = t4 * 16 + fq * 4;
                u32x2 w; w[0] = pk2(kt[0], kt[1]); w[1] = pk2(kt[2], kt[3]); *(u32x2*)(KTR + dcol * 72 + tok) = w;
                w[0] = pk2(vt[0], vt[1]); w[1] = pk2(vt[2], vt[3]); *(u32x2*)(VT + dcol * 72 + tok) = w;
                SCHED_FENCE();
            }
        }
        SYNC();
#pragma unroll 1
        for (int s5 = 0; s5 < 5; ++s5) {
            const bf16_t* PcF = (bf16_t*)(sm + ((s5 & 1) ? L_X1F : L_X0F)); const bf16_t* PcTF = (bf16_t*)(sm + ((s5 & 1) ? L_X1TF : L_X0TF));
            bf16_t* PnF = (bf16_t*)(sm + ((s5 & 1) ? L_X0F : L_X1F)); bf16_t* PnTF = (bf16_t*)(sm + ((s5 & 1) ? L_X0TF : L_X1TF));
            const bf16_t* PcB = (bf16_t*)(sm + ((s5 & 1) ? L_X1B : L_X0B)); const bf16_t* PcTB = (bf16_t*)(sm + ((s5 & 1) ? L_X1TB : L_X0TB));
            bf16_t* PnB = (bf16_t*)(sm + ((s5 & 1) ? L_X0B : L_X1B)); bf16_t* PnTB = (bf16_t*)(sm + ((s5 & 1) ? L_X0TB : L_X1TB));
#pragma unroll
            for (int tt = 0; tt < 2; ++tt) {
                const int t = wid * 2 + tt, ti = t >> 2, tj = t & 3;
                f32x4 p2 = z4, p2T = z4, q2 = z4, q2T = z4;
#pragma unroll
                for (int ks = 0; ks < 2; ++ks) { const int oa = (ti * 16 + fr) * 72 + ks * 32 + fq * 8, ob = (tj * 16 + fr) * 72 + ks * 32 + fq * 8;
                    const bf16x8 a = frag16(PcF + oa), b = frag16(PcTF + ob), c = frag16(PcB + oa), d = frag16(PcTB + ob);
                    p2 = mfma16(a, b, p2); p2T = mfma16(b, a, p2T); q2 = mfma16(c, d, q2); q2T = mfma16(d, c, q2T); }
                u32x2 w; const int oT = (tj * 16 + fr) * 72 + ti * 16 + fq * 4, oN = (ti * 16 + fr) * 72 + tj * 16 + fq * 4;
                w[0] = pk2(p2[0], p2[1]); w[1] = pk2(p2[2], p2[3]); *(u32x2*)(PnTF + oT) = w;
                w[0] = pk2(p2T[0], p2T[1]); w[1] = pk2(p2T[2], p2T[3]); *(u32x2*)(PnF + oN) = w;
                w[0] = pk2(q2[0], q2[1]); w[1] = pk2(q2[2], q2[3]); *(u32x2*)(PnTB + oT) = w;
                w[0] = pk2(q2T[0], q2T[1]); w[1] = pk2(q2T[2], q2T[3]); *(u32x2*)(PnB + oN) = w;
            }
            SYNC();
#pragma unroll
            for (int tt = 0; tt < 2; ++tt) {
                const int t = wid * 2 + tt, ti = t >> 2, tj = t & 3;
#pragma unroll
                for (int ks = 0; ks < 2; ++ks) { const int oa = (ti * 16 + fr) * 72 + ks * 32 + fq * 8, ob = (tj * 16 + fr) * 72 + ks * 32 + fq * 8;
                    const bf16x8 a = frag16(PnF + oa), b = frag16(TTF + ob), c = frag16(PnB + oa), d = frag16(TTB + ob);
                    TregF[tt] = mfma16(a, b, TregF[tt]); TTregF[tt] = mfma16(b, a, TTregF[tt]); TregB[tt] = mfma16(c, d, TregB[tt]); TTregB[tt] = mfma16(d, c, TTregB[tt]); }
            }
            SYNC();
            if (s5 < 4) {
#pragma unroll
                for (int tt = 0; tt < 2; ++tt) { const int t = wid * 2 + tt, ti = t >> 2, tj = t & 3, oT = (tj * 16 + fr) * 72 + ti * 16 + fq * 4;
                    u32x2 w; w[0] = pk2(TregF[tt][0], TregF[tt][1]); w[1] = pk2(TregF[tt][2], TregF[tt][3]); *(u32x2*)(TTF + oT) = w;
                    w[0] = pk2(TregB[tt][0], TregB[tt][1]); w[1] = pk2(TregB[tt][2], TregB[tt][3]); *(u32x2*)(TTB + oT) = w; }
            }
        }
#pragma unroll
        for (int tt = 0; tt < 2; ++tt) {
            const int t = wid * 2 + tt, ti = t >> 2, tj = t & 3, i = ti * 16 + fr, j0 = tj * 16 + fq * 4;
            const f32x4 bq = *(const f32x4*)(btf + j0), gq = *(const f32x4*)(gcf + j0), cq = *(const f32x4*)(btb + j0), hq = *(const f32x4*)(gcb + j0);
            float tu[4], tw[4], su[4], sw[4];
#pragma unroll
            for (int r = 0; r < 4; ++r) { tu[r] = TTregF[tt][r] * bq[r]; tw[r] = tu[r] * __expf(gq[r]); su[r] = TTregB[tt][r] * cq[r]; sw[r] = su[r] * __expf(hq[r]); }
            u32x2 w; const int o_ = i * 72 + j0;
            w[0] = pk2(tu[0], tu[1]); w[1] = pk2(tu[2], tu[3]); *(u32x2*)(X0F + o_) = w;
            w[0] = pk2(tw[0], tw[1]); w[1] = pk2(tw[2], tw[3]); *(u32x2*)(X0TF + o_) = w;
            w[0] = pk2(su[0], su[1]); w[1] = pk2(su[2], su[3]); *(u32x2*)(X0B + o_) = w;
            w[0] = pk2(sw[0], sw[1]); w[1] = pk2(sw[2], sw[3]); *(u32x2*)(X0TB + o_) = w;
        }
        if (TID == 0) { float* scp = (float*)(sm + L_SCAL); scp[0] = __expf(glf); scp[1] = 0.f; scp[2] = 0.f; scp[3] = 0.f; scp[72] = __expf(glb); scp[73] = 0.f; scp[74] = 0.f; scp[75] = 0.f; }
        SYNC();
        bf16_t* WF = (bf16_t*)(sm + L_WF); bf16_t* WB = (bf16_t*)(sm + L_WB);
#pragma unroll
        for (int i4 = 0; i4 < 4; ++i4) {
            f32x4 uf = z4, wf = z4, ub = z4, wb = z4;
#pragma unroll
            for (int ks = 0; ks < 2; ++ks) {
                const bf16x8 av = frag16(VT + (wid * 16 + fr) * 72 + ks * 32 + fq * 8), ak = frag16(KTR + (wid * 16 + fr) * 72 + ks * 32 + fq * 8);
                const int ot = (i4 * 16 + fr) * 72 + ks * 32 + fq * 8;
                uf = mfma16(frag16(X0F + ot), av, uf); wf = mfma16(ak, frag16(X0TF + ot), wf); ub = mfma16(frag16(X0B + ot), av, ub); wb = mfma16(ak, frag16(X0TB + ot), wb);
            }
            u32x2 w; w[0] = pk2(uf[0], uf[1]); w[1] = pk2(uf[2], uf[3]); *(u32x2*)(imgf + IMG_U + ((wid * 4 + i4) * 64 + lane) * 8) = w;
            w[0] = pk2(ub[3], ub[2]); w[1] = pk2(ub[1], ub[0]); *(u32x2*)(imgb + IMG_U + ((wid * 4 + (3 - i4)) * 64 + (3 - fq) * 16 + fr) * 8) = w;
            const int i = i4 * 16 + fr, c = wid * 16 + fq * 4;
            w[0] = pk2(wf[0], wf[1]); w[1] = pk2(wf[2], wf[3]); *(u32x2*)(WF + i * 136 + c) = w;
            w[0] = pk2(wb[0], wb[1]); w[1] = pk2(wb[2], wb[3]); *(u32x2*)(WB + (63 - i) * 136 + c) = w;
        }
        SYNC();
#pragma unroll
        for (int q = 0; q < 5; ++q) { int pc = TID + q * 512; pc = pc < 2082 ? pc : 2081;
            const int sp = pc - 2048, dirb = pc >= 2048 ? (sp >= 17) : (pc >> 10), p = pc & 1023, mt = p >> 8, ks = (p >> 6) & 3, ln = p & 63;
            const int so = pc >= 2048 ? L_SCAL + dirb * 288 + (sp - dirb * 17) * 16 : (dirb ? L_WB : L_WF) + ((mt * 16 + (ln & 15)) * 136 + ks * 32 + (ln >> 4) * 8) * 2;
            const int dofs = pc >= 2048 ? IMG_SC + (sp - dirb * 17) * 16 : IMG_W + p * 16;
            *(u32x4*)((dirb ? imgb : imgf) + dofs) = *(const u32x4*)(sm + so); }
#pragma unroll
        for (int q = 0; q < 2; ++q) { const int p = TID + q * 512, d = (p >> 7) * 16 + (p & 15), p0 = ((p >> 6) & 1) * 32 + ((p >> 4) & 3) * 8;
            { const u32x4 v = *(const u32x4*)(KTR + d * 72 + p0); const f32x4 g0 = *(const f32x4*)(gcf + p0), g1 = *(const f32x4*)(gcf + p0 + 4); u32x4 o;
              o[0] = pk2(__builtin_bit_cast(float, v[0] << 16) * __expf(glf - g0[0]), __builtin_bit_cast(float, v[0] & 0xffff0000u) * __expf(glf - g0[1]));
              o[1] = pk2(__builtin_bit_cast(float, v[1] << 16) * __expf(glf - g0[2]), __builtin_bit_cast(float, v[1] & 0xffff0000u) * __expf(glf - g0[3]));
              o[2] = pk2(__builtin_bit_cast(float, v[2] << 16) * __expf(glf - g1[0]), __builtin_bit_cast(float, v[2] & 0xffff0000u) * __expf(glf - g1[1]));
              o[3] = pk2(__builtin_bit_cast(float, v[3] << 16) * __expf(glf - g1[2]), __builtin_bit_cast(float, v[3] & 0xffff0000u) * __expf(glf - g1[3]));
              *(u32x4*)(imgf + IMG_KT + p * 16) = o; }
            { const int t0 = 56 - p0;
              const u32x4 v = *(const u32x4*)(KTR + d * 72 + t0); const f32x4 g0 = *(const f32x4*)(gcb + t0), g1 = *(const f32x4*)(gcb + t0 + 4); u32x4 o;
              o[0] = pk2(__builtin_bit_cast(float, v[3] & 0xffff0000u) * __expf(glb - g1[3]), __builtin_bit_cast(float, v[3] << 16) * __expf(glb - g1[2]));
              o[1] = pk2(__builtin_bit_cast(float, v[2] & 0xffff0000u) * __expf(glb - g1[1]), __builtin_bit_cast(float, v[2] << 16) * __expf(glb - g1[0]));
              o[2] = pk2(__builtin_bit_cast(float, v[1] & 0xffff0000u) * __expf(glb - g0[3]), __builtin_bit_cast(float, v[1] << 16) * __expf(glb - g0[2]));
              o[3] = pk2(__builtin_bit_cast(float, v[0] & 0xffff0000u) * __expf(glb - g0[1]), __builtin_bit_cast(float, v[0] << 16) * __expf(glb - g0[0]));
              *(u32x4*)(imgb + IMG_KT + p * 16) = o; } }
        { const int p = TID, row = (p >> 7) * 16 + (p & 15), c0 = ((p >> 6) & 1) * 32 + ((p >> 4) & 3) * 8;
          *(u32x4*)(imgf + IMG_A + p * 16) = *(const u32x4*)((const bf16_t*)(sm + L_AF) + row * 64 + c0);
          *(u32x4*)(imgb + IMG_A + p * 16) = *(const u32x4*)((const bf16_t*)(sm + L_AB) + row * 64 + c0); }
        SYNC();
    }
#undef PP_LOAD
#undef PP_ROW0
}

DEV void phase4_fft(const Params& P, unsigned char* sm) {
    PHASE_TID;
    const bf16_t* GT = (const bf16_t*)((const unsigned char*)P.out + DO_GT);
    bf16_t* ZT = (bf16_t*)((unsigned char*)P.out + DO_ZT);
    const bf16_t* tab = (const bf16_t*)(P.ws + WS_TAB);
    bf16_t* YR = (bf16_t*)sm; bf16_t* YI = YR + 64 * 136;
    const int wid = TID >> 6, lane = TID & 63, fr = lane & 15, fq = lane >> 4;
    bf16x8 c64[4][2], s64[4][2], c128[4], s128[4];
#pragma unroll
    for (int nt = 0; nt < 4; ++nt)
#pragma unroll
        for (int ks = 0; ks < 2; ++ks) { c64[nt][ks] = frag16(tab + (nt * 16 + fr) * 64 + ks * 32 + fq * 8); s64[nt][ks] = frag16(tab + 4096 + (nt * 16 + fr) * 64 + ks * 32 + fq * 8); }
#pragma unroll
    for (int ks = 0; ks < 4; ++ks) { c128[ks] = frag16(tab + 8192 + (wid * 16 + fr) * 128 + ks * 32 + fq * 8); s128[ks] = frag16(tab + 8192 + 16384 + (wid * 16 + fr) * 128 + ks * 32 + fq * 8); }
    bf16x8 far[2][2], fai[2][2];
#define FFT_LOAD(set, it_) do { const int itc_ = (it_) < 512 * NB ? (it_) : BID; const int cp_ = itc_ >> 3, b_ = itc_ & 7; \
        const bf16_t* gr_ = GT + (size_t)cp_ * NTOK + b_ * SEQ; const bf16_t* gi_ = GT + (size_t)(512 + cp_) * NTOK + b_ * SEQ; \
        _Pragma("unroll") for (int ks = 0; ks < 2; ++ks) { far[set][ks] = frag16(gr_ + (wid * 16 + fr) * 64 + ks * 32 + fq * 8); fai[set][ks] = frag16(gi_ + (wid * 16 + fr) * 64 + ks * 32 + fq * 8); } } while (0)
    FFT_LOAD(0, BID);
    for (int it2 = BID; it2 < 512 * NB; it2 += 2 * NBLK) {
#pragma unroll
      for (int pp = 0; pp < 2; ++pp) { const int it = it2 + pp * NBLK; if (it < 512 * NB) {
        const int cp = it >> 3, b = it & 7;
        bf16x8 ar[2], ai[2], an[2];
#pragma unroll
        for (int ks = 0; ks < 2; ++ks) { ar[ks] = far[pp][ks]; ai[ks] = fai[pp][ks];
#pragma unroll
            for (int j = 0; j < 8; ++j) an[ks][j] = (short)(ar[ks][j] ^ (short)0x8000); }
        FFT_LOAD(pp ^ 1, it + NBLK);
#pragma unroll
        for (int nt = 0; nt < 4; ++nt) {
            f32x4 yr = (f32x4){0.f, 0.f, 0.f, 0.f}, yi = (f32x4){0.f, 0.f, 0.f, 0.f};
#pragma unroll
            for (int ks = 0; ks < 2; ++ks) { yr = mfma16(ar[ks], c64[nt][ks], yr); yr = mfma16(ai[ks], s64[nt][ks], yr); yi = mfma16(ai[ks], c64[nt][ks], yi); yi = mfma16(an[ks], s64[nt][ks], yi); }
            const int k1 = nt * 16 + fr; float orr[4], oii[4];
#pragma unroll
            for (int r = 0; r < 4; ++r) { const int n2 = wid * 16 + fq * 4 + r; float s, c; sincospi_f((float)(n2 * k1) * (2.0f / 8192.0f), &s, &c);
                orr[r] = yr[r] * c + yi[r] * s; oii[r] = yi[r] * c - yr[r] * s; }
            u32x2 w; w[0] = pk2(orr[0], orr[1]); w[1] = pk2(orr[2], orr[3]); *(u32x2*)(YR + k1 * 136 + wid * 16 + fq * 4) = w;
            w[0] = pk2(oii[0], oii[1]); w[1] = pk2(oii[2], oii[3]); *(u32x2*)(YI + k1 * 136 + wid * 16 + fq * 4) = w;
        }
        SYNC();
        bf16_t* zrow = ZT + (size_t)cp * NTOK + b * SEQ;
#pragma unroll
        for (int mt = 0; mt < 4; ++mt) {
            f32x4 z = (f32x4){0.f, 0.f, 0.f, 0.f};
#pragma unroll
            for (int ks = 0; ks < 4; ++ks) { z = mfma16(frag16(YR + (mt * 16 + fr) * 136 + ks * 32 + fq * 8), c128[ks], z); z = mfma16(frag16(YI + (mt * 16 + fr) * 136 + ks * 32 + fq * 8), s128[ks], z); }
            u32x2 w; w[0] = pk2(z[0], z[1]); w[1] = pk2(z[2], z[3]);
            *(u32x2*)(zrow + 64 * (wid * 16 + fr) + mt * 16 + fq * 4) = w;
        }
        SYNC();
      } }
    }
#undef FFT_LOAD
}

constexpr int SC_W = 0, SC_U = 17408, SC_KT = 22528, SC_Q = SC_KT + 18432, SC_A = SC_Q + 17408, SC_ST = SC_A + 9216, SC_VN = SC_ST + 2 * 8704, SC_END = SC_VN + 4608;

DEV void phase5_scan(const Params& P, unsigned char* sm) {
    PHASE_TID;
    const unsigned char* images = P.ws + WS_R4;
    bf16_t* obuf = (bf16_t*)(P.ws + WS_R4 + R4_OBUF);
    const int wid = TID >> 6, lane = TID & 63, fr = lane & 15, fq = lane >> 4;
    bf16_t* ST = (bf16_t*)sm; bf16_t* VN = (bf16_t*)(sm + 2 * 8704);
    for (int item = BID; item < NCHAIN * 4; item += NBLK) {
        const int xj = item >> 3, chain = (item & 7) * 8 + (xj >> 2), c0 = (xj & 3) * 32, b = chain >> 3, hh = (chain >> 1) & 3, dir = chain & 1;
        const unsigned char* blk0 = images + (size_t)chain * NSTEP * IMG_BYTES;
        const int oK = IMG_KT + (wid * 2 * 64 + lane) * 16;
        f32x4 Sacc[2];
        Sacc[0] = (f32x4){0.f, 0.f, 0.f, 0.f}; Sacc[1] = (f32x4){0.f, 0.f, 0.f, 0.f};
        for (int q = TID; q < 2 * 8704 / 4; q += 512) ((unsigned*)ST)[q] = 0u;
#define SC_SUPD(rkset) do { _Pragma("unroll") for (int tt = 0; tt < 2; ++tt) { f32x4 a = Sacc[tt] * dl; \
            _Pragma("unroll") for (int ks = 0; ks < 2; ++ks) a = mfma16(__builtin_bit_cast(bf16x8, rkset[ks]), frag16(VN + (tt * 16 + fr) * 72 + ks * 32 + fq * 8), a); \
            Sacc[tt] = a; u32x2 w_; w_[0] = pk2(a[0], a[1]); w_[1] = pk2(a[2], a[3]); *(u32x2*)(STn + (tt * 16 + fr) * 136 + wid * 16 + fq * 4) = w_; } } while (0)
        if (wid < 4) {
            const int mt = wid;
            const int oW = IMG_W + (mt * 4 * 64 + lane) * 16, oA = IMG_A + (mt * 2 * 64 + lane) * 16, oS = IMG_SC + 16 + (mt * 16 + fq * 4) * 4;
            const bf16_t* qbase = (const bf16_t*)(P.ws + WS_R3) + hh * 128 + fq * 8;
            const int oU = IMG_U + (((c0 >> 4) * 4 + mt) * 64 + lane) * 8;
            u32x4 rw[3][4], rk[3][2], rq[3][4], ra[3][2]; u32x2 ru[3][2]; f32x4 rs[3]; float dlr[3];
#define SC_LOAD1(set, blk) do { \
            _Pragma("unroll") for (int ks = 0; ks < 4; ++ks) rw[set][ks] = *(const u32x4*)((blk) + oW + ks * 1024); \
            ru[set][0] = *(const u32x2*)((blk) + oU); ru[set][1] = *(const u32x2*)((blk) + oU + 2048); dlr[set] = *(const float*)((blk) + IMG_SC); } while (0)
#define SC_LOAD2(set, blk, stp) do { const bf16_t* qrow_ = qbase + (size_t)chunk_row(chain, (stp), mt * 16 + fr) * 1536; \
            _Pragma("unroll") for (int ks = 0; ks < 2; ++ks) rk[set][ks] = *(const u32x4*)((blk) + oK + ks * 1024); \
            _Pragma("unroll") for (int ks = 0; ks < 4; ++ks) rq[set][ks] = *(const u32x4*)(qrow_ + ks * 32); \
            rs[set] = *(const f32x4*)((blk) + oS); \
            _Pragma("unroll") for (int ks = 0; ks < 2; ++ks) ra[set][ks] = *(const u32x4*)((blk) + oA + ks * 1024); } while (0)
#define SC_LOAD(set, blk, stp) do { SC_LOAD1(set, blk); SC_LOAD2(set, blk, stp); } while (0)
            SC_LOAD(0, blk0, 0); SC_LOAD(1, blk0 + IMG_BYTES, 1); SC_LOAD(2, blk0 + 2 * IMG_BYTES, 2);
            SYNC();
#pragma unroll 1
            for (int s3 = 0; s3 < NSTEP; s3 += 3) {
#pragma unroll
                for (int u = 0; u < 3; ++u) {
                    const int step = s3 + u, cur = step & 1;
                    const bf16_t* STc = ST + cur * 4352; bf16_t* STn = ST + (cur ^ 1) * 4352;
#pragma unroll
                    for (int nt = 0; nt < 2; ++nt) {
                        f32x4 vn = (f32x4){0.f, 0.f, 0.f, 0.f};
#pragma unroll
                        for (int ks = 0; ks < 4; ++ks) vn = mfma16(__builtin_bit_cast(bf16x8, rw[u][ks]), frag16(STc + (nt * 16 + fr) * 136 + ks * 32 + fq * 8), vn);
                        const unsigned u0 = ru[u][nt][0], u1 = ru[u][nt][1];
                        u32x2 w; w[0] = pk2(bf2f((bf16_t)(u0 & 0xffffu)) - vn[0], bf2f((bf16_t)(u0 >> 16)) - vn[1]); w[1] = pk2(bf2f((bf16_t)(u1 & 0xffffu)) - vn[2], bf2f((bf16_t)(u1 >> 16)) - vn[3]);
                        *(u32x2*)(VN + (nt * 16 + fr) * 72 + mt * 16 + fq * 4) = w;
                    }
                    const float dl = dlr[u];
                    const int stp3 = step + 3 < NSTEP ? step + 3 : NSTEP - 1;
                    const unsigned char* blk3 = blk0 + (size_t)stp3 * IMG_BYTES;
                    SC_LOAD1(u, blk3);
                    SYNC();
                    SC_SUPD(rk[u]);
                    if (step >= 4) {
#pragma unroll
                        for (int nt = 0; nt < 2; ++nt) {
                            f32x4 o1 = (f32x4){0.f, 0.f, 0.f, 0.f}, o = (f32x4){0.f, 0.f, 0.f, 0.f};
#pragma unroll
                            for (int ks = 0; ks < 4; ++ks) o1 = mfma16(__builtin_bit_cast(bf16x8, rq[u][ks]), frag16(STc + (nt * 16 + fr) * 136 + ks * 32 + fq * 8), o1);
#pragma unroll
                            for (int ks = 0; ks < 2; ++ks) o = mfma16(__builtin_bit_cast(bf16x8, ra[u][ks]), frag16(VN + (nt * 16 + fr) * 72 + ks * 32 + fq * 8), o);
                            o += o1 * rs[u];
#pragma unroll
                            for (int r = 0; r < 4; ++r) { const int pos = (step - 4) * 64 + mt * 16 + fq * 4 + r; const int tok = b * SEQ + (dir ? (SEQ - 1 - pos) : pos);
                                obuf[((size_t)dir * NTOK + tok) * 512 + hh * 128 + c0 + nt * 16 + fr] = f2bf(o[r]); }
                        }
                    }
                    SC_LOAD2(u, blk3, stp3);
                    SYNC();
                }
            }
#undef SC_LOAD
#undef SC_LOAD1
#undef SC_LOAD2
        } else {
            u32x4 rk[3][2]; float dlr[3];
#define SC_LOADK(set, blk) do { dlr[set] = *(const float*)((blk) + IMG_SC); _Pragma("unroll") for (int ks = 0; ks < 2; ++ks) rk[set][ks] = *(const u32x4*)((blk) + oK + ks * 1024); } while (0)
            SC_LOADK(0, blk0); SC_LOADK(1, blk0 + IMG_BYTES); SC_LOADK(2, blk0 + 2 * IMG_BYTES);
            SYNC();
#pragma unroll 1
            for (int s3 = 0; s3 < NSTEP; s3 += 3) {
#pragma unroll
                for (int u = 0; u < 3; ++u) {
                    const int step = s3 + u, cur = step & 1;
                    bf16_t* STn = ST + (cur ^ 1) * 4352;
                    const float dl = dlr[u];
                    SYNC();
                    SC_SUPD(rk[u]);
                    { const unsigned char* blk3 = blk0 + (size_t)(step + 3 < NSTEP ? step + 3 : NSTEP - 1) * IMG_BYTES; SC_LOADK(u, blk3); }
                    SYNC();
                }
            }
#undef SC_LOADK
        }
#undef SC_SUPD
        SYNC();
    }
}

DEV void phase6_amix(const Params& P, unsigned char* sm) {
    PHASE_TID;
    const bf16_t* ZT = (const bf16_t*)((const unsigned char*)P.out + DO_ZT);
    const bf16_t* zs = (const bf16_t*)((const unsigned char*)P.out + DO_ZS);
    const bf16_t* obuf = (const bf16_t*)(P.ws + WS_R4 + R4_OBUF);
    bf16_t* amix = (bf16_t*)(P.ws + WS_R4 + R4_AMIX);
    unsigned* tile = (unsigned*)sm;
    for (int tt = BID; tt < NTOK / 64; tt += NBLK) {
        const int tok0 = tt * 64;
        { u32x4 r[8];
#pragma unroll
          for (int q = 0; q < 8; ++q) { const int idx = TID + q * 512, cp = idx >> 3, piece = idx & 7; r[q] = *(const u32x4*)(ZT + (size_t)cp * NTOK + tok0 + piece * 8); }
#pragma unroll
          for (int q = 0; q < 8; ++q) { const int idx = TID + q * 512, cp = idx >> 3, piece = idx & 7; unsigned* t = tile + cp * 33 + piece * 4; t[0] = r[q][0]; t[1] = r[q][1]; t[2] = r[q][2]; t[3] = r[q][3]; } }
        SYNC();
        u32x4 oa[8], ob[8], oz[8];
#pragma unroll
        for (int q = 0; q < 8; ++q) { const int idx = TID + q * 512, tok = idx >> 6, hh = (idx >> 4) & 3, l16 = idx & 15; const size_t off = (size_t)(tok0 + tok) * 512 + hh * 128 + l16 * 8;
            oa[q] = *(const u32x4*)(obuf + off); ob[q] = *(const u32x4*)(obuf + (size_t)NTOK * 512 + off); oz[q] = *(const u32x4*)(zs + off); }
#pragma unroll
        for (int q = 0; q < 8; ++q) { const int tok = TID & 63, c8 = ((TID >> 6) * 8 + q) * 8, sh = (tok & 1) * 16; u32x4 o;
#pragma unroll
            for (int j = 0; j < 4; ++j) o[j] = ((tile[(c8 + 2 * j) * 33 + (tok >> 1)] >> sh) & 0xffffu) | (((tile[(c8 + 2 * j + 1) * 33 + (tok >> 1)] >> sh) & 0xffffu) << 16);
            *(u32x4*)(amix + (size_t)(tok0 + tok) * 1024 + c8) = o; }
        const int l16 = TID & 15;
        float og[8];
#pragma unroll
        for (int j = 0; j < 8; ++j) og[j] = P.onorm_g[l16 * 8 + j];
#pragma unroll
        for (int q = 0; q < 8; ++q) {
            const int idx = TID + q * 512, tok = idx >> 6, hh = (idx >> 4) & 3;
            const u32x4 a = oa[q], bq = ob[q], zv = oz[q];
            float v[8]; float ss = 0.f;
#pragma unroll
            for (int j = 0; j < 4; ++j) { v[2 * j] = bf2f((bf16_t)(a[j] & 0xffffu)) + bf2f((bf16_t)(bq[j] & 0xffffu)); v[2 * j + 1] = bf2f((bf16_t)(a[j] >> 16)) + bf2f((bf16_t)(bq[j] >> 16)); }
#pragma unroll
            for (int j = 0; j < 8; ++j) ss += v[j] * v[j];
            ss += shfl_xor_f(ss, 1); ss += shfl_xor_f(ss, 2); ss += shfl_xor_f(ss, 4); ss += shfl_xor_f(ss, 8);
            const float rstd = rsq_f(ss * (1.0f / 128.0f) + EPS);
            u32x4 o;
#pragma unroll
            for (int j = 0; j < 4; ++j) o[j] = pk2(v[2 * j] * rstd * og[2 * j] * bf2f((bf16_t)(zv[j] & 0xffffu)), v[2 * j + 1] * rstd * og[2 * j + 1] * bf2f((bf16_t)(zv[j] >> 16)));
            *(u32x4*)(amix + (size_t)(tok0 + tok) * 1024 + 512 + hh * 128 + l16 * 8) = o;
        }
        SYNC();
    }
}

DEV void phase8_router(const Params& P, unsigned char* sm, int dry) {
    PHASE_TID;
    float* wr = (float*)sm;
    {
        f32x4 g[2], rt[2][8];
#pragma unroll
        for (int h = 0; h < 2; ++h) { const int k = TID + h * 512; g[h] = *(const f32x4*)(P.w_group + k * 4);
#pragma unroll
            for (int q = 0; q < 8; ++q) rt[h][q] = *(const f32x4*)(P.w_router + k * 32 + q * 4); }
#pragma unroll
        for (int h = 0; h < 2; ++h) { const int k = TID + h * 512;
#pragma unroll
            for (int e = 0; e < 4; ++e) wr[e * 1028 + k] = g[h][e];
#pragma unroll
            for (int q = 0; q < 8; ++q)
#pragma unroll
                for (int e = 0; e < 4; ++e) wr[(4 + q * 4 + e) * 1028 + k] = rt[h][q][e]; }
    }
    SYNC();
    const float* mod = (const float*)(P.ws + WS_MOD);
    const float* x1 = P.out;
    bf16_t* h2 = (bf16_t*)(P.ws + WS_R4 + R4_H2);
    unsigned* cnt = (unsigned*)(P.ws + WS_CNT + (dry ? 8192 : 0)); unsigned* tokk = (unsigned*)(P.ws + (dry ? WS_R3 : WS_TOKK)); float* wl = (float*)(P.ws + (dry ? WS_R3 + 16 * MiB : WS_WL));
    const int wid = TID >> 6, lane = TID & 63;
    const int rstep = NBLK * 8;
    int r = BID * 8 + wid;
    unsigned* lc = (unsigned*)(sm + 148224);
    unsigned* aE = lc + 64; float* aW = (float*)(aE + 512); unsigned* aP = (unsigned*)(aW + 512);
    float* gsv = (float*)(sm + 154624); float* shv = gsv + 1024;
    float* brs = shv + 1024;
    if (TID < 32) { lc[TID] = 0u; brs[TID] = P.b_router[TID]; }
    const float bg0 = P.b_group[0], bg1 = P.b_group[1], bg2 = P.b_group[2], bg3 = P.b_group[3];
    SYNC();
    int jrow = 0;
    f32x4 vr[4][4];
#pragma unroll
    for (int jj = 0; jj < 4; ++jj) { const int rl = (r + jj * rstep < NTOK) ? r + jj * rstep : r;
#pragma unroll
        for (int i = 0; i < 4; ++i) vr[jj][i] = *(const f32x4*)(x1 + (size_t)rl * D + i * 256 + lane * 4); }
    const float n2a = P.norm2_g[TID], n2b = P.norm2_g[TID + 512];
    float msa, msb, mha, mhb;
    { const float* shift = mod + (r >> 13) * 6144 + 3 * 1024; msa = shift[1024 + TID]; msb = shift[1024 + TID + 512]; mha = shift[TID]; mhb = shift[TID + 512]; }
#pragma unroll 1
    for (; r < NTOK; ) {
        SYNC();
        gsv[TID] = n2a * (1.0f + msa); gsv[TID + 512] = n2b * (1.0f + msb); shv[TID] = mha; shv[TID + 512] = mhb;
        { const int rn = (r + 4 * rstep < NTOK) ? r + 4 * rstep : r; const float* shift = mod + (rn >> 13) * 6144 + 3 * 1024; msa = shift[1024 + TID]; msb = shift[1024 + TID + 512]; mha = shift[TID]; mhb = shift[TID + 512]; }
        SYNC();
#pragma unroll
      for (int jj = 0; jj < 4; ++jj) { if (r < NTOK) {
        f32x4 v[4]; float ss = 0.f;
#pragma unroll
        for (int i = 0; i < 4; ++i) { v[i] = vr[jj][i]; ss += v[i][0] * v[i][0] + v[i][1] * v[i][1] + v[i][2] * v[i][2] + v[i][3] * v[i][3]; }
        { const int rl = (r + 4 * rstep < NTOK) ? r + 4 * rstep : r;
#pragma unroll
          for (int i = 0; i < 4; ++i) vr[jj][i] = *(const f32x4*)(x1 + (size_t)rl * D + i * 256 + lane * 4); }
        ss = wave_sum(ss);
        const float rstd = rsq_f(ss * (1.0f / 1024.0f) + EPS);
        float gl[4] = {0.f, 0.f, 0.f, 0.f};
#pragma unroll
        for (int i = 0; i < 4; ++i) {
            const int k = i * 256 + lane * 4;
            const f32x4 g2 = *(const f32x4*)(gsv + k), sh = *(const f32x4*)(shv + k);
#pragma unroll
            for (int e = 0; e < 4; ++e) v[i][e] = v[i][e] * rstd * g2[e] + sh[e];
#pragma unroll
            for (int j = 0; j < 4; ++j) { const f32x4 wv = *(const f32x4*)(wr + j * 1028 + k); gl[j] += v[i][0] * wv[0] + v[i][1] * wv[1] + v[i][2] * wv[2] + v[i][3] * wv[3]; }
#if MK_F8
            *(unsigned*)((unsigned char*)h2 + (size_t)r * D + k) = pk4_fp8(v[i][0], v[i][1], v[i][2], v[i][3]);
#else
            u32x2 w; w[0] = pk2(v[i][0], v[i][1]); w[1] = pk2(v[i][2], v[i][3]);
            *(u32x2*)(h2 + (size_t)r * D + k) = w;
#endif
        }
#pragma unroll
        for (int j = 0; j < 4; ++j) gl[j] += 0.f;
        { const float t = wave_sum_multi<4>(gl, lane);
#pragma unroll
          for (int j = 0; j < 4; ++j) gl[j] = lane_bcast(t, j) + (j == 0 ? bg0 : j == 1 ? bg1 : j == 2 ? bg2 : bg3); }
        int gsel = 0; float gmax = gl[0];
#pragma unroll
        for (int j = 1; j < 4; ++j) if (gl[j] > gmax) { gmax = gl[j]; gsel = j; }
        float gden = 0.f;
#pragma unroll
        for (int j = 0; j < 4; ++j) gden += __expf(gl[j] - gmax);
        const float pg = 1.0f / gden;
        float el[8] = {0.f, 0.f, 0.f, 0.f, 0.f, 0.f, 0.f, 0.f};
#pragma unroll
        for (int i = 0; i < 4; ++i)
#pragma unroll
            for (int j = 0; j < 8; ++j) { const f32x4 wv = *(const f32x4*)(wr + (4 + gsel * 8 + j) * 1028 + i * 256 + lane * 4); el[j] += v[i][0] * wv[0] + v[i][1] * wv[1] + v[i][2] * wv[2] + v[i][3] * wv[3]; }
#pragma unroll
        for (int j = 0; j < 8; ++j) el[j] += 0.f;
        { const float t = wave_sum_multi<8>(el, lane);
#pragma unroll
          for (int j = 0; j < 8; ++j) el[j] = lane_bcast(t, j) + brs[gsel * 8 + j]; }
        int e1 = 0; float m1 = el[0];
#pragma unroll
        for (int j = 1; j < 8; ++j) if (el[j] > m1) { m1 = el[j]; e1 = j; }
        int e2 = -1; float m2 = -3.0e38f;
#pragma unroll
        for (int j = 0; j < 8; ++j) if (j != e1 && el[j] > m2) { m2 = el[j]; e2 = j; }
        if (e2 < 0) e2 = (e1 + 1) & 7;
        const float p2 = __expf(m2 - m1);
        const float w1 = pg / (1.0f + p2), w2 = pg * p2 / (1.0f + p2);
        if (lane < 2) {
            const int ee = gsel * 8 + (lane == 0 ? e1 : e2); const float ww = lane == 0 ? w1 : w2;
            const unsigned pos = atomic_add_u32(&lc[ee], 1u);
            const int a = (jrow * 8 + wid) * 2 + lane;
            if (a < 512) { aE[a] = (unsigned)ee; aW[a] = ww; aP[a] = pos; }
        }
        ++jrow; r += rstep;
      } }
    }
    SYNC();
    if (TID < 32) lc[32 + TID] = atomic_add_u32(&cnt[TID * 64], lc[TID]);
    SYNC();
    { const int a = TID, rl = a >> 1, rr = BID * 8 + (rl & 7) + (rl >> 3) * rstep;
      if (rr < NTOK && (rl >> 3) < jrow) { const unsigned ee = aE[a]; const unsigned pos = lc[32 + ee] + aP[a];
          tokk[(size_t)ee * LCAP + pos] = (unsigned)rr * 2u + (unsigned)(a & 1); wl[(size_t)ee * LCAP + pos] = aW[a]; } }
}

DEV void phase11_final(const Params& P, unsigned char* sm, float* dstbase) {
    PHASE_TID;
    (void)sm;
    const float* mod = (const float*)(P.ws + WS_MOD);
    const int wid = TID >> 6, lane = TID & 63;
#if MK_F8
    typedef float f32x2_ __attribute__((ext_vector_type(2)));
    const unsigned char* Y = P.ws + WS_R4 + R4_Y;
    for (int r0 = (BID * 8 + wid) * 2; r0 < NTOK; r0 += NBLK * 16) {
        f32x4 xv[2][4]; unsigned y0[2][4], y1[2][4];
#pragma unroll
        for (int u = 0; u < 2; ++u)
#pragma unroll
            for (int i = 0; i < 4; ++i) { const int k = i * 256 + lane * 4; const size_t r = (size_t)(r0 + u);
                xv[u][i] = *(const f32x4*)(P.out + r * D + k); y0[u][i] = *(const unsigned*)(Y + r * D + k); y1[u][i] = *(const unsigned*)(Y + ((size_t)NTOK + r) * D + k); }
        const float* gate = mod + (r0 >> 13) * 6144 + 5 * 1024;
#pragma unroll
        for (int u = 0; u < 2; ++u) {
            float* row = dstbase + (size_t)(r0 + u) * D;
            f32x4 v[4]; float ss = 0.f;
#pragma unroll
            for (int i = 0; i < 4; ++i) { const int k = i * 256 + lane * 4; const f32x4 gv = *(const f32x4*)(gate + k) * 0.0625f;
                const f32x2_ a0 = __builtin_amdgcn_cvt_pk_f32_fp8((int)y0[u][i], false), a1 = __builtin_amdgcn_cvt_pk_f32_fp8((int)y0[u][i], true);
                const f32x2_ b0 = __builtin_amdgcn_cvt_pk_f32_fp8((int)y1[u][i], false), b1 = __builtin_amdgcn_cvt_pk_f32_fp8((int)y1[u][i], true);
                f32x4 m; m[0] = a0[0] + b0[0]; m[1] = a0[1] + b0[1]; m[2] = a1[0] + b1[0]; m[3] = a1[1] + b1[1];
                v[i] = xv[u][i] + gv * m; ss += v[i][0] * v[i][0] + v[i][1] * v[i][1] + v[i][2] * v[i][2] + v[i][3] * v[i][3]; }
            ss = wave_sum(ss);
            const float rstd = rsq_f(ss * (1.0f / 1024.0f) + EPS);
#pragma unroll
            for (int i = 0; i < 4; ++i) { const int k = i * 256 + lane * 4; const f32x4 fg = *(const f32x4*)(P.final_g + k); *(f32x4*)(row + k) = v[i] * rstd * fg; }
        }
    }
#else
    const bf16_t* Y = (const bf16_t*)(P.ws + WS_R4 + R4_Y);
    for (int r0 = (BID * 8 + wid) * 2; r0 < NTOK; r0 += NBLK * 16) {
        f32x4 xv[2][4]; u32x2 y0[2][4], y1[2][4];
#pragma unroll
        for (int u = 0; u < 2; ++u)
#pragma unroll
            for (int i = 0; i < 4; ++i) { const int k = i * 256 + lane * 4; const size_t r = (size_t)(r0 + u);
                xv[u][i] = *(const f32x4*)(P.out + r * D + k); y0[u][i] = *(const u32x2*)(Y + r * D + k); y1[u][i] = *(const u32x2*)(Y + ((size_t)NTOK + r) * D + k); }
        const float* gate = mod + (r0 >> 13) * 6144 + 5 * 1024;
#pragma unroll
        for (int u = 0; u < 2; ++u) {
            float* row = dstbase + (size_t)(r0 + u) * D;
            f32x4 v[4]; float ss = 0.f;
#pragma unroll
            for (int i = 0; i < 4; ++i) { const int k = i * 256 + lane * 4; const f32x4 gv = *(const f32x4*)(gate + k);
                f32x4 m; m[0] = bf2f((bf16_t)(y0[u][i][0] & 0xffffu)) + bf2f((bf16_t)(y1[u][i][0] & 0xffffu)); m[1] = bf2f((bf16_t)(y0[u][i][0] >> 16)) + bf2f((bf16_t)(y1[u][i][0] >> 16));
                m[2] = bf2f((bf16_t)(y0[u][i][1] & 0xffffu)) + bf2f((bf16_t)(y1[u][i][1] & 0xffffu)); m[3] = bf2f((bf16_t)(y0[u][i][1] >> 16)) + bf2f((bf16_t)(y1[u][i][1] >> 16));
                v[i] = xv[u][i] + gv * m; ss += v[i][0] * v[i][0] + v[i][1] * v[i][1] + v[i][2] * v[i][2] + v[i][3] * v[i][3]; }
            ss = wave_sum(ss);
            const float rstd = rsq_f(ss * (1.0f / 1024.0f) + EPS);
#pragma unroll
            for (int i = 0; i < 4; ++i) { const int k = i * 256 + lane * 4; const f32x4 fg = *(const f32x4*)(P.final_g + k); *(f32x4*)(row + k) = v[i] * rstd * fg; }
        }
    }
#endif
}

#ifndef CPU_EMU
#define XB_TMO      128
#define XB_XCNT(j)  (256  + 64 * (j))
#define XB_XSUB(j)  (1280 + 64 * (j))
#define XB_XGEN(j)  (2304 + 64 * (j))
#define XB_TOP      3328
#define XB_TOPGEN   3392
#define XCD_BAR_WORDS 3456
#define XB_SPIN_CAP (1u << 22)
#define LAS __attribute__((address_space(3)))
__device__ __forceinline__ unsigned xb_ld(unsigned* p)              { return __hip_atomic_load(p, __ATOMIC_RELAXED, __HIP_MEMORY_SCOPE_AGENT); }
__device__ __forceinline__ unsigned xb_add(unsigned* p, unsigned v) { return __hip_atomic_fetch_add(p, v, __ATOMIC_RELAXED, __HIP_MEMORY_SCOPE_AGENT); }
__device__ __forceinline__ unsigned xb_xcc_id() { return (unsigned)__builtin_amdgcn_s_getreg((3 << 11) | 20) & 0xFu; }
#define XB_SPIN(cond, bar) do { unsigned _sp = 0; while (cond) { __builtin_amdgcn_s_sleep(1); \
    if ((++_sp & 255u) == 0u) { if (xb_ld(&(bar)[XB_TMO])) break; if (_sp > XB_SPIN_CAP) { atomicAdd(&(bar)[XB_TMO], 1u); break; } } } } while (0)
struct XcdBarrier { unsigned* bar; unsigned x; volatile LAS unsigned* st; };
__device__ __forceinline__ XcdBarrier xcd_barrier_post(unsigned* bar, volatile LAS unsigned* st) {
    XcdBarrier b; b.bar = bar; b.x = xb_xcc_id(); b.st = st;
    if (threadIdx.x == 0) (void)xb_add(&bar[XB_XCNT(b.x)], 1u);
    return b;
}
__device__ __forceinline__ void xcd_barrier_complete(unsigned* bar, unsigned x, unsigned& nloc, unsigned& nx) {
    const unsigned G = gridDim.x * gridDim.y * gridDim.z;
    unsigned sum, cnt, mine, sp = 0u;
    for (;;) {
        sum = 0u; cnt = 0u; mine = 0u;
#pragma unroll
        for (unsigned j = 0; j < 16; ++j) { const unsigned c = xb_ld(&bar[XB_XCNT(j)]); sum += c; cnt += (c > 0u) ? 1u : 0u; mine = (j == x) ? c : mine; }
        if (sum == G) break;
        __builtin_amdgcn_s_sleep(1);
        if ((++sp & 255u) == 0u) { if (xb_ld(&bar[XB_TMO])) break; if (sp > XB_SPIN_CAP) { atomicAdd(&bar[XB_TMO], 1u); break; } }
    }
    nloc = mine > 0u ? mine : 1u; nx = cnt > 0u ? cnt : 1u;
}
__device__ __forceinline__ void xcd_barrier(const XcdBarrier& b) {
    asm volatile("s_waitcnt vmcnt(0)" ::: "memory");
    __syncthreads();
    if (threadIdx.x == 0) {
        unsigned* bar = b.bar;
        __builtin_amdgcn_s_waitcnt(0);
        unsigned nloc = b.st[0], nx = b.st[1];
        if (nloc == 0u) { xcd_barrier_complete(bar, b.x, nloc, nx); b.st[0] = nloc; b.st[1] = nx; }
        const unsigned old = xb_add(&bar[XB_XSUB(b.x)], 1u);
        const unsigned gen = old / nloc;
        if (old + 1u == (gen + 1u) * nloc) {
            __builtin_amdgcn_fence(__ATOMIC_RELEASE, "agent");
            asm volatile("s_waitcnt vmcnt(0)" ::: "memory");
            const unsigned og = xb_add(&bar[XB_TOP], 1u);
            const unsigned tg = og / nx;
            if (og + 1u == (tg + 1u) * nx) xb_add(&bar[XB_TOPGEN], 1u);
            else XB_SPIN(xb_ld(&bar[XB_TOPGEN]) == tg, bar);
            __builtin_amdgcn_fence(__ATOMIC_ACQUIRE, "agent");
            xb_add(&bar[XB_XGEN(b.x)], 1u);
            asm volatile("s_waitcnt vmcnt(0)" ::: "memory");
        } else {
            XB_SPIN(xb_ld(&bar[XB_XGEN(b.x)]) == gen, bar);
            __builtin_amdgcn_fence(__ATOMIC_ACQUIRE, "agent");
            asm volatile("s_waitcnt vmcnt(0)" ::: "memory");
        }
    }
    __syncthreads();
}

#ifndef MK_PH
#define MK_PH 0x7ff
#endif
#ifndef MK_REP
#define MK_REP 0
#endif
#define REPS(k) for (int rep_ = 0; rep_ < (((MK_REP >> (k)) & 1) ? 2 : 1); ++rep_)
extern __shared__ __attribute__((aligned(16))) unsigned char smem_dyn[];

__device__ __forceinline__ void moe_tables(const Params& P, LAS int* tb, LAS int* cn) {
    const unsigned* cnt = (const unsigned*)(P.ws + WS_CNT);
    if (threadIdx.x < 32) cn[threadIdx.x] = (int)cnt[threadIdx.x * 64];
    __syncthreads();
    if (threadIdx.x == 0) { int acc = 0; for (int e = 0; e < 32; ++e) { tb[e] = acc; acc += (cn[e] + 255) >> 8; } tb[32] = acc; }
    __syncthreads();
}

__global__ void __launch_bounds__(512, 2) hymba_fwd(Params P) {
    unsigned char* sm = smem_dyn;
    LAS unsigned char* lsm = (LAS unsigned char*)smem_dyn;
    volatile LAS unsigned* xbw = (volatile LAS unsigned*)(lsm + LDS_BYTES - 16);
    if (threadIdx.x == 0) { xbw[0] = 0u; xbw[1] = 0u; xbw[2] = 0u; xbw[3] = 0u; }
    __syncthreads();
    XcdBarrier bar = xcd_barrier_post((unsigned*)(P.ws + WS_BAR), xbw);
    using namespace pg8;

#if (MK_PH >> 0) & 1
    REPS(15) phase0_mod(P, sm); REPS(0) { phase0_weights(P, sm); phase0_wf(P, sm); }
    xcd_barrier(bar);
#endif
#if (MK_PH >> 1) & 1
    REPS(1) phase1_prep(P, sm);
    xcd_barrier(bar);
#endif
#if (MK_PH >> 2) & 1
    REPS(2) {
    { ProbInproj G; G.init(MROWS / 256, 8, gridDim.x, blockIdx.x); G.A = (const bf16_t*)(P.ws + WS_R4 + R4_H); G.Bt = (const bf16_t*)(P.ws + WS_WQKVZ); G.K = 1024;
      EpiInproj E; E.O = (bf16_t*)(P.ws + WS_R4 + R4_P); E.zs = (bf16_t*)((unsigned char*)P.out + DO_ZS); E.rstd = (const float*)(P.ws + WS_RSTD); E.bias = (const float*)(P.ws + WS_BIAS); gemm_phase(lsm, G, E); }
    { ProbGT G; G.init(4, NTOK / 256, gridDim.x, blockIdx.x); G.A = (const bf16_t*)(P.ws + WS_WF); G.Bt = (const bf16_t*)(P.ws + WS_R4 + R4_H); G.K = 1024;
      EpiGT E; E.O = (bf16_t*)((unsigned char*)P.out + DO_GT); E.rstd = (const float*)(P.ws + WS_RSTD); E.bias = (const float*)(P.ws + WS_BIAS); gemm_phase(lsm, G, E); }
    }
    xcd_barrier(bar);
#endif
#if (MK_PH >> 3) & 1
    REPS(3) phase3_conv(P, sm);
    xcd_barrier(bar);
#endif
#if (MK_PH >> 4) & 1
    REPS(4) phase4_prepass(P, sm);
    REPS(11) phase4_fft(P, sm);
    xcd_barrier(bar);
#endif
#if (MK_PH >> 5) & 1
    REPS(5) phase5_scan(P, sm);
    xcd_barrier(bar);
#endif
#if (MK_PH >> 6) & 1
    REPS(6) phase6_amix(P, sm);
    xcd_barrier(bar);
#endif
#if (MK_PH >> 7) & 1
    REPS(7)
    { ProbOut G; G.init(NTOK / 256, 4, gridDim.x, blockIdx.x); G.A = (const bf16_t*)(P.ws + WS_R4 + R4_AMIX); G.Bt = (const bf16_t*)(P.ws + WS_WOUT); G.K = 1024;
      EpiResid E; E.x = P.x; E.mod = (const float*)(P.ws + WS_MOD); E.out = P.out; gemm_phase(lsm, G, E); }
    xcd_barrier(bar);
#endif
#if (MK_PH >> 8) & 1
#if (MK_REP >> 13) & 1
    phase8_router(P, sm, 1);
#endif
    phase8_router(P, sm, 0);
#if (MK_REP >> 14) & 1
    xcd_barrier(bar); xcd_barrier(bar); xcd_barrier(bar); xcd_barrier(bar);
#endif
    xcd_barrier(bar);
#endif
#if (MK_PH >> 9) & 1
#if MK_F8
    LAS int* tb = (LAS int*)(lsm + F8_LDS); LAS int* cn = tb + 64;
    moe_tables(P, tb, cn);
    { ProbMoe1F8 G; G.tb = tb; G.cnt = cn; G.G = gridDim.x; G.c = blockIdx.x; G.A = P.ws + WS_R4 + R4_H2; G.Bt = P.ws + WS_WGU; G.KB = 1024; G.tokk = (const unsigned*)(P.ws + WS_TOKK);
      EpiMoe1F8 E; E.hid = P.ws + WS_R4 + R4_HID; gemm_f8(lsm, G, E); }
    xcd_barrier(bar);
    { ProbMoe2F8 G; G.tb = tb; G.cnt = cn; G.G = gridDim.x; G.c = blockIdx.x; G.A = P.ws + WS_R4 + R4_HID; G.Bt = P.ws + WS_WD; G.KB = 512;
      EpiMoe2F8 E; E.Y = P.ws + WS_R4 + R4_Y; E.tokk = (const unsigned*)(P.ws + WS_TOKK); E.wl = (const float*)(P.ws + WS_WL); E.tb = tb; gemm_f8(lsm, G, E); }
    xcd_barrier(bar);
#else
    LAS int* tb = (LAS int*)(lsm + STAGE_BYTES); LAS int* cn = tb + 64;
    moe_tables(P, tb, cn);
    REPS(9)
    { ProbMoe1 G; G.tb = tb; G.cnt = cn; G.G = gridDim.x; G.c = blockIdx.x; G.A = (const bf16_t*)(P.ws + WS_R4 + R4_H2); G.Bt = (const bf16_t*)(P.ws + WS_WGU); G.K = 1024; G.tokk = (const unsigned*)(P.ws + WS_TOKK);
      EpiMoe1 E; E.hid = (bf16_t*)(P.ws + WS_R4 + R4_HID); gemm_phase(lsm, G, E); }
    xcd_barrier(bar);
    REPS(10)
    { ProbMoe2 G; G.tb = tb; G.cnt = cn; G.G = gridDim.x; G.c = blockIdx.x; G.A = (const bf16_t*)(P.ws + WS_R4 + R4_HID); G.Bt = (const bf16_t*)(P.ws + WS_WD); G.K = 512;
      EpiMoe2 E; E.Y = (bf16_t*)(P.ws + WS_R4 + R4_Y); E.tokk = (const unsigned*)(P.ws + WS_TOKK); E.wl = (const float*)(P.ws + WS_WL); E.tb = tb; gemm_phase(lsm, G, E); }
    xcd_barrier(bar);
#endif
#endif
#if (MK_PH >> 10) & 1
#if (MK_REP >> 12) & 1
    phase11_final(P, sm, (float*)(P.ws + WS_R4 + 300 * MiB));
#endif
    phase11_final(P, sm, P.out);
#endif
}

extern "C" void kernel_launch(void* const* d_in, const int* in_sizes, int n_in, void* d_out, int out_size, void* d_ws, size_t ws_size, hipStream_t stream) {
    (void)in_sizes; (void)n_in; (void)out_size;
    static int grid = 0;
    if (!grid) {
        int dev = 0, cus = 0, per_cu = 0;
        hipGetDevice(&dev);
        hipDeviceGetAttribute(&cus, hipDeviceAttributeMultiprocessorCount, dev);
        hipFuncSetAttribute((const void*)hymba_fwd, hipFuncAttributeMaxDynamicSharedMemorySize, LDS_BYTES);
        hipOccupancyMaxActiveBlocksPerMultiprocessor(&per_cu, hymba_fwd, 512, LDS_BYTES);
        if (per_cu < 1) { fprintf(stderr, "occupancy query says 0 blocks per CU\n"); per_cu = 1; }
        grid = cus;
        if (ws_size < WS_NEED) fprintf(stderr, "workspace too small: %zu < %zu\n", ws_size, (size_t)WS_NEED);
    }
    Params p{};
    p.x = (const float*)d_in[0]; p.c = (const float*)d_in[1]; p.ctx = (const float*)d_in[2]; p.c_ctx = (const float*)d_in[3]; p.w_mod = (const float*)d_in[4]; p.b_mod = (const float*)d_in[5];
    p.norm1_g = (const float*)d_in[6]; p.w_in = (const float*)d_in[7]; p.conv_w = (const float*)d_in[8]; p.a_log = (const float*)d_in[9]; p.dt_bias = (const float*)d_in[10]; p.onorm_g = (const float*)d_in[11];
    p.w_out = (const float*)d_in[12]; p.norm2_g = (const float*)d_in[13]; p.w_group = (const float*)d_in[14]; p.b_group = (const float*)d_in[15]; p.w_router = (const float*)d_in[16]; p.b_router = (const float*)d_in[17];
    p.w_gate = (const float*)d_in[18]; p.w_up = (const float*)d_in[19]; p.w_down = (const float*)d_in[20]; p.final_g = (const float*)d_in[21];
    p.out = (float*)d_out; p.ws = (unsigned char*)d_ws;
    hipMemsetAsync(d_ws, 0, WS_ZERO_BYTES, stream);
    hipLaunchKernelGGL(hymba_fwd, dim3(grid), dim3(512), LDS_BYTES, stream, p);
}
#endif
```

```cpp
#ifndef CPU_EMU
#include <hip/hip_runtime.h>
#include <cstdio>
#include <cstdint>
#define DEV __device__ __forceinline__
#define TID tid_local
__device__ __forceinline__ int mk_lane_volatile() { int l; asm volatile("v_mbcnt_lo_u32_b32 %0, -1, 0\n\tv_mbcnt_hi_u32_b32 %0, -1, %0" : "=v"(l)); return l; }
#define MK_TID(wave) ((wave) * 64 + mk_lane_volatile())
#define PHASE_TID int tid_local = MK_TID(P.wave); asm volatile("" : "+v"(tid_local))
#define BID ((int)blockIdx.x)
#define NBLK ((int)gridDim.x)
#define SYNC() __syncthreads()
#define SCHED_FENCE() __builtin_amdgcn_sched_barrier(0)
#endif

typedef unsigned short bf16_t;
typedef short bf16x8 __attribute__((ext_vector_type(8)));
typedef float f32x4 __attribute__((ext_vector_type(4)));
typedef unsigned u32x4 __attribute__((ext_vector_type(4)));
typedef unsigned u32x2 __attribute__((ext_vector_type(2)));

constexpr int D = 1024, NB = 8, SEQ = 8192, CTX = 256;
constexpr int NTOK = NB * SEQ;
constexpr int NCTX = NB * CTX;
constexpr int MROWS = NTOK + NCTX;
constexpr int W_IN = 2576;
constexpr int NSTEP = 4 + 128;
constexpr int NCHAIN = NB * 4 * 2;
constexpr int NPROB = NCHAIN * NSTEP;
constexpr float EPS = 1e-6f;
constexpr int NEXP = 32;
constexpr int LCAP = 65536;

constexpr int IMG_W = 0, IMG_KT = 16384, IMG_A = 32768, IMG_U = 40960, IMG_SC = 57344, IMG_BYTES = 57664;

constexpr size_t MiB = 1048576;
constexpr size_t WS_BAR = 0;
constexpr size_t WS_MOD = 16384;
constexpr size_t WS_CNT = 16384 + 221184;
constexpr size_t WS_ZERO_BYTES = WS_CNT + 16384;
constexpr size_t WS_TAB = 262144;
constexpr size_t WS_BIAS = 393216;
constexpr size_t WS_RSTD = 5 * MiB + 524288;
constexpr size_t WS_GB = 1 * MiB;
constexpr size_t WS_TOKK = 6 * MiB;
constexpr size_t WS_WL = 14 * MiB;
constexpr size_t WS_W = 22 * MiB;
constexpr size_t WS_WQKVZ = WS_W;
constexpr size_t WS_WF = WS_WQKVZ + 2048ull * 1024 * 2;
constexpr size_t WS_WOUT = WS_WF + 1024ull * 1024 * 2;
constexpr size_t WS_WGU = WS_WOUT + 1024ull * 1024 * 2;
constexpr size_t WS_WD = WS_WGU + 32ull * 1024 * 1024 * 2;
constexpr size_t WS_R3 = 126 * MiB;
constexpr size_t WS_R4 = 324 * MiB;
constexpr size_t WS_NEED = WS_R4 + 645 * MiB;
constexpr size_t R4_H = 0, R4_P = 132 * MiB;
constexpr size_t R4_AMIX = 0, R4_H2 = 128 * MiB, R4_HID = 256 * MiB, R4_Y = 0;
constexpr size_t R4_OBUF = 480 * MiB;
constexpr size_t DO_GT = 0, DO_ZT = 128 * MiB, DO_ZS = 192 * MiB;

constexpr int LDS_BYTES = 163840;

struct Params {
    const float *x, *c, *ctx, *c_ctx, *w_mod, *b_mod, *norm1_g, *w_in, *conv_w, *a_log, *dt_bias, *onorm_g, *w_out, *norm2_g,
                *w_group, *b_group, *w_router, *b_router, *w_gate, *w_up, *w_down, *final_g;
    float* out;
    unsigned char* ws;
    int wave;
};

DEV bf16_t f2bf(float f) { unsigned u = __builtin_bit_cast(unsigned, f); u += 0x7FFFu + ((u >> 16) & 1u); return (bf16_t)(u >> 16); }
DEV float bf2f(bf16_t b) { return __builtin_bit_cast(float, ((unsigned)b) << 16); }
#ifndef MK_F8
#define MK_F8 2
#endif
#ifndef CPU_EMU
DEV unsigned pk4_fp8(float a, float b, float c, float d) { int t = 0; t = __builtin_amdgcn_cvt_pk_fp8_f32(a, b, t, false); t = __builtin_amdgcn_cvt_pk_fp8_f32(c, d, t, true); return (unsigned)t; }
typedef __bf16 bf16n2 __attribute__((ext_vector_type(2)));
DEV unsigned pk2(float lo, float hi) { bf16n2 v; v[0] = (__bf16)lo; v[1] = (__bf16)hi; return __builtin_bit_cast(unsigned, v); }
DEV float rcp_f(float x) { return __builtin_amdgcn_rcpf(x); }
DEV float rsq_f(float x) { return __builtin_amdgcn_rsqf(x); }
#else
DEV unsigned pk2(float lo, float hi) { return (unsigned)f2bf(lo) | ((unsigned)f2bf(hi) << 16); }
DEV float rcp_f(float x) { return 1.0f / x; }
DEV float rsq_f(float x) { return 1.0f / sqrtf(x); }
#endif
DEV float silu_f(float v) { return v * rcp_f(1.0f + __expf(-v)); }

#ifndef CPU_EMU
DEV f32x4 mfma16(bf16x8 a, bf16x8 b, f32x4 c) { return __builtin_amdgcn_mfma_f32_16x16x32_bf16(a, b, c, 0, 0, 0); }
DEV float shfl_xor_f(float v, int m) { return __shfl_xor(v, m); }
DEV float shfl_up_f(float v, int d) { return __shfl_up(v, d); }
DEV float shfl_idx_f(float v, int l) { return __shfl(v, l); }
DEV void atomic_add_f32(float* p, float v) { atomicAdd(p, v); }
DEV unsigned atomic_add_u32(unsigned* p, unsigned v) { return atomicAdd(p, v); }
DEV void sincospi_f(float x, float* s, float* c) { sincospif(x, s, c); }
#endif

DEV float wave_sum(float v) {
#pragma unroll
    for (int o = 32; o >= 1; o >>= 1) v += shfl_xor_f(v, o);
    return v;
}
template <int N> DEV float wave_sum_multi(const float (&v)[N], int lane) {
    float a[N];
#pragma unroll
    for (int i = 0; i < N; ++i) a[i] = v[i];
    int m = 1;
#pragma unroll
    for (int n = N; n > 1; n >>= 1, m <<= 1) {
        const bool up = (lane & m) != 0;
#pragma unroll
        for (int i = 0; i < n / 2; ++i) { const float keep = up ? a[2 * i + 1] : a[2 * i], send = up ? a[2 * i] : a[2 * i + 1]; a[i] = keep + shfl_xor_f(send, m); }
    }
    float r = a[0];
#pragma unroll
    for (int o = N; o < 64; o <<= 1) r += shfl_xor_f(r, o);
    return r;
}
#ifndef CPU_EMU
DEV float lane_bcast(float v, int l) { return __builtin_bit_cast(float, __builtin_amdgcn_readlane(__builtin_bit_cast(int, v), l)); }
#endif
DEV bf16x8 frag_gather(const bf16_t* p, int stride) {
    bf16x8 r;
#pragma unroll
    for (int j = 0; j < 8; ++j) r[j] = (short)p[j * stride];
    return r;
}
DEV bf16x8 frag16(const bf16_t* p) { return *(const bf16x8*)p; }

DEV void phase0_mod(const Params& P, unsigned char* sm) {
    PHASE_TID;
    float* sil = (float*)sm;
    float* red = (float*)(sm + 36864);
    for (int i = TID; i < 9 * 1024; i += 512) { const int r = i >> 10, k = i & 1023; const float v = r < 8 ? P.c[r * 1024 + k] : P.c_ctx[k]; sil[i] = silu_f(v); }
    SYNC();
    float* mod = (float*)(P.ws + WS_MOD);
    for (int cb = BID; cb < 256; cb += NBLK) {
        const int c = TID % 24, kg = TID / 24, j0 = cb * 24;
        if (kg < 21) {
            float acc[9];
#pragma unroll
            for (int r = 0; r < 9; ++r) acc[r] = 0.f;
#pragma unroll 7
            for (int k = kg; k < 1024; k += 21) { const float w = P.w_mod[(size_t)k * 6144 + j0 + c];
#pragma unroll
                for (int r = 0; r < 9; ++r) acc[r] += sil[r * 1024 + k] * w; }
#pragma unroll
            for (int r = 0; r < 9; ++r) red[(kg * 24 + c) * 9 + r] = acc[r];
        }
        SYNC();
        if (TID < 24 * 9) { const int cc = TID / 9, r = TID - cc * 9; float t = P.b_mod[j0 + cc];
            for (int g = 0; g < 21; ++g) t += red[(g * 24 + cc) * 9 + r];
            mod[r * 6144 + j0 + cc] = t; }
        SYNC();
    }
}

struct WJob { const float* src; unsigned char* dst; int lds_, ldd, inter, f8; };
DEV WJob wjob(const Params& P, int t) {
    unsigned char* wqkvz = P.ws + WS_WQKVZ; unsigned char* wout = P.ws + WS_WOUT; unsigned char* wgu = P.ws + WS_WGU; unsigned char* wd = P.ws + WS_WD;
    WJob j;
    if (t < 128) { const int kt = t >> 3, nt = t & 7;
        j.src = P.w_in + (size_t)(kt * 64) * W_IN + 512 + nt * 256; j.lds_ = W_IN; j.dst = wqkvz + ((size_t)(nt * 256) * 1024 + kt * 64) * 2; j.ldd = 2048; j.inter = 0; j.f8 = 0;
    } else if (t < 192) { const int u = t - 128, kt = u >> 2, nt = u & 3;
        j.src = P.w_out + (size_t)(kt * 64) * 1024 + nt * 256; j.lds_ = 1024; j.dst = wout + ((size_t)(nt * 256) * 1024 + kt * 64) * 2; j.ldd = 2048; j.inter = 0; j.f8 = 0;
    } else if (t < 192 + 2048) { const int u = t - 192, up = u >> 10, v = u & 1023, e = v >> 5, w = v & 31, kt = w >> 1, nt = w & 1;
        j.src = (up ? P.w_up : P.w_gate) + (size_t)e * 1024 * 512 + (size_t)(kt * 64) * 512 + nt * 256; j.lds_ = 512; j.inter = 1 + up;
#if MK_F8
        j.dst = wgu + (size_t)e * 1024 * 1024 + (size_t)(nt * 512) * 1024 + kt * 64; j.ldd = 1024; j.f8 = 1;
#else
        j.dst = wgu + ((size_t)e * 1024 * 1024 + (size_t)(nt * 512) * 1024 + kt * 64) * 2; j.ldd = 2048; j.f8 = 0;
#endif
    } else { const int v = t - 192 - 2048, e = v >> 5, w = v & 31, kt = w >> 2, nt = w & 3;
        j.src = P.w_down + (size_t)e * 512 * 1024 + (size_t)(kt * 64) * 1024 + nt * 256; j.lds_ = 1024; j.inter = 0;
#if MK_F8
        j.dst = wd + (size_t)e * 1024 * 512 + (size_t)(nt * 256) * 512 + kt * 64; j.ldd = 512; j.f8 = 1;
#else
        j.dst = wd + ((size_t)e * 1024 * 512 + (size_t)(nt * 256) * 512 + kt * 64) * 2; j.ldd = 1024; j.f8 = 0;
#endif
    }
    return j;
}
DEV void phase0_weights(const Params& P, unsigned char* sm) {
    PHASE_TID;
    float* tile = (float*)sm;
    const int NJ = 128 + 64 + 3 * 1024;
    f32x4 v[8];
    int t = BID;
    if (t < NJ) { const WJob j = wjob(P, t);
#pragma unroll
        for (int q = 0; q < 8; ++q) v[q] = *(const f32x4*)(j.src + (size_t)((TID >> 6) + q * 8) * j.lds_ + (TID & 63) * 4); }
    for (; t < NJ; t += NBLK) {
        const WJob j = wjob(P, t);
#pragma unroll
        for (int q = 0; q < 8; ++q) { float* tp = tile + ((TID >> 6) + q * 8) * 257 + (TID & 63) * 4; tp[0] = v[q][0]; tp[1] = v[q][1]; tp[2] = v[q][2]; tp[3] = v[q][3]; }
        { const WJob jn = wjob(P, t + NBLK < NJ ? t + NBLK : t);
#pragma unroll
          for (int q = 0; q < 8; ++q) v[q] = *(const f32x4*)(jn.src + (size_t)((TID >> 6) + q * 8) * jn.lds_ + (TID & 63) * 4); }
        SYNC();
        const int c = TID & 255, half = TID >> 8;
        if (j.f8) {
            const int c5 = c & 31, p32 = 16 * ((c5 >> 2) & 1) + 4 * (c5 >> 3) + (c5 & 3), s64 = (c & 0xC3) | (((c >> 2) & 3) << 4) | (((c >> 4) & 3) << 2);
#if MK_F8 == 2
            const int drow8 = j.inter ? ((c >> 7) * 256 + (j.inter - 1) * 128 + ((c >> 5) & 3) * 32 + ((c >> 2) & 1) * 16 + ((c >> 3) & 3) * 4 + (c & 3))
                                      : (((c >> 3) & 1) * 128 + (c >> 6) * 32 + ((c >> 2) & 1) * 16 + ((c >> 4) & 3) * 4 + (c & 3));
            (void)p32; (void)s64;
#else
            const int drow8 = j.inter ? ((c >> 7) * 256 + ((c >> 5) & 3) * 64 + (j.inter - 1) * 32 + p32) : s64;
#endif
            u32x4 w[2];
#pragma unroll
            for (int q = 0; q < 2; ++q)
#pragma unroll
                for (int jj = 0; jj < 4; ++jj) { const int k0 = half * 32 + q * 16 + jj * 4; w[q][jj] = pk4_fp8(tile[k0 * 257 + c] * 32.0f, tile[(k0 + 1) * 257 + c] * 32.0f, tile[(k0 + 2) * 257 + c] * 32.0f, tile[(k0 + 3) * 257 + c] * 32.0f); }
            unsigned char* d8 = j.dst + (size_t)drow8 * j.ldd + half * 32;
            *(u32x4*)d8 = w[0]; *(u32x4*)(d8 + 16) = w[1];
        } else {
            const int drow = j.inter ? ((c >> 7) * 256 + (j.inter - 1) * 128 + (c & 127)) : c;
            u32x4 w[4];
#pragma unroll
            for (int q = 0; q < 4; ++q)
#pragma unroll
                for (int jj = 0; jj < 4; ++jj) w[q][jj] = pk2(tile[(half * 32 + q * 8 + 2 * jj) * 257 + c], tile[(half * 32 + q * 8 + 2 * jj + 1) * 257 + c]);
            unsigned char* d2 = j.dst + (size_t)drow * j.ldd + half * 64;
#pragma unroll
            for (int q = 0; q < 4; ++q) *(u32x4*)(d2 + q * 16) = w[q];
        }
        SYNC();
    }
}

DEV void phase0_wf(const Params& P, unsigned char* sm) {
    PHASE_TID;
    float* cs = (float*)sm;
    if (TID < 128) { float s, c; sincospi_f((float)TID * (2.0f / 128.0f), &s, &c); cs[TID] = c; cs[128 + TID] = s; }
    SYNC();
    bf16_t* wf = (bf16_t*)(P.ws + WS_WF);
    const float sc = 0.08838834764831845f;
    for (int it = BID; it < 256; it += NBLK) {
        const int kb = it & 1, cb = (it >> 1) & 15, part = (it >> 5) & 1, g = it >> 6;
        const int k = kb * 512 + TID;
        const float* wrow = P.w_in + (size_t)k * W_IN + g * 128;
        float acc[8];
#pragma unroll
        for (int q = 0; q < 8; ++q) acc[q] = 0.f;
#pragma unroll 8
        for (int c4 = 0; c4 < 32; ++c4) { const f32x4 w4 = *(const f32x4*)(wrow + c4 * 4);
#pragma unroll
            for (int e = 0; e < 4; ++e) { const int c = c4 * 4 + e;
#pragma unroll
                for (int q = 0; q < 8; ++q) { const int cp = cb * 8 + q; acc[q] += w4[e] * cs[part * 128 + ((c * cp) & 127)]; } } }
#pragma unroll
        for (int q = 0; q < 8; ++q) { const int chc = part * 512 + g * 128 + cb * 8 + q; wf[(size_t)chc * 1024 + k] = f2bf((part ? -acc[q] : acc[q]) * sc); }
    }
    bf16_t* tab = (bf16_t*)(P.ws + WS_TAB);
    const float sc2 = 0.011048543456039806f;
    for (int i = BID * 512 + TID; i < 4096 + 16384; i += NBLK * 512) {
        if (i < 4096) { const int a = i >> 6, b = i & 63; float s, c; sincospi_f((float)((a * b) & 63) * (2.0f / 64.0f), &s, &c); tab[i] = f2bf(c); tab[4096 + i] = f2bf(s); }
        else { const int j = i - 4096, a = j >> 7, b = j & 127; float s, c; sincospi_f((float)((a * b) & 127) * (2.0f / 128.0f), &s, &c); tab[8192 + j] = f2bf(c * sc2); tab[8192 + 16384 + j] = f2bf(s * sc2); }
    }
}

DEV void phase1_prep(const Params& P, unsigned char* sm) {
    PHASE_TID;
    bf16_t* Bhi = (bf16_t*)sm; bf16_t* Blo = (bf16_t*)(sm + 33024);
    float* gsv = (float*)(sm + 66048);
    float* gbl = (float*)(sm + 70144);
    {
        f32x4 w[2][4];
#pragma unroll
        for (int h = 0; h < 2; ++h)
#pragma unroll
            for (int q = 0; q < 4; ++q) w[h][q] = *(const f32x4*)(P.w_in + (size_t)(TID + h * 512) * W_IN + 2560 + q * 4);
#pragma unroll
        for (int h = 0; h < 2; ++h)
#pragma unroll
            for (int q = 0; q < 4; ++q)
#pragma unroll
                for (int e = 0; e < 4; ++e) { const int n = q * 4 + e, k = TID + h * 512; const float v = w[h][q][e]; const bf16_t hi = f2bf(v); Bhi[n * 1032 + k] = hi; Blo[n * 1032 + k] = f2bf(v - bf2f(hi)); }
    }
    const float* mod = (const float*)(P.ws + WS_MOD);
    bf16_t* h = (bf16_t*)(P.ws + WS_R4 + R4_H);
    float* gb = (float*)(P.ws + WS_GB);
    float* rstd_arr = (float*)(P.ws + WS_RSTD);
    float* bias = (float*)(P.ws + WS_BIAS);
    const int wid = TID >> 6, lane = TID & 63, fr = lane & 15, fq = lane >> 4;
    SYNC();
    const float* shrow = mod + (fr < 8 ? fr : 8) * 6144 + fq * 8;
    if (TID < 256) gbl[TID] = 0.f;
    SYNC();
    {
        f32x4 acc = (f32x4){0.f, 0.f, 0.f, 0.f};
#pragma unroll
        for (int k4 = 0; k4 < 4; ++k4) {
            const int ks = wid * 4 + k4;
            const f32x4 a0 = *(const f32x4*)(shrow + ks * 32), a1 = *(const f32x4*)(shrow + ks * 32 + 4);
            const float hv[8] = {a0[0], a0[1], a0[2], a0[3], a1[0], a1[1], a1[2], a1[3]};
            u32x4 whi, wlo;
#pragma unroll
            for (int e = 0; e < 4; ++e) { whi[e] = pk2(hv[2 * e], hv[2 * e + 1]); wlo[e] = pk2(hv[2 * e] - __builtin_bit_cast(float, whi[e] << 16), hv[2 * e + 1] - __builtin_bit_cast(float, whi[e] & 0xffff0000u)); }
            const bf16x8 ahi = __builtin_bit_cast(bf16x8, whi), alo = __builtin_bit_cast(bf16x8, wlo);
            const bf16x8 bhi = frag16(Bhi + fr * 1032 + ks * 32 + fq * 8), blo = frag16(Blo + fr * 1032 + ks * 32 + fq * 8);
            acc = mfma16(ahi, bhi, acc); acc = mfma16(alo, bhi, acc); acc = mfma16(ahi, blo, acc);
        }
#pragma unroll
        for (int r = 0; r < 4; ++r) atomic_add_f32(&gbl[(fq * 4 + r) * 16 + fr], acc[r]);
    }
    {
        const bf16_t* wq = (const bf16_t*)(P.ws + WS_WQKVZ); const bf16_t* wf = (const bf16_t*)(P.ws + WS_WF);
        for (int it = BID * 8 + wid; it < 192; it += NBLK * 8) {
            const int n0 = it * 16;
            const bf16_t* wrow = (n0 < 2048 ? wq + (size_t)(n0 + fr) * 1024 : wf + (size_t)(n0 - 2048 + fr) * 1024) + fq * 8;
            f32x4 acc = (f32x4){0.f, 0.f, 0.f, 0.f};
#pragma unroll 4
            for (int ks = 0; ks < 32; ++ks) {
                const f32x4 a0 = *(const f32x4*)(shrow + ks * 32), a1 = *(const f32x4*)(shrow + ks * 32 + 4);
                const float hv[8] = {a0[0], a0[1], a0[2], a0[3], a1[0], a1[1], a1[2], a1[3]};
                u32x4 whi, wlo;
#pragma unroll
                for (int e = 0; e < 4; ++e) { whi[e] = pk2(hv[2 * e], hv[2 * e + 1]); wlo[e] = pk2(hv[2 * e] - __builtin_bit_cast(float, whi[e] << 16), hv[2 * e + 1] - __builtin_bit_cast(float, whi[e] & 0xffff0000u)); }
                const bf16x8 bw = frag16(wrow + ks * 32);
                acc = mfma16(__builtin_bit_cast(bf16x8, whi), bw, acc); acc = mfma16(__builtin_bit_cast(bf16x8, wlo), bw, acc);
            }
#pragma unroll
            for (int r = 0; r < 4; ++r) { const int mbr = fq * 4 + r; if (mbr < 9) bias[mbr * 3072 + n0 + fr] = acc[r]; }
        }
    }
    for (int t = BID; t < MROWS / 128; t += NBLK) {
        const int r0 = t * 128 + wid * 16, mb = (t * 128 < NTOK) ? ((t * 128) >> 13) : 8;
        SYNC();
        { const float* scale = mod + mb * 6144 + 1024;
#pragma unroll
          for (int q = 0; q < 2; ++q) { const int k = TID + q * 512; gsv[k] = P.norm1_g[k] * (1.0f + scale[k]); } }
        SYNC();
        const int rr = r0 + fr;
        const float* src = (rr < NTOK ? P.x + (size_t)rr * D : P.ctx + (size_t)(rr - NTOK) * D) + fq * 8;
        float ss = 0.f;
        f32x4 acc = (f32x4){0.f, 0.f, 0.f, 0.f};
        bf16_t* hrow = h + (size_t)rr * D + fq * 8;
#pragma unroll 8
        for (int ks = 0; ks < 32; ++ks) {
            const f32x4 a0 = *(const f32x4*)(src + ks * 32), a1 = *(const f32x4*)(src + ks * 32 + 4);
            ss += a0[0] * a0[0] + a0[1] * a0[1] + a0[2] * a0[2] + a0[3] * a0[3] + a1[0] * a1[0] + a1[1] * a1[1] + a1[2] * a1[2] + a1[3] * a1[3];
            const f32x4 g0 = *(const f32x4*)(gsv + ks * 32 + fq * 8), g1 = *(const f32x4*)(gsv + ks * 32 + fq * 8 + 4);
            float hv[8];
#pragma unroll
            for (int e = 0; e < 4; ++e) { hv[e] = a0[e] * g0[e]; hv[4 + e] = a1[e] * g1[e]; }
            u32x4 whi, wlo;
#pragma unroll
            for (int e = 0; e < 4; ++e) { whi[e] = pk2(hv[2 * e], hv[2 * e + 1]); wlo[e] = pk2(hv[2 * e] - __builtin_bit_cast(float, whi[e] << 16), hv[2 * e + 1] - __builtin_bit_cast(float, whi[e] & 0xffff0000u)); }
            *(u32x4*)(hrow + ks * 32) = whi;
            const bf16x8 ahi = __builtin_bit_cast(bf16x8, whi), alo = __builtin_bit_cast(bf16x8, wlo);
            const bf16x8 bhi = frag16(Bhi + fr * 1032 + ks * 32 + fq * 8), blo = frag16(Blo + fr * 1032 + ks * 32 + fq * 8);
            acc = mfma16(ahi, bhi, acc); acc = mfma16(alo, bhi, acc); acc = mfma16(ahi, blo, acc);
        }
        ss += shfl_xor_f(ss, 16); ss += shfl_xor_f(ss, 32);
        const float rstd = rsq_f(ss * (1.0f / 1024.0f) + EPS);
        if (fq == 0) rstd_arr[rr] = rstd;
        float ea = 0.f, db = 0.f;
        if (fr >= 8) { ea = -__expf(P.a_log[fr - 8]); db = P.dt_bias[fr - 8]; }
        const float gbias = gbl[mb * 16 + fr];
#pragma unroll
        for (int reg = 0; reg < 4; ++reg) { const float v = acc[reg] * shfl_idx_f(rstd, fq * 4 + reg) + gbias; float o;
            if (fr < 8) o = rcp_f(1.0f + __expf(-v));
            else { const float z = v + db; const float sp = z > 20.f ? z : log1pf(__expf(z)); o = ea * sp; }
            gb[(size_t)(r0 + fq * 4 + reg) * 16 + fr] = o; }
    }
}

#ifndef CPU_EMU
namespace pg8 {
#define PG8_LAS __attribute__((address_space(3)))
constexpr int BM = 256, BK = 64, HALF = 128, HTB = HALF * BK * 2, STAGE_BYTES = 8 * HTB;
__device__ __forceinline__ int lds_byte(int r, int c) { const int st = (r >> 4) * 2 + (c >> 5), rr = r & 15, cc = c & 31, ob = rr * 64 + cc * 2; return st * 1024 + (ob ^ (((ob >> 9) & 1) << 5)); }
__device__ __forceinline__ void stage_rc(int b, int& R, int& C) { const int st = b / 1024, sb = b % 1024, swz = sb ^ (((sb >> 9) & 1) << 5); R = (st >> 1) * 16 + swz / 64; C = (st & 1) * 32 + (swz % 64) / 2; }
__device__ __forceinline__ int perm32(int rho) { const int n = rho >> 4, i = rho & 15; return 8 * (i >> 2) + 4 * n + (i & 3); }
struct Unit { int pm, pn, e, cnt; };
typedef int v8i32 __attribute__((ext_vector_type(8)));
typedef int v4i32 __attribute__((ext_vector_type(4)));
__device__ __forceinline__ unsigned cvt_pk_bf16(float lo, float hi) { unsigned r; asm volatile("v_cvt_pk_bf16_f32 %0, %1, %2" : "=v"(r) : "v"(lo), "v"(hi)); return r; }

template <class Prob, class Epi>
__device__ __forceinline__ void gemm_phase(PG8_LAS unsigned char* lds, const Prob& G, const Epi& E) {
    int tid_ = MK_TID(G.wv); asm volatile("" : "+v"(tid_));
    const int tid = tid_, wid = __builtin_amdgcn_readfirstlane(tid >> 6), lane = tid & 63, wr = wid >> 2, wc = wid & 3, fr = lane & 15, fq = lane >> 4;
    const int K = G.K, nt = K / BK;
    int R0, C0; stage_rc(tid * 16, R0, C0);
    const int rA0 = R0, rA1 = R0 + 64;
    const int rB0 = Epi::PERM ? ((R0 & ~31) + perm32(R0 & 31)) : R0, rB1 = Epi::PERM ? (((R0 + 64) & ~31) + perm32((R0 + 64) & 31)) : R0 + 64;
    const unsigned ldsw = (unsigned)wid * 1024u;
    const int aoff = lds_byte(wr * 64 + fr, fq * 8), boff = lds_byte(wc * 32 + fr, fq * 8);
    const unsigned ldsbase = (unsigned)__builtin_amdgcn_readfirstlane((int)(unsigned)(__SIZE_TYPE__)(lds + ldsw));
    const char* Ab = (const char*)G.A; const char* Bb = (const char*)G.Bt;
#define PG8_SA(b, h) (((b) * 2 + (h)) * HTB)
#define PG8_SB(b, h) ((4 + (b) * 2 + (h)) * HTB)
#define PG8_STAGE(bufoff, gbase, ub, l0, l1) do { \
        if constexpr (Prob::F8) {     \
            const char* sb_ = (gbase) + (size_t)(ub); const unsigned m0_ = ldsbase + (unsigned)(bufoff); \
            asm volatile("s_mov_b32 m0, %2\n\ts_nop 0\n\tglobal_load_lds_dwordx4 %0, %1\n\ts_mov_b32 m0, %4\n\ts_nop 0\n\tglobal_load_lds_dwordx4 %3, %1" \
                         :: "v"(l0), "s"(sb_), "s"(m0_), "v"(l1), "s"(m0_ + 8192u) : "memory", "m0"); \
        } else { \
        __builtin_amdgcn_global_load_lds((const unsigned*)((gbase) + (size_t)(ub) + (l0)), (PG8_LAS unsigned*)(lds + (bufoff) + ldsw), 16, 0, 0); \
        __builtin_amdgcn_global_load_lds((const unsigned*)((gbase) + (size_t)(ub) + (l1)), (PG8_LAS unsigned*)(lds + (bufoff) + ldsw + 8192), 16, 0, 0); } } while (0)
#define PG8_LDA(dst, b, h) do { _Pragma("unroll") for (int m = 0; m < 4; ++m) _Pragma("unroll") for (int k = 0; k < 2; ++k) dst[m][k] = *(const PG8_LAS bf16x8*)(lds + PG8_SA(b, h) + aoff + m * 2048 + k * 1024); } while (0)
#define PG8_LDB(dst, b, h) do { _Pragma("unroll") for (int n = 0; n < 2; ++n) _Pragma("unroll") for (int k = 0; k < 2; ++k) dst[n][k] = *(const PG8_LAS bf16x8*)(lds + PG8_SB(b, h) + boff + n * 2048 + k * 1024); } while (0)
#define PG8_CAT(f) __builtin_shufflevector(__builtin_bit_cast(v4i32, f[0]), __builtin_bit_cast(v4i32, f[1]), 0, 1, 2, 3, 4, 5, 6, 7)
#define PG8_MMA(ai, bj, At, Bt) do { __builtin_amdgcn_s_setprio(1); \
        if constexpr (Prob::F8) { _Pragma("unroll") for (int m = 0; m < 4; ++m) _Pragma("unroll") for (int n = 0; n < 2; ++n) \
            acc[ai][bj][m][n] = __builtin_amdgcn_mfma_scale_f32_16x16x128_f8f6f4(PG8_CAT(Bt[n]), PG8_CAT(At[m]), acc[ai][bj][m][n], 0, 0, 0, 0, 0, 0); } \
        else { _Pragma("unroll") for (int m = 0; m < 4; ++m) _Pragma("unroll") for (int n = 0; n < 2; ++n) _Pragma("unroll") for (int k = 0; k < 2; ++k) \
            acc[ai][bj][m][n] = __builtin_amdgcn_mfma_f32_16x16x32_bf16(Bt[n][k], At[m][k], acc[ai][bj][m][n], 0, 0, 0); } \
        __builtin_amdgcn_s_setprio(0); } while (0)
#define PG8_WAIT_V(n) asm volatile("s_waitcnt vmcnt(" #n ")" ::: "memory")
#define PG8_WAIT_L(n) asm volatile("s_waitcnt lgkmcnt(" #n ")" ::: "memory")
#define PG8_BAR __builtin_amdgcn_s_barrier()
#define PG8_SCHED __builtin_amdgcn_sched_barrier(0)
    Unit cur, nxt; int ui = 0;
    if (!G.next(0, cur)) return;
    f32x4 acc[2][2][4][2];
#pragma unroll
    for (int a = 0; a < 2; ++a)
#pragma unroll
        for (int b = 0; b < 2; ++b)
#pragma unroll
            for (int m = 0; m < 4; ++m)
#pragma unroll
                for (int n = 0; n < 2; ++n) acc[a][b][m][n] = (f32x4){0.f, 0.f, 0.f, 0.f};
    bf16x8 At[4][2], B0[2][2], B1[2][2];
    const unsigned cb2 = (unsigned)C0 * 2u;
    const unsigned lB00 = G.laneB(rB0) + cb2, lB01 = G.laneB(rB1) + cb2, lB10 = G.laneB(128 + rB0) + cb2, lB11 = G.laneB(128 + rB1) + cb2;
    const unsigned lA00 = G.laneA(rA0) + cb2, lA01 = G.laneA(rA1) + cb2, lA10 = G.laneA(128 + rA0) + cb2, lA11 = G.laneA(128 + rA1) + cb2;
    unsigned cA00 = lA00, cA01 = lA01, cA10 = lA10, cA11 = lA11, nA00 = lA00, nA01 = lA01, nA10 = lA10, nA11 = lA11;
    if constexpr (Prob::GATHER_A) { cA00 += G.gathA(cur, rA0); cA01 += G.gathA(cur, rA1); cA10 += G.gathA(cur, 128 + rA0); cA11 += G.gathA(cur, 128 + rA1); }
    unsigned uAc = G.baseA(cur), uBc = G.baseB(cur), uAn = uAc, uBn = uBc;
    if constexpr (Epi::PREFETCH) E.prefetch(cur, lds + STAGE_BYTES + 2048, wid, lane);
    PG8_STAGE(PG8_SB(0, 0), Bb, uBc, lB00, lB01); PG8_STAGE(PG8_SA(0, 0), Ab, uAc, cA00, cA01); PG8_STAGE(PG8_SB(0, 1), Bb, uBc, lB10, lB11); PG8_STAGE(PG8_SA(0, 1), Ab, uAc, cA10, cA11);
    if (wr == 1) PG8_BAR;
    PG8_WAIT_V(4); PG8_BAR;
    PG8_STAGE(PG8_SB(1, 0), Bb, uBc + 128u, lB00, lB01); PG8_STAGE(PG8_SA(1, 0), Ab, uAc + 128u, cA00, cA01); PG8_STAGE(PG8_SB(1, 1), Bb, uBc + 128u, lB10, lB11);
    PG8_WAIT_V(6); PG8_BAR;
    for (;;) {
        const bool has_next = G.next(ui + 1, nxt);
        if constexpr (Epi::PREFETCH) { if (has_next) { const int lane_o = mk_lane_volatile(); E.prefetch(nxt, lds + STAGE_BYTES + 2048 + ((ui + 1) % 3) * 2048, wid, lane_o); } }
        if constexpr (Prob::LDSGATH) { if (has_next) { const int lane_o = mk_lane_volatile(); G.prefetchA(nxt, lds + STAGE_BYTES + 8192, wid, lane_o); } }
        if (has_next) {
            uAn = G.baseA(nxt); uBn = G.baseB(nxt);
            if constexpr (Prob::GATHER_A && !Prob::LDSGATH) { nA00 = lA00 + G.gathA(nxt, rA0); nA01 = lA01 + G.gathA(nxt, rA1); nA10 = lA10 + G.gathA(nxt, 128 + rA0); nA11 = lA11 + G.gathA(nxt, 128 + rA1); }
        } else { uAn = uAc; uBn = uBc; if constexpr (Prob::GATHER_A && !Prob::LDSGATH) { nA00 = cA00; nA01 = cA01; nA10 = cA10; nA11 = cA11; } }
        for (int t = 0; t < nt; t += 2) {
            const bool last = (t == nt - 2);
            const unsigned k1 = (unsigned)(t + 1) * 128u;
            const unsigned uA2 = last ? uAn : uAc + (unsigned)(t + 2) * 128u, uB2 = last ? uBn : uBc + (unsigned)(t + 2) * 128u, uA3 = uA2 + 128u, uB3 = uB2 + 128u;
            unsigned a00 = cA00, a01 = cA01, a10 = cA10, a11 = cA11;
            if constexpr (Prob::GATHER_A && !Prob::LDSGATH) { a00 = last ? nA00 : cA00; a01 = last ? nA01 : cA01; a10 = last ? nA10 : cA10; a11 = last ? nA11 : cA11; }
            PG8_LDB(B0, 0, 0); PG8_SCHED; PG8_LDA(At, 0, 0); PG8_STAGE(PG8_SA(1, 1), Ab, uAc + k1, cA10, cA11);
            PG8_WAIT_L(8); PG8_BAR; PG8_WAIT_L(0); PG8_MMA(0, 0, At, B0); PG8_BAR; PG8_SCHED;
            if constexpr (Prob::LDSGATH) {
                if (last && has_next) { const PG8_LAS unsigned char* gb = lds + STAGE_BYTES + 8192;
                    cA00 = lA00 + G.gathL(nxt, gb, rA0); cA01 = lA01 + G.gathL(nxt, gb, rA1); cA10 = lA10 + G.gathL(nxt, gb, 128 + rA0); cA11 = lA11 + G.gathL(nxt, gb, 128 + rA1); }
                a00 = cA00; a01 = cA01; a10 = cA10; a11 = cA11; }
            PG8_LDB(B1, 0, 1); PG8_STAGE(PG8_SB(0, 0), Bb, uB2, lB00, lB01);
            PG8_BAR; PG8_WAIT_L(0); PG8_MMA(0, 1, At, B1); PG8_BAR;
            PG8_LDA(At, 0, 1); PG8_STAGE(PG8_SA(0, 0), Ab, uA2, a00, a01);
            PG8_BAR; PG8_WAIT_L(0); PG8_MMA(1, 0, At, B0); PG8_BAR; PG8_SCHED;
            PG8_STAGE(PG8_SB(0, 1), Bb, uB2, lB10, lB11);
            PG8_WAIT_V(6); PG8_BAR; PG8_MMA(1, 1, At, B1); PG8_BAR;
            PG8_LDB(B0, 1, 0); PG8_SCHED; PG8_LDA(At, 1, 0); PG8_STAGE(PG8_SA(0, 1), Ab, uA2, a10, a11);
            PG8_WAIT_L(8); PG8_BAR; PG8_WAIT_L(0); PG8_MMA(0, 0, At, B0); PG8_BAR; PG8_SCHED;
            PG8_LDB(B1, 1, 1); PG8_STAGE(PG8_SB(1, 0), Bb, uB3, lB00, lB01);
            PG8_BAR; PG8_WAIT_L(0); PG8_MMA(0, 1, At, B1); PG8_BAR;
            PG8_LDA(At, 1, 1); PG8_STAGE(PG8_SA(1, 0), Ab, uA3, a00, a01);
            PG8_BAR; PG8_WAIT_L(0); PG8_MMA(1, 0, At, B0); PG8_BAR; PG8_SCHED;
            PG8_STAGE(PG8_SB(1, 1), Bb, uB3, lB10, lB11);
            PG8_WAIT_V(6); PG8_BAR; PG8_MMA(1, 1, At, B1); PG8_BAR;
        }
        { const int le = mk_lane_volatile();
          E(acc, cur, wr, wc, le & 15, le >> 4, (const PG8_LAS float*)(lds + STAGE_BYTES + 2048 + (ui % 3) * 2048)); }
        if (!has_next) break;
#pragma unroll
        for (int a = 0; a < 2; ++a)
#pragma unroll
            for (int b = 0; b < 2; ++b)
#pragma unroll
                for (int m = 0; m < 4; ++m)
#pragma unroll
                    for (int n = 0; n < 2; ++n) acc[a][b][m][n] = (f32x4){0.f, 0.f, 0.f, 0.f};
        cur = nxt; ++ui; uAc = uAn; uBc = uBn;
        if constexpr (Prob::GATHER_A && !Prob::LDSGATH) { cA00 = nA00; cA01 = nA01; cA10 = nA10; cA11 = nA11; }
    }
    PG8_WAIT_V(0);
    if (wr == 0) PG8_BAR;
    PG8_BAR;
#undef PG8_SA
#undef PG8_SB
#undef PG8_STAGE
#undef PG8_LDA
#undef PG8_LDB
#undef PG8_MMA
#undef PG8_CAT
#undef PG8_WAIT_V
#undef PG8_WAIT_L
#undef PG8_BAR
#undef PG8_SCHED
}

struct GridOrder {
    int nM, nN, nwg, G, c, wv;
    __device__ __forceinline__ void init(int nM_, int nN_, int G_, int c_) { nM = nM_; nN = nN_; nwg = nM * nN; G = G_; c = c_; }
    __device__ __forceinline__ bool next(int i, Unit& u) const {
        const long L = (long)i * G + c; if (L >= nwg) return false;
        int wgid = (int)L; { const int q = nwg / 8, r = nwg % 8, xcd = wgid % 8, off = wgid / 8; wgid = (xcd < r ? xcd * (q + 1) : r * (q + 1) + (xcd - r) * q) + off; }
        const int nig = 8 * nN, gid = wgid / nig, fm = gid * 8, gsz = (nM - fm) < 8 ? (nM - fm) : 8;
        u.pm = fm + ((wgid % nig) % gsz); u.pn = (wgid % nig) / gsz; u.e = 0; u.cnt = 256; return true;
    }
};

struct ProbInproj : GridOrder { const bf16_t* A; const bf16_t* Bt; int K; static constexpr bool GATHER_A = false; static constexpr bool F8 = false; static constexpr bool LDSGATH = false;
    __device__ __forceinline__ unsigned laneA(int r) const { return (unsigned)r * 2048u; }
    __device__ __forceinline__ unsigned laneB(int r) const { return (unsigned)r * 2048u; }
    __device__ __forceinline__ unsigned baseA(const Unit& u) const { return (unsigned)(u.pm * 256) * 2048u; }
    __device__ __forceinline__ unsigned baseB(const Unit& u) const { return (unsigned)(u.pn * 256) * 2048u; }
    __device__ __forceinline__ unsigned gathA(const Unit&, int) const { return 0u; } };
struct ProbGT : GridOrder { const bf16_t* A; const bf16_t* Bt; int K; static constexpr bool GATHER_A = false; static constexpr bool F8 = false; static constexpr bool LDSGATH = false;
    __device__ __forceinline__ unsigned laneA(int r) const { return (unsigned)r * 2048u; }
    __device__ __forceinline__ unsigned laneB(int r) const { return (unsigned)(128 * (r & 63) + (r >> 6)) * 2048u; }
    __device__ __forceinline__ unsigned baseA(const Unit& u) const { return (unsigned)(u.pm * 256) * 2048u; }
    __device__ __forceinline__ unsigned baseB(const Unit& u) const { const int col = u.pn * 256, b = col >> 13, w = col & 8191; return (unsigned)(b * 8192 + (w >> 6)) * 2048u; }
    __device__ __forceinline__ unsigned gathA(const Unit&, int) const { return 0u; } };
struct EpiStoreBf16 {
    static constexpr bool PERM = true, PREFETCH = false; bf16_t* O; int ldc;
    __device__ __forceinline__ void operator()(const f32x4 (&acc)[2][2][4][2], const Unit& u, int wr, int wc, int fr, int fq, const PG8_LAS float* ex) const {
        const int row0 = u.pm * 256 + wr * 64 + fr, col0 = u.pn * 256 + wc * 32 + 8 * fq;
#pragma unroll
        for (int ai = 0; ai < 2; ++ai)
#pragma unroll
            for (int m = 0; m < 4; ++m) { bf16_t* rowp = O + (size_t)(row0 + ai * 128 + m * 16) * ldc + col0;
#pragma unroll
                for (int bj = 0; bj < 2; ++bj) { const f32x4 v0 = acc[ai][bj][m][0], v1 = acc[ai][bj][m][1];
                    u32x4 w; w.x = cvt_pk_bf16(v0[0], v0[1]); w.y = cvt_pk_bf16(v0[2], v0[3]); w.z = cvt_pk_bf16(v1[0], v1[1]); w.w = cvt_pk_bf16(v1[2], v1[3]);
                    *(u32x4*)(rowp + bj * 128) = w; } }
    }
};
struct EpiGT {
    static constexpr bool PERM = true, PREFETCH = true; bf16_t* O; const float* rstd; const float* bias;
    __device__ __forceinline__ void prefetch(const Unit& u, PG8_LAS unsigned char* ex, int wid, int lane) const {
        const int mb = (u.pn * 256) >> 13;
        if (wid == 0) __builtin_amdgcn_global_load_lds((const unsigned*)(bias + mb * 3072 + 2048 + u.pm * 256 + lane * 4), (PG8_LAS unsigned*)(ex + 1024), 16, 0, 0);
        else if (wid <= 4) { const int c = u.pn * 256 + (wid - 1) * 64 + lane, w = c & 8191;
            __builtin_amdgcn_global_load_lds((const unsigned*)(rstd + mb * 8192 + 128 * (w & 63) + (w >> 6)), (PG8_LAS unsigned*)(ex + (wid - 1) * 256), 4, 0, 0); }
    }
    __device__ __forceinline__ void operator()(const f32x4 (&acc)[2][2][4][2], const Unit& u, int wr, int wc, int fr, int fq, const PG8_LAS float* ex) const {
        const int row0 = u.pm * 256 + wr * 64 + fr, col0 = u.pn * 256 + wc * 32 + 8 * fq;
        float rs[2][8];
#pragma unroll
        for (int bj = 0; bj < 2; ++bj) { const f32x4 r0_ = *(const PG8_LAS f32x4*)(ex + bj * 128 + wc * 32 + 8 * fq), r1_ = *(const PG8_LAS f32x4*)(ex + bj * 128 + wc * 32 + 8 * fq + 4);
            rs[bj][0] = r0_[0]; rs[bj][1] = r0_[1]; rs[bj][2] = r0_[2]; rs[bj][3] = r0_[3]; rs[bj][4] = r1_[0]; rs[bj][5] = r1_[1]; rs[bj][6] = r1_[2]; rs[bj][7] = r1_[3]; }
#pragma unroll
        for (int ai = 0; ai < 2; ++ai)
#pragma unroll
            for (int m = 0; m < 4; ++m) { const int row = row0 + ai * 128 + m * 16; const float bg = ex[256 + wr * 64 + fr + ai * 128 + m * 16]; bf16_t* rowp = O + (size_t)row * NTOK + col0;
#pragma unroll
                for (int bj = 0; bj < 2; ++bj) { const f32x4 a0 = acc[ai][bj][m][0], a1 = acc[ai][bj][m][1];
                    u32x4 w; w.x = cvt_pk_bf16(a0[0] * rs[bj][0] + bg, a0[1] * rs[bj][1] + bg); w.y = cvt_pk_bf16(a0[2] * rs[bj][2] + bg, a0[3] * rs[bj][3] + bg);
                    w.z = cvt_pk_bf16(a1[0] * rs[bj][4] + bg, a1[1] * rs[bj][5] + bg); w.w = cvt_pk_bf16(a1[2] * rs[bj][6] + bg, a1[3] * rs[bj][7] + bg);
                    *(u32x4*)(rowp + bj * 128) = w; } }
    }
};
struct EpiInproj {
    static constexpr bool PERM = true, PREFETCH = true; bf16_t* O; bf16_t* zs; const float* rstd; const float* bias;
    __device__ __forceinline__ void prefetch(const Unit& u, PG8_LAS unsigned char* ex, int wid, int lane) const {
        if (wid == 0) __builtin_amdgcn_global_load_lds((const unsigned*)(rstd + u.pm * 256 + lane * 4), (PG8_LAS unsigned*)ex, 16, 0, 0);
        else if (wid == 1) __builtin_amdgcn_global_load_lds((const unsigned*)(bias + ((u.pm * 256 < NTOK) ? ((u.pm * 256) >> 13) : 8) * 3072 + u.pn * 256 + lane * 4), (PG8_LAS unsigned*)(ex + 1024), 16, 0, 0);
    }
    __device__ __forceinline__ void operator()(const f32x4 (&acc)[2][2][4][2], const Unit& u, int wr, int wc, int fr, int fq, const PG8_LAS float* ex) const {
        const int row0 = u.pm * 256 + wr * 64 + fr, col0 = u.pn * 256 + wc * 32 + 8 * fq;
        const bool isz = u.pn >= 6;
        if (isz && u.pm * 256 >= NTOK) return;
        f32x4 bv[2][2];
#pragma unroll
        for (int bj = 0; bj < 2; ++bj) { bv[bj][0] = *(const PG8_LAS f32x4*)(ex + 256 + bj * 128 + wc * 32 + 8 * fq); bv[bj][1] = *(const PG8_LAS f32x4*)(ex + 256 + bj * 128 + wc * 32 + 8 * fq + 4); }
#pragma unroll
        for (int ai = 0; ai < 2; ++ai)
#pragma unroll
            for (int m = 0; m < 4; ++m) { const size_t row = (size_t)(row0 + ai * 128 + m * 16); const float rs = ex[wr * 64 + fr + ai * 128 + m * 16];
                bf16_t* rowp = isz ? zs + row * 512 + (col0 - 1536) : O + row * 2048 + col0;
#pragma unroll
                for (int bj = 0; bj < 2; ++bj) { f32x4 v0 = acc[ai][bj][m][0] * rs + bv[bj][0], v1 = acc[ai][bj][m][1] * rs + bv[bj][1];
                    if (isz) {
#pragma unroll
                        for (int j = 0; j < 4; ++j) { v0[j] = v0[j] * __builtin_amdgcn_rcpf(1.0f + __expf(-v0[j])); v1[j] = v1[j] * __builtin_amdgcn_rcpf(1.0f + __expf(-v1[j])); } }
                    u32x4 w; w.x = cvt_pk_bf16(v0[0], v0[1]); w.y = cvt_pk_bf16(v0[2], v0[3]); w.z = cvt_pk_bf16(v1[0], v1[1]); w.w = cvt_pk_bf16(v1[2], v1[3]);
                    *(u32x4*)(rowp + bj * 128) = w; } }
    }
};
typedef ProbInproj ProbOut;
struct EpiResid {
    static constexpr bool PERM = false, PREFETCH = false; const float* x; const float* mod; float* out;
    __device__ __forceinline__ void operator()(const f32x4 (&acc)[2][2][4][2], const Unit& u, int wr, int wc, int fr, int fq, const PG8_LAS float* ex) const {
        const int row0 = u.pm * 256 + wr * 64 + fr, col0 = u.pn * 256 + wc * 32 + 4 * fq;
        const float* gate = mod + ((u.pm * 256) >> 13) * 6144 + 2 * 1024;
        f32x4 gv[2][2];
#pragma unroll
        for (int bj = 0; bj < 2; ++bj)
#pragma unroll
            for (int n = 0; n < 2; ++n) gv[bj][n] = *(const f32x4*)(gate + col0 + bj * 128 + n * 16);
#pragma unroll
        for (int ai = 0; ai < 2; ++ai) {
            f32x4 xv[4][2][2];
#pragma unroll
            for (int m = 0; m < 4; ++m) { const size_t off = (size_t)(row0 + ai * 128 + m * 16) * 1024 + col0;
#pragma unroll
                for (int bj = 0; bj < 2; ++bj)
#pragma unroll
                    for (int n = 0; n < 2; ++n) xv[m][bj][n] = *(const f32x4*)(x + off + bj * 128 + n * 16); }
            __builtin_amdgcn_sched_barrier(0);
#pragma unroll
            for (int m = 0; m < 4; ++m) { const size_t off = (size_t)(row0 + ai * 128 + m * 16) * 1024 + col0;
#pragma unroll
                for (int bj = 0; bj < 2; ++bj)
#pragma unroll
                    for (int n = 0; n < 2; ++n) *(f32x4*)(out + off + bj * 128 + n * 16) = xv[m][bj][n] + gv[bj][n] * acc[ai][bj][m][n]; }
        }
    }
};
struct MoeOrder {
    const PG8_LAS int* tb; const PG8_LAS int* cnt; int G, c, wv;
    __device__ __forceinline__ bool next(int i, Unit& u) const {
        const int L = i * G + c, ntile = tb[32]; if (L >= ntile * 4) return false;
        const int tile = L >> 2; u.pn = L & 3; int e = 0;
#pragma unroll
        for (int s = 16; s >= 1; s >>= 1) if (__builtin_amdgcn_readfirstlane(tb[e + s]) <= tile) e += s;
        u.e = e; u.pm = tile; const int loc = (tile - __builtin_amdgcn_readfirstlane(tb[e])) * 256; u.cnt = __builtin_amdgcn_readfirstlane(cnt[e]) - loc; return true;
    }
};
struct ProbMoe1 : MoeOrder { const bf16_t* A; const bf16_t* Bt; int K; const unsigned* tokk; static constexpr bool GATHER_A = true; static constexpr bool F8 = false; static constexpr bool LDSGATH = false;
    __device__ __forceinline__ unsigned laneA(int) const { return 0u; }
    __device__ __forceinline__ unsigned laneB(int r) const { return (unsigned)r * 2048u; }
    __device__ __forceinline__ unsigned baseA(const Unit&) const { return 0u; }
    __device__ __forceinline__ unsigned baseB(const Unit& u) const { return (unsigned)(u.e * 1024 + u.pn * 256) * 2048u; }
    __device__ __forceinline__ unsigned gathA(const Unit& u, int r) const { const int loc = (u.pm - __builtin_amdgcn_readfirstlane(tb[u.e])) * 256 + r; const unsigned tk = r < u.cnt ? tokk[(size_t)u.e * LCAP + loc] : 0u; return (tk >> 1) * 2048u; } };
struct EpiMoe1 {
    static constexpr bool PERM = true, PREFETCH = false; bf16_t* hid;
    __device__ __forceinline__ void operator()(const f32x4 (&acc)[2][2][4][2], const Unit& u, int wr, int wc, int fr, int fq, const PG8_LAS float* ex) const {
        const int row0 = u.pm * 256 + wr * 64 + fr, col0 = u.pn * 128 + wc * 32 + 8 * fq;
#pragma unroll
        for (int ai = 0; ai < 2; ++ai)
#pragma unroll
            for (int m = 0; m < 4; ++m) { float hv[8];
#pragma unroll
                for (int n = 0; n < 2; ++n)
#pragma unroll
                    for (int j = 0; j < 4; ++j) { const float g = acc[ai][0][m][n][j], up = acc[ai][1][m][n][j]; hv[n * 4 + j] = g * __builtin_amdgcn_rcpf(1.0f + __expf(-g)) * up; }
                u32x4 w; w.x = cvt_pk_bf16(hv[0], hv[1]); w.y = cvt_pk_bf16(hv[2], hv[3]); w.z = cvt_pk_bf16(hv[4], hv[5]); w.w = cvt_pk_bf16(hv[6], hv[7]);
                *(u32x4*)(hid + (size_t)(row0 + ai * 128 + m * 16) * 512 + col0) = w; }
    }
};
struct ProbMoe2 : MoeOrder { const bf16_t* A; const bf16_t* Bt; int K; static constexpr bool GATHER_A = false; static constexpr bool F8 = false; static constexpr bool LDSGATH = false;
    __device__ __forceinline__ unsigned laneA(int r) const { return (unsigned)r * 1024u; }
    __device__ __forceinline__ unsigned laneB(int r) const { return (unsigned)r * 1024u; }
    __device__ __forceinline__ unsigned baseA(const Unit& u) const { return (unsigned)(u.pm * 256) * 1024u; }
    __device__ __forceinline__ unsigned baseB(const Unit& u) const { return (unsigned)(u.e * 1024 + u.pn * 256) * 1024u; }
    __device__ __forceinline__ unsigned gathA(const Unit&, int) const { return 0u; } };
struct EpiMoe2 {
    static constexpr bool PERM = true, PREFETCH = true; bf16_t* Y; const unsigned* tokk; const float* wl; const PG8_LAS int* tb;
    __device__ __forceinline__ void prefetch(const Unit& u, PG8_LAS unsigned char* ex, int wid, int lane) const {
        const size_t o = (size_t)u.e * LCAP + (u.pm - __builtin_amdgcn_readfirstlane(tb[u.e])) * 256 + lane * 4;
        if (wid == 0) __builtin_amdgcn_global_load_lds((const unsigned*)(tokk + o), (PG8_LAS unsigned*)ex, 16, 0, 0);
        else if (wid == 1) __builtin_amdgcn_global_load_lds((const unsigned*)(wl + o), (PG8_LAS unsigned*)(ex + 1024), 16, 0, 0);
    }
    __device__ __forceinline__ void operator()(const f32x4 (&acc)[2][2][4][2], const Unit& u, int wr, int wc, int fr, int fq, const PG8_LAS float* ex) const {
        const int col0 = u.pn * 256 + wc * 32 + 8 * fq;
#pragma unroll
        for (int ai = 0; ai < 2; ++ai)
#pragma unroll
            for (int m = 0; m < 4; ++m) { const int r = ai * 128 + wr * 64 + m * 16 + fr;
                if (r < u.cnt) { const unsigned tk = __builtin_bit_cast(unsigned, ex[r]); const float w = ex[256 + r];
                    bf16_t* rowp = Y + ((size_t)(tk & 1u) * NTOK + (tk >> 1)) * 1024 + col0;
#pragma unroll
                    for (int bj = 0; bj < 2; ++bj) { const f32x4 v0 = acc[ai][bj][m][0] * w, v1 = acc[ai][bj][m][1] * w;
                        u32x4 q; q.x = cvt_pk_bf16(v0[0], v0[1]); q.y = cvt_pk_bf16(v0[2], v0[3]); q.z = cvt_pk_bf16(v1[0], v1[1]); q.w = cvt_pk_bf16(v1[2], v1[3]);
                        *(u32x4*)(rowp + bj * 128) = q; } } }
    }
};

constexpr int F8_STAGE = 65536, F8_LDS = 2 * F8_STAGE;
template <class Prob, class Epi, int VAR = 0>
__device__ __forceinline__ void gemm_f8(PG8_LAS unsigned char* lds, const Prob& G, const Epi& E) {
    int tid_ = MK_TID(G.wv); asm volatile("" : "+v"(tid_));
    const int tid = tid_, wid = __builtin_amdgcn_readfirstlane(tid >> 6), lane = tid & 63, wr = wid >> 2, wc = wid & 3, fr = lane & 15, fq = lane >> 4;
    const int nt = G.KB >> 7;
    int R0, C0; stage_rc(tid * 16, R0, C0);
    const unsigned cb = (unsigned)C0 * 2u, ldsw = (unsigned)wid * 1024u;
    const int aoff = lds_byte(wr * 64 + fr, fq * 8), boff = (wc >> 1) * 16384 + lds_byte((wc & 1) * 64 + fr, fq * 8);
    const char* Ab = (const char*)G.A; const char* Bb = (const char*)G.Bt;
    Unit cur, nxt;
    if (!G.next(0, cur)) return;
    const unsigned lB00 = G.laneB(R0) + cb, lB01 = G.laneB(R0 + 64) + cb, lB10 = G.laneB(128 + R0) + cb, lB11 = G.laneB(192 + R0) + cb;
    unsigned cA00 = G.rowA(cur, R0) + cb, cA01 = G.rowA(cur, R0 + 64) + cb, cA10 = G.rowA(cur, 128 + R0) + cb, cA11 = G.rowA(cur, 192 + R0) + cb;
    unsigned nA00 = cA00, nA01 = cA01, nA10 = cA10, nA11 = cA11;
    unsigned uBc = G.baseB(cur), uBn = uBc;
#define F8_ISSUE(buf, a00, a01, a10, a11, ub, kb) do { PG8_LAS unsigned char* sb_ = lds + (buf) * F8_STAGE + ldsw; \
        __builtin_amdgcn_global_load_lds((const unsigned*)(Ab + (size_t)((a00) + (kb))), (PG8_LAS unsigned*)(sb_), 16, 0, 0); \
        __builtin_amdgcn_global_load_lds((const unsigned*)(Ab + (size_t)((a01) + (kb))), (PG8_LAS unsigned*)(sb_ + 8192), 16, 0, 0); \
        __builtin_amdgcn_global_load_lds((const unsigned*)(Ab + (size_t)((a10) + (kb))), (PG8_LAS unsigned*)(sb_ + 16384), 16, 0, 0); \
        __builtin_amdgcn_global_load_lds((const unsigned*)(Ab + (size_t)((a11) + (kb))), (PG8_LAS unsigned*)(sb_ + 24576), 16, 0, 0); \
        __builtin_amdgcn_global_load_lds((const unsigned*)(Bb + (size_t)(ub) + (size_t)(lB00 + (kb))), (PG8_LAS unsigned*)(sb_ + 32768), 16, 0, 0); \
        __builtin_amdgcn_global_load_lds((const unsigned*)(Bb + (size_t)(ub) + (size_t)(lB01 + (kb))), (PG8_LAS unsigned*)(sb_ + 40960), 16, 0, 0); \
        __builtin_amdgcn_global_load_lds((const unsigned*)(Bb + (size_t)(ub) + (size_t)(lB10 + (kb))), (PG8_LAS unsigned*)(sb_ + 49152), 16, 0, 0); \
        __builtin_amdgcn_global_load_lds((const unsigned*)(Bb + (size_t)(ub) + (size_t)(lB11 + (kb))), (PG8_LAS unsigned*)(sb_ + 57344), 16, 0, 0); } while (0)
    f32x4 acc[2][4][4];
#pragma unroll
    for (int a = 0; a < 2; ++a)
#pragma unroll
        for (int m = 0; m < 4; ++m)
#pragma unroll
            for (int n = 0; n < 4; ++n) acc[a][m][n] = (f32x4){0.f, 0.f, 0.f, 0.f};
    F8_ISSUE(0, cA00, cA01, cA10, cA11, uBc, 0u);
    int g = 0, ui = 0;
    for (;;) {
        const bool has_next = G.next(ui + 1, nxt);
        if (has_next) { nA00 = G.rowA(nxt, R0) + cb; nA01 = G.rowA(nxt, R0 + 64) + cb; nA10 = G.rowA(nxt, 128 + R0) + cb; nA11 = G.rowA(nxt, 192 + R0) + cb; uBn = G.baseB(nxt); }
        else { nA00 = cA00; nA01 = cA01; nA10 = cA10; nA11 = cA11; uBn = uBc; }
#pragma unroll 1
        for (int kt = 0; kt < nt; ++kt) {
            asm volatile("s_waitcnt vmcnt(0)" ::: "memory");
            __builtin_amdgcn_s_barrier();
            asm volatile("" ::: "memory");
            {
                const bool wrap = kt + 1 >= nt; const unsigned kb = wrap ? 0u : (unsigned)(kt + 1) * 128u;
                const unsigned a00 = wrap ? nA00 : cA00, a01 = wrap ? nA01 : cA01, a10 = wrap ? nA10 : cA10, a11 = wrap ? nA11 : cA11, ub = wrap ? uBn : uBc;
                if (VAR != 2) F8_ISSUE((g + 1) & 1, a00, a01, a10, a11, ub, kb);
            }
            if (VAR == 1) { ++g; continue; }
            PG8_LAS unsigned char* st = lds + (g & 1) * F8_STAGE;
            v8i32 B8[4];
#pragma unroll
            for (int n = 0; n < 4; ++n) { const v4i32 lo = *(const PG8_LAS v4i32*)(st + 32768 + boff + n * 2048), hi = *(const PG8_LAS v4i32*)(st + 32768 + boff + n * 2048 + 1024);
                B8[n] = __builtin_shufflevector(lo, hi, 0, 1, 2, 3, 4, 5, 6, 7); }
#pragma unroll
            for (int ai = 0; ai < 2; ++ai) {
                v8i32 A8[4];
#pragma unroll
                for (int m = 0; m < 4; ++m) { const v4i32 lo = *(const PG8_LAS v4i32*)(st + ai * 16384 + aoff + m * 2048), hi = *(const PG8_LAS v4i32*)(st + ai * 16384 + aoff + m * 2048 + 1024);
                    A8[m] = __builtin_shufflevector(lo, hi, 0, 1, 2, 3, 4, 5, 6, 7); }
                asm volatile("s_waitcnt lgkmcnt(0)" ::: "memory");
                __builtin_amdgcn_s_setprio(1);
#pragma unroll
                for (int m = 0; m < 4; ++m)
#pragma unroll
                    for (int n = 0; n < 4; ++n) acc[ai][m][n] = __builtin_amdgcn_mfma_scale_f32_16x16x128_f8f6f4(B8[n], A8[m], acc[ai][m][n], 0, 0, 0, 0, 0, 0);
                __builtin_amdgcn_s_setprio(0);
            }
            ++g;
        }
        if (VAR == 0) E(acc, cur, wr, wc, fr, fq);
        else if (acc[0][0][0][0] == 1234.5f && acc[1][3][3][3] == 77.0f) E(acc, cur, wr, wc, fr, fq);
        if (!has_next) break;
#pragma unroll
        for (int a = 0; a < 2; ++a)
#pragma unroll
            for (int m = 0; m < 4; ++m)
#pragma unroll
                for (int n = 0; n < 4; ++n) acc[a][m][n] = (f32x4){0.f, 0.f, 0.f, 0.f};
        cur = nxt; ++ui; cA00 = nA00; cA01 = nA01; cA10 = nA10; cA11 = nA11; uBc = uBn;
    }
    asm volatile("s_waitcnt vmcnt(0)" ::: "memory");
    __builtin_amdgcn_s_barrier();
#undef F8_ISSUE
}
struct MoeOrder8 {
    const PG8_LAS int* tb; const PG8_LAS int* cnt; int G, c, wv;
    __device__ __forceinline__ bool next(int i, Unit& u) const {
        const int ntile = __builtin_amdgcn_readfirstlane(tb[32]), xj = c >> 3, tile = i * (G >> 2) + (c & 7) * (G >> 5) + (xj >> 2); if (tile >= ntile) return false;
        u.pn = xj & 3; int e = 0;
#pragma unroll
        for (int s = 16; s >= 1; s >>= 1) if (__builtin_amdgcn_readfirstlane(tb[e + s]) <= tile) e += s;
        u.e = e; u.pm = tile; const int loc = (tile - __builtin_amdgcn_readfirstlane(tb[e])) * 256; u.cnt = __builtin_amdgcn_readfirstlane(cnt[e]) - loc; return true;
    }
};
struct ProbMoe1F8 : MoeOrder8 { const unsigned char* A; const unsigned char* Bt; int KB; const unsigned* tokk;
    __device__ __forceinline__ unsigned laneB(int r) const { return (unsigned)r * 1024u; }
    __device__ __forceinline__ unsigned baseB(const Unit& u) const { return (unsigned)((u.e * 4 + u.pn) * 256) * 1024u; }
    __device__ __forceinline__ unsigned rowA(const Unit& u, int r) const { const int loc = (u.pm - __builtin_amdgcn_readfirstlane(tb[u.e])) * 256 + r; const unsigned tk = r < u.cnt ? tokk[(size_t)u.e * LCAP + loc] : 0u; return (tk >> 1) * 1024u; } };
struct EpiMoe1F8 {
    unsigned char* hid;
    __device__ __forceinline__ void operator()(const f32x4 (&acc)[2][4][4], const Unit& u, int wr, int wc, int fr, int fq) const {
        const int row0 = u.pm * 256 + wr * 64 + fr, col0 = u.pn * 128 + wc * 32 + fq * 8;
#pragma unroll
        for (int ai = 0; ai < 2; ++ai)
#pragma unroll
            for (int m = 0; m < 4; ++m) { u32x2 q;
#pragma unroll
                for (int n2 = 0; n2 < 2; ++n2) { float hv[4];
#pragma unroll
                    for (int j = 0; j < 4; ++j) { const float g = acc[ai][m][n2][j] * 0.03125f, up = acc[ai][m][2 + n2][j] * 0.03125f; hv[j] = g * __builtin_amdgcn_rcpf(1.0f + __expf(-g)) * up; }
                    q[n2] = pk4_fp8(hv[0], hv[1], hv[2], hv[3]); }
                *(u32x2*)(hid + (size_t)(row0 + ai * 128 + m * 16) * 512 + col0) = q; }
    }
};
struct ProbMoe2F8 : MoeOrder8 { const unsigned char* A; const unsigned char* Bt; int KB;
    __device__ __forceinline__ unsigned laneB(int r) const { return (unsigned)r * 512u; }
    __device__ __forceinline__ unsigned baseB(const Unit& u) const { return (unsigned)(u.e * 1024 + u.pn * 256) * 512u; }
    __device__ __forceinline__ unsigned rowA(const Unit& u, int r) const { return (unsigned)(u.pm * 256 + r) * 512u; } };
struct EpiMoe2F8 {
    unsigned char* Y; const unsigned* tokk; const float* wl; const PG8_LAS int* tb;
    __device__ __forceinline__ void operator()(const f32x4 (&acc)[2][4][4], const Unit& u, int wr, int wc, int fr, int fq) const {
        const int col0 = u.pn * 256 + wc * 64 + 16 * fq, locb = (u.pm - __builtin_amdgcn_readfirstlane(tb[u.e])) * 256;
#pragma unroll
        for (int ai = 0; ai < 2; ++ai)
#pragma unroll
            for (int m = 0; m < 4; ++m) { const int r = ai * 128 + wr * 64 + m * 16 + fr;
                if (r < u.cnt) { const unsigned tk = tokk[(size_t)u.e * LCAP + locb + r]; const float w = wl[(size_t)u.e * LCAP + locb + r] * 0.5f;
                    unsigned char* rowp = Y + ((size_t)(tk & 1u) * NTOK + (tk >> 1)) * 1024 + col0;
                    u32x4 q;
#pragma unroll
                    for (int n = 0; n < 4; ++n) { const f32x4 v = acc[ai][m][n] * w; q[n] = pk4_fp8(v[0], v[1], v[2], v[3]); }
                    *(u32x4*)rowp = q; } }
    }
};
struct ProbMoe1P8 : MoeOrder8 { const unsigned char* A; const unsigned char* Bt; int K; const unsigned* tokk; static constexpr bool GATHER_A = true; static constexpr bool F8 = true; static constexpr bool LDSGATH = true;
    __device__ __forceinline__ void prefetchA(const Unit& u, PG8_LAS unsigned char* gb, int wid, int lane) const {
        if (wid == 0) __builtin_amdgcn_global_load_lds((const unsigned*)(tokk + (size_t)u.e * LCAP + (u.pm - __builtin_amdgcn_readfirstlane(tb[u.e])) * 256 + lane * 4), (PG8_LAS unsigned*)gb, 16, 0, 0); }
    __device__ __forceinline__ unsigned gathL(const Unit& u, const PG8_LAS unsigned char* gb, int r) const { const unsigned tk = *(const PG8_LAS unsigned*)(gb + r * 4); return ((r < u.cnt ? tk : 0u) >> 1) * 1024u; }
    __device__ __forceinline__ unsigned laneA(int) const { return 0u; }
    __device__ __forceinline__ unsigned laneB(int r) const { return (unsigned)r * 1024u; }
    __device__ __forceinline__ unsigned baseA(const Unit&) const { return 0u; }
    __device__ __forceinline__ unsigned baseB(const Unit& u) const { return (unsigned)((u.e * 4 + u.pn) * 256) * 1024u; }
    __device__ __forceinline__ unsigned gathA(const Unit& u, int r) const { const int loc = (u.pm - __builtin_amdgcn_readfirstlane(tb[u.e])) * 256 + r; const unsigned tk = r < u.cnt ? tokk[(size_t)u.e * LCAP + loc] : 0u; return (tk >> 1) * 1024u; } };
struct EpiMoe1P8 {
    static constexpr bool PERM = false, PREFETCH = false; unsigned char* hid;
    __device__ __forceinline__ void operator()(const f32x4 (&acc)[2][2][4][2], const Unit& u, int wr, int wc, int fr, int fq, const PG8_LAS float* ex) const {
        const int row0 = u.pm * 256 + wr * 64 + fr, col0 = u.pn * 128 + wc * 32 + 8 * fq;
#pragma unroll
        for (int ai = 0; ai < 2; ++ai)
#pragma unroll
            for (int m = 0; m < 4; ++m) { u32x2 q;
#pragma unroll
                for (int n = 0; n < 2; ++n) { float hv[4];
#pragma unroll
                    for (int j = 0; j < 4; ++j) { const float g = acc[ai][0][m][n][j] * 0.03125f, up = acc[ai][1][m][n][j] * 0.03125f; hv[j] = g * __builtin_amdgcn_rcpf(1.0f + __expf(-g)) * up; }
                    q[n] = pk4_fp8(hv[0], hv[1], hv[2], hv[3]); }
                *(u32x2*)(hid + (size_t)(row0 + ai * 128 + m * 16) * 512 + col0) = q; }
    }
};
struct ProbMoe2P8 : MoeOrder8 { const unsigned char* A; const unsigned char* Bt; int K; static constexpr bool GATHER_A = false; static constexpr bool F8 = true; static constexpr bool LDSGATH = false;
    __device__ __forceinline__ unsigned laneA(int r) const { return (unsigned)r * 512u; }
    __device__ __forceinline__ unsigned laneB(int r) const { return (unsigned)r * 512u; }
    __device__ __forceinline__ unsigned baseA(const Unit& u) const { return (unsigned)(u.pm * 256) * 512u; }
    __device__ __forceinline__ unsigned baseB(const Unit& u) const { return (unsigned)(u.e * 1024 + u.pn * 256) * 512u; }
    __device__ __forceinline__ unsigned gathA(const Unit&, int) const { return 0u; } };
struct EpiMoe2P8 {
    static constexpr bool PERM = false, PREFETCH = true; unsigned char* Y; const unsigned* tokk; const float* wl; const PG8_LAS int* tb;
    __device__ __forceinline__ void prefetch(const Unit& u, PG8_LAS unsigned char* ex, int wid, int lane) const {
        const size_t o = (size_t)u.e * LCAP + (u.pm - __builtin_amdgcn_readfirstlane(tb[u.e])) * 256 + lane * 4;
        if (wid == 0) __builtin_amdgcn_global_load_lds((const unsigned*)(tokk + o), (PG8_LAS unsigned*)ex, 16, 0, 0);
        else if (wid == 1) __builtin_amdgcn_global_load_lds((const unsigned*)(wl + o), (PG8_LAS unsigned*)(ex + 1024), 16, 0, 0);
    }
    __device__ __forceinline__ void operator()(const f32x4 (&acc)[2][2][4][2], const Unit& u, int wr, int wc, int fr, int fq, const PG8_LAS float* ex) const {
        const int col0 = u.pn * 256 + wc * 64 + 16 * fq;
#pragma unroll
        for (int ai = 0; ai < 2; ++ai)
#pragma unroll
            for (int m = 0; m < 4; ++m) { const int r = ai * 128 + wr * 64 + m * 16 + fr;
                if (r < u.cnt) { const unsigned tk = __builtin_bit_cast(unsigned, ex[r]); const float w = ex[256 + r] * 0.5f;
                    unsigned char* rowp = Y + ((size_t)(tk & 1u) * NTOK + (tk >> 1)) * 1024 + col0;
                    u32x4 q;
#pragma unroll
                    for (int bj = 0; bj < 2; ++bj)
#pragma unroll
                        for (int n = 0; n < 2; ++n) { const f32x4 v = acc[ai][bj][m][n] * w; q[bj * 2 + n] = pk4_fp8(v[0], v[1], v[2], v[3]); }
                    *(u32x4*)rowp = q; } }
    }
};
}
#endif

DEV void conv_row_compute(const Params& P, const bf16_t* ring, const float* wts, int s0, int s1, int s2, int ntap_rows, int slab, bf16_t* dst, int tid) {
    const int cq = tid & 31, tg = tid >> 5;
    typedef float f32x2 __attribute__((ext_vector_type(2)));
    f32x2 acc2[4][2];
#pragma unroll
    for (int t = 0; t < 4; ++t) { acc2[t][0] = (f32x2){0.f, 0.f}; acc2[t][1] = (f32x2){0.f, 0.f}; }
#pragma unroll
    for (int ky = 0; ky < 3; ++ky) {
        if (ntap_rows == 1 && ky != 1) continue;
        const int sl = ky == 0 ? s0 : ky == 1 ? s1 : s2;
        f32x2 w[3][2];
#pragma unroll
        for (int kx = 0; kx < 3; ++kx) { const f32x4 t = *(const f32x4*)(wts + (ky * 3 + kx) * 128 + cq * 4); w[kx][0] = (f32x2){t[0], t[1]}; w[kx][1] = (f32x2){t[2], t[3]}; }
        f32x2 in[6][2];
#pragma unroll
        for (int pos = 0; pos < 6; ++pos) { const u32x2 v = *(const u32x2*)(ring + sl * 8448 + (tg * 4 + pos) * 128 + cq * 4);
            in[pos][0] = (f32x2){__builtin_bit_cast(float, v[0] << 16), __builtin_bit_cast(float, v[0] & 0xffff0000u)}; in[pos][1] = (f32x2){__builtin_bit_cast(float, v[1] << 16), __builtin_bit_cast(float, v[1] & 0xffff0000u)}; }
#pragma unroll
        for (int t = 0; t < 4; ++t)
#pragma unroll
            for (int kx = 0; kx < 3; ++kx) { acc2[t][0] += w[kx][0] * in[t + kx][0]; acc2[t][1] += w[kx][1] * in[t + kx][1]; }
    }
    float acc[4][4];
#pragma unroll
    for (int t = 0; t < 4; ++t) { acc[t][0] = acc2[t][0][0]; acc[t][1] = acc2[t][0][1]; acc[t][2] = acc2[t][1][0]; acc[t][3] = acc2[t][1][1]; }
#pragma unroll
    for (int t = 0; t < 4; ++t) {
        float ss = 0.f;
#pragma unroll
        for (int c = 0; c < 4; ++c) { acc[t][c] = silu_f(acc[t][c]); ss += acc[t][c] * acc[t][c]; }
        if (slab < 8) { ss += shfl_xor_f(ss, 1); ss += shfl_xor_f(ss, 2); ss += shfl_xor_f(ss, 4); ss += shfl_xor_f(ss, 8); ss += shfl_xor_f(ss, 16); const float sc = rsq_f(ss + EPS);
#pragma unroll
            for (int c = 0; c < 4; ++c) acc[t][c] *= sc; }
        u32x2 o; o[0] = pk2(acc[t][0], acc[t][1]); o[1] = pk2(acc[t][2], acc[t][3]);
        *(u32x2*)(dst + (size_t)(tg * 4 + t) * 1536 + cq * 4) = o;
    }
}

DEV void phase3_conv(const Params& P, unsigned char* sm) {
    PHASE_TID;
    const bf16_t* p = (const bf16_t*)(P.ws + WS_R4 + R4_P);
    bf16_t* qkvn = (bf16_t*)(P.ws + WS_R3);
    bf16_t* ring = (bf16_t*)sm;
    float* wts = (float*)(sm + 3 * 16896);
    const u32x4 zero4 = (u32x4){0u, 0u, 0u, 0u};
    for (int it = BID; it < NB * 12 * 8; it += NBLK) {
        const int slab = it % 12, yb = (it / 12) & 7, b = it / 96, y0 = yb * 16;
        const bf16_t* src = p + (size_t)(b * SEQ) * 2048 + slab * 128;
        if (TID < 96) { const int sl = TID / 32, w = TID & 31, cc = (w >> 4) * 65, pc = w & 15; *(u32x4*)(ring + sl * 8448 + cc * 128 + pc * 8) = zero4; }
        if (TID < 288) *(f32x4*)(wts + TID * 4) = *(const f32x4*)(P.conv_w + (size_t)(TID >> 5) * 1536 + slab * 128 + (TID & 31) * 4);
        const int tk0 = TID >> 4, pc = TID & 15;
        u32x4 rr[4][2];
#define CV_LOAD(set, y) do { const bool ok_ = (y) >= 0 && (y) < 128; const int yc_ = ok_ ? (y) : y0;        \
            const u32x4 t0_ = *(const u32x4*)(src + (size_t)(yc_ * 64 + tk0) * 2048 + pc * 8), t1_ = *(const u32x4*)(src + (size_t)(yc_ * 64 + tk0 + 32) * 2048 + pc * 8); \
            rr[set][0] = ok_ ? t0_ : zero4; rr[set][1] = ok_ ? t1_ : zero4; } while (0)
#define CV_STORE(set, slot) do { *(u32x4*)(ring + (slot) * 8448 + (tk0 + 1) * 128 + pc * 8) = rr[set][0]; *(u32x4*)(ring + (slot) * 8448 + (tk0 + 33) * 128 + pc * 8) = rr[set][1]; } while (0)
        CV_LOAD(0, y0 - 1); CV_LOAD(1, y0); CV_LOAD(2, y0 + 1); CV_LOAD(3, y0 + 2);
        CV_STORE(0, 0); CV_STORE(1, 1);
        CV_LOAD(0, y0 + 3);
#pragma unroll 1
        for (int y4 = 0; y4 < 16; y4 += 4) {
#pragma unroll
            for (int u = 0; u < 4; ++u) {
                const int yy = y4 + u;
                const int s0 = yy % 3, s1 = (yy + 1) % 3, s2 = (yy + 2) % 3;
                CV_STORE((u + 2) & 3, s2);
                SYNC();
                CV_LOAD((u + 1) & 3, (yy + 4 <= 16) ? y0 + yy + 4 : 999);
                conv_row_compute(P, ring, wts, s0, s1, s2, 3, slab, qkvn + (size_t)(b * SEQ + (y0 + yy) * 64) * 1536 + slab * 128, TID);
                SYNC();
            }
        }
#undef CV_LOAD
#undef CV_STORE
    }
    for (int it = BID; it < NB * 12 * 4; it += NBLK) {
        const int slab = it % 12, sg = (it / 12) & 3, b = it / 48;
        const bf16_t* src = p + (size_t)(NTOK + b * CTX) * 2048 + slab * 128;
        if (TID < 288) *(f32x4*)(wts + TID * 4) = *(const f32x4*)(P.conv_w + (size_t)(TID >> 5) * 1536 + slab * 128 + (TID & 31) * 4);
        u32x4 r[3];
#pragma unroll
        for (int q = 0; q < 3; ++q) { const int idx = TID + q * 512; r[q] = zero4;
            if (idx < 66 * 16) { const int cc = idx >> 4, pc = idx & 15, tok = sg * 64 + cc - 1; if (tok >= 0 && tok < CTX) r[q] = *(const u32x4*)(src + (size_t)tok * 2048 + pc * 8); } }
#pragma unroll
        for (int q = 0; q < 3; ++q) { const int idx = TID + q * 512; if (idx < 66 * 16) { const int cc = idx >> 4, pc = idx & 15; *(u32x4*)(ring + 1 * 8448 + cc * 128 + pc * 8) = r[q]; } }
        SYNC();
        conv_row_compute(P, ring, wts, 0, 1, 2, 1, slab, qkvn + (size_t)(NTOK + b * CTX + sg * 64) * 1536 + slab * 128, TID);
        SYNC();
    }
}

constexpr int L_K = 0, L_Q = 17408, L_V = 34816, L_KTR = 52224, L_VT = 70656, L_X0F = 89088, L_X0TF = 98304, L_TTF = 107520, L_X0B = 116736, L_X0TB = 125952, L_TTB = 135168, L_GC = 144384, L_SCAL = 161824;
constexpr int L_X1F = 0, L_X1TF = 9216, L_X1B = 18432, L_X1TB = 27648, L_WF = 0, L_WB = 17408, L_AF = 145440, L_AB = 153632;

DEV int chunk_row(int chain, int step, int i) {
    const int b = chain >> 3, dir = chain & 1;
    if (step < 4) { const int pos = step * 64 + i; return NTOK + b * CTX + (dir ? (CTX - 1 - pos) : pos); }
    const int pos = (step - 4) * 64 + i; return b * SEQ + (dir ? (SEQ - 1 - pos) : pos);
}

DEV int img_piece_A(int row, int col0) { return (((row >> 4) * 2 + (col0 >> 5)) * 64 + ((col0 & 31) >> 3) * 16 + (row & 15)) * 16 + ((col0 >> 2) & 1) * 8; }
DEV int img_piece_W(int row, int d0) { return (((row >> 4) * 4 + (d0 >> 5)) * 64 + ((d0 & 31) >> 3) * 16 + (row & 15)) * 16; }

DEV void phase4_prepass(const Params& P, unsigned char* sm) {
    PHASE_TID;
    const bf16_t* qkvn = (const bf16_t*)(P.ws + WS_R3);
    const float* gb = (const float*)(P.ws + WS_GB);
    unsigned char* images = P.ws + WS_R4;
    bf16_t* Ks = (bf16_t*)(sm + L_K); bf16_t* Qs = (bf16_t*)(sm + L_Q); bf16_t* Vs = (bf16_t*)(sm + L_V); bf16_t* KTR = (bf16_t*)(sm + L_KTR); bf16_t* VT = (bf16_t*)(sm + L_VT);
    float* gcf = (float*)(sm + L_GC); float* gcb = gcf + 64; float* btf = gcf + 128; float* btb = gcf + 192;
    const float QSCALE = 0.08838834764831845f;
    const f32x4 z4 = (f32x4){0.f, 0.f, 0.f, 0.f};
    u32x4 pf[6]; float gfp, bfp, gbp, bbp, gbr;
#define PP_ROW0(it_) ((((it_) % NSTEP) < 4) ? NTOK + ((it_) / NSTEP / 4) * CTX + ((it_) % NSTEP) * 64 : ((it_) / NSTEP / 4) * SEQ + (((it_) % NSTEP) - 4) * 64)
#define PP_LOAD(it_) do { const int row0_ = PP_ROW0(it_), h_ = ((it_) / NSTEP) & 3; \
        _Pragma("unroll") for (int q = 0; q < 6; ++q) { const int idx = TID + q * 512, piece = idx & 15, i = (idx >> 4) & 63, which = idx >> 10; \
            pf[q] = *(const u32x4*)(qkvn + (size_t)(row0_ + i) * 1536 + which * 512 + h_ * 128 + piece * 8); } \
        { const int ln_ = TID & 63; const float* gr = gb + (size_t)(row0_ + ln_) * 16; gfp = gr[8 + h_]; bfp = gr[h_]; gbp = gr[12 + h_]; bbp = gr[4 + h_]; gbr = gb[(size_t)(row0_ + 63 - ln_) * 16 + 12 + h_]; } } while (0)
    const int NIT = NB * 4 * NSTEP;
    int it = BID;
    if (it < NIT) PP_LOAD(it);
    for (; it < NIT; it += NBLK) {
        int tq_ = TID;
#ifndef CPU_EMU
        asm volatile("" : "+v"(tq_));
#endif
        const int wid = tq_ >> 6, lane = tq_ & 63, fr = lane & 15, fq = lane >> 4;
        const int bh = it / NSTEP, st = it - bh * NSTEP;
        const int stb = st < 4 ? 3 - st : 4 + (127 - (st - 4));
        unsigned char* imgf = images + ((size_t)(bh * 2) * NSTEP + st) * IMG_BYTES;
        unsigned char* imgb = images + ((size_t)(bh * 2 + 1) * NSTEP + stb) * IMG_BYTES;
#pragma unroll
        for (int q = 0; q < 6; ++q) { const int idx = TID + q * 512, piece = idx & 15, i = (idx >> 4) & 63, which = idx >> 10;
            *(u32x4*)((which == 0 ? Qs : which == 1 ? Ks : Vs) + i * 136 + piece * 8) = pf[q]; }
        if (wid == 0) { float g = gfp;
#pragma unroll
            for (int o = 1; o < 64; o <<= 1) { const float t = shfl_up_f(g, o); if (lane >= o) g += t; }
            gcf[lane] = g; btf[lane] = bfp; }
        if (wid == 1) { float g = gbr;
#pragma unroll
            for (int o = 1; o < 64; o <<= 1) { const float t = shfl_up_f(g, o); if (lane >= o) g += t; }
            gcb[63 - lane] = g; btb[lane] = bbp; }
        { const int nx = (it + NBLK < NIT) ? it + NBLK : it; PP_LOAD(nx); }
        SYNC();
        const float glf = gcf[63], glb = gcb[0];
        bf16_t* X0F = (bf16_t*)(sm + L_X0F); bf16_t* X0TF = (bf16_t*)(sm + L_X0TF); bf16_t* TTF = (bf16_t*)(sm + L_TTF);
        bf16_t* X0B = (bf16_t*)(sm + L_X0B); bf16_t* X0TB = (bf16_t*)(sm + L_X0TB); bf16_t* TTB = (bf16_t*)(sm + L_TTB);
        f32x4 TregF[2], TTregF[2], TregB[2], TTregB[2];
#pragma unroll
        for (int tt = 0; tt < 2; ++tt) {
            const int t = wid * 2 + tt, ti = t >> 2, tj = t & 3;
            f32x4 kk = z4, kkT = z4, qkT = z4;
#pragma unroll
            for (int ks = 0; ks < 4; ++ks) {
                const bf16x8 fKi = frag16(Ks + (ti * 16 + fr) * 136 + ks * 32 + fq * 8), fKj = frag16(Ks + (tj * 16 + fr) * 136 + ks * 32 + fq * 8), fQi = frag16(Qs + (ti * 16 + fr) * 136 + ks * 32 + fq * 8);
                kk = mfma16(fKi, fKj, kk); kkT = mfma16(fKj, fKi, kkT); qkT = mfma16(fKj, fQi, qkT);
            }
            {
              const int j = tj * 16 + fr; const float gfj = gcf[j], gbj = gcb[j]; float mf[4], mb_[4];
#pragma unroll
              for (int r = 0; r < 4; ++r) { const int i = ti * 16 + fq * 4 + r;
                  const float ef = __expf(fminf(gcf[i] - gfj, 0.f)) * btf[i] * kk[r], eb = __expf(fminf(gcb[i] - gbj, 0.f)) * btb[i] * kk[r];
                  mf[r] = (i > j) ? ef : 0.f; TregF[tt][r] = (i == j ? 1.0f : 0.0f) - mf[r];
                  mb_[r] = (i < j) ? eb : 0.f; TregB[tt][r] = (i == j ? 1.0f : 0.0f) - mb_[r]; }
              u32x2 w; const int o_ = j * 72 + ti * 16 + fq * 4;
              w[0] = pk2(mf[0], mf[1]); w[1] = pk2(mf[2], mf[3]); *(u32x2*)(X0TF + o_) = w;
              w[0] = pk2(TregF[tt][0], TregF[tt][1]); w[1] = pk2(TregF[tt][2], TregF[tt][3]); *(u32x2*)(TTF + o_) = w;
              w[0] = pk2(mb_[0], mb_[1]); w[1] = pk2(mb_[2], mb_[3]); *(u32x2*)(X0TB + o_) = w;
              w[0] = pk2(TregB[tt][0], TregB[tt][1]); w[1] = pk2(TregB[tt][2], TregB[tt][3]); *(u32x2*)(TTB + o_) = w; }
            SCHED_FENCE();
            {
              const int i = ti * 16 + fr, j0 = tj * 16 + fq * 4; const float gfi = gcf[i], gbi = gcb[i], bfi = btf[i], bbi = btb[i]; float mf[4], af[4], mb_[4], ab[4];
#pragma unroll
              for (int r = 0; r < 4; ++r) { const int j = j0 + r;
                  const float ef = __expf(fminf(gfi - gcf[j], 0.f)), eb = __expf(fminf(gbi - gcb[j], 0.f));
                  const float df = (i >= j) ? ef : 0.f, db = (i <= j) ? eb : 0.f;
                  mf[r] = (i > j) ? bfi * kkT[r] * ef : 0.f; TTregF[tt][r] = (i == j ? 1.0f : 0.0f) - mf[r]; af[r] = qkT[r] * QSCALE * df;
                  mb_[r] = (i < j) ? bbi * kkT[r] * eb : 0.f; TTregB[tt][r] = (i == j ? 1.0f : 0.0f) - mb_[r]; ab[r] = qkT[r] * QSCALE * db; }
              u32x2 w; const int o_ = i * 72 + j0;
              w[0] = pk2(mf[0], mf[1]); w[1] = pk2(mf[2], mf[3]); *(u32x2*)(X0F + o_) = w;
              w[0] = pk2(mb_[0], mb_[1]); w[1] = pk2(mb_[2], mb_[3]); *(u32x2*)(X0B + o_) = w;
              w[0] = pk2(af[0], af[1]); w[1] = pk2(af[2], af[3]); *(u32x2*)((bf16_t*)(sm + L_AF) + i * 64 + j0) = w;
              w[0] = pk2(ab[3], ab[2]); w[1] = pk2(ab[1], ab[0]); *(u32x2*)((bf16_t*)(sm + L_AB) + (63 - i) * 64 + 60 - j0) = w; }
            SCHED_FENCE();
        }
        if (TID < 64) { float* sf = (float*)(sm + L_SCAL), *sb = (float*)(sm + L_SCAL + 288);
            sf[4 + TID] = QSCALE * __expf(gcf[TID]); sb[4 + TID] = QSCALE * __expf(gcb[63 - TID]); }
        {
            const int dcol = wid * 16 + fr, ks = wid >> 1;
            bf16x8 idf;
#pragma unroll
            for (int j = 0; j < 8; ++j) idf[j] = (dcol == ks * 32 + fq * 8 + j) ? (short)0x3F80 : (short)0;
#pragma unroll
            for (int t4 = 0; t4 < 4; ++t4) {
                const f32x4 kt = mfma16(frag16(Ks + (t4 * 16 + fr) * 136 + ks * 32 + fq * 8), idf, z4);
                const f32x4 vt = mfma16(frag16(Vs + (t4 * 16 + fr) * 136 + ks * 32 + fq * 8), idf, z4);
                const int tok = t4 * 16 + fq * 4;
                u32x2 w; w[0] = pk2(kt[0], kt[1]); w[1] = pk2(kt[2], kt[3]); *(u32x2*)(KTR + dcol * 72 + tok) = w;
                w[0] = pk2(vt[0], vt[1]); w[1] = pk2(vt[2], vt[3]); *(u32x2*)(VT + dcol * 72 + tok) = w;
                SCHED_FENCE();
            }
        }
        SYNC();
#pragma unroll 1
        for (int s5 = 0; s5 < 5; ++s5) {
            const bf16_t* PcF = (bf16_t*)(sm + ((s5 & 1) ? L_X1F : L_X0F)); const bf16_t* PcTF = (bf16_t*)(sm + ((s5 & 1) ? L_X1TF : L_X0TF));
            bf16_t* PnF = (bf16_t*)(sm + ((s5 & 1) ? L_X0F : L_X1F)); bf16_t* PnTF = (bf16_t*)(sm + ((s5 & 1) ? L_X0TF : L_X1TF));
            const bf16_t* PcB = (bf16_t*)(sm + ((s5 & 1) ? L_X1B : L_X0B)); const bf16_t* PcTB = (bf16_t*)(sm + ((s5 & 1) ? L_X1TB : L_X0TB));
            bf16_t* PnB = (bf16_t*)(sm + ((s5 & 1) ? L_X0B : L_X1B)); bf16_t* PnTB = (bf16_t*)(sm + ((s5 & 1) ? L_X0TB : L_X1TB));
#pragma unroll
            for (int tt = 0; tt < 2; ++tt) {
                const int t = wid * 2 + tt, ti = t >> 2, tj = t & 3;
                f32x4 p2 = z4, p2T = z4, q2 = z4, q2T = z4;
#pragma unroll
                for (int ks = 0; ks < 2; ++ks) { const int oa = (ti * 16 + fr) * 72 + ks * 32 + fq * 8, ob = (tj * 16 + fr) * 72 + ks * 32 + fq * 8;
                    const bf16x8 a = frag16(PcF + oa), b = frag16(PcTF + ob), c = frag16(PcB + oa), d = frag16(PcTB + ob);
                    p2 = mfma16(a, b, p2); p2T = mfma16(b, a, p2T); q2 = mfma16(c, d, q2); q2T = mfma16(d, c, q2T); }
                u32x2 w; const int oT = (tj * 16 + fr) * 72 + ti * 16 + fq * 4, oN = (ti * 16 + fr) * 72 + tj * 16 + fq * 4;
                w[0] = pk2(p2[0], p2[1]); w[1] = pk2(p2[2], p2[3]); *(u32x2*)(PnTF + oT) = w;
                w[0] = pk2(p2T[0], p2T[1]); w[1] = pk2(p2T[2], p2T[3]); *(u32x2*)(PnF + oN) = w;
                w[0] = pk2(q2[0], q2[1]); w[1] = pk2(q2[2], q2[3]); *(u32x2*)(PnTB + oT) = w;
                w[0] = pk2(q2T[0], q2T[1]); w[1] = pk2(q2T[2], q2T[3]); *(u32x2*)(PnB + oN) = w;
            }
            SYNC();
#pragma unroll
            for (int tt = 0; tt < 2; ++tt) {
                const int t = wid * 2 + tt, ti = t >> 2, tj = t & 3;
#pragma unroll
                for (int ks = 0; ks < 2; ++ks) { const int oa = (ti * 16 + fr) * 72 + ks * 32 + fq * 8, ob = (tj * 16 + fr) * 72 + ks * 32 + fq * 8;
                    const bf16x8 a = frag16(PnF + oa), b = frag16(TTF + ob), c = frag16(PnB + oa), d = frag16(TTB + ob);
                    TregF[tt] = mfma16(a, b, TregF[tt]); TTregF[tt] = mfma16(b, a, TTregF[tt]); TregB[tt] = mfma16(c, d, TregB[tt]); TTregB[tt] = mfma16(d, c, TTregB[tt]); }
            }
            SYNC();
            if (s5 < 4) {
#pragma unroll
                for (int tt = 0; tt < 2; ++tt) { const int t = wid * 2 + tt, ti = t >> 2, tj = t & 3, oT = (tj * 16 + fr) * 72 + ti * 16 + fq * 4;
                    u32x2 w; w[0] = pk2(TregF[tt][0], TregF[tt][1]); w[1] = pk2(TregF[tt][2], TregF[tt][3]); *(u32x2*)(TTF + oT) = w;
                    w[0] = pk2(TregB[tt][0], TregB[tt][1]); w[1] = pk2(TregB[tt][2], TregB[tt][3]); *(u32x2*)(TTB + oT) = w; }
            }
        }
#pragma unroll
        for (int tt = 0; tt < 2; ++tt) {
            const int t = wid * 2 + tt, ti = t >> 2, tj = t & 3, i = ti * 16 + fr, j0 = tj * 16 + fq * 4;
            const f32x4 bq = *(const f32x4*)(btf + j0), gq = *(const f32x4*)(gcf + j0), cq = *(const f32x4*)(btb + j0), hq = *(const f32x4*)(gcb + j0);
            float tu[4], tw[4], su[4], sw[4];
#pragma unroll
            for (int r = 0; r < 4; ++r) { tu[r] = TTregF[tt][r] * bq[r]; tw[r] = tu[r] * __expf(gq[r]); su[r] = TTregB[tt][r] * cq[r]; sw[r] = su[r] * __expf(hq[r]); }
            u32x2 w; const int o_ = i * 72 + j0;
            w[0] = pk2(tu[0], tu[1]); w[1] = pk2(tu[2], tu[3]); *(u32x2*)(X0F + o_) = w;
            w[0] = pk2(tw[0], tw[1]); w[1] = pk2(tw[2], tw[3]); *(u32x2*)(X0TF + o_) = w;
            w[0] = pk2(su[0], su[1]); w[1] = pk2(su[2], su[3]); *(u32x2*)(X0B + o_) = w;
            w[0] = pk2(sw[0], sw[1]); w[1] = pk2(sw[2], sw[3]); *(u32x2*)(X0TB + o_) = w;
        }
        if (TID == 0) { float* scp = (float*)(sm + L_SCAL); scp[0] = __expf(glf); scp[1] = 0.f; scp[2] = 0.f; scp[3] = 0.f; scp[72] = __expf(glb); scp[73] = 0.f; scp[74] = 0.f; scp[75] = 0.f; }
        SYNC();
        bf16_t* WF = (bf16_t*)(sm + L_WF); bf16_t* WB = (bf16_t*)(sm + L_WB);
#pragma unroll
        for (int i4 = 0; i4 < 4; ++i4) {
            f32x4 uf = z4, wf = z4, ub = z4, wb = z4;
#pragma unroll
            for (int ks = 0; ks < 2; ++ks) {
                const bf16x8 av = frag16(VT + (wid * 16 + fr) * 72 + ks * 32 + fq * 8), ak = frag16(KTR + (wid * 16 + fr) * 72 + ks * 32 + fq * 8);
                const int ot = (i4 * 16 + fr) * 72 + ks * 32 + fq * 8;
                uf = mfma16(frag16(X0F + ot), av, uf); wf = mfma16(ak, frag16(X0TF + ot), wf); ub = mfma16(frag16(X0B + ot), av, ub); wb = mfma16(ak, frag16(X0TB + ot), wb);
            }
            u32x2 w; w[0] = pk2(uf[0], uf[1]); w[1] = pk2(uf[2], uf[3]); *(u32x2*)(imgf + IMG_U + ((wid * 4 + i4) * 64 + lane) * 8) = w;
            w[0] = pk2(ub[3], ub[2]); w[1] = pk2(ub[1], ub[0]); *(u32x2*)(imgb + IMG_U + ((wid * 4 + (3 - i4)) * 64 + (3 - fq) * 16 + fr) * 8) = w;
            const int i = i4 * 16 + fr, c = wid * 16 + fq * 4;
            w[0] = pk2(wf[0], wf[1]); w[1] = pk2(wf[2], wf[3]); *(u32x2*)(WF + i * 136 + c) = w;
            w[0] = pk2(wb[0], wb[1]); w[1] = pk2(wb[2], wb[3]); *(u32x2*)(WB + (63 - i) * 136 + c) = w;
        }
        SYNC();
#pragma unroll
        for (int q = 0; q < 5; ++q) { int pc = TID + q * 512; pc = pc < 2082 ? pc : 2081;
            const int sp = pc - 2048, dirb = pc >= 2048 ? (sp >= 17) : (pc >> 10), p = pc & 1023, mt = p >> 8, ks = (p >> 6) & 3, ln = p & 63;
            const int so = pc >= 2048 ? L_SCAL + dirb * 288 + (sp - dirb * 17) * 16 : (dirb ? L_WB : L_WF) + ((mt * 16 + (ln & 15)) * 136 + ks * 32 + (ln >> 4) * 8) * 2;
            const int dofs = pc >= 2048 ? IMG_SC + (sp - dirb * 17) * 16 : IMG_W + p * 16;
            *(u32x4*)((dirb ? imgb : imgf) + dofs) = *(const u32x4*)(sm + so); }
#pragma unroll
        for (int q = 0; q < 2; ++q) { const int p = TID + q * 512, d = (p >> 7) * 16 + (p & 15), p0 = ((p >> 6) & 1) * 32 + ((p >> 4) & 3) * 8;
            { const u32x4 v = *(const u32x4*)(KTR + d * 72 + p0); const f32x4 g0 = *(const f32x4*)(gcf + p0), g1 = *(const f32x4*)(gcf + p0 + 4); u32x4 o;
              o[0] = pk2(__builtin_bit_cast(float, v[0] << 16) * __expf(glf - g0[0]), __builtin_bit_cast(float, v[0] & 0xffff0000u) * __expf(glf - g0[1]));
              o[1] = pk2(__builtin_bit_cast(float, v[1] << 16) * __expf(glf - g0[2]), __builtin_bit_cast(float, v[1] & 0xffff0000u) * __expf(glf - g0[3]));
              o[2] = pk2(__builtin_bit_cast(float, v[2] << 16) * __expf(glf - g1[0]), __builtin_bit_cast(float, v[2] & 0xffff0000u) * __expf(glf - g1[1]));
              o[3] = pk2(__builtin_bit_cast(float, v[3] << 16) * __expf(glf - g1[2]), __builtin_bit_cast(float, v[3] & 0xffff0000u) * __expf(glf - g1[3]));
              *(u32x4*)(imgf + IMG_KT + p * 16) = o; }
            { const int t0 = 56 - p0;
              const u32x4 v = *(const u32x4*)(KTR + d * 72 + t0); const f32x4 g0 = *(const f32x4*)(gcb + t0), g1 = *(const f32x4*)(gcb + t0 + 4); u32x4 o;
              o[0] = pk2(__builtin_bit_cast(float, v[3] & 0xffff0000u) * __expf(glb - g1[3]), __builtin_bit_cast(float, v[3] << 16) * __expf(glb - g1[2]));
              o[1] = pk2(__builtin_bit_cast(float, v[2] & 0xffff0000u) * __expf(glb - g1[1]), __builtin_bit_cast(float, v[2] << 16) * __expf(glb - g1[0]));
              o[2] = pk2(__builtin_bit_cast(float, v[1] & 0xffff0000u) * __expf(glb - g0[3]), __builtin_bit_cast(float, v[1] << 16) * __expf(glb - g0[2]));
              o[3] = pk2(__builtin_bit_cast(float, v[0] & 0xffff0000u) * __expf(glb - g0[1]), __builtin_bit_cast(float, v[0] << 16) * __expf(glb - g0[0]));
              *(u32x4*)(imgb + IMG_KT + p * 16) = o; } }
        { const int p = TID, row = (p >> 7) * 16 + (p & 15), c0 = ((p >> 6) & 1) * 32 + ((p >> 4) & 3) * 8;
          *(u32x4*)(imgf + IMG_A + p * 16) = *(const u32x4*)((const bf16_t*)(sm + L_AF) + row * 64 + c0);
          *(u32x4*)(imgb + IMG_A + p * 16) = *(const u32x4*)((const bf16_t*)(sm + L_AB) + row * 64 + c0); }
        SYNC();
    }
#undef PP_LOAD
#undef PP_ROW0
}

DEV void phase4_fft(const Params& P, unsigned char* sm) {
    PHASE_TID;
    const bf16_t* GT = (const bf16_t*)((const unsigned char*)P.out + DO_GT);
    bf16_t* ZT = (bf16_t*)((unsigned char*)P.out + DO_ZT);
    const bf16_t* tab = (const bf16_t*)(P.ws + WS_TAB);
    bf16_t* YR = (bf16_t*)sm; bf16_t* YI = YR + 64 * 136;
    const int wid = TID >> 6, lane = TID & 63, fr = lane & 15, fq = lane >> 4;
    bf16x8 c64[4][2], s64[4][2], c128[4], s128[4];
#pragma unroll
    for (int nt = 0; nt < 4; ++nt)
#pragma unroll
        for (int ks = 0; ks < 2; ++ks) { c64[nt][ks] = frag16(tab + (nt * 16 + fr) * 64 + ks * 32 + fq * 8); s64[nt][ks] = frag16(tab + 4096 + (nt * 16 + fr) * 64 + ks * 32 + fq * 8); }
#pragma unroll
    for (int ks = 0; ks < 4; ++ks) { c128[ks] = frag16(tab + 8192 + (wid * 16 + fr) * 128 + ks * 32 + fq * 8); s128[ks] = frag16(tab + 8192 + 16384 + (wid * 16 + fr) * 128 + ks * 32 + fq * 8); }
    bf16x8 far[2][2], fai[2][2];
#define FFT_LOAD(set, it_) do { const int itc_ = (it_) < 512 * NB ? (it_) : BID; const int cp_ = itc_ >> 3, b_ = itc_ & 7; \
        const bf16_t* gr_ = GT + (size_t)cp_ * NTOK + b_ * SEQ; const bf16_t* gi_ = GT + (size_t)(512 + cp_) * NTOK + b_ * SEQ; \
        _Pragma("unroll") for (int ks = 0; ks < 2; ++ks) { far[set][ks] = frag16(gr_ + (wid * 16 + fr) * 64 + ks * 32 + fq * 8); fai[set][ks] = frag16(gi_ + (wid * 16 + fr) * 64 + ks * 32 + fq * 8); } } while (0)
    FFT_LOAD(0, BID);
    for (int it2 = BID; it2 < 512 * NB; it2 += 2 * NBLK) {
#pragma unroll
      for (int pp = 0; pp < 2; ++pp) { const int it = it2 + pp * NBLK; if (it < 512 * NB) {
        const int cp = it >> 3, b = it & 7;
        bf16x8 ar[2], ai[2], an[2];
#pragma unroll
        for (int ks = 0; ks < 2; ++ks) { ar[ks] = far[pp][ks]; ai[ks] = fai[pp][ks];
#pragma unroll
            for (int j = 0; j < 8; ++j) an[ks][j] = (short)(ar[ks][j] ^ (short)0x8000); }
        FFT_LOAD(pp ^ 1, it + NBLK);
#pragma unroll
        for (int nt = 0; nt < 4; ++nt) {
            f32x4 yr = (f32x4){0.f, 0.f, 0.f, 0.f}, yi = (f32x4){0.f, 0.f, 0.f, 0.f};
#pragma unroll
            for (int ks = 0; ks < 2; ++ks) { yr = mfma16(ar[ks], c64[nt][ks], yr); yr = mfma16(ai[ks], s64[nt][ks], yr); yi = mfma16(ai[ks], c64[nt][ks], yi); yi = mfma16(an[ks], s64[nt][ks], yi); }
            const int k1 = nt * 16 + fr; float orr[4], oii[4];
#pragma unroll
            for (int r = 0; r < 4; ++r) { const int n2 = wid * 16 + fq * 4 + r; float s, c; sincospi_f((float)(n2 * k1) * (2.0f / 8192.0f), &s, &c);
                orr[r] = yr[r] * c + yi[r] * s; oii[r] = yi[r] * c - yr[r] * s; }
            u32x2 w; w[0] = pk2(orr[0], orr[1]); w[1] = pk2(orr[2], orr[3]); *(u32x2*)(YR + k1 * 136 + wid * 16 + fq * 4) = w;
            w[0] = pk2(oii[0], oii[1]); w[1] = pk2(oii[2], oii[3]); *(u32x2*)(YI + k1 * 136 + wid * 16 + fq * 4) = w;
        }
        SYNC();
        bf16_t* zrow = ZT + (size_t)cp * NTOK + b * SEQ;
#pragma unroll
        for (int mt = 0; mt < 4; ++mt) {
            f32x4 z = (f32x4){0.f, 0.f, 0.f, 0.f};
#pragma unroll
            for (int ks = 0; ks < 4; ++ks) { z = mfma16(frag16(YR + (mt * 16 + fr) * 136 + ks * 32 + fq * 8), c128[ks], z); z = mfma16(frag16(YI + (mt * 16 + fr) * 136 + ks * 32 + fq * 8), s128[ks], z); }
            u32x2 w; w[0] = pk2(z[0], z[1]); w[1] = pk2(z[2], z[3]);
            *(u32x2*)(zrow + 64 * (wid * 16 + fr) + mt * 16 + fq * 4) = w;
        }
        SYNC();
      } }
    }
#undef FFT_LOAD
}

constexpr int SC_W = 0, SC_U = 17408, SC_KT = 22528, SC_Q = SC_KT + 18432, SC_A = SC_Q + 17408, SC_ST = SC_A + 9216, SC_VN = SC_ST + 2 * 8704, SC_END = SC_VN + 4608;

DEV void phase5_scan(const Params& P, unsigned char* sm) {
    PHASE_TID;
    const unsigned char* images = P.ws + WS_R4;
    bf16_t* obuf = (bf16_t*)(P.ws + WS_R4 + R4_OBUF);
    const int wid = TID >> 6, lane = TID & 63, fr = lane & 15, fq = lane >> 4;
    bf16_t* ST = (bf16_t*)sm; bf16_t* VN = (bf16_t*)(sm + 2 * 8704);
    for (int item = BID; item < NCHAIN * 4; item += NBLK) {
        const int xj = item >> 3, chain = (item & 7) * 8 + (xj >> 2), c0 = (xj & 3) * 32, b = chain >> 3, hh = (chain >> 1) & 3, dir = chain & 1;
        const unsigned char* blk0 = images + (size_t)chain * NSTEP * IMG_BYTES;
        const int oK = IMG_KT + (wid * 2 * 64 + lane) * 16;
        f32x4 Sacc[2];
        Sacc[0] = (f32x4){0.f, 0.f, 0.f, 0.f}; Sacc[1] = (f32x4){0.f, 0.f, 0.f, 0.f};
        for (int q = TID; q < 2 * 8704 / 4; q += 512) ((unsigned*)ST)[q] = 0u;
#define SC_SUPD(rkset) do { _Pragma("unroll") for (int tt = 0; tt < 2; ++tt) { f32x4 a = Sacc[tt] * dl; \
            _Pragma("unroll") for (int ks = 0; ks < 2; ++ks) a = mfma16(__builtin_bit_cast(bf16x8, rkset[ks]), frag16(VN + (tt * 16 + fr) * 72 + ks * 32 + fq * 8), a); \
            Sacc[tt] = a; u32x2 w_; w_[0] = pk2(a[0], a[1]); w_[1] = pk2(a[2], a[3]); *(u32x2*)(STn + (tt * 16 + fr) * 136 + wid * 16 + fq * 4) = w_; } } while (0)
        if (wid < 4) {
            const int mt = wid;
            const int oW = IMG_W + (mt * 4 * 64 + lane) * 16, oA = IMG_A + (mt * 2 * 64 + lane) * 16, oS = IMG_SC + 16 + (mt * 16 + fr) * 4;
            const bf16_t* qbase = (const bf16_t*)(P.ws + WS_R3) + hh * 128 + fq * 8;
            const int oU = IMG_U + (((c0 >> 4) * 4 + mt) * 64 + lane) * 8;
            u32x4 rw[3][4], rk[3][2], rq[3][4], ra[3][2]; u32x2 ru[3][2]; float rs[3]; float dlr[3];
#define SC_LOAD1(set, blk) do { \
            _Pragma("unroll") for (int ks = 0; ks < 4; ++ks) rw[set][ks] = *(const u32x4*)((blk) + oW + ks * 1024); \
            ru[set][0] = *(const u32x2*)((blk) + oU); ru[set][1] = *(const u32x2*)((blk) + oU + 2048); dlr[set] = *(const float*)((blk) + IMG_SC); } while (0)
#define SC_LOAD2(set, blk, stp) do { const bf16_t* qrow_ = qbase + (size_t)chunk_row(chain, (stp), mt * 16 + fr) * 1536; \
            _Pragma("unroll") for (int ks = 0; ks < 2; ++ks) rk[set][ks] = *(const u32x4*)((blk) + oK + ks * 1024); \
            _Pragma("unroll") for (int ks = 0; ks < 4; ++ks) rq[set][ks] = *(const u32x4*)(qrow_ + ks * 32); \
            rs[set] = *(const float*)((blk) + oS); \
            _Pragma("unroll") for (int ks = 0; ks < 2; ++ks) ra[set][ks] = *(const u32x4*)((blk) + oA + ks * 1024); } while (0)
#define SC_LOAD(set, blk, stp) do { SC_LOAD1(set, blk); SC_LOAD2(set, blk, stp); } while (0)
            SC_LOAD(0, blk0, 0); SC_LOAD(1, blk0 + IMG_BYTES, 1); SC_LOAD(2, blk0 + 2 * IMG_BYTES, 2);
            SYNC();
#pragma unroll 1
            for (int s3 = 0; s3 < NSTEP; s3 += 3) {
#pragma unroll
                for (int u = 0; u < 3; ++u) {
                    const int step = s3 + u, cur = step & 1;
                    const bf16_t* STc = ST + cur * 4352; bf16_t* STn = ST + (cur ^ 1) * 4352;
#pragma unroll
                    for (int nt = 0; nt < 2; ++nt) {
                        f32x4 vn = (f32x4){0.f, 0.f, 0.f, 0.f};
#pragma unroll
                        for (int ks = 0; ks < 4; ++ks) vn = mfma16(__builtin_bit_cast(bf16x8, rw[u][ks]), frag16(STc + (nt * 16 + fr) * 136 + ks * 32 + fq * 8), vn);
                        const unsigned u0 = ru[u][nt][0], u1 = ru[u][nt][1];
                        u32x2 w; w[0] = pk2(bf2f((bf16_t)(u0 & 0xffffu)) - vn[0], bf2f((bf16_t)(u0 >> 16)) - vn[1]); w[1] = pk2(bf2f((bf16_t)(u1 & 0xffffu)) - vn[2], bf2f((bf16_t)(u1 >> 16)) - vn[3]);
                        *(u32x2*)(VN + (nt * 16 + fr) * 72 + mt * 16 + fq * 4) = w;
                    }
                    const float dl = dlr[u];
                    const int stp3 = step + 3 < NSTEP ? step + 3 : NSTEP - 1;
                    const unsigned char* blk3 = blk0 + (size_t)stp3 * IMG_BYTES;
                    SC_LOAD1(u, blk3);
                    SYNC();
                    SC_SUPD(rk[u]);
                    if (step >= 4) {
                        const int pos = (step - 4) * 64 + mt * 16 + fr; const int tok = b * SEQ + (dir ? (SEQ - 1 - pos) : pos);
                        bf16_t* orow = obuf + ((size_t)dir * NTOK + tok) * 512 + hh * 128 + c0 + fq * 4;
#pragma unroll
                        for (int nt = 0; nt < 2; ++nt) {
                            f32x4 o1 = (f32x4){0.f, 0.f, 0.f, 0.f}, o = (f32x4){0.f, 0.f, 0.f, 0.f};
#pragma unroll
                            for (int ks = 0; ks < 4; ++ks) o1 = mfma16(frag16(STc + (nt * 16 + fr) * 136 + ks * 32 + fq * 8), __builtin_bit_cast(bf16x8, rq[u][ks]), o1);
#pragma unroll
                            for (int ks = 0; ks < 2; ++ks) o = mfma16(frag16(VN + (nt * 16 + fr) * 72 + ks * 32 + fq * 8), __builtin_bit_cast(bf16x8, ra[u][ks]), o);
                            o += o1 * rs[u];
                            u32x2 w_; w_[0] = pk2(o[0], o[1]); w_[1] = pk2(o[2], o[3]); *(u32x2*)(orow + nt * 16) = w_;
                        }
                    }
                    SC_LOAD2(u, blk3, stp3);
                    SYNC();
                }
            }
#undef SC_LOAD
#undef SC_LOAD1
#undef SC_LOAD2
        } else {
            u32x4 rk[3][2]; float dlr[3];
#define SC_LOADK(set, blk) do { dlr[set] = *(const float*)((blk) + IMG_SC); _Pragma("unroll") for (int ks = 0; ks < 2; ++ks) rk[set][ks] = *(const u32x4*)((blk) + oK + ks * 1024); } while (0)
            SC_LOADK(0, blk0); SC_LOADK(1, blk0 + IMG_BYTES); SC_LOADK(2, blk0 + 2 * IMG_BYTES);
            SYNC();
#pragma unroll 1
            for (int s3 = 0; s3 < NSTEP; s3 += 3) {
#pragma unroll
                for (int u = 0; u < 3; ++u) {
                    const int step = s3 + u, cur = step & 1;
                    bf16_t* STn = ST + (cur ^ 1) * 4352;
                    const float dl = dlr[u];
                    SYNC();
                    SC_SUPD(rk[u]);
                    { const unsigned char* blk3 = blk0 + (size_t)(step + 3 < NSTEP ? step + 3 : NSTEP - 1) * IMG_BYTES; SC_LOADK(u, blk3); }
                    SYNC();
                }
            }
#undef SC_LOADK
        }
#undef SC_SUPD
        SYNC();
    }
}

DEV void phase6_amix(const Params& P, unsigned char* sm) {
    PHASE_TID;
    const bf16_t* ZT = (const bf16_t*)((const unsigned char*)P.out + DO_ZT);
    const bf16_t* zs = (const bf16_t*)((const unsigned char*)P.out + DO_ZS);
    const bf16_t* obuf = (const bf16_t*)(P.ws + WS_R4 + R4_OBUF);
    bf16_t* amix = (bf16_t*)(P.ws + WS_R4 + R4_AMIX);
    unsigned* tile = (unsigned*)sm;
    for (int tt = BID; tt < NTOK / 64; tt += NBLK) {
        const int tok0 = tt * 64;
        { u32x4 r[8];
#pragma unroll
          for (int q = 0; q < 8; ++q) { const int idx = TID + q * 512, cp = idx >> 3, piece = idx & 7; r[q] = *(const u32x4*)(ZT + (size_t)cp * NTOK + tok0 + piece * 8); }
#pragma unroll
          for (int q = 0; q < 8; ++q) { const int idx = TID + q * 512, cp = idx >> 3, piece = idx & 7; unsigned* t = tile + cp * 33 + piece * 4; t[0] = r[q][0]; t[1] = r[q][1]; t[2] = r[q][2]; t[3] = r[q][3]; } }
        SYNC();
        u32x4 oa[8], ob[8], oz[8];
#pragma unroll
        for (int q = 0; q < 8; ++q) { const int idx = TID + q * 512, tok = idx >> 6, hh = (idx >> 4) & 3, l16 = idx & 15; const size_t off = (size_t)(tok0 + tok) * 512 + hh * 128 + l16 * 8;
            oa[q] = *(const u32x4*)(obuf + off); ob[q] = *(const u32x4*)(obuf + (size_t)NTOK * 512 + off); oz[q] = *(const u32x4*)(zs + off); }
#pragma unroll
        for (int q = 0; q < 8; ++q) { const int tok = TID & 63, c8 = ((TID >> 6) * 8 + q) * 8, sh = (tok & 1) * 16; u32x4 o;
#pragma unroll
            for (int j = 0; j < 4; ++j) o[j] = ((tile[(c8 + 2 * j) * 33 + (tok >> 1)] >> sh) & 0xffffu) | (((tile[(c8 + 2 * j + 1) * 33 + (tok >> 1)] >> sh) & 0xffffu) << 16);
            *(u32x4*)(amix + (size_t)(tok0 + tok) * 1024 + c8) = o; }
        const int l16 = TID & 15;
        float og[8];
#pragma unroll
        for (int j = 0; j < 8; ++j) og[j] = P.onorm_g[l16 * 8 + j];
#pragma unroll
        for (int q = 0; q < 8; ++q) {
            const int idx = TID + q * 512, tok = idx >> 6, hh = (idx >> 4) & 3;
            const u32x4 a = oa[q], bq = ob[q], zv = oz[q];
            float v[8]; float ss = 0.f;
#pragma unroll
            for (int j = 0; j < 4; ++j) { v[2 * j] = bf2f((bf16_t)(a[j] & 0xffffu)) + bf2f((bf16_t)(bq[j] & 0xffffu)); v[2 * j + 1] = bf2f((bf16_t)(a[j] >> 16)) + bf2f((bf16_t)(bq[j] >> 16)); }
#pragma unroll
            for (int j = 0; j < 8; ++j) ss += v[j] * v[j];
            ss += shfl_xor_f(ss, 1); ss += shfl_xor_f(ss, 2); ss += shfl_xor_f(ss, 4); ss += shfl_xor_f(ss, 8);
            const float rstd = rsq_f(ss * (1.0f / 128.0f) + EPS);
            u32x4 o;
#pragma unroll
            for (int j = 0; j < 4; ++j) o[j] = pk2(v[2 * j] * rstd * og[2 * j] * bf2f((bf16_t)(zv[j] & 0xffffu)), v[2 * j + 1] * rstd * og[2 * j + 1] * bf2f((bf16_t)(zv[j] >> 16)));
            *(u32x4*)(amix + (size_t)(tok0 + tok) * 1024 + 512 + hh * 128 + l16 * 8) = o;
        }
        SYNC();
    }
}

DEV void phase8_router(const Params& P, unsigned char* sm, int dry) {
    PHASE_TID;
    float* wr = (float*)sm;
    {
        f32x4 g[2], rt[2][8];
#pragma unroll
        for (int h = 0; h < 2; ++h) { const int k = TID + h * 512; g[h] = *(const f32x4*)(P.w_group + k * 4);
#pragma unroll
            for (int q = 0; q < 8; ++q) rt[h][q] = *(const f32x4*)(P.w_router + k * 32 + q * 4); }
#pragma unroll
        for (int h = 0; h < 2; ++h) { const int k = TID + h * 512;
#pragma unroll
            for (int e = 0; e < 4; ++e) wr[e * 1028 + k] = g[h][e];
#pragma unroll
            for (int q = 0; q < 8; ++q)
#pragma unroll
                for (int e = 0; e < 4; ++e) wr[(4 + q * 4 + e) * 1028 + k] = rt[h][q][e]; }
    }
    SYNC();
    const float* mod = (const float*)(P.ws + WS_MOD);
    const float* x1 = P.out;
    bf16_t* h2 = (bf16_t*)(P.ws + WS_R4 + R4_H2);
    unsigned* cnt = (unsigned*)(P.ws + WS_CNT + (dry ? 8192 : 0)); unsigned* tokk = (unsigned*)(P.ws + (dry ? WS_R3 : WS_TOKK)); float* wl = (float*)(P.ws + (dry ? WS_R3 + 16 * MiB : WS_WL));
    const int wid = TID >> 6, lane = TID & 63;
    const int rstep = NBLK * 8;
    int r = BID * 8 + wid;
    unsigned* lc = (unsigned*)(sm + 148224);
    unsigned* aE = lc + 64; float* aW = (float*)(aE + 512); unsigned* aP = (unsigned*)(aW + 512);
    float* gsv = (float*)(sm + 154624); float* shv = gsv + 1024;
    float* brs = shv + 1024;
    if (TID < 32) { lc[TID] = 0u; brs[TID] = P.b_router[TID]; }
    const float bg0 = P.b_group[0], bg1 = P.b_group[1], bg2 = P.b_group[2], bg3 = P.b_group[3];
    SYNC();
    int jrow = 0;
    f32x4 vr[4][4];
#pragma unroll
    for (int jj = 0; jj < 4; ++jj) { const int rl = (r + jj * rstep < NTOK) ? r + jj * rstep : r;
#pragma unroll
        for (int i = 0; i < 4; ++i) vr[jj][i] = *(const f32x4*)(x1 + (size_t)rl * D + i * 256 + lane * 4); }
    const float n2a = P.norm2_g[TID], n2b = P.norm2_g[TID + 512];
    float msa, msb, mha, mhb;
    { const float* shift = mod + (r >> 13) * 6144 + 3 * 1024; msa = shift[1024 + TID]; msb = shift[1024 + TID + 512]; mha = shift[TID]; mhb = shift[TID + 512]; }
#pragma unroll 1
    for (; r < NTOK; ) {
        SYNC();
        gsv[TID] = n2a * (1.0f + msa); gsv[TID + 512] = n2b * (1.0f + msb); shv[TID] = mha; shv[TID + 512] = mhb;
        { const int rn = (r + 4 * rstep < NTOK) ? r + 4 * rstep : r; const float* shift = mod + (rn >> 13) * 6144 + 3 * 1024; msa = shift[1024 + TID]; msb = shift[1024 + TID + 512]; mha = shift[TID]; mhb = shift[TID + 512]; }
        SYNC();
#pragma unroll
      for (int jj = 0; jj < 4; ++jj) { if (r < NTOK) {
        f32x4 v[4]; float ss = 0.f;
#pragma unroll
        for (int i = 0; i < 4; ++i) { v[i] = vr[jj][i]; ss += v[i][0] * v[i][0] + v[i][1] * v[i][1] + v[i][2] * v[i][2] + v[i][3] * v[i][3]; }
        { const int rl = (r + 4 * rstep < NTOK) ? r + 4 * rstep : r;
#pragma unroll
          for (int i = 0; i < 4; ++i) vr[jj][i] = *(const f32x4*)(x1 + (size_t)rl * D + i * 256 + lane * 4); }
        ss = wave_sum(ss);
        const float rstd = rsq_f(ss * (1.0f / 1024.0f) + EPS);
        float gl[4] = {0.f, 0.f, 0.f, 0.f};
#pragma unroll
        for (int i = 0; i < 4; ++i) {
            const int k = i * 256 + lane * 4;
            const f32x4 g2 = *(const f32x4*)(gsv + k), sh = *(const f32x4*)(shv + k);
#pragma unroll
            for (int e = 0; e < 4; ++e) v[i][e] = v[i][e] * rstd * g2[e] + sh[e];
#pragma unroll
            for (int j = 0; j < 4; ++j) { const f32x4 wv = *(const f32x4*)(wr + j * 1028 + k); gl[j] += v[i][0] * wv[0] + v[i][1] * wv[1] + v[i][2] * wv[2] + v[i][3] * wv[3]; }
#if MK_F8
            *(unsigned*)((unsigned char*)h2 + (size_t)r * D + k) = pk4_fp8(v[i][0], v[i][1], v[i][2], v[i][3]);
#else
            u32x2 w; w[0] = pk2(v[i][0], v[i][1]); w[1] = pk2(v[i][2], v[i][3]);
            *(u32x2*)(h2 + (size_t)r * D + k) = w;
#endif
        }
#pragma unroll
        for (int j = 0; j < 4; ++j) gl[j] += 0.f;
        { const float t = wave_sum_multi<4>(gl, lane);
#pragma unroll
          for (int j = 0; j < 4; ++j) gl[j] = lane_bcast(t, j) + (j == 0 ? bg0 : j == 1 ? bg1 : j == 2 ? bg2 : bg3); }
        int gsel = 0; float gmax = gl[0];
#pragma unroll
        for (int j = 1; j < 4; ++j) if (gl[j] > gmax) { gmax = gl[j]; gsel = j; }
        float gden = 0.f;
#pragma unroll
        for (int j = 0; j < 4; ++j) gden += __expf(gl[j] - gmax);
        const float pg = 1.0f / gden;
        float el[8] = {0.f, 0.f, 0.f, 0.f, 0.f, 0.f, 0.f, 0.f};
#pragma unroll
        for (int i = 0; i < 4; ++i)
#pragma unroll
            for (int j = 0; j < 8; ++j) { const f32x4 wv = *(const f32x4*)(wr + (4 + gsel * 8 + j) * 1028 + i * 256 + lane * 4); el[j] += v[i][0] * wv[0] + v[i][1] * wv[1] + v[i][2] * wv[2] + v[i][3] * wv[3]; }
#pragma unroll
        for (int j = 0; j < 8; ++j) el[j] += 0.f;
        { const float t = wave_sum_multi<8>(el, lane);
#pragma unroll
          for (int j = 0; j < 8; ++j) el[j] = lane_bcast(t, j) + brs[gsel * 8 + j]; }
        int e1 = 0; float m1 = el[0];
#pragma unroll
        for (int j = 1; j < 8; ++j) if (el[j] > m1) { m1 = el[j]; e1 = j; }
        int e2 = -1; float m2 = -3.0e38f;
#pragma unroll
        for (int j = 0; j < 8; ++j) if (j != e1 && el[j] > m2) { m2 = el[j]; e2 = j; }
        if (e2 < 0) e2 = (e1 + 1) & 7;
        const float p2 = __expf(m2 - m1);
        const float w1 = pg / (1.0f + p2), w2 = pg * p2 / (1.0f + p2);
        if (lane < 2) {
            const int ee = gsel * 8 + (lane == 0 ? e1 : e2); const float ww = lane == 0 ? w1 : w2;
            const unsigned pos = atomic_add_u32(&lc[ee], 1u);
            const int a = (jrow * 8 + wid) * 2 + lane;
            if (a < 512) { aE[a] = (unsigned)ee; aW[a] = ww; aP[a] = pos; }
        }
        ++jrow; r += rstep;
      } }
    }
    SYNC();
    if (TID < 32) lc[32 + TID] = atomic_add_u32(&cnt[TID * 64], lc[TID]);
    SYNC();
    { const int a = TID, rl = a >> 1, rr = BID * 8 + (rl & 7) + (rl >> 3) * rstep;
      if (rr < NTOK && (rl >> 3) < jrow) { const unsigned ee = aE[a]; const unsigned pos = lc[32 + ee] + aP[a];
          tokk[(size_t)ee * LCAP + pos] = (unsigned)rr * 2u + (unsigned)(a & 1); wl[(size_t)ee * LCAP + pos] = aW[a]; } }
}

DEV void phase11_final(const Params& P, unsigned char* sm, float* dstbase) {
    PHASE_TID;
    (void)sm;
    const float* mod = (const float*)(P.ws + WS_MOD);
    const int wid = TID >> 6, lane = TID & 63;
#if MK_F8
    typedef float f32x2_ __attribute__((ext_vector_type(2)));
    const unsigned char* Y = P.ws + WS_R4 + R4_Y;
    for (int r0 = (BID * 8 + wid) * 2; r0 < NTOK; r0 += NBLK * 16) {
        f32x4 xv[2][4]; unsigned y0[2][4], y1[2][4];
#pragma unroll
        for (int u = 0; u < 2; ++u)
#pragma unroll
            for (int i = 0; i < 4; ++i) { const int k = i * 256 + lane * 4; const size_t r = (size_t)(r0 + u);
                xv[u][i] = *(const f32x4*)(P.out + r * D + k); y0[u][i] = *(const unsigned*)(Y + r * D + k); y1[u][i] = *(const unsigned*)(Y + ((size_t)NTOK + r) * D + k); }
        const float* gate = mod + (r0 >> 13) * 6144 + 5 * 1024;
#pragma unroll
        for (int u = 0; u < 2; ++u) {
            float* row = dstbase + (size_t)(r0 + u) * D;
            f32x4 v[4]; float ss = 0.f;
#pragma unroll
            for (int i = 0; i < 4; ++i) { const int k = i * 256 + lane * 4; const f32x4 gv = *(const f32x4*)(gate + k) * 0.0625f;
                const f32x2_ a0 = __builtin_amdgcn_cvt_pk_f32_fp8((int)y0[u][i], false), a1 = __builtin_amdgcn_cvt_pk_f32_fp8((int)y0[u][i], true);
                const f32x2_ b0 = __builtin_amdgcn_cvt_pk_f32_fp8((int)y1[u][i], false), b1 = __builtin_amdgcn_cvt_pk_f32_fp8((int)y1[u][i], true);
                f32x4 m; m[0] = a0[0] + b0[0]; m[1] = a0[1] + b0[1]; m[2] = a1[0] + b1[0]; m[3] = a1[1] + b1[1];
                v[i] = xv[u][i] + gv * m; ss += v[i][0] * v[i][0] + v[i][1] * v[i][1] + v[i][2] * v[i][2] + v[i][3] * v[i][3]; }
            ss = wave_sum(ss);
            const float rstd = rsq_f(ss * (1.0f / 1024.0f) + EPS);
#pragma unroll
            for (int i = 0; i < 4; ++i) { const int k = i * 256 + lane * 4; const f32x4 fg = *(const f32x4*)(P.final_g + k); *(f32x4*)(row + k) = v[i] * rstd * fg; }
        }
    }
#else
    const bf16_t* Y = (const bf16_t*)(P.ws + WS_R4 + R4_Y);
    for (int r0 = (BID * 8 + wid) * 2; r0 < NTOK; r0 += NBLK * 16) {
        f32x4 xv[2][4]; u32x2 y0[2][4], y1[2][4];
#pragma unroll
        for (int u = 0; u < 2; ++u)
#pragma unroll
            for (int i = 0; i < 4; ++i) { const int k = i * 256 + lane * 4; const size_t r = (size_t)(r0 + u);
                xv[u][i] = *(const f32x4*)(P.out + r * D + k); y0[u][i] = *(const u32x2*)(Y + r * D + k); y1[u][i] = *(const u32x2*)(Y + ((size_t)NTOK + r) * D + k); }
        const float* gate = mod + (r0 >> 13) * 6144 + 5 * 1024;
#pragma unroll
        for (int u = 0; u < 2; ++u) {
            float* row = dstbase + (size_t)(r0 + u) * D;
            f32x4 v[4]; float ss = 0.f;
#pragma unroll
            for (int i = 0; i < 4; ++i) { const int k = i * 256 + lane * 4; const f32x4 gv = *(const f32x4*)(gate + k);
                f32x4 m; m[0] = bf2f((bf16_t)(y0[u][i][0] & 0xffffu)) + bf2f((bf16_t)(y1[u][i][0] & 0xffffu)); m[1] = bf2f((bf16_t)(y0[u][i][0] >> 16)) + bf2f((bf16_t)(y1[u][i][0] >> 16));
                m[2] = bf2f((bf16_t)(y0[u][i][1] & 0xffffu)) + bf2f((bf16_t)(y1[u][i][1] & 0xffffu)); m[3] = bf2f((bf16_t)(y0[u][i][1] >> 16)) + bf2f((bf16_t)(y1[u][i][1] >> 16));
                v[i] = xv[u][i] + gv * m; ss += v[i][0] * v[i][0] + v[i][1] * v[i][1] + v[i][2] * v[i][2] + v[i][3] * v[i][3]; }
            ss = wave_sum(ss);
            const float rstd = rsq_f(ss * (1.0f / 1024.0f) + EPS);
#pragma unroll
            for (int i = 0; i < 4; ++i) { const int k = i * 256 + lane * 4; const f32x4 fg = *(const f32x4*)(P.final_g + k); *(f32x4*)(row + k) = v[i] * rstd * fg; }
        }
    }
#endif
}

#ifndef CPU_EMU
#define XB_TMO      128
#define XB_XCNT(j)  (256  + 64 * (j))
#define XB_XSUB(j)  (1280 + 64 * (j))
#define XB_XGEN(j)  (2304 + 64 * (j))
#define XB_TOP      3328
#define XB_TOPGEN   3392
#define XCD_BAR_WORDS 3456
#define XB_SPIN_CAP (1u << 22)
#define LAS __attribute__((address_space(3)))
__device__ __forceinline__ unsigned xb_ld(unsigned* p)              { return __hip_atomic_load(p, __ATOMIC_RELAXED, __HIP_MEMORY_SCOPE_AGENT); }
__device__ __forceinline__ unsigned xb_add(unsigned* p, unsigned v) { return __hip_atomic_fetch_add(p, v, __ATOMIC_RELAXED, __HIP_MEMORY_SCOPE_AGENT); }
__device__ __forceinline__ unsigned xb_xcc_id() { return (unsigned)__builtin_amdgcn_s_getreg((3 << 11) | 20) & 0xFu; }
#define XB_SPIN(cond, bar) do { unsigned _sp = 0; while (cond) { __builtin_amdgcn_s_sleep(1); \
    if ((++_sp & 255u) == 0u) { if (xb_ld(&(bar)[XB_TMO])) break; if (_sp > XB_SPIN_CAP) { atomicAdd(&(bar)[XB_TMO], 1u); break; } } } } while (0)
struct XcdBarrier { unsigned* bar; unsigned x; volatile LAS unsigned* st; int wave; };
__device__ __forceinline__ XcdBarrier xcd_barrier_post(unsigned* bar, volatile LAS unsigned* st, int wave) {
    XcdBarrier b; b.bar = bar; b.x = xb_xcc_id(); b.st = st; b.wave = wave;
    if (MK_TID(wave) == 0) (void)xb_add(&bar[XB_XCNT(b.x)], 1u);
    return b;
}
__device__ __forceinline__ void xcd_barrier_complete(unsigned* bar, unsigned x, unsigned& nloc, unsigned& nx) {
    const unsigned G = gridDim.x * gridDim.y * gridDim.z;
    unsigned sum, cnt, mine, sp = 0u;
    for (;;) {
        sum = 0u; cnt = 0u; mine = 0u;
#pragma unroll
        for (unsigned j = 0; j < 16; ++j) { const unsigned c = xb_ld(&bar[XB_XCNT(j)]); sum += c; cnt += (c > 0u) ? 1u : 0u; mine = (j == x) ? c : mine; }
        if (sum == G) break;
        __builtin_amdgcn_s_sleep(1);
        if ((++sp & 255u) == 0u) { if (xb_ld(&bar[XB_TMO])) break; if (sp > XB_SPIN_CAP) { atomicAdd(&bar[XB_TMO], 1u); break; } }
    }
    nloc = mine > 0u ? mine : 1u; nx = cnt > 0u ? cnt : 1u;
}
__device__ __forceinline__ void xcd_barrier(const XcdBarrier& b) {
    asm volatile("s_waitcnt vmcnt(0)" ::: "memory");
    __syncthreads();
    if (MK_TID(b.wave) == 0) {
        unsigned* bar = b.bar;
        __builtin_amdgcn_s_waitcnt(0);
        unsigned nloc = b.st[0], nx = b.st[1];
        if (nloc == 0u) { xcd_barrier_complete(bar, b.x, nloc, nx); b.st[0] = nloc; b.st[1] = nx; }
        const unsigned old = xb_add(&bar[XB_XSUB(b.x)], 1u);
        const unsigned gen = old / nloc;
        if (old + 1u == (gen + 1u) * nloc) {
            __builtin_amdgcn_fence(__ATOMIC_RELEASE, "agent");
            asm volatile("s_waitcnt vmcnt(0)" ::: "memory");
            const unsigned og = xb_add(&bar[XB_TOP], 1u);
            const unsigned tg = og / nx;
            if (og + 1u == (tg + 1u) * nx) xb_add(&bar[XB_TOPGEN], 1u);
            else XB_SPIN(xb_ld(&bar[XB_TOPGEN]) == tg, bar);
            __builtin_amdgcn_fence(__ATOMIC_ACQUIRE, "agent");
            xb_add(&bar[XB_XGEN(b.x)], 1u);
            asm volatile("s_waitcnt vmcnt(0)" ::: "memory");
        } else {
            XB_SPIN(xb_ld(&bar[XB_XGEN(b.x)]) == gen, bar);
            __builtin_amdgcn_fence(__ATOMIC_ACQUIRE, "agent");
            asm volatile("s_waitcnt vmcnt(0)" ::: "memory");
        }
    }
    __syncthreads();
}

#ifndef MK_PH
#define MK_PH 0x7ff
#endif
#ifndef MK_REP
#define MK_REP 0
#endif
#define REPS(k) for (int rep_ = 0; rep_ < (((MK_REP >> (k)) & 1) ? 2 : 1); ++rep_)
extern __shared__ __attribute__((aligned(16))) unsigned char smem_dyn[];

__device__ __forceinline__ void moe_tables(const Params& P, LAS int* tb, LAS int* cn) {
    const unsigned* cnt = (const unsigned*)(P.ws + WS_CNT);
    const int t_ = MK_TID(P.wave);
    if (t_ < 32) cn[t_] = (int)cnt[t_ * 64];
    __syncthreads();
    if (t_ == 0) { int acc = 0; for (int e = 0; e < 32; ++e) { tb[e] = acc; acc += (cn[e] + 255) >> 8; } tb[32] = acc; }
    __syncthreads();
}

__global__ void __launch_bounds__(512, 2) hymba_fwd(Params Pin) {
    Params P = Pin; P.wave = __builtin_amdgcn_readfirstlane((int)threadIdx.x >> 6);
    unsigned char* sm = smem_dyn;
    LAS unsigned char* lsm = (LAS unsigned char*)smem_dyn;
    volatile LAS unsigned* xbw = (volatile LAS unsigned*)(lsm + LDS_BYTES - 16);
    if (MK_TID(P.wave) == 0) { xbw[0] = 0u; xbw[1] = 0u; xbw[2] = 0u; xbw[3] = 0u; }
    __syncthreads();
    XcdBarrier bar = xcd_barrier_post((unsigned*)(P.ws + WS_BAR), xbw, P.wave);
    using namespace pg8;

#if (MK_PH >> 0) & 1
    REPS(15) phase0_mod(P, sm); REPS(0) { phase0_weights(P, sm); phase0_wf(P, sm); }
    xcd_barrier(bar);
#endif
#if (MK_PH >> 1) & 1
    REPS(1) phase1_prep(P, sm);
    xcd_barrier(bar);
#endif
#if (MK_PH >> 2) & 1
    REPS(2) {
    { ProbInproj G; G.init(MROWS / 256, 8, gridDim.x, blockIdx.x); G.wv = P.wave; G.A = (const bf16_t*)(P.ws + WS_R4 + R4_H); G.Bt = (const bf16_t*)(P.ws + WS_WQKVZ); G.K = 1024;
      EpiInproj E; E.O = (bf16_t*)(P.ws + WS_R4 + R4_P); E.zs = (bf16_t*)((unsigned char*)P.out + DO_ZS); E.rstd = (const float*)(P.ws + WS_RSTD); E.bias = (const float*)(P.ws + WS_BIAS); gemm_phase(lsm, G, E); }
    { ProbGT G; G.init(4, NTOK / 256, gridDim.x, blockIdx.x); G.wv = P.wave; G.A = (const bf16_t*)(P.ws + WS_WF); G.Bt = (const bf16_t*)(P.ws + WS_R4 + R4_H); G.K = 1024;
      EpiGT E; E.O = (bf16_t*)((unsigned char*)P.out + DO_GT); E.rstd = (const float*)(P.ws + WS_RSTD); E.bias = (const float*)(P.ws + WS_BIAS); gemm_phase(lsm, G, E); }
    }
    xcd_barrier(bar);
#endif
#if (MK_PH >> 3) & 1
    REPS(3) phase3_conv(P, sm);
    xcd_barrier(bar);
#endif
#if (MK_PH >> 4) & 1
    REPS(4) phase4_prepass(P, sm);
    REPS(11) phase4_fft(P, sm);
    xcd_barrier(bar);
#endif
#if (MK_PH >> 5) & 1
    REPS(5) phase5_scan(P, sm);
    xcd_barrier(bar);
#endif
#if (MK_PH >> 6) & 1
    REPS(6) phase6_amix(P, sm);
    xcd_barrier(bar);
#endif
#if (MK_PH >> 7) & 1
    REPS(7)
    { ProbOut G; G.init(NTOK / 256, 4, gridDim.x, blockIdx.x); G.wv = P.wave; G.A = (const bf16_t*)(P.ws + WS_R4 + R4_AMIX); G.Bt = (const bf16_t*)(P.ws + WS_WOUT); G.K = 1024;
      EpiResid E; E.x = P.x; E.mod = (const float*)(P.ws + WS_MOD); E.out = P.out; gemm_phase(lsm, G, E); }
    xcd_barrier(bar);
#endif
#if (MK_PH >> 8) & 1
#if (MK_REP >> 13) & 1
    phase8_router(P, sm, 1);
#endif
    phase8_router(P, sm, 0);
#if (MK_REP >> 14) & 1
    xcd_barrier(bar); xcd_barrier(bar); xcd_barrier(bar); xcd_barrier(bar);
#endif
    xcd_barrier(bar);
#endif
#if (MK_PH >> 9) & 1
#if MK_F8 == 2
    LAS int* tb = (LAS int*)(lsm + STAGE_BYTES); LAS int* cn = tb + 64;
    moe_tables(P, tb, cn);
    REPS(9)
    { ProbMoe1P8 G; G.tb = tb; G.wv = P.wave; G.cnt = cn; G.G = gridDim.x; G.c = blockIdx.x; G.A = P.ws + WS_R4 + R4_H2; G.Bt = P.ws + WS_WGU; G.K = 512; G.tokk = (const unsigned*)(P.ws + WS_TOKK);
      EpiMoe1P8 E; E.hid = P.ws + WS_R4 + R4_HID; gemm_phase(lsm, G, E); }
    xcd_barrier(bar);
    REPS(10)
    { ProbMoe2P8 G; G.tb = tb; G.wv = P.wave; G.cnt = cn; G.G = gridDim.x; G.c = blockIdx.x; G.A = P.ws + WS_R4 + R4_HID; G.Bt = P.ws + WS_WD; G.K = 256;
      EpiMoe2P8 E; E.Y = P.ws + WS_R4 + R4_Y; E.tokk = (const unsigned*)(P.ws + WS_TOKK); E.wl = (const float*)(P.ws + WS_WL); E.tb = tb; gemm_phase(lsm, G, E); }
    xcd_barrier(bar);
#elif MK_F8
    LAS int* tb = (LAS int*)(lsm + F8_LDS); LAS int* cn = tb + 64;
    moe_tables(P, tb, cn);
#if (MK_REP >> 16) & 3
    { ProbMoe1F8 G; G.tb = tb; G.wv = P.wave; G.cnt = cn; G.G = gridDim.x; G.c = blockIdx.x; G.A = P.ws + WS_R4 + R4_H2; G.Bt = P.ws + WS_WGU; G.KB = 1024; G.tokk = (const unsigned*)(P.ws + WS_TOKK);
      EpiMoe1F8 E; E.hid = P.ws + WS_R4 + R4_HID; gemm_f8<ProbMoe1F8, EpiMoe1F8, (MK_REP >> 16) & 3>(lsm, G, E); }
    xcd_barrier(bar);
#endif
    REPS(9)
    { ProbMoe1F8 G; G.tb = tb; G.wv = P.wave; G.cnt = cn; G.G = gridDim.x; G.c = blockIdx.x; G.A = P.ws + WS_R4 + R4_H2; G.Bt = P.ws + WS_WGU; G.KB = 1024; G.tokk = (const unsigned*)(P.ws + WS_TOKK);
      EpiMoe1F8 E; E.hid = P.ws + WS_R4 + R4_HID; gemm_f8(lsm, G, E); }
    xcd_barrier(bar);
    REPS(10)
    { ProbMoe2F8 G; G.tb = tb; G.wv = P.wave; G.cnt = cn; G.G = gridDim.x; G.c = blockIdx.x; G.A = P.ws + WS_R4 + R4_HID; G.Bt = P.ws + WS_WD; G.KB = 512;
      EpiMoe2F8 E; E.Y = P.ws + WS_R4 + R4_Y; E.tokk = (const unsigned*)(P.ws + WS_TOKK); E.wl = (const float*)(P.ws + WS_WL); E.tb = tb; gemm_f8(lsm, G, E); }
    xcd_barrier(bar);
#else
    LAS int* tb = (LAS int*)(lsm + STAGE_BYTES); LAS int* cn = tb + 64;
    moe_tables(P, tb, cn);
    REPS(9)
    { ProbMoe1 G; G.tb = tb; G.wv = P.wave; G.cnt = cn; G.G = gridDim.x; G.c = blockIdx.x; G.A = (const bf16_t*)(P.ws + WS_R4 + R4_H2); G.Bt = (const bf16_t*)(P.ws + WS_WGU); G.K = 1024; G.tokk = (const unsigned*)(P.ws + WS_TOKK);
      EpiMoe1 E; E.hid = (bf16_t*)(P.ws + WS_R4 + R4_HID); gemm_phase(lsm, G, E); }
    xcd_barrier(bar);
    REPS(10)
    { ProbMoe2 G; G.tb = tb; G.wv = P.wave; G.cnt = cn; G.G = gridDim.x; G.c = blockIdx.x; G.A = (const bf16_t*)(P.ws + WS_R4 + R4_HID); G.Bt = (const bf16_t*)(P.ws + WS_WD); G.K = 512;
      EpiMoe2 E; E.Y = (bf16_t*)(P.ws + WS_R4 + R4_Y); E.tokk = (const unsigned*)(P.ws + WS_TOKK); E.wl = (const float*)(P.ws + WS_WL); E.tb = tb; gemm_phase(lsm, G, E); }
    xcd_barrier(bar);
#endif
#endif
#if (MK_PH >> 10) & 1
#if (MK_REP >> 12) & 1
    phase11_final(P, sm, (float*)(P.ws + WS_R4 + 300 * MiB));
#endif
    phase11_final(P, sm, P.out);
#endif
}

extern "C" void kernel_launch(void* const* d_in, const int* in_sizes, int n_in, void* d_out, int out_size, void* d_ws, size_t ws_size, hipStream_t stream) {
    (void)in_sizes; (void)n_in; (void)out_size;
    static int grid = 0;
    if (!grid) {
        int dev = 0, cus = 0, per_cu = 0;
        hipGetDevice(&dev);
        hipDeviceGetAttribute(&cus, hipDeviceAttributeMultiprocessorCount, dev);
        hipFuncSetAttribute((const void*)hymba_fwd, hipFuncAttributeMaxDynamicSharedMemorySize, LDS_BYTES);
        hipOccupancyMaxActiveBlocksPerMultiprocessor(&per_cu, hymba_fwd, 512, LDS_BYTES);
        if (per_cu < 1) { fprintf(stderr, "occupancy query says 0 blocks per CU\n"); per_cu = 1; }
        grid = cus;
        if (ws_size < WS_NEED) fprintf(stderr, "workspace too small: %zu < %zu\n", ws_size, (size_t)WS_NEED);
    }
    Params p{};
    p.x = (const float*)d_in[0]; p.c = (const float*)d_in[1]; p.ctx = (const float*)d_in[2]; p.c_ctx = (const float*)d_in[3]; p.w_mod = (const float*)d_in[4]; p.b_mod = (const float*)d_in[5];
    p.norm1_g = (const float*)d_in[6]; p.w_in = (const float*)d_in[7]; p.conv_w = (const float*)d_in[8]; p.a_log = (const float*)d_in[9]; p.dt_bias = (const float*)d_in[10]; p.onorm_g = (const float*)d_in[11];
    p.w_out = (const float*)d_in[12]; p.norm2_g = (const float*)d_in[13]; p.w_group = (const float*)d_in[14]; p.b_group = (const float*)d_in[15]; p.w_router = (const float*)d_in[16]; p.b_router = (const float*)d_in[17];
    p.w_gate = (const float*)d_in[18]; p.w_up = (const float*)d_in[19]; p.w_down = (const float*)d_in[20]; p.final_g = (const float*)d_in[21];
    p.out = (float*)d_out; p.ws = (unsigned char*)d_ws;
    hipMemsetAsync(d_ws, 0, WS_ZERO_BYTES, stream);
    hipLaunchKernelGGL(hymba_fwd, dim3(grid), dim3(512), LDS_BYTES, stream, p);
}
#endif
```

```cpp
#ifndef CPU_EMU
#include <hip/hip_runtime.h>
#include <cstdio>
#include <cstdint>
#define DEV __device__ __forceinline__
#define TID tid_local
__device__ __forceinline__ int mk_lane_volatile() { int l; asm volatile("v_mbcnt_lo_u32_b32 %0, -1, 0\n\tv_mbcnt_hi_u32_b32 %0, -1, %0" : "=v"(l)); return l; }
#define MK_TID(wave) ((wave) * 64 + mk_lane_volatile())
#define PHASE_TID int tid_local = MK_TID(P.wave); asm volatile("" : "+v"(tid_local))
#define BID ((int)blockIdx.x)
#define NBLK ((int)gridDim.x)
#define SYNC() __syncthreads()
#define SCHED_FENCE() __builtin_amdgcn_sched_barrier(0)
#endif

typedef unsigned short bf16_t;
typedef short bf16x8 __attribute__((ext_vector_type(8)));
typedef float f32x4 __attribute__((ext_vector_type(4)));
typedef unsigned u32x4 __attribute__((ext_vector_type(4)));
typedef unsigned u32x2 __attribute__((ext_vector_type(2)));

constexpr int D = 1024, NB = 8, SEQ = 8192, CTX = 256;
constexpr int NTOK = NB * SEQ;
constexpr int NCTX = NB * CTX;
constexpr int MROWS = NTOK + NCTX;
constexpr int W_IN = 2576;
constexpr int NSTEP = 4 + 128;
constexpr int NCHAIN = NB * 4 * 2;
constexpr int NPROB = NCHAIN * NSTEP;
constexpr float EPS = 1e-6f;
constexpr int NEXP = 32;
constexpr int LCAP = 65536;

constexpr int IMG_W = 0, IMG_KT = 16384, IMG_A = 32768, IMG_U = 40960, IMG_SC = 57344, IMG_BYTES = 57664;

constexpr size_t MiB = 1048576;
constexpr size_t WS_BAR = 0;
constexpr size_t WS_MOD = 16384;
constexpr size_t WS_CNT = 16384 + 221184;
constexpr size_t WS_ZERO_BYTES = WS_CNT + 16384;
constexpr size_t WS_TAB = 262144;
constexpr size_t WS_BIAS = 393216;
constexpr size_t WS_RSTD = 5 * MiB + 524288;
constexpr size_t WS_GB = 1 * MiB;
constexpr size_t WS_TOKK = 6 * MiB;
constexpr size_t WS_WL = 14 * MiB;
constexpr size_t WS_W = 22 * MiB;
constexpr size_t WS_WQKVZ = WS_W;
constexpr size_t WS_WF = WS_WQKVZ + 2048ull * 1024 * 2;
constexpr size_t WS_WOUT = WS_WF + 1024ull * 1024 * 2;
constexpr size_t WS_WGU = WS_WOUT + 1024ull * 1024 * 2;
constexpr size_t WS_WD = WS_WGU + 32ull * 1024 * 1024 * 2;
constexpr size_t WS_R3 = 126 * MiB;
constexpr size_t WS_R4 = 324 * MiB;
constexpr size_t WS_NEED = WS_R4 + 645 * MiB;
constexpr size_t R4_H = 0, R4_P = 132 * MiB;
constexpr size_t R4_AMIX = 0, R4_H2 = 128 * MiB, R4_HID = 256 * MiB, R4_Y = 0;
constexpr size_t R4_PROJ = 384 * MiB;
constexpr size_t R4_OBUF = 480 * MiB;
constexpr size_t DO_GT = 0, DO_ZT = 128 * MiB, DO_ZS = 192 * MiB;

constexpr int LDS_BYTES = 163840;

struct Params {
    const float *x, *c, *ctx, *c_ctx, *w_mod, *b_mod, *norm1_g, *w_in, *conv_w, *a_log, *dt_bias, *onorm_g, *w_out, *norm2_g,
                *w_group, *b_group, *w_router, *b_router, *w_gate, *w_up, *w_down, *final_g;
    float* out;
    unsigned char* ws;
    int wave;
};

DEV bf16_t f2bf(float f) { unsigned u = __builtin_bit_cast(unsigned, f); u += 0x7FFFu + ((u >> 16) & 1u); return (bf16_t)(u >> 16); }
DEV float bf2f(bf16_t b) { return __builtin_bit_cast(float, ((unsigned)b) << 16); }
#ifndef MK_REP
#define MK_REP 0
#endif
#ifndef MK_TP
#define MK_TP 0
#endif
#ifndef MK_F8
#define MK_F8 2
#endif
#ifndef CPU_EMU
DEV unsigned pk4_fp8(float a, float b, float c, float d) { int t = 0; t = __builtin_amdgcn_cvt_pk_fp8_f32(a, b, t, false); t = __builtin_amdgcn_cvt_pk_fp8_f32(c, d, t, true); return (unsigned)t; }
typedef __bf16 bf16n2 __attribute__((ext_vector_type(2)));
DEV unsigned pk2(float lo, float hi) { bf16n2 v; v[0] = (__bf16)lo; v[1] = (__bf16)hi; return __builtin_bit_cast(unsigned, v); }
DEV float rcp_f(float x) { return __builtin_amdgcn_rcpf(x); }
DEV float rsq_f(float x) { return __builtin_amdgcn_rsqf(x); }
#else
DEV unsigned pk2(float lo, float hi) { return (unsigned)f2bf(lo) | ((unsigned)f2bf(hi) << 16); }
DEV float rcp_f(float x) { return 1.0f / x; }
DEV float rsq_f(float x) { return 1.0f / sqrtf(x); }
#endif
DEV float silu_f(float v) { return v * rcp_f(1.0f + __expf(-v)); }

#ifndef CPU_EMU
DEV f32x4 mfma16(bf16x8 a, bf16x8 b, f32x4 c) { return __builtin_amdgcn_mfma_f32_16x16x32_bf16(a, b, c, 0, 0, 0); }
DEV float shfl_xor_f(float v, int m) { return __shfl_xor(v, m); }
DEV float shfl_up_f(float v, int d) { return __shfl_up(v, d); }
DEV float shfl_idx_f(float v, int l) { return __shfl(v, l); }
DEV void atomic_add_f32(float* p, float v) { atomicAdd(p, v); }
DEV unsigned atomic_add_u32(unsigned* p, unsigned v) { return atomicAdd(p, v); }
DEV void sincospi_f(float x, float* s, float* c) { sincospif(x, s, c); }
#endif

DEV float wave_sum(float v) {
#pragma unroll
    for (int o = 32; o >= 1; o >>= 1) v += shfl_xor_f(v, o);
    return v;
}
template <int N> DEV float wave_sum_multi(const float (&v)[N], int lane) {
    float a[N];
#pragma unroll
    for (int i = 0; i < N; ++i) a[i] = v[i];
    int m = 1;
#pragma unroll
    for (int n = N; n > 1; n >>= 1, m <<= 1) {
        const bool up = (lane & m) != 0;
#pragma unroll
        for (int i = 0; i < n / 2; ++i) { const float keep = up ? a[2 * i + 1] : a[2 * i], send = up ? a[2 * i] : a[2 * i + 1]; a[i] = keep + shfl_xor_f(send, m); }
    }
    float r = a[0];
#pragma unroll
    for (int o = N; o < 64; o <<= 1) r += shfl_xor_f(r, o);
    return r;
}
#ifndef CPU_EMU
DEV float lane_bcast(float v, int l) { return __builtin_bit_cast(float, __builtin_amdgcn_readlane(__builtin_bit_cast(int, v), l)); }
#endif
DEV bf16x8 frag_gather(const bf16_t* p, int stride) {
    bf16x8 r;
#pragma unroll
    for (int j = 0; j < 8; ++j) r[j] = (short)p[j * stride];
    return r;
}
DEV bf16x8 frag16(const bf16_t* p) { return *(const bf16x8*)p; }

DEV void phase0_mod(const Params& P, unsigned char* sm) {
    PHASE_TID;
    float* sil = (float*)sm;
    float* red = (float*)(sm + 36864);
    for (int i = TID; i < 9 * 1024; i += 512) { const int r = i >> 10, k = i & 1023; const float v = r < 8 ? P.c[r * 1024 + k] : P.c_ctx[k]; sil[i] = silu_f(v); }
    SYNC();
    float* mod = (float*)(P.ws + WS_MOD);
    for (int cb = BID; cb < 256; cb += NBLK) {
        const int c = TID % 24, kg = TID / 24, j0 = cb * 24;
        if (kg < 21) {
            float acc[9];
#pragma unroll
            for (int r = 0; r < 9; ++r) acc[r] = 0.f;
#pragma unroll 7
            for (int k = kg; k < 1024; k += 21) { const float w = P.w_mod[(size_t)k * 6144 + j0 + c];
#pragma unroll
                for (int r = 0; r < 9; ++r) acc[r] += sil[r * 1024 + k] * w; }
#pragma unroll
            for (int r = 0; r < 9; ++r) red[(kg * 24 + c) * 9 + r] = acc[r];
        }
        SYNC();
        if (TID < 24 * 9) { const int cc = TID / 9, r = TID - cc * 9; float t = P.b_mod[j0 + cc];
            for (int g = 0; g < 21; ++g) t += red[(g * 24 + cc) * 9 + r];
            mod[r * 6144 + j0 + cc] = t; }
        SYNC();
    }
}

struct WJob { const float* src; unsigned char* dst; int lds_, ldd, inter, f8; };
DEV WJob wjob(const Params& P, int t) {
    unsigned char* wqkvz = P.ws + WS_WQKVZ; unsigned char* wout = P.ws + WS_WOUT; unsigned char* wgu = P.ws + WS_WGU; unsigned char* wd = P.ws + WS_WD;
    WJob j;
    if (t < 128) { const int kt = t >> 3, nt = t & 7;
        j.src = P.w_in + (size_t)(kt * 64) * W_IN + 512 + nt * 256; j.lds_ = W_IN; j.dst = wqkvz + ((size_t)(nt * 256) * 1024 + kt * 64) * 2; j.ldd = 2048; j.inter = 0; j.f8 = 0;
    } else if (t < 192) { const int u = t - 128, kt = u >> 2, nt = u & 3;
        j.src = P.w_out + (size_t)(kt * 64) * 1024 + nt * 256; j.lds_ = 1024; j.dst = wout + ((size_t)(nt * 256) * 1024 + kt * 64) * 2; j.ldd = 2048; j.inter = 0; j.f8 = 0;
    } else if (t < 192 + 2048) { const int u = t - 192, up = u >> 10, v = u & 1023, e = v >> 5, w = v & 31, kt = w >> 1, nt = w & 1;
        j.src = (up ? P.w_up : P.w_gate) + (size_t)e * 1024 * 512 + (size_t)(kt * 64) * 512 + nt * 256; j.lds_ = 512; j.inter = 1 + up;
#if MK_F8
        j.dst = wgu + (size_t)e * 1024 * 1024 + (size_t)(nt * 512) * 1024 + kt * 64; j.ldd = 1024; j.f8 = 1;
#else
        j.dst = wgu + ((size_t)e * 1024 * 1024 + (size_t)(nt * 512) * 1024 + kt * 64) * 2; j.ldd = 2048; j.f8 = 0;
#endif
    } else { const int v = t - 192 - 2048, e = v >> 5, w = v & 31, kt = w >> 2, nt = w & 3;
        j.src = P.w_down + (size_t)e * 512 * 1024 + (size_t)(kt * 64) * 1024 + nt * 256; j.lds_ = 1024; j.inter = 0;
#if MK_F8
        j.dst = wd + (size_t)e * 1024 * 512 + (size_t)(nt * 256) * 512 + kt * 64; j.ldd = 512; j.f8 = 1;
#else
        j.dst = wd + ((size_t)e * 1024 * 512 + (size_t)(nt * 256) * 512 + kt * 64) * 2; j.ldd = 1024; j.f8 = 0;
#endif
    }
    return j;
}
DEV void phase0_weights(const Params& P, unsigned char* sm) {
    PHASE_TID;
    float* tile = (float*)sm;
    const int NJ = 128 + 64 + 3 * 1024;
    f32x4 v[8];
    int t = BID;
    if (t < NJ) { const WJob j = wjob(P, t);
#pragma unroll
        for (int q = 0; q < 8; ++q) v[q] = *(const f32x4*)(j.src + (size_t)((TID >> 6) + q * 8) * j.lds_ + (TID & 63) * 4); }
    for (; t < NJ; t += NBLK) {
        const WJob j = wjob(P, t);
#pragma unroll
        for (int q = 0; q < 8; ++q) { float* tp = tile + ((TID >> 6) + q * 8) * 257 + (TID & 63) * 4; tp[0] = v[q][0]; tp[1] = v[q][1]; tp[2] = v[q][2]; tp[3] = v[q][3]; }
        { const WJob jn = wjob(P, t + NBLK < NJ ? t + NBLK : t);
#pragma unroll
          for (int q = 0; q < 8; ++q) v[q] = *(const f32x4*)(jn.src + (size_t)((TID >> 6) + q * 8) * jn.lds_ + (TID & 63) * 4); }
        SYNC();
        const int c = TID & 255, half = TID >> 8;
        if (j.f8) {
            const int c5 = c & 31, p32 = 16 * ((c5 >> 2) & 1) + 4 * (c5 >> 3) + (c5 & 3), s64 = (c & 0xC3) | (((c >> 2) & 3) << 4) | (((c >> 4) & 3) << 2);
#if MK_F8 == 2
            const int drow8 = j.inter ? ((c >> 7) * 256 + (j.inter - 1) * 128 + ((c >> 5) & 3) * 32 + ((c >> 2) & 1) * 16 + ((c >> 3) & 3) * 4 + (c & 3))
                                      : (((c >> 3) & 1) * 128 + (c >> 6) * 32 + ((c >> 2) & 1) * 16 + ((c >> 4) & 3) * 4 + (c & 3));
            (void)p32; (void)s64;
#else
            const int drow8 = j.inter ? ((c >> 7) * 256 + ((c >> 5) & 3) * 64 + (j.inter - 1) * 32 + p32) : s64;
#endif
            u32x4 w[2];
#pragma unroll
            for (int q = 0; q < 2; ++q)
#pragma unroll
                for (int jj = 0; jj < 4; ++jj) { const int k0 = half * 32 + q * 16 + jj * 4; w[q][jj] = pk4_fp8(tile[k0 * 257 + c] * 32.0f, tile[(k0 + 1) * 257 + c] * 32.0f, tile[(k0 + 2) * 257 + c] * 32.0f, tile[(k0 + 3) * 257 + c] * 32.0f); }
            unsigned char* d8 = j.dst + (size_t)drow8 * j.ldd + half * 32;
            *(u32x4*)d8 = w[0]; *(u32x4*)(d8 + 16) = w[1];
        } else {
            const int drow = j.inter ? ((c >> 7) * 256 + (j.inter - 1) * 128 + (c & 127)) : c;
            u32x4 w[4];
#pragma unroll
            for (int q = 0; q < 4; ++q)
#pragma unroll
                for (int jj = 0; jj < 4; ++jj) w[q][jj] = pk2(tile[(half * 32 + q * 8 + 2 * jj) * 257 + c], tile[(half * 32 + q * 8 + 2 * jj + 1) * 257 + c]);
            unsigned char* d2 = j.dst + (size_t)drow * j.ldd + half * 64;
#pragma unroll
            for (int q = 0; q < 4; ++q) *(u32x4*)(d2 + q * 16) = w[q];
        }
        SYNC();
    }
}

DEV void phase0_wf(const Params& P, unsigned char* sm) {
    PHASE_TID;
    float* cs = (float*)sm;
    if (TID < 128) { float s, c; sincospi_f((float)TID * (2.0f / 128.0f), &s, &c); cs[TID] = c; cs[128 + TID] = s; }
    SYNC();
    bf16_t* wf = (bf16_t*)(P.ws + WS_WF);
    const float sc = 0.08838834764831845f;
    for (int it = BID; it < 256; it += NBLK) {
        const int kb = it & 1, cb = (it >> 1) & 15, part = (it >> 5) & 1, g = it >> 6;
        const int k = kb * 512 + TID;
        const float* wrow = P.w_in + (size_t)k * W_IN + g * 128;
        float acc[8];
#pragma unroll
        for (int q = 0; q < 8; ++q) acc[q] = 0.f;
#pragma unroll 8
        for (int c4 = 0; c4 < 32; ++c4) { const f32x4 w4 = *(const f32x4*)(wrow + c4 * 4);
#pragma unroll
            for (int e = 0; e < 4; ++e) { const int c = c4 * 4 + e;
#pragma unroll
                for (int q = 0; q < 8; ++q) { const int cp = cb * 8 + q; acc[q] += w4[e] * cs[part * 128 + ((c * cp) & 127)]; } } }
#pragma unroll
        for (int q = 0; q < 8; ++q) { const int chc = part * 512 + g * 128 + cb * 8 + q; wf[(size_t)chc * 1024 + k] = f2bf((part ? -acc[q] : acc[q]) * sc); }
    }
    bf16_t* tab = (bf16_t*)(P.ws + WS_TAB);
    const float sc2 = 0.011048543456039806f;
    for (int i = BID * 512 + TID; i < 4096 + 16384; i += NBLK * 512) {
        if (i < 4096) { const int a = i >> 6, b = i & 63; float s, c; sincospi_f((float)((a * b) & 63) * (2.0f / 64.0f), &s, &c); tab[i] = f2bf(c); tab[4096 + i] = f2bf(s); }
        else { const int j = i - 4096, a = j >> 7, b = j & 127; float s, c; sincospi_f((float)((a * b) & 127) * (2.0f / 128.0f), &s, &c); tab[8192 + j] = f2bf(c * sc2); tab[8192 + 16384 + j] = f2bf(s * sc2); }
    }
}

DEV void phase1_prep(const Params& P, unsigned char* sm) {
    PHASE_TID;
    bf16_t* Bhi = (bf16_t*)sm; bf16_t* Blo = (bf16_t*)(sm + 33024);
    float* gsv = (float*)(sm + 66048);
    float* gbl = (float*)(sm + 70144);
    {
        f32x4 w[2][4];
#pragma unroll
        for (int h = 0; h < 2; ++h)
#pragma unroll
            for (int q = 0; q < 4; ++q) w[h][q] = *(const f32x4*)(P.w_in + (size_t)(TID + h * 512) * W_IN + 2560 + q * 4);
#pragma unroll
        for (int h = 0; h < 2; ++h)
#pragma unroll
            for (int q = 0; q < 4; ++q)
#pragma unroll
                for (int e = 0; e < 4; ++e) { const int n = q * 4 + e, k = TID + h * 512; const float v = w[h][q][e]; const bf16_t hi = f2bf(v); Bhi[n * 1032 + k] = hi; Blo[n * 1032 + k] = f2bf(v - bf2f(hi)); }
    }
    const float* mod = (const float*)(P.ws + WS_MOD);
    bf16_t* h = (bf16_t*)(P.ws + WS_R4 + R4_H);
    float* gb = (float*)(P.ws + WS_GB);
    float* rstd_arr = (float*)(P.ws + WS_RSTD);
    float* bias = (float*)(P.ws + WS_BIAS);
    const int wid = TID >> 6, lane = TID & 63, fr = lane & 15, fq = lane >> 4;
    SYNC();
    const float* shrow = mod + (fr < 8 ? fr : 8) * 6144 + fq * 8;
    if (TID < 256) gbl[TID] = 0.f;
    SYNC();
    {
        f32x4 acc = (f32x4){0.f, 0.f, 0.f, 0.f};
#pragma unroll
        for (int k4 = 0; k4 < 4; ++k4) {
            const int ks = wid * 4 + k4;
            const f32x4 a0 = *(const f32x4*)(shrow + ks * 32), a1 = *(const f32x4*)(shrow + ks * 32 + 4);
            const float hv[8] = {a0[0], a0[1], a0[2], a0[3], a1[0], a1[1], a1[2], a1[3]};
            u32x4 whi, wlo;
#pragma unroll
            for (int e = 0; e < 4; ++e) { whi[e] = pk2(hv[2 * e], hv[2 * e + 1]); wlo[e] = pk2(hv[2 * e] - __builtin_bit_cast(float, whi[e] << 16), hv[2 * e + 1] - __builtin_bit_cast(float, whi[e] & 0xffff0000u)); }
            const bf16x8 ahi = __builtin_bit_cast(bf16x8, whi), alo = __builtin_bit_cast(bf16x8, wlo);
            const bf16x8 bhi = frag16(Bhi + fr * 1032 + ks * 32 + fq * 8), blo = frag16(Blo + fr * 1032 + ks * 32 + fq * 8);
            acc = mfma16(ahi, bhi, acc); acc = mfma16(alo, bhi, acc); acc = mfma16(ahi, blo, acc);
        }
#pragma unroll
        for (int r = 0; r < 4; ++r) atomic_add_f32(&gbl[(fq * 4 + r) * 16 + fr], acc[r]);
    }
    {
        const bf16_t* wq = (const bf16_t*)(P.ws + WS_WQKVZ); const bf16_t* wf = (const bf16_t*)(P.ws + WS_WF);
        for (int it = BID * 8 + wid; it < 192; it += NBLK * 8) {
            const int n0 = it * 16;
            const bf16_t* wrow = (n0 < 2048 ? wq + (size_t)(n0 + fr) * 1024 : wf + (size_t)(n0 - 2048 + fr) * 1024) + fq * 8;
            f32x4 acc = (f32x4){0.f, 0.f, 0.f, 0.f};
#pragma unroll 4
            for (int ks = 0; ks < 32; ++ks) {
                const f32x4 a0 = *(const f32x4*)(shrow + ks * 32), a1 = *(const f32x4*)(shrow + ks * 32 + 4);
                const float hv[8] = {a0[0], a0[1], a0[2], a0[3], a1[0], a1[1], a1[2], a1[3]};
                u32x4 whi, wlo;
#pragma unroll
                for (int e = 0; e < 4; ++e) { whi[e] = pk2(hv[2 * e], hv[2 * e + 1]); wlo[e] = pk2(hv[2 * e] - __builtin_bit_cast(float, whi[e] << 16), hv[2 * e + 1] - __builtin_bit_cast(float, whi[e] & 0xffff0000u)); }
                const bf16x8 bw = frag16(wrow + ks * 32);
                acc = mfma16(__builtin_bit_cast(bf16x8, whi), bw, acc); acc = mfma16(__builtin_bit_cast(bf16x8, wlo), bw, acc);
            }
#pragma unroll
            for (int r = 0; r < 4; ++r) { const int mbr = fq * 4 + r; if (mbr < 9) bias[mbr * 3072 + n0 + fr] = acc[r]; }
        }
    }
    for (int t = BID; t < MROWS / 128; t += NBLK) {
        const int r0 = t * 128 + wid * 16, mb = (t * 128 < NTOK) ? ((t * 128) >> 13) : 8;
        SYNC();
        { const float* scale = mod + mb * 6144 + 1024;
#pragma unroll
          for (int q = 0; q < 2; ++q) { const int k = TID + q * 512; gsv[k] = P.norm1_g[k] * (1.0f + scale[k]); } }
        SYNC();
        const int rr = r0 + fr;
        const float* src = (rr < NTOK ? P.x + (size_t)rr * D : P.ctx + (size_t)(rr - NTOK) * D) + fq * 8;
        float ss = 0.f;
        f32x4 acc = (f32x4){0.f, 0.f, 0.f, 0.f};
        bf16_t* hrow = h + (size_t)rr * D + fq * 8;
#pragma unroll 8
        for (int ks = 0; ks < 32; ++ks) {
            const f32x4 a0 = *(const f32x4*)(src + ks * 32), a1 = *(const f32x4*)(src + ks * 32 + 4);
            ss += a0[0] * a0[0] + a0[1] * a0[1] + a0[2] * a0[2] + a0[3] * a0[3] + a1[0] * a1[0] + a1[1] * a1[1] + a1[2] * a1[2] + a1[3] * a1[3];
            const f32x4 g0 = *(const f32x4*)(gsv + ks * 32 + fq * 8), g1 = *(const f32x4*)(gsv + ks * 32 + fq * 8 + 4);
            float hv[8];
#pragma unroll
            for (int e = 0; e < 4; ++e) { hv[e] = a0[e] * g0[e]; hv[4 + e] = a1[e] * g1[e]; }
            u32x4 whi, wlo;
#pragma unroll
            for (int e = 0; e < 4; ++e) { whi[e] = pk2(hv[2 * e], hv[2 * e + 1]); wlo[e] = pk2(hv[2 * e] - __builtin_bit_cast(float, whi[e] << 16), hv[2 * e + 1] - __builtin_bit_cast(float, whi[e] & 0xffff0000u)); }
            *(u32x4*)(hrow + ks * 32) = whi;
            const bf16x8 ahi = __builtin_bit_cast(bf16x8, whi), alo = __builtin_bit_cast(bf16x8, wlo);
            const bf16x8 bhi = frag16(Bhi + fr * 1032 + ks * 32 + fq * 8), blo = frag16(Blo + fr * 1032 + ks * 32 + fq * 8);
            acc = mfma16(ahi, bhi, acc); acc = mfma16(alo, bhi, acc); acc = mfma16(ahi, blo, acc);
        }
        ss += shfl_xor_f(ss, 16); ss += shfl_xor_f(ss, 32);
        const float rstd = rsq_f(ss * (1.0f / 1024.0f) + EPS);
        if (fq == 0) rstd_arr[rr] = rstd;
        float ea = 0.f, db = 0.f;
        if (fr >= 8) { ea = -__expf(P.a_log[fr - 8]); db = P.dt_bias[fr - 8]; }
        const float gbias = gbl[mb * 16 + fr];
#pragma unroll
        for (int reg = 0; reg < 4; ++reg) { const float v = acc[reg] * shfl_idx_f(rstd, fq * 4 + reg) + gbias; float o;
            if (fr < 8) o = rcp_f(1.0f + __expf(-v));
            else { const float z = v + db; const float sp = z > 20.f ? z : log1pf(__expf(z)); o = ea * sp; }
            gb[(size_t)(r0 + fq * 4 + reg) * 16 + fr] = o; }
    }
}

#ifndef CPU_EMU
namespace pg8 {
#define PG8_LAS __attribute__((address_space(3)))
constexpr int BM = 256, BK = 64, HALF = 128, HTB = HALF * BK * 2, STAGE_BYTES = 8 * HTB;
__device__ __forceinline__ int lds_byte(int r, int c) { const int st = (r >> 4) * 2 + (c >> 5), rr = r & 15, cc = c & 31, ob = rr * 64 + cc * 2; return st * 1024 + (ob ^ (((ob >> 9) & 1) << 5)); }
__device__ __forceinline__ void stage_rc(int b, int& R, int& C) { const int st = b / 1024, sb = b % 1024, swz = sb ^ (((sb >> 9) & 1) << 5); R = (st >> 1) * 16 + swz / 64; C = (st & 1) * 32 + (swz % 64) / 2; }
__device__ __forceinline__ int perm32(int rho) { const int n = rho >> 4, i = rho & 15; return 8 * (i >> 2) + 4 * n + (i & 3); }
struct Unit { int pm, pn, e, cnt; };
typedef int v8i32 __attribute__((ext_vector_type(8)));
typedef int v4i32 __attribute__((ext_vector_type(4)));
__device__ __forceinline__ unsigned cvt_pk_bf16(float lo, float hi) { unsigned r; asm volatile("v_cvt_pk_bf16_f32 %0, %1, %2" : "=v"(r) : "v"(lo), "v"(hi)); return r; }

template <class Prob, class Epi>
__device__ __forceinline__ void gemm_phase(PG8_LAS unsigned char* lds, const Prob& G, const Epi& E) {
    int tid_ = MK_TID(G.wv); asm volatile("" : "+v"(tid_));
    const int tid = tid_, wid = __builtin_amdgcn_readfirstlane(tid >> 6), lane = tid & 63, wr = wid >> 2, wc = wid & 3, fr = lane & 15, fq = lane >> 4;
    const int K = G.K, nt = K / BK;
    int R0, C0; stage_rc(tid * 16, R0, C0);
    const int rA0 = R0, rA1 = R0 + 64;
    const int rB0 = Epi::PERM ? ((R0 & ~31) + perm32(R0 & 31)) : R0, rB1 = Epi::PERM ? (((R0 + 64) & ~31) + perm32((R0 + 64) & 31)) : R0 + 64;
    const unsigned ldsw = (unsigned)wid * 1024u;
    const int aoff = lds_byte(wr * 64 + fr, fq * 8), boff = lds_byte(wc * 32 + fr, fq * 8);
    const unsigned ldsbase = (unsigned)__builtin_amdgcn_readfirstlane((int)(unsigned)(__SIZE_TYPE__)(lds + ldsw));
    const char* Ab = (const char*)G.A; const char* Bb = (const char*)G.Bt;
#define PG8_SA(b, h) (((b) * 2 + (h)) * HTB)
#define PG8_SB(b, h) ((4 + (b) * 2 + (h)) * HTB)
#define PG8_STAGE(bufoff, gbase, ub, l0, l1) do { \
        if constexpr (Prob::F8) {     \
            const char* sb_ = (gbase) + (size_t)(ub); const unsigned m0_ = ldsbase + (unsigned)(bufoff); \
            asm volatile("s_mov_b32 m0, %2\n\ts_nop 0\n\tglobal_load_lds_dwordx4 %0, %1\n\ts_mov_b32 m0, %4\n\ts_nop 0\n\tglobal_load_lds_dwordx4 %3, %1" \
                         :: "v"(l0), "s"(sb_), "s"(m0_), "v"(l1), "s"(m0_ + 8192u) : "memory", "m0"); \
        } else { \
        __builtin_amdgcn_global_load_lds((const unsigned*)((gbase) + (size_t)(ub) + (l0)), (PG8_LAS unsigned*)(lds + (bufoff) + ldsw), 16, 0, 0); \
        __builtin_amdgcn_global_load_lds((const unsigned*)((gbase) + (size_t)(ub) + (l1)), (PG8_LAS unsigned*)(lds + (bufoff) + ldsw + 8192), 16, 0, 0); } } while (0)
#define PG8_LDA(dst, b, h) do { _Pragma("unroll") for (int m = 0; m < 4; ++m) _Pragma("unroll") for (int k = 0; k < 2; ++k) dst[m][k] = *(const PG8_LAS bf16x8*)(lds + PG8_SA(b, h) + aoff + m * 2048 + k * 1024); } while (0)
#define PG8_LDB(dst, b, h) do { _Pragma("unroll") for (int n = 0; n < 2; ++n) _Pragma("unroll") for (int k = 0; k < 2; ++k) dst[n][k] = *(const PG8_LAS bf16x8*)(lds + PG8_SB(b, h) + boff + n * 2048 + k * 1024); } while (0)
#define PG8_CAT(f) __builtin_shufflevector(__builtin_bit_cast(v4i32, f[0]), __builtin_bit_cast(v4i32, f[1]), 0, 1, 2, 3, 4, 5, 6, 7)
#define PG8_MMA(ai, bj, At, Bt) do { __builtin_amdgcn_s_setprio(1); \
        if constexpr (Prob::F8) { _Pragma("unroll") for (int m = 0; m < 4; ++m) _Pragma("unroll") for (int n = 0; n < 2; ++n) \
            acc[ai][bj][m][n] = __builtin_amdgcn_mfma_scale_f32_16x16x128_f8f6f4(PG8_CAT(Bt[n]), PG8_CAT(At[m]), acc[ai][bj][m][n], 0, 0, 0, 0, 0, 0); } \
        else { _Pragma("unroll") for (int m = 0; m < 4; ++m) _Pragma("unroll") for (int n = 0; n < 2; ++n) _Pragma("unroll") for (int k = 0; k < 2; ++k) \
            acc[ai][bj][m][n] = __builtin_amdgcn_mfma_f32_16x16x32_bf16(Bt[n][k], At[m][k], acc[ai][bj][m][n], 0, 0, 0); } \
        __builtin_amdgcn_s_setprio(0); } while (0)
#define PG8_WAIT_V(n) asm volatile("s_waitcnt vmcnt(" #n ")" ::: "memory")
#define PG8_WAIT_L(n) asm volatile("s_waitcnt lgkmcnt(" #n ")" ::: "memory")
#define PG8_BAR __builtin_amdgcn_s_barrier()
#define PG8_SCHED __builtin_amdgcn_sched_barrier(0)
    Unit cur, nxt; int ui = 0;
    if (!G.next(0, cur)) return;
    f32x4 acc[2][2][4][2];
#pragma unroll
    for (int a = 0; a < 2; ++a)
#pragma unroll
        for (int b = 0; b < 2; ++b)
#pragma unroll
            for (int m = 0; m < 4; ++m)
#pragma unroll
                for (int n = 0; n < 2; ++n) acc[a][b][m][n] = (f32x4){0.f, 0.f, 0.f, 0.f};
    bf16x8 At[4][2], B0[2][2], B1[2][2];
    const unsigned cb2 = (unsigned)C0 * 2u;
    const unsigned lB00 = G.laneB(rB0) + cb2, lB01 = G.laneB(rB1) + cb2, lB10 = G.laneB(128 + rB0) + cb2, lB11 = G.laneB(128 + rB1) + cb2;
    const unsigned lA00 = G.laneA(rA0) + cb2, lA01 = G.laneA(rA1) + cb2, lA10 = G.laneA(128 + rA0) + cb2, lA11 = G.laneA(128 + rA1) + cb2;
    unsigned cA00 = lA00, cA01 = lA01, cA10 = lA10, cA11 = lA11, nA00 = lA00, nA01 = lA01, nA10 = lA10, nA11 = lA11;
    if constexpr (Prob::GATHER_A) { cA00 += G.gathA(cur, rA0); cA01 += G.gathA(cur, rA1); cA10 += G.gathA(cur, 128 + rA0); cA11 += G.gathA(cur, 128 + rA1); }
    unsigned uAc = G.baseA(cur), uBc = G.baseB(cur), uAn = uAc, uBn = uBc;
    if constexpr (Epi::PREFETCH) E.prefetch(cur, lds + STAGE_BYTES + 2048, wid, lane);
    PG8_STAGE(PG8_SB(0, 0), Bb, uBc, lB00, lB01); PG8_STAGE(PG8_SA(0, 0), Ab, uAc, cA00, cA01); PG8_STAGE(PG8_SB(0, 1), Bb, uBc, lB10, lB11); PG8_STAGE(PG8_SA(0, 1), Ab, uAc, cA10, cA11);
    if (wr == 1) PG8_BAR;
    PG8_WAIT_V(4); PG8_BAR;
    PG8_STAGE(PG8_SB(1, 0), Bb, uBc + 128u, lB00, lB01); PG8_STAGE(PG8_SA(1, 0), Ab, uAc + 128u, cA00, cA01); PG8_STAGE(PG8_SB(1, 1), Bb, uBc + 128u, lB10, lB11);
    PG8_WAIT_V(6); PG8_BAR;
#if MK_TP
    long long tp_t0 = 0, tp_acc = 0;
#if MK_TP == 5
    const long long tp_all0 = (long long)__builtin_readcyclecounter();
#endif
#endif
    for (;;) {
        const bool has_next = G.next(ui + 1, nxt);
        if constexpr (Epi::PREFETCH) { if (has_next) { const int lane_o = mk_lane_volatile(); E.prefetch(nxt, lds + STAGE_BYTES + 2048 + ((ui + 1) % 3) * 2048, wid, lane_o); } }
        if constexpr (Prob::LDSGATH) { if (has_next) { const int lane_o = mk_lane_volatile(); G.prefetchA(nxt, lds + STAGE_BYTES + 8192, wid, lane_o); } }
        if (has_next) {
            uAn = G.baseA(nxt); uBn = G.baseB(nxt);
            if constexpr (Prob::GATHER_A && !Prob::LDSGATH) { nA00 = lA00 + G.gathA(nxt, rA0); nA01 = lA01 + G.gathA(nxt, rA1); nA10 = lA10 + G.gathA(nxt, 128 + rA0); nA11 = lA11 + G.gathA(nxt, 128 + rA1); }
        } else { uAn = uAc; uBn = uBc; if constexpr (Prob::GATHER_A && !Prob::LDSGATH) { nA00 = cA00; nA01 = cA01; nA10 = cA10; nA11 = cA11; } }
#if MK_TP == 1
        if constexpr (Epi::TP) { if (ui > 0) tp_acc += (long long)__builtin_readcyclecounter() - tp_t0; }
#endif
#if MK_TP == 2 || MK_TP == 4
        if constexpr (Epi::TP) tp_t0 = (long long)__builtin_readcyclecounter();
#endif
        for (int t = 0; t < nt; t += 2) {
            const bool last = (t == nt - 2);
#if MK_TP == 2
            if constexpr (Epi::TP) { if (t == 4) tp_acc += (long long)__builtin_readcyclecounter() - tp_t0; }
#endif
#if MK_TP == 4
            if constexpr (Epi::TP) { if (ui > 0 && last) tp_t0 = (long long)__builtin_readcyclecounter(); }
#endif
#if MK_TP == 3
            if constexpr (Epi::TP) { if (ui > 0 && t == 4) tp_t0 = (long long)__builtin_readcyclecounter(); if (ui > 0 && t == 6) tp_acc += (long long)__builtin_readcyclecounter() - tp_t0; }
#endif
            const unsigned k1 = (unsigned)(t + 1) * 128u;
            const unsigned uA2 = last ? uAn : uAc + (unsigned)(t + 2) * 128u, uB2 = last ? uBn : uBc + (unsigned)(t + 2) * 128u, uA3 = uA2 + 128u, uB3 = uB2 + 128u;
            unsigned a00 = cA00, a01 = cA01, a10 = cA10, a11 = cA11;
            if constexpr (Prob::GATHER_A && !Prob::LDSGATH) { a00 = last ? nA00 : cA00; a01 = last ? nA01 : cA01; a10 = last ? nA10 : cA10; a11 = last ? nA11 : cA11; }
            PG8_LDB(B0, 0, 0); PG8_SCHED; PG8_LDA(At, 0, 0); PG8_STAGE(PG8_SA(1, 1), Ab, uAc + k1, cA10, cA11);
            PG8_WAIT_L(8); PG8_BAR; PG8_WAIT_L(0); PG8_MMA(0, 0, At, B0); PG8_BAR; PG8_SCHED;
            if constexpr (Prob::LDSGATH) {
                if (last && has_next) { const PG8_LAS unsigned char* gb = lds + STAGE_BYTES + 8192;
                    cA00 = lA00 + G.gathL(nxt, gb, rA0); cA01 = lA01 + G.gathL(nxt, gb, rA1); cA10 = lA10 + G.gathL(nxt, gb, 128 + rA0); cA11 = lA11 + G.gathL(nxt, gb, 128 + rA1); }
                a00 = cA00; a01 = cA01; a10 = cA10; a11 = cA11; }
            PG8_LDB(B1, 0, 1); PG8_STAGE(PG8_SB(0, 0), Bb, uB2, lB00, lB01);
            PG8_BAR; PG8_WAIT_L(0); PG8_MMA(0, 1, At, B1); PG8_BAR;
            PG8_LDA(At, 0, 1); PG8_STAGE(PG8_SA(0, 0), Ab, uA2, a00, a01);
            PG8_BAR; PG8_WAIT_L(0); PG8_MMA(1, 0, At, B0); PG8_BAR; PG8_SCHED;
            PG8_STAGE(PG8_SB(0, 1), Bb, uB2, lB10, lB11);
            PG8_WAIT_V(6); PG8_BAR; PG8_MMA(1, 1, At, B1); PG8_BAR;
            PG8_LDB(B0, 1, 0); PG8_SCHED; PG8_LDA(At, 1, 0); PG8_STAGE(PG8_SA(0, 1), Ab, uA2, a10, a11);
            PG8_WAIT_L(8); PG8_BAR; PG8_WAIT_L(0); PG8_MMA(0, 0, At, B0); PG8_BAR; PG8_SCHED;
            PG8_LDB(B1, 1, 1); PG8_STAGE(PG8_SB(1, 0), Bb, uB3, lB00, lB01);
            PG8_BAR; PG8_WAIT_L(0); PG8_MMA(0, 1, At, B1); PG8_BAR;
            PG8_LDA(At, 1, 1); PG8_STAGE(PG8_SA(1, 0), Ab, uA3, a00, a01);
            PG8_BAR; PG8_WAIT_L(0); PG8_MMA(1, 0, At, B0); PG8_BAR; PG8_SCHED;
            PG8_STAGE(PG8_SB(1, 1), Bb, uB3, lB10, lB11);
            PG8_WAIT_V(6); PG8_BAR; PG8_MMA(1, 1, At, B1); PG8_BAR;
        }
#if MK_TP == 1
        if constexpr (Epi::TP) tp_t0 = (long long)__builtin_readcyclecounter();
#endif
#if MK_TP == 4
        if constexpr (Epi::TP) { if (ui > 0) tp_acc += (long long)__builtin_readcyclecounter() - tp_t0; }
#endif
        { const int le = mk_lane_volatile();
          E(acc, cur, wr, wc, le & 15, le >> 4, (const PG8_LAS float*)(lds + STAGE_BYTES + 2048 + (ui % 3) * 2048)); }
        if (!has_next) break;
#pragma unroll
        for (int a = 0; a < 2; ++a)
#pragma unroll
            for (int b = 0; b < 2; ++b)
#pragma unroll
                for (int m = 0; m < 4; ++m)
#pragma unroll
                    for (int n = 0; n < 2; ++n) acc[a][b][m][n] = (f32x4){0.f, 0.f, 0.f, 0.f};
        cur = nxt; ++ui; uAc = uAn; uBc = uBn;
        if constexpr (Prob::GATHER_A && !Prob::LDSGATH) { cA00 = nA00; cA01 = nA01; cA10 = nA10; cA11 = nA11; }
    }
    PG8_WAIT_V(0);
    if (wr == 0) PG8_BAR;
    PG8_BAR;
#if MK_TP
#if MK_TP == 5
    tp_acc = ((long long)__builtin_readcyclecounter() - tp_all0) / 8;
#endif
#ifndef MK_TPWG
#define MK_TPWG 0
#endif
    if constexpr (Epi::TP) { if (G.c == MK_TPWG && wid == 0) { const long long t0 = (long long)__builtin_readcyclecounter(); while ((long long)__builtin_readcyclecounter() - t0 < tp_acc * 32) __builtin_amdgcn_s_sleep(4); } }
#endif
#undef PG8_SA
#undef PG8_SB
#undef PG8_STAGE
#undef PG8_LDA
#undef PG8_LDB
#undef PG8_MMA
#undef PG8_CAT
#undef PG8_WAIT_V
#undef PG8_WAIT_L
#undef PG8_BAR
#undef PG8_SCHED
}

struct GridOrder {
    int nM, nN, nwg, G, c, wv;
    __device__ __forceinline__ void init(int nM_, int nN_, int G_, int c_) { nM = nM_; nN = nN_; nwg = nM * nN; G = G_; c = c_; }
    __device__ __forceinline__ bool next(int i, Unit& u) const {
        const long L = (long)i * G + c; if (L >= nwg) return false;
        int wgid = (int)L; { const int q = nwg / 8, r = nwg % 8, xcd = wgid % 8, off = wgid / 8; wgid = (xcd < r ? xcd * (q + 1) : r * (q + 1) + (xcd - r) * q) + off; }
        const int nig = 8 * nN, gid = wgid / nig, fm = gid * 8, gsz = (nM - fm) < 8 ? (nM - fm) : 8;
        u.pm = fm + ((wgid % nig) % gsz); u.pn = (wgid % nig) / gsz; u.e = 0; u.cnt = 256; return true;
    }
};

struct ProbInproj : GridOrder { const bf16_t* A; const bf16_t* Bt; int K; static constexpr bool GATHER_A = false; static constexpr bool F8 = false; static constexpr bool LDSGATH = false;
    __device__ __forceinline__ unsigned laneA(int r) const { return (unsigned)r * 2048u; }
    __device__ __forceinline__ unsigned laneB(int r) const { return (unsigned)r * 2048u; }
    __device__ __forceinline__ unsigned baseA(const Unit& u) const { return (unsigned)(u.pm * 256) * 2048u; }
    __device__ __forceinline__ unsigned baseB(const Unit& u) const { return (unsigned)(u.pn * 256) * 2048u; }
    __device__ __forceinline__ unsigned gathA(const Unit&, int) const { return 0u; } };
struct ProbGT : GridOrder { const bf16_t* A; const bf16_t* Bt; int K; static constexpr bool GATHER_A = false; static constexpr bool F8 = false; static constexpr bool LDSGATH = false;
    __device__ __forceinline__ unsigned laneA(int r) const { return (unsigned)r * 2048u; }
    __device__ __forceinline__ unsigned laneB(int r) const { return (unsigned)(128 * (r & 63) + (r >> 6)) * 2048u; }
    __device__ __forceinline__ unsigned baseA(const Unit& u) const { return (unsigned)(u.pm * 256) * 2048u; }
    __device__ __forceinline__ unsigned baseB(const Unit& u) const { const int col = u.pn * 256, b = col >> 13, w = col & 8191; return (unsigned)(b * 8192 + (w >> 6)) * 2048u; }
    __device__ __forceinline__ unsigned gathA(const Unit&, int) const { return 0u; } };
struct EpiStoreBf16 {
    static constexpr bool TP = false; static constexpr bool PERM = true, PREFETCH = false; bf16_t* O; int ldc;
    __device__ __forceinline__ void operator()(const f32x4 (&acc)[2][2][4][2], const Unit& u, int wr, int wc, int fr, int fq, const PG8_LAS float* ex) const {
        const int row0 = u.pm * 256 + wr * 64 + fr, col0 = u.pn * 256 + wc * 32 + 8 * fq;
#pragma unroll
        for (int ai = 0; ai < 2; ++ai)
#pragma unroll
            for (int m = 0; m < 4; ++m) { bf16_t* rowp = O + (size_t)(row0 + ai * 128 + m * 16) * ldc + col0;
#pragma unroll
                for (int bj = 0; bj < 2; ++bj) { const f32x4 v0 = acc[ai][bj][m][0], v1 = acc[ai][bj][m][1];
                    u32x4 w; w.x = cvt_pk_bf16(v0[0], v0[1]); w.y = cvt_pk_bf16(v0[2], v0[3]); w.z = cvt_pk_bf16(v1[0], v1[1]); w.w = cvt_pk_bf16(v1[2], v1[3]);
                    *(u32x4*)(rowp + bj * 128) = w; } }
    }
};
struct EpiGT {
    static constexpr bool TP = false; static constexpr bool PERM = true, PREFETCH = true; bf16_t* O; const float* rstd; const float* bias;
    __device__ __forceinline__ void prefetch(const Unit& u, PG8_LAS unsigned char* ex, int wid, int lane) const {
        const int mb = (u.pn * 256) >> 13;
        if (wid == 0) __builtin_amdgcn_global_load_lds((const unsigned*)(bias + mb * 3072 + 2048 + u.pm * 256 + lane * 4), (PG8_LAS unsigned*)(ex + 1024), 16, 0, 0);
        else if (wid <= 4) { const int c = u.pn * 256 + (wid - 1) * 64 + lane, w = c & 8191;
            __builtin_amdgcn_global_load_lds((const unsigned*)(rstd + mb * 8192 + 128 * (w & 63) + (w >> 6)), (PG8_LAS unsigned*)(ex + (wid - 1) * 256), 4, 0, 0); }
    }
    __device__ __forceinline__ void operator()(const f32x4 (&acc)[2][2][4][2], const Unit& u, int wr, int wc, int fr, int fq, const PG8_LAS float* ex) const {
        const int row0 = u.pm * 256 + wr * 64 + fr, col0 = u.pn * 256 + wc * 32 + 8 * fq;
        float rs[2][8];
#pragma unroll
        for (int bj = 0; bj < 2; ++bj) { const f32x4 r0_ = *(const PG8_LAS f32x4*)(ex + bj * 128 + wc * 32 + 8 * fq), r1_ = *(const PG8_LAS f32x4*)(ex + bj * 128 + wc * 32 + 8 * fq + 4);
            rs[bj][0] = r0_[0]; rs[bj][1] = r0_[1]; rs[bj][2] = r0_[2]; rs[bj][3] = r0_[3]; rs[bj][4] = r1_[0]; rs[bj][5] = r1_[1]; rs[bj][6] = r1_[2]; rs[bj][7] = r1_[3]; }
#pragma unroll
        for (int ai = 0; ai < 2; ++ai)
#pragma unroll
            for (int m = 0; m < 4; ++m) { const int row = row0 + ai * 128 + m * 16; const float bg = ex[256 + wr * 64 + fr + ai * 128 + m * 16]; bf16_t* rowp = O + (size_t)row * NTOK + col0;
#pragma unroll
                for (int bj = 0; bj < 2; ++bj) { const f32x4 a0 = acc[ai][bj][m][0], a1 = acc[ai][bj][m][1];
                    u32x4 w; w.x = cvt_pk_bf16(a0[0] * rs[bj][0] + bg, a0[1] * rs[bj][1] + bg); w.y = cvt_pk_bf16(a0[2] * rs[bj][2] + bg, a0[3] * rs[bj][3] + bg);
                    w.z = cvt_pk_bf16(a1[0] * rs[bj][4] + bg, a1[1] * rs[bj][5] + bg); w.w = cvt_pk_bf16(a1[2] * rs[bj][6] + bg, a1[3] * rs[bj][7] + bg);
                    *(u32x4*)(rowp + bj * 128) = w; } }
    }
};
struct EpiInproj {
    static constexpr bool TP = false; static constexpr bool PERM = true, PREFETCH = true; bf16_t* O; bf16_t* zs; const float* rstd; const float* bias;
    __device__ __forceinline__ void prefetch(const Unit& u, PG8_LAS unsigned char* ex, int wid, int lane) const {
        if (wid == 0) __builtin_amdgcn_global_load_lds((const unsigned*)(rstd + u.pm * 256 + lane * 4), (PG8_LAS unsigned*)ex, 16, 0, 0);
        else if (wid == 1) __builtin_amdgcn_global_load_lds((const unsigned*)(bias + ((u.pm * 256 < NTOK) ? ((u.pm * 256) >> 13) : 8) * 3072 + u.pn * 256 + lane * 4), (PG8_LAS unsigned*)(ex + 1024), 16, 0, 0);
    }
    __device__ __forceinline__ void operator()(const f32x4 (&acc)[2][2][4][2], const Unit& u, int wr, int wc, int fr, int fq, const PG8_LAS float* ex) const {
        const int row0 = u.pm * 256 + wr * 64 + fr, col0 = u.pn * 256 + wc * 32 + 8 * fq;
        const bool isz = u.pn >= 6;
        if (isz && u.pm * 256 >= NTOK) return;
        f32x4 bv[2][2];
#pragma unroll
        for (int bj = 0; bj < 2; ++bj) { bv[bj][0] = *(const PG8_LAS f32x4*)(ex + 256 + bj * 128 + wc * 32 + 8 * fq); bv[bj][1] = *(const PG8_LAS f32x4*)(ex + 256 + bj * 128 + wc * 32 + 8 * fq + 4); }
#pragma unroll
        for (int ai = 0; ai < 2; ++ai)
#pragma unroll
            for (int m = 0; m < 4; ++m) { const size_t row = (size_t)(row0 + ai * 128 + m * 16); const float rs = ex[wr * 64 + fr + ai * 128 + m * 16];
                bf16_t* rowp = isz ? zs + row * 512 + (col0 - 1536) : O + row * 2048 + col0;
#pragma unroll
                for (int bj = 0; bj < 2; ++bj) { f32x4 v0 = acc[ai][bj][m][0] * rs + bv[bj][0], v1 = acc[ai][bj][m][1] * rs + bv[bj][1];
                    if (isz) {
#pragma unroll
                        for (int j = 0; j < 4; ++j) { v0[j] = v0[j] * __builtin_amdgcn_rcpf(1.0f + __expf(-v0[j])); v1[j] = v1[j] * __builtin_amdgcn_rcpf(1.0f + __expf(-v1[j])); } }
                    u32x4 w; w.x = cvt_pk_bf16(v0[0], v0[1]); w.y = cvt_pk_bf16(v0[2], v0[3]); w.z = cvt_pk_bf16(v1[0], v1[1]); w.w = cvt_pk_bf16(v1[2], v1[3]);
                    *(u32x4*)(rowp + bj * 128) = w; } }
    }
};
typedef ProbInproj ProbOut;
struct EpiProj {
    static constexpr bool TP = false; static constexpr bool PERM = true, PREFETCH = false; const float* mod; bf16_t* O;
    __device__ __forceinline__ void operator()(const f32x4 (&acc)[2][2][4][2], const Unit& u, int wr, int wc, int fr, int fq, const PG8_LAS float* ex) const {
        const int row0 = u.pm * 256 + wr * 64 + fr, col0 = u.pn * 256 + wc * 32 + 8 * fq;
        const float* gate = mod + ((u.pm * 256) >> 13) * 6144 + 2 * 1024 + col0;
        f32x4 gv[2][2];
#pragma unroll
        for (int bj = 0; bj < 2; ++bj) { gv[bj][0] = *(const f32x4*)(gate + bj * 128); gv[bj][1] = *(const f32x4*)(gate + bj * 128 + 4); }
#pragma unroll
        for (int ai = 0; ai < 2; ++ai)
#pragma unroll
            for (int m = 0; m < 4; ++m) { bf16_t* rowp = O + (size_t)(row0 + ai * 128 + m * 16) * 1024 + col0;
#pragma unroll
                for (int bj = 0; bj < 2; ++bj) { const f32x4 v0 = acc[ai][bj][m][0] * gv[bj][0], v1 = acc[ai][bj][m][1] * gv[bj][1];
                    u32x4 w; w.x = cvt_pk_bf16(v0[0], v0[1]); w.y = cvt_pk_bf16(v0[2], v0[3]); w.z = cvt_pk_bf16(v1[0], v1[1]); w.w = cvt_pk_bf16(v1[2], v1[3]);
                    *(u32x4*)(rowp + bj * 128) = w; } }
    }
};
struct EpiResid {
    static constexpr bool TP = false; static constexpr bool PERM = false, PREFETCH = false; const float* x; const float* mod; float* out;
    __device__ __forceinline__ void operator()(const f32x4 (&acc)[2][2][4][2], const Unit& u, int wr, int wc, int fr, int fq, const PG8_LAS float* ex) const {
        const int row0 = u.pm * 256 + wr * 64 + fr, col0 = u.pn * 256 + wc * 32 + 4 * fq;
        const float* gate = mod + ((u.pm * 256) >> 13) * 6144 + 2 * 1024;
        f32x4 gv[2][2];
#pragma unroll
        for (int bj = 0; bj < 2; ++bj)
#pragma unroll
            for (int n = 0; n < 2; ++n) gv[bj][n] = *(const f32x4*)(gate + col0 + bj * 128 + n * 16);
#pragma unroll
        for (int ai = 0; ai < 2; ++ai) {
            f32x4 xv[4][2][2];
#pragma unroll
            for (int m = 0; m < 4; ++m) { const size_t off = (size_t)(row0 + ai * 128 + m * 16) * 1024 + col0;
#pragma unroll
                for (int bj = 0; bj < 2; ++bj)
#pragma unroll
                    for (int n = 0; n < 2; ++n) xv[m][bj][n] = *(const f32x4*)(x + off + bj * 128 + n * 16); }
            __builtin_amdgcn_sched_barrier(0);
#pragma unroll
            for (int m = 0; m < 4; ++m) { const size_t off = (size_t)(row0 + ai * 128 + m * 16) * 1024 + col0;
#pragma unroll
                for (int bj = 0; bj < 2; ++bj)
#pragma unroll
                    for (int n = 0; n < 2; ++n) *(f32x4*)(out + off + bj * 128 + n * 16) = xv[m][bj][n] + gv[bj][n] * acc[ai][bj][m][n]; }
        }
    }
};
struct ProbOutHot : GridOrder { const bf16_t* A; const bf16_t* Bt; int K; int hot; static constexpr bool GATHER_A = false; static constexpr bool F8 = false; static constexpr bool LDSGATH = false;
    __device__ __forceinline__ unsigned laneA(int r) const { return (unsigned)r * 2048u; }
    __device__ __forceinline__ unsigned laneB(int r) const { return (unsigned)r * 2048u; }
    __device__ __forceinline__ unsigned baseA(const Unit& u) const { return hot ? 0u : (unsigned)(u.pm * 256) * 2048u; }
    __device__ __forceinline__ unsigned baseB(const Unit& u) const { return (unsigned)(u.pn * 256) * 2048u; }
    __device__ __forceinline__ unsigned gathA(const Unit&, int) const { return 0u; } };
struct EpiDry {
    static constexpr bool TP = true; static constexpr bool PERM = false, PREFETCH = false; float* out;
    __device__ __forceinline__ void operator()(const f32x4 (&acc)[2][2][4][2], const Unit& u, int wr, int wc, int fr, int fq, const PG8_LAS float* ex) const {
        float sacc = 0.f;
#pragma unroll
        for (int ai = 0; ai < 2; ++ai)
#pragma unroll
            for (int bj = 0; bj < 2; ++bj)
#pragma unroll
                for (int m = 0; m < 4; ++m)
#pragma unroll
                    for (int n = 0; n < 2; ++n) sacc += acc[ai][bj][m][n][0] + acc[ai][bj][m][n][1] + acc[ai][bj][m][n][2] + acc[ai][bj][m][n][3];
        if (sacc == 1234.5f) out[(size_t)(u.pm * 256 + wr * 64 + fr) * 1024 + u.pn * 256 + wc * 32 + fq] = sacc;
    }
};
struct MoeOrder {
    const PG8_LAS int* tb; const PG8_LAS int* cnt; int G, c, wv;
    __device__ __forceinline__ bool next(int i, Unit& u) const {
        const int L = i * G + c, ntile = tb[32]; if (L >= ntile * 4) return false;
        const int tile = L >> 2; u.pn = L & 3; int e = 0;
#pragma unroll
        for (int s = 16; s >= 1; s >>= 1) if (__builtin_amdgcn_readfirstlane(tb[e + s]) <= tile) e += s;
        u.e = e; u.pm = tile; const int loc = (tile - __builtin_amdgcn_readfirstlane(tb[e])) * 256; u.cnt = __builtin_amdgcn_readfirstlane(cnt[e]) - loc; return true;
    }
};
struct ProbMoe1 : MoeOrder { const bf16_t* A; const bf16_t* Bt; int K; const unsigned* tokk; static constexpr bool GATHER_A = true; static constexpr bool F8 = false; static constexpr bool LDSGATH = false;
    __device__ __forceinline__ unsigned laneA(int) const { return 0u; }
    __device__ __forceinline__ unsigned laneB(int r) const { return (unsigned)r * 2048u; }
    __device__ __forceinline__ unsigned baseA(const Unit&) const { return 0u; }
    __device__ __forceinline__ unsigned baseB(const Unit& u) const { return (unsigned)(u.e * 1024 + u.pn * 256) * 2048u; }
    __device__ __forceinline__ unsigned gathA(const Unit& u, int r) const { const int loc = (u.pm - __builtin_amdgcn_readfirstlane(tb[u.e])) * 256 + r; const unsigned tk = r < u.cnt ? tokk[(size_t)u.e * LCAP + loc] : 0u; return (tk >> 1) * 2048u; } };
struct EpiMoe1 {
    static constexpr bool TP = false; static constexpr bool PERM = true, PREFETCH = false; bf16_t* hid;
    __device__ __forceinline__ void operator()(const f32x4 (&acc)[2][2][4][2], const Unit& u, int wr, int wc, int fr, int fq, const PG8_LAS float* ex) const {
        const int row0 = u.pm * 256 + wr * 64 + fr, col0 = u.pn * 128 + wc * 32 + 8 * fq;
#pragma unroll
        for (int ai = 0; ai < 2; ++ai)
#pragma unroll
            for (int m = 0; m < 4; ++m) { float hv[8];
#pragma unroll
                for (int n = 0; n < 2; ++n)
#pragma unroll
                    for (int j = 0; j < 4; ++j) { const float g = acc[ai][0][m][n][j], up = acc[ai][1][m][n][j]; hv[n * 4 + j] = g * __builtin_amdgcn_rcpf(1.0f + __expf(-g)) * up; }
                u32x4 w; w.x = cvt_pk_bf16(hv[0], hv[1]); w.y = cvt_pk_bf16(hv[2], hv[3]); w.z = cvt_pk_bf16(hv[4], hv[5]); w.w = cvt_pk_bf16(hv[6], hv[7]);
                *(u32x4*)(hid + (size_t)(row0 + ai * 128 + m * 16) * 512 + col0) = w; }
    }
};
struct ProbMoe2 : MoeOrder { const bf16_t* A; const bf16_t* Bt; int K; static constexpr bool GATHER_A = false; static constexpr bool F8 = false; static constexpr bool LDSGATH = false;
    __device__ __forceinline__ unsigned laneA(int r) const { return (unsigned)r * 1024u; }
    __device__ __forceinline__ unsigned laneB(int r) const { return (unsigned)r * 1024u; }
    __device__ __forceinline__ unsigned baseA(const Unit& u) const { return (unsigned)(u.pm * 256) * 1024u; }
    __device__ __forceinline__ unsigned baseB(const Unit& u) const { return (unsigned)(u.e * 1024 + u.pn * 256) * 1024u; }
    __device__ __forceinline__ unsigned gathA(const Unit&, int) const { return 0u; } };
struct EpiMoe2 {
    static constexpr bool TP = false; static constexpr bool PERM = true, PREFETCH = true; bf16_t* Y; const unsigned* tokk; const float* wl; const PG8_LAS int* tb;
    __device__ __forceinline__ void prefetch(const Unit& u, PG8_LAS unsigned char* ex, int wid, int lane) const {
        const size_t o = (size_t)u.e * LCAP + (u.pm - __builtin_amdgcn_readfirstlane(tb[u.e])) * 256 + lane * 4;
        if (wid == 0) __builtin_amdgcn_global_load_lds((const unsigned*)(tokk + o), (PG8_LAS unsigned*)ex, 16, 0, 0);
        else if (wid == 1) __builtin_amdgcn_global_load_lds((const unsigned*)(wl + o), (PG8_LAS unsigned*)(ex + 1024), 16, 0, 0);
    }
    __device__ __forceinline__ void operator()(const f32x4 (&acc)[2][2][4][2], const Unit& u, int wr, int wc, int fr, int fq, const PG8_LAS float* ex) const {
        const int col0 = u.pn * 256 + wc * 32 + 8 * fq;
#pragma unroll
        for (int ai = 0; ai < 2; ++ai)
#pragma unroll
            for (int m = 0; m < 4; ++m) { const int r = ai * 128 + wr * 64 + m * 16 + fr;
                if (r < u.cnt) { const unsigned tk = __builtin_bit_cast(unsigned, ex[r]); const float w = ex[256 + r];
                    bf16_t* rowp = Y + ((size_t)(tk & 1u) * NTOK + (tk >> 1)) * 1024 + col0;
#pragma unroll
                    for (int bj = 0; bj < 2; ++bj) { const f32x4 v0 = acc[ai][bj][m][0] * w, v1 = acc[ai][bj][m][1] * w;
                        u32x4 q; q.x = cvt_pk_bf16(v0[0], v0[1]); q.y = cvt_pk_bf16(v0[2], v0[3]); q.z = cvt_pk_bf16(v1[0], v1[1]); q.w = cvt_pk_bf16(v1[2], v1[3]);
                        *(u32x4*)(rowp + bj * 128) = q; } } }
    }
};

constexpr int F8_STAGE = 65536, F8_LDS = 2 * F8_STAGE;
template <class Prob, class Epi, int VAR = 0>
__device__ __forceinline__ void gemm_f8(PG8_LAS unsigned char* lds, const Prob& G, const Epi& E) {
    int tid_ = MK_TID(G.wv); asm volatile("" : "+v"(tid_));
    const int tid = tid_, wid = __builtin_amdgcn_readfirstlane(tid >> 6), lane = tid & 63, wr = wid >> 2, wc = wid & 3, fr = lane & 15, fq = lane >> 4;
    const int nt = G.KB >> 7;
    int R0, C0; stage_rc(tid * 16, R0, C0);
    const unsigned cb = (unsigned)C0 * 2u, ldsw = (unsigned)wid * 1024u;
    const int aoff = lds_byte(wr * 64 + fr, fq * 8), boff = (wc >> 1) * 16384 + lds_byte((wc & 1) * 64 + fr, fq * 8);
    const char* Ab = (const char*)G.A; const char* Bb = (const char*)G.Bt;
    Unit cur, nxt;
    if (!G.next(0, cur)) return;
    const unsigned lB00 = G.laneB(R0) + cb, lB01 = G.laneB(R0 + 64) + cb, lB10 = G.laneB(128 + R0) + cb, lB11 = G.laneB(192 + R0) + cb;
    unsigned cA00 = G.rowA(cur, R0) + cb, cA01 = G.rowA(cur, R0 + 64) + cb, cA10 = G.rowA(cur, 128 + R0) + cb, cA11 = G.rowA(cur, 192 + R0) + cb;
    unsigned nA00 = cA00, nA01 = cA01, nA10 = cA10, nA11 = cA11;
    unsigned uBc = G.baseB(cur), uBn = uBc;
#define F8_ISSUE(buf, a00, a01, a10, a11, ub, kb) do { PG8_LAS unsigned char* sb_ = lds + (buf) * F8_STAGE + ldsw; \
        __builtin_amdgcn_global_load_lds((const unsigned*)(Ab + (size_t)((a00) + (kb))), (PG8_LAS unsigned*)(sb_), 16, 0, 0); \
        __builtin_amdgcn_global_load_lds((const unsigned*)(Ab + (size_t)((a01) + (kb))), (PG8_LAS unsigned*)(sb_ + 8192), 16, 0, 0); \
        __builtin_amdgcn_global_load_lds((const unsigned*)(Ab + (size_t)((a10) + (kb))), (PG8_LAS unsigned*)(sb_ + 16384), 16, 0, 0); \
        __builtin_amdgcn_global_load_lds((const unsigned*)(Ab + (size_t)((a11) + (kb))), (PG8_LAS unsigned*)(sb_ + 24576), 16, 0, 0); \
        __builtin_amdgcn_global_load_lds((const unsigned*)(Bb + (size_t)(ub) + (size_t)(lB00 + (kb))), (PG8_LAS unsigned*)(sb_ + 32768), 16, 0, 0); \
        __builtin_amdgcn_global_load_lds((const unsigned*)(Bb + (size_t)(ub) + (size_t)(lB01 + (kb))), (PG8_LAS unsigned*)(sb_ + 40960), 16, 0, 0); \
        __builtin_amdgcn_global_load_lds((const unsigned*)(Bb + (size_t)(ub) + (size_t)(lB10 + (kb))), (PG8_LAS unsigned*)(sb_ + 49152), 16, 0, 0); \
        __builtin_amdgcn_global_load_lds((const unsigned*)(Bb + (size_t)(ub) + (size_t)(lB11 + (kb))), (PG8_LAS unsigned*)(sb_ + 57344), 16, 0, 0); } while (0)
    f32x4 acc[2][4][4];
#pragma unroll
    for (int a = 0; a < 2; ++a)
#pragma unroll
        for (int m = 0; m < 4; ++m)
#pragma unroll
            for (int n = 0; n < 4; ++n) acc[a][m][n] = (f32x4){0.f, 0.f, 0.f, 0.f};
    F8_ISSUE(0, cA00, cA01, cA10, cA11, uBc, 0u);
    int g = 0, ui = 0;
    for (;;) {
        const bool has_next = G.next(ui + 1, nxt);
        if (has_next) { nA00 = G.rowA(nxt, R0) + cb; nA01 = G.rowA(nxt, R0 + 64) + cb; nA10 = G.rowA(nxt, 128 + R0) + cb; nA11 = G.rowA(nxt, 192 + R0) + cb; uBn = G.baseB(nxt); }
        else { nA00 = cA00; nA01 = cA01; nA10 = cA10; nA11 = cA11; uBn = uBc; }
#pragma unroll 1
        for (int kt = 0; kt < nt; ++kt) {
            asm volatile("s_waitcnt vmcnt(0)" ::: "memory");
            __builtin_amdgcn_s_barrier();
            asm volatile("" ::: "memory");
            {
                const bool wrap = kt + 1 >= nt; const unsigned kb = wrap ? 0u : (unsigned)(kt + 1) * 128u;
                const unsigned a00 = wrap ? nA00 : cA00, a01 = wrap ? nA01 : cA01, a10 = wrap ? nA10 : cA10, a11 = wrap ? nA11 : cA11, ub = wrap ? uBn : uBc;
                if (VAR != 2) F8_ISSUE((g + 1) & 1, a00, a01, a10, a11, ub, kb);
            }
            if (VAR == 1) { ++g; continue; }
            PG8_LAS unsigned char* st = lds + (g & 1) * F8_STAGE;
            v8i32 B8[4];
#pragma unroll
            for (int n = 0; n < 4; ++n) { const v4i32 lo = *(const PG8_LAS v4i32*)(st + 32768 + boff + n * 2048), hi = *(const PG8_LAS v4i32*)(st + 32768 + boff + n * 2048 + 1024);
                B8[n] = __builtin_shufflevector(lo, hi, 0, 1, 2, 3, 4, 5, 6, 7); }
#pragma unroll
            for (int ai = 0; ai < 2; ++ai) {
                v8i32 A8[4];
#pragma unroll
                for (int m = 0; m < 4; ++m) { const v4i32 lo = *(const PG8_LAS v4i32*)(st + ai * 16384 + aoff + m * 2048), hi = *(const PG8_LAS v4i32*)(st + ai * 16384 + aoff + m * 2048 + 1024);
                    A8[m] = __builtin_shufflevector(lo, hi, 0, 1, 2, 3, 4, 5, 6, 7); }
                asm volatile("s_waitcnt lgkmcnt(0)" ::: "memory");
                __builtin_amdgcn_s_setprio(1);
#pragma unroll
                for (int m = 0; m < 4; ++m)
#pragma unroll
                    for (int n = 0; n < 4; ++n) acc[ai][m][n] = __builtin_amdgcn_mfma_scale_f32_16x16x128_f8f6f4(B8[n], A8[m], acc[ai][m][n], 0, 0, 0, 0, 0, 0);
                __builtin_amdgcn_s_setprio(0);
            }
            ++g;
        }
        if (VAR == 0) E(acc, cur, wr, wc, fr, fq);
        else if (acc[0][0][0][0] == 1234.5f && acc[1][3][3][3] == 77.0f) E(acc, cur, wr, wc, fr, fq);
        if (!has_next) break;
#pragma unroll
        for (int a = 0; a < 2; ++a)
#pragma unroll
            for (int m = 0; m < 4; ++m)
#pragma unroll
                for (int n = 0; n < 4; ++n) acc[a][m][n] = (f32x4){0.f, 0.f, 0.f, 0.f};
        cur = nxt; ++ui; cA00 = nA00; cA01 = nA01; cA10 = nA10; cA11 = nA11; uBc = uBn;
    }
    asm volatile("s_waitcnt vmcnt(0)" ::: "memory");
    __builtin_amdgcn_s_barrier();
#undef F8_ISSUE
}
struct MoeOrder8 {
    const PG8_LAS int* tb; const PG8_LAS int* cnt; int G, c, wv, rev = 0;
    __device__ __forceinline__ bool next(int i, Unit& u) const {
        const int ntile = __builtin_amdgcn_readfirstlane(tb[32]), xj = c >> 3, per = G >> 2, off = (c & 7) * (G >> 5) + (xj >> 2);
        int tile = i * per + off;
        if (rev) { const int mine = (ntile - off + per - 1) / per;
            if (i >= mine) return false; tile = (mine - 1 - i) * per + off; }
        if (tile >= ntile) return false;
        u.pn = xj & 3; const int e = __builtin_amdgcn_readfirstlane((int)((const PG8_LAS unsigned char*)tb)[512 + tile]);
        u.e = e; u.pm = tile; const int loc = (tile - __builtin_amdgcn_readfirstlane(tb[e])) * 256; u.cnt = __builtin_amdgcn_readfirstlane(cnt[e]) - loc; return true;
    }
};
struct ProbMoe1F8 : MoeOrder8 { const unsigned char* A; const unsigned char* Bt; int KB; const unsigned* tokk;
    __device__ __forceinline__ unsigned laneB(int r) const { return (unsigned)r * 1024u; }
    __device__ __forceinline__ unsigned baseB(const Unit& u) const { return (unsigned)((u.e * 4 + u.pn) * 256) * 1024u; }
    __device__ __forceinline__ unsigned rowA(const Unit& u, int r) const { const int loc = (u.pm - __builtin_amdgcn_readfirstlane(tb[u.e])) * 256 + r; const unsigned tk = r < u.cnt ? tokk[(size_t)u.e * LCAP + loc] : 0u; return (tk >> 1) * 1024u; } };
struct EpiMoe1F8 {
    unsigned char* hid;
    __device__ __forceinline__ void operator()(const f32x4 (&acc)[2][4][4], const Unit& u, int wr, int wc, int fr, int fq) const {
        const int row0 = u.pm * 256 + wr * 64 + fr, col0 = u.pn * 128 + wc * 32 + fq * 8;
#pragma unroll
        for (int ai = 0; ai < 2; ++ai)
#pragma unroll
            for (int m = 0; m < 4; ++m) { u32x2 q;
#pragma unroll
                for (int n2 = 0; n2 < 2; ++n2) { float hv[4];
#pragma unroll
                    for (int j = 0; j < 4; ++j) { const float g = acc[ai][m][n2][j] * 0.03125f, up = acc[ai][m][2 + n2][j] * 0.03125f; hv[j] = g * __builtin_amdgcn_rcpf(1.0f + __expf(-g)) * up; }
                    q[n2] = pk4_fp8(hv[0], hv[1], hv[2], hv[3]); }
                *(u32x2*)(hid + (size_t)(row0 + ai * 128 + m * 16) * 512 + col0) = q; }
    }
};
struct ProbMoe2F8 : MoeOrder8 { const unsigned char* A; const unsigned char* Bt; int KB;
    __device__ __forceinline__ unsigned laneB(int r) const { return (unsigned)r * 512u; }
    __device__ __forceinline__ unsigned baseB(const Unit& u) const { return (unsigned)(u.e * 1024 + u.pn * 256) * 512u; }
    __device__ __forceinline__ unsigned rowA(const Unit& u, int r) const { return (unsigned)(u.pm * 256 + r) * 512u; } };
struct EpiMoe2F8 {
    unsigned char* Y; const unsigned* tokk; const float* wl; const PG8_LAS int* tb;
    __device__ __forceinline__ void operator()(const f32x4 (&acc)[2][4][4], const Unit& u, int wr, int wc, int fr, int fq) const {
        const int col0 = u.pn * 256 + wc * 64 + 16 * fq, locb = (u.pm - __builtin_amdgcn_readfirstlane(tb[u.e])) * 256;
#pragma unroll
        for (int ai = 0; ai < 2; ++ai)
#pragma unroll
            for (int m = 0; m < 4; ++m) { const int r = ai * 128 + wr * 64 + m * 16 + fr;
                if (r < u.cnt) { const unsigned tk = tokk[(size_t)u.e * LCAP + locb + r]; const float w = wl[(size_t)u.e * LCAP + locb + r] * 0.5f;
                    unsigned char* rowp = Y + ((size_t)(tk & 1u) * NTOK + (tk >> 1)) * 1024 + col0;
                    u32x4 q;
#pragma unroll
                    for (int n = 0; n < 4; ++n) { const f32x4 v = acc[ai][m][n] * w; q[n] = pk4_fp8(v[0], v[1], v[2], v[3]); }
                    *(u32x4*)rowp = q; } }
    }
};
struct ProbMoe1P8 : MoeOrder8 { const unsigned char* A; const unsigned char* Bt; int K; const unsigned* tokk; static constexpr bool GATHER_A = true; static constexpr bool F8 = true; static constexpr bool LDSGATH = true;
    __device__ __forceinline__ void prefetchA(const Unit& u, PG8_LAS unsigned char* gb, int wid, int lane) const {
        if (wid == 0) __builtin_amdgcn_global_load_lds((const unsigned*)(tokk + (size_t)u.e * LCAP + (u.pm - __builtin_amdgcn_readfirstlane(tb[u.e])) * 256 + lane * 4), (PG8_LAS unsigned*)gb, 16, 0, 0); }
    __device__ __forceinline__ unsigned gathL(const Unit& u, const PG8_LAS unsigned char* gb, int r) const { const unsigned tk = *(const PG8_LAS unsigned*)(gb + r * 4); return ((r < u.cnt ? tk : 0u) >> 1) * 1024u; }
    __device__ __forceinline__ unsigned laneA(int) const { return 0u; }
    __device__ __forceinline__ unsigned laneB(int r) const { return (unsigned)r * 1024u; }
    __device__ __forceinline__ unsigned baseA(const Unit&) const { return 0u; }
    __device__ __forceinline__ unsigned baseB(const Unit& u) const { return (unsigned)((u.e * 4 + u.pn) * 256) * 1024u; }
    __device__ __forceinline__ unsigned gathA(const Unit& u, int r) const { const int loc = (u.pm - __builtin_amdgcn_readfirstlane(tb[u.e])) * 256 + r; const unsigned tk = r < u.cnt ? tokk[(size_t)u.e * LCAP + loc] : 0u; return (tk >> 1) * 1024u; } };
struct EpiMoe1P8 {
    static constexpr bool TP = false; static constexpr bool PERM = false, PREFETCH = false; unsigned char* hid;
    __device__ __forceinline__ void operator()(const f32x4 (&acc)[2][2][4][2], const Unit& u, int wr, int wc, int fr, int fq, const PG8_LAS float* ex) const {
        const int row0 = u.pm * 256 + wr * 64 + fr, col0 = u.pn * 128 + wc * 32 + 8 * fq;
#pragma unroll
        for (int ai = 0; ai < 2; ++ai)
#pragma unroll
            for (int m = 0; m < 4; ++m) { u32x2 q;
#pragma unroll
                for (int n = 0; n < 2; ++n) { float hv[4];
#pragma unroll
                    for (int j = 0; j < 4; ++j) { const float g = acc[ai][0][m][n][j] * 0.03125f, up = acc[ai][1][m][n][j] * 0.03125f; hv[j] = g * __builtin_amdgcn_rcpf(1.0f + __expf(-g)) * up; }
                    q[n] = pk4_fp8(hv[0], hv[1], hv[2], hv[3]); }
                *(u32x2*)(hid + (size_t)(row0 + ai * 128 + m * 16) * 512 + col0) = q; }
    }
};
struct ProbMoe2P8 : MoeOrder8 { const unsigned char* A; const unsigned char* Bt; int K; static constexpr bool GATHER_A = false; static constexpr bool F8 = true; static constexpr bool LDSGATH = false;
    __device__ __forceinline__ unsigned laneA(int r) const { return (unsigned)r * 512u; }
    __device__ __forceinline__ unsigned laneB(int r) const { return (unsigned)r * 512u; }
    __device__ __forceinline__ unsigned baseA(const Unit& u) const { return (unsigned)(u.pm * 256) * 512u; }
    __device__ __forceinline__ unsigned baseB(const Unit& u) const { return (unsigned)(u.e * 1024 + u.pn * 256) * 512u; }
    __device__ __forceinline__ unsigned gathA(const Unit&, int) const { return 0u; } };
struct EpiMoe2P8 {
    static constexpr bool TP = false; static constexpr bool PERM = false, PREFETCH = true; unsigned char* Y; const unsigned* tokk; const float* wl; const PG8_LAS int* tb; int dry = 0;
    __device__ __forceinline__ void prefetch(const Unit& u, PG8_LAS unsigned char* ex, int wid, int lane) const {
        const size_t o = (size_t)u.e * LCAP + (u.pm - __builtin_amdgcn_readfirstlane(tb[u.e])) * 256 + lane * 4;
        if (wid == 0) __builtin_amdgcn_global_load_lds((const unsigned*)(tokk + o), (PG8_LAS unsigned*)ex, 16, 0, 0);
        else if (wid == 1) __builtin_amdgcn_global_load_lds((const unsigned*)(wl + o), (PG8_LAS unsigned*)(ex + 1024), 16, 0, 0);
    }
    __device__ __forceinline__ void operator()(const f32x4 (&acc)[2][2][4][2], const Unit& u, int wr, int wc, int fr, int fq, const PG8_LAS float* ex) const {
        const int col0 = u.pn * 256 + wc * 64 + 16 * fq;
#pragma unroll
        for (int ai = 0; ai < 2; ++ai)
#pragma unroll
            for (int m = 0; m < 4; ++m) { const int r = ai * 128 + wr * 64 + m * 16 + fr;
                if (r < u.cnt && (!dry || ex[256 + r] == 1234.5f)) { const unsigned tk = __builtin_bit_cast(unsigned, ex[r]); const float w = ex[256 + r] * 0.5f;
                    unsigned char* rowp = Y + ((size_t)(tk & 1u) * NTOK + (tk >> 1)) * 1024 + col0;
                    u32x4 q;
#pragma unroll
                    for (int bj = 0; bj < 2; ++bj)
#pragma unroll
                        for (int n = 0; n < 2; ++n) { const f32x4 v = acc[ai][bj][m][n] * w; q[bj * 2 + n] = pk4_fp8(v[0], v[1], v[2], v[3]); }
                    *(u32x4*)rowp = q; } }
    }
};
}
#endif

DEV void phase2_ctx(const Params& P, unsigned char* sm) {
    PHASE_TID;
    const bf16_t* hc = (const bf16_t*)(P.ws + WS_R4 + R4_H) + (size_t)NTOK * 1024;
    const bf16_t* wq = (const bf16_t*)(P.ws + WS_WQKVZ);
    bf16_t* pc = (bf16_t*)(P.ws + WS_R4 + R4_P) + (size_t)NTOK * 2048;
    const float* rstd = (const float*)(P.ws + WS_RSTD) + NTOK; const float* bias = (const float*)(P.ws + WS_BIAS) + 8 * 3072;
    const int wid = TID >> 6, lane = TID & 63, fr = lane & 15, fq = lane >> 4;
    float* red = (float*)sm;
    for (int t = BID; t < 256; t += NBLK) {
        const int rt = t >> 4, ct = t & 15, n = wid & 3, kh = wid >> 2;
        const bf16_t* arow = hc + (size_t)(rt * 16 + fr) * 1024 + kh * 512 + fq * 8;
        const bf16_t* brow = wq + (size_t)(512 + ct * 64 + n * 16 + fr) * 1024 + kh * 512 + fq * 8;
        f32x4 acc = (f32x4){0.f, 0.f, 0.f, 0.f};
#pragma unroll
        for (int half = 0; half < 2; ++half) {
            u32x4 a[8], b[8];
#pragma unroll
            for (int ks = 0; ks < 8; ++ks) { a[ks] = *(const u32x4*)(arow + (half * 8 + ks) * 32); b[ks] = *(const u32x4*)(brow + (half * 8 + ks) * 32); }
#pragma unroll
            for (int ks = 0; ks < 8; ++ks) acc = mfma16(__builtin_bit_cast(bf16x8, b[ks]), __builtin_bit_cast(bf16x8, a[ks]), acc);
        }
        if (TID < 64) *(u32x4*)(pc + (size_t)t * 2048 + TID * 8) = (u32x4){0u, 0u, 0u, 0u};
        SYNC();
        if (kh == 1) *(f32x4*)(red + (n * 64 + lane) * 4) = acc;
        SYNC();
        if (kh == 0) { const f32x4 o = *(const f32x4*)(red + (n * 64 + lane) * 4); const int row = rt * 16 + fr, col = 512 + ct * 64 + n * 16 + 4 * fq;
            const float rs = rstd[row]; const f32x4 bv = *(const f32x4*)(bias + col);
            u32x2 w; w[0] = pk2((acc[0] + o[0]) * rs + bv[0], (acc[1] + o[1]) * rs + bv[1]); w[1] = pk2((acc[2] + o[2]) * rs + bv[2], (acc[3] + o[3]) * rs + bv[3]);
            *(u32x2*)(pc + (size_t)row * 2048 + col) = w; }
    }
    SYNC();
}

DEV void conv_row_compute(const Params& P, const bf16_t* ring, const float* wts, int s0, int s1, int s2, int ntap_rows, int slab, bf16_t* dst, int tid) {
    const int cq = tid & 31, tg = tid >> 5;
    typedef float f32x2 __attribute__((ext_vector_type(2)));
    f32x2 acc2[4][2];
#pragma unroll
    for (int t = 0; t < 4; ++t) { acc2[t][0] = (f32x2){0.f, 0.f}; acc2[t][1] = (f32x2){0.f, 0.f}; }
#pragma unroll
    for (int ky = 0; ky < 3; ++ky) {
        if (ntap_rows == 1 && ky != 1) continue;
        const int sl = ky == 0 ? s0 : ky == 1 ? s1 : s2;
        f32x2 w[3][2];
#pragma unroll
        for (int kx = 0; kx < 3; ++kx) { const f32x4 t = *(const f32x4*)(wts + (ky * 3 + kx) * 128 + cq * 4); w[kx][0] = (f32x2){t[0], t[1]}; w[kx][1] = (f32x2){t[2], t[3]}; }
        f32x2 in[6][2];
#pragma unroll
        for (int pos = 0; pos < 6; ++pos) { const u32x2 v = *(const u32x2*)(ring + sl * 8448 + (tg * 4 + pos) * 128 + cq * 4);
            in[pos][0] = (f32x2){__builtin_bit_cast(float, v[0] << 16), __builtin_bit_cast(float, v[0] & 0xffff0000u)}; in[pos][1] = (f32x2){__builtin_bit_cast(float, v[1] << 16), __builtin_bit_cast(float, v[1] & 0xffff0000u)}; }
#pragma unroll
        for (int t = 0; t < 4; ++t)
#pragma unroll
            for (int kx = 0; kx < 3; ++kx) { acc2[t][0] += w[kx][0] * in[t + kx][0]; acc2[t][1] += w[kx][1] * in[t + kx][1]; }
    }
    float acc[4][4];
#pragma unroll
    for (int t = 0; t < 4; ++t) { acc[t][0] = acc2[t][0][0]; acc[t][1] = acc2[t][0][1]; acc[t][2] = acc2[t][1][0]; acc[t][3] = acc2[t][1][1]; }
#pragma unroll
    for (int t = 0; t < 4; ++t) {
        float ss = 0.f;
#pragma unroll
        for (int c = 0; c < 4; ++c) { acc[t][c] = silu_f(acc[t][c]); ss += acc[t][c] * acc[t][c]; }
        if (slab < 8) { ss += shfl_xor_f(ss, 1); ss += shfl_xor_f(ss, 2); ss += shfl_xor_f(ss, 4); ss += shfl_xor_f(ss, 8); ss += shfl_xor_f(ss, 16); const float sc = rsq_f(ss + EPS);
#pragma unroll
            for (int c = 0; c < 4; ++c) acc[t][c] *= sc; }
        u32x2 o; o[0] = pk2(acc[t][0], acc[t][1]); o[1] = pk2(acc[t][2], acc[t][3]);
        *(u32x2*)(dst + (size_t)(tg * 4 + t) * 1536 + cq * 4) = o;
    }
}

DEV void phase3_conv(const Params& P, unsigned char* sm) {
    PHASE_TID;
    const bf16_t* p = (const bf16_t*)(P.ws + WS_R4 + R4_P);
    bf16_t* qkvn = (bf16_t*)(P.ws + WS_R3);
    bf16_t* ring = (bf16_t*)sm;
    float* wts = (float*)(sm + 3 * 16896);
    const u32x4 zero4 = (u32x4){0u, 0u, 0u, 0u};
    for (int it = BID; it < NB * 12 * 8; it += NBLK) {
        const int slab = it % 12, yb = (it / 12) & 7, b = it / 96, y0 = yb * 16;
        const bf16_t* src = p + (size_t)(b * SEQ) * 2048 + slab * 128;
        if (TID < 96) { const int sl = TID / 32, w = TID & 31, cc = (w >> 4) * 65, pc = w & 15; *(u32x4*)(ring + sl * 8448 + cc * 128 + pc * 8) = zero4; }
        if (TID < 288) *(f32x4*)(wts + TID * 4) = *(const f32x4*)(P.conv_w + (size_t)(TID >> 5) * 1536 + slab * 128 + (TID & 31) * 4);
        const int tk0 = TID >> 4, pc = TID & 15;
        u32x4 rr[4][2];
#define CV_LOAD(set, y) do { const bool ok_ = (y) >= 0 && (y) < 128; const int yc_ = ok_ ? (y) : y0;        \
            const u32x4 t0_ = *(const u32x4*)(src + (size_t)(yc_ * 64 + tk0) * 2048 + pc * 8), t1_ = *(const u32x4*)(src + (size_t)(yc_ * 64 + tk0 + 32) * 2048 + pc * 8); \
            rr[set][0] = ok_ ? t0_ : zero4; rr[set][1] = ok_ ? t1_ : zero4; } while (0)
#define CV_STORE(set, slot) do { *(u32x4*)(ring + (slot) * 8448 + (tk0 + 1) * 128 + pc * 8) = rr[set][0]; *(u32x4*)(ring + (slot) * 8448 + (tk0 + 33) * 128 + pc * 8) = rr[set][1]; } while (0)
        CV_LOAD(0, y0 - 1); CV_LOAD(1, y0); CV_LOAD(2, y0 + 1); CV_LOAD(3, y0 + 2);
        CV_STORE(0, 0); CV_STORE(1, 1);
        CV_LOAD(0, y0 + 3);
#pragma unroll 1
        for (int y4 = 0; y4 < 16; y4 += 4) {
#pragma unroll
            for (int u = 0; u < 4; ++u) {
                const int yy = y4 + u;
                const int s0 = yy % 3, s1 = (yy + 1) % 3, s2 = (yy + 2) % 3;
                CV_STORE((u + 2) & 3, s2);
                SYNC();
                CV_LOAD((u + 1) & 3, (yy + 4 <= 16) ? y0 + yy + 4 : 999);
                conv_row_compute(P, ring, wts, s0, s1, s2, 3, slab, qkvn + (size_t)(b * SEQ + (y0 + yy) * 64) * 1536 + slab * 128, TID);
                SYNC();
            }
        }
#undef CV_LOAD
#undef CV_STORE
    }
    for (int it = BID; it < NB * 12 * 4; it += NBLK) {
        const int slab = it % 12, sg = (it / 12) & 3, b = it / 48;
        const bf16_t* src = p + (size_t)(NTOK + b * CTX) * 2048 + slab * 128;
        if (TID < 288) *(f32x4*)(wts + TID * 4) = *(const f32x4*)(P.conv_w + (size_t)(TID >> 5) * 1536 + slab * 128 + (TID & 31) * 4);
        u32x4 r[3];
#pragma unroll
        for (int q = 0; q < 3; ++q) { const int idx = TID + q * 512; r[q] = zero4;
            if (idx < 66 * 16) { const int cc = idx >> 4, pc = idx & 15, tok = sg * 64 + cc - 1; if (tok >= 0 && tok < CTX) r[q] = *(const u32x4*)(src + (size_t)tok * 2048 + pc * 8); } }
#pragma unroll
        for (int q = 0; q < 3; ++q) { const int idx = TID + q * 512; if (idx < 66 * 16) { const int cc = idx >> 4, pc = idx & 15; *(u32x4*)(ring + 1 * 8448 + cc * 128 + pc * 8) = r[q]; } }
        SYNC();
        conv_row_compute(P, ring, wts, 0, 1, 2, 1, slab, qkvn + (size_t)(NTOK + b * CTX + sg * 64) * 1536 + slab * 128, TID);
        SYNC();
    }
}

constexpr int L_K = 0, L_Q = 17408, L_V = 34816, L_KTR = 52224, L_VT = 70656, L_X0F = 89088, L_X0TF = 98304, L_TTF = 107520, L_X0B = 116736, L_X0TB = 125952, L_TTB = 135168, L_GC = 144384, L_SCAL = 161824;
constexpr int L_X1F = 0, L_X1TF = 9216, L_X1B = 18432, L_X1TB = 27648, L_WF = 0, L_WB = 17408, L_AF = 145440, L_AB = 153632;

DEV int chunk_row(int chain, int step, int i) {
    const int b = chain >> 3, dir = chain & 1;
    if (step < 4) { const int pos = step * 64 + i; return NTOK + b * CTX + (dir ? (CTX - 1 - pos) : pos); }
    const int pos = (step - 4) * 64 + i; return b * SEQ + (dir ? (SEQ - 1 - pos) : pos);
}

DEV int img_piece_A(int row, int col0) { return (((row >> 4) * 2 + (col0 >> 5)) * 64 + ((col0 & 31) >> 3) * 16 + (row & 15)) * 16 + ((col0 >> 2) & 1) * 8; }
DEV int img_piece_W(int row, int d0) { return (((row >> 4) * 4 + (d0 >> 5)) * 64 + ((d0 & 31) >> 3) * 16 + (row & 15)) * 16; }

DEV void phase4_prepass(const Params& P, unsigned char* sm) {
    PHASE_TID;
    const bf16_t* qkvn = (const bf16_t*)(P.ws + WS_R3);
    const float* gb = (const float*)(P.ws + WS_GB);
    unsigned char* images = P.ws + WS_R4;
    bf16_t* Ks = (bf16_t*)(sm + L_K); bf16_t* Qs = (bf16_t*)(sm + L_Q); bf16_t* Vs = (bf16_t*)(sm + L_V); bf16_t* KTR = (bf16_t*)(sm + L_KTR); bf16_t* VT = (bf16_t*)(sm + L_VT);
    float* gcf = (float*)(sm + L_GC); float* gcb = gcf + 64; float* btf = gcf + 128; float* btb = gcf + 192;
    const float QSCALE = 0.08838834764831845f;
    const f32x4 z4 = (f32x4){0.f, 0.f, 0.f, 0.f};
    u32x4 pf[6]; float gfp, bfp, gbp, bbp, gbr;
#define PP_ROW0(it_) ((((it_) % NSTEP) < 4) ? NTOK + ((it_) / NSTEP / 4) * CTX + ((it_) % NSTEP) * 64 : ((it_) / NSTEP / 4) * SEQ + (((it_) % NSTEP) - 4) * 64)
#define PP_LOAD(it_) do { const int row0_ = PP_ROW0(it_), h_ = ((it_) / NSTEP) & 3; \
        _Pragma("unroll") for (int q = 0; q < 6; ++q) { const int idx = TID + q * 512, piece = idx & 15, i = (idx >> 4) & 63, which = idx >> 10; \
            pf[q] = *(const u32x4*)(qkvn + (size_t)(row0_ + i) * 1536 + which * 512 + h_ * 128 + piece * 8); } \
        { const int ln_ = TID & 63; const float* gr = gb + (size_t)(row0_ + ln_) * 16; gfp = gr[8 + h_]; bfp = gr[h_]; gbp = gr[12 + h_]; bbp = gr[4 + h_]; gbr = gb[(size_t)(row0_ + 63 - ln_) * 16 + 12 + h_]; } } while (0)
    const int NIT = NB * 4 * NSTEP;
    int it = BID;
    if (it < NIT) PP_LOAD(it);
    for (; it < NIT; it += NBLK) {
        int tq_ = TID;
#ifndef CPU_EMU
        asm volatile("" : "+v"(tq_));
#endif
        const int wid = tq_ >> 6, lane = tq_ & 63, fr = lane & 15, fq = lane >> 4;
        const int bh = it / NSTEP, st = it - bh * NSTEP;
        const int stb = st < 4 ? 3 - st : 4 + (127 - (st - 4));
        unsigned char* imgf = images + ((size_t)(bh * 2) * NSTEP + st) * IMG_BYTES;
        unsigned char* imgb = images + ((size_t)(bh * 2 + 1) * NSTEP + stb) * IMG_BYTES;
#pragma unroll
        for (int q = 0; q < 6; ++q) { const int idx = TID + q * 512, piece = idx & 15, i = (idx >> 4) & 63, which = idx >> 10;
            *(u32x4*)((which == 0 ? Qs : which == 1 ? Ks : Vs) + i * 136 + piece * 8) = pf[q]; }
        if (wid == 0) { float g = gfp;
#pragma unroll
            for (int o = 1; o < 64; o <<= 1) { const float t = shfl_up_f(g, o); if (lane >= o) g += t; }
            gcf[lane] = g; btf[lane] = bfp; }
        if (wid == 1) { float g = gbr;
#pragma unroll
            for (int o = 1; o < 64; o <<= 1) { const float t = shfl_up_f(g, o); if (lane >= o) g += t; }
            gcb[63 - lane] = g; btb[lane] = bbp; }
        { const int nx = (it + NBLK < NIT) ? it + NBLK : it; PP_LOAD(nx); }
        SYNC();
        const float glf = gcf[63], glb = gcb[0];
        bf16_t* X0F = (bf16_t*)(sm + L_X0F); bf16_t* X0TF = (bf16_t*)(sm + L_X0TF); bf16_t* TTF = (bf16_t*)(sm + L_TTF);
        bf16_t* X0B = (bf16_t*)(sm + L_X0B); bf16_t* X0TB = (bf16_t*)(sm + L_X0TB); bf16_t* TTB = (bf16_t*)(sm + L_TTB);
        f32x4 TregF[2], TTregF[2], TregB[2], TTregB[2];
#pragma unroll
        for (int tt = 0; tt < 2; ++tt) {
            const int t = wid * 2 + tt, ti = t >> 2, tj = t & 3;
            f32x4 kk = z4, kkT = z4, qkT = z4;
#pragma unroll
            for (int ks = 0; ks < 4; ++ks) {
                const bf16x8 fKi = frag16(Ks + (ti * 16 + fr) * 136 + ks * 32 + fq * 8), fKj = frag16(Ks + (tj * 16 + fr) * 136 + ks * 32 + fq * 8), fQi = frag16(Qs + (ti * 16 + fr) * 136 + ks * 32 + fq * 8);
                kk = mfma16(fKi, fKj, kk); kkT = mfma16(fKj, fKi, kkT); qkT = mfma16(fKj, fQi, qkT);
            }
            {
              const int j = tj * 16 + fr; const float gfj = gcf[j], gbj = gcb[j]; float mf[4], mb_[4];
#pragma unroll
              for (int r = 0; r < 4; ++r) { const int i = ti * 16 + fq * 4 + r;
                  const float ef = __expf(fminf(gcf[i] - gfj, 0.f)) * btf[i] * kk[r], eb = __expf(fminf(gcb[i] - gbj, 0.f)) * btb[i] * kk[r];
                  mf[r] = (i > j) ? ef : 0.f; TregF[tt][r] = (i == j ? 1.0f : 0.0f) - mf[r];
                  mb_[r] = (i < j) ? eb : 0.f; TregB[tt][r] = (i == j ? 1.0f : 0.0f) - mb_[r]; }
              u32x2 w; const int o_ = j * 72 + ti * 16 + fq * 4;
              w[0] = pk2(mf[0], mf[1]); w[1] = pk2(mf[2], mf[3]); *(u32x2*)(X0TF + o_) = w;
              w[0] = pk2(TregF[tt][0], TregF[tt][1]); w[1] = pk2(TregF[tt][2], TregF[tt][3]); *(u32x2*)(TTF + o_) = w;
              w[0] = pk2(mb_[0], mb_[1]); w[1] = pk2(mb_[2], mb_[3]); *(u32x2*)(X0TB + o_) = w;
              w[0] = pk2(TregB[tt][0], TregB[tt][1]); w[1] = pk2(TregB[tt][2], TregB[tt][3]); *(u32x2*)(TTB + o_) = w; }
            SCHED_FENCE();
            {
              const int i = ti * 16 + fr, j0 = tj * 16 + fq * 4; const float gfi = gcf[i], gbi = gcb[i], bfi = btf[i], bbi = btb[i]; float mf[4], af[4], mb_[4], ab[4];
#pragma unroll
              for (int r = 0; r < 4; ++r) { const int j = j0 + r;
                  const float ef = __expf(fminf(gfi - gcf[j], 0.f)), eb = __expf(fminf(gbi - gcb[j], 0.f));
                  const float df = (i >= j) ? ef : 0.f, db = (i <= j) ? eb : 0.f;
                  mf[r] = (i > j) ? bfi * kkT[r] * ef : 0.f; TTregF[tt][r] = (i == j ? 1.0f : 0.0f) - mf[r]; af[r] = qkT[r] * QSCALE * df;
                  mb_[r] = (i < j) ? bbi * kkT[r] * eb : 0.f; TTregB[tt][r] = (i == j ? 1.0f : 0.0f) - mb_[r]; ab[r] = qkT[r] * QSCALE * db; }
              u32x2 w; const int o_ = i * 72 + j0;
              w[0] = pk2(mf[0], mf[1]); w[1] = pk2(mf[2], mf[3]); *(u32x2*)(X0F + o_) = w;
              w[0] = pk2(mb_[0], mb_[1]); w[1] = pk2(mb_[2], mb_[3]); *(u32x2*)(X0B + o_) = w;
              w[0] = pk2(af[0], af[1]); w[1] = pk2(af[2], af[3]); *(u32x2*)((bf16_t*)(sm + L_AF) + i * 64 + j0) = w;
              w[0] = pk2(ab[3], ab[2]); w[1] = pk2(ab[1], ab[0]); *(u32x2*)((bf16_t*)(sm + L_AB) + (63 - i) * 64 + 60 - j0) = w; }
            SCHED_FENCE();
        }
        if (TID < 64) { float* sf = (float*)(sm + L_SCAL), *sb = (float*)(sm + L_SCAL + 288);
            sf[4 + TID] = QSCALE * __expf(gcf[TID]); sb[4 + TID] = QSCALE * __expf(gcb[63 - TID]); }
        {
            const int dcol = wid * 16 + fr, ks = wid >> 1;
            bf16x8 idf;
#pragma unroll
            for (int j = 0; j < 8; ++j) idf[j] = (dcol == ks * 32 + fq * 8 + j) ? (short)0x3F80 : (short)0;
#pragma unroll
            for (int t4 = 0; t4 < 4; ++t4) {
                const f32x4 kt = mfma16(frag16(Ks + (t4 * 16 + fr) * 136 + ks * 32 + fq * 8), idf, z4);
                const f32x4 vt = mfma16(frag16(Vs + (t4 * 16 + fr) * 136 + ks * 32 + fq * 8), idf, z4);
                const int tok = t4 * 16 + fq * 4;
                u32x2 w; w[0] = pk2(kt[0], kt[1]); w[1] = pk2(kt[2], kt[3]); *(u32x2*)(KTR + dcol * 72 + tok) = w;
                w[0] = pk2(vt[0], vt[1]); w[1] = pk2(vt[2], vt[3]); *(u32x2*)(VT + dcol * 72 + tok) = w;
                SCHED_FENCE();
            }
        }
        SYNC();
#pragma unroll 1
        for (int s5 = 0; s5 < 5; ++s5) {
            const bf16_t* PcF = (bf16_t*)(sm + ((s5 & 1) ? L_X1F : L_X0F)); const bf16_t* PcTF = (bf16_t*)(sm + ((s5 & 1) ? L_X1TF : L_X0TF));
            bf16_t* PnF = (bf16_t*)(sm + ((s5 & 1) ? L_X0F : L_X1F)); bf16_t* PnTF = (bf16_t*)(sm + ((s5 & 1) ? L_X0TF : L_X1TF));
            const bf16_t* PcB = (bf16_t*)(sm + ((s5 & 1) ? L_X1B : L_X0B)); const bf16_t* PcTB = (bf16_t*)(sm + ((s5 & 1) ? L_X1TB : L_X0TB));
            bf16_t* PnB = (bf16_t*)(sm + ((s5 & 1) ? L_X0B : L_X1B)); bf16_t* PnTB = (bf16_t*)(sm + ((s5 & 1) ? L_X0TB : L_X1TB));
#pragma unroll
            for (int tt = 0; tt < 2; ++tt) {
                const int t = wid * 2 + tt, ti = t >> 2, tj = t & 3;
                f32x4 p2 = z4, p2T = z4, q2 = z4, q2T = z4;
#pragma unroll
                for (int ks = 0; ks < 2; ++ks) { const int oa = (ti * 16 + fr) * 72 + ks * 32 + fq * 8, ob = (tj * 16 + fr) * 72 + ks * 32 + fq * 8;
                    const bf16x8 a = frag16(PcF + oa), b = frag16(PcTF + ob), c = frag16(PcB + oa), d = frag16(PcTB + ob);
                    p2 = mfma16(a, b, p2); p2T = mfma16(b, a, p2T); q2 = mfma16(c, d, q2); q2T = mfma16(d, c, q2T); }
                u32x2 w; const int oT = (tj * 16 + fr) * 72 + ti * 16 + fq * 4, oN = (ti * 16 + fr) * 72 + tj * 16 + fq * 4;
                w[0] = pk2(p2[0], p2[1]); w[1] = pk2(p2[2], p2[3]); *(u32x2*)(PnTF + oT) = w;
                w[0] = pk2(p2T[0], p2T[1]); w[1] = pk2(p2T[2], p2T[3]); *(u32x2*)(PnF + oN) = w;
                w[0] = pk2(q2[0], q2[1]); w[1] = pk2(q2[2], q2[3]); *(u32x2*)(PnTB + oT) = w;
                w[0] = pk2(q2T[0], q2T[1]); w[1] = pk2(q2T[2], q2T[3]); *(u32x2*)(PnB + oN) = w;
            }
            SYNC();
#pragma unroll
            for (int tt = 0; tt < 2; ++tt) {
                const int t = wid * 2 + tt, ti = t >> 2, tj = t & 3;
#pragma unroll
                for (int ks = 0; ks < 2; ++ks) { const int oa = (ti * 16 + fr) * 72 + ks * 32 + fq * 8, ob = (tj * 16 + fr) * 72 + ks * 32 + fq * 8;
                    const bf16x8 a = frag16(PnF + oa), b = frag16(TTF + ob), c = frag16(PnB + oa), d = frag16(TTB + ob);
                    TregF[tt] = mfma16(a, b, TregF[tt]); TTregF[tt] = mfma16(b, a, TTregF[tt]); TregB[tt] = mfma16(c, d, TregB[tt]); TTregB[tt] = mfma16(d, c, TTregB[tt]); }
            }
            SYNC();
            if (s5 < 4) {
#pragma unroll
                for (int tt = 0; tt < 2; ++tt) { const int t = wid * 2 + tt, ti = t >> 2, tj = t & 3, oT = (tj * 16 + fr) * 72 + ti * 16 + fq * 4;
                    u32x2 w; w[0] = pk2(TregF[tt][0], TregF[tt][1]); w[1] = pk2(TregF[tt][2], TregF[tt][3]); *(u32x2*)(TTF + oT) = w;
                    w[0] = pk2(TregB[tt][0], TregB[tt][1]); w[1] = pk2(TregB[tt][2], TregB[tt][3]); *(u32x2*)(TTB + oT) = w; }
            }
        }
#pragma unroll
        for (int tt = 0; tt < 2; ++tt) {
            const int t = wid * 2 + tt, ti = t >> 2, tj = t & 3, i = ti * 16 + fr, j0 = tj * 16 + fq * 4;
            const f32x4 bq = *(const f32x4*)(btf + j0), gq = *(const f32x4*)(gcf + j0), cq = *(const f32x4*)(btb + j0), hq = *(const f32x4*)(gcb + j0);
            float tu[4], tw[4], su[4], sw[4];
#pragma unroll
            for (int r = 0; r < 4; ++r) { tu[r] = TTregF[tt][r] * bq[r]; tw[r] = tu[r] * __expf(gq[r]); su[r] = TTregB[tt][r] * cq[r]; sw[r] = su[r] * __expf(hq[r]); }
            u32x2 w; const int o_ = i * 72 + j0;
            w[0] = pk2(tu[0], tu[1]); w[1] = pk2(tu[2], tu[3]); *(u32x2*)(X0F + o_) = w;
            w[0] = pk2(tw[0], tw[1]); w[1] = pk2(tw[2], tw[3]); *(u32x2*)(X0TF + o_) = w;
            w[0] = pk2(su[0], su[1]); w[1] = pk2(su[2], su[3]); *(u32x2*)(X0B + o_) = w;
            w[0] = pk2(sw[0], sw[1]); w[1] = pk2(sw[2], sw[3]); *(u32x2*)(X0TB + o_) = w;
        }
        if (TID == 0) { float* scp = (float*)(sm + L_SCAL); scp[0] = __expf(glf); scp[1] = 0.f; scp[2] = 0.f; scp[3] = 0.f; scp[72] = __expf(glb); scp[73] = 0.f; scp[74] = 0.f; scp[75] = 0.f; }
        SYNC();
        bf16_t* WF = (bf16_t*)(sm + L_WF); bf16_t* WB = (bf16_t*)(sm + L_WB);
#pragma unroll
        for (int i4 = 0; i4 < 4; ++i4) {
            f32x4 uf = z4, wf = z4, ub = z4, wb = z4;
#pragma unroll
            for (int ks = 0; ks < 2; ++ks) {
                const bf16x8 av = frag16(VT + (32 * (wid >> 1) + 8 * (fr >> 2) + 4 * (wid & 1) + (fr & 3)) * 72 + ks * 32 + fq * 8), ak = frag16(KTR + (wid * 16 + fr) * 72 + ks * 32 + fq * 8);
                const int ot = (i4 * 16 + fr) * 72 + ks * 32 + fq * 8;
                uf = mfma16(frag16(X0F + ot), av, uf); wf = mfma16(ak, frag16(X0TF + ot), wf); ub = mfma16(frag16(X0B + ot), av, ub); wb = mfma16(ak, frag16(X0TB + ot), wb);
            }
            u32x2 w; w[0] = pk2(uf[0], uf[1]); w[1] = pk2(uf[2], uf[3]); *(u32x2*)(imgf + IMG_U + ((wid * 4 + i4) * 64 + lane) * 8) = w;
            w[0] = pk2(ub[3], ub[2]); w[1] = pk2(ub[1], ub[0]); *(u32x2*)(imgb + IMG_U + ((wid * 4 + (3 - i4)) * 64 + (3 - fq) * 16 + fr) * 8) = w;
            const int i = i4 * 16 + fr, c = wid * 16 + fq * 4;
            w[0] = pk2(wf[0], wf[1]); w[1] = pk2(wf[2], wf[3]); *(u32x2*)(WF + i * 136 + c) = w;
            w[0] = pk2(wb[0], wb[1]); w[1] = pk2(wb[2], wb[3]); *(u32x2*)(WB + (63 - i) * 136 + c) = w;
        }
        SYNC();
#pragma unroll
        for (int q = 0; q < 5; ++q) { int pc = TID + q * 512; pc = pc < 2082 ? pc : 2081;
            const int sp = pc - 2048, dirb = pc >= 2048 ? (sp >= 17) : (pc >> 10), p = pc & 1023, mt = p >> 8, ks = (p >> 6) & 3, ln = p & 63;
            const int so = pc >= 2048 ? L_SCAL + dirb * 288 + (sp - dirb * 17) * 16 : (dirb ? L_WB : L_WF) + ((mt * 16 + (ln & 15)) * 136 + ks * 32 + (ln >> 4) * 8) * 2;
            const int dofs = pc >= 2048 ? IMG_SC + (sp - dirb * 17) * 16 : IMG_W + p * 16;
            *(u32x4*)((dirb ? imgb : imgf) + dofs) = *(const u32x4*)(sm + so); }
#pragma unroll
        for (int q = 0; q < 2; ++q) { const int p = TID + q * 512, d = (p >> 7) * 16 + (p & 15), p0 = ((p >> 6) & 1) * 32 + ((p >> 4) & 3) * 8;
            { const u32x4 v = *(const u32x4*)(KTR + d * 72 + p0); const f32x4 g0 = *(const f32x4*)(gcf + p0), g1 = *(const f32x4*)(gcf + p0 + 4); u32x4 o;
              o[0] = pk2(__builtin_bit_cast(float, v[0] << 16) * __expf(glf - g0[0]), __builtin_bit_cast(float, v[0] & 0xffff0000u) * __expf(glf - g0[1]));
              o[1] = pk2(__builtin_bit_cast(float, v[1] << 16) * __expf(glf - g0[2]), __builtin_bit_cast(float, v[1] & 0xffff0000u) * __expf(glf - g0[3]));
              o[2] = pk2(__builtin_bit_cast(float, v[2] << 16) * __expf(glf - g1[0]), __builtin_bit_cast(float, v[2] & 0xffff0000u) * __expf(glf - g1[1]));
              o[3] = pk2(__builtin_bit_cast(float, v[3] << 16) * __expf(glf - g1[2]), __builtin_bit_cast(float, v[3] & 0xffff0000u) * __expf(glf - g1[3]));
              *(u32x4*)(imgf + IMG_KT + p * 16) = o; }
            { const int t0 = 56 - p0;
              const u32x4 v = *(const u32x4*)(KTR + d * 72 + t0); const f32x4 g0 = *(const f32x4*)(gcb + t0), g1 = *(const f32x4*)(gcb + t0 + 4); u32x4 o;
              o[0] = pk2(__builtin_bit_cast(float, v[3] & 0xffff0000u) * __expf(glb - g1[3]), __builtin_bit_cast(float, v[3] << 16) * __expf(glb - g1[2]));
              o[1] = pk2(__builtin_bit_cast(float, v[2] & 0xffff0000u) * __expf(glb - g1[1]), __builtin_bit_cast(float, v[2] << 16) * __expf(glb - g1[0]));
              o[2] = pk2(__builtin_bit_cast(float, v[1] & 0xffff0000u) * __expf(glb - g0[3]), __builtin_bit_cast(float, v[1] << 16) * __expf(glb - g0[2]));
              o[3] = pk2(__builtin_bit_cast(float, v[0] & 0xffff0000u) * __expf(glb - g0[1]), __builtin_bit_cast(float, v[0] << 16) * __expf(glb - g0[0]));
              *(u32x4*)(imgb + IMG_KT + p * 16) = o; } }
        { const int p = TID, row = (p >> 7) * 16 + (p & 15), c0 = ((p >> 6) & 1) * 32 + ((p >> 4) & 3) * 8;
          *(u32x4*)(imgf + IMG_A + p * 16) = *(const u32x4*)((const bf16_t*)(sm + L_AF) + row * 64 + c0);
          *(u32x4*)(imgb + IMG_A + p * 16) = *(const u32x4*)((const bf16_t*)(sm + L_AB) + row * 64 + c0); }
        SYNC();
    }
#undef PP_LOAD
#undef PP_ROW0
}

DEV void phase4_fft(const Params& P, unsigned char* sm) {
    PHASE_TID;
    const bf16_t* GT = (const bf16_t*)((const unsigned char*)P.out + DO_GT);
    bf16_t* ZT = (bf16_t*)((unsigned char*)P.out + DO_ZT);
    const bf16_t* tab = (const bf16_t*)(P.ws + WS_TAB);
    bf16_t* YR = (bf16_t*)sm; bf16_t* YI = YR + 64 * 136;
    const int wid = TID >> 6, lane = TID & 63, fr = lane & 15, fq = lane >> 4;
    bf16x8 c64[4][2], s64[4][2], c128[4], s128[4];
#pragma unroll
    for (int nt = 0; nt < 4; ++nt)
#pragma unroll
        for (int ks = 0; ks < 2; ++ks) { c64[nt][ks] = frag16(tab + (nt * 16 + fr) * 64 + ks * 32 + fq * 8); s64[nt][ks] = frag16(tab + 4096 + (nt * 16 + fr) * 64 + ks * 32 + fq * 8); }
#pragma unroll
    for (int ks = 0; ks < 4; ++ks) { c128[ks] = frag16(tab + 8192 + (wid * 16 + fr) * 128 + ks * 32 + fq * 8); s128[ks] = frag16(tab + 8192 + 16384 + (wid * 16 + fr) * 128 + ks * 32 + fq * 8); }
    bf16x8 far[2][2], fai[2][2];
#define FFT_LOAD(set, it_) do { const int itc_ = (it_) < 512 * NB ? (it_) : BID; const int cp_ = itc_ >> 3, b_ = itc_ & 7; \
        const bf16_t* gr_ = GT + (size_t)cp_ * NTOK + b_ * SEQ; const bf16_t* gi_ = GT + (size_t)(512 + cp_) * NTOK + b_ * SEQ; \
        _Pragma("unroll") for (int ks = 0; ks < 2; ++ks) { far[set][ks] = frag16(gr_ + (wid * 16 + fr) * 64 + ks * 32 + fq * 8); fai[set][ks] = frag16(gi_ + (wid * 16 + fr) * 64 + ks * 32 + fq * 8); } } while (0)
    const bool rebal = (NBLK == 256);
    const int fn = rebal ? (BID < 128 ? 12 : 20) : (512 * NB - BID + NBLK - 1) / NBLK, fs = rebal ? 128 : NBLK, fb = rebal ? (BID < 128 ? BID : 1536 + (BID - 128)) : BID;
    if (fn > 0) FFT_LOAD(0, fb);
    for (int k2 = 0; k2 < fn; k2 += 2) {
#pragma unroll
      for (int pp = 0; pp < 2; ++pp) { const int kk = k2 + pp; const int it = fb + fs * kk; if (kk < fn) {
        const int cp = it >> 3, b = it & 7;
        bf16x8 ar[2], ai[2], an[2];
#pragma unroll
        for (int ks = 0; ks < 2; ++ks) { ar[ks] = far[pp][ks]; ai[ks] = fai[pp][ks];
#pragma unroll
            for (int j = 0; j < 8; ++j) an[ks][j] = (short)(ar[ks][j] ^ (short)0x8000); }
        FFT_LOAD(pp ^ 1, (kk + 1 < fn) ? it + fs : fb);
#pragma unroll
        for (int nt = 0; nt < 4; ++nt) {
            f32x4 yr = (f32x4){0.f, 0.f, 0.f, 0.f}, yi = (f32x4){0.f, 0.f, 0.f, 0.f};
#pragma unroll
            for (int ks = 0; ks < 2; ++ks) { yr = mfma16(ar[ks], c64[nt][ks], yr); yr = mfma16(ai[ks], s64[nt][ks], yr); yi = mfma16(ai[ks], c64[nt][ks], yi); yi = mfma16(an[ks], s64[nt][ks], yi); }
            const int k1 = nt * 16 + fr; float orr[4], oii[4];
#pragma unroll
            for (int r = 0; r < 4; ++r) { const int n2 = wid * 16 + fq * 4 + r; float s, c; sincospi_f((float)(n2 * k1) * (2.0f / 8192.0f), &s, &c);
                orr[r] = yr[r] * c + yi[r] * s; oii[r] = yi[r] * c - yr[r] * s; }
            u32x2 w; w[0] = pk2(orr[0], orr[1]); w[1] = pk2(orr[2], orr[3]); *(u32x2*)(YR + k1 * 136 + wid * 16 + fq * 4) = w;
            w[0] = pk2(oii[0], oii[1]); w[1] = pk2(oii[2], oii[3]); *(u32x2*)(YI + k1 * 136 + wid * 16 + fq * 4) = w;
        }
        SYNC();
        bf16_t* zrow = ZT + (size_t)cp * NTOK + b * SEQ;
#pragma unroll
        for (int mt = 0; mt < 4; ++mt) {
            f32x4 z = (f32x4){0.f, 0.f, 0.f, 0.f};
#pragma unroll
            for (int ks = 0; ks < 4; ++ks) { z = mfma16(frag16(YR + (mt * 16 + fr) * 136 + ks * 32 + fq * 8), c128[ks], z); z = mfma16(frag16(YI + (mt * 16 + fr) * 136 + ks * 32 + fq * 8), s128[ks], z); }
            u32x2 w; w[0] = pk2(z[0], z[1]); w[1] = pk2(z[2], z[3]);
            *(u32x2*)(zrow + 64 * (wid * 16 + fr) + mt * 16 + fq * 4) = w;
        }
        SYNC();
      } }
    }
#undef FFT_LOAD
}

constexpr int SC_W = 0, SC_U = 17408, SC_KT = 22528, SC_Q = SC_KT + 18432, SC_A = SC_Q + 17408, SC_ST = SC_A + 9216, SC_VN = SC_ST + 2 * 8704, SC_END = SC_VN + 4608;

template <int MODE>
DEV void phase5_scan(const Params& P, unsigned char* sm) {
    PHASE_TID;
#if MK_TP >= 6 && MK_TP <= 13
    long long tp_acc = 0, tp_w0 = 0;
#define SC_TPSYNC(id, w) do { if (MODE == 0 && BID == 0 && wid == (w) && (MK_TP == (id) || MK_TP == (id) + 4)) { const long long t0_ = (long long)__builtin_readcyclecounter(); \
            if (MK_TP == (id) + 4) tp_acc += t0_ - tp_w0; SYNC(); const long long t1_ = (long long)__builtin_readcyclecounter(); if (MK_TP == (id)) tp_acc += t1_ - t0_; tp_w0 = t1_; } \
        else if (MODE == 0 && BID == 0 && wid == (w) && MK_TP >= 10) { SYNC(); tp_w0 = (long long)__builtin_readcyclecounter(); } else SYNC(); } while (0)
#else
#define SC_TPSYNC(id, w) SYNC()
#endif
    const unsigned char* images = P.ws + WS_R4;
    bf16_t* obuf = MODE ? (bf16_t*)P.out : (bf16_t*)(P.ws + WS_R4 + R4_OBUF);
    const int wid = TID >> 6, lane = TID & 63, fr = lane & 15, fq = lane >> 4;
    bf16_t* ST = (bf16_t*)sm; bf16_t* VNB = (bf16_t*)(sm + 3 * 8704);
    for (int item = BID; item < NCHAIN * 4; item += NBLK) {
        const int xj = item >> 3, chain = (item & 7) * 8 + (xj >> 2), c0 = (xj & 3) * 32, b = chain >> 3, hh = (chain >> 1) & 3, dir = chain & 1;
        const unsigned char* blk0 = images + (size_t)chain * NSTEP * IMG_BYTES;
        for (int q = TID; q < 3 * 8704 / 4; q += 512) ((unsigned*)ST)[q] = 0u;
#define SC_IMG(st_) (blk0 + (size_t)(MODE == 2 ? ((st_) & 3) : (st_)) * IMG_BYTES)
        if (wid < 4) {
            __builtin_amdgcn_s_setprio(3);
            const int mt = wid;
            const int oW = IMG_W + (mt * 4 * 64 + lane) * 16;
            const int oU = IMG_U + (((c0 >> 4) * 4 + mt) * 64 + lane) * 8;
            const int oK = IMG_KT + (mt * 4 * 64 + lane) * 16;
            f32x4 Sacc[2][2];
#pragma unroll
            for (int sl = 0; sl < 2; ++sl) { Sacc[sl][0] = (f32x4){0.f, 0.f, 0.f, 0.f}; Sacc[sl][1] = (f32x4){0.f, 0.f, 0.f, 0.f}; }
            u32x4 rw[3][4], rk[3][2][2]; u32x2 ru[3][2]; float dlr[3];
#define SC_LOAD1(set, blk) do { \
            _Pragma("unroll") for (int ks = 0; ks < 4; ++ks) rw[set][ks] = *(const u32x4*)((blk) + oW + ks * 1024); \
            ru[set][0] = *(const u32x2*)((blk) + oU); ru[set][1] = *(const u32x2*)((blk) + oU + 2048); } while (0)
#define SC_LOADK(set, blk) do { dlr[set] = *(const float*)((blk) + IMG_SC); \
            _Pragma("unroll") for (int sl = 0; sl < 2; ++sl) _Pragma("unroll") for (int ks = 0; ks < 2; ++ks) rk[set][sl][ks] = *(const u32x4*)((blk) + oK + sl * 2048 + ks * 1024); } while (0)
            SC_LOAD1(0, blk0); SC_LOADK(0, blk0); SC_LOAD1(1, SC_IMG(1)); SC_LOADK(1, SC_IMG(1)); SC_LOAD1(2, SC_IMG(2)); SC_LOADK(2, SC_IMG(2));
            SYNC();
#pragma unroll 1
            for (int s3 = 0; s3 < NSTEP; s3 += 3) {
#pragma unroll
                for (int u = 0; u < 3; ++u) {
                    const int step = s3 + u;
                    const bf16_t* STc = ST + u * 4352; bf16_t* STn = ST + ((u + 1) % 3) * 4352; bf16_t* VN = VNB + u * 2304;
                    {
                        bf16x8 sf[2][4];
#pragma unroll
                        for (int nt = 0; nt < 2; ++nt)
#pragma unroll
                            for (int ks = 0; ks < 4; ++ks) sf[nt][ks] = frag16(STc + (nt * 16 + fr) * 136 + ks * 32 + fq * 8);
                        f32x4 vn0 = (f32x4){0.f, 0.f, 0.f, 0.f}, vn1 = (f32x4){0.f, 0.f, 0.f, 0.f};
#pragma unroll
                        for (int ks = 0; ks < 4; ++ks) { vn0 = mfma16(__builtin_bit_cast(bf16x8, rw[u][ks]), sf[0][ks], vn0); vn1 = mfma16(__builtin_bit_cast(bf16x8, rw[u][ks]), sf[1][ks], vn1); }
#pragma unroll
                        for (int nt = 0; nt < 2; ++nt) { const f32x4 vn = nt ? vn1 : vn0;
                            const unsigned u0 = ru[u][nt][0], u1 = ru[u][nt][1];
                            u32x2 w; w[0] = pk2(bf2f((bf16_t)(u0 & 0xffffu)) - vn[0], bf2f((bf16_t)(u0 >> 16)) - vn[1]); w[1] = pk2(bf2f((bf16_t)(u1 & 0xffffu)) - vn[2], bf2f((bf16_t)(u1 >> 16)) - vn[3]);
                            *(u32x2*)(VN + (nt * 16 + fr) * 72 + mt * 16 + fq * 4) = w; }
                    }
                    const float dl = dlr[u];
                    const unsigned char* blk3 = SC_IMG(step + 3 < NSTEP ? step + 3 : NSTEP - 1);
                    SC_LOAD1(u, blk3);
                    SC_TPSYNC(6, 0);
                    {
                        bf16x8 vf[2][2];
#pragma unroll
                        for (int tt = 0; tt < 2; ++tt)
#pragma unroll
                            for (int ks = 0; ks < 2; ++ks) vf[tt][ks] = frag16(VN + (tt * 16 + fr) * 72 + ks * 32 + fq * 8);
                        f32x4 a[2][2];
#pragma unroll
                        for (int sl = 0; sl < 2; ++sl) { a[sl][0] = Sacc[sl][0] * dl; a[sl][1] = Sacc[sl][1] * dl; }
#pragma unroll
                        for (int ks = 0; ks < 2; ++ks)
#pragma unroll
                            for (int sl = 0; sl < 2; ++sl)
#pragma unroll
                                for (int tt = 0; tt < 2; ++tt) a[sl][tt] = mfma16(__builtin_bit_cast(bf16x8, rk[u][sl][ks]), vf[tt][ks], a[sl][tt]);
#pragma unroll
                        for (int sl = 0; sl < 2; ++sl)
#pragma unroll
                            for (int tt = 0; tt < 2; ++tt) { Sacc[sl][tt] = a[sl][tt]; u32x2 w_; w_[0] = pk2(a[sl][tt][0], a[sl][tt][1]); w_[1] = pk2(a[sl][tt][2], a[sl][tt][3]);
                                *(u32x2*)(STn + (tt * 16 + fr) * 136 + (mt * 2 + sl) * 16 + fq * 4) = w_; }
                    }
                    SC_LOADK(u, blk3);
                    SC_TPSYNC(7, 0);
                }
            }
#undef SC_LOAD1
#undef SC_LOADK
            __builtin_amdgcn_s_setprio(0);
            SYNC();
        } else {
            const int mt = wid - 4;
            const int oA = IMG_A + (mt * 2 * 64 + lane) * 16, oS = IMG_SC + 16 + (mt * 16 + fr) * 4;
            const bf16_t* qbase = (const bf16_t*)(P.ws + WS_R3) + hh * 128 + fq * 8;
            u32x4 rq[4][4], ra[4][2]; float rs[4];
#define SC_LOADQ(set, blk, stp) do { const bf16_t* qrow_ = qbase + (size_t)chunk_row(chain, (stp), mt * 16 + fr) * 1536; \
            _Pragma("unroll") for (int ks = 0; ks < 4; ++ks) rq[set][ks] = *(const u32x4*)(qrow_ + ks * 32); \
            rs[set] = *(const float*)((blk) + oS); \
            _Pragma("unroll") for (int ks = 0; ks < 2; ++ks) ra[set][ks] = *(const u32x4*)((blk) + oA + ks * 1024); } while (0)
#define SC_OUT1(set, ostep, bi) do { if ((ostep) >= 4) { const bf16_t* STo = ST + (bi) * 4352; bf16x8 sf_[2][4]; \
                _Pragma("unroll") for (int nt = 0; nt < 2; ++nt) _Pragma("unroll") for (int ks = 0; ks < 4; ++ks) sf_[nt][ks] = frag16(STo + (nt * 16 + fr) * 136 + ks * 32 + fq * 8); \
                p0 = (f32x4){0.f, 0.f, 0.f, 0.f}; p1 = p0; \
                _Pragma("unroll") for (int ks = 0; ks < 4; ++ks) { p0 = mfma16(sf_[0][ks], __builtin_bit_cast(bf16x8, rq[set][ks]), p0); p1 = mfma16(sf_[1][ks], __builtin_bit_cast(bf16x8, rq[set][ks]), p1); } } } while (0)
#define SC_OUT2(set, ostep, bi) do { if ((ostep) >= 4) { const bf16_t* VNo = VNB + (bi) * 2304; bf16x8 vf_[2][2]; \
                _Pragma("unroll") for (int nt = 0; nt < 2; ++nt) _Pragma("unroll") for (int ks = 0; ks < 2; ++ks) vf_[nt][ks] = frag16(VNo + (nt * 16 + fr) * 72 + ks * 32 + fq * 8); \
                f32x4 q0_ = p0 * rs[set], q1_ = p1 * rs[set]; \
                _Pragma("unroll") for (int ks = 0; ks < 2; ++ks) { q0_ = mfma16(vf_[0][ks], __builtin_bit_cast(bf16x8, ra[set][ks]), q0_); q1_ = mfma16(vf_[1][ks], __builtin_bit_cast(bf16x8, ra[set][ks]), q1_); } \
                const int pos = ((ostep) - 4) * 64 + mt * 16 + fr; const int tok = b * SEQ + (dir ? (SEQ - 1 - pos) : pos); \
                bf16_t* orow = obuf + (((size_t)(dir * 16 + hh * 4 + (c0 >> 5))) * NTOK + tok) * 32 + fq * 8;     \
                u32x4 w_; w_[0] = pk2(q0_[0], q0_[1]); w_[1] = pk2(q0_[2], q0_[3]); w_[2] = pk2(q1_[0], q1_[1]); w_[3] = pk2(q1_[2], q1_[3]); \
                if (MODE != 3 || w_[0] == 0x12345678u) *(u32x4*)(orow) = w_; } } while (0)
            f32x4 p0 = (f32x4){0.f, 0.f, 0.f, 0.f}, p1 = p0;
            SC_LOADQ(0, blk0, (MODE == 2 ? 4 : 0)); SC_LOADQ(1, SC_IMG(1), (MODE == 2 ? 5 : 1)); SC_LOADQ(2, SC_IMG(2), (MODE == 2 ? 6 : 2));
            SYNC();
            int bi = 2;
#pragma unroll 1
            for (int s4 = 0; s4 < NSTEP; s4 += 4) {
#pragma unroll
                for (int u = 0; u < 4; ++u) {
                    const int step = s4 + u;
                    if (step > 0) SC_OUT1((u + 3) % 4, step - 1, bi);
                    SC_TPSYNC(8, 4);
                    if (step > 0) SC_OUT2((u + 3) % 4, step - 1, bi);
                    { const int stq = step + 3 < NSTEP ? step + 3 : NSTEP - 1; SC_LOADQ((u + 3) % 4, SC_IMG(stq), (MODE == 2 ? (stq & 3) + 4 : stq)); }
                    bi = bi == 2 ? 0 : bi + 1;
                    SC_TPSYNC(9, 4);
                }
            }
            SC_OUT1((NSTEP - 1) % 4, NSTEP - 1, (NSTEP - 1) % 3); SC_OUT2((NSTEP - 1) % 4, NSTEP - 1, (NSTEP - 1) % 3);
            SYNC();
#undef SC_LOADQ
#undef SC_OUT1
#undef SC_OUT2
        }
#undef SC_IMG
#if MK_TP >= 6 && MK_TP <= 13
        if (MODE == 0 && BID == 0 && (wid == 0 || wid == 4)) { const long long t0_ = (long long)__builtin_readcyclecounter(); while ((long long)__builtin_readcyclecounter() - t0_ < tp_acc * 8) __builtin_amdgcn_s_sleep(4); }
#endif
        SYNC();
    }
}

DEV void phase6_amix(const Params& P, unsigned char* sm) {
    PHASE_TID;
    const bf16_t* ZT = (const bf16_t*)((const unsigned char*)P.out + DO_ZT);
    const bf16_t* zs = (const bf16_t*)((const unsigned char*)P.out + DO_ZS);
    const bf16_t* obuf = (const bf16_t*)(P.ws + WS_R4 + R4_OBUF);
    bf16_t* amix = (bf16_t*)(P.ws + WS_R4 + R4_AMIX);
    unsigned* tile = (unsigned*)sm;
    for (int tt = BID; tt < NTOK / 64; tt += NBLK) {
        const int tok0 = tt * 64;
        { u32x4 r[8];
#pragma unroll
          for (int q = 0; q < 8; ++q) { const int idx = TID + q * 512, cp = idx >> 3, piece = idx & 7; r[q] = *(const u32x4*)(ZT + (size_t)cp * NTOK + tok0 + piece * 8); }
#pragma unroll
          for (int q = 0; q < 8; ++q) { const int idx = TID + q * 512, cp = idx >> 3, piece = idx & 7; unsigned* t = tile + cp * 33 + piece * 4; t[0] = r[q][0]; t[1] = r[q][1]; t[2] = r[q][2]; t[3] = r[q][3]; } }
        SYNC();
        u32x4 oa[8], ob[8], oz[8];
#pragma unroll
        for (int q = 0; q < 8; ++q) { const int idx = TID + q * 512, tok = idx >> 6, hh = (idx >> 4) & 3, l16 = idx & 15; const size_t off = (size_t)(tok0 + tok) * 512 + hh * 128 + l16 * 8;
            const size_t oo = ((size_t)(hh * 4 + (l16 >> 2)) * NTOK + tok0 + tok) * 32 + (l16 & 3) * 8;
            oa[q] = *(const u32x4*)(obuf + oo); ob[q] = *(const u32x4*)(obuf + (size_t)NTOK * 512 + oo); oz[q] = *(const u32x4*)(zs + off); }
#pragma unroll
        for (int q = 0; q < 8; ++q) { const int tok = TID & 63, c8 = ((TID >> 6) * 8 + q) * 8, sh = (tok & 1) * 16; u32x4 o;
#pragma unroll
            for (int j = 0; j < 4; ++j) o[j] = ((tile[(c8 + 2 * j) * 33 + (tok >> 1)] >> sh) & 0xffffu) | (((tile[(c8 + 2 * j + 1) * 33 + (tok >> 1)] >> sh) & 0xffffu) << 16);
            *(u32x4*)(amix + (size_t)(tok0 + tok) * 1024 + c8) = o; }
        const int l16 = TID & 15;
        float og[8];
#pragma unroll
        for (int j = 0; j < 8; ++j) og[j] = P.onorm_g[l16 * 8 + j];
#pragma unroll
        for (int q = 0; q < 8; ++q) {
            const int idx = TID + q * 512, tok = idx >> 6, hh = (idx >> 4) & 3;
            const u32x4 a = oa[q], bq = ob[q], zv = oz[q];
            float v[8]; float ss = 0.f;
#pragma unroll
            for (int j = 0; j < 4; ++j) { v[2 * j] = bf2f((bf16_t)(a[j] & 0xffffu)) + bf2f((bf16_t)(bq[j] & 0xffffu)); v[2 * j + 1] = bf2f((bf16_t)(a[j] >> 16)) + bf2f((bf16_t)(bq[j] >> 16)); }
#pragma unroll
            for (int j = 0; j < 8; ++j) ss += v[j] * v[j];
            ss += shfl_xor_f(ss, 1); ss += shfl_xor_f(ss, 2); ss += shfl_xor_f(ss, 4); ss += shfl_xor_f(ss, 8);
            const float rstd = rsq_f(ss * (1.0f / 128.0f) + EPS);
            u32x4 o;
#pragma unroll
            for (int j = 0; j < 4; ++j) o[j] = pk2(v[2 * j] * rstd * og[2 * j] * bf2f((bf16_t)(zv[j] & 0xffffu)), v[2 * j + 1] * rstd * og[2 * j + 1] * bf2f((bf16_t)(zv[j] >> 16)));
            *(u32x4*)(amix + (size_t)(tok0 + tok) * 1024 + 512 + hh * 128 + l16 * 8) = o;
        }
        SYNC();
    }
}

DEV void phase8_router(const Params& P, unsigned char* sm, int dry) {
    PHASE_TID;
    float* wr = (float*)sm;
    {
        f32x4 g[2], rt[2][8];
#pragma unroll
        for (int h = 0; h < 2; ++h) { const int k = TID + h * 512; g[h] = *(const f32x4*)(P.w_group + k * 4);
#pragma unroll
            for (int q = 0; q < 8; ++q) rt[h][q] = *(const f32x4*)(P.w_router + k * 32 + q * 4); }
#pragma unroll
        for (int h = 0; h < 2; ++h) { const int k = TID + h * 512;
#pragma unroll
            for (int e = 0; e < 4; ++e) wr[e * 1028 + k] = g[h][e];
#pragma unroll
            for (int q = 0; q < 8; ++q)
#pragma unroll
                for (int e = 0; e < 4; ++e) wr[(4 + q * 4 + e) * 1028 + k] = rt[h][q][e]; }
    }
    SYNC();
    const float* mod = (const float*)(P.ws + WS_MOD);
    const float* xin = P.x; const bf16_t* proj = (const bf16_t*)(P.ws + WS_R4 + R4_PROJ);
    bf16_t* h2 = (bf16_t*)(P.ws + WS_R4 + R4_H2);
    unsigned* cnt = (unsigned*)(P.ws + WS_CNT + (dry ? 8192 : 0)); unsigned* tokk = (unsigned*)(P.ws + (dry ? WS_R3 : WS_TOKK)); float* wl = (float*)(P.ws + (dry ? WS_R3 + 16 * MiB : WS_WL));
    const int wid = TID >> 6, lane = TID & 63;
    const int rstep = NBLK * 8;
    int r = BID * 8 + wid;
    unsigned* lc = (unsigned*)(sm + 148224);
    unsigned* aE = lc + 64; float* aW = (float*)(aE + 512); unsigned* aP = (unsigned*)(aW + 512);
    float* gsv = (float*)(sm + 154624); float* shv = gsv + 1024;
    float* brs = shv + 1024;
    if (TID < 32) { lc[TID] = 0u; brs[TID] = P.b_router[TID]; }
    const float bg0 = P.b_group[0], bg1 = P.b_group[1], bg2 = P.b_group[2], bg3 = P.b_group[3];
    SYNC();
    int jrow = 0;
    f32x4 vr[4][4]; u32x2 pr[4][4];
#pragma unroll
    for (int jj = 0; jj < 4; ++jj) { const int rl = (r + jj * rstep < NTOK) ? r + jj * rstep : r;
#pragma unroll
        for (int i = 0; i < 4; ++i) { vr[jj][i] = *(const f32x4*)(xin + (size_t)rl * D + i * 256 + lane * 4); pr[jj][i] = *(const u32x2*)(proj + (size_t)rl * D + i * 256 + lane * 4); } }
    const float n2a = P.norm2_g[TID], n2b = P.norm2_g[TID + 512];
    float msa, msb, mha, mhb;
    { const float* shift = mod + (r >> 13) * 6144 + 3 * 1024; msa = shift[1024 + TID]; msb = shift[1024 + TID + 512]; mha = shift[TID]; mhb = shift[TID + 512]; }
#pragma unroll 1
    for (; r < NTOK; ) {
        SYNC();
        gsv[TID] = n2a * (1.0f + msa); gsv[TID + 512] = n2b * (1.0f + msb); shv[TID] = mha; shv[TID + 512] = mhb;
        { const int rn = (r + 4 * rstep < NTOK) ? r + 4 * rstep : r; const float* shift = mod + (rn >> 13) * 6144 + 3 * 1024; msa = shift[1024 + TID]; msb = shift[1024 + TID + 512]; mha = shift[TID]; mhb = shift[TID + 512]; }
        SYNC();
#pragma unroll
      for (int jj = 0; jj < 4; ++jj) { if (r < NTOK) {
        f32x4 v[4]; float ss = 0.f;
#pragma unroll
        for (int i = 0; i < 4; ++i) { const u32x2 pw = pr[jj][i]; v[i] = vr[jj][i];
            v[i][0] += __builtin_bit_cast(float, pw[0] << 16); v[i][1] += __builtin_bit_cast(float, pw[0] & 0xffff0000u); v[i][2] += __builtin_bit_cast(float, pw[1] << 16); v[i][3] += __builtin_bit_cast(float, pw[1] & 0xffff0000u);
            ss += v[i][0] * v[i][0] + v[i][1] * v[i][1] + v[i][2] * v[i][2] + v[i][3] * v[i][3]; }
        { const int rl = (r + 4 * rstep < NTOK) ? r + 4 * rstep : r;
#pragma unroll
          for (int i = 0; i < 4; ++i) { vr[jj][i] = *(const f32x4*)(xin + (size_t)rl * D + i * 256 + lane * 4); pr[jj][i] = *(const u32x2*)(proj + (size_t)rl * D + i * 256 + lane * 4); } }
        ss = wave_sum(ss);
        const float rstd = rsq_f(ss * (1.0f / 1024.0f) + EPS);
        float gl[4] = {0.f, 0.f, 0.f, 0.f};
#pragma unroll
        for (int i = 0; i < 4; ++i) {
            const int k = i * 256 + lane * 4;
            const f32x4 g2 = *(const f32x4*)(gsv + k), sh = *(const f32x4*)(shv + k);
#pragma unroll
            for (int e = 0; e < 4; ++e) v[i][e] = v[i][e] * rstd * g2[e] + sh[e];
#pragma unroll
            for (int j = 0; j < 4; ++j) { const f32x4 wv = *(const f32x4*)(wr + j * 1028 + k); gl[j] += v[i][0] * wv[0] + v[i][1] * wv[1] + v[i][2] * wv[2] + v[i][3] * wv[3]; }
#if MK_F8
            *(unsigned*)((unsigned char*)h2 + (size_t)r * D + k) = pk4_fp8(v[i][0], v[i][1], v[i][2], v[i][3]);
#else
            u32x2 w; w[0] = pk2(v[i][0], v[i][1]); w[1] = pk2(v[i][2], v[i][3]);
            *(u32x2*)(h2 + (size_t)r * D + k) = w;
#endif
        }
#pragma unroll
        for (int j = 0; j < 4; ++j) gl[j] += 0.f;
        { const float t = wave_sum_multi<4>(gl, lane);
#pragma unroll
          for (int j = 0; j < 4; ++j) gl[j] = lane_bcast(t, j) + (j == 0 ? bg0 : j == 1 ? bg1 : j == 2 ? bg2 : bg3); }
        int gsel = 0; float gmax = gl[0];
#pragma unroll
        for (int j = 1; j < 4; ++j) if (gl[j] > gmax) { gmax = gl[j]; gsel = j; }
        float gden = 0.f;
#pragma unroll
        for (int j = 0; j < 4; ++j) gden += __expf(gl[j] - gmax);
        const float pg = 1.0f / gden;
        float el[8] = {0.f, 0.f, 0.f, 0.f, 0.f, 0.f, 0.f, 0.f};
#pragma unroll
        for (int i = 0; i < 4; ++i)
#pragma unroll
            for (int j = 0; j < 8; ++j) { const f32x4 wv = *(const f32x4*)(wr + (4 + gsel * 8 + j) * 1028 + i * 256 + lane * 4); el[j] += v[i][0] * wv[0] + v[i][1] * wv[1] + v[i][2] * wv[2] + v[i][3] * wv[3]; }
#pragma unroll
        for (int j = 0; j < 8; ++j) el[j] += 0.f;
        { const float t = wave_sum_multi<8>(el, lane);
#pragma unroll
          for (int j = 0; j < 8; ++j) el[j] = lane_bcast(t, j) + brs[gsel * 8 + j]; }
        int e1 = 0; float m1 = el[0];
#pragma unroll
        for (int j = 1; j < 8; ++j) if (el[j] > m1) { m1 = el[j]; e1 = j; }
        int e2 = -1; float m2 = -3.0e38f;
#pragma unroll
        for (int j = 0; j < 8; ++j) if (j != e1 && el[j] > m2) { m2 = el[j]; e2 = j; }
        if (e2 < 0) e2 = (e1 + 1) & 7;
        const float p2 = __expf(m2 - m1);
        const float w1 = pg / (1.0f + p2), w2 = pg * p2 / (1.0f + p2);
        if (lane < 2) {
            const int ee = gsel * 8 + (lane == 0 ? e1 : e2); const float ww = lane == 0 ? w1 : w2;
            const unsigned pos = atomic_add_u32(&lc[ee], 1u);
            const int a = (jrow * 8 + wid) * 2 + lane;
            if (a < 512) { aE[a] = (unsigned)ee; aW[a] = ww; aP[a] = pos; }
        }
        ++jrow; r += rstep;
      } }
    }
    SYNC();
    if (TID < 32) lc[32 + TID] = atomic_add_u32(&cnt[TID * 64], lc[TID]);
    SYNC();
    { const int a = TID, rl = a >> 1, rr = BID * 8 + (rl & 7) + (rl >> 3) * rstep;
      if (rr < NTOK && (rl >> 3) < jrow) { const unsigned ee = aE[a]; const unsigned pos = lc[32 + ee] + aP[a];
          tokk[(size_t)ee * LCAP + pos] = (unsigned)rr * 2u + (unsigned)(a & 1); wl[(size_t)ee * LCAP + pos] = aW[a]; } }
}

DEV void phase11_final(const Params& P, unsigned char* sm, float* dstbase) {
    PHASE_TID;
    (void)sm;
    const float* mod = (const float*)(P.ws + WS_MOD);
    const int wid = TID >> 6, lane = TID & 63;
#if MK_F8
    typedef float f32x2_ __attribute__((ext_vector_type(2)));
    const unsigned char* Y = P.ws + WS_R4 + R4_Y;
    const bf16_t* proj = (const bf16_t*)(P.ws + WS_R4 + R4_PROJ);
    for (int r0 = (BID * 8 + wid) * 2; r0 < NTOK; r0 += NBLK * 16) {
        f32x4 xv[2][4]; u32x2 pj[2][4]; unsigned y0[2][4], y1[2][4];
#pragma unroll
        for (int u = 0; u < 2; ++u)
#pragma unroll
            for (int i = 0; i < 4; ++i) { const int k = i * 256 + lane * 4; const size_t r = (size_t)(r0 + u);
                xv[u][i] = *(const f32x4*)(P.x + r * D + k); pj[u][i] = *(const u32x2*)(proj + r * D + k); y0[u][i] = *(const unsigned*)(Y + r * D + k); y1[u][i] = *(const unsigned*)(Y + ((size_t)NTOK + r) * D + k); }
        const float* gate = mod + (r0 >> 13) * 6144 + 5 * 1024;
#pragma unroll
        for (int u = 0; u < 2; ++u) {
            float* row = dstbase + (size_t)(r0 + u) * D;
            f32x4 v[4]; float ss = 0.f;
#pragma unroll
            for (int i = 0; i < 4; ++i) { const int k = i * 256 + lane * 4; const f32x4 gv = *(const f32x4*)(gate + k) * 0.0625f;
                const f32x2_ a0 = __builtin_amdgcn_cvt_pk_f32_fp8((int)y0[u][i], false), a1 = __builtin_amdgcn_cvt_pk_f32_fp8((int)y0[u][i], true);
                const f32x2_ b0 = __builtin_amdgcn_cvt_pk_f32_fp8((int)y1[u][i], false), b1 = __builtin_amdgcn_cvt_pk_f32_fp8((int)y1[u][i], true);
                f32x4 m; m[0] = a0[0] + b0[0]; m[1] = a0[1] + b0[1]; m[2] = a1[0] + b1[0]; m[3] = a1[1] + b1[1];
                f32x4 pv; pv[0] = __builtin_bit_cast(float, pj[u][i][0] << 16); pv[1] = __builtin_bit_cast(float, pj[u][i][0] & 0xffff0000u); pv[2] = __builtin_bit_cast(float, pj[u][i][1] << 16); pv[3] = __builtin_bit_cast(float, pj[u][i][1] & 0xffff0000u);
                v[i] = xv[u][i] + pv + gv * m; ss += v[i][0] * v[i][0] + v[i][1] * v[i][1] + v[i][2] * v[i][2] + v[i][3] * v[i][3]; }
            ss = wave_sum(ss);
            const float rstd = rsq_f(ss * (1.0f / 1024.0f) + EPS);
#pragma unroll
            for (int i = 0; i < 4; ++i) { const int k = i * 256 + lane * 4; const f32x4 fg = *(const f32x4*)(P.final_g + k); *(f32x4*)(row + k) = v[i] * rstd * fg; }
        }
    }
#else
    const bf16_t* Y = (const bf16_t*)(P.ws + WS_R4 + R4_Y);
    for (int r0 = (BID * 8 + wid) * 2; r0 < NTOK; r0 += NBLK * 16) {
        f32x4 xv[2][4]; u32x2 y0[2][4], y1[2][4];
#pragma unroll
        for (int u = 0; u < 2; ++u)
#pragma unroll
            for (int i = 0; i < 4; ++i) { const int k = i * 256 + lane * 4; const size_t r = (size_t)(r0 + u);
                xv[u][i] = *(const f32x4*)(P.out + r * D + k); y0[u][i] = *(const u32x2*)(Y + r * D + k); y1[u][i] = *(const u32x2*)(Y + ((size_t)NTOK + r) * D + k); }
        const float* gate = mod + (r0 >> 13) * 6144 + 5 * 1024;
#pragma unroll
        for (int u = 0; u < 2; ++u) {
            float* row = dstbase + (size_t)(r0 + u) * D;
            f32x4 v[4]; float ss = 0.f;
#pragma unroll
            for (int i = 0; i < 4; ++i) { const int k = i * 256 + lane * 4; const f32x4 gv = *(const f32x4*)(gate + k);
                f32x4 m; m[0] = bf2f((bf16_t)(y0[u][i][0] & 0xffffu)) + bf2f((bf16_t)(y1[u][i][0] & 0xffffu)); m[1] = bf2f((bf16_t)(y0[u][i][0] >> 16)) + bf2f((bf16_t)(y1[u][i][0] >> 16));
                m[2] = bf2f((bf16_t)(y0[u][i][1] & 0xffffu)) + bf2f((bf16_t)(y1[u][i][1] & 0xffffu)); m[3] = bf2f((bf16_t)(y0[u][i][1] >> 16)) + bf2f((bf16_t)(y1[u][i][1] >> 16));
                v[i] = xv[u][i] + gv * m; ss += v[i][0] * v[i][0] + v[i][1] * v[i][1] + v[i][2] * v[i][2] + v[i][3] * v[i][3]; }
            ss = wave_sum(ss);
            const float rstd = rsq_f(ss * (1.0f / 1024.0f) + EPS);
#pragma unroll
            for (int i = 0; i < 4; ++i) { const int k = i * 256 + lane * 4; const f32x4 fg = *(const f32x4*)(P.final_g + k); *(f32x4*)(row + k) = v[i] * rstd * fg; }
        }
    }
#endif
}

#ifndef CPU_EMU
#define XB_TMO      128
#define XB_XCNT(j)  (256  + 64 * (j))
#define XB_XSUB(j)  (1280 + 64 * (j))
#define XB_XGEN(j)  (2304 + 64 * (j))
#define XB_TOP      3328
#define XB_TOPGEN   3392
#define XCD_BAR_WORDS 3456
#define XB_SPIN_CAP (1u << 22)
#define LAS __attribute__((address_space(3)))
__device__ __forceinline__ unsigned xb_ld(unsigned* p)              { return __hip_atomic_load(p, __ATOMIC_RELAXED, __HIP_MEMORY_SCOPE_AGENT); }
__device__ __forceinline__ unsigned xb_add(unsigned* p, unsigned v) { return __hip_atomic_fetch_add(p, v, __ATOMIC_RELAXED, __HIP_MEMORY_SCOPE_AGENT); }
__device__ __forceinline__ unsigned xb_xcc_id() { return (unsigned)__builtin_amdgcn_s_getreg((3 << 11) | 20) & 0xFu; }
#define XB_SPIN(cond, bar) do { unsigned _sp = 0; while (cond) { __builtin_amdgcn_s_sleep(1); \
    if ((++_sp & 255u) == 0u) { if (xb_ld(&(bar)[XB_TMO])) break; if (_sp > XB_SPIN_CAP) { atomicAdd(&(bar)[XB_TMO], 1u); break; } } } } while (0)
struct XcdBarrier { unsigned* bar; unsigned x; volatile LAS unsigned* st; int wave; };
__device__ __forceinline__ XcdBarrier xcd_barrier_post(unsigned* bar, volatile LAS unsigned* st, int wave) {
    XcdBarrier b; b.bar = bar; b.x = xb_xcc_id(); b.st = st; b.wave = wave;
    if (MK_TID(wave) == 0) (void)xb_add(&bar[XB_XCNT(b.x)], 1u);
    return b;
}
__device__ __forceinline__ void xcd_barrier_complete(unsigned* bar, unsigned x, unsigned& nloc, unsigned& nx) {
    const unsigned G = gridDim.x * gridDim.y * gridDim.z;
    unsigned sum, cnt, mine, sp = 0u;
    for (;;) {
        sum = 0u; cnt = 0u; mine = 0u;
#pragma unroll
        for (unsigned j = 0; j < 16; ++j) { const unsigned c = xb_ld(&bar[XB_XCNT(j)]); sum += c; cnt += (c > 0u) ? 1u : 0u; mine = (j == x) ? c : mine; }
        if (sum == G) break;
        __builtin_amdgcn_s_sleep(1);
        if ((++sp & 255u) == 0u) { if (xb_ld(&bar[XB_TMO])) break; if (sp > XB_SPIN_CAP) { atomicAdd(&bar[XB_TMO], 1u); break; } }
    }
    nloc = mine > 0u ? mine : 1u; nx = cnt > 0u ? cnt : 1u;
}
__device__ __forceinline__ void xcd_barrier(const XcdBarrier& b) {
    asm volatile("s_waitcnt vmcnt(0)" ::: "memory");
    __syncthreads();
    if (MK_TID(b.wave) == 0) {
        unsigned* bar = b.bar;
        __builtin_amdgcn_s_waitcnt(0);
        unsigned nloc = b.st[0], nx = b.st[1];
        if (nloc == 0u) { xcd_barrier_complete(bar, b.x, nloc, nx); b.st[0] = nloc; b.st[1] = nx; }
        const unsigned old = xb_add(&bar[XB_XSUB(b.x)], 1u);
        const unsigned gen = old / nloc;
        if (old + 1u == (gen + 1u) * nloc) {
            __builtin_amdgcn_fence(__ATOMIC_RELEASE, "agent");
            asm volatile("s_waitcnt vmcnt(0)" ::: "memory");
            const unsigned og = xb_add(&bar[XB_TOP], 1u);
            const unsigned tg = og / nx;
            if (og + 1u == (tg + 1u) * nx) xb_add(&bar[XB_TOPGEN], 1u);
            else XB_SPIN(xb_ld(&bar[XB_TOPGEN]) == tg, bar);
            __builtin_amdgcn_fence(__ATOMIC_ACQUIRE, "agent");
            xb_add(&bar[XB_XGEN(b.x)], 1u);
            asm volatile("s_waitcnt vmcnt(0)" ::: "memory");
        } else {
            XB_SPIN(xb_ld(&bar[XB_XGEN(b.x)]) == gen, bar);
            __builtin_amdgcn_fence(__ATOMIC_ACQUIRE, "agent");
            asm volatile("s_waitcnt vmcnt(0)" ::: "memory");
        }
    }
    __syncthreads();
}

#ifndef MK_PH
#define MK_PH 0x7ff
#endif
#define REPS(k) for (int rep_ = 0; rep_ < (((MK_REP >> (k)) & 1) ? 2 : 1); ++rep_)
extern __shared__ __attribute__((aligned(16))) unsigned char smem_dyn[];

__device__ __forceinline__ void moe_tables(const Params& P, LAS int* tb, LAS int* cn) {
    const unsigned* cnt = (const unsigned*)(P.ws + WS_CNT);
    const int t_ = MK_TID(P.wave);
    if (t_ < 32) cn[t_] = (int)cnt[t_ * 64];
    __syncthreads();
    if (t_ == 0) { int acc = 0; for (int e = 0; e < 32; ++e) { tb[e] = acc; acc += (cn[e] + 255) >> 8; } tb[32] = acc; }
    __syncthreads();
    {
        LAS unsigned char* te = (LAS unsigned char*)tb + 512;
        for (int tile = t_; tile < 1536; tile += 512) { int e = 0;
#pragma unroll
            for (int sft = 16; sft >= 1; sft >>= 1) if (tb[e + sft] <= tile) e += sft;
            te[tile] = (unsigned char)e; }
    }
    __syncthreads();
}

__global__ void __launch_bounds__(512, 2) hymba_fwd(Params Pin) {
    Params P = Pin; P.wave = __builtin_amdgcn_readfirstlane((int)threadIdx.x >> 6);
    unsigned char* sm = smem_dyn;
    LAS unsigned char* lsm = (LAS unsigned char*)smem_dyn;
    volatile LAS unsigned* xbw = (volatile LAS unsigned*)(lsm + LDS_BYTES - 16);
    if (MK_TID(P.wave) == 0) { xbw[0] = 0u; xbw[1] = 0u; xbw[2] = 0u; xbw[3] = 0u; }
    __syncthreads();
    XcdBarrier bar = xcd_barrier_post((unsigned*)(P.ws + WS_BAR), xbw, P.wave);
    using namespace pg8;

#if (MK_PH >> 0) & 1
    REPS(15) phase0_mod(P, sm); REPS(0) { phase0_weights(P, sm); phase0_wf(P, sm); }
    xcd_barrier(bar);
#endif
#if (MK_PH >> 1) & 1
    REPS(1) phase1_prep(P, sm);
    xcd_barrier(bar);
#endif
#if (MK_PH >> 2) & 1
    REPS(2) {
    phase2_ctx(P, sm);
    { ProbInproj G; G.init(NTOK / 256, 8, gridDim.x, blockIdx.x); G.wv = P.wave; G.A = (const bf16_t*)(P.ws + WS_R4 + R4_H); G.Bt = (const bf16_t*)(P.ws + WS_WQKVZ); G.K = 1024;
      EpiInproj E; E.O = (bf16_t*)(P.ws + WS_R4 + R4_P); E.zs = (bf16_t*)((unsigned char*)P.out + DO_ZS); E.rstd = (const float*)(P.ws + WS_RSTD); E.bias = (const float*)(P.ws + WS_BIAS); gemm_phase(lsm, G, E); }
    { ProbGT G; G.init(4, NTOK / 256, gridDim.x, blockIdx.x); G.wv = P.wave; G.A = (const bf16_t*)(P.ws + WS_WF); G.Bt = (const bf16_t*)(P.ws + WS_R4 + R4_H); G.K = 1024;
      EpiGT E; E.O = (bf16_t*)((unsigned char*)P.out + DO_GT); E.rstd = (const float*)(P.ws + WS_RSTD); E.bias = (const float*)(P.ws + WS_BIAS); gemm_phase(lsm, G, E); }
    }
    xcd_barrier(bar);
#endif
#if (MK_PH >> 3) & 1
    REPS(3) phase3_conv(P, sm);
    xcd_barrier(bar);
#endif
#if (MK_PH >> 4) & 1
    REPS(4) phase4_prepass(P, sm);
    REPS(11) phase4_fft(P, sm);
    xcd_barrier(bar);
#endif
#if (MK_PH >> 5) & 1
#if (MK_REP >> 22) & 3
    phase5_scan<(MK_REP >> 22) & 3>(P, sm);
#endif
    REPS(5) phase5_scan<0>(P, sm);
    xcd_barrier(bar);
#endif
#if (MK_PH >> 6) & 1
    REPS(6) phase6_amix(P, sm);
    xcd_barrier(bar);
#endif
#if (MK_PH >> 7) & 1
#if (MK_REP >> 19) & 3
    { ProbOutHot G; G.init(NTOK / 256, 4, gridDim.x, blockIdx.x); G.wv = P.wave; G.hot = ((MK_REP >> 19) & 3) != 2; G.A = (const bf16_t*)(P.ws + WS_R4 + R4_AMIX); G.Bt = (const bf16_t*)(P.ws + WS_WOUT); G.K = (((MK_REP >> 19) & 3) == 3) ? 512 : 1024;
      EpiDry E; E.out = P.out; gemm_phase(lsm, G, E); }
    xcd_barrier(bar);
#endif
    REPS(7)
    { ProbOut G; G.init(NTOK / 256, 4, gridDim.x, blockIdx.x); G.wv = P.wave; G.A = (const bf16_t*)(P.ws + WS_R4 + R4_AMIX); G.Bt = (const bf16_t*)(P.ws + WS_WOUT); G.K = 1024;
      EpiProj E; E.mod = (const float*)(P.ws + WS_MOD); E.O = (bf16_t*)(P.ws + WS_R4 + R4_PROJ); gemm_phase(lsm, G, E); }
    xcd_barrier(bar);
#endif
#if (MK_PH >> 8) & 1
#if (MK_REP >> 13) & 1
    phase8_router(P, sm, 1);
#endif
    phase8_router(P, sm, 0);
#if (MK_REP >> 14) & 1
    xcd_barrier(bar); xcd_barrier(bar); xcd_barrier(bar); xcd_barrier(bar);
#endif
    xcd_barrier(bar);
#endif
#if (MK_PH >> 9) & 1
#if MK_F8 == 2
    LAS int* tb = (LAS int*)(lsm + STAGE_BYTES); LAS int* cn = tb + 64;
    moe_tables(P, tb, cn);
    REPS(9)
    { ProbMoe1P8 G; G.tb = tb; G.wv = P.wave; G.cnt = cn; G.G = gridDim.x; G.c = blockIdx.x; G.A = P.ws + WS_R4 + R4_H2; G.Bt = P.ws + WS_WGU; G.K = 512; G.tokk = (const unsigned*)(P.ws + WS_TOKK);
      EpiMoe1P8 E; E.hid = P.ws + WS_R4 + R4_HID; gemm_phase(lsm, G, E); }
    xcd_barrier(bar);
#if (MK_REP >> 18) & 1
    { ProbMoe2P8 G; G.tb = tb; G.wv = P.wave; G.cnt = cn; G.G = gridDim.x; G.c = blockIdx.x; G.A = P.ws + WS_R4 + R4_HID; G.Bt = P.ws + WS_WD; G.K = 256;
      EpiMoe2P8 E; E.dry = 1; E.Y = P.ws + WS_R4 + R4_Y; E.tokk = (const unsigned*)(P.ws + WS_TOKK); E.wl = (const float*)(P.ws + WS_WL); E.tb = tb; gemm_phase(lsm, G, E); }
    xcd_barrier(bar);
#endif
    REPS(10)
    { ProbMoe2P8 G; G.tb = tb; G.wv = P.wave; G.cnt = cn; G.G = gridDim.x; G.c = blockIdx.x; G.A = P.ws + WS_R4 + R4_HID; G.Bt = P.ws + WS_WD; G.K = 256;
      EpiMoe2P8 E; E.Y = P.ws + WS_R4 + R4_Y; E.tokk = (const unsigned*)(P.ws + WS_TOKK); E.wl = (const float*)(P.ws + WS_WL); E.tb = tb; gemm_phase(lsm, G, E); }
    xcd_barrier(bar);
#elif MK_F8
    LAS int* tb = (LAS int*)(lsm + F8_LDS); LAS int* cn = tb + 64;
    moe_tables(P, tb, cn);
#if (MK_REP >> 16) & 3
    { ProbMoe1F8 G; G.tb = tb; G.wv = P.wave; G.cnt = cn; G.G = gridDim.x; G.c = blockIdx.x; G.A = P.ws + WS_R4 + R4_H2; G.Bt = P.ws + WS_WGU; G.KB = 1024; G.tokk = (const unsigned*)(P.ws + WS_TOKK);
      EpiMoe1F8 E; E.hid = P.ws + WS_R4 + R4_HID; gemm_f8<ProbMoe1F8, EpiMoe1F8, (MK_REP >> 16) & 3>(lsm, G, E); }
    xcd_barrier(bar);
#endif
    REPS(9)
    { ProbMoe1F8 G; G.tb = tb; G.wv = P.wave; G.cnt = cn; G.G = gridDim.x; G.c = blockIdx.x; G.A = P.ws + WS_R4 + R4_H2; G.Bt = P.ws + WS_WGU; G.KB = 1024; G.tokk = (const unsigned*)(P.ws + WS_TOKK);
      EpiMoe1F8 E; E.hid = P.ws + WS_R4 + R4_HID; gemm_f8(lsm, G, E); }
    xcd_barrier(bar);
    REPS(10)
    { ProbMoe2F8 G; G.tb = tb; G.wv = P.wave; G.cnt = cn; G.G = gridDim.x; G.c = blockIdx.x; G.A = P.ws + WS_R4 + R4_HID; G.Bt = P.ws + WS_WD; G.KB = 512;
      EpiMoe2F8 E; E.Y = P.ws + WS_R4 + R4_Y; E.tokk = (const unsigned*)(P.ws + WS_TOKK); E.wl = (const float*)(P.ws + WS_WL); E.tb = tb; gemm_f8(lsm, G, E); }
    xcd_barrier(bar);
#else
    LAS int* tb = (LAS int*)(lsm + STAGE_BYTES); LAS int* cn = tb + 64;
    moe_tables(P, tb, cn);
    REPS(9)
    { ProbMoe1 G; G.tb = tb; G.wv = P.wave; G.cnt = cn; G.G = gridDim.x; G.c = blockIdx.x; G.A = (const bf16_t*)(P.ws + WS_R4 + R4_H2); G.Bt = (const bf16_t*)(P.ws + WS_WGU); G.K = 1024; G.tokk = (const unsigned*)(P.ws + WS_TOKK);
      EpiMoe1 E; E.hid = (bf16_t*)(P.ws + WS_R4 + R4_HID); gemm_phase(lsm, G, E); }
    xcd_barrier(bar);
    REPS(10)
    { ProbMoe2 G; G.tb = tb; G.wv = P.wave; G.cnt = cn; G.G = gridDim.x; G.c = blockIdx.x; G.A = (const bf16_t*)(P.ws + WS_R4 + R4_HID); G.Bt = (const bf16_t*)(P.ws + WS_WD); G.K = 512;
      EpiMoe2 E; E.Y = (bf16_t*)(P.ws + WS_R4 + R4_Y); E.tokk = (const unsigned*)(P.ws + WS_TOKK); E.wl = (const float*)(P.ws + WS_WL); E.tb = tb; gemm_phase(lsm, G, E); }
    xcd_barrier(bar);
#endif
#endif
#if (MK_PH >> 10) & 1
#if (MK_REP >> 12) & 1
    phase11_final(P, sm, (float*)(P.ws + WS_R4 + 300 * MiB));
#endif
    phase11_final(P, sm, P.out);
#endif
}

extern "C" void kernel_launch(void* const* d_in, const int* in_sizes, int n_in, void* d_out, int out_size, void* d_ws, size_t ws_size, hipStream_t stream) {
    (void)in_sizes; (void)n_in; (void)out_size;
    static int grid = 0;
    if (!grid) {
        int dev = 0, cus = 0, per_cu = 0;
        hipGetDevice(&dev);
        hipDeviceGetAttribute(&cus, hipDeviceAttributeMultiprocessorCount, dev);
        hipFuncSetAttribute((const void*)hymba_fwd, hipFuncAttributeMaxDynamicSharedMemorySize, LDS_BYTES);
        hipOccupancyMaxActiveBlocksPerMultiprocessor(&per_cu, hymba_fwd, 512, LDS_BYTES);
        if (per_cu < 1) { fprintf(stderr, "occupancy query says 0 blocks per CU\n"); per_cu = 1; }
        grid = cus;
        if (ws_size < WS_NEED) fprintf(stderr, "workspace too small: %zu < %zu\n", ws_size, (size_t)WS_NEED);
    }
    Params p{};
    p.x = (const float*)d_in[0]; p.c = (const float*)d_in[1]; p.ctx = (const float*)d_in[2]; p.c_ctx = (const float*)d_in[3]; p.w_mod = (const float*)d_in[4]; p.b_mod = (const float*)d_in[5];
    p.norm1_g = (const float*)d_in[6]; p.w_in = (const float*)d_in[7]; p.conv_w = (const float*)d_in[8]; p.a_log = (const float*)d_in[9]; p.dt_bias = (const float*)d_in[10]; p.onorm_g = (const float*)d_in[11];
    p.w_out = (const float*)d_in[12]; p.norm2_g = (const float*)d_in[13]; p.w_group = (const float*)d_in[14]; p.b_group = (const float*)d_in[15]; p.w_router = (const float*)d_in[16]; p.b_router = (const float*)d_in[17];
    p.w_gate = (const float*)d_in[18]; p.w_up = (const float*)d_in[19]; p.w_down = (const float*)d_in[20]; p.final_g = (const float*)d_in[21];
    p.out = (float*)d_out; p.ws = (unsigned char*)d_ws;
    hipMemsetAsync(d_ws, 0, WS_ZERO_BYTES, stream);
    hipLaunchKernelGGL(hymba_fwd, dim3(grid), dim3(512), LDS_BYTES, stream, p);
}
#endif
```

```cpp
#ifndef CPU_EMU
#include <hip/hip_runtime.h>
#include <cstdio>
#include <cstdint>
#define DEV __device__ __forceinline__
#define TID tid_local
__device__ __forceinline__ int mk_lane_volatile() { int l; asm volatile("v_mbcnt_lo_u32_b32 %0, -1, 0\n\tv_mbcnt_hi_u32_b32 %0, -1, %0" : "=v"(l)); return l; }
#define MK_TID(wave) ((wave) * 64 + mk_lane_volatile())
#define PHASE_TID int tid_local = MK_TID(P.wave); asm volatile("" : "+v"(tid_local))
#define BID ((int)blockIdx.x)
#define NBLK ((int)gridDim.x)
#define SYNC() __syncthreads()
#define SCHED_FENCE() __builtin_amdgcn_sched_barrier(0)
#endif

typedef unsigned short bf16_t;
typedef short bf16x8 __attribute__((ext_vector_type(8)));
typedef float f32x4 __attribute__((ext_vector_type(4)));
typedef unsigned u32x4 __attribute__((ext_vector_type(4)));
typedef unsigned u32x2 __attribute__((ext_vector_type(2)));

constexpr int D = 1024, NB = 8, SEQ = 8192, CTX = 256;
constexpr int NTOK = NB * SEQ;
constexpr int NCTX = NB * CTX;
constexpr int MROWS = NTOK + NCTX;
constexpr int W_IN = 2576;
constexpr int NSTEP = 4 + 128;
constexpr int NCHAIN = NB * 4 * 2;
constexpr int NPROB = NCHAIN * NSTEP;
constexpr float EPS = 1e-6f;
constexpr int NEXP = 32;
constexpr int LCAP = 65536;

constexpr int IMG_W = 0, IMG_KT = 16384, IMG_A = 32768, IMG_U = 40960, IMG_SC = 57344, IMG_BYTES = 57664;

constexpr size_t MiB = 1048576;
constexpr size_t WS_BAR = 0;
constexpr size_t WS_MOD = 16384;
constexpr size_t WS_CNT = 16384 + 221184;
constexpr size_t WS_ZERO_BYTES = WS_CNT + 16384;
constexpr size_t WS_TAB = 262144;
constexpr size_t WS_BIAS = 393216;
constexpr size_t WS_RSTD = 5 * MiB + 524288;
constexpr size_t WS_GB = 1 * MiB;
constexpr size_t WS_TOKK = 6 * MiB;
constexpr size_t WS_WL = 14 * MiB;
constexpr size_t WS_W = 22 * MiB;
constexpr size_t WS_WQKVZ = WS_W;
constexpr size_t WS_WF = WS_WQKVZ + 2048ull * 1024 * 2;
constexpr size_t WS_WOUT = WS_WF + 1024ull * 1024 * 2;
constexpr size_t WS_WGU = WS_WOUT + 1024ull * 1024 * 2;
constexpr size_t WS_WD = WS_WGU + 32ull * 1024 * 1024 * 2;
constexpr size_t WS_R3 = 126 * MiB;
constexpr size_t WS_R4 = 324 * MiB;
constexpr size_t WS_NEED = WS_R4 + 645 * MiB;
constexpr size_t R4_H = 0, R4_P = 132 * MiB;
constexpr size_t R4_AMIX = 0, R4_H2 = 128 * MiB, R4_HID = 256 * MiB, R4_Y = 0;
constexpr size_t R4_PROJ = 384 * MiB;
constexpr size_t R4_X1B = 512 * MiB;
constexpr size_t R4_OBUF = 480 * MiB;
constexpr size_t DO_GT = 0, DO_ZT = 128 * MiB, DO_ZS = 192 * MiB;

constexpr int LDS_BYTES = 163840;

struct Params {
    const float *x, *c, *ctx, *c_ctx, *w_mod, *b_mod, *norm1_g, *w_in, *conv_w, *a_log, *dt_bias, *onorm_g, *w_out, *norm2_g,
                *w_group, *b_group, *w_router, *b_router, *w_gate, *w_up, *w_down, *final_g;
    float* out;
    unsigned char* ws;
    int wave;
};

DEV bf16_t f2bf(float f) { unsigned u = __builtin_bit_cast(unsigned, f); u += 0x7FFFu + ((u >> 16) & 1u); return (bf16_t)(u >> 16); }
DEV float bf2f(bf16_t b) { return __builtin_bit_cast(float, ((unsigned)b) << 16); }
#ifndef MK_REP
#define MK_REP 0
#endif
#ifndef MK_TP
#define MK_TP 0
#endif
#ifndef MK_F8
#define MK_F8 2
#endif
#ifndef CPU_EMU
DEV unsigned pk4_fp8(float a, float b, float c, float d) { int t = 0; t = __builtin_amdgcn_cvt_pk_fp8_f32(a, b, t, false); t = __builtin_amdgcn_cvt_pk_fp8_f32(c, d, t, true); return (unsigned)t; }
typedef __bf16 bf16n2 __attribute__((ext_vector_type(2)));
DEV unsigned pk2(float lo, float hi) { bf16n2 v; v[0] = (__bf16)lo; v[1] = (__bf16)hi; return __builtin_bit_cast(unsigned, v); }
DEV float rcp_f(float x) { return __builtin_amdgcn_rcpf(x); }
DEV float rsq_f(float x) { return __builtin_amdgcn_rsqf(x); }
#else
DEV unsigned pk2(float lo, float hi) { return (unsigned)f2bf(lo) | ((unsigned)f2bf(hi) << 16); }
DEV float rcp_f(float x) { return 1.0f / x; }
DEV float rsq_f(float x) { return 1.0f / sqrtf(x); }
#endif
DEV float silu_f(float v) { return v * rcp_f(1.0f + __expf(-v)); }

#ifndef CPU_EMU
DEV f32x4 mfma16(bf16x8 a, bf16x8 b, f32x4 c) { return __builtin_amdgcn_mfma_f32_16x16x32_bf16(a, b, c, 0, 0, 0); }
DEV float shfl_xor_f(float v, int m) { return __shfl_xor(v, m); }
DEV float shfl_up_f(float v, int d) { return __shfl_up(v, d); }
DEV float shfl_idx_f(float v, int l) { return __shfl(v, l); }
DEV void atomic_add_f32(float* p, float v) { atomicAdd(p, v); }
DEV unsigned atomic_add_u32(unsigned* p, unsigned v) { return atomicAdd(p, v); }
DEV void sincospi_f(float x, float* s, float* c) { sincospif(x, s, c); }
#endif

DEV float wave_sum(float v) {
#pragma unroll
    for (int o = 32; o >= 1; o >>= 1) v += shfl_xor_f(v, o);
    return v;
}
template <int N> DEV float wave_sum_multi(const float (&v)[N], int lane) {
    float a[N];
#pragma unroll
    for (int i = 0; i < N; ++i) a[i] = v[i];
    int m = 1;
#pragma unroll
    for (int n = N; n > 1; n >>= 1, m <<= 1) {
        const bool up = (lane & m) != 0;
#pragma unroll
        for (int i = 0; i < n / 2; ++i) { const float keep = up ? a[2 * i + 1] : a[2 * i], send = up ? a[2 * i] : a[2 * i + 1]; a[i] = keep + shfl_xor_f(send, m); }
    }
    float r = a[0];
#pragma unroll
    for (int o = N; o < 64; o <<= 1) r += shfl_xor_f(r, o);
    return r;
}
#ifndef CPU_EMU
DEV float lane_bcast(float v, int l) { return __builtin_bit_cast(float, __builtin_amdgcn_readlane(__builtin_bit_cast(int, v), l)); }
#endif
DEV bf16x8 frag_gather(const bf16_t* p, int stride) {
    bf16x8 r;
#pragma unroll
    for (int j = 0; j < 8; ++j) r[j] = (short)p[j * stride];
    return r;
}
DEV bf16x8 frag16(const bf16_t* p) { return *(const bf16x8*)p; }

DEV void phase0_mod(const Params& P, unsigned char* sm) {
    PHASE_TID;
    float* sil = (float*)sm;
    float* red = (float*)(sm + 36864);
    for (int i = TID; i < 9 * 1024; i += 512) { const int r = i >> 10, k = i & 1023; const float v = r < 8 ? P.c[r * 1024 + k] : P.c_ctx[k]; sil[i] = silu_f(v); }
    SYNC();
    float* mod = (float*)(P.ws + WS_MOD);
    for (int cb = BID; cb < 256; cb += NBLK) {
        const int c = TID % 24, kg = TID / 24, j0 = cb * 24;
        if (kg < 21) {
            float acc[9];
#pragma unroll
            for (int r = 0; r < 9; ++r) acc[r] = 0.f;
#pragma unroll 7
            for (int k = kg; k < 1024; k += 21) { const float w = P.w_mod[(size_t)k * 6144 + j0 + c];
#pragma unroll
                for (int r = 0; r < 9; ++r) acc[r] += sil[r * 1024 + k] * w; }
#pragma unroll
            for (int r = 0; r < 9; ++r) red[(kg * 24 + c) * 9 + r] = acc[r];
        }
        SYNC();
        if (TID < 24 * 9) { const int cc = TID / 9, r = TID - cc * 9; float t = P.b_mod[j0 + cc];
            for (int g = 0; g < 21; ++g) t += red[(g * 24 + cc) * 9 + r];
            mod[r * 6144 + j0 + cc] = t; }
        SYNC();
    }
}

struct WJob { const float* src; unsigned char* dst; int lds_, ldd, inter, f8; };
DEV WJob wjob(const Params& P, int t) {
    unsigned char* wqkvz = P.ws + WS_WQKVZ; unsigned char* wout = P.ws + WS_WOUT; unsigned char* wgu = P.ws + WS_WGU; unsigned char* wd = P.ws + WS_WD;
    WJob j;
    if (t < 128) { const int kt = t >> 3, nt = t & 7;
        j.src = P.w_in + (size_t)(kt * 64) * W_IN + 512 + nt * 256; j.lds_ = W_IN; j.dst = wqkvz + ((size_t)(nt * 256) * 1024 + kt * 64) * 2; j.ldd = 2048; j.inter = 0; j.f8 = 0;
    } else if (t < 192) { const int u = t - 128, kt = u >> 2, nt = u & 3;
        j.src = P.w_out + (size_t)(kt * 64) * 1024 + nt * 256; j.lds_ = 1024; j.dst = wout + ((size_t)(nt * 256) * 1024 + kt * 64) * 2; j.ldd = 2048; j.inter = 0; j.f8 = 0;
    } else if (t < 192 + 2048) { const int u = t - 192, up = u >> 10, v = u & 1023, e = v >> 5, w = v & 31, kt = w >> 1, nt = w & 1;
        j.src = (up ? P.w_up : P.w_gate) + (size_t)e * 1024 * 512 + (size_t)(kt * 64) * 512 + nt * 256; j.lds_ = 512; j.inter = 1 + up;
#if MK_F8
        j.dst = wgu + (size_t)e * 1024 * 1024 + (size_t)(nt * 512) * 1024 + kt * 64; j.ldd = 1024; j.f8 = 1;
#else
        j.dst = wgu + ((size_t)e * 1024 * 1024 + (size_t)(nt * 512) * 1024 + kt * 64) * 2; j.ldd = 2048; j.f8 = 0;
#endif
    } else { const int v = t - 192 - 2048, e = v >> 5, w = v & 31, kt = w >> 2, nt = w & 3;
        j.src = P.w_down + (size_t)e * 512 * 1024 + (size_t)(kt * 64) * 1024 + nt * 256; j.lds_ = 1024; j.inter = 0;
#if MK_F8
        j.dst = wd + (size_t)e * 1024 * 512 + (size_t)(nt * 256) * 512 + kt * 64; j.ldd = 512; j.f8 = 1;
#else
        j.dst = wd + ((size_t)e * 1024 * 512 + (size_t)(nt * 256) * 512 + kt * 64) * 2; j.ldd = 1024; j.f8 = 0;
#endif
    }
    return j;
}
DEV void phase0_weights(const Params& P, unsigned char* sm) {
    PHASE_TID;
    float* tile = (float*)sm;
    const int NJ = 128 + 64 + 3 * 1024;
    f32x4 v[8];
    int t = BID;
    if (t < NJ) { const WJob j = wjob(P, t);
#pragma unroll
        for (int q = 0; q < 8; ++q) v[q] = __builtin_nontemporal_load((const f32x4*)(j.src + (size_t)((TID >> 6) + q * 8) * j.lds_ + (TID & 63) * 4)); }
    for (; t < NJ; t += NBLK) {
        const WJob j = wjob(P, t);
#pragma unroll
        for (int q = 0; q < 8; ++q) { float* tp = tile + ((TID >> 6) + q * 8) * 257 + (TID & 63) * 4; tp[0] = v[q][0]; tp[1] = v[q][1]; tp[2] = v[q][2]; tp[3] = v[q][3]; }
        { const WJob jn = wjob(P, t + NBLK < NJ ? t + NBLK : t);
#pragma unroll
          for (int q = 0; q < 8; ++q) v[q] = __builtin_nontemporal_load((const f32x4*)(jn.src + (size_t)((TID >> 6) + q * 8) * jn.lds_ + (TID & 63) * 4)); }
        SYNC();
        const int c = TID & 255, half = TID >> 8;
        if (j.f8) {
            const int c5 = c & 31, p32 = 16 * ((c5 >> 2) & 1) + 4 * (c5 >> 3) + (c5 & 3), s64 = (c & 0xC3) | (((c >> 2) & 3) << 4) | (((c >> 4) & 3) << 2);
#if MK_F8 == 2
            const int drow8 = j.inter ? ((c >> 7) * 256 + (j.inter - 1) * 128 + ((c >> 5) & 3) * 32 + ((c >> 2) & 1) * 16 + ((c >> 3) & 3) * 4 + (c & 3))
                                      : (((c >> 3) & 1) * 128 + (c >> 6) * 32 + ((c >> 2) & 1) * 16 + ((c >> 4) & 3) * 4 + (c & 3));
            (void)p32; (void)s64;
#else
            const int drow8 = j.inter ? ((c >> 7) * 256 + ((c >> 5) & 3) * 64 + (j.inter - 1) * 32 + p32) : s64;
#endif
            u32x4 w[2];
#pragma unroll
            for (int q = 0; q < 2; ++q)
#pragma unroll
                for (int jj = 0; jj < 4; ++jj) { const int k0 = half * 32 + q * 16 + jj * 4; w[q][jj] = pk4_fp8(tile[k0 * 257 + c] * 32.0f, tile[(k0 + 1) * 257 + c] * 32.0f, tile[(k0 + 2) * 257 + c] * 32.0f, tile[(k0 + 3) * 257 + c] * 32.0f); }
            unsigned char* d8 = j.dst + (size_t)drow8 * j.ldd + half * 32;
            *(u32x4*)d8 = w[0]; *(u32x4*)(d8 + 16) = w[1];
        } else {
            const int drow = j.inter ? ((c >> 7) * 256 + (j.inter - 1) * 128 + (c & 127)) : c;
            u32x4 w[4];
#pragma unroll
            for (int q = 0; q < 4; ++q)
#pragma unroll
                for (int jj = 0; jj < 4; ++jj) w[q][jj] = pk2(tile[(half * 32 + q * 8 + 2 * jj) * 257 + c], tile[(half * 32 + q * 8 + 2 * jj + 1) * 257 + c]);
            unsigned char* d2 = j.dst + (size_t)drow * j.ldd + half * 64;
#pragma unroll
            for (int q = 0; q < 4; ++q) *(u32x4*)(d2 + q * 16) = w[q];
        }
        SYNC();
    }
}

DEV void phase0_wf(const Params& P, unsigned char* sm) {
    PHASE_TID;
    float* cs = (float*)sm;
    if (TID < 128) { float s, c; sincospi_f((float)TID * (2.0f / 128.0f), &s, &c); cs[TID] = c; cs[128 + TID] = s; }
    SYNC();
    bf16_t* wf = (bf16_t*)(P.ws + WS_WF);
    const float sc = 0.08838834764831845f;
    for (int it = BID; it < 256; it += NBLK) {
        const int kb = it & 1, cb = (it >> 1) & 15, part = (it >> 5) & 1, g = it >> 6;
        const int k = kb * 512 + TID;
        const float* wrow = P.w_in + (size_t)k * W_IN + g * 128;
        float acc[8];
#pragma unroll
        for (int q = 0; q < 8; ++q) acc[q] = 0.f;
#pragma unroll 8
        for (int c4 = 0; c4 < 32; ++c4) { const f32x4 w4 = *(const f32x4*)(wrow + c4 * 4);
#pragma unroll
            for (int e = 0; e < 4; ++e) { const int c = c4 * 4 + e;
#pragma unroll
                for (int q = 0; q < 8; ++q) { const int cp = cb * 8 + q; acc[q] += w4[e] * cs[part * 128 + ((c * cp) & 127)]; } } }
#pragma unroll
        for (int q = 0; q < 8; ++q) { const int chc = part * 512 + g * 128 + cb * 8 + q; wf[(size_t)chc * 1024 + k] = f2bf((part ? -acc[q] : acc[q]) * sc); }
    }
    bf16_t* tab = (bf16_t*)(P.ws + WS_TAB);
    const float sc2 = 0.011048543456039806f;
    for (int i = BID * 512 + TID; i < 4096 + 16384; i += NBLK * 512) {
        if (i < 4096) { const int a = i >> 6, b = i & 63; float s, c; sincospi_f((float)((a * b) & 63) * (2.0f / 64.0f), &s, &c); tab[i] = f2bf(c); tab[4096 + i] = f2bf(s); }
        else { const int j = i - 4096, a = j >> 7, b = j & 127; float s, c; sincospi_f((float)((a * b) & 127) * (2.0f / 128.0f), &s, &c); tab[8192 + j] = f2bf(c * sc2); tab[8192 + 16384 + j] = f2bf(s * sc2); }
    }
}

DEV void phase1_prep(const Params& P, unsigned char* sm) {
    PHASE_TID;
    bf16_t* Bhi = (bf16_t*)sm; bf16_t* Blo = (bf16_t*)(sm + 33024);
    float* gsv = (float*)(sm + 66048);
    float* gbl = (float*)(sm + 70144);
    {
        f32x4 w[2][4];
#pragma unroll
        for (int h = 0; h < 2; ++h)
#pragma unroll
            for (int q = 0; q < 4; ++q) w[h][q] = *(const f32x4*)(P.w_in + (size_t)(TID + h * 512) * W_IN + 2560 + q * 4);
#pragma unroll
        for (int h = 0; h < 2; ++h)
#pragma unroll
            for (int q = 0; q < 4; ++q)
#pragma unroll
                for (int e = 0; e < 4; ++e) { const int n = q * 4 + e, k = TID + h * 512; const float v = w[h][q][e]; const bf16_t hi = f2bf(v); Bhi[n * 1032 + k] = hi; Blo[n * 1032 + k] = f2bf(v - bf2f(hi)); }
    }
    const float* mod = (const float*)(P.ws + WS_MOD);
    bf16_t* h = (bf16_t*)(P.ws + WS_R4 + R4_H);
    float* gb = (float*)(P.ws + WS_GB);
    float* rstd_arr = (float*)(P.ws + WS_RSTD);
    float* bias = (float*)(P.ws + WS_BIAS);
    const int wid = TID >> 6, lane = TID & 63, fr = lane & 15, fq = lane >> 4;
    SYNC();
    const float* shrow = mod + (fr < 8 ? fr : 8) * 6144 + fq * 8;
    if (TID < 256) gbl[TID] = 0.f;
    SYNC();
    {
        f32x4 acc = (f32x4){0.f, 0.f, 0.f, 0.f};
#pragma unroll
        for (int k4 = 0; k4 < 4; ++k4) {
            const int ks = wid * 4 + k4;
            const f32x4 a0 = *(const f32x4*)(shrow + ks * 32), a1 = *(const f32x4*)(shrow + ks * 32 + 4);
            const float hv[8] = {a0[0], a0[1], a0[2], a0[3], a1[0], a1[1], a1[2], a1[3]};
            u32x4 whi, wlo;
#pragma unroll
            for (int e = 0; e < 4; ++e) { whi[e] = pk2(hv[2 * e], hv[2 * e + 1]); wlo[e] = pk2(hv[2 * e] - __builtin_bit_cast(float, whi[e] << 16), hv[2 * e + 1] - __builtin_bit_cast(float, whi[e] & 0xffff0000u)); }
            const bf16x8 ahi = __builtin_bit_cast(bf16x8, whi), alo = __builtin_bit_cast(bf16x8, wlo);
            const bf16x8 bhi = frag16(Bhi + fr * 1032 + ks * 32 + fq * 8), blo = frag16(Blo + fr * 1032 + ks * 32 + fq * 8);
            acc = mfma16(ahi, bhi, acc); acc = mfma16(alo, bhi, acc); acc = mfma16(ahi, blo, acc);
        }
#pragma unroll
        for (int r = 0; r < 4; ++r) atomic_add_f32(&gbl[(fq * 4 + r) * 16 + fr], acc[r]);
    }
    {
        const bf16_t* wq = (const bf16_t*)(P.ws + WS_WQKVZ); const bf16_t* wf = (const bf16_t*)(P.ws + WS_WF);
        for (int it = BID * 8 + wid; it < 192; it += NBLK * 8) {
            const int n0 = it * 16;
            const bf16_t* wrow = (n0 < 2048 ? wq + (size_t)(n0 + fr) * 1024 : wf + (size_t)(n0 - 2048 + fr) * 1024) + fq * 8;
            f32x4 acc = (f32x4){0.f, 0.f, 0.f, 0.f};
#pragma unroll 4
            for (int ks = 0; ks < 32; ++ks) {
                const f32x4 a0 = *(const f32x4*)(shrow + ks * 32), a1 = *(const f32x4*)(shrow + ks * 32 + 4);
                const float hv[8] = {a0[0], a0[1], a0[2], a0[3], a1[0], a1[1], a1[2], a1[3]};
                u32x4 whi, wlo;
#pragma unroll
                for (int e = 0; e < 4; ++e) { whi[e] = pk2(hv[2 * e], hv[2 * e + 1]); wlo[e] = pk2(hv[2 * e] - __builtin_bit_cast(float, whi[e] << 16), hv[2 * e + 1] - __builtin_bit_cast(float, whi[e] & 0xffff0000u)); }
                const bf16x8 bw = frag16(wrow + ks * 32);
                acc = mfma16(__builtin_bit_cast(bf16x8, whi), bw, acc); acc = mfma16(__builtin_bit_cast(bf16x8, wlo), bw, acc);
            }
#pragma unroll
            for (int r = 0; r < 4; ++r) { const int mbr = fq * 4 + r; if (mbr < 9) bias[mbr * 3072 + n0 + fr] = acc[r]; }
        }
    }
    for (int t = BID; t < MROWS / 128; t += NBLK) {
        const int r0 = t * 128 + wid * 16, mb = (t * 128 < NTOK) ? ((t * 128) >> 13) : 8;
        SYNC();
        { const float* scale = mod + mb * 6144 + 1024;
#pragma unroll
          for (int q = 0; q < 2; ++q) { const int k = TID + q * 512; gsv[k] = P.norm1_g[k] * (1.0f + scale[k]); } }
        SYNC();
        const int rr = r0 + fr;
        const float* src = (rr < NTOK ? P.x + (size_t)rr * D : P.ctx + (size_t)(rr - NTOK) * D) + fq * 8;
        float ss = 0.f;
        f32x4 acc = (f32x4){0.f, 0.f, 0.f, 0.f};
        bf16_t* hrow = h + (size_t)rr * D + fq * 8;
        f32x4 bA[4][2], bB[4][2];
#define P1_LD(buf, kb) do { _Pragma("unroll") for (int j = 0; j < 4; ++j) { buf[j][0] = *(const f32x4*)(src + ((kb) * 4 + j) * 32); buf[j][1] = *(const f32x4*)(src + ((kb) * 4 + j) * 32 + 4); } SCHED_FENCE(); } while (0)
#define P1_STEP(a0, a1, ks) do { \
            ss += a0[0] * a0[0] + a0[1] * a0[1] + a0[2] * a0[2] + a0[3] * a0[3] + a1[0] * a1[0] + a1[1] * a1[1] + a1[2] * a1[2] + a1[3] * a1[3]; \
            const f32x4 g0 = *(const f32x4*)(gsv + (ks) * 32 + fq * 8), g1 = *(const f32x4*)(gsv + (ks) * 32 + fq * 8 + 4); \
            float hv[8]; \
            _Pragma("unroll") for (int e = 0; e < 4; ++e) { hv[e] = a0[e] * g0[e]; hv[4 + e] = a1[e] * g1[e]; } \
            u32x4 whi, wlo; \
            _Pragma("unroll") for (int e = 0; e < 4; ++e) { whi[e] = pk2(hv[2 * e], hv[2 * e + 1]); wlo[e] = pk2(hv[2 * e] - __builtin_bit_cast(float, whi[e] << 16), hv[2 * e + 1] - __builtin_bit_cast(float, whi[e] & 0xffff0000u)); } \
            *(u32x4*)(hrow + (ks) * 32) = whi; \
            const bf16x8 ahi = __builtin_bit_cast(bf16x8, whi), alo = __builtin_bit_cast(bf16x8, wlo); \
            const bf16x8 bhi = frag16(Bhi + fr * 1032 + (ks) * 32 + fq * 8), blo = frag16(Blo + fr * 1032 + (ks) * 32 + fq * 8); \
            acc = mfma16(ahi, bhi, acc); acc = mfma16(alo, bhi, acc); acc = mfma16(ahi, blo, acc); } while (0)
        P1_LD(bA, 0);
#pragma unroll
        for (int kb = 0; kb < 8; kb += 2) {
            P1_LD(bB, kb + 1);
#pragma unroll
            for (int j = 0; j < 4; ++j) P1_STEP(bA[j][0], bA[j][1], kb * 4 + j);
            SCHED_FENCE();
            if (kb + 2 < 8) P1_LD(bA, kb + 2);
#pragma unroll
            for (int j = 0; j < 4; ++j) P1_STEP(bB[j][0], bB[j][1], (kb + 1) * 4 + j);
            SCHED_FENCE();
        }
#undef P1_LD
#undef P1_STEP
        ss += shfl_xor_f(ss, 16); ss += shfl_xor_f(ss, 32);
        const float rstd = rsq_f(ss * (1.0f / 1024.0f) + EPS);
        if (fq == 0) rstd_arr[rr] = rstd;
        float ea = 0.f, db = 0.f;
        if (fr >= 8) { ea = -__expf(P.a_log[fr - 8]); db = P.dt_bias[fr - 8]; }
        const float gbias = gbl[mb * 16 + fr];
#pragma unroll
        for (int reg = 0; reg < 4; ++reg) { const float v = acc[reg] * shfl_idx_f(rstd, fq * 4 + reg) + gbias; float o;
            if (fr < 8) o = rcp_f(1.0f + __expf(-v));
            else { const float z = v + db; const float sp = z > 20.f ? z : log1pf(__expf(z)); o = ea * sp; }
            gb[(size_t)(r0 + fq * 4 + reg) * 16 + fr] = o; }
    }
}

#ifndef CPU_EMU
namespace pg8 {
#define PG8_LAS __attribute__((address_space(3)))
constexpr int BM = 256, BK = 64, HALF = 128, HTB = HALF * BK * 2, STAGE_BYTES = 8 * HTB;
__device__ __forceinline__ int lds_byte(int r, int c) { const int st = (r >> 4) * 2 + (c >> 5), rr = r & 15, cc = c & 31, ob = rr * 64 + cc * 2; return st * 1024 + (ob ^ (((ob >> 9) & 1) << 5)); }
__device__ __forceinline__ void stage_rc(int b, int& R, int& C) { const int st = b / 1024, sb = b % 1024, swz = sb ^ (((sb >> 9) & 1) << 5); R = (st >> 1) * 16 + swz / 64; C = (st & 1) * 32 + (swz % 64) / 2; }
__device__ __forceinline__ int perm32(int rho) { const int n = rho >> 4, i = rho & 15; return 8 * (i >> 2) + 4 * n + (i & 3); }
struct Unit { int pm, pn, e, cnt; };
typedef int v8i32 __attribute__((ext_vector_type(8)));
typedef int v4i32 __attribute__((ext_vector_type(4)));
__device__ __forceinline__ unsigned cvt_pk_bf16(float lo, float hi) { unsigned r; asm volatile("v_cvt_pk_bf16_f32 %0, %1, %2" : "=v"(r) : "v"(lo), "v"(hi)); return r; }

template <class Prob, class Epi>
__device__ __forceinline__ void gemm_phase(PG8_LAS unsigned char* lds, const Prob& G, const Epi& E) {
    int tid_ = MK_TID(G.wv); asm volatile("" : "+v"(tid_));
    const int tid = tid_, wid = __builtin_amdgcn_readfirstlane(tid >> 6), lane = tid & 63, wr = wid >> 2, wc = wid & 3, fr = lane & 15, fq = lane >> 4;
    const int K = G.K, nt = K / BK;
    int R0, C0; stage_rc(tid * 16, R0, C0);
    const int rA0 = R0, rA1 = R0 + 64;
    const int rB0 = Epi::PERM ? ((R0 & ~31) + perm32(R0 & 31)) : R0, rB1 = Epi::PERM ? (((R0 + 64) & ~31) + perm32((R0 + 64) & 31)) : R0 + 64;
    const unsigned ldsw = (unsigned)wid * 1024u;
    const int aoff = lds_byte(wr * 64 + fr, fq * 8), boff = lds_byte(wc * 32 + fr, fq * 8);
    const unsigned ldsbase = (unsigned)__builtin_amdgcn_readfirstlane((int)(unsigned)(__SIZE_TYPE__)(lds + ldsw));
    const char* Ab = (const char*)G.A; const char* Bb = (const char*)G.Bt;
#define PG8_SA(b, h) (((b) * 2 + (h)) * HTB)
#define PG8_SB(b, h) ((4 + (b) * 2 + (h)) * HTB)
#define PG8_STAGE(bufoff, gbase, ub, l0, l1) do { \
        if constexpr (Prob::F8) {     \
            const char* sb_ = (gbase) + (size_t)(ub); const unsigned m0_ = ldsbase + (unsigned)(bufoff); \
            asm volatile("s_mov_b32 m0, %2\n\ts_nop 0\n\tglobal_load_lds_dwordx4 %0, %1\n\ts_mov_b32 m0, %4\n\ts_nop 0\n\tglobal_load_lds_dwordx4 %3, %1" \
                         :: "v"(l0), "s"(sb_), "s"(m0_), "v"(l1), "s"(m0_ + 8192u) : "memory", "m0"); \
        } else { \
        __builtin_amdgcn_global_load_lds((const unsigned*)((gbase) + (size_t)(ub) + (l0)), (PG8_LAS unsigned*)(lds + (bufoff) + ldsw), 16, 0, 0); \
        __builtin_amdgcn_global_load_lds((const unsigned*)((gbase) + (size_t)(ub) + (l1)), (PG8_LAS unsigned*)(lds + (bufoff) + ldsw + 8192), 16, 0, 0); } } while (0)
#define PG8_LDA(dst, b, h) do { _Pragma("unroll") for (int m = 0; m < 4; ++m) _Pragma("unroll") for (int k = 0; k < 2; ++k) dst[m][k] = *(const PG8_LAS bf16x8*)(lds + PG8_SA(b, h) + aoff + m * 2048 + k * 1024); } while (0)
#define PG8_LDB(dst, b, h) do { _Pragma("unroll") for (int n = 0; n < 2; ++n) _Pragma("unroll") for (int k = 0; k < 2; ++k) dst[n][k] = *(const PG8_LAS bf16x8*)(lds + PG8_SB(b, h) + boff + n * 2048 + k * 1024); } while (0)
#define PG8_CAT(f) __builtin_shufflevector(__builtin_bit_cast(v4i32, f[0]), __builtin_bit_cast(v4i32, f[1]), 0, 1, 2, 3, 4, 5, 6, 7)
#define PG8_MMA(ai, bj, At, Bt) do { __builtin_amdgcn_s_setprio(1); \
        if constexpr (Prob::F8) { _Pragma("unroll") for (int m = 0; m < 4; ++m) _Pragma("unroll") for (int n = 0; n < 2; ++n) \
            acc[ai][bj][m][n] = __builtin_amdgcn_mfma_scale_f32_16x16x128_f8f6f4(PG8_CAT(Bt[n]), PG8_CAT(At[m]), acc[ai][bj][m][n], 0, 0, 0, 0, 0, 0); } \
        else { _Pragma("unroll") for (int m = 0; m < 4; ++m) _Pragma("unroll") for (int n = 0; n < 2; ++n) _Pragma("unroll") for (int k = 0; k < 2; ++k) \
            acc[ai][bj][m][n] = __builtin_amdgcn_mfma_f32_16x16x32_bf16(Bt[n][k], At[m][k], acc[ai][bj][m][n], 0, 0, 0); } \
        __builtin_amdgcn_s_setprio(0); } while (0)
#define PG8_WAIT_V(n) asm volatile("s_waitcnt vmcnt(" #n ")" ::: "memory")
#define PG8_WAIT_L(n) asm volatile("s_waitcnt lgkmcnt(" #n ")" ::: "memory")
#define PG8_BAR __builtin_amdgcn_s_barrier()
#define PG8_SCHED __builtin_amdgcn_sched_barrier(0)
    Unit cur, nxt; int ui = 0;
    if (!G.next(0, cur)) return;
    f32x4 acc[2][2][4][2];
#pragma unroll
    for (int a = 0; a < 2; ++a)
#pragma unroll
        for (int b = 0; b < 2; ++b)
#pragma unroll
            for (int m = 0; m < 4; ++m)
#pragma unroll
                for (int n = 0; n < 2; ++n) acc[a][b][m][n] = (f32x4){0.f, 0.f, 0.f, 0.f};
    bf16x8 At[4][2], B0[2][2], B1[2][2];
    const unsigned cb2 = (unsigned)C0 * 2u;
    const unsigned lB00 = G.laneB(rB0) + cb2, lB01 = G.laneB(rB1) + cb2, lB10 = G.laneB(128 + rB0) + cb2, lB11 = G.laneB(128 + rB1) + cb2;
    const unsigned lA00 = G.laneA(rA0) + cb2, lA01 = G.laneA(rA1) + cb2, lA10 = G.laneA(128 + rA0) + cb2, lA11 = G.laneA(128 + rA1) + cb2;
    unsigned cA00 = lA00, cA01 = lA01, cA10 = lA10, cA11 = lA11, nA00 = lA00, nA01 = lA01, nA10 = lA10, nA11 = lA11;
    if constexpr (Prob::GATHER_A) { cA00 += G.gathA(cur, rA0); cA01 += G.gathA(cur, rA1); cA10 += G.gathA(cur, 128 + rA0); cA11 += G.gathA(cur, 128 + rA1); }
    unsigned uAc = G.baseA(cur), uBc = G.baseB(cur), uAn = uAc, uBn = uBc;
    if constexpr (Epi::PREFETCH) E.prefetch(cur, lds + STAGE_BYTES + 2048, wid, lane);
    PG8_STAGE(PG8_SB(0, 0), Bb, uBc, lB00, lB01); PG8_STAGE(PG8_SA(0, 0), Ab, uAc, cA00, cA01); PG8_STAGE(PG8_SB(0, 1), Bb, uBc, lB10, lB11); PG8_STAGE(PG8_SA(0, 1), Ab, uAc, cA10, cA11);
    if (wr == 1) PG8_BAR;
    PG8_WAIT_V(4); PG8_BAR;
    PG8_STAGE(PG8_SB(1, 0), Bb, uBc + 128u, lB00, lB01); PG8_STAGE(PG8_SA(1, 0), Ab, uAc + 128u, cA00, cA01); PG8_STAGE(PG8_SB(1, 1), Bb, uBc + 128u, lB10, lB11);
    PG8_WAIT_V(6); PG8_BAR;
#if MK_TP
    long long tp_t0 = 0, tp_acc = 0;
#if MK_TP == 5
    const long long tp_all0 = (long long)__builtin_readcyclecounter();
#endif
#endif
    for (;;) {
        const bool has_next = G.next(ui + 1, nxt);
        if constexpr (Epi::PREFETCH) { if (has_next) { const int lane_o = mk_lane_volatile(); E.prefetch(nxt, lds + STAGE_BYTES + 2048 + ((ui + 1) % 3) * 2048, wid, lane_o); } }
        if constexpr (Prob::LDSGATH) { if (has_next) { const int lane_o = mk_lane_volatile(); G.prefetchA(nxt, lds + STAGE_BYTES + 8192, wid, lane_o); } }
        if (has_next) {
            uAn = G.baseA(nxt); uBn = G.baseB(nxt);
            if constexpr (Prob::GATHER_A && !Prob::LDSGATH) { nA00 = lA00 + G.gathA(nxt, rA0); nA01 = lA01 + G.gathA(nxt, rA1); nA10 = lA10 + G.gathA(nxt, 128 + rA0); nA11 = lA11 + G.gathA(nxt, 128 + rA1); }
        } else { uAn = uAc; uBn = uBc; if constexpr (Prob::GATHER_A && !Prob::LDSGATH) { nA00 = cA00; nA01 = cA01; nA10 = cA10; nA11 = cA11; } }
#if MK_TP == 1
        if constexpr (Epi::TP) { if (ui > 0) tp_acc += (long long)__builtin_readcyclecounter() - tp_t0; }
#endif
#if MK_TP == 2 || MK_TP == 4
        if constexpr (Epi::TP) tp_t0 = (long long)__builtin_readcyclecounter();
#endif
        for (int t = 0; t < nt; t += 2) {
            const bool last = (t == nt - 2);
#if MK_TP == 2
            if constexpr (Epi::TP) { if (t == 4) tp_acc += (long long)__builtin_readcyclecounter() - tp_t0; }
#endif
#if MK_TP == 4
            if constexpr (Epi::TP) { if (ui > 0 && last) tp_t0 = (long long)__builtin_readcyclecounter(); }
#endif
#if MK_TP == 3
            if constexpr (Epi::TP) { if (ui > 0 && t == 4) tp_t0 = (long long)__builtin_readcyclecounter(); if (ui > 0 && t == 6) tp_acc += (long long)__builtin_readcyclecounter() - tp_t0; }
#endif
            const unsigned k1 = (unsigned)(t + 1) * 128u;
            const unsigned uA2 = last ? uAn : uAc + (unsigned)(t + 2) * 128u, uB2 = last ? uBn : uBc + (unsigned)(t + 2) * 128u, uA3 = uA2 + 128u, uB3 = uB2 + 128u;
            unsigned a00 = cA00, a01 = cA01, a10 = cA10, a11 = cA11;
            if constexpr (Prob::GATHER_A && !Prob::LDSGATH) { a00 = last ? nA00 : cA00; a01 = last ? nA01 : cA01; a10 = last ? nA10 : cA10; a11 = last ? nA11 : cA11; }
            PG8_LDB(B0, 0, 0); PG8_SCHED; PG8_LDA(At, 0, 0); PG8_STAGE(PG8_SA(1, 1), Ab, uAc + k1, cA10, cA11);
            PG8_WAIT_L(8); PG8_BAR; PG8_WAIT_L(0); PG8_MMA(0, 0, At, B0); PG8_BAR; PG8_SCHED;
            if constexpr (Prob::LDSGATH) {
                if (last && has_next) { const PG8_LAS unsigned char* gb = lds + STAGE_BYTES + 8192;
                    cA00 = lA00 + G.gathL(nxt, gb, rA0); cA01 = lA01 + G.gathL(nxt, gb, rA1); cA10 = lA10 + G.gathL(nxt, gb, 128 + rA0); cA11 = lA11 + G.gathL(nxt, gb, 128 + rA1); }
                a00 = cA00; a01 = cA01; a10 = cA10; a11 = cA11; }
            PG8_LDB(B1, 0, 1); PG8_STAGE(PG8_SB(0, 0), Bb, uB2, lB00, lB01);
            PG8_BAR; PG8_WAIT_L(0); PG8_MMA(0, 1, At, B1); PG8_BAR;
            PG8_LDA(At, 0, 1); PG8_STAGE(PG8_SA(0, 0), Ab, uA2, a00, a01);
            PG8_BAR; PG8_WAIT_L(0); PG8_MMA(1, 0, At, B0); PG8_BAR; PG8_SCHED;
            PG8_STAGE(PG8_SB(0, 1), Bb, uB2, lB10, lB11);
            PG8_WAIT_V(6); PG8_BAR; PG8_MMA(1, 1, At, B1); PG8_BAR;
            PG8_LDB(B0, 1, 0); PG8_SCHED; PG8_LDA(At, 1, 0); PG8_STAGE(PG8_SA(0, 1), Ab, uA2, a10, a11);
            PG8_WAIT_L(8); PG8_BAR; PG8_WAIT_L(0); PG8_MMA(0, 0, At, B0); PG8_BAR; PG8_SCHED;
            PG8_LDB(B1, 1, 1); PG8_STAGE(PG8_SB(1, 0), Bb, uB3, lB00, lB01);
            PG8_BAR; PG8_WAIT_L(0); PG8_MMA(0, 1, At, B1); PG8_BAR;
            PG8_LDA(At, 1, 1); PG8_STAGE(PG8_SA(1, 0), Ab, uA3, a00, a01);
            PG8_BAR; PG8_WAIT_L(0); PG8_MMA(1, 0, At, B0); PG8_BAR; PG8_SCHED;
            PG8_STAGE(PG8_SB(1, 1), Bb, uB3, lB10, lB11);
            PG8_WAIT_V(6); PG8_BAR; PG8_MMA(1, 1, At, B1); PG8_BAR;
        }
#if MK_TP == 1
        if constexpr (Epi::TP) tp_t0 = (long long)__builtin_readcyclecounter();
#endif
#if MK_TP == 4
        if constexpr (Epi::TP) { if (ui > 0) tp_acc += (long long)__builtin_readcyclecounter() - tp_t0; }
#endif
        { const int le = mk_lane_volatile();
          E(acc, cur, wr, wc, le & 15, le >> 4, (const PG8_LAS float*)(lds + STAGE_BYTES + 2048 + (ui % 3) * 2048)); }
        if (!has_next) break;
#pragma unroll
        for (int a = 0; a < 2; ++a)
#pragma unroll
            for (int b = 0; b < 2; ++b)
#pragma unroll
                for (int m = 0; m < 4; ++m)
#pragma unroll
                    for (int n = 0; n < 2; ++n) acc[a][b][m][n] = (f32x4){0.f, 0.f, 0.f, 0.f};
        cur = nxt; ++ui; uAc = uAn; uBc = uBn;
        if constexpr (Prob::GATHER_A && !Prob::LDSGATH) { cA00 = nA00; cA01 = nA01; cA10 = nA10; cA11 = nA11; }
    }
    PG8_WAIT_V(0);
    if (wr == 0) PG8_BAR;
    PG8_BAR;
#if MK_TP
#if MK_TP == 5
    tp_acc = ((long long)__builtin_readcyclecounter() - tp_all0) / 8;
#endif
#ifndef MK_TPWG
#define MK_TPWG 0
#endif
    if constexpr (Epi::TP) { if (G.c == MK_TPWG && wid == 0) { const long long t0 = (long long)__builtin_readcyclecounter(); while ((long long)__builtin_readcyclecounter() - t0 < tp_acc * 32) __builtin_amdgcn_s_sleep(4); } }
#endif
#undef PG8_SA
#undef PG8_SB
#undef PG8_STAGE
#undef PG8_LDA
#undef PG8_LDB
#undef PG8_MMA
#undef PG8_CAT
#undef PG8_WAIT_V
#undef PG8_WAIT_L
#undef PG8_BAR
#undef PG8_SCHED
}

struct GridOrder {
    int nM, nN, nwg, G, c, wv;
    __device__ __forceinline__ void init(int nM_, int nN_, int G_, int c_) { nM = nM_; nN = nN_; nwg = nM * nN; G = G_; c = c_; }
    __device__ __forceinline__ bool next(int i, Unit& u) const {
        const long L = (long)i * G + c; if (L >= nwg) return false;
        int wgid = (int)L; { const int q = nwg / 8, r = nwg % 8, xcd = wgid % 8, off = wgid / 8; wgid = (xcd < r ? xcd * (q + 1) : r * (q + 1) + (xcd - r) * q) + off; }
        const int nig = 8 * nN, gid = wgid / nig, fm = gid * 8, gsz = (nM - fm) < 8 ? (nM - fm) : 8;
        u.pm = fm + ((wgid % nig) % gsz); u.pn = (wgid % nig) / gsz; u.e = 0; u.cnt = 256; return true;
    }
};

struct ProbInproj : GridOrder { const bf16_t* A; const bf16_t* Bt; int K; static constexpr bool GATHER_A = false; static constexpr bool F8 = false; static constexpr bool LDSGATH = false;
    __device__ __forceinline__ unsigned laneA(int r) const { return (unsigned)r * 2048u; }
    __device__ __forceinline__ unsigned laneB(int r) const { return (unsigned)r * 2048u; }
    __device__ __forceinline__ unsigned baseA(const Unit& u) const { return (unsigned)(u.pm * 256) * 2048u; }
    __device__ __forceinline__ unsigned baseB(const Unit& u) const { return (unsigned)(u.pn * 256) * 2048u; }
    __device__ __forceinline__ unsigned gathA(const Unit&, int) const { return 0u; } };
struct ProbGT : GridOrder { const bf16_t* A; const bf16_t* Bt; int K; static constexpr bool GATHER_A = false; static constexpr bool F8 = false; static constexpr bool LDSGATH = false;
    __device__ __forceinline__ unsigned laneA(int r) const { return (unsigned)r * 2048u; }
    __device__ __forceinline__ unsigned laneB(int r) const { return (unsigned)(128 * (r & 63) + (r >> 6)) * 2048u; }
    __device__ __forceinline__ unsigned baseA(const Unit& u) const { return (unsigned)(u.pm * 256) * 2048u; }
    __device__ __forceinline__ unsigned baseB(const Unit& u) const { const int col = u.pn * 256, b = col >> 13, w = col & 8191; return (unsigned)(b * 8192 + (w >> 6)) * 2048u; }
    __device__ __forceinline__ unsigned gathA(const Unit&, int) const { return 0u; } };
struct EpiStoreBf16 {
    static constexpr bool TP = false; static constexpr bool PERM = true, PREFETCH = false; bf16_t* O; int ldc;
    __device__ __forceinline__ void operator()(const f32x4 (&acc)[2][2][4][2], const Unit& u, int wr, int wc, int fr, int fq, const PG8_LAS float* ex) const {
        const int row0 = u.pm * 256 + wr * 64 + fr, col0 = u.pn * 256 + wc * 32 + 8 * fq;
#pragma unroll
        for (int ai = 0; ai < 2; ++ai)
#pragma unroll
            for (int m = 0; m < 4; ++m) { bf16_t* rowp = O + (size_t)(row0 + ai * 128 + m * 16) * ldc + col0;
#pragma unroll
                for (int bj = 0; bj < 2; ++bj) { const f32x4 v0 = acc[ai][bj][m][0], v1 = acc[ai][bj][m][1];
                    u32x4 w; w.x = cvt_pk_bf16(v0[0], v0[1]); w.y = cvt_pk_bf16(v0[2], v0[3]); w.z = cvt_pk_bf16(v1[0], v1[1]); w.w = cvt_pk_bf16(v1[2], v1[3]);
                    *(u32x4*)(rowp + bj * 128) = w; } }
    }
};
struct EpiGT {
    static constexpr bool TP = false; static constexpr bool PERM = true, PREFETCH = true; bf16_t* O; const float* rstd; const float* bias;
    __device__ __forceinline__ void prefetch(const Unit& u, PG8_LAS unsigned char* ex, int wid, int lane) const {
        const int mb = (u.pn * 256) >> 13;
        if (wid == 0) __builtin_amdgcn_global_load_lds((const unsigned*)(bias + mb * 3072 + 2048 + u.pm * 256 + lane * 4), (PG8_LAS unsigned*)(ex + 1024), 16, 0, 0);
        else if (wid <= 4) { const int c = u.pn * 256 + (wid - 1) * 64 + lane, w = c & 8191;
            __builtin_amdgcn_global_load_lds((const unsigned*)(rstd + mb * 8192 + 128 * (w & 63) + (w >> 6)), (PG8_LAS unsigned*)(ex + (wid - 1) * 256), 4, 0, 0); }
    }
    __device__ __forceinline__ void operator()(const f32x4 (&acc)[2][2][4][2], const Unit& u, int wr, int wc, int fr, int fq, const PG8_LAS float* ex) const {
        const int row0 = u.pm * 256 + wr * 64 + fr, col0 = u.pn * 256 + wc * 32 + 8 * fq;
        float rs[2][8];
#pragma unroll
        for (int bj = 0; bj < 2; ++bj) { const f32x4 r0_ = *(const PG8_LAS f32x4*)(ex + bj * 128 + wc * 32 + 8 * fq), r1_ = *(const PG8_LAS f32x4*)(ex + bj * 128 + wc * 32 + 8 * fq + 4);
            rs[bj][0] = r0_[0]; rs[bj][1] = r0_[1]; rs[bj][2] = r0_[2]; rs[bj][3] = r0_[3]; rs[bj][4] = r1_[0]; rs[bj][5] = r1_[1]; rs[bj][6] = r1_[2]; rs[bj][7] = r1_[3]; }
#pragma unroll
        for (int ai = 0; ai < 2; ++ai)
#pragma unroll
            for (int m = 0; m < 4; ++m) { const int row = row0 + ai * 128 + m * 16; const float bg = ex[256 + wr * 64 + fr + ai * 128 + m * 16]; bf16_t* rowp = O + (size_t)row * NTOK + col0;
#pragma unroll
                for (int bj = 0; bj < 2; ++bj) { const f32x4 a0 = acc[ai][bj][m][0], a1 = acc[ai][bj][m][1];
                    u32x4 w; w.x = cvt_pk_bf16(a0[0] * rs[bj][0] + bg, a0[1] * rs[bj][1] + bg); w.y = cvt_pk_bf16(a0[2] * rs[bj][2] + bg, a0[3] * rs[bj][3] + bg);
                    w.z = cvt_pk_bf16(a1[0] * rs[bj][4] + bg, a1[1] * rs[bj][5] + bg); w.w = cvt_pk_bf16(a1[2] * rs[bj][6] + bg, a1[3] * rs[bj][7] + bg);
                    *(u32x4*)(rowp + bj * 128) = w; } }
    }
};
struct EpiInproj {
    static constexpr bool TP = false; static constexpr bool PERM = true, PREFETCH = true; bf16_t* O; bf16_t* zs; const float* rstd; const float* bias;
    __device__ __forceinline__ void prefetch(const Unit& u, PG8_LAS unsigned char* ex, int wid, int lane) const {
        if (wid == 0) __builtin_amdgcn_global_load_lds((const unsigned*)(rstd + u.pm * 256 + lane * 4), (PG8_LAS unsigned*)ex, 16, 0, 0);
        else if (wid == 1) __builtin_amdgcn_global_load_lds((const unsigned*)(bias + ((u.pm * 256 < NTOK) ? ((u.pm * 256) >> 13) : 8) * 3072 + u.pn * 256 + lane * 4), (PG8_LAS unsigned*)(ex + 1024), 16, 0, 0);
    }
    __device__ __forceinline__ void operator()(const f32x4 (&acc)[2][2][4][2], const Unit& u, int wr, int wc, int fr, int fq, const PG8_LAS float* ex) const {
        const int row0 = u.pm * 256 + wr * 64 + fr, col0 = u.pn * 256 + wc * 32 + 8 * fq;
        const bool isz = u.pn >= 6;
        if (isz && u.pm * 256 >= NTOK) return;
        f32x4 bv[2][2];
#pragma unroll
        for (int bj = 0; bj < 2; ++bj) { bv[bj][0] = *(const PG8_LAS f32x4*)(ex + 256 + bj * 128 + wc * 32 + 8 * fq); bv[bj][1] = *(const PG8_LAS f32x4*)(ex + 256 + bj * 128 + wc * 32 + 8 * fq + 4); }
#pragma unroll
        for (int ai = 0; ai < 2; ++ai)
#pragma unroll
            for (int m = 0; m < 4; ++m) { const size_t row = (size_t)(row0 + ai * 128 + m * 16); const float rs = ex[wr * 64 + fr + ai * 128 + m * 16];
                bf16_t* rowp = isz ? zs + row * 512 + (col0 - 1536) : O + row * 2048 + col0;
#pragma unroll
                for (int bj = 0; bj < 2; ++bj) { f32x4 v0 = acc[ai][bj][m][0] * rs + bv[bj][0], v1 = acc[ai][bj][m][1] * rs + bv[bj][1];
                    if (isz) {
#pragma unroll
                        for (int j = 0; j < 4; ++j) { v0[j] = v0[j] * __builtin_amdgcn_rcpf(1.0f + __expf(-v0[j])); v1[j] = v1[j] * __builtin_amdgcn_rcpf(1.0f + __expf(-v1[j])); } }
                    u32x4 w; w.x = cvt_pk_bf16(v0[0], v0[1]); w.y = cvt_pk_bf16(v0[2], v0[3]); w.z = cvt_pk_bf16(v1[0], v1[1]); w.w = cvt_pk_bf16(v1[2], v1[3]);
                    *(u32x4*)(rowp + bj * 128) = w; } }
    }
};
typedef ProbInproj ProbOut;
struct EpiProj {
    static constexpr bool TP = false; static constexpr bool PERM = true, PREFETCH = false; const float* mod; bf16_t* O;
    __device__ __forceinline__ void operator()(const f32x4 (&acc)[2][2][4][2], const Unit& u, int wr, int wc, int fr, int fq, const PG8_LAS float* ex) const {
        const int row0 = u.pm * 256 + wr * 64 + fr, col0 = u.pn * 256 + wc * 32 + 8 * fq;
        const float* gate = mod + ((u.pm * 256) >> 13) * 6144 + 2 * 1024 + col0;
        f32x4 gv[2][2];
#pragma unroll
        for (int bj = 0; bj < 2; ++bj) { gv[bj][0] = *(const f32x4*)(gate + bj * 128); gv[bj][1] = *(const f32x4*)(gate + bj * 128 + 4); }
#pragma unroll
        for (int ai = 0; ai < 2; ++ai)
#pragma unroll
            for (int m = 0; m < 4; ++m) { bf16_t* rowp = O + (size_t)(row0 + ai * 128 + m * 16) * 1024 + col0;
#pragma unroll
                for (int bj = 0; bj < 2; ++bj) { const f32x4 v0 = acc[ai][bj][m][0] * gv[bj][0], v1 = acc[ai][bj][m][1] * gv[bj][1];
                    u32x4 w; w.x = cvt_pk_bf16(v0[0], v0[1]); w.y = cvt_pk_bf16(v0[2], v0[3]); w.z = cvt_pk_bf16(v1[0], v1[1]); w.w = cvt_pk_bf16(v1[2], v1[3]);
                    *(u32x4*)(rowp + bj * 128) = w; } }
    }
};
struct EpiResid {
    static constexpr bool TP = false; static constexpr bool PERM = false, PREFETCH = false; const float* x; const float* mod; float* out;
    __device__ __forceinline__ void operator()(const f32x4 (&acc)[2][2][4][2], const Unit& u, int wr, int wc, int fr, int fq, const PG8_LAS float* ex) const {
        const int row0 = u.pm * 256 + wr * 64 + fr, col0 = u.pn * 256 + wc * 32 + 4 * fq;
        const float* gate = mod + ((u.pm * 256) >> 13) * 6144 + 2 * 1024;
        f32x4 gv[2][2];
#pragma unroll
        for (int bj = 0; bj < 2; ++bj)
#pragma unroll
            for (int n = 0; n < 2; ++n) gv[bj][n] = *(const f32x4*)(gate + col0 + bj * 128 + n * 16);
#pragma unroll
        for (int ai = 0; ai < 2; ++ai) {
            f32x4 xv[4][2][2];
#pragma unroll
            for (int m = 0; m < 4; ++m) { const size_t off = (size_t)(row0 + ai * 128 + m * 16) * 1024 + col0;
#pragma unroll
                for (int bj = 0; bj < 2; ++bj)
#pragma unroll
                    for (int n = 0; n < 2; ++n) xv[m][bj][n] = *(const f32x4*)(x + off + bj * 128 + n * 16); }
            __builtin_amdgcn_sched_barrier(0);
#pragma unroll
            for (int m = 0; m < 4; ++m) { const size_t off = (size_t)(row0 + ai * 128 + m * 16) * 1024 + col0;
#pragma unroll
                for (int bj = 0; bj < 2; ++bj)
#pragma unroll
                    for (int n = 0; n < 2; ++n) *(f32x4*)(out + off + bj * 128 + n * 16) = xv[m][bj][n] + gv[bj][n] * acc[ai][bj][m][n]; }
        }
    }
};
struct ProbOutHot : GridOrder { const bf16_t* A; const bf16_t* Bt; int K; int hot; static constexpr bool GATHER_A = false; static constexpr bool F8 = false; static constexpr bool LDSGATH = false;
    __device__ __forceinline__ unsigned laneA(int r) const { return (unsigned)r * 2048u; }
    __device__ __forceinline__ unsigned laneB(int r) const { return (unsigned)r * 2048u; }
    __device__ __forceinline__ unsigned baseA(const Unit& u) const { return hot ? 0u : (unsigned)(u.pm * 256) * 2048u; }
    __device__ __forceinline__ unsigned baseB(const Unit& u) const { return (unsigned)(u.pn * 256) * 2048u; }
    __device__ __forceinline__ unsigned gathA(const Unit&, int) const { return 0u; } };
struct EpiDry {
    static constexpr bool TP = true; static constexpr bool PERM = false, PREFETCH = false; float* out;
    __device__ __forceinline__ void operator()(const f32x4 (&acc)[2][2][4][2], const Unit& u, int wr, int wc, int fr, int fq, const PG8_LAS float* ex) const {
        float sacc = 0.f;
#pragma unroll
        for (int ai = 0; ai < 2; ++ai)
#pragma unroll
            for (int bj = 0; bj < 2; ++bj)
#pragma unroll
                for (int m = 0; m < 4; ++m)
#pragma unroll
                    for (int n = 0; n < 2; ++n) sacc += acc[ai][bj][m][n][0] + acc[ai][bj][m][n][1] + acc[ai][bj][m][n][2] + acc[ai][bj][m][n][3];
        if (sacc == 1234.5f) out[(size_t)(u.pm * 256 + wr * 64 + fr) * 1024 + u.pn * 256 + wc * 32 + fq] = sacc;
    }
};
struct MoeOrder {
    const PG8_LAS int* tb; const PG8_LAS int* cnt; int G, c, wv;
    __device__ __forceinline__ bool next(int i, Unit& u) const {
        const int L = i * G + c, ntile = tb[32]; if (L >= ntile * 4) return false;
        const int tile = L >> 2; u.pn = L & 3; int e = 0;
#pragma unroll
        for (int s = 16; s >= 1; s >>= 1) if (__builtin_amdgcn_readfirstlane(tb[e + s]) <= tile) e += s;
        u.e = e; u.pm = tile; const int loc = (tile - __builtin_amdgcn_readfirstlane(tb[e])) * 256; u.cnt = __builtin_amdgcn_readfirstlane(cnt[e]) - loc; return true;
    }
};
struct ProbMoe1 : MoeOrder { const bf16_t* A; const bf16_t* Bt; int K; const unsigned* tokk; static constexpr bool GATHER_A = true; static constexpr bool F8 = false; static constexpr bool LDSGATH = false;
    __device__ __forceinline__ unsigned laneA(int) const { return 0u; }
    __device__ __forceinline__ unsigned laneB(int r) const { return (unsigned)r * 2048u; }
    __device__ __forceinline__ unsigned baseA(const Unit&) const { return 0u; }
    __device__ __forceinline__ unsigned baseB(const Unit& u) const { return (unsigned)(u.e * 1024 + u.pn * 256) * 2048u; }
    __device__ __forceinline__ unsigned gathA(const Unit& u, int r) const { const int loc = (u.pm - __builtin_amdgcn_readfirstlane(tb[u.e])) * 256 + r; const unsigned tk = r < u.cnt ? tokk[(size_t)u.e * LCAP + loc] : 0u; return (tk >> 1) * 2048u; } };
struct EpiMoe1 {
    static constexpr bool TP = false; static constexpr bool PERM = true, PREFETCH = false; bf16_t* hid;
    __device__ __forceinline__ void operator()(const f32x4 (&acc)[2][2][4][2], const Unit& u, int wr, int wc, int fr, int fq, const PG8_LAS float* ex) const {
        const int row0 = u.pm * 256 + wr * 64 + fr, col0 = u.pn * 128 + wc * 32 + 8 * fq;
#pragma unroll
        for (int ai = 0; ai < 2; ++ai)
#pragma unroll
            for (int m = 0; m < 4; ++m) { float hv[8];
#pragma unroll
                for (int n = 0; n < 2; ++n)
#pragma unroll
                    for (int j = 0; j < 4; ++j) { const float g = acc[ai][0][m][n][j], up = acc[ai][1][m][n][j]; hv[n * 4 + j] = g * __builtin_amdgcn_rcpf(1.0f + __expf(-g)) * up; }
                u32x4 w; w.x = cvt_pk_bf16(hv[0], hv[1]); w.y = cvt_pk_bf16(hv[2], hv[3]); w.z = cvt_pk_bf16(hv[4], hv[5]); w.w = cvt_pk_bf16(hv[6], hv[7]);
                *(u32x4*)(hid + (size_t)(row0 + ai * 128 + m * 16) * 512 + col0) = w; }
    }
};
struct ProbMoe2 : MoeOrder { const bf16_t* A; const bf16_t* Bt; int K; static constexpr bool GATHER_A = false; static constexpr bool F8 = false; static constexpr bool LDSGATH = false;
    __device__ __forceinline__ unsigned laneA(int r) const { return (unsigned)r * 1024u; }
    __device__ __forceinline__ unsigned laneB(int r) const { return (unsigned)r * 1024u; }
    __device__ __forceinline__ unsigned baseA(const Unit& u) const { return (unsigned)(u.pm * 256) * 1024u; }
    __device__ __forceinline__ unsigned baseB(const Unit& u) const { return (unsigned)(u.e * 1024 + u.pn * 256) * 1024u; }
    __device__ __forceinline__ unsigned gathA(const Unit&, int) const { return 0u; } };
struct EpiMoe2 {
    static constexpr bool TP = false; static constexpr bool PERM = true, PREFETCH = true; bf16_t* Y; const unsigned* tokk; const float* wl; const PG8_LAS int* tb;
    __device__ __forceinline__ void prefetch(const Unit& u, PG8_LAS unsigned char* ex, int wid, int lane) const {
        const size_t o = (size_t)u.e * LCAP + (u.pm - __builtin_amdgcn_readfirstlane(tb[u.e])) * 256 + lane * 4;
        if (wid == 0) __builtin_amdgcn_global_load_lds((const unsigned*)(tokk + o), (PG8_LAS unsigned*)ex, 16, 0, 0);
        else if (wid == 1) __builtin_amdgcn_global_load_lds((const unsigned*)(wl + o), (PG8_LAS unsigned*)(ex + 1024), 16, 0, 0);
    }
    __device__ __forceinline__ void operator()(const f32x4 (&acc)[2][2][4][2], const Unit& u, int wr, int wc, int fr, int fq, const PG8_LAS float* ex) const {
        const int col0 = u.pn * 256 + wc * 32 + 8 * fq;
#pragma unroll
        for (int ai = 0; ai < 2; ++ai)
#pragma unroll
            for (int m = 0; m < 4; ++m) { const int r = ai * 128 + wr * 64 + m * 16 + fr;
                if (r < u.cnt) { const unsigned tk = __builtin_bit_cast(unsigned, ex[r]); const float w = ex[256 + r];
                    bf16_t* rowp = Y + ((size_t)(tk & 1u) * NTOK + (tk >> 1)) * 1024 + col0;
#pragma unroll
                    for (int bj = 0; bj < 2; ++bj) { const f32x4 v0 = acc[ai][bj][m][0] * w, v1 = acc[ai][bj][m][1] * w;
                        u32x4 q; q.x = cvt_pk_bf16(v0[0], v0[1]); q.y = cvt_pk_bf16(v0[2], v0[3]); q.z = cvt_pk_bf16(v1[0], v1[1]); q.w = cvt_pk_bf16(v1[2], v1[3]);
                        *(u32x4*)(rowp + bj * 128) = q; } } }
    }
};

constexpr int F8_STAGE = 65536, F8_LDS = 2 * F8_STAGE;
template <class Prob, class Epi, int VAR = 0>
__device__ __forceinline__ void gemm_f8(PG8_LAS unsigned char* lds, const Prob& G, const Epi& E) {
    int tid_ = MK_TID(G.wv); asm volatile("" : "+v"(tid_));
    const int tid = tid_, wid = __builtin_amdgcn_readfirstlane(tid >> 6), lane = tid & 63, wr = wid >> 2, wc = wid & 3, fr = lane & 15, fq = lane >> 4;
    const int nt = G.KB >> 7;
    int R0, C0; stage_rc(tid * 16, R0, C0);
    const unsigned cb = (unsigned)C0 * 2u, ldsw = (unsigned)wid * 1024u;
    const int aoff = lds_byte(wr * 64 + fr, fq * 8), boff = (wc >> 1) * 16384 + lds_byte((wc & 1) * 64 + fr, fq * 8);
    const char* Ab = (const char*)G.A; const char* Bb = (const char*)G.Bt;
    Unit cur, nxt;
    if (!G.next(0, cur)) return;
    const unsigned lB00 = G.laneB(R0) + cb, lB01 = G.laneB(R0 + 64) + cb, lB10 = G.laneB(128 + R0) + cb, lB11 = G.laneB(192 + R0) + cb;
    unsigned cA00 = G.rowA(cur, R0) + cb, cA01 = G.rowA(cur, R0 + 64) + cb, cA10 = G.rowA(cur, 128 + R0) + cb, cA11 = G.rowA(cur, 192 + R0) + cb;
    unsigned nA00 = cA00, nA01 = cA01, nA10 = cA10, nA11 = cA11;
    unsigned uBc = G.baseB(cur), uBn = uBc;
#define F8_ISSUE(buf, a00, a01, a10, a11, ub, kb) do { PG8_LAS unsigned char* sb_ = lds + (buf) * F8_STAGE + ldsw; \
        __builtin_amdgcn_global_load_lds((const unsigned*)(Ab + (size_t)((a00) + (kb))), (PG8_LAS unsigned*)(sb_), 16, 0, 0); \
        __builtin_amdgcn_global_load_lds((const unsigned*)(Ab + (size_t)((a01) + (kb))), (PG8_LAS unsigned*)(sb_ + 8192), 16, 0, 0); \
        __builtin_amdgcn_global_load_lds((const unsigned*)(Ab + (size_t)((a10) + (kb))), (PG8_LAS unsigned*)(sb_ + 16384), 16, 0, 0); \
        __builtin_amdgcn_global_load_lds((const unsigned*)(Ab + (size_t)((a11) + (kb))), (PG8_LAS unsigned*)(sb_ + 24576), 16, 0, 0); \
        __builtin_amdgcn_global_load_lds((const unsigned*)(Bb + (size_t)(ub) + (size_t)(lB00 + (kb))), (PG8_LAS unsigned*)(sb_ + 32768), 16, 0, 0); \
        __builtin_amdgcn_global_load_lds((const unsigned*)(Bb + (size_t)(ub) + (size_t)(lB01 + (kb))), (PG8_LAS unsigned*)(sb_ + 40960), 16, 0, 0); \
        __builtin_amdgcn_global_load_lds((const unsigned*)(Bb + (size_t)(ub) + (size_t)(lB10 + (kb))), (PG8_LAS unsigned*)(sb_ + 49152), 16, 0, 0); \
        __builtin_amdgcn_global_load_lds((const unsigned*)(Bb + (size_t)(ub) + (size_t)(lB11 + (kb))), (PG8_LAS unsigned*)(sb_ + 57344), 16, 0, 0); } while (0)
    f32x4 acc[2][4][4];
#pragma unroll
    for (int a = 0; a < 2; ++a)
#pragma unroll
        for (int m = 0; m < 4; ++m)
#pragma unroll
            for (int n = 0; n < 4; ++n) acc[a][m][n] = (f32x4){0.f, 0.f, 0.f, 0.f};
    F8_ISSUE(0, cA00, cA01, cA10, cA11, uBc, 0u);
    int g = 0, ui = 0;
    for (;;) {
        const bool has_next = G.next(ui + 1, nxt);
        if (has_next) { nA00 = G.rowA(nxt, R0) + cb; nA01 = G.rowA(nxt, R0 + 64) + cb; nA10 = G.rowA(nxt, 128 + R0) + cb; nA11 = G.rowA(nxt, 192 + R0) + cb; uBn = G.baseB(nxt); }
        else { nA00 = cA00; nA01 = cA01; nA10 = cA10; nA11 = cA11; uBn = uBc; }
#pragma unroll 1
        for (int kt = 0; kt < nt; ++kt) {
            asm volatile("s_waitcnt vmcnt(0)" ::: "memory");
            __builtin_amdgcn_s_barrier();
            asm volatile("" ::: "memory");
            {
                const bool wrap = kt + 1 >= nt; const unsigned kb = wrap ? 0u : (unsigned)(kt + 1) * 128u;
                const unsigned a00 = wrap ? nA00 : cA00, a01 = wrap ? nA01 : cA01, a10 = wrap ? nA10 : cA10, a11 = wrap ? nA11 : cA11, ub = wrap ? uBn : uBc;
                if (VAR != 2) F8_ISSUE((g + 1) & 1, a00, a01, a10, a11, ub, kb);
            }
            if (VAR == 1) { ++g; continue; }
            PG8_LAS unsigned char* st = lds + (g & 1) * F8_STAGE;
            v8i32 B8[4];
#pragma unroll
            for (int n = 0; n < 4; ++n) { const v4i32 lo = *(const PG8_LAS v4i32*)(st + 32768 + boff + n * 2048), hi = *(const PG8_LAS v4i32*)(st + 32768 + boff + n * 2048 + 1024);
                B8[n] = __builtin_shufflevector(lo, hi, 0, 1, 2, 3, 4, 5, 6, 7); }
#pragma unroll
            for (int ai = 0; ai < 2; ++ai) {
                v8i32 A8[4];
#pragma unroll
                for (int m = 0; m < 4; ++m) { const v4i32 lo = *(const PG8_LAS v4i32*)(st + ai * 16384 + aoff + m * 2048), hi = *(const PG8_LAS v4i32*)(st + ai * 16384 + aoff + m * 2048 + 1024);
                    A8[m] = __builtin_shufflevector(lo, hi, 0, 1, 2, 3, 4, 5, 6, 7); }
                asm volatile("s_waitcnt lgkmcnt(0)" ::: "memory");
                __builtin_amdgcn_s_setprio(1);
#pragma unroll
                for (int m = 0; m < 4; ++m)
#pragma unroll
                    for (int n = 0; n < 4; ++n) acc[ai][m][n] = __builtin_amdgcn_mfma_scale_f32_16x16x128_f8f6f4(B8[n], A8[m], acc[ai][m][n], 0, 0, 0, 0, 0, 0);
                __builtin_amdgcn_s_setprio(0);
            }
            ++g;
        }
        if (VAR == 0) E(acc, cur, wr, wc, fr, fq);
        else if (acc[0][0][0][0] == 1234.5f && acc[1][3][3][3] == 77.0f) E(acc, cur, wr, wc, fr, fq);
        if (!has_next) break;
#pragma unroll
        for (int a = 0; a < 2; ++a)
#pragma unroll
            for (int m = 0; m < 4; ++m)
#pragma unroll
                for (int n = 0; n < 4; ++n) acc[a][m][n] = (f32x4){0.f, 0.f, 0.f, 0.f};
        cur = nxt; ++ui; cA00 = nA00; cA01 = nA01; cA10 = nA10; cA11 = nA11; uBc = uBn;
    }
    asm volatile("s_waitcnt vmcnt(0)" ::: "memory");
    __builtin_amdgcn_s_barrier();
#undef F8_ISSUE
}
struct MoeOrder8 {
    const PG8_LAS int* tb; const PG8_LAS int* cnt; int G, c, wv, rev = 0;
    __device__ __forceinline__ bool next(int i, Unit& u) const {
        const int ntile = __builtin_amdgcn_readfirstlane(tb[32]), xj = c >> 3, per = G >> 2, off = (c & 7) * (G >> 5) + (xj >> 2);
        int tile = i * per + off;
        if (rev) { const int mine = (ntile - off + per - 1) / per;
            if (i >= mine) return false; tile = (mine - 1 - i) * per + off; }
        if (tile >= ntile) return false;
        u.pn = xj & 3; const int e = __builtin_amdgcn_readfirstlane((int)((const PG8_LAS unsigned char*)tb)[512 + tile]);
        u.e = e; u.pm = tile; const int loc = (tile - __builtin_amdgcn_readfirstlane(tb[e])) * 256; u.cnt = __builtin_amdgcn_readfirstlane(cnt[e]) - loc; return true;
    }
};
struct ProbMoe1F8 : MoeOrder8 { const unsigned char* A; const unsigned char* Bt; int KB; const unsigned* tokk;
    __device__ __forceinline__ unsigned laneB(int r) const { return (unsigned)r * 1024u; }
    __device__ __forceinline__ unsigned baseB(const Unit& u) const { return (unsigned)((u.e * 4 + u.pn) * 256) * 1024u; }
    __device__ __forceinline__ unsigned rowA(const Unit& u, int r) const { const int loc = (u.pm - __builtin_amdgcn_readfirstlane(tb[u.e])) * 256 + r; const unsigned tk = r < u.cnt ? tokk[(size_t)u.e * LCAP + loc] : 0u; return (tk >> 1) * 1024u; } };
struct EpiMoe1F8 {
    unsigned char* hid;
    __device__ __forceinline__ void operator()(const f32x4 (&acc)[2][4][4], const Unit& u, int wr, int wc, int fr, int fq) const {
        const int row0 = u.pm * 256 + wr * 64 + fr, col0 = u.pn * 128 + wc * 32 + fq * 8;
#pragma unroll
        for (int ai = 0; ai < 2; ++ai)
#pragma unroll
            for (int m = 0; m < 4; ++m) { u32x2 q;
#pragma unroll
                for (int n2 = 0; n2 < 2; ++n2) { float hv[4];
#pragma unroll
                    for (int j = 0; j < 4; ++j) { const float g = acc[ai][m][n2][j] * 0.03125f, up = acc[ai][m][2 + n2][j] * 0.03125f; hv[j] = g * __builtin_amdgcn_rcpf(1.0f + __expf(-g)) * up; }
                    q[n2] = pk4_fp8(hv[0], hv[1], hv[2], hv[3]); }
                *(u32x2*)(hid + (size_t)(row0 + ai * 128 + m * 16) * 512 + col0) = q; }
    }
};
struct ProbMoe2F8 : MoeOrder8 { const unsigned char* A; const unsigned char* Bt; int KB;
    __device__ __forceinline__ unsigned laneB(int r) const { return (unsigned)r * 512u; }
    __device__ __forceinline__ unsigned baseB(const Unit& u) const { return (unsigned)(u.e * 1024 + u.pn * 256) * 512u; }
    __device__ __forceinline__ unsigned rowA(const Unit& u, int r) const { return (unsigned)(u.pm * 256 + r) * 512u; } };
struct EpiMoe2F8 {
    unsigned char* Y; const unsigned* tokk; const float* wl; const PG8_LAS int* tb;
    __device__ __forceinline__ void operator()(const f32x4 (&acc)[2][4][4], const Unit& u, int wr, int wc, int fr, int fq) const {
        const int col0 = u.pn * 256 + wc * 64 + 16 * fq, locb = (u.pm - __builtin_amdgcn_readfirstlane(tb[u.e])) * 256;
#pragma unroll
        for (int ai = 0; ai < 2; ++ai)
#pragma unroll
            for (int m = 0; m < 4; ++m) { const int r = ai * 128 + wr * 64 + m * 16 + fr;
                if (r < u.cnt) { const unsigned tk = tokk[(size_t)u.e * LCAP + locb + r]; const float w = wl[(size_t)u.e * LCAP + locb + r] * 0.5f;
                    unsigned char* rowp = Y + ((size_t)(tk & 1u) * NTOK + (tk >> 1)) * 1024 + col0;
                    u32x4 q;
#pragma unroll
                    for (int n = 0; n < 4; ++n) { const f32x4 v = acc[ai][m][n] * w; q[n] = pk4_fp8(v[0], v[1], v[2], v[3]); }
                    *(u32x4*)rowp = q; } }
    }
};
struct ProbMoe1P8 : MoeOrder8 { const unsigned char* A; const unsigned char* Bt; int K; const unsigned* tokk; static constexpr bool GATHER_A = true; static constexpr bool F8 = true; static constexpr bool LDSGATH = true;
    __device__ __forceinline__ void prefetchA(const Unit& u, PG8_LAS unsigned char* gb, int wid, int lane) const {
        if (wid == 0) __builtin_amdgcn_global_load_lds((const unsigned*)(tokk + (size_t)u.e * LCAP + (u.pm - __builtin_amdgcn_readfirstlane(tb[u.e])) * 256 + lane * 4), (PG8_LAS unsigned*)gb, 16, 0, 0); }
    __device__ __forceinline__ unsigned gathL(const Unit& u, const PG8_LAS unsigned char* gb, int r) const { const unsigned tk = *(const PG8_LAS unsigned*)(gb + r * 4); return ((r < u.cnt ? tk : 0u) >> 1) * 1024u; }
    __device__ __forceinline__ unsigned laneA(int) const { return 0u; }
    __device__ __forceinline__ unsigned laneB(int r) const { return (unsigned)r * 1024u; }
    __device__ __forceinline__ unsigned baseA(const Unit&) const { return 0u; }
    __device__ __forceinline__ unsigned baseB(const Unit& u) const { return (unsigned)((u.e * 4 + u.pn) * 256) * 1024u; }
    __device__ __forceinline__ unsigned gathA(const Unit& u, int r) const { const int loc = (u.pm - __builtin_amdgcn_readfirstlane(tb[u.e])) * 256 + r; const unsigned tk = r < u.cnt ? tokk[(size_t)u.e * LCAP + loc] : 0u; return (tk >> 1) * 1024u; } };
struct EpiMoe1P8 {
    static constexpr bool TP = false; static constexpr bool PERM = false, PREFETCH = false; unsigned char* hid;
    __device__ __forceinline__ void operator()(const f32x4 (&acc)[2][2][4][2], const Unit& u, int wr, int wc, int fr, int fq, const PG8_LAS float* ex) const {
        const int row0 = u.pm * 256 + wr * 64 + fr, col0 = u.pn * 128 + wc * 32 + 8 * fq;
#pragma unroll
        for (int ai = 0; ai < 2; ++ai)
#pragma unroll
            for (int m = 0; m < 4; ++m) { u32x2 q;
#pragma unroll
                for (int n = 0; n < 2; ++n) { float hv[4];
#pragma unroll
                    for (int j = 0; j < 4; ++j) { const float g = acc[ai][0][m][n][j] * 0.03125f, up = acc[ai][1][m][n][j] * 0.03125f; hv[j] = g * __builtin_amdgcn_rcpf(1.0f + __expf(-g)) * up; }
                    q[n] = pk4_fp8(hv[0], hv[1], hv[2], hv[3]); }
                *(u32x2*)(hid + (size_t)(row0 + ai * 128 + m * 16) * 512 + col0) = q; }
    }
};
struct ProbMoe2P8 : MoeOrder8 { const unsigned char* A; const unsigned char* Bt; int K; static constexpr bool GATHER_A = false; static constexpr bool F8 = true; static constexpr bool LDSGATH = false;
    __device__ __forceinline__ unsigned laneA(int r) const { return (unsigned)r * 512u; }
    __device__ __forceinline__ unsigned laneB(int r) const { return (unsigned)r * 512u; }
    __device__ __forceinline__ unsigned baseA(const Unit& u) const { return (unsigned)(u.pm * 256) * 512u; }
    __device__ __forceinline__ unsigned baseB(const Unit& u) const { return (unsigned)(u.e * 1024 + u.pn * 256) * 512u; }
    __device__ __forceinline__ unsigned gathA(const Unit&, int) const { return 0u; } };
struct EpiMoe2P8 {
    static constexpr bool TP = false; static constexpr bool PERM = false, PREFETCH = true; unsigned char* Y; const unsigned* tokk; const float* wl; const PG8_LAS int* tb; int dry = 0;
    __device__ __forceinline__ void prefetch(const Unit& u, PG8_LAS unsigned char* ex, int wid, int lane) const {
        const size_t o = (size_t)u.e * LCAP + (u.pm - __builtin_amdgcn_readfirstlane(tb[u.e])) * 256 + lane * 4;
        if (wid == 0) __builtin_amdgcn_global_load_lds((const unsigned*)(tokk + o), (PG8_LAS unsigned*)ex, 16, 0, 0);
        else if (wid == 1) __builtin_amdgcn_global_load_lds((const unsigned*)(wl + o), (PG8_LAS unsigned*)(ex + 1024), 16, 0, 0);
    }
    __device__ __forceinline__ void operator()(const f32x4 (&acc)[2][2][4][2], const Unit& u, int wr, int wc, int fr, int fq, const PG8_LAS float* ex) const {
        const int col0 = u.pn * 256 + wc * 64 + 16 * fq;
#pragma unroll
        for (int ai = 0; ai < 2; ++ai)
#pragma unroll
            for (int m = 0; m < 4; ++m) { const int r = ai * 128 + wr * 64 + m * 16 + fr;
                if (r < u.cnt && (!dry || ex[256 + r] == 1234.5f)) { const unsigned tk = __builtin_bit_cast(unsigned, ex[r]); const float w = ex[256 + r] * 0.5f;
                    unsigned char* rowp = Y + ((size_t)(tk & 1u) * NTOK + (tk >> 1)) * 1024 + col0;
                    u32x4 q;
#pragma unroll
                    for (int bj = 0; bj < 2; ++bj)
#pragma unroll
                        for (int n = 0; n < 2; ++n) { const f32x4 v = acc[ai][bj][m][n] * w; q[bj * 2 + n] = pk4_fp8(v[0], v[1], v[2], v[3]); }
                    *(u32x4*)rowp = q; } }
    }
};
}
#endif

DEV void phase2_ctx(const Params& P, unsigned char* sm) {
    PHASE_TID;
    const bf16_t* hc = (const bf16_t*)(P.ws + WS_R4 + R4_H) + (size_t)NTOK * 1024;
    const bf16_t* wq = (const bf16_t*)(P.ws + WS_WQKVZ);
    bf16_t* pc = (bf16_t*)(P.ws + WS_R4 + R4_P) + (size_t)NTOK * 2048;
    const float* rstd = (const float*)(P.ws + WS_RSTD) + NTOK; const float* bias = (const float*)(P.ws + WS_BIAS) + 8 * 3072;
    const int wid = TID >> 6, lane = TID & 63, fr = lane & 15, fq = lane >> 4;
    float* red = (float*)sm;
    for (int t = BID; t < 256; t += NBLK) {
        const int rt = t >> 4, ct = t & 15, n = wid & 3, kh = wid >> 2;
        const bf16_t* arow = hc + (size_t)(rt * 16 + fr) * 1024 + kh * 512 + fq * 8;
        const bf16_t* brow = wq + (size_t)(512 + ct * 64 + n * 16 + fr) * 1024 + kh * 512 + fq * 8;
        f32x4 acc = (f32x4){0.f, 0.f, 0.f, 0.f};
#pragma unroll
        for (int half = 0; half < 2; ++half) {
            u32x4 a[8], b[8];
#pragma unroll
            for (int ks = 0; ks < 8; ++ks) { a[ks] = *(const u32x4*)(arow + (half * 8 + ks) * 32); b[ks] = *(const u32x4*)(brow + (half * 8 + ks) * 32); }
#pragma unroll
            for (int ks = 0; ks < 8; ++ks) acc = mfma16(__builtin_bit_cast(bf16x8, b[ks]), __builtin_bit_cast(bf16x8, a[ks]), acc);
        }
        if (TID < 64) *(u32x4*)(pc + (size_t)t * 2048 + TID * 8) = (u32x4){0u, 0u, 0u, 0u};
        SYNC();
        if (kh == 1) *(f32x4*)(red + (n * 64 + lane) * 4) = acc;
        SYNC();
        if (kh == 0) { const f32x4 o = *(const f32x4*)(red + (n * 64 + lane) * 4); const int row = rt * 16 + fr, col = 512 + ct * 64 + n * 16 + 4 * fq;
            const float rs = rstd[row]; const f32x4 bv = *(const f32x4*)(bias + col);
            u32x2 w; w[0] = pk2((acc[0] + o[0]) * rs + bv[0], (acc[1] + o[1]) * rs + bv[1]); w[1] = pk2((acc[2] + o[2]) * rs + bv[2], (acc[3] + o[3]) * rs + bv[3]);
            *(u32x2*)(pc + (size_t)row * 2048 + col) = w; }
    }
    SYNC();
}

DEV void conv_row_compute(const Params& P, const bf16_t* ring, const float* wts, int s0, int s1, int s2, int ntap_rows, int slab, bf16_t* dst, int tid) {
    const int cq = tid & 31, tg = tid >> 5;
    typedef float f32x2 __attribute__((ext_vector_type(2)));
    f32x2 acc2[4][2];
#pragma unroll
    for (int t = 0; t < 4; ++t) { acc2[t][0] = (f32x2){0.f, 0.f}; acc2[t][1] = (f32x2){0.f, 0.f}; }
#pragma unroll
    for (int ky = 0; ky < 3; ++ky) {
        if (ntap_rows == 1 && ky != 1) continue;
        const int sl = ky == 0 ? s0 : ky == 1 ? s1 : s2;
        f32x2 w[3][2];
#pragma unroll
        for (int kx = 0; kx < 3; ++kx) { const f32x4 t = *(const f32x4*)(wts + (ky * 3 + kx) * 128 + cq * 4); w[kx][0] = (f32x2){t[0], t[1]}; w[kx][1] = (f32x2){t[2], t[3]}; }
        f32x2 in[6][2];
#pragma unroll
        for (int pos = 0; pos < 6; ++pos) { const u32x2 v = *(const u32x2*)(ring + sl * 8448 + (tg * 4 + pos) * 128 + cq * 4);
            in[pos][0] = (f32x2){__builtin_bit_cast(float, v[0] << 16), __builtin_bit_cast(float, v[0] & 0xffff0000u)}; in[pos][1] = (f32x2){__builtin_bit_cast(float, v[1] << 16), __builtin_bit_cast(float, v[1] & 0xffff0000u)}; }
#pragma unroll
        for (int t = 0; t < 4; ++t)
#pragma unroll
            for (int kx = 0; kx < 3; ++kx) { acc2[t][0] += w[kx][0] * in[t + kx][0]; acc2[t][1] += w[kx][1] * in[t + kx][1]; }
    }
    float acc[4][4];
#pragma unroll
    for (int t = 0; t < 4; ++t) { acc[t][0] = acc2[t][0][0]; acc[t][1] = acc2[t][0][1]; acc[t][2] = acc2[t][1][0]; acc[t][3] = acc2[t][1][1]; }
#pragma unroll
    for (int t = 0; t < 4; ++t) {
        float ss = 0.f;
#pragma unroll
        for (int c = 0; c < 4; ++c) { acc[t][c] = silu_f(acc[t][c]); ss += acc[t][c] * acc[t][c]; }
        if (slab < 8) { ss += shfl_xor_f(ss, 1); ss += shfl_xor_f(ss, 2); ss += shfl_xor_f(ss, 4); ss += shfl_xor_f(ss, 8); ss += shfl_xor_f(ss, 16); const float sc = rsq_f(ss + EPS);
#pragma unroll
            for (int c = 0; c < 4; ++c) acc[t][c] *= sc; }
        u32x2 o; o[0] = pk2(acc[t][0], acc[t][1]); o[1] = pk2(acc[t][2], acc[t][3]);
        *(u32x2*)(dst + (size_t)(tg * 4 + t) * 1536 + cq * 4) = o;
    }
}

DEV void phase3_conv(const Params& P, unsigned char* sm) {
    PHASE_TID;
    const bf16_t* p = (const bf16_t*)(P.ws + WS_R4 + R4_P);
    bf16_t* qkvn = (bf16_t*)(P.ws + WS_R3);
    bf16_t* ring = (bf16_t*)sm;
    float* wts = (float*)(sm + 3 * 16896);
    const u32x4 zero4 = (u32x4){0u, 0u, 0u, 0u};
    for (int it = BID; it < NB * 12 * 8; it += NBLK) {
        const int slab = it % 12, yb = (it / 12) & 7, b = it / 96, y0 = yb * 16;
        const bf16_t* src = p + (size_t)(b * SEQ) * 2048 + slab * 128;
        if (TID < 96) { const int sl = TID / 32, w = TID & 31, cc = (w >> 4) * 65, pc = w & 15; *(u32x4*)(ring + sl * 8448 + cc * 128 + pc * 8) = zero4; }
        if (TID < 288) *(f32x4*)(wts + TID * 4) = *(const f32x4*)(P.conv_w + (size_t)(TID >> 5) * 1536 + slab * 128 + (TID & 31) * 4);
        const int tk0 = TID >> 4, pc = TID & 15;
        u32x4 rr[4][2];
#define CV_LOAD(set, y) do { const bool ok_ = (y) >= 0 && (y) < 128; const int yc_ = ok_ ? (y) : y0;        \
            const u32x4 t0_ = __builtin_nontemporal_load((const u32x4*)(src + (size_t)(yc_ * 64 + tk0) * 2048 + pc * 8)), t1_ = __builtin_nontemporal_load((const u32x4*)(src + (size_t)(yc_ * 64 + tk0 + 32) * 2048 + pc * 8)); \
            rr[set][0] = ok_ ? t0_ : zero4; rr[set][1] = ok_ ? t1_ : zero4; } while (0)
#define CV_STORE(set, slot) do { *(u32x4*)(ring + (slot) * 8448 + (tk0 + 1) * 128 + pc * 8) = rr[set][0]; *(u32x4*)(ring + (slot) * 8448 + (tk0 + 33) * 128 + pc * 8) = rr[set][1]; } while (0)
        CV_LOAD(0, y0 - 1); CV_LOAD(1, y0); CV_LOAD(2, y0 + 1); CV_LOAD(3, y0 + 2);
        CV_STORE(0, 0); CV_STORE(1, 1);
        CV_LOAD(0, y0 + 3);
#pragma unroll 1
        for (int y4 = 0; y4 < 16; y4 += 4) {
#pragma unroll
            for (int u = 0; u < 4; ++u) {
                const int yy = y4 + u;
                const int s0 = yy % 3, s1 = (yy + 1) % 3, s2 = (yy + 2) % 3;
                CV_STORE((u + 2) & 3, s2);
                SYNC();
                CV_LOAD((u + 1) & 3, (yy + 4 <= 16) ? y0 + yy + 4 : 999);
                conv_row_compute(P, ring, wts, s0, s1, s2, 3, slab, qkvn + (size_t)(b * SEQ + (y0 + yy) * 64) * 1536 + slab * 128, TID);
                SYNC();
            }
        }
#undef CV_LOAD
#undef CV_STORE
    }
    for (int it = BID; it < NB * 12 * 4; it += NBLK) {
        const int slab = it % 12, sg = (it / 12) & 3, b = it / 48;
        const bf16_t* src = p + (size_t)(NTOK + b * CTX) * 2048 + slab * 128;
        if (TID < 288) *(f32x4*)(wts + TID * 4) = *(const f32x4*)(P.conv_w + (size_t)(TID >> 5) * 1536 + slab * 128 + (TID & 31) * 4);
        u32x4 r[3];
#pragma unroll
        for (int q = 0; q < 3; ++q) { const int idx = TID + q * 512; r[q] = zero4;
            if (idx < 66 * 16) { const int cc = idx >> 4, pc = idx & 15, tok = sg * 64 + cc - 1; if (tok >= 0 && tok < CTX) r[q] = *(const u32x4*)(src + (size_t)tok * 2048 + pc * 8); } }
#pragma unroll
        for (int q = 0; q < 3; ++q) { const int idx = TID + q * 512; if (idx < 66 * 16) { const int cc = idx >> 4, pc = idx & 15; *(u32x4*)(ring + 1 * 8448 + cc * 128 + pc * 8) = r[q]; } }
        SYNC();
        conv_row_compute(P, ring, wts, 0, 1, 2, 1, slab, qkvn + (size_t)(NTOK + b * CTX + sg * 64) * 1536 + slab * 128, TID);
        SYNC();
    }
}

constexpr int L_K = 0, L_Q = 17408, L_V = 34816, L_KTR = 52224, L_VT = 70656, L_X0F = 89088, L_X0TF = 98304, L_TTF = 107520, L_X0B = 116736, L_X0TB = 125952, L_TTB = 135168, L_GC = 144384, L_SCAL = 161824;
constexpr int L_X1F = 0, L_X1TF = 9216, L_X1B = 18432, L_X1TB = 27648, L_WF = 0, L_WB = 17408, L_AF = 145440, L_AB = 153632;

DEV int chunk_row(int chain, int step, int i) {
    const int b = chain >> 3, dir = chain & 1;
    if (step < 4) { const int pos = step * 64 + i; return NTOK + b * CTX + (dir ? (CTX - 1 - pos) : pos); }
    const int pos = (step - 4) * 64 + i; return b * SEQ + (dir ? (SEQ - 1 - pos) : pos);
}

DEV int img_piece_A(int row, int col0) { return (((row >> 4) * 2 + (col0 >> 5)) * 64 + ((col0 & 31) >> 3) * 16 + (row & 15)) * 16 + ((col0 >> 2) & 1) * 8; }
DEV int img_piece_W(int row, int d0) { return (((row >> 4) * 4 + (d0 >> 5)) * 64 + ((d0 & 31) >> 3) * 16 + (row & 15)) * 16; }

DEV void phase4_prepass(const Params& P, unsigned char* sm) {
    PHASE_TID;
    const bf16_t* qkvn = (const bf16_t*)(P.ws + WS_R3);
    const float* gb = (const float*)(P.ws + WS_GB);
    unsigned char* images = P.ws + WS_R4;
    bf16_t* Ks = (bf16_t*)(sm + L_K); bf16_t* Qs = (bf16_t*)(sm + L_Q); bf16_t* Vs = (bf16_t*)(sm + L_V); bf16_t* KTR = (bf16_t*)(sm + L_KTR); bf16_t* VT = (bf16_t*)(sm + L_VT);
    float* gcf = (float*)(sm + L_GC); float* gcb = gcf + 64; float* btf = gcf + 128; float* btb = gcf + 192;
    const float QSCALE = 0.08838834764831845f;
    const f32x4 z4 = (f32x4){0.f, 0.f, 0.f, 0.f};
    u32x4 pf[6]; float gfp, bfp, gbp, bbp, gbr;
#define PP_ROW0(it_) ((((it_) % NSTEP) < 4) ? NTOK + ((it_) / NSTEP / 4) * CTX + ((it_) % NSTEP) * 64 : ((it_) / NSTEP / 4) * SEQ + (((it_) % NSTEP) - 4) * 64)
#define PP_LOAD(it_) do { const int row0_ = PP_ROW0(it_), h_ = ((it_) / NSTEP) & 3; \
        _Pragma("unroll") for (int q = 0; q < 6; ++q) { const int idx = TID + q * 512, piece = idx & 15, i = (idx >> 4) & 63, which = idx >> 10; \
            pf[q] = __builtin_nontemporal_load((const u32x4*)(qkvn + (size_t)(row0_ + i) * 1536 + which * 512 + h_ * 128 + piece * 8)); } \
        { const int ln_ = TID & 63; const float* gr = gb + (size_t)(row0_ + ln_) * 16; gfp = gr[8 + h_]; bfp = gr[h_]; gbp = gr[12 + h_]; bbp = gr[4 + h_]; gbr = gb[(size_t)(row0_ + 63 - ln_) * 16 + 12 + h_]; } } while (0)
    const int NIT = NB * 4 * NSTEP;
    int it = BID;
    if (it < NIT) PP_LOAD(it);
    for (; it < NIT; it += NBLK) {
        int tq_ = TID;
#ifndef CPU_EMU
        asm volatile("" : "+v"(tq_));
#endif
        const int wid = tq_ >> 6, lane = tq_ & 63, fr = lane & 15, fq = lane >> 4;
        const int bh = it / NSTEP, st = it - bh * NSTEP;
        const int stb = st < 4 ? 3 - st : 4 + (127 - (st - 4));
        unsigned char* imgf = images + ((size_t)(bh * 2) * NSTEP + st) * IMG_BYTES;
        unsigned char* imgb = images + ((size_t)(bh * 2 + 1) * NSTEP + stb) * IMG_BYTES;
#pragma unroll
        for (int q = 0; q < 6; ++q) { const int idx = TID + q * 512, piece = idx & 15, i = (idx >> 4) & 63, which = idx >> 10;
            *(u32x4*)((which == 0 ? Qs : which == 1 ? Ks : Vs) + i * 136 + piece * 8) = pf[q]; }
        if (wid == 0) { float g = gfp;
#pragma unroll
            for (int o = 1; o < 64; o <<= 1) { const float t = shfl_up_f(g, o); if (lane >= o) g += t; }
            gcf[lane] = g; btf[lane] = bfp; }
        if (wid == 1) { float g = gbr;
#pragma unroll
            for (int o = 1; o < 64; o <<= 1) { const float t = shfl_up_f(g, o); if (lane >= o) g += t; }
            gcb[63 - lane] = g; btb[lane] = bbp; }
        { const int nx = (it + NBLK < NIT) ? it + NBLK : it; PP_LOAD(nx); }
        SYNC();
        const float glf = gcf[63], glb = gcb[0];
        bf16_t* X0F = (bf16_t*)(sm + L_X0F); bf16_t* X0TF = (bf16_t*)(sm + L_X0TF); bf16_t* TTF = (bf16_t*)(sm + L_TTF);
        bf16_t* X0B = (bf16_t*)(sm + L_X0B); bf16_t* X0TB = (bf16_t*)(sm + L_X0TB); bf16_t* TTB = (bf16_t*)(sm + L_TTB);
        f32x4 TregF[2], TTregF[2], TregB[2], TTregB[2];
#pragma unroll
        for (int tt = 0; tt < 2; ++tt) {
            const int t = wid * 2 + tt, ti = t >> 2, tj = t & 3;
            f32x4 kk = z4, kkT = z4, qkT = z4;
#pragma unroll
            for (int ks = 0; ks < 4; ++ks) {
                const bf16x8 fKi = frag16(Ks + (ti * 16 + fr) * 136 + ks * 32 + fq * 8), fKj = frag16(Ks + (tj * 16 + fr) * 136 + ks * 32 + fq * 8), fQi = frag16(Qs + (ti * 16 + fr) * 136 + ks * 32 + fq * 8);
                kk = mfma16(fKi, fKj, kk); kkT = mfma16(fKj, fKi, kkT); qkT = mfma16(fKj, fQi, qkT);
            }
            {
              const int j = tj * 16 + fr; const float gfj = gcf[j], gbj = gcb[j]; float mf[4] = {0.f, 0.f, 0.f, 0.f}, mb_[4] = {0.f, 0.f, 0.f, 0.f};
              if (ti >= tj) {
#pragma unroll
                  for (int r = 0; r < 4; ++r) { const int i = ti * 16 + fq * 4 + r; const float ef = __expf(fminf(gcf[i] - gfj, 0.f)) * btf[i] * kk[r]; mf[r] = (i > j) ? ef : 0.f; } }
              if (ti <= tj) {
#pragma unroll
                  for (int r = 0; r < 4; ++r) { const int i = ti * 16 + fq * 4 + r; const float eb = __expf(fminf(gcb[i] - gbj, 0.f)) * btb[i] * kk[r]; mb_[r] = (i < j) ? eb : 0.f; } }
#pragma unroll
              for (int r = 0; r < 4; ++r) { const int i = ti * 16 + fq * 4 + r; TregF[tt][r] = (i == j ? 1.0f : 0.0f) - mf[r]; TregB[tt][r] = (i == j ? 1.0f : 0.0f) - mb_[r]; }
              u32x2 w; const int o_ = j * 72 + ti * 16 + fq * 4;
              w[0] = pk2(mf[0], mf[1]); w[1] = pk2(mf[2], mf[3]); *(u32x2*)(X0TF + o_) = w;
              w[0] = pk2(TregF[tt][0], TregF[tt][1]); w[1] = pk2(TregF[tt][2], TregF[tt][3]); *(u32x2*)(TTF + o_) = w;
              w[0] = pk2(mb_[0], mb_[1]); w[1] = pk2(mb_[2], mb_[3]); *(u32x2*)(X0TB + o_) = w;
              w[0] = pk2(TregB[tt][0], TregB[tt][1]); w[1] = pk2(TregB[tt][2], TregB[tt][3]); *(u32x2*)(TTB + o_) = w; }
            SCHED_FENCE();
            {
              const int i = ti * 16 + fr, j0 = tj * 16 + fq * 4; const float gfi = gcf[i], gbi = gcb[i], bfi = btf[i], bbi = btb[i];
              float mf[4] = {0.f, 0.f, 0.f, 0.f}, af[4] = {0.f, 0.f, 0.f, 0.f}, mb_[4] = {0.f, 0.f, 0.f, 0.f}, ab[4] = {0.f, 0.f, 0.f, 0.f};
              if (ti >= tj) {
#pragma unroll
                  for (int r = 0; r < 4; ++r) { const int j = j0 + r; const float ef = __expf(fminf(gfi - gcf[j], 0.f)); const float df = (i >= j) ? ef : 0.f;
                      mf[r] = (i > j) ? bfi * kkT[r] * ef : 0.f; af[r] = qkT[r] * QSCALE * df; } }
              if (ti <= tj) {
#pragma unroll
                  for (int r = 0; r < 4; ++r) { const int j = j0 + r; const float eb = __expf(fminf(gbi - gcb[j], 0.f)); const float db = (i <= j) ? eb : 0.f;
                      mb_[r] = (i < j) ? bbi * kkT[r] * eb : 0.f; ab[r] = qkT[r] * QSCALE * db; } }
#pragma unroll
              for (int r = 0; r < 4; ++r) { const int j = j0 + r; TTregF[tt][r] = (i == j ? 1.0f : 0.0f) - mf[r]; TTregB[tt][r] = (i == j ? 1.0f : 0.0f) - mb_[r]; }
              u32x2 w; const int o_ = i * 72 + j0;
              w[0] = pk2(mf[0], mf[1]); w[1] = pk2(mf[2], mf[3]); *(u32x2*)(X0F + o_) = w;
              w[0] = pk2(mb_[0], mb_[1]); w[1] = pk2(mb_[2], mb_[3]); *(u32x2*)(X0B + o_) = w;
              w[0] = pk2(af[0], af[1]); w[1] = pk2(af[2], af[3]); *(u32x2*)((bf16_t*)(sm + L_AF) + i * 64 + j0) = w;
              w[0] = pk2(ab[3], ab[2]); w[1] = pk2(ab[1], ab[0]); *(u32x2*)((bf16_t*)(sm + L_AB) + (63 - i) * 64 + 60 - j0) = w; }
            SCHED_FENCE();
        }
        if (TID < 64) { float* sf = (float*)(sm + L_SCAL), *sb = (float*)(sm + L_SCAL + 288);
            sf[4 + TID] = QSCALE * __expf(gcf[TID]); sb[4 + TID] = QSCALE * __expf(gcb[63 - TID]); }
        {
            const int dcol = wid * 16 + fr, ks = wid >> 1;
            bf16x8 idf;
#pragma unroll
            for (int j = 0; j < 8; ++j) idf[j] = (dcol == ks * 32 + fq * 8 + j) ? (short)0x3F80 : (short)0;
#pragma unroll
            for (int t4 = 0; t4 < 4; ++t4) {
                const f32x4 kt = mfma16(frag16(Ks + (t4 * 16 + fr) * 136 + ks * 32 + fq * 8), idf, z4);
                const f32x4 vt = mfma16(frag16(Vs + (t4 * 16 + fr) * 136 + ks * 32 + fq * 8), idf, z4);
                const int tok = t4 * 16 + fq * 4;
                u32x2 w; w[0] = pk2(kt[0], kt[1]); w[1] = pk2(kt[2], kt[3]); *(u32x2*)(KTR + dcol * 72 + tok) = w;
                w[0] = pk2(vt[0], vt[1]); w[1] = pk2(vt[2], vt[3]); *(u32x2*)(VT + dcol * 72 + tok) = w;
                SCHED_FENCE();
            }
        }
        SYNC();
#pragma unroll 1
        for (int s5 = 0; s5 < 5; ++s5) {
            const bf16_t* PcF = (bf16_t*)(sm + ((s5 & 1) ? L_X1F : L_X0F)); const bf16_t* PcTF = (bf16_t*)(sm + ((s5 & 1) ? L_X1TF : L_X0TF));
            bf16_t* PnF = (bf16_t*)(sm + ((s5 & 1) ? L_X0F : L_X1F)); bf16_t* PnTF = (bf16_t*)(sm + ((s5 & 1) ? L_X0TF : L_X1TF));
            const bf16_t* PcB = (bf16_t*)(sm + ((s5 & 1) ? L_X1B : L_X0B)); const bf16_t* PcTB = (bf16_t*)(sm + ((s5 & 1) ? L_X1TB : L_X0TB));
            bf16_t* PnB = (bf16_t*)(sm + ((s5 & 1) ? L_X0B : L_X1B)); bf16_t* PnTB = (bf16_t*)(sm + ((s5 & 1) ? L_X0TB : L_X1TB));
            const int tiw = wid >> 1, tj0 = (wid & 1) * 2;
#define PP_NEEDF(ks) ((tiw >= tj0 && (ks) >= (tj0 >> 1) && (ks) <= (tiw >> 1)) || (tiw >= tj0 + 1 && (ks) >= ((tj0 + 1) >> 1) && (ks) <= (tiw >> 1)))
#define PP_NEEDB(ks) ((tiw <= tj0 && (ks) >= (tiw >> 1) && (ks) <= (tj0 >> 1)) || (tiw <= tj0 + 1 && (ks) >= (tiw >> 1) && (ks) <= ((tj0 + 1) >> 1)))
            bf16x8 aF[2], cB[2];
#pragma unroll
            for (int ks = 0; ks < 2; ++ks) { const int oa = (tiw * 16 + fr) * 72 + ks * 32 + fq * 8;
                aF[ks] = frag16(PcF + (PP_NEEDF(ks) ? oa : 0)); cB[ks] = frag16(PcB + (PP_NEEDB(ks) ? oa : 0)); }
#pragma unroll
            for (int tt = 0; tt < 2; ++tt) {
                const int t = wid * 2 + tt, ti = t >> 2, tj = t & 3;
                const int oT = (tj * 16 + fr) * 72 + ti * 16 + fq * 4, oN = (ti * 16 + fr) * 72 + tj * 16 + fq * 4;
                if (ti >= tj) {
                    f32x4 p2 = z4, p2T = z4;
#pragma unroll
                    for (int ks = 0; ks < 2; ++ks) if (ks >= (tj >> 1) && ks <= (ti >> 1)) {
                        const int ob = (tj * 16 + fr) * 72 + ks * 32 + fq * 8;
                        const bf16x8 a = aF[ks], b = frag16(PcTF + ob);
                        p2 = mfma16(a, b, p2); p2T = mfma16(b, a, p2T); }
                    u32x2 w; w[0] = pk2(p2[0], p2[1]); w[1] = pk2(p2[2], p2[3]); *(u32x2*)(PnTF + oT) = w;
                    w[0] = pk2(p2T[0], p2T[1]); w[1] = pk2(p2T[2], p2T[3]); *(u32x2*)(PnF + oN) = w;
                } else if (s5 == 0) { const u32x2 zz = (u32x2){0u, 0u}; *(u32x2*)(PnTF + oT) = zz; *(u32x2*)(PnF + oN) = zz; }
                if (ti <= tj) {
                    f32x4 q2 = z4, q2T = z4;
#pragma unroll
                    for (int ks = 0; ks < 2; ++ks) if (ks >= (ti >> 1) && ks <= (tj >> 1)) {
                        const int ob = (tj * 16 + fr) * 72 + ks * 32 + fq * 8;
                        const bf16x8 c = cB[ks], d = frag16(PcTB + ob);
                        q2 = mfma16(c, d, q2); q2T = mfma16(d, c, q2T); }
                    u32x2 w; w[0] = pk2(q2[0], q2[1]); w[1] = pk2(q2[2], q2[3]); *(u32x2*)(PnTB + oT) = w;
                    w[0] = pk2(q2T[0], q2T[1]); w[1] = pk2(q2T[2], q2T[3]); *(u32x2*)(PnB + oN) = w;
                } else if (s5 == 0) { const u32x2 zz = (u32x2){0u, 0u}; *(u32x2*)(PnTB + oT) = zz; *(u32x2*)(PnB + oN) = zz; }
            }
            SYNC();
#pragma unroll
            for (int ks = 0; ks < 2; ++ks) { const int oa = (tiw * 16 + fr) * 72 + ks * 32 + fq * 8;
                aF[ks] = frag16(PnF + (PP_NEEDF(ks) ? oa : 0)); cB[ks] = frag16(PnB + (PP_NEEDB(ks) ? oa : 0)); }
#pragma unroll
            for (int tt = 0; tt < 2; ++tt) {
                const int t = wid * 2 + tt, ti = t >> 2, tj = t & 3;
                if (ti >= tj) {
#pragma unroll
                    for (int ks = 0; ks < 2; ++ks) if (ks >= (tj >> 1) && ks <= (ti >> 1)) {
                        const int ob = (tj * 16 + fr) * 72 + ks * 32 + fq * 8;
                        const bf16x8 a = aF[ks], b = frag16(TTF + ob);
                        TregF[tt] = mfma16(a, b, TregF[tt]); TTregF[tt] = mfma16(b, a, TTregF[tt]); } }
                if (ti <= tj) {
#pragma unroll
                    for (int ks = 0; ks < 2; ++ks) if (ks >= (ti >> 1) && ks <= (tj >> 1)) {
                        const int ob = (tj * 16 + fr) * 72 + ks * 32 + fq * 8;
                        const bf16x8 c = cB[ks], d = frag16(TTB + ob);
                        TregB[tt] = mfma16(c, d, TregB[tt]); TTregB[tt] = mfma16(d, c, TTregB[tt]); } }
            }
            SYNC();
            if (s5 < 4) {
#pragma unroll
                for (int tt = 0; tt < 2; ++tt) { const int t = wid * 2 + tt, ti = t >> 2, tj = t & 3, oT = (tj * 16 + fr) * 72 + ti * 16 + fq * 4;
                    u32x2 w;
                    if (ti >= tj) { w[0] = pk2(TregF[tt][0], TregF[tt][1]); w[1] = pk2(TregF[tt][2], TregF[tt][3]); *(u32x2*)(TTF + oT) = w; }
                    if (ti <= tj) { w[0] = pk2(TregB[tt][0], TregB[tt][1]); w[1] = pk2(TregB[tt][2], TregB[tt][3]); *(u32x2*)(TTB + oT) = w; } }
            }
        }
#undef PP_NEEDF
#undef PP_NEEDB
#pragma unroll
        for (int tt = 0; tt < 2; ++tt) {
            const int t = wid * 2 + tt, ti = t >> 2, tj = t & 3, i = ti * 16 + fr, j0 = tj * 16 + fq * 4;
            const f32x4 bq = *(const f32x4*)(btf + j0), gq = *(const f32x4*)(gcf + j0), cq = *(const f32x4*)(btb + j0), hq = *(const f32x4*)(gcb + j0);
            float tu[4], tw[4], su[4], sw[4];
#pragma unroll
            for (int r = 0; r < 4; ++r) { tu[r] = TTregF[tt][r] * bq[r]; tw[r] = tu[r] * __expf(gq[r]); su[r] = TTregB[tt][r] * cq[r]; sw[r] = su[r] * __expf(hq[r]); }
            u32x2 w; const int o_ = i * 72 + j0;
            w[0] = pk2(tu[0], tu[1]); w[1] = pk2(tu[2], tu[3]); *(u32x2*)(X0F + o_) = w;
            w[0] = pk2(tw[0], tw[1]); w[1] = pk2(tw[2], tw[3]); *(u32x2*)(X0TF + o_) = w;
            w[0] = pk2(su[0], su[1]); w[1] = pk2(su[2], su[3]); *(u32x2*)(X0B + o_) = w;
            w[0] = pk2(sw[0], sw[1]); w[1] = pk2(sw[2], sw[3]); *(u32x2*)(X0TB + o_) = w;
        }
        if (TID == 0) { float* scp = (float*)(sm + L_SCAL); scp[0] = __expf(glf); scp[1] = 0.f; scp[2] = 0.f; scp[3] = 0.f; scp[72] = __expf(glb); scp[73] = 0.f; scp[74] = 0.f; scp[75] = 0.f; }
        SYNC();
        bf16_t* WF = (bf16_t*)(sm + L_WF); bf16_t* WB = (bf16_t*)(sm + L_WB);
        bf16x8 avk[2], akk[2];
#pragma unroll
        for (int ks = 0; ks < 2; ++ks) { avk[ks] = frag16(VT + (32 * (wid >> 1) + 8 * (fr >> 2) + 4 * (wid & 1) + (fr & 3)) * 72 + ks * 32 + fq * 8); akk[ks] = frag16(KTR + (wid * 16 + fr) * 72 + ks * 32 + fq * 8); }
#pragma unroll
        for (int i4 = 0; i4 < 4; ++i4) {
            f32x4 uf = z4, wf = z4, ub = z4, wb = z4;
#pragma unroll
            for (int ks = 0; ks < 2; ++ks) {
                const bf16x8 av = avk[ks], ak = akk[ks];
                const int ot = (i4 * 16 + fr) * 72 + ks * 32 + fq * 8;
                if (ks <= (i4 >> 1)) { uf = mfma16(frag16(X0F + ot), av, uf); wf = mfma16(ak, frag16(X0TF + ot), wf); }
                if (ks >= (i4 >> 1)) { ub = mfma16(frag16(X0B + ot), av, ub); wb = mfma16(ak, frag16(X0TB + ot), wb); }
            }
            u32x2 w; w[0] = pk2(uf[0], uf[1]); w[1] = pk2(uf[2], uf[3]); *(u32x2*)(imgf + IMG_U + ((wid * 4 + i4) * 64 + lane) * 8) = w;
            w[0] = pk2(ub[3], ub[2]); w[1] = pk2(ub[1], ub[0]); *(u32x2*)(imgb + IMG_U + ((wid * 4 + (3 - i4)) * 64 + (3 - fq) * 16 + fr) * 8) = w;
            const int i = i4 * 16 + fr, c = wid * 16 + fq * 4;
            w[0] = pk2(wf[0], wf[1]); w[1] = pk2(wf[2], wf[3]); *(u32x2*)(WF + i * 136 + c) = w;
            w[0] = pk2(wb[0], wb[1]); w[1] = pk2(wb[2], wb[3]); *(u32x2*)(WB + (63 - i) * 136 + c) = w;
        }
        SYNC();
#pragma unroll
        for (int q = 0; q < 5; ++q) { int pc = TID + q * 512; pc = pc < 2082 ? pc : 2081;
            const int sp = pc - 2048, dirb = pc >= 2048 ? (sp >= 17) : (pc >> 10), p = pc & 1023, mt = p >> 8, ks = (p >> 6) & 3, ln = p & 63;
            const int so = pc >= 2048 ? L_SCAL + dirb * 288 + (sp - dirb * 17) * 16 : (dirb ? L_WB : L_WF) + ((mt * 16 + (ln & 15)) * 136 + ks * 32 + (ln >> 4) * 8) * 2;
            const int dofs = pc >= 2048 ? IMG_SC + (sp - dirb * 17) * 16 : IMG_W + p * 16;
            *(u32x4*)((dirb ? imgb : imgf) + dofs) = *(const u32x4*)(sm + so); }
#pragma unroll
        for (int q = 0; q < 2; ++q) { const int p = TID + q * 512, d = (p >> 7) * 16 + (p & 15), p0 = ((p >> 6) & 1) * 32 + ((p >> 4) & 3) * 8;
            { const u32x4 v = *(const u32x4*)(KTR + d * 72 + p0); const f32x4 g0 = *(const f32x4*)(gcf + p0), g1 = *(const f32x4*)(gcf + p0 + 4); u32x4 o;
              o[0] = pk2(__builtin_bit_cast(float, v[0] << 16) * __expf(glf - g0[0]), __builtin_bit_cast(float, v[0] & 0xffff0000u) * __expf(glf - g0[1]));
              o[1] = pk2(__builtin_bit_cast(float, v[1] << 16) * __expf(glf - g0[2]), __builtin_bit_cast(float, v[1] & 0xffff0000u) * __expf(glf - g0[3]));
              o[2] = pk2(__builtin_bit_cast(float, v[2] << 16) * __expf(glf - g1[0]), __builtin_bit_cast(float, v[2] & 0xffff0000u) * __expf(glf - g1[1]));
              o[3] = pk2(__builtin_bit_cast(float, v[3] << 16) * __expf(glf - g1[2]), __builtin_bit_cast(float, v[3] & 0xffff0000u) * __expf(glf - g1[3]));
              *(u32x4*)(imgf + IMG_KT + p * 16) = o; }
            { const int t0 = 56 - p0;
              const u32x4 v = *(const u32x4*)(KTR + d * 72 + t0); const f32x4 g0 = *(const f32x4*)(gcb + t0), g1 = *(const f32x4*)(gcb + t0 + 4); u32x4 o;
              o[0] = pk2(__builtin_bit_cast(float, v[3] & 0xffff0000u) * __expf(glb - g1[3]), __builtin_bit_cast(float, v[3] << 16) * __expf(glb - g1[2]));
              o[1] = pk2(__builtin_bit_cast(float, v[2] & 0xffff0000u) * __expf(glb - g1[1]), __builtin_bit_cast(float, v[2] << 16) * __expf(glb - g1[0]));
              o[2] = pk2(__builtin_bit_cast(float, v[1] & 0xffff0000u) * __expf(glb - g0[3]), __builtin_bit_cast(float, v[1] << 16) * __expf(glb - g0[2]));
              o[3] = pk2(__builtin_bit_cast(float, v[0] & 0xffff0000u) * __expf(glb - g0[1]), __builtin_bit_cast(float, v[0] << 16) * __expf(glb - g0[0]));
              *(u32x4*)(imgb + IMG_KT + p * 16) = o; } }
        { const int p = TID, row = (p >> 7) * 16 + (p & 15), c0 = ((p >> 6) & 1) * 32 + ((p >> 4) & 3) * 8;
          *(u32x4*)(imgf + IMG_A + p * 16) = *(const u32x4*)((const bf16_t*)(sm + L_AF) + row * 64 + c0);
          *(u32x4*)(imgb + IMG_A + p * 16) = *(const u32x4*)((const bf16_t*)(sm + L_AB) + row * 64 + c0); }
        SYNC();
    }
#undef PP_LOAD
#undef PP_ROW0
}

DEV void phase4_fft(const Params& P, unsigned char* sm) {
    PHASE_TID;
    const bf16_t* GT = (const bf16_t*)((const unsigned char*)P.out + DO_GT);
    bf16_t* ZT = (bf16_t*)((unsigned char*)P.out + DO_ZT);
    const bf16_t* tab = (const bf16_t*)(P.ws + WS_TAB);
    bf16_t* YR = (bf16_t*)sm; bf16_t* YI = YR + 64 * 136;
    const int wid = TID >> 6, lane = TID & 63, fr = lane & 15, fq = lane >> 4;
    bf16x8 c64[4][2], s64[4][2], c128[4], s128[4];
#pragma unroll
    for (int nt = 0; nt < 4; ++nt)
#pragma unroll
        for (int ks = 0; ks < 2; ++ks) { c64[nt][ks] = frag16(tab + (nt * 16 + fr) * 64 + ks * 32 + fq * 8); s64[nt][ks] = frag16(tab + 4096 + (nt * 16 + fr) * 64 + ks * 32 + fq * 8); }
#pragma unroll
    for (int ks = 0; ks < 4; ++ks) { c128[ks] = frag16(tab + 8192 + (wid * 16 + fr) * 128 + ks * 32 + fq * 8); s128[ks] = frag16(tab + 8192 + 16384 + (wid * 16 + fr) * 128 + ks * 32 + fq * 8); }
    bf16x8 far[2][2], fai[2][2];
#define FFT_LOAD(set, it_) do { const int itc_ = (it_) < 512 * NB ? (it_) : BID; const int cp_ = itc_ >> 3, b_ = itc_ & 7; \
        const bf16_t* gr_ = GT + (size_t)cp_ * NTOK + b_ * SEQ; const bf16_t* gi_ = GT + (size_t)(512 + cp_) * NTOK + b_ * SEQ; \
        _Pragma("unroll") for (int ks = 0; ks < 2; ++ks) { far[set][ks] = frag16(gr_ + (wid * 16 + fr) * 64 + ks * 32 + fq * 8); fai[set][ks] = frag16(gi_ + (wid * 16 + fr) * 64 + ks * 32 + fq * 8); } } while (0)
    const bool rebal = (NBLK == 256);
    const int fn = rebal ? (BID < 128 ? 12 : 20) : (512 * NB - BID + NBLK - 1) / NBLK, fs = rebal ? 128 : NBLK, fb = rebal ? (BID < 128 ? BID : 1536 + (BID - 128)) : BID;
    if (fn > 0) FFT_LOAD(0, fb);
    for (int k2 = 0; k2 < fn; k2 += 2) {
#pragma unroll
      for (int pp = 0; pp < 2; ++pp) { const int kk = k2 + pp; const int it = fb + fs * kk; if (kk < fn) {
        const int cp = it >> 3, b = it & 7;
        bf16x8 ar[2], ai[2], an[2];
#pragma unroll
        for (int ks = 0; ks < 2; ++ks) { ar[ks] = far[pp][ks]; ai[ks] = fai[pp][ks];
#pragma unroll
            for (int j = 0; j < 8; ++j) an[ks][j] = (short)(ar[ks][j] ^ (short)0x8000); }
        FFT_LOAD(pp ^ 1, (kk + 1 < fn) ? it + fs : fb);
#pragma unroll
        for (int nt = 0; nt < 4; ++nt) {
            f32x4 yr = (f32x4){0.f, 0.f, 0.f, 0.f}, yi = (f32x4){0.f, 0.f, 0.f, 0.f};
#pragma unroll
            for (int ks = 0; ks < 2; ++ks) { yr = mfma16(ar[ks], c64[nt][ks], yr); yr = mfma16(ai[ks], s64[nt][ks], yr); yi = mfma16(ai[ks], c64[nt][ks], yi); yi = mfma16(an[ks], s64[nt][ks], yi); }
            const int k1 = nt * 16 + fr; float orr[4], oii[4];
#pragma unroll
            for (int r = 0; r < 4; ++r) { const int n2 = wid * 16 + fq * 4 + r; float s, c; sincospi_f((float)(n2 * k1) * (2.0f / 8192.0f), &s, &c);
                orr[r] = yr[r] * c + yi[r] * s; oii[r] = yi[r] * c - yr[r] * s; }
            u32x2 w; w[0] = pk2(orr[0], orr[1]); w[1] = pk2(orr[2], orr[3]); *(u32x2*)(YR + k1 * 136 + wid * 16 + fq * 4) = w;
            w[0] = pk2(oii[0], oii[1]); w[1] = pk2(oii[2], oii[3]); *(u32x2*)(YI + k1 * 136 + wid * 16 + fq * 4) = w;
        }
        SYNC();
        bf16_t* zrow = ZT + (size_t)cp * NTOK + b * SEQ;
#pragma unroll
        for (int mt = 0; mt < 4; ++mt) {
            f32x4 z = (f32x4){0.f, 0.f, 0.f, 0.f};
#pragma unroll
            for (int ks = 0; ks < 4; ++ks) { z = mfma16(frag16(YR + (mt * 16 + fr) * 136 + ks * 32 + fq * 8), c128[ks], z); z = mfma16(frag16(YI + (mt * 16 + fr) * 136 + ks * 32 + fq * 8), s128[ks], z); }
            u32x2 w; w[0] = pk2(z[0], z[1]); w[1] = pk2(z[2], z[3]);
            *(u32x2*)(zrow + 64 * (wid * 16 + fr) + mt * 16 + fq * 4) = w;
        }
        SYNC();
      } }
    }
#undef FFT_LOAD
}

constexpr int SC_W = 0, SC_U = 17408, SC_KT = 22528, SC_Q = SC_KT + 18432, SC_A = SC_Q + 17408, SC_ST = SC_A + 9216, SC_VN = SC_ST + 2 * 8704, SC_END = SC_VN + 4608;

template <int MODE>
DEV void phase5_scan(const Params& P, unsigned char* sm) {
    PHASE_TID;
#if MK_TP >= 6 && MK_TP <= 9
    long long tp_acc = 0;
#define SC_TPSYNC(id, w) do { if (MODE == 0 && MK_TP == (id) && BID == 0 && wid == (w)) { const long long t0_ = (long long)__builtin_readcyclecounter(); SYNC(); tp_acc += (long long)__builtin_readcyclecounter() - t0_; } else SYNC(); } while (0)
#else
#define SC_TPSYNC(id, w) SYNC()
#endif
    const unsigned char* images = P.ws + WS_R4;
    bf16_t* obuf = MODE ? (bf16_t*)P.out : (bf16_t*)(P.ws + WS_R4 + R4_OBUF);
    const int wid = TID >> 6, lane = TID & 63, fr = lane & 15, fq = lane >> 4;
    bf16_t* ST = (bf16_t*)sm; bf16_t* VNB = (bf16_t*)(sm + 3 * 8704);
    for (int item = BID; item < NCHAIN * 4; item += NBLK) {
        const int xj = item >> 3, chain = (item & 7) * 8 + (xj >> 2), c0 = (xj & 3) * 32, b = chain >> 3, hh = (chain >> 1) & 3, dir = chain & 1;
        const unsigned char* blk0 = images + (size_t)chain * NSTEP * IMG_BYTES;
        for (int q = TID; q < 3 * 8704 / 4; q += 512) ((unsigned*)ST)[q] = 0u;
#define SC_IMG(st_) (blk0 + (size_t)(MODE == 2 ? ((st_) & 3) : (st_)) * IMG_BYTES)
        if (wid < 4) {
            __builtin_amdgcn_s_setprio(3);
            const int mt = wid;
            const int oW = IMG_W + (mt * 4 * 64 + lane) * 16;
            const int oU = IMG_U + (((c0 >> 4) * 4 + mt) * 64 + lane) * 8;
            const int oK = IMG_KT + (mt * 4 * 64 + lane) * 16;
            f32x4 Sacc[2][2];
#pragma unroll
            for (int sl = 0; sl < 2; ++sl) { Sacc[sl][0] = (f32x4){0.f, 0.f, 0.f, 0.f}; Sacc[sl][1] = (f32x4){0.f, 0.f, 0.f, 0.f}; }
            u32x4 rw[3][4], rk[3][2][2]; u32x2 ru[3][2]; float dlr[3];
#define SC_LOAD1(set, blk) do { \
            _Pragma("unroll") for (int ks = 0; ks < 4; ++ks) rw[set][ks] = *(const u32x4*)((blk) + oW + ks * 1024); \
            ru[set][0] = *(const u32x2*)((blk) + oU); ru[set][1] = *(const u32x2*)((blk) + oU + 2048); } while (0)
#define SC_LOADK(set, blk) do { dlr[set] = *(const float*)((blk) + IMG_SC); \
            _Pragma("unroll") for (int sl = 0; sl < 2; ++sl) _Pragma("unroll") for (int ks = 0; ks < 2; ++ks) rk[set][sl][ks] = *(const u32x4*)((blk) + oK + sl * 2048 + ks * 1024); } while (0)
            SC_LOAD1(0, blk0); SC_LOADK(0, blk0); SC_LOAD1(1, SC_IMG(1)); SC_LOADK(1, SC_IMG(1)); SC_LOAD1(2, SC_IMG(2)); SC_LOADK(2, SC_IMG(2));
            SYNC();
#pragma unroll 1
            for (int s3 = 0; s3 < NSTEP; s3 += 3) {
#pragma unroll
                for (int u = 0; u < 3; ++u) {
                    const int step = s3 + u;
                    const bf16_t* STc = ST + u * 4352; bf16_t* STn = ST + ((u + 1) % 3) * 4352; bf16_t* VN = VNB + u * 2304;
                    {
                        bf16x8 sf[2][4];
#pragma unroll
                        for (int nt = 0; nt < 2; ++nt)
#pragma unroll
                            for (int ks = 0; ks < 4; ++ks) sf[nt][ks] = frag16(STc + (nt * 16 + fr) * 136 + ks * 32 + fq * 8);
                        f32x4 vn0 = (f32x4){0.f, 0.f, 0.f, 0.f}, vn1 = (f32x4){0.f, 0.f, 0.f, 0.f};
#pragma unroll
                        for (int ks = 0; ks < 4; ++ks) { vn0 = mfma16(__builtin_bit_cast(bf16x8, rw[u][ks]), sf[0][ks], vn0); vn1 = mfma16(__builtin_bit_cast(bf16x8, rw[u][ks]), sf[1][ks], vn1); }
#pragma unroll
                        for (int nt = 0; nt < 2; ++nt) { const f32x4 vn = nt ? vn1 : vn0;
                            const unsigned u0 = ru[u][nt][0], u1 = ru[u][nt][1];
                            u32x2 w; w[0] = pk2(bf2f((bf16_t)(u0 & 0xffffu)) - vn[0], bf2f((bf16_t)(u0 >> 16)) - vn[1]); w[1] = pk2(bf2f((bf16_t)(u1 & 0xffffu)) - vn[2], bf2f((bf16_t)(u1 >> 16)) - vn[3]);
                            *(u32x2*)(VN + (nt * 16 + fr) * 72 + mt * 16 + fq * 4) = w; }
                    }
                    const float dl = dlr[u];
                    const unsigned char* blk3 = SC_IMG(step + 3 < NSTEP ? step + 3 : NSTEP - 1);
                    SC_LOAD1(u, blk3);
                    SC_TPSYNC(6, 0);
                    {
                        bf16x8 vf[2][2];
#pragma unroll
                        for (int tt = 0; tt < 2; ++tt)
#pragma unroll
                            for (int ks = 0; ks < 2; ++ks) vf[tt][ks] = frag16(VN + (tt * 16 + fr) * 72 + ks * 32 + fq * 8);
                        f32x4 a[2][2];
#pragma unroll
                        for (int sl = 0; sl < 2; ++sl) { a[sl][0] = Sacc[sl][0] * dl; a[sl][1] = Sacc[sl][1] * dl; }
#pragma unroll
                        for (int ks = 0; ks < 2; ++ks)
#pragma unroll
                            for (int sl = 0; sl < 2; ++sl)
#pragma unroll
                                for (int tt = 0; tt < 2; ++tt) a[sl][tt] = mfma16(__builtin_bit_cast(bf16x8, rk[u][sl][ks]), vf[tt][ks], a[sl][tt]);
#pragma unroll
                        for (int sl = 0; sl < 2; ++sl)
#pragma unroll
                            for (int tt = 0; tt < 2; ++tt) { Sacc[sl][tt] = a[sl][tt]; u32x2 w_; w_[0] = pk2(a[sl][tt][0], a[sl][tt][1]); w_[1] = pk2(a[sl][tt][2], a[sl][tt][3]);
                                *(u32x2*)(STn + (tt * 16 + fr) * 136 + (mt * 2 + sl) * 16 + fq * 4) = w_; }
                    }
                    SC_LOADK(u, blk3);
                    SC_TPSYNC(7, 0);
                }
            }
#undef SC_LOAD1
#undef SC_LOADK
            __builtin_amdgcn_s_setprio(0);
            SYNC();
        } else {
            const int mt = wid - 4;
            const int oA = IMG_A + (mt * 2 * 64 + lane) * 16, oS = IMG_SC + 16 + (mt * 16 + fr) * 4;
            const bf16_t* qbase = (const bf16_t*)(P.ws + WS_R3) + hh * 128 + fq * 8;
            u32x4 rq[3][4], ra[3][2]; float rs[3];
#define SC_LOADQ(set, blk, stp) do { const bf16_t* qrow_ = qbase + (size_t)chunk_row(chain, (stp), mt * 16 + fr) * 1536; \
            _Pragma("unroll") for (int ks = 0; ks < 4; ++ks) rq[set][ks] = *(const u32x4*)(qrow_ + ks * 32); \
            rs[set] = *(const float*)((blk) + oS); \
            _Pragma("unroll") for (int ks = 0; ks < 2; ++ks) ra[set][ks] = *(const u32x4*)((blk) + oA + ks * 1024); } while (0)
#define SC_OUT1(set, ostep) do { if ((ostep) >= 4) { const bf16_t* STo = ST + (set) * 4352; bf16x8 sf_[2][4]; \
                _Pragma("unroll") for (int nt = 0; nt < 2; ++nt) _Pragma("unroll") for (int ks = 0; ks < 4; ++ks) sf_[nt][ks] = frag16(STo + (nt * 16 + fr) * 136 + ks * 32 + fq * 8); \
                p0 = (f32x4){0.f, 0.f, 0.f, 0.f}; p1 = p0; \
                _Pragma("unroll") for (int ks = 0; ks < 4; ++ks) { p0 = mfma16(sf_[0][ks], __builtin_bit_cast(bf16x8, rq[set][ks]), p0); p1 = mfma16(sf_[1][ks], __builtin_bit_cast(bf16x8, rq[set][ks]), p1); } } } while (0)
#define SC_OUT2(set, ostep) do { if ((ostep) >= 4) { const bf16_t* VNo = VNB + (set) * 2304; bf16x8 vf_[2][2]; \
                _Pragma("unroll") for (int nt = 0; nt < 2; ++nt) _Pragma("unroll") for (int ks = 0; ks < 2; ++ks) vf_[nt][ks] = frag16(VNo + (nt * 16 + fr) * 72 + ks * 32 + fq * 8); \
                f32x4 q0_ = p0 * rs[set], q1_ = p1 * rs[set]; \
                _Pragma("unroll") for (int ks = 0; ks < 2; ++ks) { q0_ = mfma16(vf_[0][ks], __builtin_bit_cast(bf16x8, ra[set][ks]), q0_); q1_ = mfma16(vf_[1][ks], __builtin_bit_cast(bf16x8, ra[set][ks]), q1_); } \
                const int pos = ((ostep) - 4) * 64 + mt * 16 + fr; const int tok = b * SEQ + (dir ? (SEQ - 1 - pos) : pos); \
                bf16_t* orow = obuf + ((size_t)dir * NTOK + tok) * 512 + hh * 128 + c0 + fq * 8; \
                u32x4 w_; w_[0] = pk2(q0_[0], q0_[1]); w_[1] = pk2(q0_[2], q0_[3]); w_[2] = pk2(q1_[0], q1_[1]); w_[3] = pk2(q1_[2], q1_[3]); \
                if (MODE != 3 || w_[0] == 0x12345678u) *(u32x4*)(orow) = w_; } } while (0)
            f32x4 p0 = (f32x4){0.f, 0.f, 0.f, 0.f}, p1 = p0;
            SC_LOADQ(0, blk0, (MODE == 2 ? 4 : 0)); SC_LOADQ(1, SC_IMG(1), (MODE == 2 ? 5 : 1));
            SYNC();
#pragma unroll 1
            for (int s3 = 0; s3 < NSTEP; s3 += 3) {
#pragma unroll
                for (int u = 0; u < 3; ++u) {
                    const int step = s3 + u;
                    if (step > 0) SC_OUT1((u + 2) % 3, step - 1);
                    SC_TPSYNC(8, 4);
                    if (step > 0) SC_OUT2((u + 2) % 3, step - 1);
                    { const int stq = step + 2 < NSTEP ? step + 2 : NSTEP - 1; SC_LOADQ((u + 2) % 3, SC_IMG(stq), (MODE == 2 ? (stq & 3) + 4 : stq)); }
                    SC_TPSYNC(9, 4);
                }
            }
            SC_OUT1((NSTEP - 1) % 3, NSTEP - 1); SC_OUT2((NSTEP - 1) % 3, NSTEP - 1);
            SYNC();
#undef SC_LOADQ
#undef SC_OUT1
#undef SC_OUT2
        }
#undef SC_IMG
#if MK_TP >= 6 && MK_TP <= 9
        if (MODE == 0 && BID == 0 && (wid == 0 || wid == 4)) { const long long t0_ = (long long)__builtin_readcyclecounter(); while ((long long)__builtin_readcyclecounter() - t0_ < tp_acc * 8) __builtin_amdgcn_s_sleep(4); }
#endif
        SYNC();
    }
}

DEV void phase6_amix(const Params& P, unsigned char* sm) {
    PHASE_TID;
    const bf16_t* ZT = (const bf16_t*)((const unsigned char*)P.out + DO_ZT);
    const bf16_t* zs = (const bf16_t*)((const unsigned char*)P.out + DO_ZS);
    const bf16_t* obuf = (const bf16_t*)(P.ws + WS_R4 + R4_OBUF);
    bf16_t* amix = (bf16_t*)(P.ws + WS_R4 + R4_AMIX);
    unsigned* tile = (unsigned*)sm;
    for (int tt = BID; tt < NTOK / 64; tt += NBLK) {
        const int tok0 = tt * 64;
        { u32x4 r[8];
#pragma unroll
          for (int q = 0; q < 8; ++q) { const int idx = TID + q * 512, cp = idx >> 3, piece = idx & 7; r[q] = __builtin_nontemporal_load((const u32x4*)(ZT + (size_t)cp * NTOK + tok0 + piece * 8)); }
#pragma unroll
          for (int q = 0; q < 8; ++q) { const int idx = TID + q * 512, cp = idx >> 3, piece = idx & 7; unsigned* t = tile + cp * 33 + piece * 4; t[0] = r[q][0]; t[1] = r[q][1]; t[2] = r[q][2]; t[3] = r[q][3]; } }
        SYNC();
        u32x4 oa[8], ob[8], oz[8];
#pragma unroll
        for (int q = 0; q < 8; ++q) { const int idx = TID + q * 512, tok = idx >> 6, hh = (idx >> 4) & 3, l16 = idx & 15; const size_t off = (size_t)(tok0 + tok) * 512 + hh * 128 + l16 * 8;
            oa[q] = __builtin_nontemporal_load((const u32x4*)(obuf + off)); ob[q] = __builtin_nontemporal_load((const u32x4*)(obuf + (size_t)NTOK * 512 + off)); oz[q] = __builtin_nontemporal_load((const u32x4*)(zs + off)); }
#pragma unroll
        for (int q = 0; q < 8; ++q) { const int tok = TID & 63, c8 = ((TID >> 6) * 8 + q) * 8, sh = (tok & 1) * 16; u32x4 o;
#pragma unroll
            for (int j = 0; j < 4; ++j) o[j] = ((tile[(c8 + 2 * j) * 33 + (tok >> 1)] >> sh) & 0xffffu) | (((tile[(c8 + 2 * j + 1) * 33 + (tok >> 1)] >> sh) & 0xffffu) << 16);
            *(u32x4*)(amix + (size_t)(tok0 + tok) * 1024 + c8) = o; }
        const int l16 = TID & 15;
        float og[8];
#pragma unroll
        for (int j = 0; j < 8; ++j) og[j] = P.onorm_g[l16 * 8 + j];
#pragma unroll
        for (int q = 0; q < 8; ++q) {
            const int idx = TID + q * 512, tok = idx >> 6, hh = (idx >> 4) & 3;
            const u32x4 a = oa[q], bq = ob[q], zv = oz[q];
            float v[8]; float ss = 0.f;
#pragma unroll
            for (int j = 0; j < 4; ++j) { v[2 * j] = bf2f((bf16_t)(a[j] & 0xffffu)) + bf2f((bf16_t)(bq[j] & 0xffffu)); v[2 * j + 1] = bf2f((bf16_t)(a[j] >> 16)) + bf2f((bf16_t)(bq[j] >> 16)); }
#pragma unroll
            for (int j = 0; j < 8; ++j) ss += v[j] * v[j];
            ss += shfl_xor_f(ss, 1); ss += shfl_xor_f(ss, 2); ss += shfl_xor_f(ss, 4); ss += shfl_xor_f(ss, 8);
            const float rstd = rsq_f(ss * (1.0f / 128.0f) + EPS);
            u32x4 o;
#pragma unroll
            for (int j = 0; j < 4; ++j) o[j] = pk2(v[2 * j] * rstd * og[2 * j] * bf2f((bf16_t)(zv[j] & 0xffffu)), v[2 * j + 1] * rstd * og[2 * j + 1] * bf2f((bf16_t)(zv[j] >> 16)));
            *(u32x4*)(amix + (size_t)(tok0 + tok) * 1024 + 512 + hh * 128 + l16 * 8) = o;
        }
        SYNC();
    }
}

DEV void phase8_router(const Params& P, unsigned char* sm, int dry) {
    PHASE_TID;
    float* wr = (float*)sm;
    {
        f32x4 g[2], rt[2][8];
#pragma unroll
        for (int h = 0; h < 2; ++h) { const int k = TID + h * 512; g[h] = *(const f32x4*)(P.w_group + k * 4);
#pragma unroll
            for (int q = 0; q < 8; ++q) rt[h][q] = *(const f32x4*)(P.w_router + k * 32 + q * 4); }
#pragma unroll
        for (int h = 0; h < 2; ++h) { const int k = TID + h * 512;
#pragma unroll
            for (int e = 0; e < 4; ++e) wr[e * 1028 + k] = g[h][e];
#pragma unroll
            for (int q = 0; q < 8; ++q)
#pragma unroll
                for (int e = 0; e < 4; ++e) wr[(4 + q * 4 + e) * 1028 + k] = rt[h][q][e]; }
    }
    SYNC();
    const float* mod = (const float*)(P.ws + WS_MOD);
    const float* xin = P.x; const bf16_t* proj = (const bf16_t*)(P.ws + WS_R4 + R4_PROJ);
    bf16_t* h2 = (bf16_t*)(P.ws + WS_R4 + R4_H2);
    unsigned* cnt = (unsigned*)(P.ws + WS_CNT + (dry ? 8192 : 0)); unsigned* tokk = (unsigned*)(P.ws + (dry ? WS_R3 : WS_TOKK)); float* wl = (float*)(P.ws + (dry ? WS_R3 + 16 * MiB : WS_WL));
    const int wid = TID >> 6, lane = TID & 63;
    const int rstep = NBLK * 8;
    int r = BID * 8 + wid;
    unsigned* lc = (unsigned*)(sm + 148224);
    unsigned* aE = lc + 64; float* aW = (float*)(aE + 512); unsigned* aP = (unsigned*)(aW + 512);
    float* gsv = (float*)(sm + 154624); float* shv = gsv + 1024;
    float* brs = shv + 1024;
    if (TID < 32) { lc[TID] = 0u; brs[TID] = P.b_router[TID]; }
    const float bg0 = P.b_group[0], bg1 = P.b_group[1], bg2 = P.b_group[2], bg3 = P.b_group[3];
    SYNC();
    int jrow = 0;
    f32x4 vr[4][4]; u32x2 pr[4][4];
#pragma unroll
    for (int jj = 0; jj < 4; ++jj) { const int rl = (r + jj * rstep < NTOK) ? r + jj * rstep : r;
#pragma unroll
        for (int i = 0; i < 4; ++i) { vr[jj][i] = __builtin_nontemporal_load((const f32x4*)(xin + (size_t)rl * D + i * 256 + lane * 4)); pr[jj][i] = __builtin_nontemporal_load((const u32x2*)(proj + (size_t)rl * D + i * 256 + lane * 4)); } }
    const float n2a = P.norm2_g[TID], n2b = P.norm2_g[TID + 512];
    float msa, msb, mha, mhb;
    { const float* shift = mod + (r >> 13) * 6144 + 3 * 1024; msa = shift[1024 + TID]; msb = shift[1024 + TID + 512]; mha = shift[TID]; mhb = shift[TID + 512]; }
#pragma unroll 1
    for (; r < NTOK; ) {
        SYNC();
        gsv[TID] = n2a * (1.0f + msa); gsv[TID + 512] = n2b * (1.0f + msb); shv[TID] = mha; shv[TID + 512] = mhb;
        { const int rn = (r + 4 * rstep < NTOK) ? r + 4 * rstep : r; const float* shift = mod + (rn >> 13) * 6144 + 3 * 1024; msa = shift[1024 + TID]; msb = shift[1024 + TID + 512]; mha = shift[TID]; mhb = shift[TID + 512]; }
        SYNC();
#pragma unroll
      for (int jj = 0; jj < 4; ++jj) { if (r < NTOK) {
        f32x4 v[4]; float ss = 0.f;
#pragma unroll
        for (int i = 0; i < 4; ++i) { const u32x2 pw = pr[jj][i]; v[i] = vr[jj][i];
            v[i][0] += __builtin_bit_cast(float, pw[0] << 16); v[i][1] += __builtin_bit_cast(float, pw[0] & 0xffff0000u); v[i][2] += __builtin_bit_cast(float, pw[1] << 16); v[i][3] += __builtin_bit_cast(float, pw[1] & 0xffff0000u);
            ss += v[i][0] * v[i][0] + v[i][1] * v[i][1] + v[i][2] * v[i][2] + v[i][3] * v[i][3];
            if (!dry) { u32x2 xb; xb[0] = pk2(v[i][0], v[i][1]); xb[1] = pk2(v[i][2], v[i][3]);
                __builtin_nontemporal_store(xb, (u32x2*)((bf16_t*)(P.ws + WS_R4 + R4_X1B) + (size_t)r * D + i * 256 + lane * 4)); } }
        { const int rl = (r + 4 * rstep < NTOK) ? r + 4 * rstep : r;
#pragma unroll
          for (int i = 0; i < 4; ++i) { vr[jj][i] = __builtin_nontemporal_load((const f32x4*)(xin + (size_t)rl * D + i * 256 + lane * 4)); pr[jj][i] = __builtin_nontemporal_load((const u32x2*)(proj + (size_t)rl * D + i * 256 + lane * 4)); } }
        ss = wave_sum(ss);
        const float rstd = rsq_f(ss * (1.0f / 1024.0f) + EPS);
        float gl[4] = {0.f, 0.f, 0.f, 0.f};
#pragma unroll
        for (int i = 0; i < 4; ++i) {
            const int k = i * 256 + lane * 4;
            const f32x4 g2 = *(const f32x4*)(gsv + k), sh = *(const f32x4*)(shv + k);
#pragma unroll
            for (int e = 0; e < 4; ++e) v[i][e] = v[i][e] * rstd * g2[e] + sh[e];
#pragma unroll
            for (int j = 0; j < 4; ++j) { const f32x4 wv = *(const f32x4*)(wr + j * 1028 + k); gl[j] += v[i][0] * wv[0] + v[i][1] * wv[1] + v[i][2] * wv[2] + v[i][3] * wv[3]; }
#if MK_F8
            *(unsigned*)((unsigned char*)h2 + (size_t)r * D + k) = pk4_fp8(v[i][0], v[i][1], v[i][2], v[i][3]);
#else
            u32x2 w; w[0] = pk2(v[i][0], v[i][1]); w[1] = pk2(v[i][2], v[i][3]);
            *(u32x2*)(h2 + (size_t)r * D + k) = w;
#endif
        }
#pragma unroll
        for (int j = 0; j < 4; ++j) gl[j] += 0.f;
        { const float t = wave_sum_multi<4>(gl, lane);
#pragma unroll
          for (int j = 0; j < 4; ++j) gl[j] = lane_bcast(t, j) + (j == 0 ? bg0 : j == 1 ? bg1 : j == 2 ? bg2 : bg3); }
        int gsel = 0; float gmax = gl[0];
#pragma unroll
        for (int j = 1; j < 4; ++j) if (gl[j] > gmax) { gmax = gl[j]; gsel = j; }
        float gden = 0.f;
#pragma unroll
        for (int j = 0; j < 4; ++j) gden += __expf(gl[j] - gmax);
        const float pg = 1.0f / gden;
        float el[8] = {0.f, 0.f, 0.f, 0.f, 0.f, 0.f, 0.f, 0.f};
#pragma unroll
        for (int i = 0; i < 4; ++i)
#pragma unroll
            for (int j = 0; j < 8; ++j) { const f32x4 wv = *(const f32x4*)(wr + (4 + gsel * 8 + j) * 1028 + i * 256 + lane * 4); el[j] += v[i][0] * wv[0] + v[i][1] * wv[1] + v[i][2] * wv[2] + v[i][3] * wv[3]; }
#pragma unroll
        for (int j = 0; j < 8; ++j) el[j] += 0.f;
        { const float t = wave_sum_multi<8>(el, lane);
#pragma unroll
          for (int j = 0; j < 8; ++j) el[j] = lane_bcast(t, j) + brs[gsel * 8 + j]; }
        int e1 = 0; float m1 = el[0];
#pragma unroll
        for (int j = 1; j < 8; ++j) if (el[j] > m1) { m1 = el[j]; e1 = j; }
        int e2 = -1; float m2 = -3.0e38f;
#pragma unroll
        for (int j = 0; j < 8; ++j) if (j != e1 && el[j] > m2) { m2 = el[j]; e2 = j; }
        if (e2 < 0) e2 = (e1 + 1) & 7;
        const float p2 = __expf(m2 - m1);
        const float w1 = pg / (1.0f + p2), w2 = pg * p2 / (1.0f + p2);
        if (lane < 2) {
            const int ee = gsel * 8 + (lane == 0 ? e1 : e2); const float ww = lane == 0 ? w1 : w2;
            const unsigned pos = atomic_add_u32(&lc[ee], 1u);
            const int a = (jrow * 8 + wid) * 2 + lane;
            if (a < 512) { aE[a] = (unsigned)ee; aW[a] = ww; aP[a] = pos; }
        }
        ++jrow; r += rstep;
      } }
    }
    SYNC();
    if (TID < 32) lc[32 + TID] = atomic_add_u32(&cnt[TID * 64], lc[TID]);
    SYNC();
    { const int a = TID, rl = a >> 1, rr = BID * 8 + (rl & 7) + (rl >> 3) * rstep;
      if (rr < NTOK && (rl >> 3) < jrow) { const unsigned ee = aE[a]; const unsigned pos = lc[32 + ee] + aP[a];
          tokk[(size_t)ee * LCAP + pos] = (unsigned)rr * 2u + (unsigned)(a & 1); wl[(size_t)ee * LCAP + pos] = aW[a]; } }
}

DEV void phase11_final(const Params& P, unsigned char* sm, float* dstbase) {
    PHASE_TID;
    (void)sm;
    const float* mod = (const float*)(P.ws + WS_MOD);
    const int wid = TID >> 6, lane = TID & 63;
#if MK_F8
    typedef float f32x2_ __attribute__((ext_vector_type(2)));
    const unsigned char* Y = P.ws + WS_R4 + R4_Y;
    const bf16_t* proj = (const bf16_t*)(P.ws + WS_R4 + R4_X1B);
    for (int r0 = (BID * 8 + wid) * 2; r0 < NTOK; r0 += NBLK * 16) {
        u32x2 pj[2][4]; unsigned y0[2][4], y1[2][4];
#pragma unroll
        for (int u = 0; u < 2; ++u)
#pragma unroll
            for (int i = 0; i < 4; ++i) { const int k = i * 256 + lane * 4; const size_t r = (size_t)(r0 + u);
                pj[u][i] = __builtin_nontemporal_load((const u32x2*)(proj + r * D + k));
                y0[u][i] = __builtin_nontemporal_load((const unsigned*)(Y + r * D + k)); y1[u][i] = __builtin_nontemporal_load((const unsigned*)(Y + ((size_t)NTOK + r) * D + k)); }
        const float* gate = mod + (r0 >> 13) * 6144 + 5 * 1024;
#pragma unroll
        for (int u = 0; u < 2; ++u) {
            float* row = dstbase + (size_t)(r0 + u) * D;
            f32x4 v[4]; float ss = 0.f;
#pragma unroll
            for (int i = 0; i < 4; ++i) { const int k = i * 256 + lane * 4; const f32x4 gv = *(const f32x4*)(gate + k) * 0.0625f;
                const f32x2_ a0 = __builtin_amdgcn_cvt_pk_f32_fp8((int)y0[u][i], false), a1 = __builtin_amdgcn_cvt_pk_f32_fp8((int)y0[u][i], true);
                const f32x2_ b0 = __builtin_amdgcn_cvt_pk_f32_fp8((int)y1[u][i], false), b1 = __builtin_amdgcn_cvt_pk_f32_fp8((int)y1[u][i], true);
                f32x4 m; m[0] = a0[0] + b0[0]; m[1] = a0[1] + b0[1]; m[2] = a1[0] + b1[0]; m[3] = a1[1] + b1[1];
                f32x4 pv; pv[0] = __builtin_bit_cast(float, pj[u][i][0] << 16); pv[1] = __builtin_bit_cast(float, pj[u][i][0] & 0xffff0000u); pv[2] = __builtin_bit_cast(float, pj[u][i][1] << 16); pv[3] = __builtin_bit_cast(float, pj[u][i][1] & 0xffff0000u);
                v[i] = pv + gv * m; ss += v[i][0] * v[i][0] + v[i][1] * v[i][1] + v[i][2] * v[i][2] + v[i][3] * v[i][3]; }
            ss = wave_sum(ss);
            const float rstd = rsq_f(ss * (1.0f / 1024.0f) + EPS);
#pragma unroll
            for (int i = 0; i < 4; ++i) { const int k = i * 256 + lane * 4; const f32x4 fg = *(const f32x4*)(P.final_g + k); __builtin_nontemporal_store(v[i] * rstd * fg, (f32x4*)(row + k)); }
        }
    }
#else
    const bf16_t* Y = (const bf16_t*)(P.ws + WS_R4 + R4_Y);
    for (int r0 = (BID * 8 + wid) * 2; r0 < NTOK; r0 += NBLK * 16) {
        f32x4 xv[2][4]; u32x2 y0[2][4], y1[2][4];
#pragma unroll
        for (int u = 0; u < 2; ++u)
#pragma unroll
            for (int i = 0; i < 4; ++i) { const int k = i * 256 + lane * 4; const size_t r = (size_t)(r0 + u);
                xv[u][i] = *(const f32x4*)(P.out + r * D + k); y0[u][i] = *(const u32x2*)(Y + r * D + k); y1[u][i] = *(const u32x2*)(Y + ((size_t)NTOK + r) * D + k); }
        const float* gate = mod + (r0 >> 13) * 6144 + 5 * 1024;
#pragma unroll
        for (int u = 0; u < 2; ++u) {
            float* row = dstbase + (size_t)(r0 + u) * D;
            f32x4 v[4]; float ss = 0.f;
#pragma unroll
            for (int i = 0; i < 4; ++i) { const int k = i * 256 + lane * 4; const f32x4 gv = *(const f32x4*)(gate + k);
                f32x4 m; m[0] = bf2f((bf16_t)(y0[u][i][0] & 0xffffu)) + bf2f((bf16_t)(y1[u][i][0] & 0xffffu)); m[1] = bf2f((bf16_t)(y0[u][i][0] >> 16)) + bf2f((bf16_t)(y1[u][i][0] >> 16));
                m[2] = bf2f((bf16_t)(y0[u][i][1] & 0xffffu)) + bf2f((bf16_t)(y1[u][i][1] & 0xffffu)); m[3] = bf2f((bf16_t)(y0[u][i][1] >> 16)) + bf2f((bf16_t)(y1[u][i][1] >> 16));
                v[i] = xv[u][i] + gv * m; ss += v[i][0] * v[i][0] + v[i][1] * v[i][1] + v[i][2] * v[i][2] + v[i][3] * v[i][3]; }
            ss = wave_sum(ss);
            const float rstd = rsq_f(ss * (1.0f / 1024.0f) + EPS);
#pragma unroll
            for (int i = 0; i < 4; ++i) { const int k = i * 256 + lane * 4; const f32x4 fg = *(const f32x4*)(P.final_g + k); *(f32x4*)(row + k) = v[i] * rstd * fg; }
        }
    }
#endif
}

#ifndef CPU_EMU
#define XB_TMO      128
#define XB_XCNT(j)  (256  + 64 * (j))
#define XB_XSUB(j)  (1280 + 64 * (j))
#define XB_XGEN(j)  (2304 + 64 * (j))
#define XB_TOP      3328
#define XB_TOPGEN   3392
#define XCD_BAR_WORDS 3456
#define XB_SPIN_CAP (1u << 22)
#define LAS __attribute__((address_space(3)))
__device__ __forceinline__ unsigned xb_ld(unsigned* p)              { return __hip_atomic_load(p, __ATOMIC_RELAXED, __HIP_MEMORY_SCOPE_AGENT); }
__device__ __forceinline__ unsigned xb_add(unsigned* p, unsigned v) { return __hip_atomic_fetch_add(p, v, __ATOMIC_RELAXED, __HIP_MEMORY_SCOPE_AGENT); }
__device__ __forceinline__ unsigned xb_xcc_id() { return (unsigned)__builtin_amdgcn_s_getreg((3 << 11) | 20) & 0xFu; }
#define XB_SPIN(cond, bar) do { unsigned _sp = 0; while (cond) { __builtin_amdgcn_s_sleep(1); \
    if ((++_sp & 255u) == 0u) { if (xb_ld(&(bar)[XB_TMO])) break; if (_sp > XB_SPIN_CAP) { atomicAdd(&(bar)[XB_TMO], 1u); break; } } } } while (0)
struct XcdBarrier { unsigned* bar; unsigned x; volatile LAS unsigned* st; int wave; };
__device__ __forceinline__ XcdBarrier xcd_barrier_post(unsigned* bar, volatile LAS unsigned* st, int wave) {
    XcdBarrier b; b.bar = bar; b.x = xb_xcc_id(); b.st = st; b.wave = wave;
    if (MK_TID(wave) == 0) (void)xb_add(&bar[XB_XCNT(b.x)], 1u);
    return b;
}
__device__ __forceinline__ void xcd_barrier_complete(unsigned* bar, unsigned x, unsigned& nloc, unsigned& nx) {
    const unsigned G = gridDim.x * gridDim.y * gridDim.z;
    unsigned sum, cnt, mine, sp = 0u;
    for (;;) {
        sum = 0u; cnt = 0u; mine = 0u;
#pragma unroll
        for (unsigned j = 0; j < 16; ++j) { const unsigned c = xb_ld(&bar[XB_XCNT(j)]); sum += c; cnt += (c > 0u) ? 1u : 0u; mine = (j == x) ? c : mine; }
        if (sum == G) break;
        __builtin_amdgcn_s_sleep(1);
        if ((++sp & 255u) == 0u) { if (xb_ld(&bar[XB_TMO])) break; if (sp > XB_SPIN_CAP) { atomicAdd(&bar[XB_TMO], 1u); break; } }
    }
    nloc = mine > 0u ? mine : 1u; nx = cnt > 0u ? cnt : 1u;
}
__device__ __forceinline__ void xcd_barrier(const XcdBarrier& b) {
    asm volatile("s_waitcnt vmcnt(0)" ::: "memory");
    __syncthreads();
    if (MK_TID(b.wave) == 0) {
        unsigned* bar = b.bar;
        __builtin_amdgcn_s_waitcnt(0);
        unsigned nloc = b.st[0], nx = b.st[1];
        if (nloc == 0u) { xcd_barrier_complete(bar, b.x, nloc, nx); b.st[0] = nloc; b.st[1] = nx; }
        const unsigned old = xb_add(&bar[XB_XSUB(b.x)], 1u);
        const unsigned gen = old / nloc;
        if (old + 1u == (gen + 1u) * nloc) {
            __builtin_amdgcn_fence(__ATOMIC_RELEASE, "agent");
            asm volatile("s_waitcnt vmcnt(0)" ::: "memory");
            const unsigned og = xb_add(&bar[XB_TOP], 1u);
            const unsigned tg = og / nx;
            if (og + 1u == (tg + 1u) * nx) xb_add(&bar[XB_TOPGEN], 1u);
            else XB_SPIN(xb_ld(&bar[XB_TOPGEN]) == tg, bar);
            __builtin_amdgcn_fence(__ATOMIC_ACQUIRE, "agent");
            xb_add(&bar[XB_XGEN(b.x)], 1u);
            asm volatile("s_waitcnt vmcnt(0)" ::: "memory");
        } else {
            XB_SPIN(xb_ld(&bar[XB_XGEN(b.x)]) == gen, bar);
            __builtin_amdgcn_fence(__ATOMIC_ACQUIRE, "agent");
            asm volatile("s_waitcnt vmcnt(0)" ::: "memory");
        }
    }
    __syncthreads();
}

#ifndef MK_PH
#define MK_PH 0x7ff
#endif
#define REPS(k) for (int rep_ = 0; rep_ < (((MK_REP >> (k)) & 1) ? 2 : 1); ++rep_)
extern __shared__ __attribute__((aligned(16))) unsigned char smem_dyn[];

__device__ __forceinline__ void moe_tables(const Params& P, LAS int* tb, LAS int* cn) {
    const unsigned* cnt = (const unsigned*)(P.ws + WS_CNT);
    const int t_ = MK_TID(P.wave);
    if (t_ < 32) cn[t_] = (int)cnt[t_ * 64];
    __syncthreads();
    if (t_ == 0) { int acc = 0; for (int e = 0; e < 32; ++e) { tb[e] = acc; acc += (cn[e] + 255) >> 8; } tb[32] = acc; }
    __syncthreads();
    {
        LAS unsigned char* te = (LAS unsigned char*)tb + 512;
        for (int tile = t_; tile < 1536; tile += 512) { int e = 0;
#pragma unroll
            for (int sft = 16; sft >= 1; sft >>= 1) if (tb[e + sft] <= tile) e += sft;
            te[tile] = (unsigned char)e; }
    }
    __syncthreads();
}

__global__ void __launch_bounds__(512, 2) hymba_fwd(Params Pin) {
    Params P = Pin; P.wave = __builtin_amdgcn_readfirstlane((int)threadIdx.x >> 6);
    unsigned char* sm = smem_dyn;
    LAS unsigned char* lsm = (LAS unsigned char*)smem_dyn;
    volatile LAS unsigned* xbw = (volatile LAS unsigned*)(lsm + LDS_BYTES - 16);
    if (MK_TID(P.wave) == 0) { xbw[0] = 0u; xbw[1] = 0u; xbw[2] = 0u; xbw[3] = 0u; }
    __syncthreads();
    XcdBarrier bar = xcd_barrier_post((unsigned*)(P.ws + WS_BAR), xbw, P.wave);
    using namespace pg8;

#if (MK_PH >> 0) & 1
    REPS(15) phase0_mod(P, sm); REPS(0) { phase0_weights(P, sm); phase0_wf(P, sm); }
    xcd_barrier(bar);
#endif
#if (MK_PH >> 1) & 1
    REPS(1) phase1_prep(P, sm);
    xcd_barrier(bar);
#endif
#if (MK_PH >> 2) & 1
    REPS(2) {
    phase2_ctx(P, sm);
    { ProbInproj G; G.init(NTOK / 256, 8, gridDim.x, blockIdx.x); G.wv = P.wave; G.A = (const bf16_t*)(P.ws + WS_R4 + R4_H); G.Bt = (const bf16_t*)(P.ws + WS_WQKVZ); G.K = 1024;
      EpiInproj E; E.O = (bf16_t*)(P.ws + WS_R4 + R4_P); E.zs = (bf16_t*)((unsigned char*)P.out + DO_ZS); E.rstd = (const float*)(P.ws + WS_RSTD); E.bias = (const float*)(P.ws + WS_BIAS); gemm_phase(lsm, G, E); }
    { ProbGT G; G.init(4, NTOK / 256, gridDim.x, blockIdx.x); G.wv = P.wave; G.A = (const bf16_t*)(P.ws + WS_WF); G.Bt = (const bf16_t*)(P.ws + WS_R4 + R4_H); G.K = 1024;
      EpiGT E; E.O = (bf16_t*)((unsigned char*)P.out + DO_GT); E.rstd = (const float*)(P.ws + WS_RSTD); E.bias = (const float*)(P.ws + WS_BIAS); gemm_phase(lsm, G, E); }
    }
    xcd_barrier(bar);
#endif
#if (MK_PH >> 3) & 1
    REPS(3) phase3_conv(P, sm);
    xcd_barrier(bar);
#endif
#if (MK_PH >> 4) & 1
    REPS(4) phase4_prepass(P, sm);
    REPS(11) phase4_fft(P, sm);
    xcd_barrier(bar);
#endif
#if (MK_PH >> 5) & 1
#if (MK_REP >> 22) & 3
    phase5_scan<(MK_REP >> 22) & 3>(P, sm);
#endif
    REPS(5) phase5_scan<0>(P, sm);
    xcd_barrier(bar);
#endif
#if (MK_PH >> 6) & 1
    REPS(6) phase6_amix(P, sm);
    xcd_barrier(bar);
#endif
#if (MK_PH >> 7) & 1
#if (MK_REP >> 19) & 3
    { ProbOutHot G; G.init(NTOK / 256, 4, gridDim.x, blockIdx.x); G.wv = P.wave; G.hot = ((MK_REP >> 19) & 3) != 2; G.A = (const bf16_t*)(P.ws + WS_R4 + R4_AMIX); G.Bt = (const bf16_t*)(P.ws + WS_WOUT); G.K = (((MK_REP >> 19) & 3) == 3) ? 512 : 1024;
      EpiDry E; E.out = P.out; gemm_phase(lsm, G, E); }
    xcd_barrier(bar);
#endif
    REPS(7)
    { ProbOut G; G.init(NTOK / 256, 4, gridDim.x, blockIdx.x); G.wv = P.wave; G.A = (const bf16_t*)(P.ws + WS_R4 + R4_AMIX); G.Bt = (const bf16_t*)(P.ws + WS_WOUT); G.K = 1024;
      EpiProj E; E.mod = (const float*)(P.ws + WS_MOD); E.O = (bf16_t*)(P.ws + WS_R4 + R4_PROJ); gemm_phase(lsm, G, E); }
    xcd_barrier(bar);
#endif
#if (MK_PH >> 8) & 1
#if (MK_REP >> 13) & 1
    phase8_router(P, sm, 1);
#endif
    phase8_router(P, sm, 0);
#if (MK_REP >> 14) & 1
    xcd_barrier(bar); xcd_barrier(bar); xcd_barrier(bar); xcd_barrier(bar);
#endif
    xcd_barrier(bar);
#endif
#if (MK_PH >> 9) & 1
#if MK_F8 == 2
    LAS int* tb = (LAS int*)(lsm + STAGE_BYTES); LAS int* cn = tb + 64;
    moe_tables(P, tb, cn);
    REPS(9)
    { ProbMoe1P8 G; G.tb = tb; G.wv = P.wave; G.cnt = cn; G.G = gridDim.x; G.c = blockIdx.x; G.A = P.ws + WS_R4 + R4_H2; G.Bt = P.ws + WS_WGU; G.K = 512; G.tokk = (const unsigned*)(P.ws + WS_TOKK);
      EpiMoe1P8 E; E.hid = P.ws + WS_R4 + R4_HID; gemm_phase(lsm, G, E); }
    xcd_barrier(bar);
#if (MK_REP >> 18) & 1
    { ProbMoe2P8 G; G.tb = tb; G.wv = P.wave; G.cnt = cn; G.G = gridDim.x; G.c = blockIdx.x; G.A = P.ws + WS_R4 + R4_HID; G.Bt = P.ws + WS_WD; G.K = 256;
      EpiMoe2P8 E; E.dry = 1; E.Y = P.ws + WS_R4 + R4_Y; E.tokk = (const unsigned*)(P.ws + WS_TOKK); E.wl = (const float*)(P.ws + WS_WL); E.tb = tb; gemm_phase(lsm, G, E); }
    xcd_barrier(bar);
#endif
    REPS(10)
    { ProbMoe2P8 G; G.tb = tb; G.wv = P.wave; G.cnt = cn; G.G = gridDim.x; G.c = blockIdx.x; G.A = P.ws + WS_R4 + R4_HID; G.Bt = P.ws + WS_WD; G.K = 256;
      EpiMoe2P8 E; E.Y = P.ws + WS_R4 + R4_Y; E.tokk = (const unsigned*)(P.ws + WS_TOKK); E.wl = (const float*)(P.ws + WS_WL); E.tb = tb; gemm_phase(lsm, G, E); }
    xcd_barrier(bar);
#elif MK_F8
    LAS int* tb = (LAS int*)(lsm + F8_LDS); LAS int* cn = tb + 64;
    moe_tables(P, tb, cn);
#if (MK_REP >> 16) & 3
    { ProbMoe1F8 G; G.tb = tb; G.wv = P.wave; G.cnt = cn; G.G = gridDim.x; G.c = blockIdx.x; G.A = P.ws + WS_R4 + R4_H2; G.Bt = P.ws + WS_WGU; G.KB = 1024; G.tokk = (const unsigned*)(P.ws + WS_TOKK);
      EpiMoe1F8 E; E.hid = P.ws + WS_R4 + R4_HID; gemm_f8<ProbMoe1F8, EpiMoe1F8, (MK_REP >> 16) & 3>(lsm, G, E); }
    xcd_barrier(bar);
#endif
    REPS(9)
    { ProbMoe1F8 G; G.tb = tb; G.wv = P.wave; G.cnt = cn; G.G = gridDim.x; G.c = blockIdx.x; G.A = P.ws + WS_R4 + R4_H2; G.Bt = P.ws + WS_WGU; G.KB = 1024; G.tokk = (const unsigned*)(P.ws + WS_TOKK);
      EpiMoe1F8 E; E.hid = P.ws + WS_R4 + R4_HID; gemm_f8(lsm, G, E); }
    xcd_barrier(bar);
    REPS(10)
    { ProbMoe2F8 G; G.tb = tb; G.wv = P.wave; G.cnt = cn; G.G = gridDim.x; G.c = blockIdx.x; G.A = P.ws + WS_R4 + R4_HID; G.Bt = P.ws + WS_WD; G.KB = 512;
      EpiMoe2F8 E; E.Y = P.ws + WS_R4 + R4_Y; E.tokk = (const unsigned*)(P.ws + WS_TOKK); E.wl = (const float*)(P.ws + WS_WL); E.tb = tb; gemm_f8(lsm, G, E); }
    xcd_barrier(bar);
#else
    LAS int* tb = (LAS int*)(lsm + STAGE_BYTES); LAS int* cn = tb + 64;
    moe_tables(P, tb, cn);
    REPS(9)
    { ProbMoe1 G; G.tb = tb; G.wv = P.wave; G.cnt = cn; G.G = gridDim.x; G.c = blockIdx.x; G.A = (const bf16_t*)(P.ws + WS_R4 + R4_H2); G.Bt = (const bf16_t*)(P.ws + WS_WGU); G.K = 1024; G.tokk = (const unsigned*)(P.ws + WS_TOKK);
      EpiMoe1 E; E.hid = (bf16_t*)(P.ws + WS_R4 + R4_HID); gemm_phase(lsm, G, E); }
    xcd_barrier(bar);
    REPS(10)
    { ProbMoe2 G; G.tb = tb; G.wv = P.wave; G.cnt = cn; G.G = gridDim.x; G.c = blockIdx.x; G.A = (const bf16_t*)(P.ws + WS_R4 + R4_HID); G.Bt = (const bf16_t*)(P.ws + WS_WD); G.K = 512;
      EpiMoe2 E; E.Y = (bf16_t*)(P.ws + WS_R4 + R4_Y); E.tokk = (const unsigned*)(P.ws + WS_TOKK); E.wl = (const float*)(P.ws + WS_WL); E.tb = tb; gemm_phase(lsm, G, E); }
    xcd_barrier(bar);
#endif
#endif
#if (MK_PH >> 10) & 1
#if (MK_REP >> 12) & 1
    phase11_final(P, sm, (float*)(P.ws + WS_R4 + 300 * MiB));
#endif
    phase11_final(P, sm, P.out);
#endif
}

extern "C" void kernel_launch(void* const* d_in, const int* in_sizes, int n_in, void* d_out, int out_size, void* d_ws, size_t ws_size, hipStream_t stream) {
    (void)in_sizes; (void)n_in; (void)out_size;
    static int grid = 0;
    if (!grid) {
        int dev = 0, cus = 0, per_cu = 0;
        hipGetDevice(&dev);
        hipDeviceGetAttribute(&cus, hipDeviceAttributeMultiprocessorCount, dev);
        hipFuncSetAttribute((const void*)hymba_fwd, hipFuncAttributeMaxDynamicSharedMemorySize, LDS_BYTES);
        hipOccupancyMaxActiveBlocksPerMultiprocessor(&per_cu, hymba_fwd, 512, LDS_BYTES);
        if (per_cu < 1) { fprintf(stderr, "occupancy query says 0 blocks per CU\n"); per_cu = 1; }
        grid = cus;
        if (ws_size < WS_NEED) fprintf(stderr, "workspace too small: %zu < %zu\n", ws_size, (size_t)WS_NEED);
    }
    Params p{};
    p.x = (const float*)d_in[0]; p.c = (const float*)d_in[1]; p.ctx = (const float*)d_in[2]; p.c_ctx = (const float*)d_in[3]; p.w_mod = (const float*)d_in[4]; p.b_mod = (const float*)d_in[5];
    p.norm1_g = (const float*)d_in[6]; p.w_in = (const float*)d_in[7]; p.conv_w = (const float*)d_in[8]; p.a_log = (const float*)d_in[9]; p.dt_bias = (const float*)d_in[10]; p.onorm_g = (const float*)d_in[11];
    p.w_out = (const float*)d_in[12]; p.norm2_g = (const float*)d_in[13]; p.w_group = (const float*)d_in[14]; p.b_group = (const float*)d_in[15]; p.w_router = (const float*)d_in[16]; p.b_router = (const float*)d_in[17];
    p.w_gate = (const float*)d_in[18]; p.w_up = (const float*)d_in[19]; p.w_down = (const float*)d_in[20]; p.final_g = (const float*)d_in[21];
    p.out = (float*)d_out; p.ws = (unsigned char*)d_ws;
    hipMemsetAsync(d_ws, 0, WS_ZERO_BYTES, stream);
    hipLaunchKernelGGL(hymba_fwd, dim3(grid), dim3(512), LDS_BYTES, stream, p);
}
#endif
```
